# Optimizing an MI355X kernel written in HIP

```python
import math
import jax
import jax.numpy as jnp
from jax import lax
import numpy as np

D_MODEL = 1024
BATCH = 2
SEQ = 8192
DEPTH = 4

GRID_W = 64
CTX_LEN = 256
HEAD_DIM = 64
A_HEADS = (3 * D_MODEL) // (8 * HEAD_DIM)
A_WIDTH = A_HEADS * HEAD_DIM
B_WIDTH = D_MODEL // 4
HYENA_ORDER = 2
C_HEADS = (3 * D_MODEL) // (8 * HEAD_DIM)
C_KV_HEADS = 2
C_WIDTH = C_HEADS * HEAD_DIM
C_KV_WIDTH = C_KV_HEADS * HEAD_DIM
MIX_WIDTH = A_WIDTH + B_WIDTH + C_WIDTH
SPLIT_SIZES = (A_WIDTH, A_WIDTH, A_WIDTH, A_WIDTH, (HYENA_ORDER + 1) * B_WIDTH, B_WIDTH, C_WIDTH, C_KV_WIDTH, C_KV_WIDTH, C_WIDTH)
IN_WIDTH = 4 * A_WIDTH + (HYENA_ORDER + 2) * B_WIDTH + 2 * C_WIDTH + 2 * C_KV_WIDTH
NA_KH = 8
NA_KW = 16
WINDOW = 128
C_BLOCK = 128
ROPE_BASE = 10000.0
HY_EMB = 33
HY_BANDS = (HY_EMB - 1) // 2
HY_FILTER_WIDTH = 64
HY_SHORT = 3
HY_FAST_DECAY = 0.3
HY_SLOW_DECAY = 1.5
HY_TARGET = 1e-2
RMS_EPS = 1e-6
NEG_INF = -1e30

kernel_name = 'hybrid_natten_hyena_swa_prefix_block'


def rmsnorm(x, g):
    xf = x.astype(jnp.float32)
    y = xf * lax.rsqrt(jnp.mean(xf * xf, axis=-1, keepdims=True) + RMS_EPS)
    return (y * g.astype(jnp.float32)).astype(x.dtype)


def split_proj(p):
    parts, start = [], 0
    for size in SPLIT_SIZES:
        parts.append(p[..., start:start + size])
        start += size
    return parts


def to_heads(t, n_heads):
    return t.reshape(t.shape[:-1] + (n_heads, HEAD_DIM))


def rope_1d(x, pos):
    half = x.shape[-1] // 2
    inv = ROPE_BASE ** (-jnp.arange(half, dtype=jnp.float32) / half)
    ang = pos.astype(jnp.float32)[:, None] * inv[None, :]
    cos = jnp.cos(ang)[:, None, :]
    sin = jnp.sin(ang)[:, None, :]
    xf = x.astype(jnp.float32)
    x1, x2 = xf[..., :half], xf[..., half:]
    return jnp.concatenate([x1 * cos - x2 * sin, x2 * cos + x1 * sin], axis=-1).astype(x.dtype)


def rope_2d(x, row, col):
    half = HEAD_DIM // 2
    return jnp.concatenate([rope_1d(x[..., :half], row), rope_1d(x[..., half:], col)], axis=-1)


def attend_context(q, k, v, sink):
    bsz, lq, nh, dh = q.shape
    nkv = k.shape[2]
    lk = k.shape[1]
    qg = q.reshape(bsz, lq, nkv, nh // nkv, dh)
    s = jnp.einsum('bqkgd,bmkd->bkgqm', qg, k).astype(jnp.float32) * (dh ** -0.5)
    if sink is not None:
        s_sink = jnp.broadcast_to(sink.astype(jnp.float32).reshape(1, nkv, nh // nkv, 1, 1), s.shape[:-1] + (1,))
        s = jnp.concatenate([s, s_sink], axis=-1)
    p = jax.nn.softmax(s, axis=-1)[..., :lk].astype(v.dtype)
    o = jnp.einsum('bkgqm,bmkd->bqkgd', p, v)
    return o.reshape(bsz, lq, nh * dh)


def neighbourhood_attention(q, k, v, k_ctx, v_ctx, rpb):
    bsz, seq, nh, dh = q.shape
    rows = seq // GRID_W
    kh = min(NA_KH, rows)
    kw = NA_KW
    scale = dh ** -0.5
    qg = q.reshape(bsz, rows, GRID_W, nh, dh)
    kg = k.reshape(bsz, rows, GRID_W, nh, dh)
    vg = v.reshape(bsz, rows, GRID_W, nh, dh)
    col = jnp.arange(GRID_W)
    c0 = jnp.clip(col - kw // 2, 0, GRID_W - kw)
    col_idx = c0[:, None] + jnp.arange(kw)[None, :]
    rel_col = col_idx - col[:, None] + (NA_KW - 1)
    bias_cols = rpb[:, :, rel_col]

    def row_block(r):
        r0 = jnp.clip(r - kh // 2, 0, rows - kh)
        q_r = lax.dynamic_index_in_dim(qg, r, axis=1, keepdims=False)
        k_r = lax.dynamic_slice_in_dim(kg, r0, kh, axis=1)[:, :, col_idx]
        v_r = lax.dynamic_slice_in_dim(vg, r0, kh, axis=1)[:, :, col_idx]
        rel_row = r0 + jnp.arange(kh) - r + (NA_KH - 1)
        bias = bias_cols[:, rel_row].transpose(0, 2, 1, 3)
        s_nb = jnp.einsum('bjhd,bajkhd->bhjak', q_r, k_r).astype(jnp.float32) * scale + bias[None].astype(jnp.float32)
        s_nb = s_nb.reshape(bsz, nh, GRID_W, kh * kw)
        s_cx = jnp.einsum('bjhd,bmhd->bhjm', q_r, k_ctx).astype(jnp.float32) * scale
        p = jax.nn.softmax(jnp.concatenate([s_nb, s_cx], axis=-1), axis=-1).astype(v.dtype)
        p_nb = p[..., :kh * kw].reshape(bsz, nh, GRID_W, kh, kw)
        p_cx = p[..., kh * kw:]
        return jnp.einsum('bhjak,bajkhd->bjhd', p_nb, v_r) + jnp.einsum('bhjm,bmhd->bjhd', p_cx, v_ctx)

    out = lax.map(row_block, jnp.arange(rows))
    return jnp.moveaxis(out, 0, 1).reshape(bsz, seq, nh * dh)


def window_attention(q, k, v, k_ctx, v_ctx, sink):
    bsz, seq, nh, dh = q.shape
    nkv = k.shape[2]
    g = nh // nkv
    ctx_len = k_ctx.shape[1]
    nblk = seq // C_BLOCK
    span = C_BLOCK + 2 * WINDOW
    scale = dh ** -0.5
    kp = jnp.pad(k, ((0, 0), (WINDOW, WINDOW), (0, 0), (0, 0)))
    vp = jnp.pad(v, ((0, 0), (WINDOW, WINDOW), (0, 0), (0, 0)))
    qb = q.reshape(bsz, nblk, C_BLOCK, nkv, g, dh)
    sink_l = sink.astype(jnp.float32).reshape(1, nkv, g, 1, 1)
    qi = jnp.arange(C_BLOCK)
    mi = jnp.arange(span)

    def block(n):
        start = n * C_BLOCK
        q_n = lax.dynamic_index_in_dim(qb, n, axis=1, keepdims=False)
        k_n = lax.dynamic_slice_in_dim(kp, start, span, axis=1)
        v_n = lax.dynamic_slice_in_dim(vp, start, span, axis=1)
        q_pos = start + qi
        k_pos = start - WINDOW + mi
        valid = (jnp.abs(q_pos[:, None] - k_pos[None, :]) <= WINDOW) & (k_pos >= 0)[None, :] & (k_pos < seq)[None, :]
        s_w = jnp.einsum('bqkgd,bmkd->bkgqm', q_n, k_n).astype(jnp.float32) * scale
        s_w = jnp.where(valid, s_w, NEG_INF)
        s_c = jnp.einsum('bqkgd,bmkd->bkgqm', q_n, k_ctx).astype(jnp.float32) * scale
        s_s = jnp.broadcast_to(sink_l, (bsz, nkv, g, C_BLOCK, 1))
        p = jax.nn.softmax(jnp.concatenate([s_w, s_c, s_s], axis=-1), axis=-1).astype(v.dtype)
        o = jnp.einsum('bkgqm,bmkd->bqkgd', p[..., :span], v_n) + jnp.einsum('bkgqm,bmkd->bqkgd', p[..., span:span + ctx_len], v_ctx)
        return o.reshape(bsz, C_BLOCK, nh * dh)

    out = lax.map(block, jnp.arange(nblk))
    return jnp.moveaxis(out, 0, 1).reshape(bsz, seq, nh * dh)


def hyena_filter_spectrum(L, w1, b1, fr1, w2, b2, fr2, w3):
    f32 = jnp.float32
    t = jnp.linspace(0.0, 1.0, L, dtype=f32)[:, None]
    w = (2.0 * math.pi / L) * jnp.arange(L, dtype=f32)[:, None]
    f = jnp.linspace(1e-4, HY_BANDS - 1, HY_BANDS, dtype=f32)[None, :]
    z = jnp.concatenate([t, jnp.cos(f * w), -jnp.sin(f * w)], axis=-1)
    h = jnp.sin(fr1.astype(f32) * (z @ w1.astype(f32) + b1.astype(f32)))
    h = jnp.sin(fr2.astype(f32) * (h @ w2.astype(f32) + b2.astype(f32)))
    h = (h @ w3.astype(f32)).reshape(L, 2, HYENA_ORDER, B_WIDTH)
    max_decay = math.log(HY_TARGET) / HY_FAST_DECAY
    min_decay = math.log(HY_TARGET) / HY_SLOW_DECAY
    deltas = jnp.abs(jnp.linspace(min_decay, max_decay, B_WIDTH, dtype=f32))
    h = h * jnp.exp(-t * deltas[None, :])[:, None, None, :]
    kern = jnp.concatenate([h[:, 0], jnp.zeros((1, HYENA_ORDER, B_WIDTH), f32), h[1:, 1][::-1]], axis=0)
    kern = kern * lax.rsqrt(jnp.sum(kern * kern, axis=0, keepdims=True) + 1e-6)
    return jnp.fft.rfft(kern, axis=0)


def long_conv(u, spec, d):
    L = u.shape[1]
    uf = u.astype(jnp.float32)
    y = jnp.fft.irfft(jnp.fft.rfft(uf, n=2 * L, axis=1) * spec[None], n=2 * L, axis=1)[:, :L]
    return (y + uf * d.astype(jnp.float32)).astype(u.dtype)


def short_conv(u, w, b):
    up = jnp.pad(u, ((0, 0), (1, 1), (0, 0)))
    return up[:, :-2] * w[0] + up[:, 1:-1] * w[1] + up[:, 2:] * w[2] + b


def hyena_mixer(proj, conv_w, conv_b, spec, d_skip):
    u = short_conv(proj, conv_w, conv_b)
    z, x1, x2 = jnp.split(u, HYENA_ORDER + 1, axis=-1)
    for o, gate in enumerate((x1, x2)):
        z = gate * long_conv(z, spec[:, o], d_skip[o])
    return z


def setup_inputs(seed: int = 0) -> dict:
    key = jax.random.key(seed)
    ks = jax.random.split(key, 22)
    f32 = jnp.float32

    def nrm(k, shape, s):
        return s * jax.random.normal(k, shape, f32)

    return {
        'x': nrm(ks[0], (BATCH, SEQ, D_MODEL), 1.0),
        'c': nrm(ks[1], (BATCH, D_MODEL), 1.0),
        'ctx': nrm(ks[2], (BATCH, CTX_LEN, D_MODEL), 1.0),
        'c_ctx': nrm(ks[3], (D_MODEL,), 1.0),
        'norm_g': 1.0 + nrm(ks[4], (DEPTH, D_MODEL), 0.02),
        'w_ada': nrm(ks[5], (DEPTH, D_MODEL, 3 * D_MODEL), 0.5 * D_MODEL ** -0.5),
        'b_ada': nrm(ks[6], (DEPTH, 3 * D_MODEL), 0.01),
        'w_in': nrm(ks[7], (DEPTH, D_MODEL, IN_WIDTH), D_MODEL ** -0.5),
        'w_out': nrm(ks[8], (DEPTH, MIX_WIDTH, D_MODEL), MIX_WIDTH ** -0.5),
        'na_rpb': nrm(ks[9], (DEPTH, A_HEADS, 2 * NA_KH - 1, 2 * NA_KW - 1), 0.1),
        'hy_conv_w': nrm(ks[10], (DEPTH, HY_SHORT, (HYENA_ORDER + 1) * B_WIDTH), HY_SHORT ** -0.5),
        'hy_conv_b': nrm(ks[11], (DEPTH, (HYENA_ORDER + 1) * B_WIDTH), 0.01),
        'hy_w1': nrm(ks[12], (DEPTH, HY_EMB, HY_FILTER_WIDTH), 1.0),
        'hy_b1': nrm(ks[13], (DEPTH, HY_FILTER_WIDTH), 0.1),
        'hy_freq1': 1.0 + nrm(ks[14], (DEPTH, HY_FILTER_WIDTH), 0.01),
        'hy_w2': nrm(ks[15], (DEPTH, HY_FILTER_WIDTH, HY_FILTER_WIDTH), HY_FILTER_WIDTH ** -0.5),
        'hy_b2': nrm(ks[16], (DEPTH, HY_FILTER_WIDTH), 0.1),
        'hy_freq2': 1.0 + nrm(ks[17], (DEPTH, HY_FILTER_WIDTH), 0.01),
        'hy_w3': nrm(ks[18], (DEPTH, HY_FILTER_WIDTH, 2 * HYENA_ORDER * B_WIDTH), HY_FILTER_WIDTH ** -0.5),
        'hy_d': nrm(ks[19], (DEPTH, HYENA_ORDER, B_WIDTH), 0.3),
        'sink': nrm(ks[20], (DEPTH, C_HEADS), 1.0),
        'final_g': 1.0 + nrm(ks[21], (D_MODEL,), 0.02),
    }


def reference(x, c, ctx, c_ctx, norm_g, w_ada, b_ada, w_in, w_out, na_rpb, hy_conv_w, hy_conv_b, hy_w1, hy_b1, hy_freq1, hy_w2, hy_b2, hy_freq2, hy_w3, hy_d, sink, final_g):
    seq = x.shape[1]
    ctx_len = ctx.shape[1]
    pos = jnp.arange(seq)
    row, col = pos // GRID_W, pos % GRID_W
    cx = ctx
    for l in range(DEPTH):
        last = l == DEPTH - 1
        shift, scale, gate = jnp.split(jax.nn.silu(c) @ w_ada[l] + b_ada[l], 3, axis=-1)
        shift_c, scale_c, gate_c = jnp.split(jax.nn.silu(c_ctx) @ w_ada[l] + b_ada[l], 3, axis=-1)
        h = rmsnorm(x, norm_g[l]) * (1.0 + scale[:, None]) + shift[:, None]
        hc = rmsnorm(cx, norm_g[l]) * (1.0 + scale_c) + shift_c
        qa, ka, va, ga, pb, gb, qc, kc, vc, gc = split_proj(h @ w_in[l])
        cqa, cka, cva, cga, cpb, cgb, cqc, ckc, cvc, cgc = split_proj(hc @ w_in[l])
        filt = (hy_w1[l], hy_b1[l], hy_freq1[l], hy_w2[l], hy_b2[l], hy_freq2[l], hy_w3[l])
        ka_ctx, va_ctx = to_heads(cka, A_HEADS), to_heads(cva, A_HEADS)
        kc_ctx, vc_ctx = to_heads(ckc, C_KV_HEADS), to_heads(cvc, C_KV_HEADS)
        y_a = neighbourhood_attention(to_heads(qa, A_HEADS), to_heads(ka, A_HEADS), to_heads(va, A_HEADS), ka_ctx, va_ctx, na_rpb[l])
        y_b = hyena_mixer(pb, hy_conv_w[l], hy_conv_b[l], hyena_filter_spectrum(seq, *filt), hy_d[l])
        y_c = window_attention(rope_2d(to_heads(qc, C_HEADS), row, col), rope_2d(to_heads(kc, C_KV_HEADS), row, col), to_heads(vc, C_KV_HEADS), kc_ctx, vc_ctx, sink[l])
        y = jnp.concatenate([y_a * jax.nn.silu(ga), y_b * jax.nn.silu(gb), y_c * jax.nn.silu(gc)], axis=-1) @ w_out[l]
        x_next = x + gate[:, None] * y
        if not last:
            yc_a = attend_context(to_heads(cqa, A_HEADS), ka_ctx, va_ctx, None)
            yc_b = hyena_mixer(cpb, hy_conv_w[l], hy_conv_b[l], hyena_filter_spectrum(ctx_len, *filt), hy_d[l])
            yc_c = attend_context(to_heads(cqc, C_HEADS), kc_ctx, vc_ctx, sink[l])
            yc = jnp.concatenate([yc_a * jax.nn.silu(cga), yc_b * jax.nn.silu(cgb), yc_c * jax.nn.silu(cgc)], axis=-1) @ w_out[l]
            cx = cx + gate_c * yc
        x = x_next
    return rmsnorm(x, final_g)
```

```cpp
#include <hip/hip_runtime.h>
#include <hip/hip_cooperative_groups.h>
#include <cstdio>
#include <cstdint>
namespace cg = cooperative_groups;

#ifndef MK_MULTI
#define MK_MULTI 1
#endif

namespace pg8 {
#define PG8_LAS __attribute__((address_space(3)))
typedef unsigned short bf16_t;
typedef short bf16x8 __attribute__((ext_vector_type(8)));
typedef float f32x4 __attribute__((ext_vector_type(4)));
typedef unsigned u32x4 __attribute__((ext_vector_type(4)));
constexpr int BM = 256, BK = 64, HALF = 128, HTB = HALF * BK * 2  , STAGE_BYTES = 8 * HTB, NXCD = 8, WGM = 8;

__host__ __device__ __forceinline__ int lds_byte(int r, int c) { const int st = (r >> 4) * 2 + (c >> 5), rr = r & 15, cc = c & 31, ob = rr * 64 + cc * 2; return st * 1024 + (ob ^ (((ob >> 9) & 1) << 5)); }
__host__ __device__ __forceinline__ void stage_rc(int b, int& R, int& C) { const int st = b / 1024, sb = b % 1024, swz = sb ^ (((sb >> 9) & 1) << 5); R = (st >> 1) * 16 + swz / 64; C = (st & 1) * 32 + (swz % 64) / 2; }
__host__ __device__ __forceinline__ int perm32(int rho) { const int n = rho >> 4, i = rho & 15; return 8 * (i >> 2) + 4 * n + (i & 3); }

struct Unit { int pm, pn; };
struct Gemm { const bf16_t* A; const bf16_t* Bt; int M, N, K; };

struct StaticOrder {
    int nM, nN, nwg, G, c;
    __host__ __device__ void init(int M, int N, int G_, int c_) { nM = M / BM; nN = N / BM; nwg = nM * nN; G = G_; c = c_; }
    __host__ __device__ bool next(int i, Unit& u) const {
        const long L = (long)i * G + c; if (L >= nwg) return false;
        int wgid = (int)L; { const int q = nwg / NXCD, r = nwg % NXCD, xcd = wgid % NXCD, off = wgid / NXCD; wgid = (xcd < r ? xcd * (q + 1) : r * (q + 1) + (xcd - r) * q) + off; }
        const int nig = WGM * nN, gid = wgid / nig, fm = gid * WGM, gsz = (nM - fm) < WGM ? (nM - fm) : WGM;
        u.pm = fm + ((wgid % nig) % gsz); u.pn = (wgid % nig) / gsz; return true;
    }
    __device__ __forceinline__ void a_ready(const Unit&) const {}
    __device__ __forceinline__ void done(const Unit&) const {}
};

template <class Epi, class Sched, bool ALIGN_EPI = false, bool SP2 = false>
__device__ __forceinline__ void gemm_phase(PG8_LAS unsigned char* lds, const Gemm g, const Sched& S, const Epi& E) {
    const int tid = threadIdx.x, wid = __builtin_amdgcn_readfirstlane(tid >> 6), lane = tid & 63, wr = wid >> 2, wc = wid & 3, fr = lane & 15, fq = lane >> 4;
    const int K = g.K, nt = K / BK;
    unsigned voffA[2], voffB[2];
#pragma unroll
    for (int i = 0; i < 2; ++i) { int R, C; stage_rc(tid * 16 + i * 8192, R, C); const int Rb = Epi::PERM ? ((R & ~31) + perm32(R & 31)) : R;
        voffA[i] = (unsigned)(R * K + C) * 2u; voffB[i] = (unsigned)(Rb * K + C) * 2u; }
    const size_t kstep = (size_t)(BK * 2);
    const size_t hstep = (size_t)HALF * K * 2;
    const size_t tstep = 2 * hstep;
    const unsigned ldsw = (unsigned)wid * 1024u;
    const int aoff = lds_byte(wr * 64 + fr, fq * 8), boff = lds_byte(wc * 32 + fr, fq * 8);
#define PG8_SA(b, h) (((b) * 2 + (h)) * HTB)
#define PG8_SB(b, h) ((4 + (b) * 2 + (h)) * HTB)
#define PG8_STAGE(bufoff, gbase, voff) do { _Pragma("unroll") for (int _i = 0; _i < 2; ++_i) \
        __builtin_amdgcn_global_load_lds((const unsigned*)((const char*)(gbase) + (voff)[_i]), (PG8_LAS unsigned*)(lds + (bufoff) + ldsw + _i * 8192), 16, 0, 0); } while (0)
#define PG8_LDA(dst, b, h) do { _Pragma("unroll") for (int m = 0; m < 4; ++m) _Pragma("unroll") for (int k = 0; k < 2; ++k) dst[m][k] = *(const PG8_LAS bf16x8*)(lds + PG8_SA(b, h) + aoff + m * 2048 + k * 1024); } while (0)
#define PG8_LDB(dst, b, h) do { _Pragma("unroll") for (int n = 0; n < 2; ++n) _Pragma("unroll") for (int k = 0; k < 2; ++k) dst[n][k] = *(const PG8_LAS bf16x8*)(lds + PG8_SB(b, h) + boff + n * 2048 + k * 1024); } while (0)
#define PG8_MMA(ai, bj, At, Bt) do { __builtin_amdgcn_s_setprio(1); _Pragma("unroll") for (int m = 0; m < 4; ++m) _Pragma("unroll") for (int n = 0; n < 2; ++n) _Pragma("unroll") for (int k = 0; k < 2; ++k) \
        acc[ai][bj][m][n] = __builtin_amdgcn_mfma_f32_16x16x32_bf16(Bt[n][k], At[m][k], acc[ai][bj][m][n], 0, 0, 0); __builtin_amdgcn_s_setprio(0); } while (0)
#define PG8_WAIT_V(n) asm volatile("s_waitcnt vmcnt(" #n ")" ::: "memory")
#define PG8_WAIT_L(n) asm volatile("s_waitcnt lgkmcnt(" #n ")" ::: "memory")
#define PG8_BAR __builtin_amdgcn_s_barrier()
#define PG8_SCHED __builtin_amdgcn_sched_barrier(0)
    Unit cur, nxt; int ui = 0;
    if (!S.next(0, cur)) return;
    f32x4 acc[2][2][4][2];
#pragma unroll
    for (int a = 0; a < 2; ++a)
#pragma unroll
        for (int b = 0; b < 2; ++b)
#pragma unroll
            for (int m = 0; m < 4; ++m)
#pragma unroll
                for (int n = 0; n < 2; ++n) acc[a][b][m][n] = (f32x4){0.f, 0.f, 0.f, 0.f};
    bf16x8 At[4][2], B0[2][2], B1[2][2];
    const char* cA = (const char*)g.A + (size_t)cur.pm * tstep; const char* cB = (const char*)g.Bt + (size_t)cur.pn * tstep;
    S.a_ready(cur);
    if constexpr (SP2) {
        PG8_STAGE(PG8_SB(0, 0), cB, voffB); PG8_STAGE(PG8_SB(0, 1), cB + hstep, voffB); PG8_STAGE(PG8_SA(0, 0), cA, voffA); PG8_STAGE(PG8_SA(0, 1), cA + hstep, voffA);
        if (wr == 1) PG8_BAR;
        PG8_WAIT_V(2); PG8_BAR;
        PG8_STAGE(PG8_SB(1, 0), cB + kstep, voffB); PG8_STAGE(PG8_SA(1, 0), cA + kstep, voffA); PG8_STAGE(PG8_SB(1, 1), cB + hstep + kstep, voffB);
        PG8_WAIT_V(6); PG8_BAR;
    } else {
        PG8_STAGE(PG8_SB(0, 0), cB, voffB); PG8_STAGE(PG8_SA(0, 0), cA, voffA); PG8_STAGE(PG8_SB(0, 1), cB + hstep, voffB); PG8_STAGE(PG8_SA(0, 1), cA + hstep, voffA);
        if (wr == 1) PG8_BAR;
        PG8_WAIT_V(4); PG8_BAR;
        PG8_STAGE(PG8_SB(1, 0), cB + kstep, voffB); PG8_STAGE(PG8_SA(1, 0), cA + kstep, voffA); PG8_STAGE(PG8_SB(1, 1), cB + hstep + kstep, voffB);
        PG8_WAIT_V(6); PG8_BAR;
    }
    for (;;) {
        const bool has_next = S.next(ui + 1, nxt);
        const char* nA = has_next ? (const char*)g.A + (size_t)nxt.pm * tstep : cA; const char* nB = has_next ? (const char*)g.Bt + (size_t)nxt.pn * tstep : cB;
        for (int t = 0; t < nt; t += 2) {
            const bool last = (t == nt - 2);
            const char* a1 = cA + (size_t)(t + 1) * kstep;
            const char* a2 = last ? nA : cA + (size_t)(t + 2) * kstep; const char* b2 = last ? nB : cB + (size_t)(t + 2) * kstep;
            const char* a3 = a2 + kstep; const char* b3 = b2 + kstep;
            if (last && has_next) S.a_ready(nxt);
            if constexpr (SP2) {
            PG8_LDB(B0, 0, 0); PG8_LDB(B1, 0, 1); PG8_SCHED; PG8_LDA(At, 0, 0); PG8_STAGE(PG8_SA(1, 1), a1 + hstep, voffA);
            PG8_WAIT_V(8); PG8_WAIT_L(0); PG8_BAR; PG8_MMA(0, 0, At, B0); PG8_MMA(0, 1, At, B1); PG8_BAR; PG8_SCHED;
            PG8_LDA(At, 0, 1); PG8_STAGE(PG8_SB(0, 0), b2, voffB); PG8_STAGE(PG8_SB(0, 1), b2 + hstep, voffB); PG8_STAGE(PG8_SA(0, 0), a2, voffA);
            PG8_WAIT_V(8); PG8_WAIT_L(0); PG8_BAR; PG8_MMA(1, 0, At, B0); PG8_MMA(1, 1, At, B1); PG8_BAR; PG8_SCHED;
            PG8_LDB(B0, 1, 0); PG8_LDB(B1, 1, 1); PG8_SCHED; PG8_LDA(At, 1, 0); PG8_STAGE(PG8_SA(0, 1), a2 + hstep, voffA);
            PG8_WAIT_V(8); PG8_WAIT_L(0); PG8_BAR; PG8_MMA(0, 0, At, B0); PG8_MMA(0, 1, At, B1); PG8_BAR; PG8_SCHED;
            PG8_LDA(At, 1, 1); PG8_STAGE(PG8_SB(1, 0), b3, voffB); PG8_STAGE(PG8_SB(1, 1), b3 + hstep, voffB); PG8_STAGE(PG8_SA(1, 0), a3, voffA);
            PG8_WAIT_V(8); PG8_WAIT_L(0); PG8_BAR; PG8_MMA(1, 0, At, B0); PG8_MMA(1, 1, At, B1); PG8_BAR; PG8_SCHED;
            } else {
            PG8_LDB(B0, 0, 0); PG8_SCHED; PG8_LDA(At, 0, 0); PG8_STAGE(PG8_SA(1, 1), a1 + hstep, voffA);
            PG8_WAIT_L(8); PG8_BAR; PG8_WAIT_L(0); PG8_MMA(0, 0, At, B0); PG8_BAR; PG8_SCHED;
            PG8_LDB(B1, 0, 1); PG8_STAGE(PG8_SB(0, 0), b2, voffB);
            PG8_BAR; PG8_WAIT_L(0); PG8_MMA(0, 1, At, B1); PG8_BAR;
            PG8_LDA(At, 0, 1); PG8_STAGE(PG8_SA(0, 0), a2, voffA);
            PG8_BAR; PG8_WAIT_L(0); PG8_MMA(1, 0, At, B0); PG8_BAR; PG8_SCHED;
            PG8_STAGE(PG8_SB(0, 1), b2 + hstep, voffB);
            PG8_WAIT_V(6); PG8_BAR; PG8_MMA(1, 1, At, B1); PG8_BAR;
            PG8_LDB(B0, 1, 0); PG8_SCHED; PG8_LDA(At, 1, 0); PG8_STAGE(PG8_SA(0, 1), a2 + hstep, voffA);
            PG8_WAIT_L(8); PG8_BAR; PG8_WAIT_L(0); PG8_MMA(0, 0, At, B0); PG8_BAR; PG8_SCHED;
            PG8_LDB(B1, 1, 1); PG8_STAGE(PG8_SB(1, 0), b3, voffB);
            PG8_BAR; PG8_WAIT_L(0); PG8_MMA(0, 1, At, B1); PG8_BAR;
            PG8_LDA(At, 1, 1); PG8_STAGE(PG8_SA(1, 0), a3, voffA);
            PG8_BAR; PG8_WAIT_L(0); PG8_MMA(1, 0, At, B0); PG8_BAR; PG8_SCHED;
            PG8_STAGE(PG8_SB(1, 1), b3 + hstep, voffB);
            PG8_WAIT_V(6); PG8_BAR; PG8_MMA(1, 1, At, B1); PG8_BAR;
            }
        }
        if constexpr (ALIGN_EPI) { if (wr == 0) PG8_BAR; }
        if constexpr (!Epi::AFTER_DRAIN) { E(acc, cur, wr, wc, fr, fq); S.done(cur); }
        if (!has_next) break;
#pragma unroll
        for (int a = 0; a < 2; ++a)
#pragma unroll
            for (int b = 0; b < 2; ++b)
#pragma unroll
                for (int m = 0; m < 4; ++m)
#pragma unroll
                    for (int n = 0; n < 2; ++n) acc[a][b][m][n] = (f32x4){0.f, 0.f, 0.f, 0.f};
        cur = nxt; cA = nA; cB = nB; ++ui;
        if constexpr (ALIGN_EPI) { if (wr == 1) PG8_BAR; }
    }
    PG8_WAIT_V(0);
    if constexpr (!ALIGN_EPI) { if (wr == 0) PG8_BAR; }
    PG8_BAR;
    if constexpr (Epi::AFTER_DRAIN) { E.fused(acc, cur, wr, wc, fr, fq, lds, wid, lane); S.done(cur); }
#undef PG8_SA
#undef PG8_SB
#undef PG8_STAGE
#undef PG8_LDA
#undef PG8_LDB
#undef PG8_MMA
#undef PG8_WAIT_V
#undef PG8_WAIT_L
#undef PG8_BAR
#undef PG8_SCHED
}
}

#define LAS __attribute__((address_space(3)))
typedef unsigned short bf16_t;
typedef short bf16x8 __attribute__((ext_vector_type(8)));
typedef float f32x4 __attribute__((ext_vector_type(4)));
typedef float f32x16 __attribute__((ext_vector_type(16)));
typedef unsigned u32x2 __attribute__((ext_vector_type(2)));
typedef unsigned u32x4 __attribute__((ext_vector_type(4)));
typedef float f32x2_t __attribute__((ext_vector_type(2)));
typedef __bf16 bf16x2_t __attribute__((ext_vector_type(2)));

constexpr int DM = 1024, NBATCH = 2, SEQ = 8192, DEPTH = 4, CTXL = 256;
constexpr int MLAT = NBATCH * SEQ, MCTX = NBATCH * CTXL, MTOT = MLAT + MCTX;
constexpr int NIN = 3584, NTM = 2048, NCM = 1536;
constexpr int C_QA = 0, C_KA = 384, C_GA = 768, C_QC = 1152, C_KC = 1536, C_GC = 1664;
constexpr int R_VA = 0, R_VC = 384, R_HZ = 512, R_GB = 1280;
constexpr int NFFT = 16384;
constexpr float LOG2E = 1.4426950408889634f;
constexpr float QK_SCALE = 0.125f * LOG2E;

constexpr size_t MiB = 1u << 20;
constexpr size_t WS_ADA = 1 * MiB;
constexpr size_t WS_ROPE = 1 * MiB + 256 * 1024;
constexpr size_t WS_H2C = 1 * MiB + 512 * 1024;
constexpr size_t WS_CX = 2 * MiB;
constexpr size_t WS_H2 = 4 * MiB;
constexpr size_t WS_WIN = 12 * MiB;
constexpr size_t WS_WOUT = 40 * MiB;
constexpr size_t WS_HY = 48 * MiB;
constexpr size_t WS_PT = 81 * MiB;
constexpr size_t WS_PCT = 147 * MiB;
constexpr size_t WS_YBT = 197 * MiB;
constexpr size_t WS_ZS = 206 * MiB;
constexpr size_t WS_END = 238 * MiB;

constexpr int LDS_BYTES = 147456;
constexpr int NTHREADS = 512;

struct KArgs {
    const float* x; const float* c; const float* ctx; const float* c_ctx; const float* norm_g; const float* w_ada; const float* b_ada;
    const float* w_in; const float* w_out; const float* na_rpb; const float* hy_conv_w; const float* hy_conv_b;
    const float* hy_w1; const float* hy_b1; const float* hy_freq1; const float* hy_w2; const float* hy_b2; const float* hy_freq2; const float* hy_w3;
    const float* hy_d; const float* sink; const float* final_g;
    float* out; unsigned char* ws;
    int ph_lo, ph_hi;
};

typedef const __attribute__((address_space(4))) KArgs CKArgs;
__device__ __forceinline__ unsigned pk2(float lo, float hi) { f32x2_t v = {lo, hi}; bf16x2_t b = __builtin_convertvector(v, bf16x2_t); return __builtin_bit_cast(unsigned, b); }
__device__ __forceinline__ float bf2f(unsigned short u) { return __uint_as_float(((unsigned)u) << 16); }
__device__ __forceinline__ float bflo(unsigned w) { return __uint_as_float(w << 16); }
__device__ __forceinline__ float bfhi(unsigned w) { return __uint_as_float(w & 0xffff0000u); }
__device__ __forceinline__ float silu_f(float x) { return x / (1.0f + __expf(-x)); }
__device__ __forceinline__ float wave_sum(float v) {
#pragma unroll
    for (int o = 1; o < 64; o <<= 1) v += __shfl_xor(v, o);
    return v;
}
__device__ __forceinline__ float rdlane(float v, int l) { return __uint_as_float(__builtin_amdgcn_readlane(__float_as_uint(v), l)); }

__device__ __forceinline__ void transpose_item(const float* W, int K, int N, bf16_t* WT, int k0, int n0, int drow0, LAS float* scr, int lane) {
#pragma unroll 8
    for (int i = 0; i < 32; ++i) { const int kk = 2 * i + (lane >> 5); scr[kk * 33 + (lane & 31)] = W[(size_t)(k0 + kk) * N + n0 + (lane & 31)]; }
    asm volatile("s_waitcnt lgkmcnt(0)" ::: "memory");
    const int c = lane & 7;
#pragma unroll
    for (int j = 0; j < 4; ++j) { const int n = (lane >> 3) + 8 * j; const LAS float* s = scr + (8 * c) * 33 + n;
        u32x4 o; o.x = pk2(s[0 * 33], s[1 * 33]); o.y = pk2(s[2 * 33], s[3 * 33]); o.z = pk2(s[4 * 33], s[5 * 33]); o.w = pk2(s[6 * 33], s[7 * 33]);
        *(u32x4*)(WT + (size_t)(drow0 + n) * K + k0 + 8 * c) = o; }
    asm volatile("s_waitcnt lgkmcnt(0)" ::: "memory");
}
__device__ __forceinline__ int win_row(int n0) {
    if (n0 < 768) return n0;
    if (n0 < 1152) return n0 - 768 + 2048;
    if (n0 < 1536) return n0 - 1152 + 768;
    if (n0 < 2304) return n0 - 1536 + 2560;
    if (n0 < 2560) return n0 - 2304 + 3328;
    if (n0 < 2944) return n0 - 2560 + 1152;
    if (n0 < 3072) return n0 - 2944 + 1536;
    if (n0 < 3200) return n0 - 3072 + 2432;
    return n0 - 3200 + 1664;
}

__device__ __forceinline__ void phase_prologue(CKArgs& A, LAS unsigned char* lds, int bid, int nblk, int tid) {
    const int wave = __builtin_amdgcn_readfirstlane(tid >> 6), lane = tid & 63;
    const int gw = bid * 8 + wave, NGW = nblk * 8;
    unsigned char* ws = A.ws;
    {
        LAS float* scr = (LAS float*)(lds + wave * 16384);
        constexpr int I_IN = 16 * 112, I_OUT = 16 * 32, I_L = I_IN + I_OUT;
        for (int it = gw; it < DEPTH * I_L; it += NGW) {
            const int l = it / I_L; int r = it % I_L;
            if (r < I_IN) { const int kb = r / 112, nb = r % 112, n0 = nb * 32;
                transpose_item(A.w_in + (size_t)l * DM * NIN, DM, NIN, (bf16_t*)(ws + WS_WIN) + (size_t)l * NIN * DM, kb * 64, n0, win_row(n0), scr, lane); }
            else { r -= I_IN; const int kb = r / 32, nb = r % 32, n0 = nb * 32;
                transpose_item(A.w_out + (size_t)l * DM * DM, DM, DM, (bf16_t*)(ws + WS_WOUT) + (size_t)l * DM * DM, kb * 64, n0, n0, scr, lane); }
        }
    }
    for (int idx = gw * 64 + lane; idx < 128 * 16; idx += NGW * 64) {
        const int p = idx >> 4, i = idx & 15;
        const float inv = powf(10000.0f, -(float)i / 16.0f);
        const float ang = (float)p * inv;
        ((float2*)(ws + WS_ROPE))[idx] = make_float2(cosf(ang), sinf(ang));
    }
    for (int it = gw; it < DEPTH * 132; it += NGW) {
        const int l = it / 132, g = it % 132;
        const int L = g < 128 ? SEQ : CTXL;
        const int n0 = g < 128 ? g * 64 : (g - 128) * 64;
        float* outp = g < 128 ? (float*)(ws + WS_H2) + ((size_t)l * SEQ + n0) * 64 : (float*)(ws + WS_H2C) + ((size_t)l * CTXL + n0) * 64;
        float w1c[33], w2c[64];
#pragma unroll
        for (int q = 0; q < 33; ++q) w1c[q] = A.hy_w1[((size_t)l * 33 + q) * 64 + lane];
#pragma unroll
        for (int j = 0; j < 64; ++j) w2c[j] = A.hy_w2[((size_t)l * 64 + j) * 64 + lane];
        const float b1 = A.hy_b1[l * 64 + lane], fr1 = A.hy_freq1[l * 64 + lane], b2 = A.hy_b2[l * 64 + lane], fr2 = A.hy_freq2[l * 64 + lane];
        const float tstep = 1.0f / (float)(L - 1), wstep = 6.283185307179586f / (float)L;
        const int fj = lane == 0 ? 0 : ((lane - 1) & 15);
        const float fq = 1e-4f + (float)fj * ((15.0f - 1e-4f) / 15.0f);
#pragma unroll 1
        for (int nn = 0; nn < 64; ++nn) {
            const int n = n0 + nn;
            const float t = (float)n * tstep, wa = (float)n * wstep;
            float zq;
            if (lane == 0) zq = t; else if (lane <= 16) zq = cosf(fq * wa); else if (lane <= 32) zq = -sinf(fq * wa); else zq = 0.f;
            float a1 = b1;
#pragma unroll
            for (int q = 0; q < 33; ++q) a1 += rdlane(zq, q) * w1c[q];
            const float h1 = sinf(fr1 * a1);
            float a2 = b2;
#pragma unroll
            for (int j = 0; j < 64; ++j) a2 += rdlane(h1, j) * w2c[j];
            outp[nn * 64 + lane] = sinf(fr2 * a2);
        }
    }
    __syncthreads();
    {
        LAS float* red = (LAS float*)lds;
        for (int it = bid; it < DEPTH * 48; it += nblk) {
            const int l = it / 48, n = (it % 48) * 64 + lane;
            const float* W = A.w_ada + (size_t)l * DM * 3072;
            float a0 = 0.f, a1 = 0.f, a2 = 0.f;
            const int kb = wave * 128;
#pragma unroll 4
            for (int k = 0; k < 128; ++k) {
                const float w = W[(size_t)(kb + k) * 3072 + n];
                a0 += silu_f(A.c[kb + k]) * w; a1 += silu_f(A.c[DM + kb + k]) * w; a2 += silu_f(A.c_ctx[kb + k]) * w;
            }
            red[(wave * 3 + 0) * 64 + lane] = a0; red[(wave * 3 + 1) * 64 + lane] = a1; red[(wave * 3 + 2) * 64 + lane] = a2;
            __syncthreads();
            if (tid < 192) { const int v = tid >> 6; float s = A.b_ada[l * 3072 + n];
#pragma unroll
                for (int w = 0; w < 8; ++w) s += red[(w * 3 + v) * 64 + lane];
                ((float*)(ws + WS_ADA))[((size_t)l * 3 + v) * 3072 + n] = s; }
            __syncthreads();
        }
    }
}

__device__ __forceinline__ void phase_norm(CKArgs& A, int l, int bid, int nblk, int tid) {
    const int wave = __builtin_amdgcn_readfirstlane(tid >> 6), lane = tid & 63;
    const int gw = bid * 8 + wave, NGW = nblk * 8;
    unsigned char* ws = A.ws;
    bf16_t* H = (bf16_t*)(ws + WS_HY);
    const float* ada = (const float*)(ws + WS_ADA) + (size_t)l * 3 * 3072;
    const float* g = A.norm_g + l * DM;
    for (int m = gw; m < MTOT; m += NGW) {
        const float* src; int v;
        if (m < MLAT) { src = (l == 0 ? A.x : A.out) + (size_t)m * DM; v = m >> 13; }
        else { src = (l == 0 ? A.ctx : (const float*)(ws + WS_CX)) + (size_t)(m - MLAT) * DM; v = 2; }
        const float* shp = ada + v * 3072; const float* scp = shp + DM;
        f32x4 xv[4]; float ss = 0.f;
#pragma unroll
        for (int j = 0; j < 4; ++j) { xv[j] = *(const f32x4*)(src + 4 * lane + 256 * j); ss += (xv[j].x * xv[j].x + xv[j].y * xv[j].y) + (xv[j].z * xv[j].z + xv[j].w * xv[j].w); }
        const float rinv = rsqrtf(wave_sum(ss) * (1.0f / DM) + 1e-6f);
#pragma unroll
        for (int j = 0; j < 4; ++j) { const int col = 4 * lane + 256 * j;
            const f32x4 gv = *(const f32x4*)(g + col), sc = *(const f32x4*)(scp + col), sh = *(const f32x4*)(shp + col);
            const f32x4 h = xv[j] * rinv * gv * (sc + 1.0f) + sh;
            u32x2 o; o.x = pk2(h.x, h.y); o.y = pk2(h.z, h.w);
            *(u32x2*)(H + (size_t)m * DM + col) = o; }
    }
}

struct EpiIn {
    static constexpr bool PERM = true, AFTER_DRAIN = false;
    bf16_t* PT; bf16_t* PCT; const float2* rope;
    __device__ __forceinline__ void operator()(const f32x4 (&acc)[2][2][4][2], const pg8::Unit& u, int wr, int wc, int fr, int fq) const {
        const int row0 = u.pm * 256 + wr * 64 + fr;
        if (u.pn < 8) {
#pragma unroll
            for (int bj = 0; bj < 2; ++bj) {
                const int blk = 2 * u.pn + bj;
                const bool rp = (blk >= 9) && (blk <= 12) && (u.pm < 64);
                const int col0 = 256 * u.pn + 128 * bj + 32 * wc + 8 * fq;
#pragma unroll
                for (int ai = 0; ai < 2; ++ai)
#pragma unroll
                    for (int m = 0; m < 4; ++m) {
                        const int r = row0 + 128 * ai + 16 * m;
                        f32x4 v0 = acc[ai][bj][m][0], v1 = acc[ai][bj][m][1];
                        if (rp) {
                            const int pos = r & (SEQ - 1);
                            const int p = (wc & 1) ? (pos & 63) : (pos >> 6);
                            const f32x4* tb = (const f32x4*)(rope + p * 16 + 8 * (fq & 1));
                            const f32x4 t0 = tb[0], t1 = tb[1], t2 = tb[2], t3 = tb[3];
                            f32x4 q0, q1;
                            q0.x = __shfl_xor(v0.x, 32); q0.y = __shfl_xor(v0.y, 32); q0.z = __shfl_xor(v0.z, 32); q0.w = __shfl_xor(v0.w, 32);
                            q1.x = __shfl_xor(v1.x, 32); q1.y = __shfl_xor(v1.y, 32); q1.z = __shfl_xor(v1.z, 32); q1.w = __shfl_xor(v1.w, 32);
                            const float sg = (fq < 2) ? -1.0f : 1.0f;
                            v0.x = v0.x * t0.x + sg * q0.x * t0.y; v0.y = v0.y * t0.z + sg * q0.y * t0.w;
                            v0.z = v0.z * t1.x + sg * q0.z * t1.y; v0.w = v0.w * t1.z + sg * q0.w * t1.w;
                            v1.x = v1.x * t2.x + sg * q1.x * t2.y; v1.y = v1.y * t2.z + sg * q1.y * t2.w;
                            v1.z = v1.z * t3.x + sg * q1.z * t3.y; v1.w = v1.w * t3.z + sg * q1.w * t3.w;
                        }
                        u32x4 w; w.x = pk2(v0.x, v0.y); w.y = pk2(v0.z, v0.w); w.z = pk2(v1.x, v1.y); w.w = pk2(v1.z, v1.w);
                        *(u32x4*)(PT + (size_t)r * NTM + col0) = w;
                        asm volatile("" ::: "memory");
                    }
            }
        } else {
#pragma unroll
            for (int bj = 0; bj < 2; ++bj) {
                const int ch0 = 256 * (u.pn - 8) + 128 * bj + 32 * wc + 8 * fq;
#pragma unroll
                for (int ai = 0; ai < 2; ++ai)
#pragma unroll
                    for (int m = 0; m < 4; ++m) {
                        const int r = row0 + 128 * ai + 16 * m;
#pragma unroll
                        for (int n = 0; n < 2; ++n) {
                            const f32x4 v = acc[ai][bj][m][n];
                            bf16_t* p = PCT + (size_t)(ch0 + 4 * n) * MTOT + r;
                            const unsigned w0 = pk2(v.x, v.y), w1 = pk2(v.z, v.w);
                            p[0] = (bf16_t)(w0 & 0xffffu); p[MTOT] = (bf16_t)(w0 >> 16); p[2 * (size_t)MTOT] = (bf16_t)(w1 & 0xffffu); p[3 * (size_t)MTOT] = (bf16_t)(w1 >> 16);
                        }
                    }
            }
        }
    }
};
struct EpiOut {
    static constexpr bool PERM = true, AFTER_DRAIN = false;
    const float* xsrc; float* xdst; const float* csrc; float* cdst; const float* ada;
    __device__ __forceinline__ void operator()(const f32x4 (&acc)[2][2][4][2], const pg8::Unit& u, int wr, int wc, int fr, int fq) const {
        const int row0 = u.pm * 256 + wr * 64 + fr;
        const bool lat = u.pm < 64;
#pragma unroll
        for (int bj = 0; bj < 2; ++bj) {
            const int col0 = 256 * u.pn + 128 * bj + 32 * wc + 8 * fq;
#pragma unroll
            for (int ai = 0; ai < 2; ++ai)
#pragma unroll
                for (int m = 0; m < 4; ++m) {
                    const int r = row0 + 128 * ai + 16 * m;
                    const int v = lat ? (r >> 13) : 2;
                    const float* gp = ada + v * 3072 + 2048 + col0;
                    const f32x4 g0 = *(const f32x4*)gp, g1 = *(const f32x4*)(gp + 4);
                    const size_t off = lat ? (size_t)r * DM + col0 : (size_t)(r - MLAT) * DM + col0;
                    const float* sp = (lat ? xsrc : csrc) + off; float* dp = (lat ? xdst : cdst) + off;
                    const f32x4 x0 = *(const f32x4*)sp, x1 = *(const f32x4*)(sp + 4);
                    *(f32x4*)dp = x0 + g0 * acc[ai][bj][m][0];
                    *(f32x4*)(dp + 4) = x1 + g1 * acc[ai][bj][m][1];
                    if (m & 1) asm volatile("" ::: "memory");
                }
        }
    }
};

template <int MK>
__device__ __forceinline__ void attn_tile(const bf16_t* kbase, const bf16_t* vbase, const bf16x8 (&bq)[4], f32x16& o0, f32x16& o1, float& m_run, float& l_run,
                                          int r31, int hh, bool rowok, int cmin, const float* biasp) {
    const bf16_t* kp = kbase + (size_t)r31 * NTM + 8 * hh;
    const bf16x8 ka0 = *(const bf16x8*)(kp), ka1 = *(const bf16x8*)(kp + 16), ka2 = *(const bf16x8*)(kp + 32), ka3 = *(const bf16x8*)(kp + 48);
    const bf16_t* vp = vbase + (size_t)r31 * MTOT + 4 * hh;
    const bf16_t* vq = vp + (size_t)32 * MTOT;
    const u32x2 a0l = *(const u32x2*)(vp), a0h = *(const u32x2*)(vp + 8), a1l = *(const u32x2*)(vp + 16), a1h = *(const u32x2*)(vp + 24);
    const u32x2 b0l = *(const u32x2*)(vq), b0h = *(const u32x2*)(vq + 8), b1l = *(const u32x2*)(vq + 16), b1h = *(const u32x2*)(vq + 24);
    f32x16 s;
#pragma unroll
    for (int i = 0; i < 16; ++i) s[i] = 0.f;
    s = __builtin_amdgcn_mfma_f32_32x32x16_bf16(ka0, bq[0], s, 0, 0, 0);
    s = __builtin_amdgcn_mfma_f32_32x32x16_bf16(ka1, bq[1], s, 0, 0, 0);
    s = __builtin_amdgcn_mfma_f32_32x32x16_bf16(ka2, bq[2], s, 0, 0, 0);
    s = __builtin_amdgcn_mfma_f32_32x32x16_bf16(ka3, bq[3], s, 0, 0, 0);
    float tmax = -INFINITY;
#pragma unroll
    for (int i = 0; i < 16; ++i) {
        const int c = (i & 3) + 8 * (i >> 2) + 4 * hh;
        float v = s[i] * QK_SCALE;
        if (MK == 1) { if (c < r31) v = -INFINITY; }
        if (MK == 2) { if (c > r31) v = -INFINITY; }
        if (MK == 3) { const bool ok = rowok && ((unsigned)(c - cmin) < 16u); float bb = 0.f; if (ok) bb = biasp[c]; v = ok ? v + bb * LOG2E : -INFINITY; }
        s[i] = v; tmax = fmaxf(tmax, v);
    }
    tmax = fmaxf(tmax, __shfl_xor(tmax, 32));
    const float m_new = fmaxf(m_run, tmax);
    const float alpha = __builtin_amdgcn_exp2f(m_run - m_new);
    m_run = m_new;
    float psum = 0.f;
#pragma unroll
    for (int i = 0; i < 16; ++i) { const float p = __builtin_amdgcn_exp2f(s[i] - m_new); s[i] = p; psum += p; }
    l_run = l_run * alpha + psum;
#pragma unroll
    for (int i = 0; i < 16; ++i) { o0[i] *= alpha; o1[i] *= alpha; }
    u32x4 pw0, pw1;
    pw0.x = pk2(s[0], s[1]); pw0.y = pk2(s[2], s[3]); pw0.z = pk2(s[4], s[5]); pw0.w = pk2(s[6], s[7]);
    pw1.x = pk2(s[8], s[9]); pw1.y = pk2(s[10], s[11]); pw1.z = pk2(s[12], s[13]); pw1.w = pk2(s[14], s[15]);
    const bf16x8 pb0 = __builtin_bit_cast(bf16x8, pw0), pb1 = __builtin_bit_cast(bf16x8, pw1);
    u32x4 t;
    t.x = a0l.x; t.y = a0l.y; t.z = a0h.x; t.w = a0h.y; const bf16x8 va00 = __builtin_bit_cast(bf16x8, t);
    t.x = a1l.x; t.y = a1l.y; t.z = a1h.x; t.w = a1h.y; const bf16x8 va01 = __builtin_bit_cast(bf16x8, t);
    t.x = b0l.x; t.y = b0l.y; t.z = b0h.x; t.w = b0h.y; const bf16x8 va10 = __builtin_bit_cast(bf16x8, t);
    t.x = b1l.x; t.y = b1l.y; t.z = b1h.x; t.w = b1h.y; const bf16x8 va11 = __builtin_bit_cast(bf16x8, t);
    o0 = __builtin_amdgcn_mfma_f32_32x32x16_bf16(va00, pb0, o0, 0, 0, 0);
    o0 = __builtin_amdgcn_mfma_f32_32x32x16_bf16(va01, pb1, o0, 0, 0, 0);
    o1 = __builtin_amdgcn_mfma_f32_32x32x16_bf16(va10, pb0, o1, 0, 0, 0);
    o1 = __builtin_amdgcn_mfma_f32_32x32x16_bf16(va11, pb1, o1, 0, 0, 0);
}

template <int MODE>
__device__ __forceinline__ void attn_item(CKArgs& A, int l, int item, int lane) {
    unsigned char* ws = A.ws;
    const bf16_t* PT = (const bf16_t*)(ws + WS_PT);
    const bf16_t* PCT = (const bf16_t*)(ws + WS_PCT);
    bf16_t* Y = (bf16_t*)(ws + WS_HY);
    const int r31 = lane & 31, hh = lane >> 5;
    int b, h, qtok;
    int rp = 0, mg = 0, qg = 0;
    if (MODE == 0) { b = item / 1536; const int rem = item % 1536; h = rem / 256; const int r2 = rem % 256; rp = r2 >> 2; mg = r2 & 3;
        qtok = b * SEQ + (2 * rp + (r31 >> 4)) * 64 + 16 * mg + (r31 & 15); }
    else if (MODE == 1) { b = item / 1536; const int rem = item % 1536; h = rem / 256; qg = rem % 256; qtok = b * SEQ + 32 * qg + r31; }
    else { b = item / 48; const int rem = item % 48; h = rem / 8; qg = rem % 8; qtok = MLAT + b * CTXL + 32 * qg + r31; }
    const bool grpA = (MODE == 0 || MODE == 2);
    const int kvh = grpA ? h : h / 3;
    const int qcol = (grpA ? C_QA : C_QC) + h * 64, kcol = (grpA ? C_KA : C_KC) + kvh * 64, gcol = (grpA ? C_GA : C_GC) + h * 64;
    const int vrow = (grpA ? R_VA : R_VC) + kvh * 64, ycol = (grpA ? 0 : 640) + h * 64;
    bf16x8 bq[4];
    { const bf16_t* qp = PT + (size_t)qtok * NTM + qcol + 8 * hh;
#pragma unroll
      for (int s = 0; s < 4; ++s) bq[s] = *(const bf16x8*)(qp + 16 * s); }
    f32x16 o0, o1;
#pragma unroll
    for (int i = 0; i < 16; ++i) { o0[i] = 0.f; o1[i] = 0.f; }
    float m_run = -1e30f, l_run = 0.f;
    if (!grpA) { m_run = A.sink[l * 6 + h] * LOG2E; l_run = hh == 0 ? 1.0f : 0.f; }
    const bf16_t* kb0 = PT + kcol; const bf16_t* vb0 = PCT + (size_t)vrow * MTOT;
#pragma unroll 1
    for (int jt = 0; jt < 8; ++jt) { const int kt = MLAT + b * CTXL + 32 * jt;
        attn_tile<0>(kb0 + (size_t)kt * NTM, vb0 + kt, bq, o0, o1, m_run, l_run, r31, hh, true, 0, nullptr); }
    if (MODE == 1) {
        const int q0 = 32 * qg;
#pragma unroll 1
        for (int i = 0; i < 9; ++i) { const int kpos = q0 - 128 + 32 * i; if (kpos < 0 || kpos >= SEQ) continue; const int kt = b * SEQ + kpos;
            if (i == 0) attn_tile<1>(kb0 + (size_t)kt * NTM, vb0 + kt, bq, o0, o1, m_run, l_run, r31, hh, true, 0, nullptr);
            else if (i == 8) attn_tile<2>(kb0 + (size_t)kt * NTM, vb0 + kt, bq, o0, o1, m_run, l_run, r31, hh, true, 0, nullptr);
            else attn_tile<0>(kb0 + (size_t)kt * NTM, vb0 + kt, bq, o0, o1, m_run, l_run, r31, hh, true, 0, nullptr); }
    }
    if (MODE == 0) {
        const int ra = min(max(2 * rp - 4, 0), 120), rb = min(max(2 * rp - 3, 0), 120) + 7;
        const int cs = min(max(16 * mg - 8, 0), 32);
        const int rq = 2 * rp + (r31 >> 4), jq = 16 * mg + (r31 & 15);
        const int r0 = min(max(rq - 4, 0), 120), c0 = min(max(jq - 8, 0), 48);
        const int cmin = c0 - cs;
        const float* rpb = A.na_rpb + (size_t)(l * 6 + h) * 15 * 31;
#pragma unroll 1
        for (int a = ra; a <= rb; ++a) { const int kt = b * SEQ + a * 64 + cs;
            const bool rowok = (a >= r0) && (a < r0 + 8);
            const float* bp = rpb + (a - rq + 7) * 31 + (cs - jq + 15);
            attn_tile<3>(kb0 + (size_t)kt * NTM, vb0 + kt, bq, o0, o1, m_run, l_run, r31, hh, rowok, cmin, bp); }
    }
    const float ltot = l_run + __shfl_xor(l_run, 32);
    const float inv = 1.0f / ltot;
    const bf16_t* gp = PT + (size_t)qtok * NTM + gcol + 4 * hh;
    bf16_t* yp = Y + (size_t)qtok * DM + ycol + 4 * hh;
#pragma unroll
    for (int db = 0; db < 2; ++db)
#pragma unroll
        for (int g4 = 0; g4 < 4; ++g4) {
            const int d0 = 32 * db + 8 * g4;
            const u32x2 gw = *(const u32x2*)(gp + d0);
            float v0, v1, v2, v3;
            if (db == 0) { v0 = o0[4 * g4]; v1 = o0[4 * g4 + 1]; v2 = o0[4 * g4 + 2]; v3 = o0[4 * g4 + 3]; }
            else { v0 = o1[4 * g4]; v1 = o1[4 * g4 + 1]; v2 = o1[4 * g4 + 2]; v3 = o1[4 * g4 + 3]; }
            v0 *= inv * silu_f(bflo(gw.x)); v1 *= inv * silu_f(bfhi(gw.x)); v2 *= inv * silu_f(bflo(gw.y)); v3 *= inv * silu_f(bfhi(gw.y));
            u32x2 o; o.x = pk2(v0, v1); o.y = pk2(v2, v3);
            *(u32x2*)(yp + d0) = o;
        }
}

typedef float cf2 __attribute__((ext_vector_type(2)));
__device__ __forceinline__ cf2 mk2(float x, float y) { cf2 r; r.x = x; r.y = y; return r; }
__device__ __forceinline__ cf2 cmul(cf2 a, cf2 b) { return mk2(a.x * b.x - a.y * b.y, a.x * b.y + a.y * b.x); }
__device__ __forceinline__ void fft_fwd(LAS cf2* buf, int tid) {
#pragma unroll 1
    for (int p = 0; p < 7; ++p) {
        const int ls = 12 - 2 * p, s = 1 << ls;
        const float rs = 1.0f / (float)(4 * s);
#pragma unroll 2
        for (int k = 0; k < 8; ++k) {
            const int bf = tid + 512 * k, i = bf & (s - 1), base = ((bf >> ls) << (ls + 2)) + i;
            const cf2 x0 = buf[base], x1 = buf[base + s], x2 = buf[base + 2 * s], x3 = buf[base + 3 * s];
            const float a = (float)i * rs;
            const cf2 w1 = mk2(__builtin_amdgcn_cosf(a), -__builtin_amdgcn_sinf(a));
            const cf2 w2 = cmul(w1, w1), w3 = cmul(w2, w1);
            const cf2 s02 = mk2(x0.x + x2.x, x0.y + x2.y), d02 = mk2(x0.x - x2.x, x0.y - x2.y);
            const cf2 s13 = mk2(x1.x + x3.x, x1.y + x3.y), d13 = mk2(x1.x - x3.x, x1.y - x3.y);
            buf[base] = mk2(s02.x + s13.x, s02.y + s13.y);
            buf[base + s] = cmul(mk2(s02.x - s13.x, s02.y - s13.y), w2);
            buf[base + 2 * s] = cmul(mk2(d02.x + d13.y, d02.y - d13.x), w1);
            buf[base + 3 * s] = cmul(mk2(d02.x - d13.y, d02.y + d13.x), w3);
        }
        __syncthreads();
    }
}
__device__ __forceinline__ void fft_inv(LAS cf2* buf, int tid) {
#pragma unroll 1
    for (int p = 0; p < 7; ++p) {
        const int ls = 2 * p, s = 1 << ls;
        const float rs = 1.0f / (float)(4 * s);
#pragma unroll 2
        for (int k = 0; k < 8; ++k) {
            const int bf = tid + 512 * k, i = bf & (s - 1), base = ((bf >> ls) << (ls + 2)) + i;
            const cf2 v0 = buf[base], v1 = buf[base + s], v2 = buf[base + 2 * s], v3 = buf[base + 3 * s];
            const float a = (float)i * rs;
            const cf2 w1 = mk2(__builtin_amdgcn_cosf(a), __builtin_amdgcn_sinf(a));
            const cf2 w2 = cmul(w1, w1);
            const cf2 bb = cmul(v1, w2), dd = cmul(v3, w2);
            const cf2 u0 = mk2(v0.x + bb.x, v0.y + bb.y), u1 = mk2(v0.x - bb.x, v0.y - bb.y);
            const cf2 u2 = mk2(v2.x + dd.x, v2.y + dd.y), u3 = mk2(v2.x - dd.x, v2.y - dd.y);
            const cf2 e = cmul(u2, w1), f0 = cmul(u3, w1);
            const cf2 f = mk2(-f0.y, f0.x);
            buf[base] = mk2(u0.x + e.x, u0.y + e.y); buf[base + 2 * s] = mk2(u0.x - e.x, u0.y - e.y);
            buf[base + s] = mk2(u1.x + f.x, u1.y + f.y); buf[base + 3 * s] = mk2(u1.x - f.x, u1.y - f.y);
        }
        __syncthreads();
    }
}
__device__ __forceinline__ float hy_short(const bf16_t* prow, int tb, int t, int L, float w0, float w1, float w2, float bias) {
    const float pm = t > 0 ? bf2f(prow[tb + t - 1]) : 0.f;
    const float pc = bf2f(prow[tb + t]);
    const float pp = t < L - 1 ? bf2f(prow[tb + t + 1]) : 0.f;
    return w0 * pm + w1 * pc + w2 * pp + bias;
}
__device__ __forceinline__ float block_sum(float v, LAS float* red, int tid) {
    v = wave_sum(v);
    __syncthreads();
    if ((tid & 63) == 0) red[tid >> 6] = v;
    __syncthreads();
    float s = 0.f;
#pragma unroll
    for (int w = 0; w < 8; ++w) s += red[w];
    return s;
}

__device__ __forceinline__ void hyena_block(CKArgs& A, int l, int c, LAS unsigned char* lds, int tid) {
    unsigned char* ws = A.ws;
    LAS cf2* buf = (LAS cf2*)lds;
    LAS float* fs = (LAS float*)lds;
    LAS float* aux = (LAS float*)(lds + 131072);
    LAS float* red = aux + 256;
    const bf16_t* PCT = (const bf16_t*)(ws + WS_PCT);
    bf16_t* YBT = (bf16_t*)(ws + WS_YBT);
    cf2* ZS = (cf2*)(ws + WS_ZS) + (size_t)c * NFFT;
    const bf16_t* rowz = PCT + (size_t)(R_HZ + c) * MTOT;
    const bf16_t* rowx1 = rowz + (size_t)256 * MTOT;
    const bf16_t* rowx2 = rowz + (size_t)512 * MTOT;
    const bf16_t* rowg = PCT + (size_t)(R_GB + c) * MTOT;
    const float* cw = A.hy_conv_w + (size_t)l * 3 * 768; const float* cb = A.hy_conv_b + (size_t)l * 768;
    const float wz0 = cw[c], wz1 = cw[768 + c], wz2 = cw[1536 + c], bz = cb[c];
    const float wa0 = cw[256 + c], wa1 = cw[768 + 256 + c], wa2 = cw[1536 + 256 + c], ba = cb[256 + c];
    const float wb0 = cw[512 + c], wb1 = cw[768 + 512 + c], wb2 = cw[1536 + 512 + c], bb = cb[512 + c];
    const float d0 = A.hy_d[(l * 2 + 0) * 256 + c], d1 = A.hy_d[(l * 2 + 1) * 256 + c];
    const float dmin = -3.0701134573253945f, dmax = -15.350567286626973f;
    const float delta = fabsf(dmin + (float)c * ((dmax - dmin) / 255.0f));
    __syncthreads();
    if (tid < 256) { const int k = tid >> 6, j = tid & 63; aux[tid] = A.hy_w3[((size_t)l * 64 + j) * 1024 + k * 256 + c]; }
    __syncthreads();

    if (l < DEPTH - 1) {
        float ss0 = 0.f, ss1 = 0.f;
        if (tid < 256) {
            const int n = tid; const f32x4* hr = (const f32x4*)((const float*)(ws + WS_H2C) + ((size_t)l * CTXL + n) * 64);
            float f0 = 0.f, f1 = 0.f, b0 = 0.f, b1 = 0.f;
#pragma unroll 1
            for (int j4 = 0; j4 < 16; ++j4) { const f32x4 hv = hr[j4];
#pragma unroll
                for (int e = 0; e < 4; ++e) { const float hvv = hv[e]; const int j = 4 * j4 + e; f0 += hvv * aux[j]; f1 += hvv * aux[64 + j]; b0 += hvv * aux[128 + j]; b1 += hvv * aux[192 + j]; } }
            const float e = __expf(-((float)n * (1.0f / 255.0f)) * delta);
            f0 *= e; f1 *= e; b0 *= e; b1 *= e;
            fs[n] = f0; fs[256 + n] = f1; fs[512 + n] = b0; fs[768 + n] = b1;
            ss0 = f0 * f0 + (n >= 1 ? b0 * b0 : 0.f); ss1 = f1 * f1 + (n >= 1 ? b1 * b1 : 0.f);
        }
        const int b = tid >> 8, t = tid & 255, tok = MLAT + b * CTXL;
        const float z = hy_short(rowz, tok, t, CTXL, wz0, wz1, wz2, bz);
        const float x1 = hy_short(rowx1, tok, t, CTXL, wa0, wa1, wa2, ba);
        const float x2 = hy_short(rowx2, tok, t, CTXL, wb0, wb1, wb2, bb);
        const float gb = bf2f(rowg[tok + t]);
        fs[1024 + tid] = z;
        const float n0 = rsqrtf(block_sum(ss0, red, tid) + 1e-6f);
        const float n1 = rsqrtf(block_sum(ss1, red, tid) + 1e-6f);
        __syncthreads();
        float y = 0.f;
#pragma unroll 4
        for (int s = 0; s < 256; ++s) { const int d = t - s; const float kv = d >= 0 ? fs[d] : fs[512 - d]; y += fs[1024 + b * 256 + s] * kv; }
        const float z1 = x1 * (y * n0 + d0 * z);
        fs[1536 + tid] = z1;
        __syncthreads();
        float y2 = 0.f;
#pragma unroll 4
        for (int s = 0; s < 256; ++s) { const int d = t - s; const float kv = d >= 0 ? fs[256 + d] : fs[768 - d]; y2 += fs[1536 + b * 256 + s] * kv; }
        const float o = x2 * (y2 * n1 + d1 * z1) * silu_f(gb);
        YBT[(size_t)c * MTOT + tok + t] = (bf16_t)(pk2(o, 0.f) & 0xffffu);
        __syncthreads();
    }

    float nrm0, nrm1;
    {
        float ss0 = 0.f, ss1 = 0.f;
        const float* H2 = (const float*)(ws + WS_H2) + (size_t)l * SEQ * 64;
#pragma unroll 1
        for (int k = 0; k < 16; ++k) {
            const int n = tid + 512 * k; const f32x4* hr = (const f32x4*)(H2 + (size_t)n * 64);
            float f0 = 0.f, f1 = 0.f, b0 = 0.f, b1 = 0.f;
#pragma unroll 1
            for (int j4 = 0; j4 < 16; ++j4) { const f32x4 hv = hr[j4];
#pragma unroll
                for (int e = 0; e < 4; ++e) { const float hvv = hv[e]; const int j = 4 * j4 + e; f0 += hvv * aux[j]; f1 += hvv * aux[64 + j]; b0 += hvv * aux[128 + j]; b1 += hvv * aux[192 + j]; } }
            const float e = __expf(-((float)n * (1.0f / 8191.0f)) * delta);
            f0 *= e; f1 *= e; b0 *= e; b1 *= e;
            buf[n] = mk2(f0, f1); ss0 += f0 * f0; ss1 += f1 * f1;
            if (n >= 1) { buf[NFFT - n] = mk2(b0, b1); ss0 += b0 * b0; ss1 += b1 * b1; }
        }
        if (tid == 0) buf[SEQ] = mk2(0.f, 0.f);
        nrm0 = rsqrtf(block_sum(ss0, red, tid) + 1e-6f) * (1.0f / NFFT);
        nrm1 = rsqrtf(block_sum(ss1, red, tid) + 1e-6f) * (1.0f / NFFT);
        __syncthreads();
        fft_fwd(buf, tid);
#pragma unroll 4
        for (int k = 0; k < 32; ++k) { const int p = tid + 512 * k; ZS[p] = buf[p]; }
        __syncthreads();
    }
    cf2 z1r[16];
#pragma unroll 1
    for (int k = 0; k < 16; ++k) {
        const int t = tid + 512 * k;
        buf[t] = mk2(hy_short(rowz, 0, t, SEQ, wz0, wz1, wz2, bz), hy_short(rowz, SEQ, t, SEQ, wz0, wz1, wz2, bz));
        buf[SEQ + t] = mk2(0.f, 0.f);
    }
    __syncthreads();
    fft_fwd(buf, tid);
#pragma unroll 2
    for (int k = 0; k < 32; ++k) {
        const int p = tid + 512 * k; const int f = (int)(__brev((unsigned)p) >> 18); const int pp = (int)(__brev((unsigned)((NFFT - f) & (NFFT - 1))) >> 18);
        const cf2 a = ZS[p], bq = ZS[pp];
        const cf2 kk = mk2((a.x + bq.x) * 0.5f * nrm0, (a.y - bq.y) * 0.5f * nrm0);
        buf[p] = cmul(buf[p], kk);
    }
    __syncthreads();
    fft_inv(buf, tid);
#pragma unroll 1
    for (int k = 0; k < 16; ++k) {
        const int t = tid + 512 * k;
        const cf2 y = buf[t];
        const float za = hy_short(rowz, 0, t, SEQ, wz0, wz1, wz2, bz), zb = hy_short(rowz, SEQ, t, SEQ, wz0, wz1, wz2, bz);
        const float xa = hy_short(rowx1, 0, t, SEQ, wa0, wa1, wa2, ba), xb = hy_short(rowx1, SEQ, t, SEQ, wa0, wa1, wa2, ba);
        buf[t] = mk2(xa * (y.x + d0 * za), xb * (y.y + d0 * zb));
        buf[SEQ + t] = mk2(0.f, 0.f);
    }
#pragma unroll
    for (int k = 0; k < 16; ++k) z1r[k] = buf[tid + 512 * k];
    __syncthreads();
    fft_fwd(buf, tid);
#pragma unroll 2
    for (int k = 0; k < 32; ++k) {
        const int p = tid + 512 * k; const int f = (int)(__brev((unsigned)p) >> 18); const int pp = (int)(__brev((unsigned)((NFFT - f) & (NFFT - 1))) >> 18);
        const cf2 a = ZS[p], bq = ZS[pp];
        const cf2 kk = mk2((a.y + bq.y) * 0.5f * nrm1, -(a.x - bq.x) * 0.5f * nrm1);
        buf[p] = cmul(buf[p], kk);
    }
    __syncthreads();
    fft_inv(buf, tid);
#pragma unroll
    for (int k = 0; k < 16; ++k) { const int t = tid + 512 * k; const cf2 y = buf[t]; buf[t] = mk2(y.x + d1 * z1r[k].x, y.y + d1 * z1r[k].y); }
    bf16_t* yrow = YBT + (size_t)c * MTOT;
#pragma unroll 1
    for (int k = 0; k < 16; ++k) {
        const int t = tid + 512 * k;
        const cf2 y = buf[t];
        const float xa = hy_short(rowx2, 0, t, SEQ, wb0, wb1, wb2, bb), xb = hy_short(rowx2, SEQ, t, SEQ, wb0, wb1, wb2, bb);
        const float ga = bf2f(rowg[t]), gb = bf2f(rowg[SEQ + t]);
        const float oa = xa * y.x * silu_f(ga), ob = xb * y.y * silu_f(gb);
        yrow[t] = (bf16_t)(pk2(oa, 0.f) & 0xffffu); yrow[SEQ + t] = (bf16_t)(pk2(ob, 0.f) & 0xffffu);
    }
    __syncthreads();
}

__device__ __forceinline__ void phase_mix(CKArgs& A, int l, LAS unsigned char* lds, int bid, int nblk, int tid) {
    const int wave = __builtin_amdgcn_readfirstlane(tid >> 6), lane = tid & 63;
    const int gw = bid * 8 + wave, NGW = nblk * 8;
#ifndef NOHY
    for (int c = bid; c < 256; c += nblk) hyena_block(A, l, c, lds, tid);
#endif
#ifndef NOAT
#pragma unroll 1
    for (int it = gw; it < 3072; it += NGW) attn_item<0>(A, l, it, lane);
#pragma unroll 1
    for (int it = gw; it < 3072; it += NGW) attn_item<1>(A, l, it, lane);
    if (l < DEPTH - 1) {
#pragma unroll 1
        for (int it = gw; it < 96; it += NGW) attn_item<2>(A, l, it, lane);
#pragma unroll 1
        for (int it = gw; it < 96; it += NGW) attn_item<3>(A, l, it, lane);
    }
#endif
}

__device__ __forceinline__ void phase_tr(CKArgs& A, int l, LAS unsigned char* lds, int bid, int nblk, int tid) {
    const int wave = __builtin_amdgcn_readfirstlane(tid >> 6), lane = tid & 63;
    const int gw = bid * 8 + wave, NGW = nblk * 8;
    unsigned char* ws = A.ws;
    const bf16_t* YBT = (const bf16_t*)(ws + WS_YBT);
    bf16_t* Y = (bf16_t*)(ws + WS_HY);
    LAS bf16_t* scr = (LAS bf16_t*)(lds + wave * 16384);
    const int ntok = (l < DEPTH - 1) ? MTOT : MLAT;
    const int nitems = (ntok / 64) * 4;
#pragma unroll 1
    for (int it = gw; it < nitems; it += NGW) {
        const int tb = (it >> 2) * 64, cb = (it & 3) * 64;
#pragma unroll 8
        for (int i = 0; i < 64; ++i) scr[i * 66 + lane] = YBT[(size_t)(cb + i) * MTOT + tb + lane];
        asm volatile("s_waitcnt lgkmcnt(0)" ::: "memory");
        const int cc = (lane & 7) * 8;
#pragma unroll
        for (int k = 0; k < 8; ++k) {
            const int tq = (lane >> 3) + 8 * k;
            u32x4 o;
            o.x = (unsigned)scr[(cc + 0) * 66 + tq] | ((unsigned)scr[(cc + 1) * 66 + tq] << 16);
            o.y = (unsigned)scr[(cc + 2) * 66 + tq] | ((unsigned)scr[(cc + 3) * 66 + tq] << 16);
            o.z = (unsigned)scr[(cc + 4) * 66 + tq] | ((unsigned)scr[(cc + 5) * 66 + tq] << 16);
            o.w = (unsigned)scr[(cc + 6) * 66 + tq] | ((unsigned)scr[(cc + 7) * 66 + tq] << 16);
            *(u32x4*)(Y + (size_t)(tb + tq) * DM + 384 + cb + cc) = o;
        }
        asm volatile("s_waitcnt lgkmcnt(0)" ::: "memory");
    }
}

__device__ __forceinline__ void phase_final(CKArgs& A, int bid, int nblk, int tid) {
    const int wave = __builtin_amdgcn_readfirstlane(tid >> 6), lane = tid & 63;
    const int gw = bid * 8 + wave, NGW = nblk * 8;
    for (int m = gw; m < MLAT; m += NGW) {
        float* row = A.out + (size_t)m * DM;
        f32x4 xv[4]; float ss = 0.f;
#pragma unroll
        for (int j = 0; j < 4; ++j) { xv[j] = *(const f32x4*)(row + 4 * lane + 256 * j); ss += (xv[j].x * xv[j].x + xv[j].y * xv[j].y) + (xv[j].z * xv[j].z + xv[j].w * xv[j].w); }
        const float rinv = rsqrtf(wave_sum(ss) * (1.0f / DM) + 1e-6f);
#pragma unroll
        for (int j = 0; j < 4; ++j) { const int col = 4 * lane + 256 * j; const f32x4 gv = *(const f32x4*)(A.final_g + col); *(f32x4*)(row + col) = xv[j] * rinv * gv; }
    }
}

constexpr int NPHASE = 2 + 5 * DEPTH;
__global__ void __launch_bounds__(NTHREADS, 2) hybrid_fwd(KArgs Aval) {
    extern __shared__ __attribute__((aligned(16))) unsigned char lds_raw[];
    LAS unsigned char* lds = (LAS unsigned char*)lds_raw;
    const int tid0 = threadIdx.x, bid = blockIdx.x, nblk = gridDim.x;
#pragma unroll 1
    for (int ph = Aval.ph_lo; ph < Aval.ph_hi; ++ph) {
        int tid = tid0; asm volatile("" : "+v"(tid));
        CKArgs* Ap = (CKArgs*)__builtin_amdgcn_kernarg_segment_ptr(); asm volatile("" : "+s"(Ap));
        CKArgs& A = *Ap;
        unsigned char* ws = A.ws;
#if !MK_MULTI
        if (ph > Aval.ph_lo) cg::this_grid().sync();
#endif
#ifndef ONLY
#define ONLY -1
#endif
#define EN(k) (ONLY < 0 || ((ONLY >> (k)) & 1))
        if (ph == 0) { if (EN(0)) phase_prologue(A, lds, bid, nblk, tid); }
        else if (ph == NPHASE - 1) { if (EN(6)) phase_final(A, bid, nblk, tid); }
        else {
            const int l = (ph - 1) / 5, k = (ph - 1) % 5;
            if (k == 0) { if (EN(1)) phase_norm(A, l, bid, nblk, tid); }
            else if (k == 1) { if (EN(2)) {
                pg8::Gemm g{(const bf16_t*)(ws + WS_HY), (const bf16_t*)(ws + WS_WIN) + (size_t)l * NIN * DM, MTOT, NIN, DM};
                pg8::StaticOrder S; S.init(MTOT, NIN, nblk, bid);
                EpiIn E{(bf16_t*)(ws + WS_PT), (bf16_t*)(ws + WS_PCT), (const float2*)(ws + WS_ROPE)};
                pg8::gemm_phase<EpiIn, pg8::StaticOrder, true, false>(lds, g, S, E);
            } }
            else if (k == 2) { if (EN(3)) phase_mix(A, l, lds, bid, nblk, tid); }
            else if (k == 3) { if (EN(4)) phase_tr(A, l, lds, bid, nblk, tid); }
            else if (EN(5)) {
                const int M2 = (l < DEPTH - 1) ? MTOT : MLAT;
                pg8::Gemm g{(const bf16_t*)(ws + WS_HY), (const bf16_t*)(ws + WS_WOUT) + (size_t)l * DM * DM, M2, DM, DM};
                pg8::StaticOrder S; S.init(M2, DM, nblk, bid);
                EpiOut E{l == 0 ? A.x : A.out, A.out, l == 0 ? A.ctx : (const float*)(ws + WS_CX), (float*)(ws + WS_CX), (const float*)(ws + WS_ADA) + (size_t)l * 3 * 3072};
                pg8::gemm_phase<EpiOut, pg8::StaticOrder, true, true>(lds, g, S, E);
            }
        }
    }
}

extern "C" void kernel_launch(void* const* d_in, const int* in_sizes, int n_in, void* d_out, int out_size, void* d_ws, size_t ws_size, hipStream_t stream) {
    static int grid = 0;
    if (grid == 0) {
        if (n_in != 22 || ws_size < WS_END) { fprintf(stderr, "kernel_launch: unexpected inputs (n_in %d, ws %zu)\n", n_in, ws_size); grid = -1; return; }
        int dev = 0, cus = 0, per_cu = 0;
        if (hipGetDevice(&dev) != hipSuccess || hipDeviceGetAttribute(&cus, hipDeviceAttributeMultiprocessorCount, dev) != hipSuccess) { grid = -1; return; }
        if (hipFuncSetAttribute((const void*)hybrid_fwd, hipFuncAttributeMaxDynamicSharedMemorySize, LDS_BYTES) != hipSuccess) { fprintf(stderr, "kernel_launch: hipFuncSetAttribute failed\n"); grid = -1; return; }
        if (hipOccupancyMaxActiveBlocksPerMultiprocessor(&per_cu, (const void*)hybrid_fwd, NTHREADS, LDS_BYTES) != hipSuccess || per_cu < 1) { fprintf(stderr, "kernel_launch: occupancy query says %d\n", per_cu); per_cu = 1; }
        (void)hipGetLastError();
        grid = cus;
    }
    if (grid < 0) return;
    KArgs a{};
    a.x = (const float*)d_in[0]; a.c = (const float*)d_in[1]; a.ctx = (const float*)d_in[2]; a.c_ctx = (const float*)d_in[3]; a.norm_g = (const float*)d_in[4];
    a.w_ada = (const float*)d_in[5]; a.b_ada = (const float*)d_in[6]; a.w_in = (const float*)d_in[7]; a.w_out = (const float*)d_in[8]; a.na_rpb = (const float*)d_in[9];
    a.hy_conv_w = (const float*)d_in[10]; a.hy_conv_b = (const float*)d_in[11]; a.hy_w1 = (const float*)d_in[12]; a.hy_b1 = (const float*)d_in[13]; a.hy_freq1 = (const float*)d_in[14];
    a.hy_w2 = (const float*)d_in[15]; a.hy_b2 = (const float*)d_in[16]; a.hy_freq2 = (const float*)d_in[17]; a.hy_w3 = (const float*)d_in[18]; a.hy_d = (const float*)d_in[19];
    a.sink = (const float*)d_in[20]; a.final_g = (const float*)d_in[21];
    a.out = (float*)d_out; a.ws = (unsigned char*)d_ws;
#if MK_MULTI
    for (int ph = 0; ph < NPHASE; ++ph) {
        a.ph_lo = ph; a.ph_hi = ph + 1;
        hipLaunchKernelGGL(hybrid_fwd, dim3(grid), dim3(NTHREADS), LDS_BYTES, stream, a);
    }
#else
    a.ph_lo = 0; a.ph_hi = NPHASE;
    void* args[] = {&a};
    hipError_t e = hipLaunchCooperativeKernel((const void*)hybrid_fwd, dim3(grid), dim3(NTHREADS), args, LDS_BYTES, stream);
    if (e != hipSuccess) fprintf(stderr, "cooperative launch failed: %s (grid %d)\n", hipGetErrorString(e), grid);
#endif
}
```

```cpp
#include <hip/hip_runtime.h>
#include <hip/hip_cooperative_groups.h>
#include <cstdio>
#include <cstdint>
namespace cg = cooperative_groups;

#ifndef MK_MULTI
#define MK_MULTI 0
#endif

namespace pg8 {
#define PG8_LAS __attribute__((address_space(3)))
typedef unsigned short bf16_t;
typedef short bf16x8 __attribute__((ext_vector_type(8)));
typedef float f32x4 __attribute__((ext_vector_type(4)));
typedef unsigned u32x4 __attribute__((ext_vector_type(4)));
constexpr int BM = 256, BK = 64, HALF = 128, HTB = HALF * BK * 2  , STAGE_BYTES = 8 * HTB, NXCD = 8, WGM = 8;

__host__ __device__ __forceinline__ int lds_byte(int r, int c) { const int st = (r >> 4) * 2 + (c >> 5), rr = r & 15, cc = c & 31, ob = rr * 64 + cc * 2; return st * 1024 + (ob ^ (((ob >> 9) & 1) << 5)); }
__host__ __device__ __forceinline__ void stage_rc(int b, int& R, int& C) { const int st = b / 1024, sb = b % 1024, swz = sb ^ (((sb >> 9) & 1) << 5); R = (st >> 1) * 16 + swz / 64; C = (st & 1) * 32 + (swz % 64) / 2; }
__host__ __device__ __forceinline__ int perm32(int rho) { const int n = rho >> 4, i = rho & 15; return 8 * (i >> 2) + 4 * n + (i & 3); }

struct Unit { int pm, pn; };
struct Gemm { const bf16_t* A; const bf16_t* Bt; int M, N, K; };

struct StaticOrder {
    int nM, nN, nwg, G, c;
    __host__ __device__ void init(int M, int N, int G_, int c_) { nM = M / BM; nN = N / BM; nwg = nM * nN; G = G_; c = c_; }
    __host__ __device__ bool next(int i, Unit& u) const {
        const long L = (long)i * G + c; if (L >= nwg) return false;
        int wgid = (int)L; { const int q = nwg / NXCD, r = nwg % NXCD, xcd = wgid % NXCD, off = wgid / NXCD; wgid = (xcd < r ? xcd * (q + 1) : r * (q + 1) + (xcd - r) * q) + off; }
        const int nig = WGM * nN, gid = wgid / nig, fm = gid * WGM, gsz = (nM - fm) < WGM ? (nM - fm) : WGM;
        u.pm = fm + ((wgid % nig) % gsz); u.pn = (wgid % nig) / gsz; return true;
    }
    __device__ __forceinline__ void a_ready(const Unit&) const {}
    __device__ __forceinline__ void done(const Unit&) const {}
};

template <class Epi, class Sched, bool ALIGN_EPI = false, bool SP2 = false>
__device__ __forceinline__ void gemm_phase(PG8_LAS unsigned char* lds, const Gemm g, const Sched& S, const Epi& E) {
    const int tid = threadIdx.x, wid = __builtin_amdgcn_readfirstlane(tid >> 6), lane = tid & 63, wr = wid >> 2, wc = wid & 3, fr = lane & 15, fq = lane >> 4;
    const int K = g.K, nt = K / BK;
    unsigned voffA[2], voffB[2];
#pragma unroll
    for (int i = 0; i < 2; ++i) { int R, C; stage_rc(tid * 16 + i * 8192, R, C); const int Rb = Epi::PERM ? ((R & ~31) + perm32(R & 31)) : R;
        voffA[i] = (unsigned)(R * K + C) * 2u; voffB[i] = (unsigned)(Rb * K + C) * 2u; }
    const size_t kstep = (size_t)(BK * 2);
    const size_t hstep = (size_t)HALF * K * 2;
    const size_t tstep = 2 * hstep;
    const unsigned ldsw = (unsigned)wid * 1024u;
    const int aoff = lds_byte(wr * 64 + fr, fq * 8), boff = lds_byte(wc * 32 + fr, fq * 8);
#define PG8_SA(b, h) (((b) * 2 + (h)) * HTB)
#define PG8_SB(b, h) ((4 + (b) * 2 + (h)) * HTB)
#define PG8_STAGE(bufoff, gbase, voff) do { _Pragma("unroll") for (int _i = 0; _i < 2; ++_i) \
        __builtin_amdgcn_global_load_lds((const unsigned*)((const char*)(gbase) + (voff)[_i]), (PG8_LAS unsigned*)(lds + (bufoff) + ldsw + _i * 8192), 16, 0, 0); } while (0)
#define PG8_LDA(dst, b, h) do { _Pragma("unroll") for (int m = 0; m < 4; ++m) _Pragma("unroll") for (int k = 0; k < 2; ++k) dst[m][k] = *(const PG8_LAS bf16x8*)(lds + PG8_SA(b, h) + aoff + m * 2048 + k * 1024); } while (0)
#define PG8_LDB(dst, b, h) do { _Pragma("unroll") for (int n = 0; n < 2; ++n) _Pragma("unroll") for (int k = 0; k < 2; ++k) dst[n][k] = *(const PG8_LAS bf16x8*)(lds + PG8_SB(b, h) + boff + n * 2048 + k * 1024); } while (0)
#define PG8_MMA(ai, bj, At, Bt) do { __builtin_amdgcn_s_setprio(1); _Pragma("unroll") for (int m = 0; m < 4; ++m) _Pragma("unroll") for (int n = 0; n < 2; ++n) _Pragma("unroll") for (int k = 0; k < 2; ++k) \
        acc[ai][bj][m][n] = __builtin_amdgcn_mfma_f32_16x16x32_bf16(Bt[n][k], At[m][k], acc[ai][bj][m][n], 0, 0, 0); __builtin_amdgcn_s_setprio(0); } while (0)
#define PG8_WAIT_V(n) asm volatile("s_waitcnt vmcnt(" #n ")" ::: "memory")
#define PG8_WAIT_L(n) asm volatile("s_waitcnt lgkmcnt(" #n ")" ::: "memory")
#define PG8_BAR __builtin_amdgcn_s_barrier()
#define PG8_SCHED __builtin_amdgcn_sched_barrier(0)
    Unit cur, nxt; int ui = 0;
    if (!S.next(0, cur)) return;
    f32x4 acc[2][2][4][2];
#pragma unroll
    for (int a = 0; a < 2; ++a)
#pragma unroll
        for (int b = 0; b < 2; ++b)
#pragma unroll
            for (int m = 0; m < 4; ++m)
#pragma unroll
                for (int n = 0; n < 2; ++n) acc[a][b][m][n] = (f32x4){0.f, 0.f, 0.f, 0.f};
    bf16x8 At[4][2], B0[2][2], B1[2][2];
    const char* cA = (const char*)g.A + (size_t)cur.pm * tstep; const char* cB = (const char*)g.Bt + (size_t)cur.pn * tstep;
    S.a_ready(cur);
    if constexpr (SP2) {
        PG8_STAGE(PG8_SB(0, 0), cB, voffB); PG8_STAGE(PG8_SB(0, 1), cB + hstep, voffB); PG8_STAGE(PG8_SA(0, 0), cA, voffA); PG8_STAGE(PG8_SA(0, 1), cA + hstep, voffA);
        if (wr == 1) PG8_BAR;
        PG8_WAIT_V(2); PG8_BAR;
        PG8_STAGE(PG8_SB(1, 0), cB + kstep, voffB); PG8_STAGE(PG8_SA(1, 0), cA + kstep, voffA); PG8_STAGE(PG8_SB(1, 1), cB + hstep + kstep, voffB);
        PG8_WAIT_V(6); PG8_BAR;
    } else {
        PG8_STAGE(PG8_SB(0, 0), cB, voffB); PG8_STAGE(PG8_SA(0, 0), cA, voffA); PG8_STAGE(PG8_SB(0, 1), cB + hstep, voffB); PG8_STAGE(PG8_SA(0, 1), cA + hstep, voffA);
        if (wr == 1) PG8_BAR;
        PG8_WAIT_V(4); PG8_BAR;
        PG8_STAGE(PG8_SB(1, 0), cB + kstep, voffB); PG8_STAGE(PG8_SA(1, 0), cA + kstep, voffA); PG8_STAGE(PG8_SB(1, 1), cB + hstep + kstep, voffB);
        PG8_WAIT_V(6); PG8_BAR;
    }
    for (;;) {
        const bool has_next = S.next(ui + 1, nxt);
        const char* nA = has_next ? (const char*)g.A + (size_t)nxt.pm * tstep : cA; const char* nB = has_next ? (const char*)g.Bt + (size_t)nxt.pn * tstep : cB;
        for (int t = 0; t < nt; t += 2) {
            const bool last = (t == nt - 2);
            const char* a1 = cA + (size_t)(t + 1) * kstep;
            const char* a2 = last ? nA : cA + (size_t)(t + 2) * kstep; const char* b2 = last ? nB : cB + (size_t)(t + 2) * kstep;
            const char* a3 = a2 + kstep; const char* b3 = b2 + kstep;
            if (last && has_next) S.a_ready(nxt);
            if constexpr (SP2) {
            PG8_LDB(B0, 0, 0); PG8_LDB(B1, 0, 1); PG8_SCHED; PG8_LDA(At, 0, 0); PG8_STAGE(PG8_SA(1, 1), a1 + hstep, voffA);
            PG8_WAIT_V(8); PG8_WAIT_L(0); PG8_BAR; PG8_MMA(0, 0, At, B0); PG8_MMA(0, 1, At, B1); PG8_BAR; PG8_SCHED;
            PG8_LDA(At, 0, 1); PG8_STAGE(PG8_SB(0, 0), b2, voffB); PG8_STAGE(PG8_SB(0, 1), b2 + hstep, voffB); PG8_STAGE(PG8_SA(0, 0), a2, voffA);
            PG8_WAIT_V(8); PG8_WAIT_L(0); PG8_BAR; PG8_MMA(1, 0, At, B0); PG8_MMA(1, 1, At, B1); PG8_BAR; PG8_SCHED;
            PG8_LDB(B0, 1, 0); PG8_LDB(B1, 1, 1); PG8_SCHED; PG8_LDA(At, 1, 0); PG8_STAGE(PG8_SA(0, 1), a2 + hstep, voffA);
            PG8_WAIT_V(8); PG8_WAIT_L(0); PG8_BAR; PG8_MMA(0, 0, At, B0); PG8_MMA(0, 1, At, B1); PG8_BAR; PG8_SCHED;
            PG8_LDA(At, 1, 1); PG8_STAGE(PG8_SB(1, 0), b3, voffB); PG8_STAGE(PG8_SB(1, 1), b3 + hstep, voffB); PG8_STAGE(PG8_SA(1, 0), a3, voffA);
            PG8_WAIT_V(8); PG8_WAIT_L(0); PG8_BAR; PG8_MMA(1, 0, At, B0); PG8_MMA(1, 1, At, B1); PG8_BAR; PG8_SCHED;
            } else {
            PG8_LDB(B0, 0, 0); PG8_SCHED; PG8_LDA(At, 0, 0); PG8_STAGE(PG8_SA(1, 1), a1 + hstep, voffA);
            PG8_WAIT_L(8); PG8_BAR; PG8_WAIT_L(0); PG8_MMA(0, 0, At, B0); PG8_BAR; PG8_SCHED;
            PG8_LDB(B1, 0, 1); PG8_STAGE(PG8_SB(0, 0), b2, voffB);
            PG8_BAR; PG8_WAIT_L(0); PG8_MMA(0, 1, At, B1); PG8_BAR;
            PG8_LDA(At, 0, 1); PG8_STAGE(PG8_SA(0, 0), a2, voffA);
            PG8_BAR; PG8_WAIT_L(0); PG8_MMA(1, 0, At, B0); PG8_BAR; PG8_SCHED;
            PG8_STAGE(PG8_SB(0, 1), b2 + hstep, voffB);
            PG8_WAIT_V(6); PG8_BAR; PG8_MMA(1, 1, At, B1); PG8_BAR;
            PG8_LDB(B0, 1, 0); PG8_SCHED; PG8_LDA(At, 1, 0); PG8_STAGE(PG8_SA(0, 1), a2 + hstep, voffA);
            PG8_WAIT_L(8); PG8_BAR; PG8_WAIT_L(0); PG8_MMA(0, 0, At, B0); PG8_BAR; PG8_SCHED;
            PG8_LDB(B1, 1, 1); PG8_STAGE(PG8_SB(1, 0), b3, voffB);
            PG8_BAR; PG8_WAIT_L(0); PG8_MMA(0, 1, At, B1); PG8_BAR;
            PG8_LDA(At, 1, 1); PG8_STAGE(PG8_SA(1, 0), a3, voffA);
            PG8_BAR; PG8_WAIT_L(0); PG8_MMA(1, 0, At, B0); PG8_BAR; PG8_SCHED;
            PG8_STAGE(PG8_SB(1, 1), b3 + hstep, voffB);
            PG8_WAIT_V(6); PG8_BAR; PG8_MMA(1, 1, At, B1); PG8_BAR;
            }
        }
        if constexpr (ALIGN_EPI) { if (wr == 0) PG8_BAR; }
        if constexpr (!Epi::AFTER_DRAIN) { E(acc, cur, wr, wc, fr, fq); S.done(cur); }
        if (!has_next) break;
#pragma unroll
        for (int a = 0; a < 2; ++a)
#pragma unroll
            for (int b = 0; b < 2; ++b)
#pragma unroll
                for (int m = 0; m < 4; ++m)
#pragma unroll
                    for (int n = 0; n < 2; ++n) acc[a][b][m][n] = (f32x4){0.f, 0.f, 0.f, 0.f};
        cur = nxt; cA = nA; cB = nB; ++ui;
        if constexpr (ALIGN_EPI) { if (wr == 1) PG8_BAR; }
    }
    PG8_WAIT_V(0);
    if constexpr (!ALIGN_EPI) { if (wr == 0) PG8_BAR; }
    PG8_BAR;
    if constexpr (Epi::AFTER_DRAIN) { E.fused(acc, cur, wr, wc, fr, fq, lds, wid, lane); S.done(cur); }
#undef PG8_SA
#undef PG8_SB
#undef PG8_STAGE
#undef PG8_LDA
#undef PG8_LDB
#undef PG8_MMA
#undef PG8_WAIT_V
#undef PG8_WAIT_L
#undef PG8_BAR
#undef PG8_SCHED
}
}

#define LAS __attribute__((address_space(3)))
typedef unsigned short bf16_t;
typedef short bf16x8 __attribute__((ext_vector_type(8)));
typedef float f32x4 __attribute__((ext_vector_type(4)));
typedef float f32x16 __attribute__((ext_vector_type(16)));
typedef unsigned u32x2 __attribute__((ext_vector_type(2)));
typedef unsigned u32x4 __attribute__((ext_vector_type(4)));
typedef float f32x2_t __attribute__((ext_vector_type(2)));
typedef __bf16 bf16x2_t __attribute__((ext_vector_type(2)));

constexpr int DM = 1024, NBATCH = 2, SEQ = 8192, DEPTH = 4, CTXL = 256;
constexpr int MLAT = NBATCH * SEQ, MCTX = NBATCH * CTXL, MTOT = MLAT + MCTX;
constexpr int NIN = 3584, NTM = 2048, NCM = 1536;
constexpr int C_QA = 0, C_KA = 384, C_GA = 768, C_QC = 1152, C_KC = 1536, C_GC = 1664;
constexpr int R_VA = 0, R_VC = 384, R_HZ = 512, R_GB = 1280;
constexpr int NFFT = 16384;
constexpr float LOG2E = 1.4426950408889634f;
constexpr float QK_SCALE = 0.125f * LOG2E;

constexpr size_t MiB = 1u << 20;
constexpr size_t WS_ADA = 1 * MiB;
constexpr size_t WS_ROPE = 1 * MiB + 256 * 1024;
constexpr size_t WS_H2C = 1 * MiB + 512 * 1024;
constexpr size_t WS_CX = 2 * MiB;
constexpr size_t WS_H2 = 4 * MiB;
constexpr size_t WS_WIN = 12 * MiB;
constexpr size_t WS_WOUT = 40 * MiB;
constexpr size_t WS_HY = 48 * MiB;
constexpr size_t WS_PT = 81 * MiB;
constexpr size_t WS_PCT = 147 * MiB;
constexpr size_t WS_YBT = 197 * MiB;
constexpr size_t WS_ZS = 206 * MiB;
constexpr size_t WS_END = 238 * MiB;

constexpr int LDS_BYTES = 147456;
constexpr int NTHREADS = 512;

struct KArgs {
    const float* x; const float* c; const float* ctx; const float* c_ctx; const float* norm_g; const float* w_ada; const float* b_ada;
    const float* w_in; const float* w_out; const float* na_rpb; const float* hy_conv_w; const float* hy_conv_b;
    const float* hy_w1; const float* hy_b1; const float* hy_freq1; const float* hy_w2; const float* hy_b2; const float* hy_freq2; const float* hy_w3;
    const float* hy_d; const float* sink; const float* final_g;
    float* out; unsigned char* ws;
    int ph_lo, ph_hi;
};

typedef const __attribute__((address_space(4))) KArgs CKArgs;
__device__ __forceinline__ unsigned pk2(float lo, float hi) { f32x2_t v = {lo, hi}; bf16x2_t b = __builtin_convertvector(v, bf16x2_t); return __builtin_bit_cast(unsigned, b); }
__device__ __forceinline__ float bf2f(unsigned short u) { return __uint_as_float(((unsigned)u) << 16); }
__device__ __forceinline__ float bflo(unsigned w) { return __uint_as_float(w << 16); }
__device__ __forceinline__ float bfhi(unsigned w) { return __uint_as_float(w & 0xffff0000u); }
__device__ __forceinline__ float silu_f(float x) { return x / (1.0f + __expf(-x)); }
__device__ __forceinline__ float wave_sum(float v) {
#pragma unroll
    for (int o = 1; o < 64; o <<= 1) v += __shfl_xor(v, o);
    return v;
}
__device__ __forceinline__ float rdlane(float v, int l) { return __uint_as_float(__builtin_amdgcn_readlane(__float_as_uint(v), l)); }

__device__ __forceinline__ void transpose_item(const float* W, int K, int N, bf16_t* WT, int k0, int n0, int drow0, LAS float* scr, int lane) {
#pragma unroll 8
    for (int i = 0; i < 32; ++i) { const int kk = 2 * i + (lane >> 5); scr[kk * 33 + (lane & 31)] = W[(size_t)(k0 + kk) * N + n0 + (lane & 31)]; }
    asm volatile("s_waitcnt lgkmcnt(0)" ::: "memory");
    const int c = lane & 7;
#pragma unroll
    for (int j = 0; j < 4; ++j) { const int n = (lane >> 3) + 8 * j; const LAS float* s = scr + (8 * c) * 33 + n;
        u32x4 o; o.x = pk2(s[0 * 33], s[1 * 33]); o.y = pk2(s[2 * 33], s[3 * 33]); o.z = pk2(s[4 * 33], s[5 * 33]); o.w = pk2(s[6 * 33], s[7 * 33]);
        *(u32x4*)(WT + (size_t)(drow0 + n) * K + k0 + 8 * c) = o; }
    asm volatile("s_waitcnt lgkmcnt(0)" ::: "memory");
}
__device__ __forceinline__ int win_row(int n0) {
    if (n0 < 768) return n0;
    if (n0 < 1152) return n0 - 768 + 2048;
    if (n0 < 1536) return n0 - 1152 + 768;
    if (n0 < 2304) return n0 - 1536 + 2560;
    if (n0 < 2560) return n0 - 2304 + 3328;
    if (n0 < 2944) return n0 - 2560 + 1152;
    if (n0 < 3072) return n0 - 2944 + 1536;
    if (n0 < 3200) return n0 - 3072 + 2432;
    return n0 - 3200 + 1664;
}

__device__ __forceinline__ void phase_prologue(CKArgs& A, LAS unsigned char* lds, int bid, int nblk, int tid) {
    const int wave = __builtin_amdgcn_readfirstlane(tid >> 6), lane = tid & 63;
    const int gw = bid * 8 + wave, NGW = nblk * 8;
    unsigned char* ws = A.ws;
    {
        LAS float* scr = (LAS float*)(lds + wave * 16384);
        constexpr int I_IN = 16 * 112, I_OUT = 16 * 32, I_L = I_IN + I_OUT;
        for (int it = gw; it < DEPTH * I_L; it += NGW) {
            const int l = it / I_L; int r = it % I_L;
            if (r < I_IN) { const int kb = r / 112, nb = r % 112, n0 = nb * 32;
                transpose_item(A.w_in + (size_t)l * DM * NIN, DM, NIN, (bf16_t*)(ws + WS_WIN) + (size_t)l * NIN * DM, kb * 64, n0, win_row(n0), scr, lane); }
            else { r -= I_IN; const int kb = r / 32, nb = r % 32, n0 = nb * 32;
                transpose_item(A.w_out + (size_t)l * DM * DM, DM, DM, (bf16_t*)(ws + WS_WOUT) + (size_t)l * DM * DM, kb * 64, n0, n0, scr, lane); }
        }
    }
    for (int idx = gw * 64 + lane; idx < 128 * 16; idx += NGW * 64) {
        const int p = idx >> 4, i = idx & 15;
        const float inv = powf(10000.0f, -(float)i / 16.0f);
        const float ang = (float)p * inv;
        ((float2*)(ws + WS_ROPE))[idx] = make_float2(cosf(ang), sinf(ang));
    }
    for (int it = gw; it < DEPTH * 132; it += NGW) {
        const int l = it / 132, g = it % 132;
        const int L = g < 128 ? SEQ : CTXL;
        const int n0 = g < 128 ? g * 64 : (g - 128) * 64;
        float* outp = g < 128 ? (float*)(ws + WS_H2) + ((size_t)l * SEQ + n0) * 64 : (float*)(ws + WS_H2C) + ((size_t)l * CTXL + n0) * 64;
        float w1c[33], w2c[64];
#pragma unroll
        for (int q = 0; q < 33; ++q) w1c[q] = A.hy_w1[((size_t)l * 33 + q) * 64 + lane];
#pragma unroll
        for (int j = 0; j < 64; ++j) w2c[j] = A.hy_w2[((size_t)l * 64 + j) * 64 + lane];
        const float b1 = A.hy_b1[l * 64 + lane], fr1 = A.hy_freq1[l * 64 + lane], b2 = A.hy_b2[l * 64 + lane], fr2 = A.hy_freq2[l * 64 + lane];
        const float tstep = 1.0f / (float)(L - 1), wstep = 6.283185307179586f / (float)L;
        const int fj = lane == 0 ? 0 : ((lane - 1) & 15);
        const float fq = 1e-4f + (float)fj * ((15.0f - 1e-4f) / 15.0f);
#pragma unroll 1
        for (int nn = 0; nn < 64; ++nn) {
            const int n = n0 + nn;
            const float t = (float)n * tstep, wa = (float)n * wstep;
            float zq;
            if (lane == 0) zq = t; else if (lane <= 16) zq = cosf(fq * wa); else if (lane <= 32) zq = -sinf(fq * wa); else zq = 0.f;
            float a1 = b1;
#pragma unroll
            for (int q = 0; q < 33; ++q) a1 += rdlane(zq, q) * w1c[q];
            const float h1 = sinf(fr1 * a1);
            float a2 = b2;
#pragma unroll
            for (int j = 0; j < 64; ++j) a2 += rdlane(h1, j) * w2c[j];
            outp[nn * 64 + lane] = sinf(fr2 * a2);
        }
    }
    __syncthreads();
    {
        LAS float* red = (LAS float*)lds;
        for (int it = bid; it < DEPTH * 48; it += nblk) {
            const int l = it / 48, n = (it % 48) * 64 + lane;
            const float* W = A.w_ada + (size_t)l * DM * 3072;
            float a0 = 0.f, a1 = 0.f, a2 = 0.f;
            const int kb = wave * 128;
#pragma unroll 4
            for (int k = 0; k < 128; ++k) {
                const float w = W[(size_t)(kb + k) * 3072 + n];
                a0 += silu_f(A.c[kb + k]) * w; a1 += silu_f(A.c[DM + kb + k]) * w; a2 += silu_f(A.c_ctx[kb + k]) * w;
            }
            red[(wave * 3 + 0) * 64 + lane] = a0; red[(wave * 3 + 1) * 64 + lane] = a1; red[(wave * 3 + 2) * 64 + lane] = a2;
            __syncthreads();
            if (tid < 192) { const int v = tid >> 6; float s = A.b_ada[l * 3072 + n];
#pragma unroll
                for (int w = 0; w < 8; ++w) s += red[(w * 3 + v) * 64 + lane];
                ((float*)(ws + WS_ADA))[((size_t)l * 3 + v) * 3072 + n] = s; }
            __syncthreads();
        }
    }
}

__device__ __forceinline__ void phase_norm(CKArgs& A, int l, int bid, int nblk, int tid) {
    const int wave = __builtin_amdgcn_readfirstlane(tid >> 6), lane = tid & 63;
    const int gw = bid * 8 + wave, NGW = nblk * 8;
    unsigned char* ws = A.ws;
    bf16_t* H = (bf16_t*)(ws + WS_HY);
    const float* ada = (const float*)(ws + WS_ADA) + (size_t)l * 3 * 3072;
    const float* g = A.norm_g + l * DM;
    for (int m = gw; m < MTOT; m += NGW) {
        const float* src; int v;
        if (m < MLAT) { src = (l == 0 ? A.x : A.out) + (size_t)m * DM; v = m >> 13; }
        else { src = (l == 0 ? A.ctx : (const float*)(ws + WS_CX)) + (size_t)(m - MLAT) * DM; v = 2; }
        const float* shp = ada + v * 3072; const float* scp = shp + DM;
        f32x4 xv[4]; float ss = 0.f;
#pragma unroll
        for (int j = 0; j < 4; ++j) { xv[j] = *(const f32x4*)(src + 4 * lane + 256 * j); ss += (xv[j].x * xv[j].x + xv[j].y * xv[j].y) + (xv[j].z * xv[j].z + xv[j].w * xv[j].w); }
        const float rinv = rsqrtf(wave_sum(ss) * (1.0f / DM) + 1e-6f);
#pragma unroll
        for (int j = 0; j < 4; ++j) { const int col = 4 * lane + 256 * j;
            const f32x4 gv = *(const f32x4*)(g + col), sc = *(const f32x4*)(scp + col), sh = *(const f32x4*)(shp + col);
            const f32x4 h = xv[j] * rinv * gv * (sc + 1.0f) + sh;
            u32x2 o; o.x = pk2(h.x, h.y); o.y = pk2(h.z, h.w);
            *(u32x2*)(H + (size_t)m * DM + col) = o; }
    }
}

struct EpiIn {
    static constexpr bool PERM = true, AFTER_DRAIN = false;
    bf16_t* PT; bf16_t* PCT; const float2* rope;
    __device__ __forceinline__ void operator()(const f32x4 (&acc)[2][2][4][2], const pg8::Unit& u, int wr, int wc, int fr, int fq) const {
        const int row0 = u.pm * 256 + wr * 64 + fr;
        if (u.pn < 8) {
#pragma unroll
            for (int bj = 0; bj < 2; ++bj) {
                const int blk = 2 * u.pn + bj;
                const bool rp = (blk >= 9) && (blk <= 12) && (u.pm < 64);
                const int col0 = 256 * u.pn + 128 * bj + 32 * wc + 8 * fq;
#pragma unroll
                for (int ai = 0; ai < 2; ++ai)
#pragma unroll
                    for (int m = 0; m < 4; ++m) {
                        const int r = row0 + 128 * ai + 16 * m;
                        f32x4 v0 = acc[ai][bj][m][0], v1 = acc[ai][bj][m][1];
                        if (rp) {
                            const int pos = r & (SEQ - 1);
                            const int p = (wc & 1) ? (pos & 63) : (pos >> 6);
                            const f32x4* tb = (const f32x4*)(rope + p * 16 + 8 * (fq & 1));
                            const f32x4 t0 = tb[0], t1 = tb[1], t2 = tb[2], t3 = tb[3];
                            f32x4 q0, q1;
                            q0.x = __shfl_xor(v0.x, 32); q0.y = __shfl_xor(v0.y, 32); q0.z = __shfl_xor(v0.z, 32); q0.w = __shfl_xor(v0.w, 32);
                            q1.x = __shfl_xor(v1.x, 32); q1.y = __shfl_xor(v1.y, 32); q1.z = __shfl_xor(v1.z, 32); q1.w = __shfl_xor(v1.w, 32);
                            const float sg = (fq < 2) ? -1.0f : 1.0f;
                            v0.x = v0.x * t0.x + sg * q0.x * t0.y; v0.y = v0.y * t0.z + sg * q0.y * t0.w;
                            v0.z = v0.z * t1.x + sg * q0.z * t1.y; v0.w = v0.w * t1.z + sg * q0.w * t1.w;
                            v1.x = v1.x * t2.x + sg * q1.x * t2.y; v1.y = v1.y * t2.z + sg * q1.y * t2.w;
                            v1.z = v1.z * t3.x + sg * q1.z * t3.y; v1.w = v1.w * t3.z + sg * q1.w * t3.w;
                        }
                        u32x4 w; w.x = pk2(v0.x, v0.y); w.y = pk2(v0.z, v0.w); w.z = pk2(v1.x, v1.y); w.w = pk2(v1.z, v1.w);
                        *(u32x4*)(PT + (size_t)r * NTM + col0) = w;
                        asm volatile("" ::: "memory");
                    }
            }
        } else {
#pragma unroll
            for (int bj = 0; bj < 2; ++bj) {
                const int ch0 = 256 * (u.pn - 8) + 128 * bj + 32 * wc + 8 * fq;
#pragma unroll
                for (int ai = 0; ai < 2; ++ai)
#pragma unroll
                    for (int m = 0; m < 4; ++m) {
                        const int r = row0 + 128 * ai + 16 * m;
#pragma unroll
                        for (int n = 0; n < 2; ++n) {
                            const f32x4 v = acc[ai][bj][m][n];
                            bf16_t* p = PCT + (size_t)(ch0 + 4 * n) * MTOT + r;
                            const unsigned w0 = pk2(v.x, v.y), w1 = pk2(v.z, v.w);
                            p[0] = (bf16_t)(w0 & 0xffffu); p[MTOT] = (bf16_t)(w0 >> 16); p[2 * (size_t)MTOT] = (bf16_t)(w1 & 0xffffu); p[3 * (size_t)MTOT] = (bf16_t)(w1 >> 16);
                        }
                    }
            }
        }
    }
};
struct EpiOut {
    static constexpr bool PERM = true, AFTER_DRAIN = false;
    const float* xsrc; float* xdst; const float* csrc; float* cdst; const float* ada;
    __device__ __forceinline__ void operator()(const f32x4 (&acc)[2][2][4][2], const pg8::Unit& u, int wr, int wc, int fr, int fq) const {
        const int row0 = u.pm * 256 + wr * 64 + fr;
        const bool lat = u.pm < 64;
#pragma unroll
        for (int bj = 0; bj < 2; ++bj) {
            const int col0 = 256 * u.pn + 128 * bj + 32 * wc + 8 * fq;
#pragma unroll
            for (int ai = 0; ai < 2; ++ai)
#pragma unroll
                for (int m = 0; m < 4; ++m) {
                    const int r = row0 + 128 * ai + 16 * m;
                    const int v = lat ? (r >> 13) : 2;
                    const float* gp = ada + v * 3072 + 2048 + col0;
                    const f32x4 g0 = *(const f32x4*)gp, g1 = *(const f32x4*)(gp + 4);
                    const size_t off = lat ? (size_t)r * DM + col0 : (size_t)(r - MLAT) * DM + col0;
                    const float* sp = (lat ? xsrc : csrc) + off; float* dp = (lat ? xdst : cdst) + off;
                    const f32x4 x0 = *(const f32x4*)sp, x1 = *(const f32x4*)(sp + 4);
                    *(f32x4*)dp = x0 + g0 * acc[ai][bj][m][0];
                    *(f32x4*)(dp + 4) = x1 + g1 * acc[ai][bj][m][1];
                    if (m & 1) asm volatile("" ::: "memory");
                }
        }
    }
};

template <int MK>
__device__ __forceinline__ void attn_tile(const bf16_t* kbase, const bf16_t* vbase, const bf16x8 (&bq)[4], f32x16& o0, f32x16& o1, float& m_run, float& l_run,
                                          int r31, int hh, bool rowok, int cmin, const float* biasp) {
    const bf16_t* kp = kbase + (size_t)r31 * NTM + 8 * hh;
    const bf16x8 ka0 = *(const bf16x8*)(kp), ka1 = *(const bf16x8*)(kp + 16), ka2 = *(const bf16x8*)(kp + 32), ka3 = *(const bf16x8*)(kp + 48);
    const bf16_t* vp = vbase + (size_t)r31 * MTOT + 4 * hh;
    const bf16_t* vq = vp + (size_t)32 * MTOT;
    const u32x2 a0l = *(const u32x2*)(vp), a0h = *(const u32x2*)(vp + 8), a1l = *(const u32x2*)(vp + 16), a1h = *(const u32x2*)(vp + 24);
    const u32x2 b0l = *(const u32x2*)(vq), b0h = *(const u32x2*)(vq + 8), b1l = *(const u32x2*)(vq + 16), b1h = *(const u32x2*)(vq + 24);
    f32x16 s;
#pragma unroll
    for (int i = 0; i < 16; ++i) s[i] = 0.f;
    s = __builtin_amdgcn_mfma_f32_32x32x16_bf16(ka0, bq[0], s, 0, 0, 0);
    s = __builtin_amdgcn_mfma_f32_32x32x16_bf16(ka1, bq[1], s, 0, 0, 0);
    s = __builtin_amdgcn_mfma_f32_32x32x16_bf16(ka2, bq[2], s, 0, 0, 0);
    s = __builtin_amdgcn_mfma_f32_32x32x16_bf16(ka3, bq[3], s, 0, 0, 0);
    float tmax = -INFINITY;
#pragma unroll
    for (int i = 0; i < 16; ++i) {
        const int c = (i & 3) + 8 * (i >> 2) + 4 * hh;
        float v = s[i] * QK_SCALE;
        if (MK == 1) { if (c < r31) v = -INFINITY; }
        if (MK == 2) { if (c > r31) v = -INFINITY; }
        if (MK == 3) { const bool ok = rowok && ((unsigned)(c - cmin) < 16u); float bb = 0.f; if (ok) bb = biasp[c]; v = ok ? v + bb * LOG2E : -INFINITY; }
        s[i] = v; tmax = fmaxf(tmax, v);
    }
    tmax = fmaxf(tmax, __shfl_xor(tmax, 32));
    const float m_new = fmaxf(m_run, tmax);
    const float alpha = __builtin_amdgcn_exp2f(m_run - m_new);
    m_run = m_new;
    float psum = 0.f;
#pragma unroll
    for (int i = 0; i < 16; ++i) { const float p = __builtin_amdgcn_exp2f(s[i] - m_new); s[i] = p; psum += p; }
    l_run = l_run * alpha + psum;
#pragma unroll
    for (int i = 0; i < 16; ++i) { o0[i] *= alpha; o1[i] *= alpha; }
    u32x4 pw0, pw1;
    pw0.x = pk2(s[0], s[1]); pw0.y = pk2(s[2], s[3]); pw0.z = pk2(s[4], s[5]); pw0.w = pk2(s[6], s[7]);
    pw1.x = pk2(s[8], s[9]); pw1.y = pk2(s[10], s[11]); pw1.z = pk2(s[12], s[13]); pw1.w = pk2(s[14], s[15]);
    const bf16x8 pb0 = __builtin_bit_cast(bf16x8, pw0), pb1 = __builtin_bit_cast(bf16x8, pw1);
    u32x4 t;
    t.x = a0l.x; t.y = a0l.y; t.z = a0h.x; t.w = a0h.y; const bf16x8 va00 = __builtin_bit_cast(bf16x8, t);
    t.x = a1l.x; t.y = a1l.y; t.z = a1h.x; t.w = a1h.y; const bf16x8 va01 = __builtin_bit_cast(bf16x8, t);
    t.x = b0l.x; t.y = b0l.y; t.z = b0h.x; t.w = b0h.y; const bf16x8 va10 = __builtin_bit_cast(bf16x8, t);
    t.x = b1l.x; t.y = b1l.y; t.z = b1h.x; t.w = b1h.y; const bf16x8 va11 = __builtin_bit_cast(bf16x8, t);
    o0 = __builtin_amdgcn_mfma_f32_32x32x16_bf16(va00, pb0, o0, 0, 0, 0);
    o0 = __builtin_amdgcn_mfma_f32_32x32x16_bf16(va01, pb1, o0, 0, 0, 0);
    o1 = __builtin_amdgcn_mfma_f32_32x32x16_bf16(va10, pb0, o1, 0, 0, 0);
    o1 = __builtin_amdgcn_mfma_f32_32x32x16_bf16(va11, pb1, o1, 0, 0, 0);
}

template <int MODE>
__device__ __forceinline__ void attn_item(CKArgs& A, int l, int item, int lane) {
    unsigned char* ws = A.ws;
    const bf16_t* PT = (const bf16_t*)(ws + WS_PT);
    const bf16_t* PCT = (const bf16_t*)(ws + WS_PCT);
    bf16_t* Y = (bf16_t*)(ws + WS_HY);
    const int r31 = lane & 31, hh = lane >> 5;
    int b, h, qtok;
    int rp = 0, mg = 0, qg = 0;
    if (MODE == 0) { b = item / 1536; const int rem = item % 1536; h = rem / 256; const int r2 = rem % 256; rp = r2 >> 2; mg = r2 & 3;
        qtok = b * SEQ + (2 * rp + (r31 >> 4)) * 64 + 16 * mg + (r31 & 15); }
    else if (MODE == 1) { b = item / 1536; const int rem = item % 1536; h = rem / 256; qg = rem % 256; qtok = b * SEQ + 32 * qg + r31; }
    else { b = item / 48; const int rem = item % 48; h = rem / 8; qg = rem % 8; qtok = MLAT + b * CTXL + 32 * qg + r31; }
    const bool grpA = (MODE == 0 || MODE == 2);
    const int kvh = grpA ? h : h / 3;
    const int qcol = (grpA ? C_QA : C_QC) + h * 64, kcol = (grpA ? C_KA : C_KC) + kvh * 64, gcol = (grpA ? C_GA : C_GC) + h * 64;
    const int vrow = (grpA ? R_VA : R_VC) + kvh * 64, ycol = (grpA ? 0 : 640) + h * 64;
    bf16x8 bq[4];
    { const bf16_t* qp = PT + (size_t)qtok * NTM + qcol + 8 * hh;
#pragma unroll
      for (int s = 0; s < 4; ++s) bq[s] = *(const bf16x8*)(qp + 16 * s); }
    f32x16 o0, o1;
#pragma unroll
    for (int i = 0; i < 16; ++i) { o0[i] = 0.f; o1[i] = 0.f; }
    float m_run = -1e30f, l_run = 0.f;
    if (!grpA) { m_run = A.sink[l * 6 + h] * LOG2E; l_run = hh == 0 ? 1.0f : 0.f; }
    const bf16_t* kb0 = PT + kcol; const bf16_t* vb0 = PCT + (size_t)vrow * MTOT;
#pragma unroll 1
    for (int jt = 0; jt < 8; ++jt) { const int kt = MLAT + b * CTXL + 32 * jt;
        attn_tile<0>(kb0 + (size_t)kt * NTM, vb0 + kt, bq, o0, o1, m_run, l_run, r31, hh, true, 0, nullptr); }
    if (MODE == 1) {
        const int q0 = 32 * qg;
#pragma unroll 1
        for (int i = 0; i < 9; ++i) { const int kpos = q0 - 128 + 32 * i; if (kpos < 0 || kpos >= SEQ) continue; const int kt = b * SEQ + kpos;
            if (i == 0) attn_tile<1>(kb0 + (size_t)kt * NTM, vb0 + kt, bq, o0, o1, m_run, l_run, r31, hh, true, 0, nullptr);
            else if (i == 8) attn_tile<2>(kb0 + (size_t)kt * NTM, vb0 + kt, bq, o0, o1, m_run, l_run, r31, hh, true, 0, nullptr);
            else attn_tile<0>(kb0 + (size_t)kt * NTM, vb0 + kt, bq, o0, o1, m_run, l_run, r31, hh, true, 0, nullptr); }
    }
    if (MODE == 0) {
        const int ra = min(max(2 * rp - 4, 0), 120), rb = min(max(2 * rp - 3, 0), 120) + 7;
        const int cs = min(max(16 * mg - 8, 0), 32);
        const int rq = 2 * rp + (r31 >> 4), jq = 16 * mg + (r31 & 15);
        const int r0 = min(max(rq - 4, 0), 120), c0 = min(max(jq - 8, 0), 48);
        const int cmin = c0 - cs;
        const float* rpb = A.na_rpb + (size_t)(l * 6 + h) * 15 * 31;
#pragma unroll 1
        for (int a = ra; a <= rb; ++a) { const int kt = b * SEQ + a * 64 + cs;
            const bool rowok = (a >= r0) && (a < r0 + 8);
            const float* bp = rpb + (a - rq + 7) * 31 + (cs - jq + 15);
            attn_tile<3>(kb0 + (size_t)kt * NTM, vb0 + kt, bq, o0, o1, m_run, l_run, r31, hh, rowok, cmin, bp); }
    }
    const float ltot = l_run + __shfl_xor(l_run, 32);
    const float inv = 1.0f / ltot;
    const bf16_t* gp = PT + (size_t)qtok * NTM + gcol + 4 * hh;
    bf16_t* yp = Y + (size_t)qtok * DM + ycol + 4 * hh;
#pragma unroll
    for (int db = 0; db < 2; ++db)
#pragma unroll
        for (int g4 = 0; g4 < 4; ++g4) {
            const int d0 = 32 * db + 8 * g4;
            const u32x2 gw = *(const u32x2*)(gp + d0);
            float v0, v1, v2, v3;
            if (db == 0) { v0 = o0[4 * g4]; v1 = o0[4 * g4 + 1]; v2 = o0[4 * g4 + 2]; v3 = o0[4 * g4 + 3]; }
            else { v0 = o1[4 * g4]; v1 = o1[4 * g4 + 1]; v2 = o1[4 * g4 + 2]; v3 = o1[4 * g4 + 3]; }
            v0 *= inv * silu_f(bflo(gw.x)); v1 *= inv * silu_f(bfhi(gw.x)); v2 *= inv * silu_f(bflo(gw.y)); v3 *= inv * silu_f(bfhi(gw.y));
            u32x2 o; o.x = pk2(v0, v1); o.y = pk2(v2, v3);
            *(u32x2*)(yp + d0) = o;
        }
}

typedef float cf2 __attribute__((ext_vector_type(2)));
__device__ __forceinline__ cf2 mk2(float x, float y) { cf2 r; r.x = x; r.y = y; return r; }
__device__ __forceinline__ cf2 cmul(cf2 a, cf2 b) { return mk2(a.x * b.x - a.y * b.y, a.x * b.y + a.y * b.x); }
__device__ __forceinline__ void fft_fwd(LAS cf2* buf, int tid) {
#pragma unroll 1
    for (int p = 0; p < 7; ++p) {
        const int ls = 12 - 2 * p, s = 1 << ls;
        const float rs = 1.0f / (float)(4 * s);
#pragma unroll 2
        for (int k = 0; k < 8; ++k) {
            const int bf = tid + 512 * k, i = bf & (s - 1), base = ((bf >> ls) << (ls + 2)) + i;
            const cf2 x0 = buf[base], x1 = buf[base + s], x2 = buf[base + 2 * s], x3 = buf[base + 3 * s];
            const float a = (float)i * rs;
            const cf2 w1 = mk2(__builtin_amdgcn_cosf(a), -__builtin_amdgcn_sinf(a));
            const cf2 w2 = cmul(w1, w1), w3 = cmul(w2, w1);
            const cf2 s02 = mk2(x0.x + x2.x, x0.y + x2.y), d02 = mk2(x0.x - x2.x, x0.y - x2.y);
            const cf2 s13 = mk2(x1.x + x3.x, x1.y + x3.y), d13 = mk2(x1.x - x3.x, x1.y - x3.y);
            buf[base] = mk2(s02.x + s13.x, s02.y + s13.y);
            buf[base + s] = cmul(mk2(s02.x - s13.x, s02.y - s13.y), w2);
            buf[base + 2 * s] = cmul(mk2(d02.x + d13.y, d02.y - d13.x), w1);
            buf[base + 3 * s] = cmul(mk2(d02.x - d13.y, d02.y + d13.x), w3);
        }
        __syncthreads();
    }
}
__device__ __forceinline__ void fft_inv(LAS cf2* buf, int tid) {
#pragma unroll 1
    for (int p = 0; p < 7; ++p) {
        const int ls = 2 * p, s = 1 << ls;
        const float rs = 1.0f / (float)(4 * s);
#pragma unroll 2
        for (int k = 0; k < 8; ++k) {
            const int bf = tid + 512 * k, i = bf & (s - 1), base = ((bf >> ls) << (ls + 2)) + i;
            const cf2 v0 = buf[base], v1 = buf[base + s], v2 = buf[base + 2 * s], v3 = buf[base + 3 * s];
            const float a = (float)i * rs;
            const cf2 w1 = mk2(__builtin_amdgcn_cosf(a), __builtin_amdgcn_sinf(a));
            const cf2 w2 = cmul(w1, w1);
            const cf2 bb = cmul(v1, w2), dd = cmul(v3, w2);
            const cf2 u0 = mk2(v0.x + bb.x, v0.y + bb.y), u1 = mk2(v0.x - bb.x, v0.y - bb.y);
            const cf2 u2 = mk2(v2.x + dd.x, v2.y + dd.y), u3 = mk2(v2.x - dd.x, v2.y - dd.y);
            const cf2 e = cmul(u2, w1), f0 = cmul(u3, w1);
            const cf2 f = mk2(-f0.y, f0.x);
            buf[base] = mk2(u0.x + e.x, u0.y + e.y); buf[base + 2 * s] = mk2(u0.x - e.x, u0.y - e.y);
            buf[base + s] = mk2(u1.x + f.x, u1.y + f.y); buf[base + 3 * s] = mk2(u1.x - f.x, u1.y - f.y);
        }
        __syncthreads();
    }
}
__device__ __forceinline__ float hy_short(const bf16_t* prow, int tb, int t, int L, float w0, float w1, float w2, float bias) {
    const float pm = t > 0 ? bf2f(prow[tb + t - 1]) : 0.f;
    const float pc = bf2f(prow[tb + t]);
    const float pp = t < L - 1 ? bf2f(prow[tb + t + 1]) : 0.f;
    return w0 * pm + w1 * pc + w2 * pp + bias;
}
__device__ __forceinline__ float block_sum(float v, LAS float* red, int tid) {
    v = wave_sum(v);
    __syncthreads();
    if ((tid & 63) == 0) red[tid >> 6] = v;
    __syncthreads();
    float s = 0.f;
#pragma unroll
    for (int w = 0; w < 8; ++w) s += red[w];
    return s;
}

__device__ __forceinline__ void hyena_block(CKArgs& A, int l, int c, LAS unsigned char* lds, int tid) {
    unsigned char* ws = A.ws;
    LAS cf2* buf = (LAS cf2*)lds;
    LAS float* fs = (LAS float*)lds;
    LAS float* aux = (LAS float*)(lds + 131072);
    LAS float* red = aux + 256;
    const bf16_t* PCT = (const bf16_t*)(ws + WS_PCT);
    bf16_t* YBT = (bf16_t*)(ws + WS_YBT);
    cf2* ZS = (cf2*)(ws + WS_ZS) + (size_t)c * NFFT;
    const bf16_t* rowz = PCT + (size_t)(R_HZ + c) * MTOT;
    const bf16_t* rowx1 = rowz + (size_t)256 * MTOT;
    const bf16_t* rowx2 = rowz + (size_t)512 * MTOT;
    const bf16_t* rowg = PCT + (size_t)(R_GB + c) * MTOT;
    const float* cw = A.hy_conv_w + (size_t)l * 3 * 768; const float* cb = A.hy_conv_b + (size_t)l * 768;
    const float wz0 = cw[c], wz1 = cw[768 + c], wz2 = cw[1536 + c], bz = cb[c];
    const float wa0 = cw[256 + c], wa1 = cw[768 + 256 + c], wa2 = cw[1536 + 256 + c], ba = cb[256 + c];
    const float wb0 = cw[512 + c], wb1 = cw[768 + 512 + c], wb2 = cw[1536 + 512 + c], bb = cb[512 + c];
    const float d0 = A.hy_d[(l * 2 + 0) * 256 + c], d1 = A.hy_d[(l * 2 + 1) * 256 + c];
    const float dmin = -3.0701134573253945f, dmax = -15.350567286626973f;
    const float delta = fabsf(dmin + (float)c * ((dmax - dmin) / 255.0f));
    __syncthreads();
    if (tid < 256) { const int k = tid >> 6, j = tid & 63; aux[tid] = A.hy_w3[((size_t)l * 64 + j) * 1024 + k * 256 + c]; }
    __syncthreads();

    if (l < DEPTH - 1) {
        float ss0 = 0.f, ss1 = 0.f;
        if (tid < 256) {
            const int n = tid; const f32x4* hr = (const f32x4*)((const float*)(ws + WS_H2C) + ((size_t)l * CTXL + n) * 64);
            float f0 = 0.f, f1 = 0.f, b0 = 0.f, b1 = 0.f;
#pragma unroll 1
            for (int j4 = 0; j4 < 16; ++j4) { const f32x4 hv = hr[j4];
#pragma unroll
                for (int e = 0; e < 4; ++e) { const float hvv = hv[e]; const int j = 4 * j4 + e; f0 += hvv * aux[j]; f1 += hvv * aux[64 + j]; b0 += hvv * aux[128 + j]; b1 += hvv * aux[192 + j]; } }
            const float e = __expf(-((float)n * (1.0f / 255.0f)) * delta);
            f0 *= e; f1 *= e; b0 *= e; b1 *= e;
            fs[n] = f0; fs[256 + n] = f1; fs[512 + n] = b0; fs[768 + n] = b1;
            ss0 = f0 * f0 + (n >= 1 ? b0 * b0 : 0.f); ss1 = f1 * f1 + (n >= 1 ? b1 * b1 : 0.f);
        }
        const int b = tid >> 8, t = tid & 255, tok = MLAT + b * CTXL;
        const float z = hy_short(rowz, tok, t, CTXL, wz0, wz1, wz2, bz);
        const float x1 = hy_short(rowx1, tok, t, CTXL, wa0, wa1, wa2, ba);
        const float x2 = hy_short(rowx2, tok, t, CTXL, wb0, wb1, wb2, bb);
        const float gb = bf2f(rowg[tok + t]);
        fs[1024 + tid] = z;
        const float n0 = rsqrtf(block_sum(ss0, red, tid) + 1e-6f);
        const float n1 = rsqrtf(block_sum(ss1, red, tid) + 1e-6f);
        __syncthreads();
        float y = 0.f;
#pragma unroll 4
        for (int s = 0; s < 256; ++s) { const int d = t - s; const float kv = d >= 0 ? fs[d] : fs[512 - d]; y += fs[1024 + b * 256 + s] * kv; }
        const float z1 = x1 * (y * n0 + d0 * z);
        fs[1536 + tid] = z1;
        __syncthreads();
        float y2 = 0.f;
#pragma unroll 4
        for (int s = 0; s < 256; ++s) { const int d = t - s; const float kv = d >= 0 ? fs[256 + d] : fs[768 - d]; y2 += fs[1536 + b * 256 + s] * kv; }
        const float o = x2 * (y2 * n1 + d1 * z1) * silu_f(gb);
        YBT[(size_t)c * MTOT + tok + t] = (bf16_t)(pk2(o, 0.f) & 0xffffu);
        __syncthreads();
    }

    float nrm0, nrm1;
    {
        float ss0 = 0.f, ss1 = 0.f;
        const float* H2 = (const float*)(ws + WS_H2) + (size_t)l * SEQ * 64;
#pragma unroll 1
        for (int k = 0; k < 16; ++k) {
            const int n = tid + 512 * k; const f32x4* hr = (const f32x4*)(H2 + (size_t)n * 64);
            float f0 = 0.f, f1 = 0.f, b0 = 0.f, b1 = 0.f;
#pragma unroll 1
            for (int j4 = 0; j4 < 16; ++j4) { const f32x4 hv = hr[j4];
#pragma unroll
                for (int e = 0; e < 4; ++e) { const float hvv = hv[e]; const int j = 4 * j4 + e; f0 += hvv * aux[j]; f1 += hvv * aux[64 + j]; b0 += hvv * aux[128 + j]; b1 += hvv * aux[192 + j]; } }
            const float e = __expf(-((float)n * (1.0f / 8191.0f)) * delta);
            f0 *= e; f1 *= e; b0 *= e; b1 *= e;
            buf[n] = mk2(f0, f1); ss0 += f0 * f0; ss1 += f1 * f1;
            if (n >= 1) { buf[NFFT - n] = mk2(b0, b1); ss0 += b0 * b0; ss1 += b1 * b1; }
        }
        if (tid == 0) buf[SEQ] = mk2(0.f, 0.f);
        nrm0 = rsqrtf(block_sum(ss0, red, tid) + 1e-6f) * (1.0f / NFFT);
        nrm1 = rsqrtf(block_sum(ss1, red, tid) + 1e-6f) * (1.0f / NFFT);
        __syncthreads();
        fft_fwd(buf, tid);
#pragma unroll 4
        for (int k = 0; k < 32; ++k) { const int p = tid + 512 * k; ZS[p] = buf[p]; }
        __syncthreads();
    }
    cf2 z1r[16];
#pragma unroll 1
    for (int k = 0; k < 16; ++k) {
        const int t = tid + 512 * k;
        buf[t] = mk2(hy_short(rowz, 0, t, SEQ, wz0, wz1, wz2, bz), hy_short(rowz, SEQ, t, SEQ, wz0, wz1, wz2, bz));
        buf[SEQ + t] = mk2(0.f, 0.f);
    }
    __syncthreads();
    fft_fwd(buf, tid);
#pragma unroll 2
    for (int k = 0; k < 32; ++k) {
        const int p = tid + 512 * k; const int f = (int)(__brev((unsigned)p) >> 18); const int pp = (int)(__brev((unsigned)((NFFT - f) & (NFFT - 1))) >> 18);
        const cf2 a = ZS[p], bq = ZS[pp];
        const cf2 kk = mk2((a.x + bq.x) * 0.5f * nrm0, (a.y - bq.y) * 0.5f * nrm0);
        buf[p] = cmul(buf[p], kk);
    }
    __syncthreads();
    fft_inv(buf, tid);
#pragma unroll 1
    for (int k = 0; k < 16; ++k) {
        const int t = tid + 512 * k;
        const cf2 y = buf[t];
        const float za = hy_short(rowz, 0, t, SEQ, wz0, wz1, wz2, bz), zb = hy_short(rowz, SEQ, t, SEQ, wz0, wz1, wz2, bz);
        const float xa = hy_short(rowx1, 0, t, SEQ, wa0, wa1, wa2, ba), xb = hy_short(rowx1, SEQ, t, SEQ, wa0, wa1, wa2, ba);
        buf[t] = mk2(xa * (y.x + d0 * za), xb * (y.y + d0 * zb));
        buf[SEQ + t] = mk2(0.f, 0.f);
    }
#pragma unroll
    for (int k = 0; k < 16; ++k) z1r[k] = buf[tid + 512 * k];
    __syncthreads();
    fft_fwd(buf, tid);
#pragma unroll 2
    for (int k = 0; k < 32; ++k) {
        const int p = tid + 512 * k; const int f = (int)(__brev((unsigned)p) >> 18); const int pp = (int)(__brev((unsigned)((NFFT - f) & (NFFT - 1))) >> 18);
        const cf2 a = ZS[p], bq = ZS[pp];
        const cf2 kk = mk2((a.y + bq.y) * 0.5f * nrm1, -(a.x - bq.x) * 0.5f * nrm1);
        buf[p] = cmul(buf[p], kk);
    }
    __syncthreads();
    fft_inv(buf, tid);
#pragma unroll
    for (int k = 0; k < 16; ++k) { const int t = tid + 512 * k; const cf2 y = buf[t]; buf[t] = mk2(y.x + d1 * z1r[k].x, y.y + d1 * z1r[k].y); }
    bf16_t* yrow = YBT + (size_t)c * MTOT;
#pragma unroll 1
    for (int k = 0; k < 16; ++k) {
        const int t = tid + 512 * k;
        const cf2 y = buf[t];
        const float xa = hy_short(rowx2, 0, t, SEQ, wb0, wb1, wb2, bb), xb = hy_short(rowx2, SEQ, t, SEQ, wb0, wb1, wb2, bb);
        const float ga = bf2f(rowg[t]), gb = bf2f(rowg[SEQ + t]);
        const float oa = xa * y.x * silu_f(ga), ob = xb * y.y * silu_f(gb);
        yrow[t] = (bf16_t)(pk2(oa, 0.f) & 0xffffu); yrow[SEQ + t] = (bf16_t)(pk2(ob, 0.f) & 0xffffu);
    }
    __syncthreads();
}

__device__ __forceinline__ void phase_mix(CKArgs& A, int l, LAS unsigned char* lds, int bid, int nblk, int tid) {
    const int wave = __builtin_amdgcn_readfirstlane(tid >> 6), lane = tid & 63;
    const int gw = bid * 8 + wave, NGW = nblk * 8;
#ifndef NOHY
    for (int c = bid; c < 256; c += nblk) hyena_block(A, l, c, lds, tid);
#endif
#ifndef NOAT
#pragma unroll 1
    for (int it = gw; it < 3072; it += NGW) attn_item<0>(A, l, it, lane);
#pragma unroll 1
    for (int it = gw; it < 3072; it += NGW) attn_item<1>(A, l, it, lane);
    if (l < DEPTH - 1) {
#pragma unroll 1
        for (int it = gw; it < 96; it += NGW) attn_item<2>(A, l, it, lane);
#pragma unroll 1
        for (int it = gw; it < 96; it += NGW) attn_item<3>(A, l, it, lane);
    }
#endif
}

__device__ __forceinline__ void phase_tr(CKArgs& A, int l, LAS unsigned char* lds, int bid, int nblk, int tid) {
    const int wave = __builtin_amdgcn_readfirstlane(tid >> 6), lane = tid & 63;
    const int gw = bid * 8 + wave, NGW = nblk * 8;
    unsigned char* ws = A.ws;
    const bf16_t* YBT = (const bf16_t*)(ws + WS_YBT);
    bf16_t* Y = (bf16_t*)(ws + WS_HY);
    LAS bf16_t* scr = (LAS bf16_t*)(lds + wave * 16384);
    const int ntok = (l < DEPTH - 1) ? MTOT : MLAT;
    const int nitems = (ntok / 64) * 4;
#pragma unroll 1
    for (int it = gw; it < nitems; it += NGW) {
        const int tb = (it >> 2) * 64, cb = (it & 3) * 64;
#pragma unroll 8
        for (int i = 0; i < 64; ++i) scr[i * 66 + lane] = YBT[(size_t)(cb + i) * MTOT + tb + lane];
        asm volatile("s_waitcnt lgkmcnt(0)" ::: "memory");
        const int cc = (lane & 7) * 8;
#pragma unroll
        for (int k = 0; k < 8; ++k) {
            const int tq = (lane >> 3) + 8 * k;
            u32x4 o;
            o.x = (unsigned)scr[(cc + 0) * 66 + tq] | ((unsigned)scr[(cc + 1) * 66 + tq] << 16);
            o.y = (unsigned)scr[(cc + 2) * 66 + tq] | ((unsigned)scr[(cc + 3) * 66 + tq] << 16);
            o.z = (unsigned)scr[(cc + 4) * 66 + tq] | ((unsigned)scr[(cc + 5) * 66 + tq] << 16);
            o.w = (unsigned)scr[(cc + 6) * 66 + tq] | ((unsigned)scr[(cc + 7) * 66 + tq] << 16);
            *(u32x4*)(Y + (size_t)(tb + tq) * DM + 384 + cb + cc) = o;
        }
        asm volatile("s_waitcnt lgkmcnt(0)" ::: "memory");
    }
}

__device__ __forceinline__ void phase_final(CKArgs& A, int bid, int nblk, int tid) {
    const int wave = __builtin_amdgcn_readfirstlane(tid >> 6), lane = tid & 63;
    const int gw = bid * 8 + wave, NGW = nblk * 8;
    for (int m = gw; m < MLAT; m += NGW) {
        float* row = A.out + (size_t)m * DM;
        f32x4 xv[4]; float ss = 0.f;
#pragma unroll
        for (int j = 0; j < 4; ++j) { xv[j] = *(const f32x4*)(row + 4 * lane + 256 * j); ss += (xv[j].x * xv[j].x + xv[j].y * xv[j].y) + (xv[j].z * xv[j].z + xv[j].w * xv[j].w); }
        const float rinv = rsqrtf(wave_sum(ss) * (1.0f / DM) + 1e-6f);
#pragma unroll
        for (int j = 0; j < 4; ++j) { const int col = 4 * lane + 256 * j; const f32x4 gv = *(const f32x4*)(A.final_g + col); *(f32x4*)(row + col) = xv[j] * rinv * gv; }
    }
}

constexpr int NPHASE = 2 + 5 * DEPTH;
__global__ void __launch_bounds__(NTHREADS, 2) hybrid_fwd(KArgs Aval) {
    extern __shared__ __attribute__((aligned(16))) unsigned char lds_raw[];
    LAS unsigned char* lds = (LAS unsigned char*)lds_raw;
    const int tid0 = threadIdx.x, bid = blockIdx.x, nblk = gridDim.x;
#pragma unroll 1
    for (int ph = Aval.ph_lo; ph < Aval.ph_hi; ++ph) {
        int tid = tid0; asm volatile("" : "+v"(tid));
        CKArgs* Ap = (CKArgs*)__builtin_amdgcn_kernarg_segment_ptr(); asm volatile("" : "+s"(Ap));
        CKArgs& A = *Ap;
        unsigned char* ws = A.ws;
#if !MK_MULTI
        if (ph > Aval.ph_lo) cg::this_grid().sync();
#endif
#ifndef ONLY
#define ONLY -1
#endif
#define EN(k) (ONLY < 0 || ((ONLY >> (k)) & 1))
        if (ph == 0) { if (EN(0)) phase_prologue(A, lds, bid, nblk, tid); }
        else if (ph == NPHASE - 1) { if (EN(6)) phase_final(A, bid, nblk, tid); }
        else {
            const int l = (ph - 1) / 5, k = (ph - 1) % 5;
            if (k == 0) { if (EN(1)) phase_norm(A, l, bid, nblk, tid); }
            else if (k == 1) { if (EN(2)) {
                pg8::Gemm g{(const bf16_t*)(ws + WS_HY), (const bf16_t*)(ws + WS_WIN) + (size_t)l * NIN * DM, MTOT, NIN, DM};
                pg8::StaticOrder S; S.init(MTOT, NIN, nblk, bid);
                EpiIn E{(bf16_t*)(ws + WS_PT), (bf16_t*)(ws + WS_PCT), (const float2*)(ws + WS_ROPE)};
                pg8::gemm_phase<EpiIn, pg8::StaticOrder, true, false>(lds, g, S, E);
            } }
            else if (k == 2) { if (EN(3)) phase_mix(A, l, lds, bid, nblk, tid); }
            else if (k == 3) { if (EN(4)) phase_tr(A, l, lds, bid, nblk, tid); }
            else if (EN(5)) {
                const int M2 = (l < DEPTH - 1) ? MTOT : MLAT;
                pg8::Gemm g{(const bf16_t*)(ws + WS_HY), (const bf16_t*)(ws + WS_WOUT) + (size_t)l * DM * DM, M2, DM, DM};
                pg8::StaticOrder S; S.init(M2, DM, nblk, bid);
                EpiOut E{l == 0 ? A.x : A.out, A.out, l == 0 ? A.ctx : (const float*)(ws + WS_CX), (float*)(ws + WS_CX), (const float*)(ws + WS_ADA) + (size_t)l * 3 * 3072};
                pg8::gemm_phase<EpiOut, pg8::StaticOrder, true, true>(lds, g, S, E);
            }
        }
    }
}

extern "C" void kernel_launch(void* const* d_in, const int* in_sizes, int n_in, void* d_out, int out_size, void* d_ws, size_t ws_size, hipStream_t stream) {
    static int grid = 0;
    if (grid == 0) {
        if (n_in != 22 || ws_size < WS_END) { fprintf(stderr, "kernel_launch: unexpected inputs (n_in %d, ws %zu)\n", n_in, ws_size); grid = -1; return; }
        int dev = 0, cus = 0, per_cu = 0;
        if (hipGetDevice(&dev) != hipSuccess || hipDeviceGetAttribute(&cus, hipDeviceAttributeMultiprocessorCount, dev) != hipSuccess) { grid = -1; return; }
        if (hipFuncSetAttribute((const void*)hybrid_fwd, hipFuncAttributeMaxDynamicSharedMemorySize, LDS_BYTES) != hipSuccess) { fprintf(stderr, "kernel_launch: hipFuncSetAttribute failed\n"); grid = -1; return; }
        if (hipOccupancyMaxActiveBlocksPerMultiprocessor(&per_cu, (const void*)hybrid_fwd, NTHREADS, LDS_BYTES) != hipSuccess || per_cu < 1) { fprintf(stderr, "kernel_launch: occupancy query says %d\n", per_cu); per_cu = 1; }
        (void)hipGetLastError();
        grid = cus;
    }
    if (grid < 0) return;
    KArgs a{};
    a.x = (const float*)d_in[0]; a.c = (const float*)d_in[1]; a.ctx = (const float*)d_in[2]; a.c_ctx = (const float*)d_in[3]; a.norm_g = (const float*)d_in[4];
    a.w_ada = (const float*)d_in[5]; a.b_ada = (const float*)d_in[6]; a.w_in = (const float*)d_in[7]; a.w_out = (const float*)d_in[8]; a.na_rpb = (const float*)d_in[9];
    a.hy_conv_w = (const float*)d_in[10]; a.hy_conv_b = (const float*)d_in[11]; a.hy_w1 = (const float*)d_in[12]; a.hy_b1 = (const float*)d_in[13]; a.hy_freq1 = (const float*)d_in[14];
    a.hy_w2 = (const float*)d_in[15]; a.hy_b2 = (const float*)d_in[16]; a.hy_freq2 = (const float*)d_in[17]; a.hy_w3 = (const float*)d_in[18]; a.hy_d = (const float*)d_in[19];
    a.sink = (const float*)d_in[20]; a.final_g = (const float*)d_in[21];
    a.out = (float*)d_out; a.ws = (unsigned char*)d_ws;
#if MK_MULTI
    for (int ph = 0; ph < NPHASE; ++ph) {
        a.ph_lo = ph; a.ph_hi = ph + 1;
        hipLaunchKernelGGL(hybrid_fwd, dim3(grid), dim3(NTHREADS), LDS_BYTES, stream, a);
    }
#else
    a.ph_lo = 0; a.ph_hi = NPHASE;
    void* args[] = {&a};
    hipError_t e = hipLaunchCooperativeKernel((const void*)hybrid_fwd, dim3(grid), dim3(NTHREADS), args, LDS_BYTES, stream);
    if (e != hipSuccess) fprintf(stderr, "cooperative launch failed: %s (grid %d)\n", hipGetErrorString(e), grid);
#endif
}
```

```cpp
#include <hip/hip_runtime.h>
#include <hip/hip_cooperative_groups.h>
#include <cstdio>
#include <cstdint>
namespace cg = cooperative_groups;

#ifndef MK_MULTI
#define MK_MULTI 0
#endif

namespace pg8 {
#define PG8_LAS __attribute__((address_space(3)))
typedef unsigned short bf16_t;
typedef short bf16x8 __attribute__((ext_vector_type(8)));
typedef float f32x4 __attribute__((ext_vector_type(4)));
typedef unsigned u32x4 __attribute__((ext_vector_type(4)));
constexpr int BM = 256, BK = 64, HALF = 128, HTB = HALF * BK * 2  , STAGE_BYTES = 8 * HTB, NXCD = 8, WGM = 8;

__host__ __device__ __forceinline__ int lds_byte(int r, int c) { const int st = (r >> 4) * 2 + (c >> 5), rr = r & 15, cc = c & 31, ob = rr * 64 + cc * 2; return st * 1024 + (ob ^ (((ob >> 9) & 1) << 5)); }
__host__ __device__ __forceinline__ void stage_rc(int b, int& R, int& C) { const int st = b / 1024, sb = b % 1024, swz = sb ^ (((sb >> 9) & 1) << 5); R = (st >> 1) * 16 + swz / 64; C = (st & 1) * 32 + (swz % 64) / 2; }
__host__ __device__ __forceinline__ int perm32(int rho) { const int n = rho >> 4, i = rho & 15; return 8 * (i >> 2) + 4 * n + (i & 3); }

struct Unit { int pm, pn; };
struct Gemm { const bf16_t* A; const bf16_t* Bt; int M, N, K; };

struct StaticOrder {
    int nM, nN, nwg, G, c;
    __host__ __device__ void init(int M, int N, int G_, int c_) { nM = M / BM; nN = N / BM; nwg = nM * nN; G = G_; c = c_; }
    __host__ __device__ bool next(int i, Unit& u) const {
        const long L = (long)i * G + c; if (L >= nwg) return false;
        int wgid = (int)L; { const int q = nwg / NXCD, r = nwg % NXCD, xcd = wgid % NXCD, off = wgid / NXCD; wgid = (xcd < r ? xcd * (q + 1) : r * (q + 1) + (xcd - r) * q) + off; }
        const int nig = WGM * nN, gid = wgid / nig, fm = gid * WGM, gsz = (nM - fm) < WGM ? (nM - fm) : WGM;
        u.pm = fm + ((wgid % nig) % gsz); u.pn = (wgid % nig) / gsz; return true;
    }
    __device__ __forceinline__ void a_ready(const Unit&) const {}
    __device__ __forceinline__ void done(const Unit&) const {}
};

template <class Epi, class Sched, bool ALIGN_EPI = false, bool SP2 = false>
__device__ __forceinline__ void gemm_phase(PG8_LAS unsigned char* lds, const Gemm g, const Sched& S, const Epi& E) {
    const int tid = threadIdx.x, wid = __builtin_amdgcn_readfirstlane(tid >> 6), lane = tid & 63, wr = wid >> 2, wc = wid & 3, fr = lane & 15, fq = lane >> 4;
    const int K = g.K, nt = K / BK;
    unsigned voffA[2], voffB[2];
#pragma unroll
    for (int i = 0; i < 2; ++i) { int R, C; stage_rc(tid * 16 + i * 8192, R, C); const int Rb = Epi::PERM ? ((R & ~31) + perm32(R & 31)) : R;
        voffA[i] = (unsigned)(R * K + C) * 2u; voffB[i] = (unsigned)(Rb * K + C) * 2u; }
    const size_t kstep = (size_t)(BK * 2);
    const size_t hstep = (size_t)HALF * K * 2;
    const size_t tstep = 2 * hstep;
    const unsigned ldsw = (unsigned)wid * 1024u;
    const int aoff = lds_byte(wr * 64 + fr, fq * 8), boff = lds_byte(wc * 32 + fr, fq * 8);
#define PG8_SA(b, h) (((b) * 2 + (h)) * HTB)
#define PG8_SB(b, h) ((4 + (b) * 2 + (h)) * HTB)
#define PG8_STAGE(bufoff, gbase, voff) do { _Pragma("unroll") for (int _i = 0; _i < 2; ++_i) \
        __builtin_amdgcn_global_load_lds((const unsigned*)((const char*)(gbase) + (voff)[_i]), (PG8_LAS unsigned*)(lds + (bufoff) + ldsw + _i * 8192), 16, 0, 0); } while (0)
#define PG8_LDA(dst, b, h) do { _Pragma("unroll") for (int m = 0; m < 4; ++m) _Pragma("unroll") for (int k = 0; k < 2; ++k) dst[m][k] = *(const PG8_LAS bf16x8*)(lds + PG8_SA(b, h) + aoff + m * 2048 + k * 1024); } while (0)
#define PG8_LDB(dst, b, h) do { _Pragma("unroll") for (int n = 0; n < 2; ++n) _Pragma("unroll") for (int k = 0; k < 2; ++k) dst[n][k] = *(const PG8_LAS bf16x8*)(lds + PG8_SB(b, h) + boff + n * 2048 + k * 1024); } while (0)
#define PG8_MMA(ai, bj, At, Bt) do { __builtin_amdgcn_s_setprio(1); _Pragma("unroll") for (int m = 0; m < 4; ++m) _Pragma("unroll") for (int n = 0; n < 2; ++n) _Pragma("unroll") for (int k = 0; k < 2; ++k) \
        acc[ai][bj][m][n] = __builtin_amdgcn_mfma_f32_16x16x32_bf16(Bt[n][k], At[m][k], acc[ai][bj][m][n], 0, 0, 0); __builtin_amdgcn_s_setprio(0); } while (0)
#define PG8_WAIT_V(n) asm volatile("s_waitcnt vmcnt(" #n ")" ::: "memory")
#define PG8_WAIT_L(n) asm volatile("s_waitcnt lgkmcnt(" #n ")" ::: "memory")
#define PG8_BAR __builtin_amdgcn_s_barrier()
#define PG8_SCHED __builtin_amdgcn_sched_barrier(0)
    Unit cur, nxt; int ui = 0;
    if (!S.next(0, cur)) return;
    f32x4 acc[2][2][4][2];
#pragma unroll
    for (int a = 0; a < 2; ++a)
#pragma unroll
        for (int b = 0; b < 2; ++b)
#pragma unroll
            for (int m = 0; m < 4; ++m)
#pragma unroll
                for (int n = 0; n < 2; ++n) acc[a][b][m][n] = (f32x4){0.f, 0.f, 0.f, 0.f};
    bf16x8 At[4][2], B0[2][2], B1[2][2];
    const char* cA = (const char*)g.A + (size_t)cur.pm * tstep; const char* cB = (const char*)g.Bt + (size_t)cur.pn * tstep;
    S.a_ready(cur);
    if constexpr (SP2) {
        PG8_STAGE(PG8_SB(0, 0), cB, voffB); PG8_STAGE(PG8_SB(0, 1), cB + hstep, voffB); PG8_STAGE(PG8_SA(0, 0), cA, voffA); PG8_STAGE(PG8_SA(0, 1), cA + hstep, voffA);
        if (wr == 1) PG8_BAR;
        PG8_WAIT_V(2); PG8_BAR;
        PG8_STAGE(PG8_SB(1, 0), cB + kstep, voffB); PG8_STAGE(PG8_SA(1, 0), cA + kstep, voffA); PG8_STAGE(PG8_SB(1, 1), cB + hstep + kstep, voffB);
        PG8_WAIT_V(6); PG8_BAR;
    } else {
        PG8_STAGE(PG8_SB(0, 0), cB, voffB); PG8_STAGE(PG8_SA(0, 0), cA, voffA); PG8_STAGE(PG8_SB(0, 1), cB + hstep, voffB); PG8_STAGE(PG8_SA(0, 1), cA + hstep, voffA);
        if (wr == 1) PG8_BAR;
        PG8_WAIT_V(4); PG8_BAR;
        PG8_STAGE(PG8_SB(1, 0), cB + kstep, voffB); PG8_STAGE(PG8_SA(1, 0), cA + kstep, voffA); PG8_STAGE(PG8_SB(1, 1), cB + hstep + kstep, voffB);
        PG8_WAIT_V(6); PG8_BAR;
    }
    for (;;) {
        const bool has_next = S.next(ui + 1, nxt);
        const char* nA = has_next ? (const char*)g.A + (size_t)nxt.pm * tstep : cA; const char* nB = has_next ? (const char*)g.Bt + (size_t)nxt.pn * tstep : cB;
        for (int t = 0; t < nt; t += 2) {
            const bool last = (t == nt - 2);
            const char* a1 = cA + (size_t)(t + 1) * kstep;
            const char* a2 = last ? nA : cA + (size_t)(t + 2) * kstep; const char* b2 = last ? nB : cB + (size_t)(t + 2) * kstep;
            const char* a3 = a2 + kstep; const char* b3 = b2 + kstep;
            if (last && has_next) S.a_ready(nxt);
            if constexpr (SP2) {
            PG8_LDB(B0, 0, 0); PG8_LDB(B1, 0, 1); PG8_SCHED; PG8_LDA(At, 0, 0); PG8_STAGE(PG8_SA(1, 1), a1 + hstep, voffA);
            PG8_WAIT_V(8); PG8_WAIT_L(0); PG8_BAR; PG8_MMA(0, 0, At, B0); PG8_MMA(0, 1, At, B1); PG8_BAR; PG8_SCHED;
            PG8_LDA(At, 0, 1); PG8_STAGE(PG8_SB(0, 0), b2, voffB); PG8_STAGE(PG8_SB(0, 1), b2 + hstep, voffB); PG8_STAGE(PG8_SA(0, 0), a2, voffA);
            PG8_WAIT_V(8); PG8_WAIT_L(0); PG8_BAR; PG8_MMA(1, 0, At, B0); PG8_MMA(1, 1, At, B1); PG8_BAR; PG8_SCHED;
            PG8_LDB(B0, 1, 0); PG8_LDB(B1, 1, 1); PG8_SCHED; PG8_LDA(At, 1, 0); PG8_STAGE(PG8_SA(0, 1), a2 + hstep, voffA);
            PG8_WAIT_V(8); PG8_WAIT_L(0); PG8_BAR; PG8_MMA(0, 0, At, B0); PG8_MMA(0, 1, At, B1); PG8_BAR; PG8_SCHED;
            PG8_LDA(At, 1, 1); PG8_STAGE(PG8_SB(1, 0), b3, voffB); PG8_STAGE(PG8_SB(1, 1), b3 + hstep, voffB); PG8_STAGE(PG8_SA(1, 0), a3, voffA);
            PG8_WAIT_V(8); PG8_WAIT_L(0); PG8_BAR; PG8_MMA(1, 0, At, B0); PG8_MMA(1, 1, At, B1); PG8_BAR; PG8_SCHED;
            } else {
            PG8_LDB(B0, 0, 0); PG8_SCHED; PG8_LDA(At, 0, 0); PG8_STAGE(PG8_SA(1, 1), a1 + hstep, voffA);
            PG8_WAIT_L(8); PG8_BAR; PG8_WAIT_L(0); PG8_MMA(0, 0, At, B0); PG8_BAR; PG8_SCHED;
            PG8_LDB(B1, 0, 1); PG8_STAGE(PG8_SB(0, 0), b2, voffB);
            PG8_BAR; PG8_WAIT_L(0); PG8_MMA(0, 1, At, B1); PG8_BAR;
            PG8_LDA(At, 0, 1); PG8_STAGE(PG8_SA(0, 0), a2, voffA);
            PG8_BAR; PG8_WAIT_L(0); PG8_MMA(1, 0, At, B0); PG8_BAR; PG8_SCHED;
            PG8_STAGE(PG8_SB(0, 1), b2 + hstep, voffB);
            PG8_WAIT_V(6); PG8_BAR; PG8_MMA(1, 1, At, B1); PG8_BAR;
            PG8_LDB(B0, 1, 0); PG8_SCHED; PG8_LDA(At, 1, 0); PG8_STAGE(PG8_SA(0, 1), a2 + hstep, voffA);
            PG8_WAIT_L(8); PG8_BAR; PG8_WAIT_L(0); PG8_MMA(0, 0, At, B0); PG8_BAR; PG8_SCHED;
            PG8_LDB(B1, 1, 1); PG8_STAGE(PG8_SB(1, 0), b3, voffB);
            PG8_BAR; PG8_WAIT_L(0); PG8_MMA(0, 1, At, B1); PG8_BAR;
            PG8_LDA(At, 1, 1); PG8_STAGE(PG8_SA(1, 0), a3, voffA);
            PG8_BAR; PG8_WAIT_L(0); PG8_MMA(1, 0, At, B0); PG8_BAR; PG8_SCHED;
            PG8_STAGE(PG8_SB(1, 1), b3 + hstep, voffB);
            PG8_WAIT_V(6); PG8_BAR; PG8_MMA(1, 1, At, B1); PG8_BAR;
            }
        }
        if constexpr (ALIGN_EPI) { if (wr == 0) PG8_BAR; }
        if constexpr (!Epi::AFTER_DRAIN) { E(acc, cur, wr, wc, fr, fq); S.done(cur); }
        if (!has_next) break;
#pragma unroll
        for (int a = 0; a < 2; ++a)
#pragma unroll
            for (int b = 0; b < 2; ++b)
#pragma unroll
                for (int m = 0; m < 4; ++m)
#pragma unroll
                    for (int n = 0; n < 2; ++n) acc[a][b][m][n] = (f32x4){0.f, 0.f, 0.f, 0.f};
        cur = nxt; cA = nA; cB = nB; ++ui;
        if constexpr (ALIGN_EPI) { if (wr == 1) PG8_BAR; }
    }
    PG8_WAIT_V(0);
    if constexpr (!ALIGN_EPI) { if (wr == 0) PG8_BAR; }
    PG8_BAR;
    if constexpr (Epi::AFTER_DRAIN) { E.fused(acc, cur, wr, wc, fr, fq, lds, wid, lane); S.done(cur); }
#undef PG8_SA
#undef PG8_SB
#undef PG8_STAGE
#undef PG8_LDA
#undef PG8_LDB
#undef PG8_MMA
#undef PG8_WAIT_V
#undef PG8_WAIT_L
#undef PG8_BAR
#undef PG8_SCHED
}
}

#define LAS __attribute__((address_space(3)))
typedef unsigned short bf16_t;
typedef short bf16x8 __attribute__((ext_vector_type(8)));
typedef float f32x4 __attribute__((ext_vector_type(4)));
typedef float f32x16 __attribute__((ext_vector_type(16)));
typedef unsigned u32x2 __attribute__((ext_vector_type(2)));
typedef unsigned u32x4 __attribute__((ext_vector_type(4)));
typedef float f32x2_t __attribute__((ext_vector_type(2)));
typedef __bf16 bf16x2_t __attribute__((ext_vector_type(2)));

constexpr int DM = 1024, NBATCH = 2, SEQ = 8192, DEPTH = 4, CTXL = 256;
constexpr int MLAT = NBATCH * SEQ, MCTX = NBATCH * CTXL, MTOT = MLAT + MCTX;
constexpr int NIN = 3584, NTM = 2048, NCM = 1536;
constexpr int C_QA = 0, C_KA = 384, C_GA = 768, C_QC = 1152, C_KC = 1536, C_GC = 1664;
constexpr int R_VA = 0, R_VC = 384, R_HZ = 512, R_GB = 1280;
constexpr int NFFT = 16384;
constexpr float LOG2E = 1.4426950408889634f;
constexpr float QK_SCALE = 0.125f * LOG2E;

constexpr size_t MiB = 1u << 20;
constexpr size_t WS_ADA = 1 * MiB;
constexpr size_t WS_ROPE = 1 * MiB + 256 * 1024;
constexpr size_t WS_H2C = 1 * MiB + 512 * 1024;
constexpr size_t WS_CX = 2 * MiB;
constexpr size_t WS_H2 = 4 * MiB;
constexpr size_t WS_WIN = 12 * MiB;
constexpr size_t WS_WOUT = 40 * MiB;
constexpr size_t WS_HY = 48 * MiB;
constexpr size_t WS_PT = 81 * MiB;
constexpr size_t WS_PCT = 147 * MiB;
constexpr size_t WS_YBT = 197 * MiB;
constexpr size_t WS_ZS = 206 * MiB;
constexpr size_t WS_W3T = 238 * MiB;
constexpr size_t WS_FILT = 239 * MiB;
constexpr size_t WS_END = 255 * MiB;

constexpr int LDS_BYTES = 147456;
constexpr int NTHREADS = 512;

struct KArgs {
    const float* x; const float* c; const float* ctx; const float* c_ctx; const float* norm_g; const float* w_ada; const float* b_ada;
    const float* w_in; const float* w_out; const float* na_rpb; const float* hy_conv_w; const float* hy_conv_b;
    const float* hy_w1; const float* hy_b1; const float* hy_freq1; const float* hy_w2; const float* hy_b2; const float* hy_freq2; const float* hy_w3;
    const float* hy_d; const float* sink; const float* final_g;
    float* out; unsigned char* ws;
    int ph_lo, ph_hi;
};

typedef const __attribute__((address_space(4))) KArgs CKArgs;
__device__ __forceinline__ unsigned pk2(float lo, float hi) { f32x2_t v = {lo, hi}; bf16x2_t b = __builtin_convertvector(v, bf16x2_t); return __builtin_bit_cast(unsigned, b); }
__device__ __forceinline__ float bf2f(unsigned short u) { return __uint_as_float(((unsigned)u) << 16); }
__device__ __forceinline__ float bflo(unsigned w) { return __uint_as_float(w << 16); }
__device__ __forceinline__ float bfhi(unsigned w) { return __uint_as_float(w & 0xffff0000u); }
__device__ __forceinline__ float silu_f(float x) { return x / (1.0f + __expf(-x)); }
__device__ __forceinline__ float wave_sum(float v) {
#pragma unroll
    for (int o = 1; o < 64; o <<= 1) v += __shfl_xor(v, o);
    return v;
}
__device__ __forceinline__ float rdlane(float v, int l) { return __uint_as_float(__builtin_amdgcn_readlane(__float_as_uint(v), l)); }

__device__ __forceinline__ void transpose_item(const float* W, int K, int N, bf16_t* WT, int k0, int n0, int drow0, LAS float* scr, int lane, int ldk = 0) {
    if (ldk == 0) ldk = K;
#pragma unroll 8
    for (int i = 0; i < 32; ++i) { const int kk = 2 * i + (lane >> 5); scr[kk * 33 + (lane & 31)] = W[(size_t)(k0 + kk) * N + n0 + (lane & 31)]; }
    asm volatile("s_waitcnt lgkmcnt(0)" ::: "memory");
    const int c = lane & 7;
#pragma unroll
    for (int j = 0; j < 4; ++j) { const int n = (lane >> 3) + 8 * j; const LAS float* s = scr + (8 * c) * 33 + n;
        u32x4 o; o.x = pk2(s[0 * 33], s[1 * 33]); o.y = pk2(s[2 * 33], s[3 * 33]); o.z = pk2(s[4 * 33], s[5 * 33]); o.w = pk2(s[6 * 33], s[7 * 33]);
        *(u32x4*)(WT + (size_t)(drow0 + n) * ldk + k0 + 8 * c) = o; }
    asm volatile("s_waitcnt lgkmcnt(0)" ::: "memory");
}
__device__ __forceinline__ int win_row(int n0) {
    if (n0 < 768) return n0;
    if (n0 < 1152) return n0 - 768 + 2048;
    if (n0 < 1536) return n0 - 1152 + 768;
    if (n0 < 2304) return n0 - 1536 + 2560;
    if (n0 < 2560) return n0 - 2304 + 3328;
    if (n0 < 2944) return n0 - 2560 + 1152;
    if (n0 < 3072) return n0 - 2944 + 1536;
    if (n0 < 3200) return n0 - 3072 + 2432;
    return n0 - 3200 + 1664;
}

__device__ __forceinline__ void phase_prologue(CKArgs& A, LAS unsigned char* lds, int bid, int nblk, int tid) {
    const int wave = __builtin_amdgcn_readfirstlane(tid >> 6), lane = tid & 63;
    const int gw = bid * 8 + wave, NGW = nblk * 8;
    unsigned char* ws = A.ws;
    {
        LAS float* scr = (LAS float*)(lds + wave * 16384);
        constexpr int I_IN = 16 * 112, I_OUT = 16 * 32, I_L = I_IN + I_OUT;
        for (int it = gw; it < DEPTH * I_L; it += NGW) {
            const int l = it / I_L; int r = it % I_L;
            if (r < I_IN) { const int kb = r / 112, nb = r % 112, n0 = nb * 32;
                transpose_item(A.w_in + (size_t)l * DM * NIN, DM, NIN, (bf16_t*)(ws + WS_WIN) + (size_t)l * NIN * DM, kb * 64, n0, win_row(n0), scr, lane); }
            else { r -= I_IN; const int kb = r / 32, nb = r % 32, n0 = nb * 32;
                transpose_item(A.w_out + (size_t)l * DM * DM, DM, DM, (bf16_t*)(ws + WS_WOUT) + (size_t)l * DM * DM, kb * 64, n0, n0, scr, lane); }
        }
    }
    {
        LAS float* scr = (LAS float*)(lds + wave * 16384);
        bf16_t* W3T = (bf16_t*)(ws + WS_W3T);
        for (int it = gw; it < DEPTH * 32; it += NGW) { const int l = it >> 5, nb = it & 31;
            transpose_item(A.hy_w3 + (size_t)l * 64 * 1024, 64, 1024, W3T + (size_t)l * 1024 * 64, 0, nb * 32, nb * 32, scr, lane); }
    }
    for (int idx = gw * 64 + lane; idx < 128 * 16; idx += NGW * 64) {
        const int p = idx >> 4, i = idx & 15;
        const float inv = powf(10000.0f, -(float)i / 16.0f);
        const float ang = (float)p * inv;
        ((float2*)(ws + WS_ROPE))[idx] = make_float2(cosf(ang), sinf(ang));
    }
    for (int it = gw; it < DEPTH * 132; it += NGW) {
        const int l = it / 132, g = it % 132;
        const int L = g < 128 ? SEQ : CTXL;
        const int n0 = g < 128 ? g * 64 : (g - 128) * 64;
        float* outp = (float*)(ws + WS_H2C) + ((size_t)l * CTXL + n0) * 64;
        bf16_t* outb = (bf16_t*)(ws + WS_H2) + ((size_t)l * SEQ + n0) * 64;
        float w1c[33], w2c[64];
#pragma unroll
        for (int q = 0; q < 33; ++q) w1c[q] = A.hy_w1[((size_t)l * 33 + q) * 64 + lane];
#pragma unroll
        for (int j = 0; j < 64; ++j) w2c[j] = A.hy_w2[((size_t)l * 64 + j) * 64 + lane];
        const float b1 = A.hy_b1[l * 64 + lane], fr1 = A.hy_freq1[l * 64 + lane], b2 = A.hy_b2[l * 64 + lane], fr2 = A.hy_freq2[l * 64 + lane];
        const float tstep = 1.0f / (float)(L - 1), wstep = 6.283185307179586f / (float)L;
        const int fj = lane == 0 ? 0 : ((lane - 1) & 15);
        const float fq = 1e-4f + (float)fj * ((15.0f - 1e-4f) / 15.0f);
#pragma unroll 1
        for (int nn = 0; nn < 64; ++nn) {
            const int n = n0 + nn;
            const float t = (float)n * tstep, wa = (float)n * wstep;
            float zq;
            if (lane == 0) zq = t; else if (lane <= 16) zq = cosf(fq * wa); else if (lane <= 32) zq = -sinf(fq * wa); else zq = 0.f;
            float a1 = b1;
#pragma unroll
            for (int q = 0; q < 33; ++q) a1 += rdlane(zq, q) * w1c[q];
            const float h1 = sinf(fr1 * a1);
            float a2 = b2;
#pragma unroll
            for (int j = 0; j < 64; ++j) a2 += rdlane(h1, j) * w2c[j];
            const float h2 = sinf(fr2 * a2);
            if (g < 128) outb[nn * 64 + lane] = (bf16_t)(pk2(h2, 0.f) & 0xffffu);
            else outp[nn * 64 + lane] = h2;
        }
    }
    __syncthreads();
    {
        LAS float* red = (LAS float*)lds;
        for (int it = bid; it < DEPTH * 48; it += nblk) {
            const int l = it / 48, n = (it % 48) * 64 + lane;
            const float* W = A.w_ada + (size_t)l * DM * 3072;
            float a0 = 0.f, a1 = 0.f, a2 = 0.f;
            const int kb = wave * 128;
#pragma unroll 4
            for (int k = 0; k < 128; ++k) {
                const float w = W[(size_t)(kb + k) * 3072 + n];
                a0 += silu_f(A.c[kb + k]) * w; a1 += silu_f(A.c[DM + kb + k]) * w; a2 += silu_f(A.c_ctx[kb + k]) * w;
            }
            red[(wave * 3 + 0) * 64 + lane] = a0; red[(wave * 3 + 1) * 64 + lane] = a1; red[(wave * 3 + 2) * 64 + lane] = a2;
            __syncthreads();
            if (tid < 192) { const int v = tid >> 6; float s = A.b_ada[l * 3072 + n];
#pragma unroll
                for (int w = 0; w < 8; ++w) s += red[(w * 3 + v) * 64 + lane];
                ((float*)(ws + WS_ADA))[((size_t)l * 3 + v) * 3072 + n] = s; }
            __syncthreads();
        }
    }
}

__device__ __forceinline__ void phase_norm(CKArgs& A, int l, int bid, int nblk, int tid) {
    const int wave = __builtin_amdgcn_readfirstlane(tid >> 6), lane = tid & 63;
    const int gw = bid * 8 + wave, NGW = nblk * 8;
    unsigned char* ws = A.ws;
    bf16_t* H = (bf16_t*)(ws + WS_HY);
    const float* ada = (const float*)(ws + WS_ADA) + (size_t)l * 3 * 3072;
    const float* g = A.norm_g + l * DM;
    for (int m = gw; m < MTOT; m += NGW) {
        const float* src; int v;
        if (m < MLAT) { src = (l == 0 ? A.x : A.out) + (size_t)m * DM; v = m >> 13; }
        else { src = (l == 0 ? A.ctx : (const float*)(ws + WS_CX)) + (size_t)(m - MLAT) * DM; v = 2; }
        const float* shp = ada + v * 3072; const float* scp = shp + DM;
        f32x4 xv[4]; float ss = 0.f;
#pragma unroll
        for (int j = 0; j < 4; ++j) { xv[j] = *(const f32x4*)(src + 4 * lane + 256 * j); ss += (xv[j].x * xv[j].x + xv[j].y * xv[j].y) + (xv[j].z * xv[j].z + xv[j].w * xv[j].w); }
        const float rinv = rsqrtf(wave_sum(ss) * (1.0f / DM) + 1e-6f);
#pragma unroll
        for (int j = 0; j < 4; ++j) { const int col = 4 * lane + 256 * j;
            const f32x4 gv = *(const f32x4*)(g + col), sc = *(const f32x4*)(scp + col), sh = *(const f32x4*)(shp + col);
            const f32x4 h = xv[j] * rinv * gv * (sc + 1.0f) + sh;
            u32x2 o; o.x = pk2(h.x, h.y); o.y = pk2(h.z, h.w);
            *(u32x2*)(H + (size_t)m * DM + col) = o; }
    }
    {
        const bf16_t* H2B = (const bf16_t*)(ws + WS_H2) + (size_t)l * SEQ * 64;
        const bf16_t* W3T = (const bf16_t*)(ws + WS_W3T) + (size_t)l * 1024 * 64;
        bf16_t* FILT = (bf16_t*)(ws + WS_FILT);
        const int fr = lane & 15, fq = lane >> 4;
#pragma unroll 1
        for (int it = gw; it < 2048; it += NGW) {
            const int pt = it >> 2, cq = it & 3;
            const bf16_t* ap = H2B + (size_t)(16 * pt + fr) * 64 + 8 * fq;
            const bf16x8 a0 = *(const bf16x8*)ap, a1 = *(const bf16x8*)(ap + 32);
#pragma unroll 4
            for (int ct = 0; ct < 16; ++ct) {
                const int col0 = 256 * cq + 16 * ct;
                const bf16_t* bp = W3T + (size_t)(col0 + fr) * 64 + 8 * fq;
                const bf16x8 b0 = *(const bf16x8*)bp, b1 = *(const bf16x8*)(bp + 32);
                f32x4 acc = {0.f, 0.f, 0.f, 0.f};
                acc = __builtin_amdgcn_mfma_f32_16x16x32_bf16(a0, b0, acc, 0, 0, 0);
                acc = __builtin_amdgcn_mfma_f32_16x16x32_bf16(a1, b1, acc, 0, 0, 0);
                u32x2 o; o.x = pk2(acc.x, acc.y); o.y = pk2(acc.z, acc.w);
                *(u32x2*)(FILT + (size_t)(col0 + fr) * SEQ + 16 * pt + 4 * fq) = o;
            }
        }
    }
}

struct EpiIn {
    static constexpr bool PERM = true, AFTER_DRAIN = false;
    bf16_t* PT; bf16_t* PCT; const float2* rope;
    __device__ __forceinline__ void operator()(const f32x4 (&acc)[2][2][4][2], const pg8::Unit& u, int wr, int wc, int fr, int fq) const {
        const int row0 = u.pm * 256 + wr * 64 + fr;
        if (u.pn < 8) {
#pragma unroll
            for (int bj = 0; bj < 2; ++bj) {
                const int blk = 2 * u.pn + bj;
                const bool rp = (blk >= 9) && (blk <= 12) && (u.pm < 64);
                const int col0 = 256 * u.pn + 128 * bj + 32 * wc + 8 * fq;
#pragma unroll
                for (int ai = 0; ai < 2; ++ai)
#pragma unroll
                    for (int m = 0; m < 4; ++m) {
                        const int r = row0 + 128 * ai + 16 * m;
                        f32x4 v0 = acc[ai][bj][m][0], v1 = acc[ai][bj][m][1];
                        if (rp) {
                            const int pos = r & (SEQ - 1);
                            const int p = (wc & 1) ? (pos & 63) : (pos >> 6);
                            const f32x4* tb = (const f32x4*)(rope + p * 16 + 8 * (fq & 1));
                            const f32x4 t0 = tb[0], t1 = tb[1], t2 = tb[2], t3 = tb[3];
                            f32x4 q0, q1;
                            q0.x = __shfl_xor(v0.x, 32); q0.y = __shfl_xor(v0.y, 32); q0.z = __shfl_xor(v0.z, 32); q0.w = __shfl_xor(v0.w, 32);
                            q1.x = __shfl_xor(v1.x, 32); q1.y = __shfl_xor(v1.y, 32); q1.z = __shfl_xor(v1.z, 32); q1.w = __shfl_xor(v1.w, 32);
                            const float sg = (fq < 2) ? -1.0f : 1.0f;
                            v0.x = v0.x * t0.x + sg * q0.x * t0.y; v0.y = v0.y * t0.z + sg * q0.y * t0.w;
                            v0.z = v0.z * t1.x + sg * q0.z * t1.y; v0.w = v0.w * t1.z + sg * q0.w * t1.w;
                            v1.x = v1.x * t2.x + sg * q1.x * t2.y; v1.y = v1.y * t2.z + sg * q1.y * t2.w;
                            v1.z = v1.z * t3.x + sg * q1.z * t3.y; v1.w = v1.w * t3.z + sg * q1.w * t3.w;
                        }
                        u32x4 w; w.x = pk2(v0.x, v0.y); w.y = pk2(v0.z, v0.w); w.z = pk2(v1.x, v1.y); w.w = pk2(v1.z, v1.w);
                        *(u32x4*)(PT + (size_t)r * NTM + col0) = w;
                        asm volatile("" ::: "memory");
                    }
            }
        } else {
#pragma unroll
            for (int bj = 0; bj < 2; ++bj) {
                const int ch0 = 256 * (u.pn - 8) + 128 * bj + 32 * wc + 8 * fq;
#pragma unroll
                for (int ai = 0; ai < 2; ++ai)
#pragma unroll
                    for (int m = 0; m < 4; ++m) {
                        const int r = row0 + 128 * ai + 16 * m;
#pragma unroll
                        for (int n = 0; n < 2; ++n) {
                            const f32x4 v = acc[ai][bj][m][n];
                            bf16_t* p = PCT + (size_t)(ch0 + 4 * n) * MTOT + r;
                            const unsigned w0 = pk2(v.x, v.y), w1 = pk2(v.z, v.w);
                            p[0] = (bf16_t)(w0 & 0xffffu); p[MTOT] = (bf16_t)(w0 >> 16); p[2 * (size_t)MTOT] = (bf16_t)(w1 & 0xffffu); p[3 * (size_t)MTOT] = (bf16_t)(w1 >> 16);
                        }
                    }
            }
        }
    }
};
struct EpiFilt {
    static constexpr bool PERM = true, AFTER_DRAIN = false;
    bf16_t* O; int ldc;
    __device__ __forceinline__ void operator()(const f32x4 (&acc)[2][2][4][2], const pg8::Unit& u, int wr, int wc, int fr, int fq) const {
        const int row0 = u.pm * 256 + wr * 64 + fr;
#pragma unroll
        for (int bj = 0; bj < 2; ++bj) { const int col0 = 256 * u.pn + 128 * bj + 32 * wc + 8 * fq;
#pragma unroll
            for (int ai = 0; ai < 2; ++ai)
#pragma unroll
                for (int m = 0; m < 4; ++m) { const int r = row0 + 128 * ai + 16 * m; const f32x4 v0 = acc[ai][bj][m][0], v1 = acc[ai][bj][m][1];
                    u32x4 w; w.x = pk2(v0.x, v0.y); w.y = pk2(v0.z, v0.w); w.z = pk2(v1.x, v1.y); w.w = pk2(v1.z, v1.w);
                    *(u32x4*)(O + (size_t)r * ldc + col0) = w; } }
    }
};
struct EpiOut {
    static constexpr bool PERM = true, AFTER_DRAIN = false;
    const float* xsrc; float* xdst; const float* csrc; float* cdst; const float* ada;
    __device__ __forceinline__ void operator()(const f32x4 (&acc)[2][2][4][2], const pg8::Unit& u, int wr, int wc, int fr, int fq) const {
        const int row0 = u.pm * 256 + wr * 64 + fr;
        const bool lat = u.pm < 64;
#pragma unroll
        for (int bj = 0; bj < 2; ++bj) {
            const int col0 = 256 * u.pn + 128 * bj + 32 * wc + 8 * fq;
#pragma unroll
            for (int ai = 0; ai < 2; ++ai)
#pragma unroll
                for (int m = 0; m < 4; ++m) {
                    const int r = row0 + 128 * ai + 16 * m;
                    const int v = lat ? (r >> 13) : 2;
                    const float* gp = ada + v * 3072 + 2048 + col0;
                    const f32x4 g0 = *(const f32x4*)gp, g1 = *(const f32x4*)(gp + 4);
                    const size_t off = lat ? (size_t)r * DM + col0 : (size_t)(r - MLAT) * DM + col0;
                    const float* sp = (lat ? xsrc : csrc) + off; float* dp = (lat ? xdst : cdst) + off;
                    const f32x4 x0 = *(const f32x4*)sp, x1 = *(const f32x4*)(sp + 4);
                    *(f32x4*)dp = x0 + g0 * acc[ai][bj][m][0];
                    *(f32x4*)(dp + 4) = x1 + g1 * acc[ai][bj][m][1];
                    if (m & 1) asm volatile("" ::: "memory");
                }
        }
    }
};

struct EpiAll {
    static constexpr bool PERM = true, AFTER_DRAIN = false;
    int mode, l; CKArgs* Ap;
    __device__ __forceinline__ void operator()(const f32x4 (&acc)[2][2][4][2], const pg8::Unit& u, int wr, int wc, int fr, int fq) const {
        unsigned char* ws = Ap->ws;
        if (mode == 0) { const EpiIn E{(bf16_t*)(ws + WS_PT), (bf16_t*)(ws + WS_PCT), (const float2*)(ws + WS_ROPE)}; E(acc, u, wr, wc, fr, fq); }
        else { const EpiOut E{l == 0 ? Ap->x : Ap->out, Ap->out, l == 0 ? Ap->ctx : (const float*)(ws + WS_CX), (float*)(ws + WS_CX), (const float*)(ws + WS_ADA) + (size_t)l * 3 * 3072}; E(acc, u, wr, wc, fr, fq); }
    }
};
template <int MK>
__device__ __forceinline__ void attn_tile(const bf16_t* kbase, const bf16_t* vbase, const bf16x8 (&bq)[4], f32x16& o0, f32x16& o1, float& m_run, float& l_run,
                                          int r31, int hh, bool rowok, int cmin, const float* biasp) {
    const bf16_t* kp = kbase + (size_t)r31 * NTM + 8 * hh;
    const bf16x8 ka0 = *(const bf16x8*)(kp), ka1 = *(const bf16x8*)(kp + 16), ka2 = *(const bf16x8*)(kp + 32), ka3 = *(const bf16x8*)(kp + 48);
    const bf16_t* vp = vbase + (size_t)r31 * MTOT + 4 * hh;
    const bf16_t* vq = vp + (size_t)32 * MTOT;
    const u32x2 a0l = *(const u32x2*)(vp), a0h = *(const u32x2*)(vp + 8), a1l = *(const u32x2*)(vp + 16), a1h = *(const u32x2*)(vp + 24);
    const u32x2 b0l = *(const u32x2*)(vq), b0h = *(const u32x2*)(vq + 8), b1l = *(const u32x2*)(vq + 16), b1h = *(const u32x2*)(vq + 24);
    f32x16 s;
#pragma unroll
    for (int i = 0; i < 16; ++i) s[i] = 0.f;
    s = __builtin_amdgcn_mfma_f32_32x32x16_bf16(ka0, bq[0], s, 0, 0, 0);
    s = __builtin_amdgcn_mfma_f32_32x32x16_bf16(ka1, bq[1], s, 0, 0, 0);
    s = __builtin_amdgcn_mfma_f32_32x32x16_bf16(ka2, bq[2], s, 0, 0, 0);
    s = __builtin_amdgcn_mfma_f32_32x32x16_bf16(ka3, bq[3], s, 0, 0, 0);
    float tmax = -INFINITY;
#pragma unroll
    for (int i = 0; i < 16; ++i) {
        const int c = (i & 3) + 8 * (i >> 2) + 4 * hh;
        float v = s[i] * QK_SCALE;
        if (MK == 1) { if (c < r31) v = -INFINITY; }
        if (MK == 2) { if (c > r31) v = -INFINITY; }
        if (MK == 3) { const bool ok = rowok && ((unsigned)(c - cmin) < 16u); float bb = 0.f; if (ok) bb = biasp[c]; v = ok ? v + bb * LOG2E : -INFINITY; }
        s[i] = v; tmax = fmaxf(tmax, v);
    }
    tmax = fmaxf(tmax, __shfl_xor(tmax, 32));
    const float m_new = fmaxf(m_run, tmax);
    const float alpha = __builtin_amdgcn_exp2f(m_run - m_new);
    m_run = m_new;
    float psum = 0.f;
#pragma unroll
    for (int i = 0; i < 16; ++i) { const float p = __builtin_amdgcn_exp2f(s[i] - m_new); s[i] = p; psum += p; }
    l_run = l_run * alpha + psum;
#pragma unroll
    for (int i = 0; i < 16; ++i) { o0[i] *= alpha; o1[i] *= alpha; }
    u32x4 pw0, pw1;
    pw0.x = pk2(s[0], s[1]); pw0.y = pk2(s[2], s[3]); pw0.z = pk2(s[4], s[5]); pw0.w = pk2(s[6], s[7]);
    pw1.x = pk2(s[8], s[9]); pw1.y = pk2(s[10], s[11]); pw1.z = pk2(s[12], s[13]); pw1.w = pk2(s[14], s[15]);
    const bf16x8 pb0 = __builtin_bit_cast(bf16x8, pw0), pb1 = __builtin_bit_cast(bf16x8, pw1);
    u32x4 t;
    t.x = a0l.x; t.y = a0l.y; t.z = a0h.x; t.w = a0h.y; const bf16x8 va00 = __builtin_bit_cast(bf16x8, t);
    t.x = a1l.x; t.y = a1l.y; t.z = a1h.x; t.w = a1h.y; const bf16x8 va01 = __builtin_bit_cast(bf16x8, t);
    t.x = b0l.x; t.y = b0l.y; t.z = b0h.x; t.w = b0h.y; const bf16x8 va10 = __builtin_bit_cast(bf16x8, t);
    t.x = b1l.x; t.y = b1l.y; t.z = b1h.x; t.w = b1h.y; const bf16x8 va11 = __builtin_bit_cast(bf16x8, t);
    o0 = __builtin_amdgcn_mfma_f32_32x32x16_bf16(va00, pb0, o0, 0, 0, 0);
    o0 = __builtin_amdgcn_mfma_f32_32x32x16_bf16(va01, pb1, o0, 0, 0, 0);
    o1 = __builtin_amdgcn_mfma_f32_32x32x16_bf16(va10, pb0, o1, 0, 0, 0);
    o1 = __builtin_amdgcn_mfma_f32_32x32x16_bf16(va11, pb1, o1, 0, 0, 0);
}

template <int MODE>
__device__ __forceinline__ void attn_item(CKArgs& A, int l, int item, int lane) {
    unsigned char* ws = A.ws;
    const bf16_t* PT = (const bf16_t*)(ws + WS_PT);
    const bf16_t* PCT = (const bf16_t*)(ws + WS_PCT);
    bf16_t* Y = (bf16_t*)(ws + WS_HY);
    const int r31 = lane & 31, hh = lane >> 5;
    int b, h, qtok;
    int rp = 0, mg = 0, qg = 0;
    if (MODE == 0) { b = item / 1536; const int rem = item % 1536; h = rem / 256; const int r2 = rem % 256; rp = r2 >> 2; mg = r2 & 3;
        qtok = b * SEQ + (2 * rp + (r31 >> 4)) * 64 + 16 * mg + (r31 & 15); }
    else if (MODE == 1) { b = item / 1536; const int rem = item % 1536; h = rem / 256; qg = rem % 256; qtok = b * SEQ + 32 * qg + r31; }
    else { b = item / 48; const int rem = item % 48; h = rem / 8; qg = rem % 8; qtok = MLAT + b * CTXL + 32 * qg + r31; }
    const bool grpA = (MODE == 0 || MODE == 2);
    const int kvh = grpA ? h : h / 3;
    const int qcol = (grpA ? C_QA : C_QC) + h * 64, kcol = (grpA ? C_KA : C_KC) + kvh * 64, gcol = (grpA ? C_GA : C_GC) + h * 64;
    const int vrow = (grpA ? R_VA : R_VC) + kvh * 64, ycol = (grpA ? 0 : 640) + h * 64;
    bf16x8 bq[4];
    { const bf16_t* qp = PT + (size_t)qtok * NTM + qcol + 8 * hh;
#pragma unroll
      for (int s = 0; s < 4; ++s) bq[s] = *(const bf16x8*)(qp + 16 * s); }
    f32x16 o0, o1;
#pragma unroll
    for (int i = 0; i < 16; ++i) { o0[i] = 0.f; o1[i] = 0.f; }
    float m_run = -1e30f, l_run = 0.f;
    if (!grpA) { m_run = A.sink[l * 6 + h] * LOG2E; l_run = hh == 0 ? 1.0f : 0.f; }
    const bf16_t* kb0 = PT + kcol; const bf16_t* vb0 = PCT + (size_t)vrow * MTOT;
#pragma unroll 1
    for (int jt = 0; jt < 8; ++jt) { const int kt = MLAT + b * CTXL + 32 * jt;
        attn_tile<0>(kb0 + (size_t)kt * NTM, vb0 + kt, bq, o0, o1, m_run, l_run, r31, hh, true, 0, nullptr); }
    if (MODE == 1) {
        const int q0 = 32 * qg;
#pragma unroll 1
        for (int i = 0; i < 9; ++i) { const int kpos = q0 - 128 + 32 * i; if (kpos < 0 || kpos >= SEQ) continue; const int kt = b * SEQ + kpos;
            if (i == 0) attn_tile<1>(kb0 + (size_t)kt * NTM, vb0 + kt, bq, o0, o1, m_run, l_run, r31, hh, true, 0, nullptr);
            else if (i == 8) attn_tile<2>(kb0 + (size_t)kt * NTM, vb0 + kt, bq, o0, o1, m_run, l_run, r31, hh, true, 0, nullptr);
            else attn_tile<0>(kb0 + (size_t)kt * NTM, vb0 + kt, bq, o0, o1, m_run, l_run, r31, hh, true, 0, nullptr); }
    }
    if (MODE == 0) {
        const int ra = min(max(2 * rp - 4, 0), 120), rb = min(max(2 * rp - 3, 0), 120) + 7;
        const int cs = min(max(16 * mg - 8, 0), 32);
        const int rq = 2 * rp + (r31 >> 4), jq = 16 * mg + (r31 & 15);
        const int r0 = min(max(rq - 4, 0), 120), c0 = min(max(jq - 8, 0), 48);
        const int cmin = c0 - cs;
        const float* rpb = A.na_rpb + (size_t)(l * 6 + h) * 15 * 31;
#pragma unroll 1
        for (int a = ra; a <= rb; ++a) { const int kt = b * SEQ + a * 64 + cs;
            const bool rowok = (a >= r0) && (a < r0 + 8);
            const float* bp = rpb + (a - rq + 7) * 31 + (cs - jq + 15);
            attn_tile<3>(kb0 + (size_t)kt * NTM, vb0 + kt, bq, o0, o1, m_run, l_run, r31, hh, rowok, cmin, bp); }
    }
    const float ltot = l_run + __shfl_xor(l_run, 32);
    const float inv = 1.0f / ltot;
    const bf16_t* gp = PT + (size_t)qtok * NTM + gcol + 4 * hh;
    bf16_t* yp = Y + (size_t)qtok * DM + ycol + 4 * hh;
#pragma unroll
    for (int db = 0; db < 2; ++db)
#pragma unroll
        for (int g4 = 0; g4 < 4; ++g4) {
            const int d0 = 32 * db + 8 * g4;
            const u32x2 gw = *(const u32x2*)(gp + d0);
            float v0, v1, v2, v3;
            if (db == 0) { v0 = o0[4 * g4]; v1 = o0[4 * g4 + 1]; v2 = o0[4 * g4 + 2]; v3 = o0[4 * g4 + 3]; }
            else { v0 = o1[4 * g4]; v1 = o1[4 * g4 + 1]; v2 = o1[4 * g4 + 2]; v3 = o1[4 * g4 + 3]; }
            v0 *= inv * silu_f(bflo(gw.x)); v1 *= inv * silu_f(bfhi(gw.x)); v2 *= inv * silu_f(bflo(gw.y)); v3 *= inv * silu_f(bfhi(gw.y));
            u32x2 o; o.x = pk2(v0, v1); o.y = pk2(v2, v3);
            *(u32x2*)(yp + d0) = o;
        }
}

typedef float cf2 __attribute__((ext_vector_type(2)));
__device__ __forceinline__ cf2 mk2(float x, float y) { cf2 r; r.x = x; r.y = y; return r; }
__device__ __forceinline__ cf2 cmul(cf2 a, cf2 b) { return mk2(a.x * b.x - a.y * b.y, a.x * b.y + a.y * b.x); }
__device__ __forceinline__ void fft_fwd(LAS cf2* buf, int tid) {
#pragma unroll 1
    for (int p = 0; p < 7; ++p) {
        const int ls = 12 - 2 * p, s = 1 << ls;
        const float rs = 1.0f / (float)(4 * s);
#pragma unroll 2
        for (int k = 0; k < 8; ++k) {
            const int bf = tid + 512 * k, i = bf & (s - 1), base = ((bf >> ls) << (ls + 2)) + i;
            const cf2 x0 = buf[base], x1 = buf[base + s], x2 = buf[base + 2 * s], x3 = buf[base + 3 * s];
            const float a = (float)i * rs;
            const cf2 w1 = mk2(__builtin_amdgcn_cosf(a), -__builtin_amdgcn_sinf(a));
            const cf2 w2 = cmul(w1, w1), w3 = cmul(w2, w1);
            const cf2 s02 = mk2(x0.x + x2.x, x0.y + x2.y), d02 = mk2(x0.x - x2.x, x0.y - x2.y);
            const cf2 s13 = mk2(x1.x + x3.x, x1.y + x3.y), d13 = mk2(x1.x - x3.x, x1.y - x3.y);
            buf[base] = mk2(s02.x + s13.x, s02.y + s13.y);
            buf[base + s] = cmul(mk2(s02.x - s13.x, s02.y - s13.y), w2);
            buf[base + 2 * s] = cmul(mk2(d02.x + d13.y, d02.y - d13.x), w1);
            buf[base + 3 * s] = cmul(mk2(d02.x - d13.y, d02.y + d13.x), w3);
        }
        __syncthreads();
    }
}
__device__ __forceinline__ void fft_inv(LAS cf2* buf, int tid) {
#pragma unroll 1
    for (int p = 0; p < 7; ++p) {
        const int ls = 2 * p, s = 1 << ls;
        const float rs = 1.0f / (float)(4 * s);
#pragma unroll 2
        for (int k = 0; k < 8; ++k) {
            const int bf = tid + 512 * k, i = bf & (s - 1), base = ((bf >> ls) << (ls + 2)) + i;
            const cf2 v0 = buf[base], v1 = buf[base + s], v2 = buf[base + 2 * s], v3 = buf[base + 3 * s];
            const float a = (float)i * rs;
            const cf2 w1 = mk2(__builtin_amdgcn_cosf(a), __builtin_amdgcn_sinf(a));
            const cf2 w2 = cmul(w1, w1);
            const cf2 bb = cmul(v1, w2), dd = cmul(v3, w2);
            const cf2 u0 = mk2(v0.x + bb.x, v0.y + bb.y), u1 = mk2(v0.x - bb.x, v0.y - bb.y);
            const cf2 u2 = mk2(v2.x + dd.x, v2.y + dd.y), u3 = mk2(v2.x - dd.x, v2.y - dd.y);
            const cf2 e = cmul(u2, w1), f0 = cmul(u3, w1);
            const cf2 f = mk2(-f0.y, f0.x);
            buf[base] = mk2(u0.x + e.x, u0.y + e.y); buf[base + 2 * s] = mk2(u0.x - e.x, u0.y - e.y);
            buf[base + s] = mk2(u1.x + f.x, u1.y + f.y); buf[base + 3 * s] = mk2(u1.x - f.x, u1.y - f.y);
        }
        __syncthreads();
    }
}
__device__ __forceinline__ float hy_short(const bf16_t* prow, int tb, int t, int L, float w0, float w1, float w2, float bias) {
    const float pm = t > 0 ? bf2f(prow[tb + t - 1]) : 0.f;
    const float pc = bf2f(prow[tb + t]);
    const float pp = t < L - 1 ? bf2f(prow[tb + t + 1]) : 0.f;
    return w0 * pm + w1 * pc + w2 * pp + bias;
}
__device__ __forceinline__ float block_sum(float v, LAS float* red, int tid) {
    v = wave_sum(v);
    __syncthreads();
    if ((tid & 63) == 0) red[tid >> 6] = v;
    __syncthreads();
    float s = 0.f;
#pragma unroll
    for (int w = 0; w < 8; ++w) s += red[w];
    return s;
}

__device__ __forceinline__ void hyena_block(CKArgs& A, int l, int c, LAS unsigned char* lds, int tid) {
    unsigned char* ws = A.ws;
    LAS cf2* buf = (LAS cf2*)lds;
    LAS float* fs = (LAS float*)lds;
    LAS float* aux = (LAS float*)(lds + 131072);
    LAS float* red = aux + 256;
    const bf16_t* PCT = (const bf16_t*)(ws + WS_PCT);
    bf16_t* YBT = (bf16_t*)(ws + WS_YBT);
    cf2* ZS = (cf2*)(ws + WS_ZS) + (size_t)c * NFFT;
    const bf16_t* rowz = PCT + (size_t)(R_HZ + c) * MTOT;
    const bf16_t* rowx1 = rowz + (size_t)256 * MTOT;
    const bf16_t* rowx2 = rowz + (size_t)512 * MTOT;
    const bf16_t* rowg = PCT + (size_t)(R_GB + c) * MTOT;
    const float* cw = A.hy_conv_w + (size_t)l * 3 * 768; const float* cb = A.hy_conv_b + (size_t)l * 768;
    const float wz0 = cw[c], wz1 = cw[768 + c], wz2 = cw[1536 + c], bz = cb[c];
    const float wa0 = cw[256 + c], wa1 = cw[768 + 256 + c], wa2 = cw[1536 + 256 + c], ba = cb[256 + c];
    const float wb0 = cw[512 + c], wb1 = cw[768 + 512 + c], wb2 = cw[1536 + 512 + c], bb = cb[512 + c];
    const float d0 = A.hy_d[(l * 2 + 0) * 256 + c], d1 = A.hy_d[(l * 2 + 1) * 256 + c];
    const float dmin = -3.0701134573253945f, dmax = -15.350567286626973f;
    const float delta = fabsf(dmin + (float)c * ((dmax - dmin) / 255.0f));
    __syncthreads();
    if (tid < 256) { const int k = tid >> 6, j = tid & 63; aux[tid] = A.hy_w3[((size_t)l * 64 + j) * 1024 + k * 256 + c]; }
    __syncthreads();

    if (l < DEPTH - 1) {
        float ss0 = 0.f, ss1 = 0.f;
        if (tid < 256) {
            const int n = tid; const f32x4* hr = (const f32x4*)((const float*)(ws + WS_H2C) + ((size_t)l * CTXL + n) * 64);
            float f0 = 0.f, f1 = 0.f, b0 = 0.f, b1 = 0.f;
#pragma unroll 1
            for (int j4 = 0; j4 < 16; ++j4) { const f32x4 hv = hr[j4];
#pragma unroll
                for (int e = 0; e < 4; ++e) { const float hvv = hv[e]; const int j = 4 * j4 + e; f0 += hvv * aux[j]; f1 += hvv * aux[64 + j]; b0 += hvv * aux[128 + j]; b1 += hvv * aux[192 + j]; } }
            const float e = __expf(-((float)n * (1.0f / 255.0f)) * delta);
            f0 *= e; f1 *= e; b0 *= e; b1 *= e;
            fs[n] = f0; fs[256 + n] = f1; fs[512 + n] = b0; fs[768 + n] = b1;
            ss0 = f0 * f0 + (n >= 1 ? b0 * b0 : 0.f); ss1 = f1 * f1 + (n >= 1 ? b1 * b1 : 0.f);
        }
        const int b = tid >> 8, t = tid & 255, tok = MLAT + b * CTXL;
        const float z = hy_short(rowz, tok, t, CTXL, wz0, wz1, wz2, bz);
        const float x1 = hy_short(rowx1, tok, t, CTXL, wa0, wa1, wa2, ba);
        const float x2 = hy_short(rowx2, tok, t, CTXL, wb0, wb1, wb2, bb);
        const float gb = bf2f(rowg[tok + t]);
        fs[1024 + tid] = z;
        const float n0 = rsqrtf(block_sum(ss0, red, tid) + 1e-6f);
        const float n1 = rsqrtf(block_sum(ss1, red, tid) + 1e-6f);
        __syncthreads();
        float y = 0.f;
#pragma unroll 4
        for (int s = 0; s < 256; ++s) { const int d = t - s; const float kv = d >= 0 ? fs[d] : fs[512 - d]; y += fs[1024 + b * 256 + s] * kv; }
        const float z1 = x1 * (y * n0 + d0 * z);
        fs[1536 + tid] = z1;
        __syncthreads();
        float y2 = 0.f;
#pragma unroll 4
        for (int s = 0; s < 256; ++s) { const int d = t - s; const float kv = d >= 0 ? fs[256 + d] : fs[768 - d]; y2 += fs[1536 + b * 256 + s] * kv; }
        const float o = x2 * (y2 * n1 + d1 * z1) * silu_f(gb);
        YBT[(size_t)c * MTOT + tok + t] = (bf16_t)(pk2(o, 0.f) & 0xffffu);
        __syncthreads();
    }

    float nrm0, nrm1;
    {
        float ss0 = 0.f, ss1 = 0.f;
        const bf16_t* F0 = (const bf16_t*)(ws + WS_FILT) + (size_t)c * SEQ;
#pragma unroll 2
        for (int k = 0; k < 16; ++k) {
            const int n = tid + 512 * k;
            float f0 = bf2f(F0[n]), f1 = bf2f(F0[(size_t)256 * SEQ + n]), b0 = bf2f(F0[(size_t)512 * SEQ + n]), b1 = bf2f(F0[(size_t)768 * SEQ + n]);
            const float e = __expf(-((float)n * (1.0f / 8191.0f)) * delta);
            f0 *= e; f1 *= e; b0 *= e; b1 *= e;
            buf[n] = mk2(f0, f1); ss0 += f0 * f0; ss1 += f1 * f1;
            if (n >= 1) { buf[NFFT - n] = mk2(b0, b1); ss0 += b0 * b0; ss1 += b1 * b1; }
        }
        if (tid == 0) buf[SEQ] = mk2(0.f, 0.f);
        nrm0 = rsqrtf(block_sum(ss0, red, tid) + 1e-6f) * (1.0f / NFFT);
        nrm1 = rsqrtf(block_sum(ss1, red, tid) + 1e-6f) * (1.0f / NFFT);
        __syncthreads();
        fft_fwd(buf, tid);
#pragma unroll 4
        for (int k = 0; k < 32; ++k) { const int p = tid + 512 * k; ZS[p] = buf[p]; }
        __syncthreads();
    }
    cf2 z1r[16];
#pragma unroll 1
    for (int k = 0; k < 16; ++k) {
        const int t = tid + 512 * k;
        buf[t] = mk2(hy_short(rowz, 0, t, SEQ, wz0, wz1, wz2, bz), hy_short(rowz, SEQ, t, SEQ, wz0, wz1, wz2, bz));
        buf[SEQ + t] = mk2(0.f, 0.f);
    }
    __syncthreads();
    fft_fwd(buf, tid);
#pragma unroll 2
    for (int k = 0; k < 32; ++k) {
        const int p = tid + 512 * k; const int f = (int)(__brev((unsigned)p) >> 18); const int pp = (int)(__brev((unsigned)((NFFT - f) & (NFFT - 1))) >> 18);
        const cf2 a = ZS[p], bq = ZS[pp];
        const cf2 kk = mk2((a.x + bq.x) * 0.5f * nrm0, (a.y - bq.y) * 0.5f * nrm0);
        buf[p] = cmul(buf[p], kk);
    }
    __syncthreads();
    fft_inv(buf, tid);
#pragma unroll 1
    for (int k = 0; k < 16; ++k) {
        const int t = tid + 512 * k;
        const cf2 y = buf[t];
        const float za = hy_short(rowz, 0, t, SEQ, wz0, wz1, wz2, bz), zb = hy_short(rowz, SEQ, t, SEQ, wz0, wz1, wz2, bz);
        const float xa = hy_short(rowx1, 0, t, SEQ, wa0, wa1, wa2, ba), xb = hy_short(rowx1, SEQ, t, SEQ, wa0, wa1, wa2, ba);
        buf[t] = mk2(xa * (y.x + d0 * za), xb * (y.y + d0 * zb));
        buf[SEQ + t] = mk2(0.f, 0.f);
    }
#pragma unroll
    for (int k = 0; k < 16; ++k) z1r[k] = buf[tid + 512 * k];
    __syncthreads();
    fft_fwd(buf, tid);
#pragma unroll 2
    for (int k = 0; k < 32; ++k) {
        const int p = tid + 512 * k; const int f = (int)(__brev((unsigned)p) >> 18); const int pp = (int)(__brev((unsigned)((NFFT - f) & (NFFT - 1))) >> 18);
        const cf2 a = ZS[p], bq = ZS[pp];
        const cf2 kk = mk2((a.y + bq.y) * 0.5f * nrm1, -(a.x - bq.x) * 0.5f * nrm1);
        buf[p] = cmul(buf[p], kk);
    }
    __syncthreads();
    fft_inv(buf, tid);
#pragma unroll
    for (int k = 0; k < 16; ++k) { const int t = tid + 512 * k; const cf2 y = buf[t]; buf[t] = mk2(y.x + d1 * z1r[k].x, y.y + d1 * z1r[k].y); }
    bf16_t* yrow = YBT + (size_t)c * MTOT;
#pragma unroll 1
    for (int k = 0; k < 16; ++k) {
        const int t = tid + 512 * k;
        const cf2 y = buf[t];
        const float xa = hy_short(rowx2, 0, t, SEQ, wb0, wb1, wb2, bb), xb = hy_short(rowx2, SEQ, t, SEQ, wb0, wb1, wb2, bb);
        const float ga = bf2f(rowg[t]), gb = bf2f(rowg[SEQ + t]);
        const float oa = xa * y.x * silu_f(ga), ob = xb * y.y * silu_f(gb);
        yrow[t] = (bf16_t)(pk2(oa, 0.f) & 0xffffu); yrow[SEQ + t] = (bf16_t)(pk2(ob, 0.f) & 0xffffu);
    }
    __syncthreads();
}

__device__ __forceinline__ void phase_mix(CKArgs& A, int l, LAS unsigned char* lds, int bid, int nblk, int tid) {
    const int wave = __builtin_amdgcn_readfirstlane(tid >> 6), lane = tid & 63;
    const int gw = bid * 8 + wave, NGW = nblk * 8;
#ifndef NOHY
    for (int c = bid; c < 256; c += nblk) hyena_block(A, l, c, lds, tid);
#endif
#ifndef NOAT
#pragma unroll 1
    for (int it = gw; it < 3072; it += NGW) attn_item<0>(A, l, it, lane);
#pragma unroll 1
    for (int it = gw; it < 3072; it += NGW) attn_item<1>(A, l, it, lane);
    if (l < DEPTH - 1) {
#pragma unroll 1
        for (int it = gw; it < 96; it += NGW) attn_item<2>(A, l, it, lane);
#pragma unroll 1
        for (int it = gw; it < 96; it += NGW) attn_item<3>(A, l, it, lane);
    }
#endif
}

__device__ __forceinline__ void phase_tr(CKArgs& A, int l, LAS unsigned char* lds, int bid, int nblk, int tid) {
    const int wave = __builtin_amdgcn_readfirstlane(tid >> 6), lane = tid & 63;
    const int gw = bid * 8 + wave, NGW = nblk * 8;
    unsigned char* ws = A.ws;
    const bf16_t* YBT = (const bf16_t*)(ws + WS_YBT);
    bf16_t* Y = (bf16_t*)(ws + WS_HY);
    LAS bf16_t* scr = (LAS bf16_t*)(lds + wave * 16384);
    const int ntok = (l < DEPTH - 1) ? MTOT : MLAT;
    const int nitems = (ntok / 64) * 4;
#pragma unroll 1
    for (int it = gw; it < nitems; it += NGW) {
        const int tb = (it >> 2) * 64, cb = (it & 3) * 64;
#pragma unroll 8
        for (int i = 0; i < 64; ++i) scr[i * 66 + lane] = YBT[(size_t)(cb + i) * MTOT + tb + lane];
        asm volatile("s_waitcnt lgkmcnt(0)" ::: "memory");
        const int cc = (lane & 7) * 8;
#pragma unroll
        for (int k = 0; k < 8; ++k) {
            const int tq = (lane >> 3) + 8 * k;
            u32x4 o;
            o.x = (unsigned)scr[(cc + 0) * 66 + tq] | ((unsigned)scr[(cc + 1) * 66 + tq] << 16);
            o.y = (unsigned)scr[(cc + 2) * 66 + tq] | ((unsigned)scr[(cc + 3) * 66 + tq] << 16);
            o.z = (unsigned)scr[(cc + 4) * 66 + tq] | ((unsigned)scr[(cc + 5) * 66 + tq] << 16);
            o.w = (unsigned)scr[(cc + 6) * 66 + tq] | ((unsigned)scr[(cc + 7) * 66 + tq] << 16);
            *(u32x4*)(Y + (size_t)(tb + tq) * DM + 384 + cb + cc) = o;
        }
        asm volatile("s_waitcnt lgkmcnt(0)" ::: "memory");
    }
}

__device__ __forceinline__ void phase_final(CKArgs& A, int bid, int nblk, int tid) {
    const int wave = __builtin_amdgcn_readfirstlane(tid >> 6), lane = tid & 63;
    const int gw = bid * 8 + wave, NGW = nblk * 8;
    for (int m = gw; m < MLAT; m += NGW) {
        float* row = A.out + (size_t)m * DM;
        f32x4 xv[4]; float ss = 0.f;
#pragma unroll
        for (int j = 0; j < 4; ++j) { xv[j] = *(const f32x4*)(row + 4 * lane + 256 * j); ss += (xv[j].x * xv[j].x + xv[j].y * xv[j].y) + (xv[j].z * xv[j].z + xv[j].w * xv[j].w); }
        const float rinv = rsqrtf(wave_sum(ss) * (1.0f / DM) + 1e-6f);
#pragma unroll
        for (int j = 0; j < 4; ++j) { const int col = 4 * lane + 256 * j; const f32x4 gv = *(const f32x4*)(A.final_g + col); *(f32x4*)(row + col) = xv[j] * rinv * gv; }
    }
}

#define XB_TMO      128
#define XB_XCNT(j)  (256  + 64 * (j))
#define XB_XSUB(j)  (1280 + 64 * (j))
#define XB_XGEN(j)  (2304 + 64 * (j))
#define XB_TOP      3328
#define XB_TOPGEN   3392
#define XCD_BAR_WORDS 3456
#define XB_SPIN_CAP (1u << 18)

__device__ __forceinline__ unsigned xb_ld(unsigned* p)              { return __hip_atomic_load(p, __ATOMIC_RELAXED, __HIP_MEMORY_SCOPE_AGENT); }
__device__ __forceinline__ unsigned xb_add(unsigned* p, unsigned v) { return __hip_atomic_fetch_add(p, v, __ATOMIC_RELAXED, __HIP_MEMORY_SCOPE_AGENT); }
__device__ __forceinline__ unsigned xb_xcc_id() { return (unsigned)__builtin_amdgcn_s_getreg((3 << 11) | 20) & 0xFu; }
#define XB_SPIN(cond, bar) do { unsigned _sp = 0; while (cond) { __builtin_amdgcn_s_sleep(1); \
    if ((++_sp & 255u) == 0u) { if (xb_ld(&(bar)[XB_TMO])) break; if (_sp > XB_SPIN_CAP) { atomicAdd(&(bar)[XB_TMO], 1u); break; } } } } while (0)

struct XcdBarrier {
    unsigned* bar; unsigned x;
    volatile LAS unsigned* st;
};

__device__ __forceinline__ XcdBarrier xcd_barrier_post(unsigned* bar, volatile LAS unsigned* st) {
    XcdBarrier b; b.bar = bar; b.x = xb_xcc_id(); b.st = st;
    if (threadIdx.x == 0) (void)xb_add(&bar[XB_XCNT(b.x)], 1u);
    return b;
}
__device__ __forceinline__ void xcd_barrier_complete(unsigned* bar, unsigned x, unsigned& nloc, unsigned& nx) {
    const unsigned G = gridDim.x * gridDim.y * gridDim.z;
    unsigned sum, cnt, mine, sp = 0u;
    for (;;) {
        sum = 0u; cnt = 0u; mine = 0u;
#pragma unroll
        for (unsigned j = 0; j < 16; ++j) { const unsigned c = xb_ld(&bar[XB_XCNT(j)]); sum += c; cnt += (c > 0u) ? 1u : 0u; mine = (j == x) ? c : mine; }
        if (sum == G) break;
        __builtin_amdgcn_s_sleep(1);
        if ((++sp & 255u) == 0u) { if (xb_ld(&bar[XB_TMO])) break; if (sp > XB_SPIN_CAP) { atomicAdd(&bar[XB_TMO], 1u); break; } }
    }
    nloc = mine > 0u ? mine : 1u; nx = cnt > 0u ? cnt : 1u;
}

__device__ __forceinline__ void xcd_barrier(const XcdBarrier& b) {
    asm volatile("s_waitcnt vmcnt(0)" ::: "memory");
    __syncthreads();
    if (threadIdx.x == 0) {
        unsigned* bar = b.bar;
        __builtin_amdgcn_s_waitcnt(0);
        unsigned nloc = b.st[0], nx = b.st[1];
        if (nloc == 0u) { xcd_barrier_complete(bar, b.x, nloc, nx); b.st[0] = nloc; b.st[1] = nx; }
        const unsigned old = xb_add(&bar[XB_XSUB(b.x)], 1u);
        const unsigned gen = old / nloc;
        if (old + 1u == (gen + 1u) * nloc) {
            __builtin_amdgcn_fence(__ATOMIC_RELEASE, "agent");
            asm volatile("s_waitcnt vmcnt(0)" ::: "memory");
            const unsigned og = xb_add(&bar[XB_TOP], 1u);
            const unsigned tg = og / nx;
            if (og + 1u == (tg + 1u) * nx) xb_add(&bar[XB_TOPGEN], 1u);
            else XB_SPIN(xb_ld(&bar[XB_TOPGEN]) == tg, bar);
            __builtin_amdgcn_fence(__ATOMIC_ACQUIRE, "agent");
            xb_add(&bar[XB_XGEN(b.x)], 1u);
            asm volatile("s_waitcnt vmcnt(0)" ::: "memory");
        } else {
            XB_SPIN(xb_ld(&bar[XB_XGEN(b.x)]) == gen, bar);
            __builtin_amdgcn_fence(__ATOMIC_ACQUIRE, "agent");
            asm volatile("s_waitcnt vmcnt(0)" ::: "memory");
        }
    }
    __syncthreads();
}


constexpr int NPHASE = 2 + 5 * DEPTH;
__global__ void __launch_bounds__(NTHREADS, 2) hybrid_fwd(KArgs Aval) {
    extern __shared__ __attribute__((aligned(16))) unsigned char lds_raw[];
    LAS unsigned char* lds = (LAS unsigned char*)lds_raw;
    const int tid0 = threadIdx.x, bid = blockIdx.x, nblk = gridDim.x;
#if !MK_MULTI
    volatile LAS unsigned* bst = (volatile LAS unsigned*)(lds + 131072 + 8192);
    if (tid0 < 2) bst[tid0] = 0u;
    __syncthreads();
    const XcdBarrier bar = xcd_barrier_post((unsigned*)Aval.ws, bst);
#endif
#pragma unroll 1
    for (int ph = Aval.ph_lo; ph < Aval.ph_hi; ++ph) {
#if !MK_MULTI
        if (ph > Aval.ph_lo) { if (ph == Aval.ph_lo + 1) cg::this_grid().sync(); else xcd_barrier(bar); }
#endif
#ifndef ONLY
#define ONLY -1
#endif
#define EN(k) (ONLY < 0 || ((ONLY >> (k)) & 1))
#ifndef REP_KIND
#define REP_KIND -1
#endif
        { const int kind_ = ph == 0 ? 0 : (ph == NPHASE - 1 ? 6 : 1 + (ph - 1) % 5); const int l_ = (ph - 1) / 5;
          const int nrep_ = (kind_ == REP_KIND && (kind_ != 5 || l_ == 0)) ? 2 : 1;
#pragma unroll 1
          for (int rep_ = 0; rep_ < nrep_; ++rep_) {
        int tid = tid0; asm volatile("" : "+v"(tid));
        CKArgs* Ap = (CKArgs*)__builtin_amdgcn_kernarg_segment_ptr(); asm volatile("" : "+s"(Ap));
        CKArgs& A = *Ap;
        unsigned char* ws = A.ws;
        if (ph == 0) { if (EN(0)) phase_prologue(A, lds, bid, nblk, tid); }
        else if (ph == NPHASE - 1) { if (EN(6)) phase_final(A, bid, nblk, tid); }
        else {
            const int l = (ph - 1) / 5, k = (ph - 1) % 5;
            if (k == 0) { if (EN(1)) phase_norm(A, l, bid, nblk, tid); }
            else if (k == 2) { if (EN(3)) phase_mix(A, l, lds, bid, nblk, tid); }
            else if (k == 3) { if (EN(4)) phase_tr(A, l, lds, bid, nblk, tid); }
            if (k == 1 || k == 4) {
                pg8::Gemm g; EpiAll E; E.l = l; E.Ap = Ap; g.A = (const bf16_t*)(ws + WS_HY); g.K = DM;
                if (k == 1) { g.Bt = (const bf16_t*)(ws + WS_WIN) + (size_t)l * NIN * DM; g.M = MTOT; g.N = NIN; E.mode = 0; }
                else { g.Bt = (const bf16_t*)(ws + WS_WOUT) + (size_t)l * DM * DM; g.M = (l < DEPTH - 1) ? MTOT : MLAT; g.N = DM; E.mode = 1; }
                pg8::StaticOrder S; S.init(g.M, g.N, nblk, bid);
                if (EN(2)) pg8::gemm_phase<EpiAll, pg8::StaticOrder, true, false>(lds, g, S, E);
            }
        }
          } }
    }
}

extern "C" void kernel_launch(void* const* d_in, const int* in_sizes, int n_in, void* d_out, int out_size, void* d_ws, size_t ws_size, hipStream_t stream) {
    static int grid = 0;
    if (grid == 0) {
        if (n_in != 22 || ws_size < WS_END) { fprintf(stderr, "kernel_launch: unexpected inputs (n_in %d, ws %zu)\n", n_in, ws_size); grid = -1; return; }
        int dev = 0, cus = 0, per_cu = 0;
        if (hipGetDevice(&dev) != hipSuccess || hipDeviceGetAttribute(&cus, hipDeviceAttributeMultiprocessorCount, dev) != hipSuccess) { grid = -1; return; }
        if (hipFuncSetAttribute((const void*)hybrid_fwd, hipFuncAttributeMaxDynamicSharedMemorySize, LDS_BYTES) != hipSuccess) { fprintf(stderr, "kernel_launch: hipFuncSetAttribute failed\n"); grid = -1; return; }
        if (hipOccupancyMaxActiveBlocksPerMultiprocessor(&per_cu, (const void*)hybrid_fwd, NTHREADS, LDS_BYTES) != hipSuccess || per_cu < 1) { fprintf(stderr, "kernel_launch: occupancy query says %d\n", per_cu); per_cu = 1; }
        (void)hipGetLastError();
        grid = cus;
    }
    if (grid < 0) return;
    KArgs a{};
    a.x = (const float*)d_in[0]; a.c = (const float*)d_in[1]; a.ctx = (const float*)d_in[2]; a.c_ctx = (const float*)d_in[3]; a.norm_g = (const float*)d_in[4];
    a.w_ada = (const float*)d_in[5]; a.b_ada = (const float*)d_in[6]; a.w_in = (const float*)d_in[7]; a.w_out = (const float*)d_in[8]; a.na_rpb = (const float*)d_in[9];
    a.hy_conv_w = (const float*)d_in[10]; a.hy_conv_b = (const float*)d_in[11]; a.hy_w1 = (const float*)d_in[12]; a.hy_b1 = (const float*)d_in[13]; a.hy_freq1 = (const float*)d_in[14];
    a.hy_w2 = (const float*)d_in[15]; a.hy_b2 = (const float*)d_in[16]; a.hy_freq2 = (const float*)d_in[17]; a.hy_w3 = (const float*)d_in[18]; a.hy_d = (const float*)d_in[19];
    a.sink = (const float*)d_in[20]; a.final_g = (const float*)d_in[21];
    a.out = (float*)d_out; a.ws = (unsigned char*)d_ws;
#if MK_MULTI
    for (int ph = 0; ph < NPHASE; ++ph) {
        a.ph_lo = ph; a.ph_hi = ph + 1;
        hipLaunchKernelGGL(hybrid_fwd, dim3(grid), dim3(NTHREADS), LDS_BYTES, stream, a);
    }
#else
    if (hipMemsetAsync(d_ws, 0, 16384, stream) != hipSuccess) { fprintf(stderr, "kernel_launch: memset of the barrier words failed\n"); return; }
    a.ph_lo = 0; a.ph_hi = NPHASE;
    void* args[] = {&a};
    hipError_t e = hipLaunchCooperativeKernel((const void*)hybrid_fwd, dim3(grid), dim3(NTHREADS), args, LDS_BYTES, stream);
    if (e != hipSuccess) fprintf(stderr, "cooperative launch failed: %s (grid %d)\n", hipGetErrorString(e), grid);
#endif
}
```

```cpp
#include <hip/hip_runtime.h>
#include <hip/hip_cooperative_groups.h>
#include <cstdio>
#include <cstdint>
namespace cg = cooperative_groups;

#ifndef MK_MULTI
#define MK_MULTI 0
#endif

namespace pg8 {
#define PG8_LAS __attribute__((address_space(3)))
typedef unsigned short bf16_t;
typedef short bf16x8 __attribute__((ext_vector_type(8)));
typedef float f32x4 __attribute__((ext_vector_type(4)));
typedef unsigned u32x4 __attribute__((ext_vector_type(4)));
constexpr int BM = 256, BK = 64, HALF = 128, HTB = HALF * BK * 2  , STAGE_BYTES = 8 * HTB, NXCD = 8, WGM = 8;

__host__ __device__ __forceinline__ int lds_byte(int r, int c) { const int st = (r >> 4) * 2 + (c >> 5), rr = r & 15, cc = c & 31, ob = rr * 64 + cc * 2; return st * 1024 + (ob ^ (((ob >> 9) & 1) << 5)); }
__host__ __device__ __forceinline__ void stage_rc(int b, int& R, int& C) { const int st = b / 1024, sb = b % 1024, swz = sb ^ (((sb >> 9) & 1) << 5); R = (st >> 1) * 16 + swz / 64; C = (st & 1) * 32 + (swz % 64) / 2; }
__host__ __device__ __forceinline__ int perm32(int rho) { const int n = rho >> 4, i = rho & 15; return 8 * (i >> 2) + 4 * n + (i & 3); }

struct Unit { int pm, pn; };
struct Gemm { const bf16_t* A; const bf16_t* Bt; int M, N, K; };

struct StaticOrder {
    int nM, nN, nwg, G, c;
    __host__ __device__ void init(int M, int N, int G_, int c_) { nM = M / BM; nN = N / BM; nwg = nM * nN; G = G_; c = c_; }
    __host__ __device__ bool next(int i, Unit& u) const {
        const long L = (long)i * G + c; if (L >= nwg) return false;
        int wgid = (int)L; { const int q = nwg / NXCD, r = nwg % NXCD, xcd = wgid % NXCD, off = wgid / NXCD; wgid = (xcd < r ? xcd * (q + 1) : r * (q + 1) + (xcd - r) * q) + off; }
        const int nig = WGM * nN, gid = wgid / nig, fm = gid * WGM, gsz = (nM - fm) < WGM ? (nM - fm) : WGM;
        u.pm = fm + ((wgid % nig) % gsz); u.pn = (wgid % nig) / gsz; return true;
    }
    __device__ __forceinline__ void a_ready(const Unit&) const {}
    __device__ __forceinline__ void done(const Unit&) const {}
};

template <class Epi, class Sched, bool ALIGN_EPI = false, bool SP2 = false>
__device__ __forceinline__ void gemm_phase(PG8_LAS unsigned char* lds, const Gemm g, const Sched& S, const Epi& E, const int tid) {
    const int wid = __builtin_amdgcn_readfirstlane(tid >> 6), lane = tid & 63, wr = wid >> 2, wc = wid & 3, fr = lane & 15, fq = lane >> 4;
    const int K = g.K, nt = K / BK;
    unsigned voffA[2], voffB[2];
#pragma unroll
    for (int i = 0; i < 2; ++i) { int R, C; stage_rc(tid * 16 + i * 8192, R, C); const int Rb = Epi::PERM ? ((R & ~31) + perm32(R & 31)) : R;
        voffA[i] = (unsigned)(R * K + C) * 2u; voffB[i] = (unsigned)(Rb * K + C) * 2u; }
    const size_t kstep = (size_t)(BK * 2);
    const size_t hstep = (size_t)HALF * K * 2;
    const size_t tstep = 2 * hstep;
    const unsigned ldsw = (unsigned)wid * 1024u;
    const int aoff = lds_byte(wr * 64 + fr, fq * 8), boff = lds_byte(wc * 32 + fr, fq * 8);
#define PG8_SA(b, h) (((b) * 2 + (h)) * HTB)
#define PG8_SB(b, h) ((4 + (b) * 2 + (h)) * HTB)
#define PG8_STAGE(bufoff, gbase, voff) do { _Pragma("unroll") for (int _i = 0; _i < 2; ++_i) \
        __builtin_amdgcn_global_load_lds((const unsigned*)((const char*)(gbase) + (voff)[_i]), (PG8_LAS unsigned*)(lds + (bufoff) + ldsw + _i * 8192), 16, 0, 0); } while (0)
#define PG8_LDA(dst, b, h) do { _Pragma("unroll") for (int m = 0; m < 4; ++m) _Pragma("unroll") for (int k = 0; k < 2; ++k) dst[m][k] = *(const PG8_LAS bf16x8*)(lds + PG8_SA(b, h) + aoff + m * 2048 + k * 1024); } while (0)
#define PG8_LDB(dst, b, h) do { _Pragma("unroll") for (int n = 0; n < 2; ++n) _Pragma("unroll") for (int k = 0; k < 2; ++k) dst[n][k] = *(const PG8_LAS bf16x8*)(lds + PG8_SB(b, h) + boff + n * 2048 + k * 1024); } while (0)
#define PG8_MMA(ai, bj, At, Bt) do { __builtin_amdgcn_s_setprio(1); _Pragma("unroll") for (int m = 0; m < 4; ++m) _Pragma("unroll") for (int n = 0; n < 2; ++n) _Pragma("unroll") for (int k = 0; k < 2; ++k) \
        acc[ai][bj][m][n] = __builtin_amdgcn_mfma_f32_16x16x32_bf16(Bt[n][k], At[m][k], acc[ai][bj][m][n], 0, 0, 0); __builtin_amdgcn_s_setprio(0); } while (0)
#define PG8_WAIT_V(n) asm volatile("s_waitcnt vmcnt(" #n ")" ::: "memory")
#define PG8_WAIT_L(n) asm volatile("s_waitcnt lgkmcnt(" #n ")" ::: "memory")
#define PG8_BAR __builtin_amdgcn_s_barrier()
#define PG8_SCHED __builtin_amdgcn_sched_barrier(0)
    Unit cur, nxt; int ui = 0;
    if (!S.next(0, cur)) return;
    f32x4 acc[2][2][4][2];
#pragma unroll
    for (int a = 0; a < 2; ++a)
#pragma unroll
        for (int b = 0; b < 2; ++b)
#pragma unroll
            for (int m = 0; m < 4; ++m)
#pragma unroll
                for (int n = 0; n < 2; ++n) acc[a][b][m][n] = (f32x4){0.f, 0.f, 0.f, 0.f};
    bf16x8 At[4][2], B0[2][2], B1[2][2];
    const char* cA = (const char*)g.A + (size_t)cur.pm * tstep; const char* cB = (const char*)g.Bt + (size_t)cur.pn * tstep;
    S.a_ready(cur);
    if constexpr (SP2) {
        PG8_STAGE(PG8_SB(0, 0), cB, voffB); PG8_STAGE(PG8_SB(0, 1), cB + hstep, voffB); PG8_STAGE(PG8_SA(0, 0), cA, voffA); PG8_STAGE(PG8_SA(0, 1), cA + hstep, voffA);
        if (wr == 1) PG8_BAR;
        PG8_WAIT_V(2); PG8_BAR;
        PG8_STAGE(PG8_SB(1, 0), cB + kstep, voffB); PG8_STAGE(PG8_SA(1, 0), cA + kstep, voffA); PG8_STAGE(PG8_SB(1, 1), cB + hstep + kstep, voffB);
        PG8_WAIT_V(6); PG8_BAR;
    } else {
        PG8_STAGE(PG8_SB(0, 0), cB, voffB); PG8_STAGE(PG8_SA(0, 0), cA, voffA); PG8_STAGE(PG8_SB(0, 1), cB + hstep, voffB); PG8_STAGE(PG8_SA(0, 1), cA + hstep, voffA);
        if (wr == 1) PG8_BAR;
        PG8_WAIT_V(4); PG8_BAR;
        PG8_STAGE(PG8_SB(1, 0), cB + kstep, voffB); PG8_STAGE(PG8_SA(1, 0), cA + kstep, voffA); PG8_STAGE(PG8_SB(1, 1), cB + hstep + kstep, voffB);
        PG8_WAIT_V(6); PG8_BAR;
    }
    for (;;) {
        const bool has_next = S.next(ui + 1, nxt);
        const char* nA = has_next ? (const char*)g.A + (size_t)nxt.pm * tstep : cA; const char* nB = has_next ? (const char*)g.Bt + (size_t)nxt.pn * tstep : cB;
        for (int t = 0; t < nt; t += 2) {
            const bool last = (t == nt - 2);
            const char* a1 = cA + (size_t)(t + 1) * kstep;
            const char* a2 = last ? nA : cA + (size_t)(t + 2) * kstep; const char* b2 = last ? nB : cB + (size_t)(t + 2) * kstep;
            const char* a3 = a2 + kstep; const char* b3 = b2 + kstep;
            if (last && has_next) S.a_ready(nxt);
            if constexpr (SP2) {
            PG8_LDB(B0, 0, 0); PG8_LDB(B1, 0, 1); PG8_SCHED; PG8_LDA(At, 0, 0); PG8_STAGE(PG8_SA(1, 1), a1 + hstep, voffA);
            PG8_WAIT_V(8); PG8_WAIT_L(0); PG8_BAR; PG8_MMA(0, 0, At, B0); PG8_MMA(0, 1, At, B1); PG8_BAR; PG8_SCHED;
            PG8_LDA(At, 0, 1); PG8_STAGE(PG8_SB(0, 0), b2, voffB); PG8_STAGE(PG8_SB(0, 1), b2 + hstep, voffB); PG8_STAGE(PG8_SA(0, 0), a2, voffA);
            PG8_WAIT_V(8); PG8_WAIT_L(0); PG8_BAR; PG8_MMA(1, 0, At, B0); PG8_MMA(1, 1, At, B1); PG8_BAR; PG8_SCHED;
            PG8_LDB(B0, 1, 0); PG8_LDB(B1, 1, 1); PG8_SCHED; PG8_LDA(At, 1, 0); PG8_STAGE(PG8_SA(0, 1), a2 + hstep, voffA);
            PG8_WAIT_V(8); PG8_WAIT_L(0); PG8_BAR; PG8_MMA(0, 0, At, B0); PG8_MMA(0, 1, At, B1); PG8_BAR; PG8_SCHED;
            PG8_LDA(At, 1, 1); PG8_STAGE(PG8_SB(1, 0), b3, voffB); PG8_STAGE(PG8_SB(1, 1), b3 + hstep, voffB); PG8_STAGE(PG8_SA(1, 0), a3, voffA);
            PG8_WAIT_V(8); PG8_WAIT_L(0); PG8_BAR; PG8_MMA(1, 0, At, B0); PG8_MMA(1, 1, At, B1); PG8_BAR; PG8_SCHED;
            } else {
            PG8_LDB(B0, 0, 0); PG8_SCHED; PG8_LDA(At, 0, 0); PG8_STAGE(PG8_SA(1, 1), a1 + hstep, voffA);
            PG8_WAIT_L(8); PG8_BAR; PG8_WAIT_L(0); PG8_MMA(0, 0, At, B0); PG8_BAR; PG8_SCHED;
            PG8_LDB(B1, 0, 1); PG8_STAGE(PG8_SB(0, 0), b2, voffB);
            PG8_BAR; PG8_WAIT_L(0); PG8_MMA(0, 1, At, B1); PG8_BAR;
            PG8_LDA(At, 0, 1); PG8_STAGE(PG8_SA(0, 0), a2, voffA);
            PG8_BAR; PG8_WAIT_L(0); PG8_MMA(1, 0, At, B0); PG8_BAR; PG8_SCHED;
            PG8_STAGE(PG8_SB(0, 1), b2 + hstep, voffB);
            PG8_WAIT_V(6); PG8_BAR; PG8_MMA(1, 1, At, B1); PG8_BAR;
            PG8_LDB(B0, 1, 0); PG8_SCHED; PG8_LDA(At, 1, 0); PG8_STAGE(PG8_SA(0, 1), a2 + hstep, voffA);
            PG8_WAIT_L(8); PG8_BAR; PG8_WAIT_L(0); PG8_MMA(0, 0, At, B0); PG8_BAR; PG8_SCHED;
            PG8_LDB(B1, 1, 1); PG8_STAGE(PG8_SB(1, 0), b3, voffB);
            PG8_BAR; PG8_WAIT_L(0); PG8_MMA(0, 1, At, B1); PG8_BAR;
            PG8_LDA(At, 1, 1); PG8_STAGE(PG8_SA(1, 0), a3, voffA);
            PG8_BAR; PG8_WAIT_L(0); PG8_MMA(1, 0, At, B0); PG8_BAR; PG8_SCHED;
            PG8_STAGE(PG8_SB(1, 1), b3 + hstep, voffB);
            PG8_WAIT_V(6); PG8_BAR; PG8_MMA(1, 1, At, B1); PG8_BAR;
            }
        }
        if constexpr (ALIGN_EPI) { if (wr == 0) PG8_BAR; }
        if constexpr (!Epi::AFTER_DRAIN) { E(acc, cur, wr, wc, fr, fq); S.done(cur); }
        if (!has_next) break;
#pragma unroll
        for (int a = 0; a < 2; ++a)
#pragma unroll
            for (int b = 0; b < 2; ++b)
#pragma unroll
                for (int m = 0; m < 4; ++m)
#pragma unroll
                    for (int n = 0; n < 2; ++n) acc[a][b][m][n] = (f32x4){0.f, 0.f, 0.f, 0.f};
        cur = nxt; cA = nA; cB = nB; ++ui;
        if constexpr (ALIGN_EPI) { if (wr == 1) PG8_BAR; }
    }
    PG8_WAIT_V(0);
    if constexpr (!ALIGN_EPI) { if (wr == 0) PG8_BAR; }
    PG8_BAR;
    if constexpr (Epi::AFTER_DRAIN) { E.fused(acc, cur, wr, wc, fr, fq, lds, wid, lane); S.done(cur); }
#undef PG8_SA
#undef PG8_SB
#undef PG8_STAGE
#undef PG8_LDA
#undef PG8_LDB
#undef PG8_MMA
#undef PG8_WAIT_V
#undef PG8_WAIT_L
#undef PG8_BAR
#undef PG8_SCHED
}
}

#define LAS __attribute__((address_space(3)))
typedef unsigned short bf16_t;
typedef short bf16x8 __attribute__((ext_vector_type(8)));
typedef float f32x4 __attribute__((ext_vector_type(4)));
typedef float f32x16 __attribute__((ext_vector_type(16)));
typedef unsigned u32x2 __attribute__((ext_vector_type(2)));
typedef unsigned u32x4 __attribute__((ext_vector_type(4)));
typedef float f32x2_t __attribute__((ext_vector_type(2)));
typedef __bf16 bf16x2_t __attribute__((ext_vector_type(2)));

constexpr int DM = 1024, NBATCH = 2, SEQ = 8192, DEPTH = 4, CTXL = 256;
constexpr int MLAT = NBATCH * SEQ, MCTX = NBATCH * CTXL, MTOT = MLAT + MCTX;
constexpr int NIN = 3584, NTM = 1536, NCM = 1024, NTB = MTOT / 64;
constexpr int C_QA = 0, C_GA = 384, C_QC = 768, C_GC = 1152;
constexpr int R_HZ = 0, R_GB = 768;
constexpr int NFFT = 16384;
constexpr float LOG2E = 1.4426950408889634f;
constexpr float QK_SCALE = 0.125f * LOG2E;

constexpr size_t MiB = 1u << 20;
constexpr size_t WS_ADA = 1 * MiB;
constexpr size_t WS_ROPE = 1 * MiB + 256 * 1024;
constexpr size_t WS_H2C = 1 * MiB + 512 * 1024;
constexpr size_t WS_CX = 2 * MiB;
constexpr size_t WS_H2 = 4 * MiB;
constexpr size_t WS_WIN = 12 * MiB;
constexpr size_t WS_WOUT = 40 * MiB;
constexpr size_t WS_HY = 48 * MiB;
constexpr size_t WS_PT = 81 * MiB;
constexpr size_t WS_KH = 130 * MiB + 512 * 1024;
constexpr size_t WS_VT = 147 * MiB;
constexpr size_t WS_PCT = 163 * MiB + 512 * 1024;
constexpr size_t WS_YBT = 197 * MiB;
constexpr size_t WS_ZS = 206 * MiB;
constexpr size_t WS_W3T = 238 * MiB;
constexpr size_t WS_FILT = 239 * MiB;
constexpr size_t WS_END = 255 * MiB;
static_assert(WS_PT + (size_t)MTOT * NTM * 2 <= WS_KH && WS_KH + (size_t)8 * MTOT * 128 <= WS_VT && WS_VT + (size_t)8 * MTOT * 128 <= WS_PCT && WS_PCT + (size_t)NCM * MTOT * 2 <= WS_YBT, "d_ws map");

constexpr int LDS_BYTES = 147456;
constexpr int NTHREADS = 512;

struct KArgs {
    const float* x; const float* c; const float* ctx; const float* c_ctx; const float* norm_g; const float* w_ada; const float* b_ada;
    const float* w_in; const float* w_out; const float* na_rpb; const float* hy_conv_w; const float* hy_conv_b;
    const float* hy_w1; const float* hy_b1; const float* hy_freq1; const float* hy_w2; const float* hy_b2; const float* hy_freq2; const float* hy_w3;
    const float* hy_d; const float* sink; const float* final_g;
    float* out; unsigned char* ws;
    int ph_lo, ph_hi;
};

typedef const __attribute__((address_space(4))) KArgs CKArgs;
__device__ __forceinline__ unsigned pk2(float lo, float hi) { f32x2_t v = {lo, hi}; bf16x2_t b = __builtin_convertvector(v, bf16x2_t); return __builtin_bit_cast(unsigned, b); }
__device__ __forceinline__ float bf2f(unsigned short u) { return __uint_as_float(((unsigned)u) << 16); }
__device__ __forceinline__ float bflo(unsigned w) { return __uint_as_float(w << 16); }
__device__ __forceinline__ float bfhi(unsigned w) { return __uint_as_float(w & 0xffff0000u); }
__device__ __forceinline__ float silu_f(float x) { return x / (1.0f + __expf(-x)); }
__device__ __forceinline__ float lane_xor(float v, int lane, int m) { return __int_as_float(__builtin_amdgcn_ds_bpermute((lane ^ m) << 2, __float_as_int(v))); }
__device__ __forceinline__ float lane_prev(float v, int lane) { return __int_as_float(__builtin_amdgcn_ds_bpermute(((lane - 1) & 63) << 2, __float_as_int(v))); }
__device__ __forceinline__ float lane_next(float v, int lane) { return __int_as_float(__builtin_amdgcn_ds_bpermute(((lane + 1) & 63) << 2, __float_as_int(v))); }
__device__ __forceinline__ float wave_sum(float v, int lane) {
#pragma unroll
    for (int o = 1; o < 64; o <<= 1) v += lane_xor(v, lane, o);
    return v;
}
__device__ __forceinline__ float rdlane(float v, int l) { return __uint_as_float(__builtin_amdgcn_readlane(__float_as_uint(v), l)); }

__device__ __forceinline__ void transpose_item(const float* W, int K, int N, bf16_t* WT, int k0, int n0, int drow0, LAS float* scr, int lane, int ldk = 0) {
    if (ldk == 0) ldk = K;
#pragma unroll 8
    for (int i = 0; i < 32; ++i) { const int kk = 2 * i + (lane >> 5); scr[kk * 33 + (lane & 31)] = W[(size_t)(k0 + kk) * N + n0 + (lane & 31)]; }
    asm volatile("s_waitcnt lgkmcnt(0)" ::: "memory");
    const int c = lane & 7;
#pragma unroll
    for (int j = 0; j < 4; ++j) { const int n = (lane >> 3) + 8 * j; const LAS float* s = scr + (8 * c) * 33 + n;
        u32x4 o; o.x = pk2(s[0 * 33], s[1 * 33]); o.y = pk2(s[2 * 33], s[3 * 33]); o.z = pk2(s[4 * 33], s[5 * 33]); o.w = pk2(s[6 * 33], s[7 * 33]);
        *(u32x4*)(WT + (size_t)(drow0 + n) * ldk + k0 + 8 * c) = o; }
    asm volatile("s_waitcnt lgkmcnt(0)" ::: "memory");
}
__device__ __forceinline__ int win_row(int n0) {
    if (n0 < 384) return n0;
    if (n0 < 768) return n0 - 384 + 1536;
    if (n0 < 1152) return n0 - 768 + 2048;
    if (n0 < 1536) return n0 - 1152 + 384;
    if (n0 < 2304) return n0 - 1536 + 2560;
    if (n0 < 2560) return n0 - 2304 + 3328;
    if (n0 < 2944) return n0 - 2560 + 768;
    if (n0 < 3072) return n0 - 2944 + 1920;
    if (n0 < 3200) return n0 - 3072 + 2432;
    return n0 - 3200 + 1152;
}

__device__ __forceinline__ void phase_prologue(CKArgs& A, LAS unsigned char* lds, int bid, int nblk, int tid) {
    const int wave = __builtin_amdgcn_readfirstlane(tid >> 6), lane = tid & 63;
    const int gw = bid * 8 + wave, NGW = nblk * 8;
    unsigned char* ws = A.ws;
    {
        LAS float* scr = (LAS float*)(lds + wave * 16384);
        constexpr int I_IN = 16 * 112, I_OUT = 16 * 32, I_L = I_IN + I_OUT;
        for (int it = gw; it < DEPTH * I_L; it += NGW) {
            const int l = it / I_L; int r = it % I_L;
            if (r < I_IN) { const int kb = r / 112, nb = r % 112, n0 = nb * 32;
                transpose_item(A.w_in + (size_t)l * DM * NIN, DM, NIN, (bf16_t*)(ws + WS_WIN) + (size_t)l * NIN * DM, kb * 64, n0, win_row(n0), scr, lane); }
            else { r -= I_IN; const int kb = r / 32, nb = r % 32, n0 = nb * 32;
                transpose_item(A.w_out + (size_t)l * DM * DM, DM, DM, (bf16_t*)(ws + WS_WOUT) + (size_t)l * DM * DM, kb * 64, n0, n0, scr, lane); }
        }
    }
    {
        LAS float* scr = (LAS float*)(lds + wave * 16384);
        bf16_t* W3T = (bf16_t*)(ws + WS_W3T);
        for (int it = gw; it < DEPTH * 32; it += NGW) { const int l = it >> 5, nb = it & 31;
            transpose_item(A.hy_w3 + (size_t)l * 64 * 1024, 64, 1024, W3T + (size_t)l * 1024 * 64, 0, nb * 32, nb * 32, scr, lane); }
    }
    for (int idx = gw * 64 + lane; idx < 128 * 16; idx += NGW * 64) {
        const int p = idx >> 4, i = idx & 15;
        const float inv = powf(10000.0f, -(float)i / 16.0f);
        const float ang = (float)p * inv;
        ((float2*)(ws + WS_ROPE))[idx] = make_float2(cosf(ang), sinf(ang));
    }
    for (int it = gw; it < DEPTH * 132; it += NGW) {
        const int l = it / 132, g = it % 132;
        const int L = g < 128 ? SEQ : CTXL;
        const int n0 = g < 128 ? g * 64 : (g - 128) * 64;
        float* outp = (float*)(ws + WS_H2C) + ((size_t)l * CTXL + n0) * 64;
        bf16_t* outb = (bf16_t*)(ws + WS_H2) + ((size_t)l * SEQ + n0) * 64;
        float w1c[33], w2c[64];
#pragma unroll
        for (int q = 0; q < 33; ++q) w1c[q] = A.hy_w1[((size_t)l * 33 + q) * 64 + lane];
#pragma unroll
        for (int j = 0; j < 64; ++j) w2c[j] = A.hy_w2[((size_t)l * 64 + j) * 64 + lane];
        const float b1 = A.hy_b1[l * 64 + lane], fr1 = A.hy_freq1[l * 64 + lane], b2 = A.hy_b2[l * 64 + lane], fr2 = A.hy_freq2[l * 64 + lane];
        const float tstep = 1.0f / (float)(L - 1), wstep = 6.283185307179586f / (float)L;
        const int fj = lane == 0 ? 0 : ((lane - 1) & 15);
        const float fq = 1e-4f + (float)fj * ((15.0f - 1e-4f) / 15.0f);
#pragma unroll 1
        for (int nn = 0; nn < 64; ++nn) {
            const int n = n0 + nn;
            const float t = (float)n * tstep, wa = (float)n * wstep;
            float zq;
            if (lane == 0) zq = t; else if (lane <= 16) zq = cosf(fq * wa); else if (lane <= 32) zq = -sinf(fq * wa); else zq = 0.f;
            float a1 = b1;
#pragma unroll
            for (int q = 0; q < 33; ++q) a1 += rdlane(zq, q) * w1c[q];
            const float h1 = sinf(fr1 * a1);
            float a2 = b2;
#pragma unroll
            for (int j = 0; j < 64; ++j) a2 += rdlane(h1, j) * w2c[j];
            const float h2 = sinf(fr2 * a2);
            if (g < 128) outb[nn * 64 + lane] = (bf16_t)(pk2(h2, 0.f) & 0xffffu);
            else outp[nn * 64 + lane] = h2;
        }
    }
    __syncthreads();
    {
        LAS float* red = (LAS float*)lds;
        for (int it = bid; it < DEPTH * 48; it += nblk) {
            const int l = it / 48, n = (it % 48) * 64 + lane;
            const float* W = A.w_ada + (size_t)l * DM * 3072;
            float a0 = 0.f, a1 = 0.f, a2 = 0.f;
            const int kb = wave * 128;
#pragma unroll 4
            for (int k = 0; k < 128; ++k) {
                const float w = W[(size_t)(kb + k) * 3072 + n];
                a0 += silu_f(A.c[kb + k]) * w; a1 += silu_f(A.c[DM + kb + k]) * w; a2 += silu_f(A.c_ctx[kb + k]) * w;
            }
            red[(wave * 3 + 0) * 64 + lane] = a0; red[(wave * 3 + 1) * 64 + lane] = a1; red[(wave * 3 + 2) * 64 + lane] = a2;
            __syncthreads();
            if (tid < 192) { const int v = tid >> 6; float s = A.b_ada[l * 3072 + n];
#pragma unroll
                for (int w = 0; w < 8; ++w) s += red[(w * 3 + v) * 64 + lane];
                ((float*)(ws + WS_ADA))[((size_t)l * 3 + v) * 3072 + n] = s; }
            __syncthreads();
        }
    }
}

__device__ __forceinline__ void phase_norm(CKArgs& A, int l, int bid, int nblk, int tid) {
    const int wave = __builtin_amdgcn_readfirstlane(tid >> 6), lane = tid & 63;
    const int gw = bid * 8 + wave, NGW = nblk * 8;
    unsigned char* ws = A.ws;
    bf16_t* H = (bf16_t*)(ws + WS_HY);
    const float* ada = (const float*)(ws + WS_ADA) + (size_t)l * 3 * 3072;
    const float* g = A.norm_g + l * DM;
    for (int m = gw; m < MTOT; m += NGW) {
        const float* src; int v;
        if (m < MLAT) { src = (l == 0 ? A.x : A.out) + (size_t)m * DM; v = m >> 13; }
        else { src = (l == 0 ? A.ctx : (const float*)(ws + WS_CX)) + (size_t)(m - MLAT) * DM; v = 2; }
        const float* shp = ada + v * 3072; const float* scp = shp + DM;
        f32x4 xv[4]; float ss = 0.f;
#pragma unroll
        for (int j = 0; j < 4; ++j) { xv[j] = *(const f32x4*)(src + 4 * lane + 256 * j); ss += (xv[j].x * xv[j].x + xv[j].y * xv[j].y) + (xv[j].z * xv[j].z + xv[j].w * xv[j].w); }
        const float rinv = rsqrtf(wave_sum(ss, lane) * (1.0f / DM) + 1e-6f);
#pragma unroll
        for (int j = 0; j < 4; ++j) { const int col = 4 * lane + 256 * j;
            const f32x4 gv = *(const f32x4*)(g + col), sc = *(const f32x4*)(scp + col), sh = *(const f32x4*)(shp + col);
            const f32x4 h = xv[j] * rinv * gv * (sc + 1.0f) + sh;
            u32x2 o; o.x = pk2(h.x, h.y); o.y = pk2(h.z, h.w);
            *(u32x2*)(H + (size_t)m * DM + col) = o; }
    }
    {
        const bf16_t* H2B = (const bf16_t*)(ws + WS_H2) + (size_t)l * SEQ * 64;
        const bf16_t* W3T = (const bf16_t*)(ws + WS_W3T) + (size_t)l * 1024 * 64;
        bf16_t* FILT = (bf16_t*)(ws + WS_FILT);
        const int fr = lane & 15, fq = lane >> 4;
#pragma unroll 1
        for (int it = gw; it < 2048; it += NGW) {
            const int pt = it >> 2, cq = it & 3;
            const bf16_t* ap = H2B + (size_t)(16 * pt + fr) * 64 + 8 * fq;
            const bf16x8 a0 = *(const bf16x8*)ap, a1 = *(const bf16x8*)(ap + 32);
#pragma unroll 4
            for (int ct = 0; ct < 16; ++ct) {
                const int col0 = 256 * cq + 16 * ct;
                const bf16_t* bp = W3T + (size_t)(col0 + fr) * 64 + 8 * fq;
                const bf16x8 b0 = *(const bf16x8*)bp, b1 = *(const bf16x8*)(bp + 32);
                f32x4 acc = {0.f, 0.f, 0.f, 0.f};
                acc = __builtin_amdgcn_mfma_f32_16x16x32_bf16(a0, b0, acc, 0, 0, 0);
                acc = __builtin_amdgcn_mfma_f32_16x16x32_bf16(a1, b1, acc, 0, 0, 0);
                u32x2 o; o.x = pk2(acc.x, acc.y); o.y = pk2(acc.z, acc.w);
                *(u32x2*)(FILT + (size_t)(col0 + fr) * SEQ + 16 * pt + 4 * fq) = o;
            }
        }
    }
}

struct EpiIn {
    static constexpr bool PERM = true, AFTER_DRAIN = false;
    bf16_t* PT; bf16_t* KH; bf16_t* VT; bf16_t* PCT; const float2* rope;
    __device__ __forceinline__ void operator()(const f32x4 (&acc)[2][2][4][2], const pg8::Unit& u, int wr, int wc, int fr, int fq) const {
        const int row0 = u.pm * 256 + wr * 64 + fr;
        if (u.pn < 8) {
#pragma unroll
            for (int bj = 0; bj < 2; ++bj) {
                const int blk = 2 * u.pn + bj;
                const bool rp = ((blk >= 6 && blk <= 8) || blk == 15) && (u.pm < 64);
                const int col0 = 256 * u.pn + 128 * bj + 32 * wc + 8 * fq;
                bf16_t* dst; size_t ld;
                if (u.pn < 6) { dst = PT + col0; ld = NTM; }
                else { const int n2 = col0 - 1536; dst = KH + (size_t)(n2 >> 6) * MTOT * 64 + (n2 & 63); ld = 64; }
#pragma unroll
                for (int ai = 0; ai < 2; ++ai)
#pragma unroll
                    for (int m = 0; m < 4; ++m) {
                        const int r = row0 + 128 * ai + 16 * m;
                        f32x4 v0 = acc[ai][bj][m][0], v1 = acc[ai][bj][m][1];
                        if (rp) {
                            const int pos = r & (SEQ - 1);
                            const int p = (wc & 1) ? (pos & 63) : (pos >> 6);
                            const f32x4* tb = (const f32x4*)(rope + p * 16 + 8 * (fq & 1));
                            const int ln = fr + 16 * fq;
                            const float sg = (fq < 2) ? -1.0f : 1.0f;
                            { const f32x4 t0 = tb[0], t1 = tb[1];
                              const float qx = lane_xor(v0.x, ln, 32), qy = lane_xor(v0.y, ln, 32), qz = lane_xor(v0.z, ln, 32), qw = lane_xor(v0.w, ln, 32);
                              v0.x = v0.x * t0.x + sg * qx * t0.y; v0.y = v0.y * t0.z + sg * qy * t0.w; v0.z = v0.z * t1.x + sg * qz * t1.y; v0.w = v0.w * t1.z + sg * qw * t1.w; }
                            { const f32x4 t2 = tb[2], t3 = tb[3];
                              const float qx = lane_xor(v1.x, ln, 32), qy = lane_xor(v1.y, ln, 32), qz = lane_xor(v1.z, ln, 32), qw = lane_xor(v1.w, ln, 32);
                              v1.x = v1.x * t2.x + sg * qx * t2.y; v1.y = v1.y * t2.z + sg * qy * t2.w; v1.z = v1.z * t3.x + sg * qz * t3.y; v1.w = v1.w * t3.z + sg * qw * t3.w; }
                        }
                        u32x4 w; w.x = pk2(v0.x, v0.y); w.y = pk2(v0.z, v0.w); w.z = pk2(v1.x, v1.y); w.w = pk2(v1.z, v1.w);
                        *(u32x4*)(dst + (size_t)r * ld) = w;
                        asm volatile("" ::: "memory");
                    }
            }
        } else {
#pragma unroll
            for (int bj = 0; bj < 2; ++bj) {
                const int n2 = 256 * ((u.pn - 8) & 1) + 128 * bj + 32 * wc + 8 * fq;
#pragma unroll
                for (int ai = 0; ai < 2; ++ai)
#pragma unroll
                    for (int m = 0; m < 4; ++m) {
                        const int r = row0 + 128 * ai + 16 * m;
                        bf16_t* p; size_t st;
                        if (u.pn < 10) { p = VT + (((size_t)(n2 >> 6) * NTB + (r >> 6)) * 64 + (n2 & 63)) * 64 + (r & 63); st = 64; }
                        else { p = PCT + (size_t)(n2 + (u.pn >= 12 ? 512 : 0)) * MTOT + r; st = MTOT; }
#pragma unroll
                        for (int n = 0; n < 2; ++n) {
                            const f32x4 v = acc[ai][bj][m][n];
                            bf16_t* q = p + (size_t)(4 * n) * st;
                            const unsigned w0 = pk2(v.x, v.y), w1 = pk2(v.z, v.w);
                            q[0] = (bf16_t)(w0 & 0xffffu); q[st] = (bf16_t)(w0 >> 16); q[2 * st] = (bf16_t)(w1 & 0xffffu); q[3 * st] = (bf16_t)(w1 >> 16);
                        }
                    }
            }
        }
    }
};
struct EpiFilt {
    static constexpr bool PERM = true, AFTER_DRAIN = false;
    bf16_t* O; int ldc;
    __device__ __forceinline__ void operator()(const f32x4 (&acc)[2][2][4][2], const pg8::Unit& u, int wr, int wc, int fr, int fq) const {
        const int row0 = u.pm * 256 + wr * 64 + fr;
#pragma unroll
        for (int bj = 0; bj < 2; ++bj) { const int col0 = 256 * u.pn + 128 * bj + 32 * wc + 8 * fq;
#pragma unroll
            for (int ai = 0; ai < 2; ++ai)
#pragma unroll
                for (int m = 0; m < 4; ++m) { const int r = row0 + 128 * ai + 16 * m; const f32x4 v0 = acc[ai][bj][m][0], v1 = acc[ai][bj][m][1];
                    u32x4 w; w.x = pk2(v0.x, v0.y); w.y = pk2(v0.z, v0.w); w.z = pk2(v1.x, v1.y); w.w = pk2(v1.z, v1.w);
                    *(u32x4*)(O + (size_t)r * ldc + col0) = w; } }
    }
};
struct EpiOut {
    static constexpr bool PERM = true, AFTER_DRAIN = false;
    const float* xsrc; float* xdst; const float* csrc; float* cdst; const float* ada;
    __device__ __forceinline__ void operator()(const f32x4 (&acc)[2][2][4][2], const pg8::Unit& u, int wr, int wc, int fr, int fq) const {
        const int row0 = u.pm * 256 + wr * 64 + fr;
        const bool lat = u.pm < 64;
#pragma unroll
        for (int bj = 0; bj < 2; ++bj) {
            const int col0 = 256 * u.pn + 128 * bj + 32 * wc + 8 * fq;
#pragma unroll
            for (int ai = 0; ai < 2; ++ai)
#pragma unroll
                for (int m = 0; m < 4; ++m) {
                    const int r = row0 + 128 * ai + 16 * m;
                    const int v = lat ? (r >> 13) : 2;
                    const float* gp = ada + v * 3072 + 2048 + col0;
                    const f32x4 g0 = *(const f32x4*)gp, g1 = *(const f32x4*)(gp + 4);
                    const size_t off = lat ? (size_t)r * DM + col0 : (size_t)(r - MLAT) * DM + col0;
                    const float* sp = (lat ? xsrc : csrc) + off; float* dp = (lat ? xdst : cdst) + off;
                    const f32x4 x0 = *(const f32x4*)sp, x1 = *(const f32x4*)(sp + 4);
                    *(f32x4*)dp = x0 + g0 * acc[ai][bj][m][0];
                    *(f32x4*)(dp + 4) = x1 + g1 * acc[ai][bj][m][1];
                    if (m & 1) asm volatile("" ::: "memory");
                }
        }
    }
};

struct EpiAll {
    static constexpr bool PERM = true, AFTER_DRAIN = false;
    int mode, l; CKArgs* Ap;
    __device__ __forceinline__ void operator()(const f32x4 (&acc)[2][2][4][2], const pg8::Unit& u, int wr, int wc, int fr, int fq) const {
        unsigned char* ws = Ap->ws;
        if (mode == 0) { const EpiIn E{(bf16_t*)(ws + WS_PT), (bf16_t*)(ws + WS_KH), (bf16_t*)(ws + WS_VT), (bf16_t*)(ws + WS_PCT), (const float2*)(ws + WS_ROPE)}; E(acc, u, wr, wc, fr, fq); }
        else { const EpiOut E{l == 0 ? Ap->x : Ap->out, Ap->out, l == 0 ? Ap->ctx : (const float*)(ws + WS_CX), (float*)(ws + WS_CX), (const float*)(ws + WS_ADA) + (size_t)l * 3 * 3072}; E(acc, u, wr, wc, fr, fq); }
    }
};
__device__ __forceinline__ void attn_tile(LAS const unsigned char* slot, int cs, const bf16x8 (&bq)[4], f32x16& o0, f32x16& o1, float& m_run, float& l_run,
                                          int r31, int hh, int clo, int chi, bool use_bias, LAS const float* btab, int bidx) {
    const int kr = cs + r31;
    LAS const unsigned char* kp = slot + kr * 128;
    const int ksw = (kr >> 1) & 7;
    const bf16x8 ka0 = *(LAS const bf16x8*)(kp + 16 * ((0 + hh) ^ ksw)), ka1 = *(LAS const bf16x8*)(kp + 16 * ((2 + hh) ^ ksw));
    const bf16x8 ka2 = *(LAS const bf16x8*)(kp + 16 * ((4 + hh) ^ ksw)), ka3 = *(LAS const bf16x8*)(kp + 16 * ((6 + hh) ^ ksw));
    LAS const unsigned char* vp = slot + 8192 + r31 * 128;
    const int vsw = (r31 >> 1) & 15, g0 = (cs >> 2) + hh;
    const u32x2 a0l = *(LAS const u32x2*)(vp + 8 * ((g0) ^ vsw)), a0h = *(LAS const u32x2*)(vp + 8 * ((g0 + 2) ^ vsw));
    const u32x2 a1l = *(LAS const u32x2*)(vp + 8 * ((g0 + 4) ^ vsw)), a1h = *(LAS const u32x2*)(vp + 8 * ((g0 + 6) ^ vsw));
    const u32x2 b0l = *(LAS const u32x2*)(vp + 4096 + 8 * ((g0) ^ vsw)), b0h = *(LAS const u32x2*)(vp + 4096 + 8 * ((g0 + 2) ^ vsw));
    const u32x2 b1l = *(LAS const u32x2*)(vp + 4096 + 8 * ((g0 + 4) ^ vsw)), b1h = *(LAS const u32x2*)(vp + 4096 + 8 * ((g0 + 6) ^ vsw));
    f32x16 s;
#pragma unroll
    for (int i = 0; i < 16; ++i) s[i] = 0.f;
    s = __builtin_amdgcn_mfma_f32_32x32x16_bf16(ka0, bq[0], s, 0, 0, 0);
    s = __builtin_amdgcn_mfma_f32_32x32x16_bf16(ka1, bq[1], s, 0, 0, 0);
    s = __builtin_amdgcn_mfma_f32_32x32x16_bf16(ka2, bq[2], s, 0, 0, 0);
    s = __builtin_amdgcn_mfma_f32_32x32x16_bf16(ka3, bq[3], s, 0, 0, 0);
    float tmax = -INFINITY;
    f32x16 bias;
#pragma unroll
    for (int i = 0; i < 16; ++i) bias[i] = 0.f;
    if (use_bias) {
#pragma unroll
        for (int i = 0; i < 16; ++i) { const int c = (i & 3) + 8 * (i >> 2) + 4 * hh; bias[i] = btab[min(max(bidx + c, 0), 464)] * LOG2E; }
    }
#pragma unroll
    for (int i = 0; i < 16; ++i) {
        const int c = (i & 3) + 8 * (i >> 2) + 4 * hh;
        float v = s[i] * QK_SCALE + bias[i];
        const bool ok = (c >= clo) && (c <= chi);
        v = ok ? v : -INFINITY;
        s[i] = v; tmax = fmaxf(tmax, v);
    }
    tmax = fmaxf(tmax, lane_xor(tmax, r31 + 32 * hh, 32));
    const float m_new = fmaxf(m_run, tmax);
    const float alpha = __builtin_amdgcn_exp2f(m_run - m_new);
    m_run = m_new;
    float psum = 0.f;
#pragma unroll
    for (int i = 0; i < 16; ++i) { const float p = __builtin_amdgcn_exp2f(s[i] - m_new); s[i] = p; psum += p; }
    l_run = l_run * alpha + psum;
#pragma unroll
    for (int i = 0; i < 16; ++i) { o0[i] *= alpha; o1[i] *= alpha; }
    u32x4 pw0, pw1;
    pw0.x = pk2(s[0], s[1]); pw0.y = pk2(s[2], s[3]); pw0.z = pk2(s[4], s[5]); pw0.w = pk2(s[6], s[7]);
    pw1.x = pk2(s[8], s[9]); pw1.y = pk2(s[10], s[11]); pw1.z = pk2(s[12], s[13]); pw1.w = pk2(s[14], s[15]);
    const bf16x8 pb0 = __builtin_bit_cast(bf16x8, pw0), pb1 = __builtin_bit_cast(bf16x8, pw1);
    u32x4 t;
    t.x = a0l.x; t.y = a0l.y; t.z = a0h.x; t.w = a0h.y; const bf16x8 va00 = __builtin_bit_cast(bf16x8, t);
    t.x = a1l.x; t.y = a1l.y; t.z = a1h.x; t.w = a1h.y; const bf16x8 va01 = __builtin_bit_cast(bf16x8, t);
    t.x = b0l.x; t.y = b0l.y; t.z = b0h.x; t.w = b0h.y; const bf16x8 va10 = __builtin_bit_cast(bf16x8, t);
    t.x = b1l.x; t.y = b1l.y; t.z = b1h.x; t.w = b1h.y; const bf16x8 va11 = __builtin_bit_cast(bf16x8, t);
    o0 = __builtin_amdgcn_mfma_f32_32x32x16_bf16(va00, pb0, o0, 0, 0, 0);
    o0 = __builtin_amdgcn_mfma_f32_32x32x16_bf16(va01, pb1, o0, 0, 0, 0);
    o1 = __builtin_amdgcn_mfma_f32_32x32x16_bf16(va10, pb0, o1, 0, 0, 0);
    o1 = __builtin_amdgcn_mfma_f32_32x32x16_bf16(va11, pb1, o1, 0, 0, 0);
}

__device__ __forceinline__ void attn_block_item(CKArgs& A, int l, int MODE, int item, LAS unsigned char* lds, int tid) {
    asm volatile("" : "+v"(tid));
    unsigned char* ws = A.ws;
    const bf16_t* PT = (const bf16_t*)(ws + WS_PT);
    bf16_t* Y = (bf16_t*)(ws + WS_HY);
    const int wave = __builtin_amdgcn_readfirstlane(tid >> 6), lane = tid & 63;
    const int r31 = lane & 31, hh = lane >> 5;
    int b, h, qtok, qi = 0;
    int rp = 0, mg = 0, qg = 0;
    if (MODE == 0) { b = item / 192; const int rem = item % 192; h = rem >> 5; qi = rem & 31; rp = 2 * qi + (wave >> 2); mg = wave & 3;
        qtok = b * SEQ + (2 * rp + (r31 >> 4)) * 64 + 16 * mg + (r31 & 15); }
    else if (MODE == 1) { b = item / 192; const int rem = item % 192; h = rem >> 5; qi = rem & 31; qg = 8 * qi + wave; qtok = b * SEQ + 32 * qg + r31; }
    else { b = item / 6; h = item % 6; qg = wave; qtok = MLAT + b * CTXL + 32 * qg + r31; }
    const bool grpA = (MODE == 0 || MODE == 2);
    const int kvh = grpA ? h : h / 3;
    const int qcol = (grpA ? C_QA : C_QC) + h * 64, gcol = (grpA ? C_GA : C_GC) + h * 64, ycol = (grpA ? 0 : 640) + h * 64;
    const int kh = grpA ? h : 6 + kvh;
    bf16x8 bq[4];
    { const bf16_t* qp = PT + (size_t)qtok * NTM + qcol + 8 * hh;
#pragma unroll
      for (int s = 0; s < 4; ++s) bq[s] = *(const bf16x8*)(qp + 16 * s); }
    f32x16 o0, o1;
#pragma unroll
    for (int i = 0; i < 16; ++i) { o0[i] = 0.f; o1[i] = 0.f; }
    float m_run = -1e30f, l_run = 0.f;
    if (!grpA) { m_run = A.sink[l * 6 + h] * LOG2E; l_run = hh == 0 ? 1.0f : 0.f; }
    int wrow0 = 0, nwin = 0;
    if (MODE == 0) { const int a0 = min(max(4 * qi - 4, 0), 120), a1 = min(max(4 * qi - 1, 0), 120) + 7; wrow0 = a0; nwin = a1 - a0 + 1; }
    if (MODE == 1) { const int k0 = max(4 * qi - 2, 0), k1 = min(4 * qi + 5, 127); wrow0 = k0; nwin = k1 - k0 + 1; }
    const int nsteps = 4 + nwin;
    int ra = 0, rb = -1, cs = 0, rq = 0, jq = 0, r0 = 0, cmin = 0;
    LAS const float* btab = (LAS const float*)(lds + 131072 + 2048);
    if (MODE == 0) { ra = min(max(2 * rp - 4, 0), 120); rb = min(max(2 * rp - 3, 0), 120) + 7; cs = min(max(16 * mg - 8, 0), 32);
        rq = 2 * rp + (r31 >> 4); jq = 16 * mg + (r31 & 15); r0 = min(max(rq - 4, 0), 120); cmin = min(max(jq - 8, 0), 48) - cs;
        }
    const int lr = tid >> 3, lc = tid & 7;
    const bf16_t* kg = (const bf16_t*)(ws + WS_KH) + (size_t)kh * MTOT * 64 + 8 * tid;
    const bf16_t* vg = (const bf16_t*)(ws + WS_VT) + (size_t)kh * NTB * 4096 + 8 * tid;
    const int kdst = lr * 128 + 16 * (lc ^ ((lr >> 1) & 7));
    const int vdst0 = 8192 + lr * 128 + 8 * ((2 * lc) ^ ((lr >> 1) & 15)), vdst1 = 8192 + lr * 128 + 8 * ((2 * lc + 1) ^ ((lr >> 1) & 15));
#define ROW_TOK(i) ((i) < 4 ? MLAT + b * CTXL + 64 * (i) : b * SEQ + 64 * (wrow0 + (i) - 4))
#define LOAD_ROW(i, kr_, vr_) do { const int t0_ = ROW_TOK(i); kr_ = *(const u32x4*)(kg + (size_t)t0_ * 64); vr_ = *(const u32x4*)(vg + (size_t)t0_ * 64); } while (0)
#define WRITE_ROW(sl_, kr_, vr_) do { *(LAS u32x4*)((sl_) + kdst) = kr_; u32x2 w_; w_.x = vr_.x; w_.y = vr_.y; *(LAS u32x2*)((sl_) + vdst0) = w_; w_.x = vr_.z; w_.y = vr_.w; *(LAS u32x2*)((sl_) + vdst1) = w_; } while (0)
    u32x4 k0, v0, k1, v1, k2, v2;
    LOAD_ROW(0, k0, v0); LOAD_ROW(1, k1, v1); LOAD_ROW(2, k2, v2);
    __syncthreads();
    if (MODE == 0 && tid < 465) ((LAS float*)(lds + 131072 + 2048))[tid] = A.na_rpb[(size_t)(l * 6 + h) * 465 + tid];
    WRITE_ROW(lds, k0, v0);
    __syncthreads();
#define ATT_STEP(i_, kL, vL, kW, vW) do { const int i = (i_); if (i < nsteps) { \
        LAS const unsigned char* slot = lds + (i & 1) * 16384; \
        { const int ir_ = min(i + 3, nsteps - 1); LOAD_ROW(ir_, kL, vL); }     \
        _Pragma("unroll 1") for (int hb = 0; hb < 2; ++hb) { \
            bool act = false, ub = false; int tcs = 32 * hb, clo = 0, chi = 31, bidx = 0; \
            if (i < 4) act = true; \
            else if (MODE == 0) { const int a = wrow0 + i - 4; act = (hb == 0) && (a >= ra) && (a <= rb); const bool rowok = (a >= r0) && (a < r0 + 8); \
                tcs = cs; clo = rowok ? cmin : 1; chi = rowok ? cmin + 15 : 0; ub = true; bidx = (a - rq + 7) * 31 + (cs - jq + 15); } \
            else if (MODE == 1) { const int rel = (64 * (wrow0 + i - 4) + 32 * hb - (32 * qg - 128)) >> 5;    \
                act = (rel >= 0) && (rel <= 8); clo = rel == 0 ? r31 : 0; chi = rel == 8 ? r31 : 31; } \
            if (act) attn_tile(slot, tcs, bq, o0, o1, m_run, l_run, r31, hh, clo, chi, ub, btab, bidx); \
        } \
        if (i + 1 < nsteps) { LAS unsigned char* nslot = lds + ((i + 1) & 1) * 16384; WRITE_ROW(nslot, kW, vW); } \
        __syncthreads(); } } while (0)
#pragma unroll 1
    for (int i3 = 0; i3 < nsteps; i3 += 3) {
        ATT_STEP(i3, k0, v0, k1, v1);
        ATT_STEP(i3 + 1, k1, v1, k2, v2);
        ATT_STEP(i3 + 2, k2, v2, k0, v0);
    }
#undef ATT_STEP
#undef LOAD_ROW
#undef WRITE_ROW
    const float ltot = l_run + lane_xor(l_run, lane, 32);
    const float inv = 1.0f / ltot;
    const bf16_t* gp = PT + (size_t)qtok * NTM + gcol + 4 * hh;
    bf16_t* yp = Y + (size_t)qtok * DM + ycol + 4 * hh;
#pragma unroll
    for (int db = 0; db < 2; ++db)
#pragma unroll
        for (int g4 = 0; g4 < 4; ++g4) {
            const int d0 = 32 * db + 8 * g4;
            const u32x2 gw = *(const u32x2*)(gp + d0);
            float v0, v1, v2, v3;
            if (db == 0) { v0 = o0[4 * g4]; v1 = o0[4 * g4 + 1]; v2 = o0[4 * g4 + 2]; v3 = o0[4 * g4 + 3]; }
            else { v0 = o1[4 * g4]; v1 = o1[4 * g4 + 1]; v2 = o1[4 * g4 + 2]; v3 = o1[4 * g4 + 3]; }
            v0 *= inv * silu_f(bflo(gw.x)); v1 *= inv * silu_f(bfhi(gw.x)); v2 *= inv * silu_f(bflo(gw.y)); v3 *= inv * silu_f(bfhi(gw.y));
            u32x2 o; o.x = pk2(v0, v1); o.y = pk2(v2, v3);
            *(u32x2*)(yp + d0) = o;
        }
}

typedef float cf2 __attribute__((ext_vector_type(2)));
__device__ __forceinline__ cf2 mk2(float x, float y) { cf2 r; r.x = x; r.y = y; return r; }
__device__ __forceinline__ cf2 cmul(cf2 a, cf2 b) { return mk2(a.x * b.x - a.y * b.y, a.x * b.y + a.y * b.x); }
__device__ __forceinline__ void fft_fwd(LAS cf2* buf, int tid) {
#pragma unroll 1
    for (int p = 0; p < 7; ++p) {
        const int ls = 12 - 2 * p, s = 1 << ls;
        const float rs = 1.0f / (float)(4 * s);
#pragma unroll 2
        for (int k = 0; k < 8; ++k) {
            const int bf = tid + 512 * k, i = bf & (s - 1), base = ((bf >> ls) << (ls + 2)) + i;
            const cf2 x0 = buf[base], x1 = buf[base + s], x2 = buf[base + 2 * s], x3 = buf[base + 3 * s];
            const float a = (float)i * rs;
            const cf2 w1 = mk2(__builtin_amdgcn_cosf(a), -__builtin_amdgcn_sinf(a));
            const cf2 w2 = cmul(w1, w1), w3 = cmul(w2, w1);
            const cf2 s02 = mk2(x0.x + x2.x, x0.y + x2.y), d02 = mk2(x0.x - x2.x, x0.y - x2.y);
            const cf2 s13 = mk2(x1.x + x3.x, x1.y + x3.y), d13 = mk2(x1.x - x3.x, x1.y - x3.y);
            buf[base] = mk2(s02.x + s13.x, s02.y + s13.y);
            buf[base + s] = cmul(mk2(s02.x - s13.x, s02.y - s13.y), w2);
            buf[base + 2 * s] = cmul(mk2(d02.x + d13.y, d02.y - d13.x), w1);
            buf[base + 3 * s] = cmul(mk2(d02.x - d13.y, d02.y + d13.x), w3);
        }
        __syncthreads();
    }
}
__device__ __forceinline__ void fft_inv(LAS cf2* buf, int tid) {
#pragma unroll 1
    for (int p = 0; p < 7; ++p) {
        const int ls = 2 * p, s = 1 << ls;
        const float rs = 1.0f / (float)(4 * s);
#pragma unroll 2
        for (int k = 0; k < 8; ++k) {
            const int bf = tid + 512 * k, i = bf & (s - 1), base = ((bf >> ls) << (ls + 2)) + i;
            const cf2 v0 = buf[base], v1 = buf[base + s], v2 = buf[base + 2 * s], v3 = buf[base + 3 * s];
            const float a = (float)i * rs;
            const cf2 w1 = mk2(__builtin_amdgcn_cosf(a), __builtin_amdgcn_sinf(a));
            const cf2 w2 = cmul(w1, w1);
            const cf2 bb = cmul(v1, w2), dd = cmul(v3, w2);
            const cf2 u0 = mk2(v0.x + bb.x, v0.y + bb.y), u1 = mk2(v0.x - bb.x, v0.y - bb.y);
            const cf2 u2 = mk2(v2.x + dd.x, v2.y + dd.y), u3 = mk2(v2.x - dd.x, v2.y - dd.y);
            const cf2 e = cmul(u2, w1), f0 = cmul(u3, w1);
            const cf2 f = mk2(-f0.y, f0.x);
            buf[base] = mk2(u0.x + e.x, u0.y + e.y); buf[base + 2 * s] = mk2(u0.x - e.x, u0.y - e.y);
            buf[base + s] = mk2(u1.x + f.x, u1.y + f.y); buf[base + 3 * s] = mk2(u1.x - f.x, u1.y - f.y);
        }
        __syncthreads();
    }
}
__device__ __forceinline__ float hy_short(const bf16_t* prow, int tb, int t, int L, float w0, float w1, float w2, float bias) {
    const float pm = t > 0 ? bf2f(prow[tb + t - 1]) : 0.f;
    const float pc = bf2f(prow[tb + t]);
    const float pp = t < L - 1 ? bf2f(prow[tb + t + 1]) : 0.f;
    return w0 * pm + w1 * pc + w2 * pp + bias;
}
__device__ __forceinline__ float block_sum(float v, LAS float* red, int tid) {
    v = wave_sum(v, tid & 63);
    __syncthreads();
    if ((tid & 63) == 0) red[tid >> 6] = v;
    __syncthreads();
    float s = 0.f;
#pragma unroll
    for (int w = 0; w < 8; ++w) s += red[w];
    return s;
}

__device__ __forceinline__ void hyena_block(CKArgs& A, int l, int c, LAS unsigned char* lds, int tid) {
    asm volatile("" : "+v"(tid));
    unsigned char* ws = A.ws;
    LAS cf2* buf = (LAS cf2*)lds;
    LAS float* fs = (LAS float*)lds;
    LAS float* aux = (LAS float*)(lds + 131072);
    LAS float* red = aux + 256;
    const bf16_t* PCT = (const bf16_t*)(ws + WS_PCT);
    bf16_t* YBT = (bf16_t*)(ws + WS_YBT);
    const bf16_t* rowz = PCT + (size_t)(R_HZ + c) * MTOT;
    const bf16_t* rowx1 = rowz + (size_t)256 * MTOT;
    const bf16_t* rowx2 = rowz + (size_t)512 * MTOT;
    const bf16_t* rowg = PCT + (size_t)(R_GB + c) * MTOT;
    const float* cw = A.hy_conv_w + (size_t)l * 3 * 768; const float* cb = A.hy_conv_b + (size_t)l * 768;
    const float wz0 = cw[c], wz1 = cw[768 + c], wz2 = cw[1536 + c], bz = cb[c];
    const float wa0 = cw[256 + c], wa1 = cw[768 + 256 + c], wa2 = cw[1536 + 256 + c], ba = cb[256 + c];
    const float wb0 = cw[512 + c], wb1 = cw[768 + 512 + c], wb2 = cw[1536 + 512 + c], bb = cb[512 + c];
    const float d0 = A.hy_d[(l * 2 + 0) * 256 + c], d1 = A.hy_d[(l * 2 + 1) * 256 + c];
    const float dmin = -3.0701134573253945f, dmax = -15.350567286626973f;
    const float delta = fabsf(dmin + (float)c * ((dmax - dmin) / 255.0f));
    __syncthreads();
    if (tid < 256) { const int k = tid >> 6, j = tid & 63; aux[tid] = A.hy_w3[((size_t)l * 64 + j) * 1024 + k * 256 + c]; }
    __syncthreads();

    if (l < DEPTH - 1) {
        float ss0 = 0.f, ss1 = 0.f;
        if (tid < 256) {
            const int n = tid; const f32x4* hr = (const f32x4*)((const float*)(ws + WS_H2C) + ((size_t)l * CTXL + n) * 64);
            float f0 = 0.f, f1 = 0.f, b0 = 0.f, b1 = 0.f;
#pragma unroll 1
            for (int j4 = 0; j4 < 16; ++j4) { const f32x4 hv = hr[j4];
#pragma unroll
                for (int e = 0; e < 4; ++e) { const float hvv = hv[e]; const int j = 4 * j4 + e; f0 += hvv * aux[j]; f1 += hvv * aux[64 + j]; b0 += hvv * aux[128 + j]; b1 += hvv * aux[192 + j]; } }
            const float e = __expf(-((float)n * (1.0f / 255.0f)) * delta);
            f0 *= e; f1 *= e; b0 *= e; b1 *= e;
            fs[n] = f0; fs[256 + n] = f1; fs[512 + n] = b0; fs[768 + n] = b1;
            ss0 = f0 * f0 + (n >= 1 ? b0 * b0 : 0.f); ss1 = f1 * f1 + (n >= 1 ? b1 * b1 : 0.f);
        }
        const int b = tid >> 8, t = tid & 255, tok = MLAT + b * CTXL;
        const float z = hy_short(rowz, tok, t, CTXL, wz0, wz1, wz2, bz);
        const float x1 = hy_short(rowx1, tok, t, CTXL, wa0, wa1, wa2, ba);
        const float x2 = hy_short(rowx2, tok, t, CTXL, wb0, wb1, wb2, bb);
        const float gb = bf2f(rowg[tok + t]);
        fs[1024 + tid] = z;
        const float n0 = rsqrtf(block_sum(ss0, red, tid) + 1e-6f);
        const float n1 = rsqrtf(block_sum(ss1, red, tid) + 1e-6f);
        __syncthreads();
        float y = 0.f;
#pragma unroll 4
        for (int s = 0; s < 256; ++s) { const int d = t - s; const float kv = d >= 0 ? fs[d] : fs[512 - d]; y += fs[1024 + b * 256 + s] * kv; }
        const float z1 = x1 * (y * n0 + d0 * z);
        fs[1536 + tid] = z1;
        __syncthreads();
        float y2 = 0.f;
#pragma unroll 4
        for (int s = 0; s < 256; ++s) { const int d = t - s; const float kv = d >= 0 ? fs[256 + d] : fs[768 - d]; y2 += fs[1536 + b * 256 + s] * kv; }
        const float o = x2 * (y2 * n1 + d1 * z1) * silu_f(gb);
        YBT[(size_t)c * MTOT + tok + t] = (bf16_t)(pk2(o, 0.f) & 0xffffu);
        __syncthreads();
    }

    unsigned* ZK = (unsigned*)(ws + WS_ZS) + (size_t)c * 2 * NFFT;
    const int lane = tid & 63;
    {
        float ss0 = 0.f, ss1 = 0.f;
        const bf16_t* F0 = (const bf16_t*)(ws + WS_FILT) + (size_t)c * SEQ;
#pragma unroll 4
        for (int k = 0; k < 16; ++k) {
            const int n = tid + 512 * k;
            const float e = __expf(-((float)n * (1.0f / 8191.0f)) * delta);
            const float f0 = bf2f(F0[n]) * e, f1 = bf2f(F0[(size_t)256 * SEQ + n]) * e, b0 = bf2f(F0[(size_t)512 * SEQ + n]) * e, b1 = bf2f(F0[(size_t)768 * SEQ + n]) * e;
            buf[n] = mk2(f0, f1); ss0 += f0 * f0; ss1 += f1 * f1;
            if (n >= 1) { buf[NFFT - n] = mk2(b0, b1); ss0 += b0 * b0; ss1 += b1 * b1; }
        }
        if (tid == 0) buf[SEQ] = mk2(0.f, 0.f);
        const float nrm0 = rsqrtf(block_sum(ss0, red, tid) + 1e-6f) * (0.5f / NFFT);
        const float nrm1 = rsqrtf(block_sum(ss1, red, tid) + 1e-6f) * (0.5f / NFFT);
        __syncthreads();
        fft_fwd(buf, tid);
#pragma unroll 4
        for (int k = 0; k < 32; ++k) {
            const int p = tid + 512 * k; const int f = (int)(__brev((unsigned)p) >> 18); const int pp = (int)(__brev((unsigned)((NFFT - f) & (NFFT - 1))) >> 18);
            const cf2 za = buf[p], zb = buf[pp];
            ZK[p] = pk2((za.x + zb.x) * nrm0 + d0 * (1.0f / NFFT), (za.y - zb.y) * nrm0);
            ZK[NFFT + p] = pk2((za.y + zb.y) * nrm1 + d1 * (1.0f / NFFT), -(za.x - zb.x) * nrm1);
        }
        __syncthreads();
    }
    const int wv = __builtin_amdgcn_readfirstlane(tid >> 6), tw0 = wv * 1024 + lane;
#define HY_ROW8(prow_, tb_, kb_, w0_, w1_, w2_, bias_, u_) do { \
        float own_[8]; const int p0_ = wv * 1024 + 64 * (kb_); \
        _Pragma("unroll") for (int k = 0; k < 8; ++k) own_[k] = bf2f((prow_)[(unsigned)((tb_) + p0_ + lane + 64 * k)]); \
        const float ep_ = p0_ > 0 ? bf2f((prow_)[(unsigned)((tb_) + p0_ - 1)]) : 0.f, en_ = p0_ + 512 < SEQ ? bf2f((prow_)[(unsigned)((tb_) + p0_ + 512)]) : 0.f; \
        _Pragma("unroll") for (int k = 0; k < 8; ++k) { const float a_ = lane_prev(own_[k], lane), b_ = lane_next(own_[k], lane); \
            const float pl_ = k > 0 ? rdlane(own_[k > 0 ? k - 1 : 0], 63) : ep_, nl_ = k < 7 ? rdlane(own_[k < 7 ? k + 1 : 7], 0) : en_; \
            const float m_ = lane == 0 ? pl_ : a_, q_ = lane == 63 ? nl_ : b_; (u_)[(kb_) + k] = (w0_) * m_ + (w1_) * own_[k] + (w2_) * q_ + (bias_); } \
        asm volatile("" ::: "memory"); __builtin_amdgcn_sched_barrier(0); } while (0)
#pragma unroll
    for (int hf = 0; hf < 2; ++hf) {
        float ua[16], ub[16];
        HY_ROW8(rowz, 0, 8 * hf, wz0, wz1, wz2, bz, ua);
        HY_ROW8(rowz, SEQ, 8 * hf, wz0, wz1, wz2, bz, ub);
#pragma unroll
        for (int k = 8 * hf; k < 8 * hf + 8; ++k) { const int t = tw0 + 64 * k; buf[t] = mk2(ua[k], ub[k]); buf[SEQ + t] = mk2(0.f, 0.f); }
        __builtin_amdgcn_sched_barrier(0);
    }
    __syncthreads();
    fft_fwd(buf, tid);
#pragma unroll 4
    for (int k = 0; k < 32; ++k) { const int p = tid + 512 * k; const unsigned w = ZK[(unsigned)p]; buf[p] = cmul(buf[p], mk2(bflo(w), bfhi(w))); }
    __syncthreads();
    fft_inv(buf, tid);
#pragma unroll
    for (int hf = 0; hf < 2; ++hf) {
        float xa[16], xb[16];
        HY_ROW8(rowx1, 0, 8 * hf, wa0, wa1, wa2, ba, xa);
        HY_ROW8(rowx1, SEQ, 8 * hf, wa0, wa1, wa2, ba, xb);
#pragma unroll
        for (int k = 8 * hf; k < 8 * hf + 8; ++k) { const int t = tw0 + 64 * k; const cf2 y = buf[t]; buf[t] = mk2(xa[k] * y.x, xb[k] * y.y); buf[SEQ + t] = mk2(0.f, 0.f); }
        __builtin_amdgcn_sched_barrier(0);
    }
    __syncthreads();
    fft_fwd(buf, tid);
#pragma unroll 4
    for (int k = 0; k < 32; ++k) { const int p = tid + 512 * k; const unsigned w = ZK[(unsigned)(NFFT + p)]; buf[p] = cmul(buf[p], mk2(bflo(w), bfhi(w))); }
    __syncthreads();
    fft_inv(buf, tid);
    {
        bf16_t* yrow = YBT + (size_t)c * MTOT;
#pragma unroll
        for (int hf = 0; hf < 2; ++hf) {
            float xa[16], xb[16], ga[8], gb[8];
#pragma unroll
            for (int k = 0; k < 8; ++k) { ga[k] = bf2f(rowg[(unsigned)(tw0 + 64 * (8 * hf + k))]); gb[k] = bf2f(rowg[(unsigned)(SEQ + tw0 + 64 * (8 * hf + k))]); }
            HY_ROW8(rowx2, 0, 8 * hf, wb0, wb1, wb2, bb, xa);
            HY_ROW8(rowx2, SEQ, 8 * hf, wb0, wb1, wb2, bb, xb);
#pragma unroll
            for (int k = 8 * hf; k < 8 * hf + 8; ++k) { const int t = tw0 + 64 * k; const cf2 y = buf[t];
                const float oa = xa[k] * y.x * silu_f(ga[k - 8 * hf]), ob = xb[k] * y.y * silu_f(gb[k - 8 * hf]);
                yrow[(unsigned)t] = (bf16_t)(pk2(oa, 0.f) & 0xffffu); yrow[(unsigned)(SEQ + t)] = (bf16_t)(pk2(ob, 0.f) & 0xffffu); }
            __builtin_amdgcn_sched_barrier(0);
        }
    }
#undef HY_ROW8
    __syncthreads();
}

__device__ __forceinline__ void phase_mix(CKArgs& A, int l, LAS unsigned char* lds, int bid, int nblk, int tid) {
    for (int c = bid; c < 256; c += nblk) hyena_block(A, l, c, lds, tid);
    const int nctx = (l < DEPTH - 1) ? 12 : 0;
    const int nitems = 768 + 2 * nctx;
#pragma unroll 1
    for (int it = bid; it < nitems; it += nblk) {
        int mode, item;
        if (it < 384) { mode = 0; item = it; } else if (it < 768) { mode = 1; item = it - 384; } else if (it < 768 + nctx) { mode = 2; item = it - 768; } else { mode = 3; item = it - 768 - nctx; }
        attn_block_item(A, l, mode, item, lds, tid);
    }
}

__device__ __forceinline__ void phase_tr(CKArgs& A, int l, LAS unsigned char* lds, int bid, int nblk, int tid) {
    const int wave = __builtin_amdgcn_readfirstlane(tid >> 6), lane = tid & 63;
    const int gw = bid * 8 + wave, NGW = nblk * 8;
    unsigned char* ws = A.ws;
    const bf16_t* YBT = (const bf16_t*)(ws + WS_YBT);
    bf16_t* Y = (bf16_t*)(ws + WS_HY);
    LAS bf16_t* scr = (LAS bf16_t*)(lds + wave * 16384);
    const int ntok = (l < DEPTH - 1) ? MTOT : MLAT;
    const int nitems = (ntok / 64) * 4;
#pragma unroll 1
    for (int it = gw; it < nitems; it += NGW) {
        const int tb = (it >> 2) * 64, cb = (it & 3) * 64;
#pragma unroll 8
        for (int i = 0; i < 64; ++i) scr[i * 66 + lane] = YBT[(size_t)(cb + i) * MTOT + tb + lane];
        asm volatile("s_waitcnt lgkmcnt(0)" ::: "memory");
        const int cc = (lane & 7) * 8;
#pragma unroll
        for (int k = 0; k < 8; ++k) {
            const int tq = (lane >> 3) + 8 * k;
            u32x4 o;
            o.x = (unsigned)scr[(cc + 0) * 66 + tq] | ((unsigned)scr[(cc + 1) * 66 + tq] << 16);
            o.y = (unsigned)scr[(cc + 2) * 66 + tq] | ((unsigned)scr[(cc + 3) * 66 + tq] << 16);
            o.z = (unsigned)scr[(cc + 4) * 66 + tq] | ((unsigned)scr[(cc + 5) * 66 + tq] << 16);
            o.w = (unsigned)scr[(cc + 6) * 66 + tq] | ((unsigned)scr[(cc + 7) * 66 + tq] << 16);
            *(u32x4*)(Y + (size_t)(tb + tq) * DM + 384 + cb + cc) = o;
        }
        asm volatile("s_waitcnt lgkmcnt(0)" ::: "memory");
    }
}

__device__ __forceinline__ void phase_final(CKArgs& A, int bid, int nblk, int tid) {
    const int wave = __builtin_amdgcn_readfirstlane(tid >> 6), lane = tid & 63;
    const int gw = bid * 8 + wave, NGW = nblk * 8;
    for (int m = gw; m < MLAT; m += NGW) {
        float* row = A.out + (size_t)m * DM;
        f32x4 xv[4]; float ss = 0.f;
#pragma unroll
        for (int j = 0; j < 4; ++j) { xv[j] = *(const f32x4*)(row + 4 * lane + 256 * j); ss += (xv[j].x * xv[j].x + xv[j].y * xv[j].y) + (xv[j].z * xv[j].z + xv[j].w * xv[j].w); }
        const float rinv = rsqrtf(wave_sum(ss, lane) * (1.0f / DM) + 1e-6f);
#pragma unroll
        for (int j = 0; j < 4; ++j) { const int col = 4 * lane + 256 * j; const f32x4 gv = *(const f32x4*)(A.final_g + col); *(f32x4*)(row + col) = xv[j] * rinv * gv; }
    }
}

#define XB_TMO      128
#define XB_XCNT(j)  (256  + 64 * (j))
#define XB_XSUB(j)  (1280 + 64 * (j))
#define XB_XGEN(j)  (2304 + 64 * (j))
#define XB_TOP      3328
#define XB_TOPGEN   3392
#define XCD_BAR_WORDS 3456
#define XB_SPIN_CAP (1u << 18)

__device__ __forceinline__ unsigned xb_ld(unsigned* p)              { return __hip_atomic_load(p, __ATOMIC_RELAXED, __HIP_MEMORY_SCOPE_AGENT); }
__device__ __forceinline__ unsigned xb_add(unsigned* p, unsigned v) { return __hip_atomic_fetch_add(p, v, __ATOMIC_RELAXED, __HIP_MEMORY_SCOPE_AGENT); }
__device__ __forceinline__ unsigned xb_xcc_id() { return (unsigned)__builtin_amdgcn_s_getreg((3 << 11) | 20) & 0xFu; }
#define XB_SPIN(cond, bar) do { unsigned _sp = 0; while (cond) { __builtin_amdgcn_s_sleep(1); \
    if ((++_sp & 255u) == 0u) { if (xb_ld(&(bar)[XB_TMO])) break; if (_sp > XB_SPIN_CAP) { atomicAdd(&(bar)[XB_TMO], 1u); break; } } } } while (0)

struct XcdBarrier {
    unsigned* bar; unsigned x;
    volatile LAS unsigned* st;
};

__device__ __forceinline__ XcdBarrier xcd_barrier_post(unsigned* bar, volatile LAS unsigned* st) {
    XcdBarrier b; b.bar = bar; b.x = xb_xcc_id(); b.st = st;
    if (threadIdx.x == 0) (void)xb_add(&bar[XB_XCNT(b.x)], 1u);
    return b;
}
__device__ __forceinline__ void xcd_barrier_complete(unsigned* bar, unsigned x, unsigned& nloc, unsigned& nx) {
    const unsigned G = gridDim.x * gridDim.y * gridDim.z;
    unsigned sum, cnt, mine, sp = 0u;
    for (;;) {
        sum = 0u; cnt = 0u; mine = 0u;
#pragma unroll
        for (unsigned j = 0; j < 16; ++j) { const unsigned c = xb_ld(&bar[XB_XCNT(j)]); sum += c; cnt += (c > 0u) ? 1u : 0u; mine = (j == x) ? c : mine; }
        if (sum == G) break;
        __builtin_amdgcn_s_sleep(1);
        if ((++sp & 255u) == 0u) { if (xb_ld(&bar[XB_TMO])) break; if (sp > XB_SPIN_CAP) { atomicAdd(&bar[XB_TMO], 1u); break; } }
    }
    nloc = mine > 0u ? mine : 1u; nx = cnt > 0u ? cnt : 1u;
}

__device__ __forceinline__ void xcd_barrier(const XcdBarrier& b) {
    asm volatile("s_waitcnt vmcnt(0)" ::: "memory");
    __syncthreads();
    if (threadIdx.x == 0) {
        unsigned* bar = b.bar;
        __builtin_amdgcn_s_waitcnt(0);
        unsigned nloc = b.st[0], nx = b.st[1];
        if (nloc == 0u) { xcd_barrier_complete(bar, b.x, nloc, nx); b.st[0] = nloc; b.st[1] = nx; }
        const unsigned old = xb_add(&bar[XB_XSUB(b.x)], 1u);
        const unsigned gen = old / nloc;
        if (old + 1u == (gen + 1u) * nloc) {
            __builtin_amdgcn_fence(__ATOMIC_RELEASE, "agent");
            asm volatile("s_waitcnt vmcnt(0)" ::: "memory");
            const unsigned og = xb_add(&bar[XB_TOP], 1u);
            const unsigned tg = og / nx;
            if (og + 1u == (tg + 1u) * nx) xb_add(&bar[XB_TOPGEN], 1u);
            else XB_SPIN(xb_ld(&bar[XB_TOPGEN]) == tg, bar);
            __builtin_amdgcn_fence(__ATOMIC_ACQUIRE, "agent");
            xb_add(&bar[XB_XGEN(b.x)], 1u);
            asm volatile("s_waitcnt vmcnt(0)" ::: "memory");
        } else {
            XB_SPIN(xb_ld(&bar[XB_XGEN(b.x)]) == gen, bar);
            __builtin_amdgcn_fence(__ATOMIC_ACQUIRE, "agent");
            asm volatile("s_waitcnt vmcnt(0)" ::: "memory");
        }
    }
    __syncthreads();
}


constexpr int NPHASE = 2 + 5 * DEPTH;
__global__ void __launch_bounds__(NTHREADS, 2) hybrid_fwd(KArgs Aval) {
    extern __shared__ __attribute__((aligned(16))) unsigned char lds_raw[];
    LAS unsigned char* lds = (LAS unsigned char*)lds_raw;
    const int tid0 = threadIdx.x, bid = blockIdx.x, nblk = gridDim.x;
#if !MK_MULTI
    volatile LAS unsigned* bst = (volatile LAS unsigned*)(lds + 131072 + 8192);
    if (tid0 < 2) bst[tid0] = 0u;
    __syncthreads();
    const XcdBarrier bar = xcd_barrier_post((unsigned*)Aval.ws, bst);
#endif
#pragma unroll 1
    for (int ph = Aval.ph_lo; ph < Aval.ph_hi; ++ph) {
#if !MK_MULTI
        if (ph > Aval.ph_lo) { if (ph == Aval.ph_lo + 1) cg::this_grid().sync(); else xcd_barrier(bar); }
#endif
#ifndef ONLY
#define ONLY -1
#endif
#define EN(k) (ONLY < 0 || ((ONLY >> (k)) & 1))
        int tid = tid0; asm volatile("" : "+v"(tid));
        CKArgs* Ap = (CKArgs*)__builtin_amdgcn_kernarg_segment_ptr(); asm volatile("" : "+s"(Ap));
        CKArgs& A = *Ap;
        unsigned char* ws = A.ws;
        if (ph == 0) { if (EN(0)) phase_prologue(A, lds, bid, nblk, tid); }
        else if (ph == NPHASE - 1) { if (EN(6)) phase_final(A, bid, nblk, tid); }
        else {
            const int l = (ph - 1) / 5, k = (ph - 1) % 5;
            if (k == 0) { if (EN(1)) phase_norm(A, l, bid, nblk, tid); }
            else if (k == 2) { if (EN(3)) phase_mix(A, l, lds, bid, nblk, tid); }
            else if (k == 3) { if (EN(4)) phase_tr(A, l, lds, bid, nblk, tid); }
            if (k == 1 || k == 4) {
                pg8::Gemm g; EpiAll E; E.l = l; E.Ap = Ap; g.A = (const bf16_t*)(ws + WS_HY); g.K = DM;
                if (k == 1) { g.Bt = (const bf16_t*)(ws + WS_WIN) + (size_t)l * NIN * DM; g.M = MTOT; g.N = NIN; E.mode = 0; }
                else { g.Bt = (const bf16_t*)(ws + WS_WOUT) + (size_t)l * DM * DM; g.M = (l < DEPTH - 1) ? MTOT : MLAT; g.N = DM; E.mode = 1; }
                pg8::StaticOrder S; S.init(g.M, g.N, nblk, bid);
                if (EN(2)) pg8::gemm_phase<EpiAll, pg8::StaticOrder, true, false>(lds, g, S, E, tid);
            }
        }
    }
}

extern "C" void kernel_launch(void* const* d_in, const int* in_sizes, int n_in, void* d_out, int out_size, void* d_ws, size_t ws_size, hipStream_t stream) {
    static int grid = 0;
    if (grid == 0) {
        if (n_in != 22 || ws_size < WS_END) { fprintf(stderr, "kernel_launch: unexpected inputs (n_in %d, ws %zu)\n", n_in, ws_size); grid = -1; return; }
        int dev = 0, cus = 0, per_cu = 0;
        if (hipGetDevice(&dev) != hipSuccess || hipDeviceGetAttribute(&cus, hipDeviceAttributeMultiprocessorCount, dev) != hipSuccess) { grid = -1; return; }
        if (hipFuncSetAttribute((const void*)hybrid_fwd, hipFuncAttributeMaxDynamicSharedMemorySize, LDS_BYTES) != hipSuccess) { fprintf(stderr, "kernel_launch: hipFuncSetAttribute failed\n"); grid = -1; return; }
        if (hipOccupancyMaxActiveBlocksPerMultiprocessor(&per_cu, (const void*)hybrid_fwd, NTHREADS, LDS_BYTES) != hipSuccess || per_cu < 1) { fprintf(stderr, "kernel_launch: occupancy query says %d\n", per_cu); per_cu = 1; }
        (void)hipGetLastError();
        grid = cus;
    }
    if (grid < 0) return;
    KArgs a{};
    a.x = (const float*)d_in[0]; a.c = (const float*)d_in[1]; a.ctx = (const float*)d_in[2]; a.c_ctx = (const float*)d_in[3]; a.norm_g = (const float*)d_in[4];
    a.w_ada = (const float*)d_in[5]; a.b_ada = (const float*)d_in[6]; a.w_in = (const float*)d_in[7]; a.w_out = (const float*)d_in[8]; a.na_rpb = (const float*)d_in[9];
    a.hy_conv_w = (const float*)d_in[10]; a.hy_conv_b = (const float*)d_in[11]; a.hy_w1 = (const float*)d_in[12]; a.hy_b1 = (const float*)d_in[13]; a.hy_freq1 = (const float*)d_in[14];
    a.hy_w2 = (const float*)d_in[15]; a.hy_b2 = (const float*)d_in[16]; a.hy_freq2 = (const float*)d_in[17]; a.hy_w3 = (const float*)d_in[18]; a.hy_d = (const float*)d_in[19];
    a.sink = (const float*)d_in[20]; a.final_g = (const float*)d_in[21];
    a.out = (float*)d_out; a.ws = (unsigned char*)d_ws;
#if MK_MULTI
    for (int ph = 0; ph < NPHASE; ++ph) {
        a.ph_lo = ph; a.ph_hi = ph + 1;
        hipLaunchKernelGGL(hybrid_fwd, dim3(grid), dim3(NTHREADS), LDS_BYTES, stream, a);
    }
#else
    if (hipMemsetAsync(d_ws, 0, 16384, stream) != hipSuccess) { fprintf(stderr, "kernel_launch: memset of the barrier words failed\n"); return; }
    a.ph_lo = 0; a.ph_hi = NPHASE;
    void* args[] = {&a};
    hipError_t e = hipLaunchCooperativeKernel((const void*)hybrid_fwd, dim3(grid), dim3(NTHREADS), args, LDS_BYTES, stream);
    if (e != hipSuccess) fprintf(stderr, "cooperative launch failed: %s (grid %d)\n", hipGetErrorString(e), grid);
#endif
}
```

```cpp
#include <hip/hip_runtime.h>
#include <hip/hip_cooperative_groups.h>
#include <cstdio>
#include <cstdint>
namespace cg = cooperative_groups;

#ifndef MK_MULTI
#define MK_MULTI 0
#endif

namespace pg8 {
#define PG8_LAS __attribute__((address_space(3)))
typedef unsigned short bf16_t;
typedef short bf16x8 __attribute__((ext_vector_type(8)));
typedef float f32x4 __attribute__((ext_vector_type(4)));
typedef unsigned u32x4 __attribute__((ext_vector_type(4)));
constexpr int BM = 256, BK = 64, HALF = 128, HTB = HALF * BK * 2  , STAGE_BYTES = 8 * HTB, NXCD = 8, WGM = 8;

__host__ __device__ __forceinline__ int lds_byte(int r, int c) { const int st = (r >> 4) * 2 + (c >> 5), rr = r & 15, cc = c & 31, ob = rr * 64 + cc * 2; return st * 1024 + (ob ^ (((ob >> 9) & 1) << 5)); }
__host__ __device__ __forceinline__ void stage_rc(int b, int& R, int& C) { const int st = b / 1024, sb = b % 1024, swz = sb ^ (((sb >> 9) & 1) << 5); R = (st >> 1) * 16 + swz / 64; C = (st & 1) * 32 + (swz % 64) / 2; }
__host__ __device__ __forceinline__ int perm32(int rho) { const int n = rho >> 4, i = rho & 15; return 8 * (i >> 2) + 4 * n + (i & 3); }

struct Unit { int pm, pn; };
struct Gemm { const bf16_t* A; const bf16_t* Bt; int M, N, K; };

struct StaticOrder {
    int nM, nN, nwg, G, c;
    __host__ __device__ void init(int M, int N, int G_, int c_) { nM = M / BM; nN = N / BM; nwg = nM * nN; G = G_; c = c_; }
    __host__ __device__ bool next(int i, Unit& u) const {
        const long L = (long)i * G + c; if (L >= nwg) return false;
        int wgid = (int)L; { const int q = nwg / NXCD, r = nwg % NXCD, xcd = wgid % NXCD, off = wgid / NXCD; wgid = (xcd < r ? xcd * (q + 1) : r * (q + 1) + (xcd - r) * q) + off; }
        const int nig = WGM * nN, gid = wgid / nig, fm = gid * WGM, gsz = (nM - fm) < WGM ? (nM - fm) : WGM;
        u.pm = fm + ((wgid % nig) % gsz); u.pn = (wgid % nig) / gsz; return true;
    }
    __device__ __forceinline__ void a_ready(const Unit&) const {}
    __device__ __forceinline__ void done(const Unit&) const {}
};

template <class Epi, class Sched, bool ALIGN_EPI = false, bool SP2 = false>
__device__ __forceinline__ void gemm_phase(PG8_LAS unsigned char* lds, const Gemm g, const Sched& S, const Epi& E, const int tid) {
    const int wid = __builtin_amdgcn_readfirstlane(tid >> 6), lane = tid & 63, wr = wid >> 2, wc = wid & 3, fr = lane & 15, fq = lane >> 4;
    const int K = g.K, nt = K / BK;
    unsigned voffA[2], voffB[2];
#pragma unroll
    for (int i = 0; i < 2; ++i) { int R, C; stage_rc(tid * 16 + i * 8192, R, C); const int Rb = Epi::PERM ? ((R & ~31) + perm32(R & 31)) : R;
        voffA[i] = (unsigned)(R * K + C) * 2u; voffB[i] = (unsigned)(Rb * K + C) * 2u; }
    const size_t kstep = (size_t)(BK * 2);
    const size_t hstep = (size_t)HALF * K * 2;
    const size_t tstep = 2 * hstep;
    const unsigned ldsw = (unsigned)wid * 1024u;
    const int aoff = lds_byte(wr * 64 + fr, fq * 8), boff = lds_byte(wc * 32 + fr, fq * 8);
#define PG8_SA(b, h) (((b) * 2 + (h)) * HTB)
#define PG8_SB(b, h) ((4 + (b) * 2 + (h)) * HTB)
#define PG8_STAGE(bufoff, gbase, voff) do { _Pragma("unroll") for (int _i = 0; _i < 2; ++_i) \
        __builtin_amdgcn_global_load_lds((const unsigned*)((const char*)(gbase) + (voff)[_i]), (PG8_LAS unsigned*)(lds + (bufoff) + ldsw + _i * 8192), 16, 0, 0); } while (0)
#define PG8_LDA(dst, b, h) do { _Pragma("unroll") for (int m = 0; m < 4; ++m) _Pragma("unroll") for (int k = 0; k < 2; ++k) dst[m][k] = *(const PG8_LAS bf16x8*)(lds + PG8_SA(b, h) + aoff + m * 2048 + k * 1024); } while (0)
#define PG8_LDB(dst, b, h) do { _Pragma("unroll") for (int n = 0; n < 2; ++n) _Pragma("unroll") for (int k = 0; k < 2; ++k) dst[n][k] = *(const PG8_LAS bf16x8*)(lds + PG8_SB(b, h) + boff + n * 2048 + k * 1024); } while (0)
#define PG8_MMA(ai, bj, At, Bt) do { __builtin_amdgcn_s_setprio(1); _Pragma("unroll") for (int m = 0; m < 4; ++m) _Pragma("unroll") for (int n = 0; n < 2; ++n) _Pragma("unroll") for (int k = 0; k < 2; ++k) \
        acc[ai][bj][m][n] = __builtin_amdgcn_mfma_f32_16x16x32_bf16(Bt[n][k], At[m][k], acc[ai][bj][m][n], 0, 0, 0); __builtin_amdgcn_s_setprio(0); } while (0)
#define PG8_WAIT_V(n) asm volatile("s_waitcnt vmcnt(" #n ")" ::: "memory")
#define PG8_WAIT_L(n) asm volatile("s_waitcnt lgkmcnt(" #n ")" ::: "memory")
#define PG8_BAR __builtin_amdgcn_s_barrier()
#define PG8_SCHED __builtin_amdgcn_sched_barrier(0)
    Unit cur, nxt; int ui = 0;
    if (!S.next(0, cur)) return;
    f32x4 acc[2][2][4][2];
#pragma unroll
    for (int a = 0; a < 2; ++a)
#pragma unroll
        for (int b = 0; b < 2; ++b)
#pragma unroll
            for (int m = 0; m < 4; ++m)
#pragma unroll
                for (int n = 0; n < 2; ++n) acc[a][b][m][n] = (f32x4){0.f, 0.f, 0.f, 0.f};
    bf16x8 At[4][2], B0[2][2], B1[2][2];
    const char* cA = (const char*)g.A + (size_t)cur.pm * tstep; const char* cB = (const char*)g.Bt + (size_t)cur.pn * tstep;
    S.a_ready(cur);
    if constexpr (SP2) {
        PG8_STAGE(PG8_SB(0, 0), cB, voffB); PG8_STAGE(PG8_SB(0, 1), cB + hstep, voffB); PG8_STAGE(PG8_SA(0, 0), cA, voffA); PG8_STAGE(PG8_SA(0, 1), cA + hstep, voffA);
        if (wr == 1) PG8_BAR;
        PG8_WAIT_V(2); PG8_BAR;
        PG8_STAGE(PG8_SB(1, 0), cB + kstep, voffB); PG8_STAGE(PG8_SA(1, 0), cA + kstep, voffA); PG8_STAGE(PG8_SB(1, 1), cB + hstep + kstep, voffB);
        PG8_WAIT_V(6); PG8_BAR;
    } else {
        PG8_STAGE(PG8_SB(0, 0), cB, voffB); PG8_STAGE(PG8_SA(0, 0), cA, voffA); PG8_STAGE(PG8_SB(0, 1), cB + hstep, voffB); PG8_STAGE(PG8_SA(0, 1), cA + hstep, voffA);
        if (wr == 1) PG8_BAR;
        PG8_WAIT_V(4); PG8_BAR;
        PG8_STAGE(PG8_SB(1, 0), cB + kstep, voffB); PG8_STAGE(PG8_SA(1, 0), cA + kstep, voffA); PG8_STAGE(PG8_SB(1, 1), cB + hstep + kstep, voffB);
        PG8_WAIT_V(6); PG8_BAR;
    }
    for (;;) {
        const bool has_next = S.next(ui + 1, nxt);
        const char* nA = has_next ? (const char*)g.A + (size_t)nxt.pm * tstep : cA; const char* nB = has_next ? (const char*)g.Bt + (size_t)nxt.pn * tstep : cB;
        for (int t = 0; t < nt; t += 2) {
            const bool last = (t == nt - 2);
            const char* a1 = cA + (size_t)(t + 1) * kstep;
            const char* a2 = last ? nA : cA + (size_t)(t + 2) * kstep; const char* b2 = last ? nB : cB + (size_t)(t + 2) * kstep;
            const char* a3 = a2 + kstep; const char* b3 = b2 + kstep;
            if (last && has_next) S.a_ready(nxt);
            if constexpr (SP2) {
            PG8_LDB(B0, 0, 0); PG8_LDB(B1, 0, 1); PG8_SCHED; PG8_LDA(At, 0, 0); PG8_STAGE(PG8_SA(1, 1), a1 + hstep, voffA);
            PG8_WAIT_V(8); PG8_WAIT_L(0); PG8_BAR; PG8_MMA(0, 0, At, B0); PG8_MMA(0, 1, At, B1); PG8_BAR; PG8_SCHED;
            PG8_LDA(At, 0, 1); PG8_STAGE(PG8_SB(0, 0), b2, voffB); PG8_STAGE(PG8_SB(0, 1), b2 + hstep, voffB); PG8_STAGE(PG8_SA(0, 0), a2, voffA);
            PG8_WAIT_V(8); PG8_WAIT_L(0); PG8_BAR; PG8_MMA(1, 0, At, B0); PG8_MMA(1, 1, At, B1); PG8_BAR; PG8_SCHED;
            PG8_LDB(B0, 1, 0); PG8_LDB(B1, 1, 1); PG8_SCHED; PG8_LDA(At, 1, 0); PG8_STAGE(PG8_SA(0, 1), a2 + hstep, voffA);
            PG8_WAIT_V(8); PG8_WAIT_L(0); PG8_BAR; PG8_MMA(0, 0, At, B0); PG8_MMA(0, 1, At, B1); PG8_BAR; PG8_SCHED;
            PG8_LDA(At, 1, 1); PG8_STAGE(PG8_SB(1, 0), b3, voffB); PG8_STAGE(PG8_SB(1, 1), b3 + hstep, voffB); PG8_STAGE(PG8_SA(1, 0), a3, voffA);
            PG8_WAIT_V(8); PG8_WAIT_L(0); PG8_BAR; PG8_MMA(1, 0, At, B0); PG8_MMA(1, 1, At, B1); PG8_BAR; PG8_SCHED;
            } else {
            PG8_LDB(B0, 0, 0); PG8_SCHED; PG8_LDA(At, 0, 0); PG8_STAGE(PG8_SA(1, 1), a1 + hstep, voffA);
            PG8_WAIT_L(8); PG8_BAR; PG8_WAIT_L(0); PG8_MMA(0, 0, At, B0); PG8_BAR; PG8_SCHED;
            PG8_LDB(B1, 0, 1); PG8_STAGE(PG8_SB(0, 0), b2, voffB);
            PG8_BAR; PG8_WAIT_L(0); PG8_MMA(0, 1, At, B1); PG8_BAR;
            PG8_LDA(At, 0, 1); PG8_STAGE(PG8_SA(0, 0), a2, voffA);
            PG8_BAR; PG8_WAIT_L(0); PG8_MMA(1, 0, At, B0); PG8_BAR; PG8_SCHED;
            PG8_STAGE(PG8_SB(0, 1), b2 + hstep, voffB);
            PG8_WAIT_V(6); PG8_BAR; PG8_MMA(1, 1, At, B1); PG8_BAR;
            PG8_LDB(B0, 1, 0); PG8_SCHED; PG8_LDA(At, 1, 0); PG8_STAGE(PG8_SA(0, 1), a2 + hstep, voffA);
            PG8_WAIT_L(8); PG8_BAR; PG8_WAIT_L(0); PG8_MMA(0, 0, At, B0); PG8_BAR; PG8_SCHED;
            PG8_LDB(B1, 1, 1); PG8_STAGE(PG8_SB(1, 0), b3, voffB);
            PG8_BAR; PG8_WAIT_L(0); PG8_MMA(0, 1, At, B1); PG8_BAR;
            PG8_LDA(At, 1, 1); PG8_STAGE(PG8_SA(1, 0), a3, voffA);
            PG8_BAR; PG8_WAIT_L(0); PG8_MMA(1, 0, At, B0); PG8_BAR; PG8_SCHED;
            PG8_STAGE(PG8_SB(1, 1), b3 + hstep, voffB);
            PG8_WAIT_V(6); PG8_BAR; PG8_MMA(1, 1, At, B1); PG8_BAR;
            }
        }
        if constexpr (ALIGN_EPI) { if (wr == 0) PG8_BAR; }
        if constexpr (!Epi::AFTER_DRAIN) { E(acc, cur, wr, wc, fr, fq); S.done(cur); }
        if (!has_next) break;
#pragma unroll
        for (int a = 0; a < 2; ++a)
#pragma unroll
            for (int b = 0; b < 2; ++b)
#pragma unroll
                for (int m = 0; m < 4; ++m)
#pragma unroll
                    for (int n = 0; n < 2; ++n) acc[a][b][m][n] = (f32x4){0.f, 0.f, 0.f, 0.f};
        cur = nxt; cA = nA; cB = nB; ++ui;
        if constexpr (ALIGN_EPI) { if (wr == 1) PG8_BAR; }
    }
    PG8_WAIT_V(0);
    if constexpr (!ALIGN_EPI) { if (wr == 0) PG8_BAR; }
    PG8_BAR;
    if constexpr (Epi::AFTER_DRAIN) { E.fused(acc, cur, wr, wc, fr, fq, lds, wid, lane); S.done(cur); }
#undef PG8_SA
#undef PG8_SB
#undef PG8_STAGE
#undef PG8_LDA
#undef PG8_LDB
#undef PG8_MMA
#undef PG8_WAIT_V
#undef PG8_WAIT_L
#undef PG8_BAR
#undef PG8_SCHED
}
}

#define LAS __attribute__((address_space(3)))
typedef unsigned short bf16_t;
typedef short bf16x8 __attribute__((ext_vector_type(8)));
typedef float f32x4 __attribute__((ext_vector_type(4)));
typedef float f32x16 __attribute__((ext_vector_type(16)));
typedef unsigned u32x2 __attribute__((ext_vector_type(2)));
typedef unsigned u32x4 __attribute__((ext_vector_type(4)));
typedef float f32x2_t __attribute__((ext_vector_type(2)));
typedef __bf16 bf16x2_t __attribute__((ext_vector_type(2)));

constexpr int DM = 1024, NBATCH = 2, SEQ = 8192, DEPTH = 4, CTXL = 256;
constexpr int MLAT = NBATCH * SEQ, MCTX = NBATCH * CTXL, MTOT = MLAT + MCTX;
constexpr int NIN = 3584, NTM = 1536, NCM = 1024, NTB = MTOT / 64;
constexpr int C_QA = 0, C_GA = 384, C_QC = 768, C_GC = 1152;
constexpr int R_HZ = 0, R_GB = 768;
constexpr int NFFT = 16384;
constexpr float LOG2E = 1.4426950408889634f;
constexpr float QK_SCALE = 0.125f * LOG2E;

constexpr size_t MiB = 1u << 20;
constexpr size_t WS_ADA = 1 * MiB;
constexpr size_t WS_ROPE = 1 * MiB + 256 * 1024;
constexpr size_t WS_H2C = 1 * MiB + 512 * 1024;
constexpr size_t WS_CX = 2 * MiB;
constexpr size_t WS_H2 = 4 * MiB;
constexpr size_t WS_WIN = 12 * MiB;
constexpr size_t WS_WOUT = 40 * MiB;
constexpr size_t WS_HY = 48 * MiB;
constexpr size_t WS_PT = 81 * MiB;
constexpr size_t WS_KH = 130 * MiB + 512 * 1024;
constexpr size_t WS_VT = 147 * MiB;
constexpr size_t WS_PCT = 163 * MiB + 512 * 1024;
constexpr size_t WS_YBT = 197 * MiB;
constexpr size_t WS_ZS = 206 * MiB;
constexpr size_t WS_W3T = 238 * MiB;
constexpr size_t WS_FILT = 239 * MiB;
constexpr size_t WS_END = 255 * MiB;
static_assert(WS_PT + (size_t)MTOT * NTM * 2 <= WS_KH && WS_KH + (size_t)8 * MTOT * 128 <= WS_VT && WS_VT + (size_t)8 * MTOT * 128 <= WS_PCT && WS_PCT + (size_t)NCM * MTOT * 2 <= WS_YBT, "d_ws map");

constexpr int AUX_OFF = 147456;
constexpr int LDS_BYTES = 163840;
constexpr int NTHREADS = 512;

struct KArgs {
    const float* x; const float* c; const float* ctx; const float* c_ctx; const float* norm_g; const float* w_ada; const float* b_ada;
    const float* w_in; const float* w_out; const float* na_rpb; const float* hy_conv_w; const float* hy_conv_b;
    const float* hy_w1; const float* hy_b1; const float* hy_freq1; const float* hy_w2; const float* hy_b2; const float* hy_freq2; const float* hy_w3;
    const float* hy_d; const float* sink; const float* final_g;
    float* out; unsigned char* ws;
    int ph_lo, ph_hi;
};

typedef const __attribute__((address_space(4))) KArgs CKArgs;
__device__ __forceinline__ unsigned pk2(float lo, float hi) { f32x2_t v = {lo, hi}; bf16x2_t b = __builtin_convertvector(v, bf16x2_t); return __builtin_bit_cast(unsigned, b); }
__device__ __forceinline__ float bf2f(unsigned short u) { return __uint_as_float(((unsigned)u) << 16); }
__device__ __forceinline__ float bflo(unsigned w) { return __uint_as_float(w << 16); }
__device__ __forceinline__ float bfhi(unsigned w) { return __uint_as_float(w & 0xffff0000u); }
__device__ __forceinline__ float silu_f(float x) { return x / (1.0f + __expf(-x)); }
__device__ __forceinline__ float lane_xor(float v, int lane, int m) { return __int_as_float(__builtin_amdgcn_ds_bpermute((lane ^ m) << 2, __float_as_int(v))); }
__device__ __forceinline__ float lane_prev(float v, int lane) { return __int_as_float(__builtin_amdgcn_ds_bpermute(((lane - 1) & 63) << 2, __float_as_int(v))); }
__device__ __forceinline__ float lane_next(float v, int lane) { return __int_as_float(__builtin_amdgcn_ds_bpermute(((lane + 1) & 63) << 2, __float_as_int(v))); }
__device__ __forceinline__ float wave_sum(float v, int lane) {
#pragma unroll
    for (int o = 1; o < 64; o <<= 1) v += lane_xor(v, lane, o);
    return v;
}
__device__ __forceinline__ float rdlane(float v, int l) { return __uint_as_float(__builtin_amdgcn_readlane(__float_as_uint(v), l)); }

__device__ __forceinline__ void transpose_item(const float* W, int K, int N, bf16_t* WT, int k0, int n0, int drow0, LAS float* scr, int lane, int ldk = 0) {
    if (ldk == 0) ldk = K;
#pragma unroll 8
    for (int i = 0; i < 32; ++i) { const int kk = 2 * i + (lane >> 5); scr[kk * 33 + (lane & 31)] = W[(size_t)(k0 + kk) * N + n0 + (lane & 31)]; }
    asm volatile("s_waitcnt lgkmcnt(0)" ::: "memory");
    const int c = lane & 7;
#pragma unroll
    for (int j = 0; j < 4; ++j) { const int n = (lane >> 3) + 8 * j; const LAS float* s = scr + (8 * c) * 33 + n;
        u32x4 o; o.x = pk2(s[0 * 33], s[1 * 33]); o.y = pk2(s[2 * 33], s[3 * 33]); o.z = pk2(s[4 * 33], s[5 * 33]); o.w = pk2(s[6 * 33], s[7 * 33]);
        *(u32x4*)(WT + (size_t)(drow0 + n) * ldk + k0 + 8 * c) = o; }
    asm volatile("s_waitcnt lgkmcnt(0)" ::: "memory");
}
__device__ __forceinline__ int win_row(int n0) {
    if (n0 < 384) return n0;
    if (n0 < 768) return n0 - 384 + 1536;
    if (n0 < 1152) return n0 - 768 + 2048;
    if (n0 < 1536) return n0 - 1152 + 384;
    if (n0 < 2304) return n0 - 1536 + 2560;
    if (n0 < 2560) return n0 - 2304 + 3328;
    if (n0 < 2944) return n0 - 2560 + 768;
    if (n0 < 3072) return n0 - 2944 + 1920;
    if (n0 < 3200) return n0 - 3072 + 2432;
    return n0 - 3200 + 1152;
}

__device__ __forceinline__ void phase_prologue(CKArgs& A, LAS unsigned char* lds, int bid, int nblk, int tid) {
    const int wave = __builtin_amdgcn_readfirstlane(tid >> 6), lane = tid & 63;
    const int gw = bid * 8 + wave, NGW = nblk * 8;
    unsigned char* ws = A.ws;
    {
        LAS float* scr = (LAS float*)(lds + wave * 16384);
        constexpr int I_IN = 16 * 112, I_OUT = 16 * 32, I_L = I_IN + I_OUT;
        for (int it = gw; it < DEPTH * I_L; it += NGW) {
            const int l = it / I_L; int r = it % I_L;
            if (r < I_IN) { const int kb = r / 112, nb = r % 112, n0 = nb * 32;
                transpose_item(A.w_in + (size_t)l * DM * NIN, DM, NIN, (bf16_t*)(ws + WS_WIN) + (size_t)l * NIN * DM, kb * 64, n0, win_row(n0), scr, lane); }
            else { r -= I_IN; const int kb = r / 32, nb = r % 32, n0 = nb * 32;
                transpose_item(A.w_out + (size_t)l * DM * DM, DM, DM, (bf16_t*)(ws + WS_WOUT) + (size_t)l * DM * DM, kb * 64, n0, n0, scr, lane); }
        }
    }
    {
        LAS float* scr = (LAS float*)(lds + wave * 16384);
        bf16_t* W3T = (bf16_t*)(ws + WS_W3T);
        for (int it = gw; it < DEPTH * 32; it += NGW) { const int l = it >> 5, nb = it & 31;
            transpose_item(A.hy_w3 + (size_t)l * 64 * 1024, 64, 1024, W3T + (size_t)l * 1024 * 64, 0, nb * 32, nb * 32, scr, lane); }
    }
    for (int idx = gw * 64 + lane; idx < 128 * 16; idx += NGW * 64) {
        const int p = idx >> 4, i = idx & 15;
        const float inv = powf(10000.0f, -(float)i / 16.0f);
        const float ang = (float)p * inv;
        ((float2*)(ws + WS_ROPE))[idx] = make_float2(cosf(ang), sinf(ang));
    }
    for (int it = gw; it < DEPTH * 528; it += NGW) {
        const int l = it / 528, g4 = it % 528, g = g4 >> 2, sub = g4 & 3;
        const int L = g < 128 ? SEQ : CTXL;
        const int n0 = (g < 128 ? g * 64 : (g - 128) * 64) + 16 * sub;
        float* outp = (float*)(ws + WS_H2C) + ((size_t)l * CTXL + n0) * 64;
        bf16_t* outb = (bf16_t*)(ws + WS_H2) + ((size_t)l * SEQ + n0) * 64;
        float w1c[33], w2c[64];
#pragma unroll
        for (int q = 0; q < 33; ++q) w1c[q] = A.hy_w1[((size_t)l * 33 + q) * 64 + lane];
#pragma unroll
        for (int j = 0; j < 64; ++j) w2c[j] = A.hy_w2[((size_t)l * 64 + j) * 64 + lane];
        const float b1 = A.hy_b1[l * 64 + lane], fr1 = A.hy_freq1[l * 64 + lane], b2 = A.hy_b2[l * 64 + lane], fr2 = A.hy_freq2[l * 64 + lane];
        const float tstep = 1.0f / (float)(L - 1), wstep = 6.283185307179586f / (float)L;
        const int fj = lane == 0 ? 0 : ((lane - 1) & 15);
        const float fq = 1e-4f + (float)fj * ((15.0f - 1e-4f) / 15.0f);
#pragma unroll 1
        for (int nn = 0; nn < 16; ++nn) {
            const int n = n0 + nn;
            const float t = (float)n * tstep, wa = (float)n * wstep;
            float zq;
            if (lane == 0) zq = t; else if (lane <= 16) zq = cosf(fq * wa); else if (lane <= 32) zq = -sinf(fq * wa); else zq = 0.f;
            float a1 = b1;
#pragma unroll
            for (int q = 0; q < 33; ++q) a1 += rdlane(zq, q) * w1c[q];
            const float h1 = sinf(fr1 * a1);
            float a2 = b2;
#pragma unroll
            for (int j = 0; j < 64; ++j) a2 += rdlane(h1, j) * w2c[j];
            const float h2 = sinf(fr2 * a2);
            if (g < 128) outb[nn * 64 + lane] = (bf16_t)(pk2(h2, 0.f) & 0xffffu);
            else outp[nn * 64 + lane] = h2;
        }
    }
    __syncthreads();
    {
        LAS float* red = (LAS float*)lds;
        LAS float* sv = (LAS float*)(lds + 8192);
        for (int i = tid; i < 3 * DM; i += NTHREADS) sv[i] = silu_f(i < 2 * DM ? A.c[i] : A.c_ctx[i - 2 * DM]);
        __syncthreads();
        for (int it = bid; it < DEPTH * 48; it += nblk) {
            const int l = it / 48, n = (it % 48) * 64 + lane;
            const float* W = A.w_ada + (size_t)l * DM * 3072 + n;
            float a0 = 0.f, a1 = 0.f, a2 = 0.f;
            const int kb = wave * 128;
#pragma unroll 1
            for (int k0 = 0; k0 < 128; k0 += 16) {
                float w[16];
#pragma unroll
                for (int k = 0; k < 16; ++k) w[k] = W[(size_t)(kb + k0 + k) * 3072];
#pragma unroll
                for (int k = 0; k < 16; ++k) { a0 += sv[kb + k0 + k] * w[k]; a1 += sv[DM + kb + k0 + k] * w[k]; a2 += sv[2 * DM + kb + k0 + k] * w[k]; }
            }
            red[(wave * 3 + 0) * 64 + lane] = a0; red[(wave * 3 + 1) * 64 + lane] = a1; red[(wave * 3 + 2) * 64 + lane] = a2;
            __syncthreads();
            if (tid < 192) { const int v = tid >> 6; float sacc = A.b_ada[l * 3072 + n];
#pragma unroll
                for (int w = 0; w < 8; ++w) sacc += red[(w * 3 + v) * 64 + lane];
                ((float*)(ws + WS_ADA))[((size_t)l * 3 + v) * 3072 + n] = sacc; }
            __syncthreads();
        }
    }
}

__device__ __forceinline__ void phase_norm(CKArgs& A, int l, int bid, int nblk, int tid) {
    const int wave = __builtin_amdgcn_readfirstlane(tid >> 6), lane = tid & 63;
    const int gw = bid * 8 + wave, NGW = nblk * 8;
    unsigned char* ws = A.ws;
    bf16_t* H = (bf16_t*)(ws + WS_HY);
    const float* ada = (const float*)(ws + WS_ADA) + (size_t)l * 3 * 3072;
    const float* g = A.norm_g + l * DM;
    for (int m = gw; m < MTOT; m += NGW) {
        const float* src; int v;
        if (m < MLAT) { src = (l == 0 ? A.x : A.out) + (size_t)m * DM; v = m >> 13; }
        else { src = (l == 0 ? A.ctx : (const float*)(ws + WS_CX)) + (size_t)(m - MLAT) * DM; v = 2; }
        const float* shp = ada + v * 3072; const float* scp = shp + DM;
        f32x4 xv[4]; float ss = 0.f;
#pragma unroll
        for (int j = 0; j < 4; ++j) { xv[j] = *(const f32x4*)(src + 4 * lane + 256 * j); ss += (xv[j].x * xv[j].x + xv[j].y * xv[j].y) + (xv[j].z * xv[j].z + xv[j].w * xv[j].w); }
        const float rinv = rsqrtf(wave_sum(ss, lane) * (1.0f / DM) + 1e-6f);
#pragma unroll
        for (int j = 0; j < 4; ++j) { const int col = 4 * lane + 256 * j;
            const f32x4 gv = *(const f32x4*)(g + col), sc = *(const f32x4*)(scp + col), sh = *(const f32x4*)(shp + col);
            const f32x4 h = xv[j] * rinv * gv * (sc + 1.0f) + sh;
            u32x2 o; o.x = pk2(h.x, h.y); o.y = pk2(h.z, h.w);
            *(u32x2*)(H + (size_t)m * DM + col) = o; }
    }
    {
        const bf16_t* H2B = (const bf16_t*)(ws + WS_H2) + (size_t)l * SEQ * 64;
        const bf16_t* W3T = (const bf16_t*)(ws + WS_W3T) + (size_t)l * 1024 * 64;
        bf16_t* FILT = (bf16_t*)(ws + WS_FILT);
        const int fr = lane & 15, fq = lane >> 4;
#pragma unroll 1
        for (int it = gw; it < 2048; it += NGW) {
            const int pt = it >> 2, cq = it & 3;
            const bf16_t* ap = H2B + (size_t)(16 * pt + fr) * 64 + 8 * fq;
            const bf16x8 a0 = *(const bf16x8*)ap, a1 = *(const bf16x8*)(ap + 32);
#pragma unroll 4
            for (int ct = 0; ct < 16; ++ct) {
                const int col0 = 256 * cq + 16 * ct;
                const bf16_t* bp = W3T + (size_t)(col0 + fr) * 64 + 8 * fq;
                const bf16x8 b0 = *(const bf16x8*)bp, b1 = *(const bf16x8*)(bp + 32);
                f32x4 acc = {0.f, 0.f, 0.f, 0.f};
                acc = __builtin_amdgcn_mfma_f32_16x16x32_bf16(a0, b0, acc, 0, 0, 0);
                acc = __builtin_amdgcn_mfma_f32_16x16x32_bf16(a1, b1, acc, 0, 0, 0);
                u32x2 o; o.x = pk2(acc.x, acc.y); o.y = pk2(acc.z, acc.w);
                *(u32x2*)(FILT + (size_t)(col0 + fr) * SEQ + 16 * pt + 4 * fq) = o;
            }
        }
    }
}

struct EpiIn {
    static constexpr bool PERM = true, AFTER_DRAIN = false;
    bf16_t* PT; bf16_t* KH; bf16_t* PCT; const float2* rope;
    __device__ __forceinline__ void operator()(const f32x4 (&acc)[2][2][4][2], const pg8::Unit& u, int wr, int wc, int fr, int fq) const {
        const int row0 = u.pm * 256 + wr * 64 + fr;
        if (u.pn < 10) {
#pragma unroll
            for (int bj = 0; bj < 2; ++bj) {
                const int blk = 2 * u.pn + bj;
                const bool rp = ((blk >= 6 && blk <= 8) || blk == 15) && (u.pm < 64);
                const int col0 = 256 * u.pn + 128 * bj + 32 * wc + 8 * fq;
                bf16_t* dst; size_t ld;
                if (u.pn < 6) { dst = PT + col0; ld = NTM; }
                else { const int n2 = col0 - 1536; dst = KH + (size_t)(n2 >> 6) * MTOT * 64 + (n2 & 63); ld = 64; }
#pragma unroll
                for (int ai = 0; ai < 2; ++ai)
#pragma unroll
                    for (int m = 0; m < 4; ++m) {
                        const int r = row0 + 128 * ai + 16 * m;
                        f32x4 v0 = acc[ai][bj][m][0], v1 = acc[ai][bj][m][1];
                        if (rp) {
                            const int pos = r & (SEQ - 1);
                            const int p = (wc & 1) ? (pos & 63) : (pos >> 6);
                            const f32x4* tb = (const f32x4*)(rope + p * 16 + 8 * (fq & 1));
                            const int ln = fr + 16 * fq;
                            const float sg = (fq < 2) ? -1.0f : 1.0f;
                            { const f32x4 t0 = tb[0], t1 = tb[1];
                              const float qx = lane_xor(v0.x, ln, 32), qy = lane_xor(v0.y, ln, 32), qz = lane_xor(v0.z, ln, 32), qw = lane_xor(v0.w, ln, 32);
                              v0.x = v0.x * t0.x + sg * qx * t0.y; v0.y = v0.y * t0.z + sg * qy * t0.w; v0.z = v0.z * t1.x + sg * qz * t1.y; v0.w = v0.w * t1.z + sg * qw * t1.w; }
                            { const f32x4 t2 = tb[2], t3 = tb[3];
                              const float qx = lane_xor(v1.x, ln, 32), qy = lane_xor(v1.y, ln, 32), qz = lane_xor(v1.z, ln, 32), qw = lane_xor(v1.w, ln, 32);
                              v1.x = v1.x * t2.x + sg * qx * t2.y; v1.y = v1.y * t2.z + sg * qy * t2.w; v1.z = v1.z * t3.x + sg * qz * t3.y; v1.w = v1.w * t3.z + sg * qw * t3.w; }
                        }
                        u32x4 w; w.x = pk2(v0.x, v0.y); w.y = pk2(v0.z, v0.w); w.z = pk2(v1.x, v1.y); w.w = pk2(v1.z, v1.w);
                        *(u32x4*)(dst + (size_t)r * ld) = w;
                        asm volatile("" ::: "memory");
                    }
            }
        } else {
#pragma unroll
            for (int bj = 0; bj < 2; ++bj) {
                const int ch0 = 256 * (u.pn - 10) + 128 * bj + 32 * wc + 8 * fq;
#pragma unroll
                for (int ai = 0; ai < 2; ++ai)
#pragma unroll
                    for (int m = 0; m < 4; ++m) {
                        const int r = row0 + 128 * ai + 16 * m;
                        bf16_t* p = PCT + (size_t)ch0 * MTOT + r;
#pragma unroll
                        for (int n = 0; n < 2; ++n) {
                            const f32x4 v = acc[ai][bj][m][n];
                            bf16_t* q = p + (size_t)(4 * n) * MTOT;
                            const unsigned w0 = pk2(v.x, v.y), w1 = pk2(v.z, v.w);
                            q[0] = (bf16_t)(w0 & 0xffffu); q[MTOT] = (bf16_t)(w0 >> 16); q[2 * (size_t)MTOT] = (bf16_t)(w1 & 0xffffu); q[3 * (size_t)MTOT] = (bf16_t)(w1 >> 16);
                        }
                    }
            }
        }
    }
};
struct EpiFilt {
    static constexpr bool PERM = true, AFTER_DRAIN = false;
    bf16_t* O; int ldc;
    __device__ __forceinline__ void operator()(const f32x4 (&acc)[2][2][4][2], const pg8::Unit& u, int wr, int wc, int fr, int fq) const {
        const int row0 = u.pm * 256 + wr * 64 + fr;
#pragma unroll
        for (int bj = 0; bj < 2; ++bj) { const int col0 = 256 * u.pn + 128 * bj + 32 * wc + 8 * fq;
#pragma unroll
            for (int ai = 0; ai < 2; ++ai)
#pragma unroll
                for (int m = 0; m < 4; ++m) { const int r = row0 + 128 * ai + 16 * m; const f32x4 v0 = acc[ai][bj][m][0], v1 = acc[ai][bj][m][1];
                    u32x4 w; w.x = pk2(v0.x, v0.y); w.y = pk2(v0.z, v0.w); w.z = pk2(v1.x, v1.y); w.w = pk2(v1.z, v1.w);
                    *(u32x4*)(O + (size_t)r * ldc + col0) = w; } }
    }
};
struct EpiOut {
    static constexpr bool PERM = true, AFTER_DRAIN = false;
    const float* xsrc; float* xdst; const float* csrc; float* cdst; const float* ada;
    __device__ __forceinline__ void operator()(const f32x4 (&acc)[2][2][4][2], const pg8::Unit& u, int wr, int wc, int fr, int fq) const {
        const int row0 = u.pm * 256 + wr * 64 + fr;
        const bool lat = u.pm < 64;
#pragma unroll
        for (int bj = 0; bj < 2; ++bj) {
            const int col0 = 256 * u.pn + 128 * bj + 32 * wc + 8 * fq;
#pragma unroll
            for (int ai = 0; ai < 2; ++ai)
#pragma unroll
                for (int m = 0; m < 4; ++m) {
                    const int r = row0 + 128 * ai + 16 * m;
                    const int v = lat ? (r >> 13) : 2;
                    const float* gp = ada + v * 3072 + 2048 + col0;
                    const f32x4 g0 = *(const f32x4*)gp, g1 = *(const f32x4*)(gp + 4);
                    const size_t off = lat ? (size_t)r * DM + col0 : (size_t)(r - MLAT) * DM + col0;
                    const float* sp = (lat ? xsrc : csrc) + off; float* dp = (lat ? xdst : cdst) + off;
                    const f32x4 x0 = *(const f32x4*)sp, x1 = *(const f32x4*)(sp + 4);
                    *(f32x4*)dp = x0 + g0 * acc[ai][bj][m][0];
                    *(f32x4*)(dp + 4) = x1 + g1 * acc[ai][bj][m][1];
                    if (m & 1) asm volatile("" ::: "memory");
                }
        }
    }
};

struct EpiAll {
    static constexpr bool PERM = true, AFTER_DRAIN = false;
    int mode, l; CKArgs* Ap;
    __device__ __forceinline__ void operator()(const f32x4 (&acc)[2][2][4][2], const pg8::Unit& u, int wr, int wc, int fr, int fq) const {
        unsigned char* ws = Ap->ws;
        if (mode == 0) { const EpiIn E{(bf16_t*)(ws + WS_PT), (bf16_t*)(ws + WS_KH), (bf16_t*)(ws + WS_PCT), (const float2*)(ws + WS_ROPE)}; E(acc, u, wr, wc, fr, fq); }
        else { const EpiOut E{l == 0 ? Ap->x : Ap->out, Ap->out, l == 0 ? Ap->ctx : (const float*)(ws + WS_CX), (float*)(ws + WS_CX), (const float*)(ws + WS_ADA) + (size_t)l * 3 * 3072}; E(acc, u, wr, wc, fr, fq); }
    }
};
__device__ __forceinline__ float max3f(float a, float b, float c) { float r; asm("v_max3_f32 %0, %1, %2, %3" : "=v"(r) : "v"(a), "v"(b), "v"(c)); return r; }
__device__ __forceinline__ float max2f(float a, float b) { float r; asm("v_max_f32_e32 %0, %1, %2" : "=v"(r) : "v"(a), "v"(b)); return r; }
__device__ __forceinline__ void attn_tile(LAS const unsigned char* slot, int cs, const bf16x8 (&bq)[4], f32x16& o0, f32x16& o1, float& m_run, float& l_run,
                                          int r31, int hh, bool use_mask, int clo, int chi, bool use_bias, LAS const float* btab, int bidx) {
    const int kr = cs + r31;
    LAS const unsigned char* kp = slot + kr * 128;
    const int ksw = (kr >> 1) & 7;
    const bf16x8 ka0 = *(LAS const bf16x8*)(kp + 16 * ((0 + hh) ^ ksw)), ka1 = *(LAS const bf16x8*)(kp + 16 * ((2 + hh) ^ ksw));
    const bf16x8 ka2 = *(LAS const bf16x8*)(kp + 16 * ((4 + hh) ^ ksw)), ka3 = *(LAS const bf16x8*)(kp + 16 * ((6 + hh) ^ ksw));
    LAS const unsigned char* vp = slot + 8192 + r31 * 128;
    const int vsw = (r31 >> 1) & 15, g0 = (cs >> 2) + hh;
    const u32x2 a0l = *(LAS const u32x2*)(vp + 8 * ((g0) ^ vsw)), a0h = *(LAS const u32x2*)(vp + 8 * ((g0 + 2) ^ vsw));
    const u32x2 a1l = *(LAS const u32x2*)(vp + 8 * ((g0 + 4) ^ vsw)), a1h = *(LAS const u32x2*)(vp + 8 * ((g0 + 6) ^ vsw));
    const u32x2 b0l = *(LAS const u32x2*)(vp + 4096 + 8 * ((g0) ^ vsw)), b0h = *(LAS const u32x2*)(vp + 4096 + 8 * ((g0 + 2) ^ vsw));
    const u32x2 b1l = *(LAS const u32x2*)(vp + 4096 + 8 * ((g0 + 4) ^ vsw)), b1h = *(LAS const u32x2*)(vp + 4096 + 8 * ((g0 + 6) ^ vsw));
    f32x16 s, t;
#pragma unroll
    for (int i = 0; i < 16; ++i) { s[i] = 0.f; t[i] = 0.f; }
    s = __builtin_amdgcn_mfma_f32_32x32x16_bf16(ka0, bq[0], s, 0, 0, 0); t = __builtin_amdgcn_mfma_f32_32x32x16_bf16(ka1, bq[1], t, 0, 0, 0);
    s = __builtin_amdgcn_mfma_f32_32x32x16_bf16(ka2, bq[2], s, 0, 0, 0); t = __builtin_amdgcn_mfma_f32_32x32x16_bf16(ka3, bq[3], t, 0, 0, 0);
    if (use_bias) {
        LAS const float* bp = btab + bidx;
#pragma unroll
        for (int i = 0; i < 16; ++i) { const int c = (i & 3) + 8 * (i >> 2) + 4 * hh; s[i] = (s[i] + t[i]) * QK_SCALE + bp[c]; }
    } else {
#pragma unroll
        for (int i = 0; i < 16; ++i) s[i] = (s[i] + t[i]) * QK_SCALE;
    }
    if (use_mask) {
        const unsigned off = (unsigned)(4 * hh - clo), rng = (unsigned)(chi - clo);
        const bool any = chi >= clo;
#pragma unroll
        for (int i = 0; i < 16; ++i) { const unsigned c0 = (unsigned)((i & 3) + 8 * (i >> 2)); s[i] = (any && (c0 + off <= rng)) ? s[i] : -INFINITY; }
    }
    float tmax = max3f(s[0], s[1], s[2]);
#pragma unroll
    for (int i = 3; i < 15; i += 2) tmax = max3f(tmax, s[i], s[i + 1]);
    tmax = max2f(tmax, s[15]);
    tmax = max2f(tmax, lane_xor(tmax, r31 + 32 * hh, 32));
    if (__any(tmax - m_run > 8.0f)) {
        const float m_new = fmaxf(m_run, tmax);
        const float alpha = __builtin_amdgcn_exp2f(m_run - m_new);
        m_run = m_new; l_run *= alpha;
#pragma unroll
        for (int i = 0; i < 16; ++i) { o0[i] *= alpha; o1[i] *= alpha; }
    }
    float ps0 = 0.f, ps1 = 0.f;
#pragma unroll
    for (int i = 0; i < 16; i += 2) { const float p0 = __builtin_amdgcn_exp2f(s[i] - m_run), p1 = __builtin_amdgcn_exp2f(s[i + 1] - m_run); s[i] = p0; s[i + 1] = p1; ps0 += p0; ps1 += p1; }
    l_run += ps0 + ps1;
    u32x4 pw0, pw1;
    pw0.x = pk2(s[0], s[1]); pw0.y = pk2(s[2], s[3]); pw0.z = pk2(s[4], s[5]); pw0.w = pk2(s[6], s[7]);
    pw1.x = pk2(s[8], s[9]); pw1.y = pk2(s[10], s[11]); pw1.z = pk2(s[12], s[13]); pw1.w = pk2(s[14], s[15]);
    const bf16x8 pb0 = __builtin_bit_cast(bf16x8, pw0), pb1 = __builtin_bit_cast(bf16x8, pw1);
    u32x4 w;
    w.x = a0l.x; w.y = a0l.y; w.z = a0h.x; w.w = a0h.y; const bf16x8 va00 = __builtin_bit_cast(bf16x8, w);
    w.x = a1l.x; w.y = a1l.y; w.z = a1h.x; w.w = a1h.y; const bf16x8 va01 = __builtin_bit_cast(bf16x8, w);
    w.x = b0l.x; w.y = b0l.y; w.z = b0h.x; w.w = b0h.y; const bf16x8 va10 = __builtin_bit_cast(bf16x8, w);
    w.x = b1l.x; w.y = b1l.y; w.z = b1h.x; w.w = b1h.y; const bf16x8 va11 = __builtin_bit_cast(bf16x8, w);
    o0 = __builtin_amdgcn_mfma_f32_32x32x16_bf16(va00, pb0, o0, 0, 0, 0); o1 = __builtin_amdgcn_mfma_f32_32x32x16_bf16(va10, pb0, o1, 0, 0, 0);
    o0 = __builtin_amdgcn_mfma_f32_32x32x16_bf16(va01, pb1, o0, 0, 0, 0); o1 = __builtin_amdgcn_mfma_f32_32x32x16_bf16(va11, pb1, o1, 0, 0, 0);
}

__device__ __forceinline__ void attn_tile2(LAS const unsigned char* slot, const bf16x8 (&bq)[4], f32x16& o0, f32x16& o1, float& m_run, float& l_run,
                                           int r31, int hh, bool use_mask, int clo0, int chi0, int clo1, int chi1) {
    const int ksw = (r31 >> 1) & 7;
    LAS const unsigned char* kp = slot + r31 * 128;
    const bf16x8 ka0 = *(LAS const bf16x8*)(kp + 16 * ((0 + hh) ^ ksw)), ka1 = *(LAS const bf16x8*)(kp + 16 * ((2 + hh) ^ ksw));
    const bf16x8 ka2 = *(LAS const bf16x8*)(kp + 16 * ((4 + hh) ^ ksw)), ka3 = *(LAS const bf16x8*)(kp + 16 * ((6 + hh) ^ ksw));
    const bf16x8 kb0 = *(LAS const bf16x8*)(kp + 4096 + 16 * ((0 + hh) ^ ksw)), kb1 = *(LAS const bf16x8*)(kp + 4096 + 16 * ((2 + hh) ^ ksw));
    const bf16x8 kb2 = *(LAS const bf16x8*)(kp + 4096 + 16 * ((4 + hh) ^ ksw)), kb3 = *(LAS const bf16x8*)(kp + 4096 + 16 * ((6 + hh) ^ ksw));
    f32x16 s0, s1;
#pragma unroll
    for (int i = 0; i < 16; ++i) { s0[i] = 0.f; s1[i] = 0.f; }
    s0 = __builtin_amdgcn_mfma_f32_32x32x16_bf16(ka0, bq[0], s0, 0, 0, 0); s1 = __builtin_amdgcn_mfma_f32_32x32x16_bf16(kb0, bq[0], s1, 0, 0, 0);
    s0 = __builtin_amdgcn_mfma_f32_32x32x16_bf16(ka1, bq[1], s0, 0, 0, 0); s1 = __builtin_amdgcn_mfma_f32_32x32x16_bf16(kb1, bq[1], s1, 0, 0, 0);
    s0 = __builtin_amdgcn_mfma_f32_32x32x16_bf16(ka2, bq[2], s0, 0, 0, 0); s1 = __builtin_amdgcn_mfma_f32_32x32x16_bf16(kb2, bq[2], s1, 0, 0, 0);
    s0 = __builtin_amdgcn_mfma_f32_32x32x16_bf16(ka3, bq[3], s0, 0, 0, 0); s1 = __builtin_amdgcn_mfma_f32_32x32x16_bf16(kb3, bq[3], s1, 0, 0, 0);
    LAS const unsigned char* vp = slot + 8192 + r31 * 128;
    const int vsw = (r31 >> 1) & 15;
    u32x2 va[2][4][2];
#pragma unroll
    for (int db = 0; db < 2; ++db)
#pragma unroll
        for (int st = 0; st < 4; ++st) { va[db][st][0] = *(LAS const u32x2*)(vp + 4096 * db + 8 * ((4 * st + hh) ^ vsw)); va[db][st][1] = *(LAS const u32x2*)(vp + 4096 * db + 8 * ((4 * st + hh + 2) ^ vsw)); }
    if (use_mask) {
        const unsigned off0 = (unsigned)(4 * hh - clo0), rng0 = (unsigned)(chi0 - clo0), off1 = (unsigned)(4 * hh - clo1), rng1 = (unsigned)(chi1 - clo1);
#pragma unroll
        for (int i = 0; i < 16; ++i) { const unsigned c0 = (unsigned)((i & 3) + 8 * (i >> 2)); s0[i] = (c0 + off0 <= rng0) ? s0[i] : -INFINITY; s1[i] = (c0 + off1 <= rng1) ? s1[i] : -INFINITY; }
    }
    float tmax = max3f(s0[0], s0[1], s1[0]);
    tmax = max2f(tmax, s1[1]);
#pragma unroll
    for (int i = 2; i < 16; i += 2) { tmax = max3f(tmax, s0[i], s0[i + 1]); tmax = max3f(tmax, s1[i], s1[i + 1]); }
    tmax = max2f(tmax, lane_xor(tmax, r31 + 32 * hh, 32)) * QK_SCALE;
    if (__any(tmax - m_run > 8.0f)) {
        const float m_new = fmaxf(m_run, tmax);
        const float alpha = __builtin_amdgcn_exp2f(m_run - m_new);
        m_run = m_new; l_run *= alpha;
#pragma unroll
        for (int i = 0; i < 16; ++i) { o0[i] *= alpha; o1[i] *= alpha; }
    }
    float ps0 = 0.f, ps1 = 0.f;
    const float nm = -m_run;
#pragma unroll
    for (int i = 0; i < 16; ++i) { const float p0 = __builtin_amdgcn_exp2f(fmaf(s0[i], QK_SCALE, nm)), p1 = __builtin_amdgcn_exp2f(fmaf(s1[i], QK_SCALE, nm)); s0[i] = p0; s1[i] = p1; ps0 += p0; ps1 += p1; }
    l_run += ps0 + ps1;
    u32x4 pw;
    pw.x = pk2(s0[0], s0[1]); pw.y = pk2(s0[2], s0[3]); pw.z = pk2(s0[4], s0[5]); pw.w = pk2(s0[6], s0[7]); const bf16x8 p00 = __builtin_bit_cast(bf16x8, pw);
    pw.x = pk2(s0[8], s0[9]); pw.y = pk2(s0[10], s0[11]); pw.z = pk2(s0[12], s0[13]); pw.w = pk2(s0[14], s0[15]); const bf16x8 p01 = __builtin_bit_cast(bf16x8, pw);
    pw.x = pk2(s1[0], s1[1]); pw.y = pk2(s1[2], s1[3]); pw.z = pk2(s1[4], s1[5]); pw.w = pk2(s1[6], s1[7]); const bf16x8 p10 = __builtin_bit_cast(bf16x8, pw);
    pw.x = pk2(s1[8], s1[9]); pw.y = pk2(s1[10], s1[11]); pw.z = pk2(s1[12], s1[13]); pw.w = pk2(s1[14], s1[15]); const bf16x8 p11 = __builtin_bit_cast(bf16x8, pw);
#define VA8(db_, st_) __builtin_bit_cast(bf16x8, (u32x4){va[db_][st_][0].x, va[db_][st_][0].y, va[db_][st_][1].x, va[db_][st_][1].y})
    o0 = __builtin_amdgcn_mfma_f32_32x32x16_bf16(VA8(0, 0), p00, o0, 0, 0, 0); o1 = __builtin_amdgcn_mfma_f32_32x32x16_bf16(VA8(1, 0), p00, o1, 0, 0, 0);
    o0 = __builtin_amdgcn_mfma_f32_32x32x16_bf16(VA8(0, 1), p01, o0, 0, 0, 0); o1 = __builtin_amdgcn_mfma_f32_32x32x16_bf16(VA8(1, 1), p01, o1, 0, 0, 0);
    o0 = __builtin_amdgcn_mfma_f32_32x32x16_bf16(VA8(0, 2), p10, o0, 0, 0, 0); o1 = __builtin_amdgcn_mfma_f32_32x32x16_bf16(VA8(1, 2), p10, o1, 0, 0, 0);
    o0 = __builtin_amdgcn_mfma_f32_32x32x16_bf16(VA8(0, 3), p11, o0, 0, 0, 0); o1 = __builtin_amdgcn_mfma_f32_32x32x16_bf16(VA8(1, 3), p11, o1, 0, 0, 0);
#undef VA8
}

__device__ __forceinline__ void attn_block_item(CKArgs& A, int l, int MODE, int item, LAS unsigned char* lds, int tid) {
    asm volatile("" : "+v"(tid));
    unsigned char* ws = A.ws;
    const bf16_t* PT = (const bf16_t*)(ws + WS_PT);
    bf16_t* Y = (bf16_t*)(ws + WS_HY);
    const int wave = __builtin_amdgcn_readfirstlane(tid >> 6), lane = tid & 63;
    const int r31 = lane & 31, hh = lane >> 5;
    int b, h, qtok, qi = 0;
    int rp = 0, mg = 0, qg = 0;
    if (MODE == 0) { b = item / 192; const int rem = item % 192; h = rem >> 5; qi = rem & 31; rp = 2 * qi + (wave >> 2); mg = wave & 3;
        qtok = b * SEQ + (2 * rp + (r31 >> 4)) * 64 + 16 * mg + (r31 & 15); }
    else if (MODE == 1) { b = item / 192; const int rem = item % 192; h = rem >> 5; qi = rem & 31; qg = 8 * qi + wave; qtok = b * SEQ + 32 * qg + r31; }
    else { b = item / 6; h = item % 6; qg = wave; qtok = MLAT + b * CTXL + 32 * qg + r31; }
    const bool grpA = (MODE == 0 || MODE == 2);
    const int kvh = grpA ? h : h / 3;
    const int qcol = (grpA ? C_QA : C_QC) + h * 64, gcol = (grpA ? C_GA : C_GC) + h * 64, ycol = (grpA ? 0 : 640) + h * 64;
    const int kh = grpA ? h : 6 + kvh;
    bf16x8 bq[4];
    { const bf16_t* qp = PT + (size_t)qtok * NTM + qcol + 8 * hh;
#pragma unroll
      for (int s = 0; s < 4; ++s) bq[s] = *(const bf16x8*)(qp + 16 * s); }
    f32x16 o0, o1;
#pragma unroll
    for (int i = 0; i < 16; ++i) { o0[i] = 0.f; o1[i] = 0.f; }
    float m_run = -1e30f, l_run = 0.f;
    if (!grpA) { m_run = A.sink[l * 6 + h] * LOG2E; l_run = hh == 0 ? 1.0f : 0.f; }
    int wrow0 = 0, nwin = 0;
    if (MODE == 0) { const int a0 = min(max(4 * qi - 4, 0), 120), a1 = min(max(4 * qi - 1, 0), 120) + 7; wrow0 = a0; nwin = a1 - a0 + 1; }
    if (MODE == 1) { const int k0 = max(4 * qi - 2, 0), k1 = min(4 * qi + 5, 127); wrow0 = k0; nwin = k1 - k0 + 1; }
    const int nsteps = 4 + nwin;
    int ra = 0, rb = -1, cs = 0, rq = 0, jq = 0, r0 = 0, cmin = 0;
    LAS const float* btab = (LAS const float*)(lds + AUX_OFF + 2048);
    if (MODE == 0) { ra = min(max(2 * rp - 4, 0), 120); rb = min(max(2 * rp - 3, 0), 120) + 7; cs = min(max(16 * mg - 8, 0), 32);
        rq = 2 * rp + (r31 >> 4); jq = 16 * mg + (r31 & 15); r0 = min(max(rq - 4, 0), 120); cmin = min(max(jq - 8, 0), 48) - cs;
        }
    const int lr = tid >> 3, lc = tid & 7;
    const bf16_t* kg = (const bf16_t*)(ws + WS_KH) + (size_t)kh * MTOT * 64 + 8 * tid;
    const bf16_t* vg = (const bf16_t*)(ws + WS_VT) + (size_t)kh * MTOT * 64 + 8 * tid;
    const int kdst = lr * 128 + 16 * (lc ^ ((lr >> 1) & 7));
    const int vdstb = 8192 + (8 * lc) * 128 + 2 * (lr & 3), vg4 = lr >> 2, vs4 = (4 * lc) & 15;
#define ROW_TOK(i) ((i) < 4 ? MLAT + b * CTXL + 64 * (i) : b * SEQ + 64 * (wrow0 + (i) - 4))
#define LOAD_ROW(i, kr_, vr_) do { const int t0_ = ROW_TOK(i); kr_ = *(const u32x4*)(kg + (size_t)t0_ * 64); vr_ = *(const u32x4*)(vg + (size_t)t0_ * 64); } while (0)
#define WRITE_ROW(sl_, kr_, vr_) do { *(LAS u32x4*)((sl_) + kdst) = kr_; \
        _Pragma("unroll") for (int j_ = 0; j_ < 8; ++j_) { const unsigned w_ = j_ < 2 ? vr_.x : (j_ < 4 ? vr_.y : (j_ < 6 ? vr_.z : vr_.w)); \
            *(LAS bf16_t*)((sl_) + vdstb + j_ * 128 + 8 * (vg4 ^ ((vs4 + (j_ >> 1)) & 15))) = (bf16_t)((j_ & 1) ? (w_ >> 16) : (w_ & 0xffffu)); } } while (0)
    u32x4 k0, v0, k1, v1, k2, v2;
    LOAD_ROW(0, k0, v0); k1 = k0; v1 = v0; k2 = k0; v2 = v0;
    __syncthreads();
    if (MODE == 0 && tid < 465) ((LAS float*)(lds + AUX_OFF + 2048))[tid] = A.na_rpb[(size_t)(l * 6 + h) * 465 + tid] * LOG2E;
    WRITE_ROW(lds, k0, v0);
    __syncthreads();
#define ATT_STEP(i_, kL, vL, kW, vW) do { const int i = (i_); if (i < nsteps) { \
        LAS const unsigned char* slot = lds + (i & 1) * 16384; \
        { const int ir_ = min(i + 1, nsteps - 1); LOAD_ROW(ir_, kL, vL); }     \
        bool use2 = false, use1 = false, um = false, um1 = false, ub = false; int c1 = 0, lo0 = 0, hi0 = 31, lo1 = 0, hi1 = 31, bidx = 0; \
        if (i < 4) use2 = true; \
        else if (MODE == 0) { const int a = wrow0 + i - 4; use1 = (a >= ra) && (a <= rb); const bool rowok = (a >= r0) && (a < r0 + 8); \
            c1 = cs; lo0 = rowok ? cmin : 1; hi0 = rowok ? cmin + 15 : 0; ub = true; um1 = true; bidx = (a - rq + 7) * 31 + (cs - jq + 15); } \
        else if (MODE == 1) { const int rel0 = (64 * (wrow0 + i - 4) - (32 * qg - 128)) >> 5, rel1 = rel0 + 1;     \
            const bool a0 = (rel0 >= 0) && (rel0 <= 8), a1 = (rel1 >= 0) && (rel1 <= 8); \
            if (a0 && a1) { use2 = true; um = (rel0 == 0) || (rel1 == 8); lo0 = rel0 == 0 ? r31 : 0; hi1 = rel1 == 8 ? r31 : 31; } \
            else if (a0) { use1 = true; um1 = (rel0 == 0) || (rel0 == 8); lo0 = rel0 == 0 ? r31 : 0; hi0 = rel0 == 8 ? r31 : 31; } \
            else if (a1) { use1 = true; c1 = 32; um1 = (rel1 == 0) || (rel1 == 8); lo0 = rel1 == 0 ? r31 : 0; hi0 = rel1 == 8 ? r31 : 31; } } \
        if (use2) attn_tile2(slot, bq, o0, o1, m_run, l_run, r31, hh, um, lo0, hi0, lo1, hi1); \
        if (use1) attn_tile(slot, c1, bq, o0, o1, m_run, l_run, r31, hh, um1, lo0, hi0, ub, btab, bidx); \
        if (i + 1 < nsteps) { LAS unsigned char* nslot = lds + ((i + 1) & 1) * 16384; WRITE_ROW(nslot, kW, vW); } \
        __syncthreads(); } } while (0)
#pragma unroll 1
    for (int i3 = 0; i3 < nsteps; ++i3) {
        ATT_STEP(i3, k1, v1, k1, v1);
    }
#undef ATT_STEP
#undef LOAD_ROW
#undef WRITE_ROW
    const float ltot = l_run + lane_xor(l_run, lane, 32);
    const float inv = 1.0f / ltot;
    const bf16_t* gp = PT + (size_t)qtok * NTM + gcol + 4 * hh;
    bf16_t* yp = Y + (size_t)qtok * DM + ycol + 4 * hh;
#pragma unroll
    for (int db = 0; db < 2; ++db)
#pragma unroll
        for (int g4 = 0; g4 < 4; ++g4) {
            const int d0 = 32 * db + 8 * g4;
            const u32x2 gw = *(const u32x2*)(gp + d0);
            float v0, v1, v2, v3;
            if (db == 0) { v0 = o0[4 * g4]; v1 = o0[4 * g4 + 1]; v2 = o0[4 * g4 + 2]; v3 = o0[4 * g4 + 3]; }
            else { v0 = o1[4 * g4]; v1 = o1[4 * g4 + 1]; v2 = o1[4 * g4 + 2]; v3 = o1[4 * g4 + 3]; }
            v0 *= inv * silu_f(bflo(gw.x)); v1 *= inv * silu_f(bfhi(gw.x)); v2 *= inv * silu_f(bflo(gw.y)); v3 *= inv * silu_f(bfhi(gw.y));
            u32x2 o; o.x = pk2(v0, v1); o.y = pk2(v2, v3);
            *(u32x2*)(yp + d0) = o;
        }
}

typedef float cf2 __attribute__((ext_vector_type(2)));
__device__ __forceinline__ cf2 mk2(float x, float y) { cf2 r; r.x = x; r.y = y; return r; }
__device__ __forceinline__ cf2 cmul(cf2 a, cf2 b) { return mk2(a.x * b.x - a.y * b.y, a.x * b.y + a.y * b.x); }
#define PA(e) ((e) + (((e) >> 4) << 1))
struct cf2x4 { cf2 a, b, c, d; };
__device__ __forceinline__ cf2x4 bfly4_fwd(cf2 x0, cf2 x1, cf2 x2, cf2 x3, float a) {
    const cf2 w1 = mk2(__builtin_amdgcn_cosf(a), -__builtin_amdgcn_sinf(a));
    const cf2 w2 = cmul(w1, w1), w3 = cmul(w2, w1);
    const cf2 s02 = x0 + x2, d02 = x0 - x2, s13 = x1 + x3, d13 = x1 - x3;
    cf2x4 r;
    r.a = s02 + s13;
    r.b = cmul(s02 - s13, w2);
    r.c = cmul(mk2(d02.x + d13.y, d02.y - d13.x), w1);
    r.d = cmul(mk2(d02.x - d13.y, d02.y + d13.x), w3);
    return r;
}
__device__ __forceinline__ cf2x4 bfly4_inv(cf2 v0, cf2 v1, cf2 v2, cf2 v3, float a) {
    const cf2 w1 = mk2(__builtin_amdgcn_cosf(a), __builtin_amdgcn_sinf(a));
    const cf2 w2 = cmul(w1, w1);
    const cf2 bb = cmul(v1, w2), dd = cmul(v3, w2);
    const cf2 u0 = v0 + bb, u1 = v0 - bb, u2 = v2 + dd, u3 = v2 - dd;
    const cf2 e = cmul(u2, w1), f0 = cmul(u3, w1);
    const cf2 f = mk2(-f0.y, f0.x);
    cf2x4 r; r.a = u0 + e; r.c = u0 - e; r.b = u1 + f; r.d = u1 - f; return r;
}
__device__ __forceinline__ void fft_fwd_fused(LAS cf2* buf, int tid, int lsb) {
    const int sB = 1 << lsb, s = 4 << lsb;
    const float ra = 1.0f / (float)(16 << lsb), rb = 1.0f / (float)(4 << lsb);
#pragma unroll 1
    for (int gg = 0; gg < 2; ++gg) {
        const int g = tid + 512 * gg, i = g & (sB - 1), base = ((g >> lsb) << (lsb + 4)) + i;
        cf2 x[4][4];
#pragma unroll
        for (int a = 0; a < 4; ++a)
#pragma unroll
            for (int b = 0; b < 4; ++b) { const int e = base + a * s + b * sB; x[a][b] = buf[PA(e)]; }
#pragma unroll
        for (int b = 0; b < 4; ++b) { const cf2x4 r = bfly4_fwd(x[0][b], x[1][b], x[2][b], x[3][b], (float)(i + b * sB) * ra); x[0][b] = r.a; x[1][b] = r.b; x[2][b] = r.c; x[3][b] = r.d; }
        const float ab = (float)i * rb;
#pragma unroll
        for (int a = 0; a < 4; ++a) { const cf2x4 r = bfly4_fwd(x[a][0], x[a][1], x[a][2], x[a][3], ab); x[a][0] = r.a; x[a][1] = r.b; x[a][2] = r.c; x[a][3] = r.d; }
#pragma unroll
        for (int a = 0; a < 4; ++a)
#pragma unroll
            for (int b = 0; b < 4; ++b) { const int e = base + a * s + b * sB; buf[PA(e)] = x[a][b]; }
    }
    __syncthreads();
}
__device__ __forceinline__ void fft_inv_fused(LAS cf2* buf, int tid, int lsb) {
    const int sB = 1 << lsb, s = 4 << lsb;
    const float ra = 1.0f / (float)(16 << lsb), rb = 1.0f / (float)(4 << lsb);
#pragma unroll 1
    for (int gg = 0; gg < 2; ++gg) {
        const int g = tid + 512 * gg, i = g & (sB - 1), base = ((g >> lsb) << (lsb + 4)) + i;
        cf2 x[4][4];
#pragma unroll
        for (int a = 0; a < 4; ++a)
#pragma unroll
            for (int b = 0; b < 4; ++b) { const int e = base + a * s + b * sB; x[a][b] = buf[PA(e)]; }
        const float ab = (float)i * rb;
#pragma unroll
        for (int a = 0; a < 4; ++a) { const cf2x4 r = bfly4_inv(x[a][0], x[a][1], x[a][2], x[a][3], ab); x[a][0] = r.a; x[a][1] = r.b; x[a][2] = r.c; x[a][3] = r.d; }
#pragma unroll
        for (int b = 0; b < 4; ++b) { const cf2x4 r = bfly4_inv(x[0][b], x[1][b], x[2][b], x[3][b], (float)(i + b * sB) * ra); x[0][b] = r.a; x[1][b] = r.b; x[2][b] = r.c; x[3][b] = r.d; }
#pragma unroll
        for (int a = 0; a < 4; ++a)
#pragma unroll
            for (int b = 0; b < 4; ++b) { const int e = base + a * s + b * sB; buf[PA(e)] = x[a][b]; }
    }
    __syncthreads();
}
__device__ __forceinline__ void fft_fwd(LAS cf2* buf, int tid) {
#pragma unroll 1
    for (int lsb = 10; lsb >= 2; lsb -= 4) fft_fwd_fused(buf, tid, lsb);
#pragma unroll 4
    for (int k = 0; k < 8; ++k) {
        const int e0 = 4 * (tid + 512 * k), base = PA(e0);
        cf2 x0 = buf[base], x1 = buf[base + 1], x2 = buf[base + 2], x3 = buf[base + 3];
        const cf2 s02 = x0 + x2, d02 = x0 - x2, s13 = x1 + x3, d13 = x1 - x3;
        buf[base] = s02 + s13; buf[base + 1] = s02 - s13;
        buf[base + 2] = mk2(d02.x + d13.y, d02.y - d13.x); buf[base + 3] = mk2(d02.x - d13.y, d02.y + d13.x);
    }
    __syncthreads();
}
__device__ __forceinline__ void fft_inv(LAS cf2* buf, int tid) {
#pragma unroll 1
    for (int lsb = 0; lsb <= 8; lsb += 4) fft_inv_fused(buf, tid, lsb);
#pragma unroll 4
    for (int k = 0; k < 8; ++k) {
        const int i = tid + 512 * k, pi = PA(tid) + 576 * k;
        cf2 v0 = buf[pi], v1 = buf[pi + 4608], v2 = buf[pi + 9216], v3 = buf[pi + 13824];
        const cf2x4 r = bfly4_inv(v0, v1, v2, v3, (float)i * (1.0f / 16384.0f));
        buf[pi] = r.a; buf[pi + 4608] = r.b; buf[pi + 9216] = r.c; buf[pi + 13824] = r.d;
    }
    __syncthreads();
}
__device__ __forceinline__ float hy_short(const bf16_t* prow, int tb, int t, int L, float w0, float w1, float w2, float bias) {
    const float pm = t > 0 ? bf2f(prow[tb + t - 1]) : 0.f;
    const float pc = bf2f(prow[tb + t]);
    const float pp = t < L - 1 ? bf2f(prow[tb + t + 1]) : 0.f;
    return w0 * pm + w1 * pc + w2 * pp + bias;
}
__device__ __forceinline__ float block_sum(float v, LAS float* red, int tid) {
    v = wave_sum(v, tid & 63);
    __syncthreads();
    if ((tid & 63) == 0) red[tid >> 6] = v;
    __syncthreads();
    float s = 0.f;
#pragma unroll
    for (int w = 0; w < 8; ++w) s += red[w];
    return s;
}

__device__ __forceinline__ void hyena_block(CKArgs& A, int l, int c, LAS unsigned char* lds, int tid) {
    asm volatile("" : "+v"(tid));
    unsigned char* ws = A.ws;
    LAS cf2* buf = (LAS cf2*)lds;
    LAS float* fs = (LAS float*)lds;
    LAS float* aux = (LAS float*)(lds + AUX_OFF);
    LAS float* red = aux + 256;
    const bf16_t* PCT = (const bf16_t*)(ws + WS_PCT);
    bf16_t* YBT = (bf16_t*)(ws + WS_YBT);
    const bf16_t* rowz = PCT + (size_t)(R_HZ + c) * MTOT;
    const bf16_t* rowx1 = rowz + (size_t)256 * MTOT;
    const bf16_t* rowx2 = rowz + (size_t)512 * MTOT;
    const bf16_t* rowg = PCT + (size_t)(R_GB + c) * MTOT;
    const float* cw = A.hy_conv_w + (size_t)l * 3 * 768; const float* cb = A.hy_conv_b + (size_t)l * 768;
    const float wz0 = cw[c], wz1 = cw[768 + c], wz2 = cw[1536 + c], bz = cb[c];
    const float wa0 = cw[256 + c], wa1 = cw[768 + 256 + c], wa2 = cw[1536 + 256 + c], ba = cb[256 + c];
    const float wb0 = cw[512 + c], wb1 = cw[768 + 512 + c], wb2 = cw[1536 + 512 + c], bb = cb[512 + c];
    const float d0 = A.hy_d[(l * 2 + 0) * 256 + c], d1 = A.hy_d[(l * 2 + 1) * 256 + c];
    const float dmin = -3.0701134573253945f, dmax = -15.350567286626973f;
    const float delta = fabsf(dmin + (float)c * ((dmax - dmin) / 255.0f));
    __syncthreads();
    if (tid < 256) { const int k = tid >> 6, j = tid & 63; aux[tid] = A.hy_w3[((size_t)l * 64 + j) * 1024 + k * 256 + c]; }
    __syncthreads();

    if (l < DEPTH - 1) {
        float ss0 = 0.f, ss1 = 0.f;
        if (tid < 256) {
            const int n = tid; const f32x4* hr = (const f32x4*)((const float*)(ws + WS_H2C) + ((size_t)l * CTXL + n) * 64);
            float f0 = 0.f, f1 = 0.f, b0 = 0.f, b1 = 0.f;
#pragma unroll 1
            for (int j4 = 0; j4 < 16; ++j4) { const f32x4 hv = hr[j4];
#pragma unroll
                for (int e = 0; e < 4; ++e) { const float hvv = hv[e]; const int j = 4 * j4 + e; f0 += hvv * aux[j]; f1 += hvv * aux[64 + j]; b0 += hvv * aux[128 + j]; b1 += hvv * aux[192 + j]; } }
            const float e = __expf(-((float)n * (1.0f / 255.0f)) * delta);
            f0 *= e; f1 *= e; b0 *= e; b1 *= e;
            fs[n] = f0; fs[256 + n] = f1; fs[512 + n] = b0; fs[768 + n] = b1;
            ss0 = f0 * f0 + (n >= 1 ? b0 * b0 : 0.f); ss1 = f1 * f1 + (n >= 1 ? b1 * b1 : 0.f);
        }
        const int b = tid >> 8, t = tid & 255, tok = MLAT + b * CTXL;
        const float z = hy_short(rowz, tok, t, CTXL, wz0, wz1, wz2, bz);
        const float x1 = hy_short(rowx1, tok, t, CTXL, wa0, wa1, wa2, ba);
        const float x2 = hy_short(rowx2, tok, t, CTXL, wb0, wb1, wb2, bb);
        const float gb = bf2f(rowg[tok + t]);
        fs[1024 + tid] = z;
        const float n0 = rsqrtf(block_sum(ss0, red, tid) + 1e-6f);
        const float n1 = rsqrtf(block_sum(ss1, red, tid) + 1e-6f);
        __syncthreads();
        float y = 0.f;
#pragma unroll 4
        for (int s = 0; s < 256; ++s) { const int d = t - s; const float kv = d >= 0 ? fs[d] : fs[512 - d]; y += fs[1024 + b * 256 + s] * kv; }
        const float z1 = x1 * (y * n0 + d0 * z);
        fs[1536 + tid] = z1;
        __syncthreads();
        float y2 = 0.f;
#pragma unroll 4
        for (int s = 0; s < 256; ++s) { const int d = t - s; const float kv = d >= 0 ? fs[256 + d] : fs[768 - d]; y2 += fs[1536 + b * 256 + s] * kv; }
        const float o = x2 * (y2 * n1 + d1 * z1) * silu_f(gb);
        YBT[(size_t)c * MTOT + tok + t] = (bf16_t)(pk2(o, 0.f) & 0xffffu);
        __syncthreads();
    }

    unsigned* ZK = (unsigned*)(ws + WS_ZS) + (size_t)c * 2 * NFFT;
    const int lane = tid & 63;
    {
        float ss0 = 0.f, ss1 = 0.f;
        const bf16_t* F0 = (const bf16_t*)(ws + WS_FILT) + (size_t)c * SEQ;
#pragma unroll 4
        for (int k = 0; k < 16; ++k) {
            const int n = tid + 512 * k;
            const float e = __expf(-((float)n * (1.0f / 8191.0f)) * delta);
            const float f0 = bf2f(F0[n]) * e, f1 = bf2f(F0[(size_t)256 * SEQ + n]) * e, b0 = bf2f(F0[(size_t)512 * SEQ + n]) * e, b1 = bf2f(F0[(size_t)768 * SEQ + n]) * e;
            buf[PA(n)] = mk2(f0, f1); ss0 += f0 * f0; ss1 += f1 * f1;
            if (n >= 1) { buf[PA(NFFT - n)] = mk2(b0, b1); ss0 += b0 * b0; ss1 += b1 * b1; }
        }
        if (tid == 0) buf[PA(SEQ)] = mk2(0.f, 0.f);
        const float nrm0 = rsqrtf(block_sum(ss0, red, tid) + 1e-6f) * (0.5f / NFFT);
        const float nrm1 = rsqrtf(block_sum(ss1, red, tid) + 1e-6f) * (0.5f / NFFT);
        __syncthreads();
        fft_fwd(buf, tid);
#pragma unroll 4
        for (int k = 0; k < 32; ++k) {
            const int p = tid + 512 * k; const int f = (int)(__brev((unsigned)p) >> 18); const int pp = (int)(__brev((unsigned)((NFFT - f) & (NFFT - 1))) >> 18);
            const cf2 za = buf[PA(p)], zb = buf[PA(pp)];
            ZK[p] = pk2((za.x + zb.x) * nrm0 + d0 * (1.0f / NFFT), (za.y - zb.y) * nrm0);
            ZK[NFFT + p] = pk2((za.y + zb.y) * nrm1 + d1 * (1.0f / NFFT), -(za.x - zb.x) * nrm1);
        }
        __syncthreads();
    }
    const int wv = __builtin_amdgcn_readfirstlane(tid >> 6), tw0 = wv * 1024 + lane, ptw = PA(tw0), ptid = PA(tid);
#define HY_ROW8(prow_, tb_, kb_, w0_, w1_, w2_, bias_, u_) do { \
        float own_[8]; const int p0_ = wv * 1024 + 64 * (kb_); \
        _Pragma("unroll") for (int k = 0; k < 8; ++k) own_[k] = bf2f((prow_)[(unsigned)((tb_) + p0_ + lane + 64 * k)]); \
        const float ep_ = p0_ > 0 ? bf2f((prow_)[(unsigned)((tb_) + p0_ - 1)]) : 0.f, en_ = p0_ + 512 < SEQ ? bf2f((prow_)[(unsigned)((tb_) + p0_ + 512)]) : 0.f; \
        _Pragma("unroll") for (int k = 0; k < 8; ++k) { const float a_ = lane_prev(own_[k], lane), b_ = lane_next(own_[k], lane); \
            const float pl_ = k > 0 ? rdlane(own_[k > 0 ? k - 1 : 0], 63) : ep_, nl_ = k < 7 ? rdlane(own_[k < 7 ? k + 1 : 7], 0) : en_; \
            const float m_ = lane == 0 ? pl_ : a_, q_ = lane == 63 ? nl_ : b_; (u_)[(kb_) + k] = (w0_) * m_ + (w1_) * own_[k] + (w2_) * q_ + (bias_); } \
        asm volatile("" ::: "memory"); __builtin_amdgcn_sched_barrier(0); } while (0)
#pragma unroll
    for (int hf = 0; hf < 2; ++hf) {
        float ua[16], ub[16];
        HY_ROW8(rowz, 0, 8 * hf, wz0, wz1, wz2, bz, ua);
        HY_ROW8(rowz, SEQ, 8 * hf, wz0, wz1, wz2, bz, ub);
#pragma unroll
        for (int k = 8 * hf; k < 8 * hf + 8; ++k) { const int t = tw0 + 64 * k; buf[ptw + 72 * k] = mk2(ua[k], ub[k]); buf[ptw + 72 * k + 9216] = mk2(0.f, 0.f); }
        __builtin_amdgcn_sched_barrier(0);
    }
    __syncthreads();
    fft_fwd(buf, tid);
#pragma unroll 4
    for (int k = 0; k < 32; ++k) { const int p = tid + 512 * k; const unsigned w = ZK[(unsigned)p]; { const int pp_ = ptid + 576 * k; buf[pp_] = cmul(buf[pp_], mk2(bflo(w), bfhi(w))); } }
    __syncthreads();
    fft_inv(buf, tid);
#pragma unroll
    for (int hf = 0; hf < 2; ++hf) {
        float xa[16], xb[16];
        HY_ROW8(rowx1, 0, 8 * hf, wa0, wa1, wa2, ba, xa);
        HY_ROW8(rowx1, SEQ, 8 * hf, wa0, wa1, wa2, ba, xb);
#pragma unroll
        for (int k = 8 * hf; k < 8 * hf + 8; ++k) { const int t = tw0 + 64 * k; const cf2 y = buf[ptw + 72 * k]; buf[ptw + 72 * k] = mk2(xa[k] * y.x, xb[k] * y.y); buf[ptw + 72 * k + 9216] = mk2(0.f, 0.f); }
        __builtin_amdgcn_sched_barrier(0);
    }
    __syncthreads();
    fft_fwd(buf, tid);
#pragma unroll 4
    for (int k = 0; k < 32; ++k) { const int p = tid + 512 * k; const unsigned w = ZK[(unsigned)(NFFT + p)]; { const int pp_ = ptid + 576 * k; buf[pp_] = cmul(buf[pp_], mk2(bflo(w), bfhi(w))); } }
    __syncthreads();
    fft_inv(buf, tid);
    {
        bf16_t* yrow = YBT + (size_t)c * MTOT;
#pragma unroll
        for (int hf = 0; hf < 2; ++hf) {
            float xa[16], xb[16], ga[8], gb[8];
#pragma unroll
            for (int k = 0; k < 8; ++k) { ga[k] = bf2f(rowg[(unsigned)(tw0 + 64 * (8 * hf + k))]); gb[k] = bf2f(rowg[(unsigned)(SEQ + tw0 + 64 * (8 * hf + k))]); }
            HY_ROW8(rowx2, 0, 8 * hf, wb0, wb1, wb2, bb, xa);
            HY_ROW8(rowx2, SEQ, 8 * hf, wb0, wb1, wb2, bb, xb);
#pragma unroll
            for (int k = 8 * hf; k < 8 * hf + 8; ++k) { const int t = tw0 + 64 * k; const cf2 y = buf[ptw + 72 * k];
                const float oa = xa[k] * y.x * silu_f(ga[k - 8 * hf]), ob = xb[k] * y.y * silu_f(gb[k - 8 * hf]);
                yrow[(unsigned)t] = (bf16_t)(pk2(oa, 0.f) & 0xffffu); yrow[(unsigned)(SEQ + t)] = (bf16_t)(pk2(ob, 0.f) & 0xffffu); }
            __builtin_amdgcn_sched_barrier(0);
        }
    }
#undef HY_ROW8
    __syncthreads();
}

__device__ __forceinline__ void phase_mix(CKArgs& A, int l, LAS unsigned char* lds, int bid, int nblk, int tid) {
    for (int c = bid; c < 256; c += nblk) hyena_block(A, l, c, lds, tid);
    const int nctx = (l < DEPTH - 1) ? 12 : 0;
    const int nitems = 768 + 2 * nctx;
#pragma unroll 1
    for (int it = bid; it < nitems; it += nblk) {
        int mode, item;
        if (it < 384) { mode = 0; item = it; } else if (it < 768) { mode = 1; item = it - 384; } else if (it < 768 + nctx) { mode = 2; item = it - 768; } else { mode = 3; item = it - 768 - nctx; }
        attn_block_item(A, l, mode, item, lds, tid);
    }
}

__device__ __forceinline__ void phase_tr(CKArgs& A, int l, LAS unsigned char* lds, int bid, int nblk, int tid) {
    const int wave = __builtin_amdgcn_readfirstlane(tid >> 6), lane = tid & 63;
    const int gw = bid * 8 + wave, NGW = nblk * 8;
    unsigned char* ws = A.ws;
    const bf16_t* YBT = (const bf16_t*)(ws + WS_YBT);
    bf16_t* Y = (bf16_t*)(ws + WS_HY);
    LAS bf16_t* scr = (LAS bf16_t*)(lds + wave * 16384);
    const int ntok = (l < DEPTH - 1) ? MTOT : MLAT;
    const int nitems = (ntok / 64) * 4;
#pragma unroll 1
    for (int it = gw; it < nitems; it += NGW) {
        const int tb = (it >> 2) * 64, cb = (it & 3) * 64;
#pragma unroll 8
        for (int i = 0; i < 64; ++i) scr[i * 66 + lane] = YBT[(size_t)(cb + i) * MTOT + tb + lane];
        asm volatile("s_waitcnt lgkmcnt(0)" ::: "memory");
        const int cc = (lane & 7) * 8;
#pragma unroll
        for (int k = 0; k < 8; ++k) {
            const int tq = (lane >> 3) + 8 * k;
            u32x4 o;
            o.x = (unsigned)scr[(cc + 0) * 66 + tq] | ((unsigned)scr[(cc + 1) * 66 + tq] << 16);
            o.y = (unsigned)scr[(cc + 2) * 66 + tq] | ((unsigned)scr[(cc + 3) * 66 + tq] << 16);
            o.z = (unsigned)scr[(cc + 4) * 66 + tq] | ((unsigned)scr[(cc + 5) * 66 + tq] << 16);
            o.w = (unsigned)scr[(cc + 6) * 66 + tq] | ((unsigned)scr[(cc + 7) * 66 + tq] << 16);
            *(u32x4*)(Y + (size_t)(tb + tq) * DM + 384 + cb + cc) = o;
        }
        asm volatile("s_waitcnt lgkmcnt(0)" ::: "memory");
    }
}

__device__ __forceinline__ void phase_final(CKArgs& A, int bid, int nblk, int tid) {
    const int wave = __builtin_amdgcn_readfirstlane(tid >> 6), lane = tid & 63;
    const int gw = bid * 8 + wave, NGW = nblk * 8;
    for (int m = gw; m < MLAT; m += NGW) {
        float* row = A.out + (size_t)m * DM;
        f32x4 xv[4]; float ss = 0.f;
#pragma unroll
        for (int j = 0; j < 4; ++j) { xv[j] = *(const f32x4*)(row + 4 * lane + 256 * j); ss += (xv[j].x * xv[j].x + xv[j].y * xv[j].y) + (xv[j].z * xv[j].z + xv[j].w * xv[j].w); }
        const float rinv = rsqrtf(wave_sum(ss, lane) * (1.0f / DM) + 1e-6f);
#pragma unroll
        for (int j = 0; j < 4; ++j) { const int col = 4 * lane + 256 * j; const f32x4 gv = *(const f32x4*)(A.final_g + col); *(f32x4*)(row + col) = xv[j] * rinv * gv; }
    }
}

#define XB_TMO      128
#define XB_XCNT(j)  (256  + 64 * (j))
#define XB_XSUB(j)  (1280 + 64 * (j))
#define XB_XGEN(j)  (2304 + 64 * (j))
#define XB_TOP      3328
#define XB_TOPGEN   3392
#define XCD_BAR_WORDS 3456
#define XB_SPIN_CAP (1u << 18)

__device__ __forceinline__ unsigned xb_ld(unsigned* p)              { return __hip_atomic_load(p, __ATOMIC_RELAXED, __HIP_MEMORY_SCOPE_AGENT); }
__device__ __forceinline__ unsigned xb_add(unsigned* p, unsigned v) { return __hip_atomic_fetch_add(p, v, __ATOMIC_RELAXED, __HIP_MEMORY_SCOPE_AGENT); }
__device__ __forceinline__ unsigned xb_xcc_id() { return (unsigned)__builtin_amdgcn_s_getreg((3 << 11) | 20) & 0xFu; }
#define XB_SPIN(cond, bar) do { unsigned _sp = 0; while (cond) { __builtin_amdgcn_s_sleep(1); \
    if ((++_sp & 255u) == 0u) { if (xb_ld(&(bar)[XB_TMO])) break; if (_sp > XB_SPIN_CAP) { atomicAdd(&(bar)[XB_TMO], 1u); break; } } } } while (0)

struct XcdBarrier {
    unsigned* bar; unsigned x;
    volatile LAS unsigned* st;
};

__device__ __forceinline__ XcdBarrier xcd_barrier_post(unsigned* bar, volatile LAS unsigned* st) {
    XcdBarrier b; b.bar = bar; b.x = xb_xcc_id(); b.st = st;
    if (threadIdx.x == 0) (void)xb_add(&bar[XB_XCNT(b.x)], 1u);
    return b;
}
__device__ __forceinline__ void xcd_barrier_complete(unsigned* bar, unsigned x, unsigned& nloc, unsigned& nx) {
    const unsigned G = gridDim.x * gridDim.y * gridDim.z;
    unsigned sum, cnt, mine, sp = 0u;
    for (;;) {
        sum = 0u; cnt = 0u; mine = 0u;
#pragma unroll
        for (unsigned j = 0; j < 16; ++j) { const unsigned c = xb_ld(&bar[XB_XCNT(j)]); sum += c; cnt += (c > 0u) ? 1u : 0u; mine = (j == x) ? c : mine; }
        if (sum == G) break;
        __builtin_amdgcn_s_sleep(1);
        if ((++sp & 255u) == 0u) { if (xb_ld(&bar[XB_TMO])) break; if (sp > XB_SPIN_CAP) { atomicAdd(&bar[XB_TMO], 1u); break; } }
    }
    nloc = mine > 0u ? mine : 1u; nx = cnt > 0u ? cnt : 1u;
}

__device__ __forceinline__ void xcd_barrier(const XcdBarrier& b) {
    asm volatile("s_waitcnt vmcnt(0)" ::: "memory");
    __syncthreads();
    if (threadIdx.x == 0) {
        unsigned* bar = b.bar;
        __builtin_amdgcn_s_waitcnt(0);
        unsigned nloc = b.st[0], nx = b.st[1];
        if (nloc == 0u) { xcd_barrier_complete(bar, b.x, nloc, nx); b.st[0] = nloc; b.st[1] = nx; }
        const unsigned old = xb_add(&bar[XB_XSUB(b.x)], 1u);
        const unsigned gen = old / nloc;
        if (old + 1u == (gen + 1u) * nloc) {
            __builtin_amdgcn_fence(__ATOMIC_RELEASE, "agent");
            asm volatile("s_waitcnt vmcnt(0)" ::: "memory");
            const unsigned og = xb_add(&bar[XB_TOP], 1u);
            const unsigned tg = og / nx;
            if (og + 1u == (tg + 1u) * nx) xb_add(&bar[XB_TOPGEN], 1u);
            else XB_SPIN(xb_ld(&bar[XB_TOPGEN]) == tg, bar);
            __builtin_amdgcn_fence(__ATOMIC_ACQUIRE, "agent");
            xb_add(&bar[XB_XGEN(b.x)], 1u);
            asm volatile("s_waitcnt vmcnt(0)" ::: "memory");
        } else {
            XB_SPIN(xb_ld(&bar[XB_XGEN(b.x)]) == gen, bar);
            __builtin_amdgcn_fence(__ATOMIC_ACQUIRE, "agent");
            asm volatile("s_waitcnt vmcnt(0)" ::: "memory");
        }
    }
    __syncthreads();
}


constexpr int NPHASE = 2 + 5 * DEPTH;
__global__ void __launch_bounds__(NTHREADS, 2) hybrid_fwd(KArgs Aval) {
    extern __shared__ __attribute__((aligned(16))) unsigned char lds_raw[];
    LAS unsigned char* lds = (LAS unsigned char*)lds_raw;
    const int tid0 = threadIdx.x, bid = blockIdx.x, nblk = gridDim.x;
#if !MK_MULTI
    volatile LAS unsigned* bst = (volatile LAS unsigned*)(lds + AUX_OFF + 8192);
    if (tid0 < 2) bst[tid0] = 0u;
    __syncthreads();
    const XcdBarrier bar = xcd_barrier_post((unsigned*)Aval.ws, bst);
#endif
#ifndef REP_PH
#define REP_PH 1000
#endif
#pragma unroll 1
    for (int pi = Aval.ph_lo; pi < Aval.ph_hi + (REP_PH < 1000 ? 1 : 0); ++pi) {
        const int ph = pi <= REP_PH ? pi : pi - 1;
#if !MK_MULTI
        if (pi > Aval.ph_lo) { if (Aval.ph_hi > 100000) cg::this_grid().sync(); else xcd_barrier(bar); }
#endif
#ifndef ONLY
#define ONLY -1
#endif
#define EN(k) (ONLY < 0 || ((ONLY >> (k)) & 1))
        int tid = tid0; asm volatile("" : "+v"(tid));
        CKArgs* Ap = (CKArgs*)__builtin_amdgcn_kernarg_segment_ptr(); asm volatile("" : "+s"(Ap));
        CKArgs& A = *Ap;
        unsigned char* ws = A.ws;
        if (ph == 0) { if (EN(0)) phase_prologue(A, lds, bid, nblk, tid); }
        else if (ph == NPHASE - 1) { if (EN(6)) phase_final(A, bid, nblk, tid); }
        else {
            const int l = (ph - 1) / 5, k = (ph - 1) % 5;
            if (k == 0) { if (EN(1)) phase_norm(A, l, bid, nblk, tid); }
            else if (k == 2) { if (EN(3)) phase_mix(A, l, lds, bid, nblk, tid); }
            else if (k == 3) { if (EN(4)) phase_tr(A, l, lds, bid, nblk, tid); }
            if (k == 1 || k == 4) {
                pg8::Gemm g; EpiAll E; E.l = l; E.Ap = Ap; g.A = (const bf16_t*)(ws + WS_HY); g.K = DM;
                if (k == 1) { g.Bt = (const bf16_t*)(ws + WS_WIN) + (size_t)l * NIN * DM; g.M = MTOT; g.N = NIN; E.mode = 0; }
                else { g.Bt = (const bf16_t*)(ws + WS_WOUT) + (size_t)l * DM * DM; g.M = (l < DEPTH - 1) ? MTOT : MLAT; g.N = DM; E.mode = 1; }
                pg8::StaticOrder S; S.init(g.M, g.N, nblk, bid);
                if (EN(2)) pg8::gemm_phase<EpiAll, pg8::StaticOrder, true, true>(lds, g, S, E, tid);
            }
        }
    }
}

extern "C" void kernel_launch(void* const* d_in, const int* in_sizes, int n_in, void* d_out, int out_size, void* d_ws, size_t ws_size, hipStream_t stream) {
    static int grid = 0;
    if (grid == 0) {
        if (n_in != 22 || ws_size < WS_END) { fprintf(stderr, "kernel_launch: unexpected inputs (n_in %d, ws %zu)\n", n_in, ws_size); grid = -1; return; }
        int dev = 0, cus = 0, per_cu = 0;
        if (hipGetDevice(&dev) != hipSuccess || hipDeviceGetAttribute(&cus, hipDeviceAttributeMultiprocessorCount, dev) != hipSuccess) { grid = -1; return; }
        if (hipFuncSetAttribute((const void*)hybrid_fwd, hipFuncAttributeMaxDynamicSharedMemorySize, LDS_BYTES) != hipSuccess) { fprintf(stderr, "kernel_launch: hipFuncSetAttribute failed\n"); grid = -1; return; }
        if (hipOccupancyMaxActiveBlocksPerMultiprocessor(&per_cu, (const void*)hybrid_fwd, NTHREADS, LDS_BYTES) != hipSuccess || per_cu < 1) { fprintf(stderr, "kernel_launch: occupancy query says %d\n", per_cu); per_cu = 1; }
        (void)hipGetLastError();
        grid = cus;
    }
    if (grid < 0) return;
    KArgs a{};
    a.x = (const float*)d_in[0]; a.c = (const float*)d_in[1]; a.ctx = (const float*)d_in[2]; a.c_ctx = (const float*)d_in[3]; a.norm_g = (const float*)d_in[4];
    a.w_ada = (const float*)d_in[5]; a.b_ada = (const float*)d_in[6]; a.w_in = (const float*)d_in[7]; a.w_out = (const float*)d_in[8]; a.na_rpb = (const float*)d_in[9];
    a.hy_conv_w = (const float*)d_in[10]; a.hy_conv_b = (const float*)d_in[11]; a.hy_w1 = (const float*)d_in[12]; a.hy_b1 = (const float*)d_in[13]; a.hy_freq1 = (const float*)d_in[14];
    a.hy_w2 = (const float*)d_in[15]; a.hy_b2 = (const float*)d_in[16]; a.hy_freq2 = (const float*)d_in[17]; a.hy_w3 = (const float*)d_in[18]; a.hy_d = (const float*)d_in[19];
    a.sink = (const float*)d_in[20]; a.final_g = (const float*)d_in[21];
    a.out = (float*)d_out; a.ws = (unsigned char*)d_ws;
#if MK_MULTI
    for (int ph = 0; ph < NPHASE; ++ph) {
        a.ph_lo = ph; a.ph_hi = ph + 1;
        hipLaunchKernelGGL(hybrid_fwd, dim3(grid), dim3(NTHREADS), LDS_BYTES, stream, a);
    }
#else
    if (hipMemsetAsync(d_ws, 0, 16384, stream) != hipSuccess) { fprintf(stderr, "kernel_launch: memset of the barrier words failed\n"); return; }
    a.ph_lo = 0; a.ph_hi = NPHASE;
    void* args[] = {&a};
    hipError_t e = hipLaunchCooperativeKernel((const void*)hybrid_fwd, dim3(grid), dim3(NTHREADS), args, LDS_BYTES, stream);
    if (e != hipSuccess) fprintf(stderr, "cooperative launch failed: %s (grid %d)\n", hipGetErrorString(e), grid);
#endif
}
```

```cpp
#include <hip/hip_runtime.h>
#include <hip/hip_cooperative_groups.h>
#include <cstdio>
#include <cstdint>
namespace cg = cooperative_groups;

#ifndef MK_MULTI
#define MK_MULTI 0
#endif

namespace pg8 {
#define PG8_LAS __attribute__((address_space(3)))
typedef unsigned short bf16_t;
typedef short bf16x8 __attribute__((ext_vector_type(8)));
typedef float f32x4 __attribute__((ext_vector_type(4)));
typedef unsigned u32x4 __attribute__((ext_vector_type(4)));
constexpr int BM = 256, BK = 64, HALF = 128, HTB = HALF * BK * 2  , STAGE_BYTES = 8 * HTB, NXCD = 8, WGM = 8;

__host__ __device__ __forceinline__ int lds_byte(int r, int c) { const int st = (r >> 4) * 2 + (c >> 5), rr = r & 15, cc = c & 31, ob = rr * 64 + cc * 2; return st * 1024 + (ob ^ (((ob >> 9) & 1) << 5)); }
__host__ __device__ __forceinline__ void stage_rc(int b, int& R, int& C) { const int st = b / 1024, sb = b % 1024, swz = sb ^ (((sb >> 9) & 1) << 5); R = (st >> 1) * 16 + swz / 64; C = (st & 1) * 32 + (swz % 64) / 2; }
__host__ __device__ __forceinline__ int perm32(int rho) { const int n = rho >> 4, i = rho & 15; return 8 * (i >> 2) + 4 * n + (i & 3); }

struct Unit { int pm, pn; };
struct Gemm { const bf16_t* A; const bf16_t* Bt; int M, N, K; };

struct StaticOrder {
    int nM, nN, nwg, G, c;
    __host__ __device__ void init(int M, int N, int G_, int c_) { nM = M / BM; nN = N / BM; nwg = nM * nN; G = G_; c = c_; }
    __host__ __device__ bool next(int i, Unit& u) const {
        const long L = (long)i * G + c; if (L >= nwg) return false;
        int wgid = (int)L; { const int q = nwg / NXCD, r = nwg % NXCD, xcd = wgid % NXCD, off = wgid / NXCD; wgid = (xcd < r ? xcd * (q + 1) : r * (q + 1) + (xcd - r) * q) + off; }
        const int nig = WGM * nN, gid = wgid / nig, fm = gid * WGM, gsz = (nM - fm) < WGM ? (nM - fm) : WGM;
        u.pm = fm + ((wgid % nig) % gsz); u.pn = (wgid % nig) / gsz; return true;
    }
    __device__ __forceinline__ void a_ready(const Unit&) const {}
    __device__ __forceinline__ void done(const Unit&) const {}
};

template <class Epi, class Sched, bool ALIGN_EPI = false, bool SP2 = false>
__device__ __forceinline__ void gemm_phase(PG8_LAS unsigned char* lds, const Gemm g, const Sched& S, const Epi& E, const int tid) {
    const int wid = __builtin_amdgcn_readfirstlane(tid >> 6), lane = tid & 63, wr = wid >> 2, wc = wid & 3, fr = lane & 15, fq = lane >> 4;
    const int K = g.K, nt = K / BK;
    unsigned voffA[2], voffB[2];
#pragma unroll
    for (int i = 0; i < 2; ++i) { int R, C; stage_rc(tid * 16 + i * 8192, R, C); const int Rb = Epi::PERM ? ((R & ~31) + perm32(R & 31)) : R;
        voffA[i] = (unsigned)(R * K + C) * 2u; voffB[i] = (unsigned)(Rb * K + C) * 2u; }
    const size_t kstep = (size_t)(BK * 2);
    const size_t hstep = (size_t)HALF * K * 2;
    const size_t tstep = 2 * hstep;
    const unsigned ldsw = (unsigned)wid * 1024u;
    const int aoff = lds_byte(wr * 64 + fr, fq * 8), boff = lds_byte(wc * 32 + fr, fq * 8);
#define PG8_SA(b, h) (((b) * 2 + (h)) * HTB)
#define PG8_SB(b, h) ((4 + (b) * 2 + (h)) * HTB)
#define PG8_STAGE(bufoff, gbase, voff) do { _Pragma("unroll") for (int _i = 0; _i < 2; ++_i) \
        __builtin_amdgcn_global_load_lds((const unsigned*)((const char*)(gbase) + (voff)[_i]), (PG8_LAS unsigned*)(lds + (bufoff) + ldsw + _i * 8192), 16, 0, 0); } while (0)
#define PG8_LDA(dst, b, h) do { _Pragma("unroll") for (int m = 0; m < 4; ++m) _Pragma("unroll") for (int k = 0; k < 2; ++k) dst[m][k] = *(const PG8_LAS bf16x8*)(lds + PG8_SA(b, h) + aoff + m * 2048 + k * 1024); } while (0)
#define PG8_LDB(dst, b, h) do { _Pragma("unroll") for (int n = 0; n < 2; ++n) _Pragma("unroll") for (int k = 0; k < 2; ++k) dst[n][k] = *(const PG8_LAS bf16x8*)(lds + PG8_SB(b, h) + boff + n * 2048 + k * 1024); } while (0)
#define PG8_MMA(ai, bj, At, Bt) do { __builtin_amdgcn_s_setprio(1); _Pragma("unroll") for (int m = 0; m < 4; ++m) _Pragma("unroll") for (int n = 0; n < 2; ++n) _Pragma("unroll") for (int k = 0; k < 2; ++k) \
        acc[ai][bj][m][n] = __builtin_amdgcn_mfma_f32_16x16x32_bf16(Bt[n][k], At[m][k], acc[ai][bj][m][n], 0, 0, 0); __builtin_amdgcn_s_setprio(0); } while (0)
#define PG8_WAIT_V(n) asm volatile("s_waitcnt vmcnt(" #n ")" ::: "memory")
#define PG8_WAIT_L(n) asm volatile("s_waitcnt lgkmcnt(" #n ")" ::: "memory")
#define PG8_BAR __builtin_amdgcn_s_barrier()
#define PG8_SCHED __builtin_amdgcn_sched_barrier(0)
    Unit cur, nxt; int ui = 0;
    if (!S.next(0, cur)) return;
    f32x4 acc[2][2][4][2];
#pragma unroll
    for (int a = 0; a < 2; ++a)
#pragma unroll
        for (int b = 0; b < 2; ++b)
#pragma unroll
            for (int m = 0; m < 4; ++m)
#pragma unroll
                for (int n = 0; n < 2; ++n) acc[a][b][m][n] = (f32x4){0.f, 0.f, 0.f, 0.f};
    bf16x8 At[4][2], B0[2][2], B1[2][2];
    const char* cA = (const char*)g.A + (size_t)cur.pm * tstep; const char* cB = (const char*)g.Bt + (size_t)cur.pn * tstep;
    S.a_ready(cur);
    if constexpr (SP2) {
        PG8_STAGE(PG8_SB(0, 0), cB, voffB); PG8_STAGE(PG8_SB(0, 1), cB + hstep, voffB); PG8_STAGE(PG8_SA(0, 0), cA, voffA); PG8_STAGE(PG8_SA(0, 1), cA + hstep, voffA);
        if (wr == 1) PG8_BAR;
        PG8_WAIT_V(2); PG8_BAR;
        PG8_STAGE(PG8_SB(1, 0), cB + kstep, voffB); PG8_STAGE(PG8_SA(1, 0), cA + kstep, voffA); PG8_STAGE(PG8_SB(1, 1), cB + hstep + kstep, voffB);
        PG8_WAIT_V(6); PG8_BAR;
    } else {
        PG8_STAGE(PG8_SB(0, 0), cB, voffB); PG8_STAGE(PG8_SA(0, 0), cA, voffA); PG8_STAGE(PG8_SB(0, 1), cB + hstep, voffB); PG8_STAGE(PG8_SA(0, 1), cA + hstep, voffA);
        if (wr == 1) PG8_BAR;
        PG8_WAIT_V(4); PG8_BAR;
        PG8_STAGE(PG8_SB(1, 0), cB + kstep, voffB); PG8_STAGE(PG8_SA(1, 0), cA + kstep, voffA); PG8_STAGE(PG8_SB(1, 1), cB + hstep + kstep, voffB);
        PG8_WAIT_V(6); PG8_BAR;
    }
    for (;;) {
        const bool has_next = S.next(ui + 1, nxt);
        const char* nA = has_next ? (const char*)g.A + (size_t)nxt.pm * tstep : cA; const char* nB = has_next ? (const char*)g.Bt + (size_t)nxt.pn * tstep : cB;
        for (int t = 0; t < nt; t += 2) {
            const bool last = (t == nt - 2);
            const char* a1 = cA + (size_t)(t + 1) * kstep;
            const char* a2 = last ? nA : cA + (size_t)(t + 2) * kstep; const char* b2 = last ? nB : cB + (size_t)(t + 2) * kstep;
            const char* a3 = a2 + kstep; const char* b3 = b2 + kstep;
            if (last && has_next) S.a_ready(nxt);
            if constexpr (SP2) {
            PG8_LDB(B0, 0, 0); PG8_LDB(B1, 0, 1); PG8_SCHED; PG8_LDA(At, 0, 0); PG8_STAGE(PG8_SA(1, 1), a1 + hstep, voffA);
            PG8_WAIT_V(8); PG8_WAIT_L(0); PG8_BAR; PG8_MMA(0, 0, At, B0); PG8_MMA(0, 1, At, B1); PG8_BAR; PG8_SCHED;
            PG8_LDA(At, 0, 1); PG8_STAGE(PG8_SB(0, 0), b2, voffB); PG8_STAGE(PG8_SB(0, 1), b2 + hstep, voffB); PG8_STAGE(PG8_SA(0, 0), a2, voffA);
            PG8_WAIT_V(8); PG8_WAIT_L(0); PG8_BAR; PG8_MMA(1, 0, At, B0); PG8_MMA(1, 1, At, B1); PG8_BAR; PG8_SCHED;
            PG8_LDB(B0, 1, 0); PG8_LDB(B1, 1, 1); PG8_SCHED; PG8_LDA(At, 1, 0); PG8_STAGE(PG8_SA(0, 1), a2 + hstep, voffA);
            PG8_WAIT_V(8); PG8_WAIT_L(0); PG8_BAR; PG8_MMA(0, 0, At, B0); PG8_MMA(0, 1, At, B1); PG8_BAR; PG8_SCHED;
            PG8_LDA(At, 1, 1); PG8_STAGE(PG8_SB(1, 0), b3, voffB); PG8_STAGE(PG8_SB(1, 1), b3 + hstep, voffB); PG8_STAGE(PG8_SA(1, 0), a3, voffA);
            PG8_WAIT_V(8); PG8_WAIT_L(0); PG8_BAR; PG8_MMA(1, 0, At, B0); PG8_MMA(1, 1, At, B1); PG8_BAR; PG8_SCHED;
            } else {
            PG8_LDB(B0, 0, 0); PG8_SCHED; PG8_LDA(At, 0, 0); PG8_STAGE(PG8_SA(1, 1), a1 + hstep, voffA);
            PG8_WAIT_L(8); PG8_BAR; PG8_WAIT_L(0); PG8_MMA(0, 0, At, B0); PG8_BAR; PG8_SCHED;
            PG8_LDB(B1, 0, 1); PG8_STAGE(PG8_SB(0, 0), b2, voffB);
            PG8_BAR; PG8_WAIT_L(0); PG8_MMA(0, 1, At, B1); PG8_BAR;
            PG8_LDA(At, 0, 1); PG8_STAGE(PG8_SA(0, 0), a2, voffA);
            PG8_BAR; PG8_WAIT_L(0); PG8_MMA(1, 0, At, B0); PG8_BAR; PG8_SCHED;
            PG8_STAGE(PG8_SB(0, 1), b2 + hstep, voffB);
            PG8_WAIT_V(6); PG8_BAR; PG8_MMA(1, 1, At, B1); PG8_BAR;
            PG8_LDB(B0, 1, 0); PG8_SCHED; PG8_LDA(At, 1, 0); PG8_STAGE(PG8_SA(0, 1), a2 + hstep, voffA);
            PG8_WAIT_L(8); PG8_BAR; PG8_WAIT_L(0); PG8_MMA(0, 0, At, B0); PG8_BAR; PG8_SCHED;
            PG8_LDB(B1, 1, 1); PG8_STAGE(PG8_SB(1, 0), b3, voffB);
            PG8_BAR; PG8_WAIT_L(0); PG8_MMA(0, 1, At, B1); PG8_BAR;
            PG8_LDA(At, 1, 1); PG8_STAGE(PG8_SA(1, 0), a3, voffA);
            PG8_BAR; PG8_WAIT_L(0); PG8_MMA(1, 0, At, B0); PG8_BAR; PG8_SCHED;
            PG8_STAGE(PG8_SB(1, 1), b3 + hstep, voffB);
            PG8_WAIT_V(6); PG8_BAR; PG8_MMA(1, 1, At, B1); PG8_BAR;
            }
        }
        if constexpr (ALIGN_EPI) { if (wr == 0) PG8_BAR; }
        if constexpr (!Epi::AFTER_DRAIN) { E(acc, cur, wr, wc, fr, fq); S.done(cur); }
        if (!has_next) break;
#pragma unroll
        for (int a = 0; a < 2; ++a)
#pragma unroll
            for (int b = 0; b < 2; ++b)
#pragma unroll
                for (int m = 0; m < 4; ++m)
#pragma unroll
                    for (int n = 0; n < 2; ++n) acc[a][b][m][n] = (f32x4){0.f, 0.f, 0.f, 0.f};
        cur = nxt; cA = nA; cB = nB; ++ui;
        if constexpr (ALIGN_EPI) { if (wr == 1) PG8_BAR; }
    }
    PG8_WAIT_V(0);
    if constexpr (!ALIGN_EPI) { if (wr == 0) PG8_BAR; }
    PG8_BAR;
    if constexpr (Epi::AFTER_DRAIN) { E.fused(acc, cur, wr, wc, fr, fq, lds, wid, lane); S.done(cur); }
#undef PG8_SA
#undef PG8_SB
#undef PG8_STAGE
#undef PG8_LDA
#undef PG8_LDB
#undef PG8_MMA
#undef PG8_WAIT_V
#undef PG8_WAIT_L
#undef PG8_BAR
#undef PG8_SCHED
}
}

#define LAS __attribute__((address_space(3)))
typedef unsigned short bf16_t;
typedef short bf16x8 __attribute__((ext_vector_type(8)));
typedef float f32x4 __attribute__((ext_vector_type(4)));
typedef float f32x16 __attribute__((ext_vector_type(16)));
typedef unsigned u32x2 __attribute__((ext_vector_type(2)));
typedef unsigned u32x4 __attribute__((ext_vector_type(4)));
typedef float f32x2_t __attribute__((ext_vector_type(2)));
typedef __bf16 bf16x2_t __attribute__((ext_vector_type(2)));

constexpr int DM = 1024, NBATCH = 2, SEQ = 8192, DEPTH = 4, CTXL = 256;
constexpr int MLAT = NBATCH * SEQ, MCTX = NBATCH * CTXL, MTOT = MLAT + MCTX;
constexpr int NIN = 3584, NTM = 1536, NCM = 1024, NTB = MTOT / 64;
constexpr int C_QA = 0, C_GA = 384, C_QC = 768, C_GC = 1152;
constexpr int R_HZ = 0, R_GB = 768;
constexpr int NFFT = 16384;
constexpr float LOG2E = 1.4426950408889634f;
constexpr float QK_SCALE = 0.125f * LOG2E;

constexpr size_t MiB = 1u << 20;
constexpr size_t WS_ADA = 1 * MiB;
constexpr size_t WS_ROPE = 1 * MiB + 256 * 1024;
constexpr size_t WS_H2C = 1 * MiB + 512 * 1024;
constexpr size_t WS_CX = 2 * MiB;
constexpr size_t WS_H2 = 4 * MiB;
constexpr size_t WS_WIN = 12 * MiB;
constexpr size_t WS_WOUT = 40 * MiB;
constexpr size_t WS_HY = 48 * MiB;
constexpr size_t WS_PT = 81 * MiB;
constexpr size_t WS_KH = 130 * MiB + 512 * 1024;
constexpr size_t WS_VT = 147 * MiB;
constexpr size_t WS_PCT = 163 * MiB + 512 * 1024;
constexpr size_t WS_YBT = 197 * MiB;
constexpr size_t WS_ZS = 206 * MiB;
constexpr size_t WS_W3T = 238 * MiB;
constexpr size_t WS_FILT = 239 * MiB;
constexpr size_t WS_END = 255 * MiB;
static_assert(WS_PT + (size_t)MTOT * NTM * 2 <= WS_KH && WS_KH + (size_t)8 * MTOT * 128 <= WS_VT && WS_VT + (size_t)8 * MTOT * 128 <= WS_PCT && WS_PCT + (size_t)NCM * MTOT * 2 <= WS_YBT, "d_ws map");

constexpr int AUX_OFF = 147456;
constexpr int LDS_BYTES = 163840;
constexpr int NTHREADS = 512;

struct KArgs {
    const float* x; const float* c; const float* ctx; const float* c_ctx; const float* norm_g; const float* w_ada; const float* b_ada;
    const float* w_in; const float* w_out; const float* na_rpb; const float* hy_conv_w; const float* hy_conv_b;
    const float* hy_w1; const float* hy_b1; const float* hy_freq1; const float* hy_w2; const float* hy_b2; const float* hy_freq2; const float* hy_w3;
    const float* hy_d; const float* sink; const float* final_g;
    float* out; unsigned char* ws;
    int ph_lo, ph_hi;
};

typedef const __attribute__((address_space(4))) KArgs CKArgs;
__device__ __forceinline__ unsigned pk2(float lo, float hi) { f32x2_t v = {lo, hi}; bf16x2_t b = __builtin_convertvector(v, bf16x2_t); return __builtin_bit_cast(unsigned, b); }
__device__ __forceinline__ float bf2f(unsigned short u) { return __uint_as_float(((unsigned)u) << 16); }
__device__ __forceinline__ float bflo(unsigned w) { return __uint_as_float(w << 16); }
__device__ __forceinline__ float bfhi(unsigned w) { return __uint_as_float(w & 0xffff0000u); }
__device__ __forceinline__ float silu_f(float x) { return x / (1.0f + __expf(-x)); }
__device__ __forceinline__ float lane_xor(float v, int lane, int m) { return __int_as_float(__builtin_amdgcn_ds_bpermute((lane ^ m) << 2, __float_as_int(v))); }
__device__ __forceinline__ float lane_prev(float v, int lane) { return __int_as_float(__builtin_amdgcn_ds_bpermute(((lane - 1) & 63) << 2, __float_as_int(v))); }
__device__ __forceinline__ float lane_next(float v, int lane) { return __int_as_float(__builtin_amdgcn_ds_bpermute(((lane + 1) & 63) << 2, __float_as_int(v))); }
__device__ __forceinline__ float wave_sum(float v, int lane) {
#pragma unroll
    for (int o = 1; o < 64; o <<= 1) v += lane_xor(v, lane, o);
    return v;
}
__device__ __forceinline__ float rdlane(float v, int l) { return __uint_as_float(__builtin_amdgcn_readlane(__float_as_uint(v), l)); }

__device__ __forceinline__ void transpose_item(const float* W, int K, int N, bf16_t* WT, int k0, int n0, int drow0, LAS float* scr, int lane, int ldk = 0) {
    if (ldk == 0) ldk = K;
#pragma unroll 8
    for (int i = 0; i < 32; ++i) { const int kk = 2 * i + (lane >> 5); scr[kk * 33 + (lane & 31)] = W[(size_t)(k0 + kk) * N + n0 + (lane & 31)]; }
    asm volatile("s_waitcnt lgkmcnt(0)" ::: "memory");
    const int c = lane & 7;
#pragma unroll
    for (int j = 0; j < 4; ++j) { const int n = (lane >> 3) + 8 * j; const LAS float* s = scr + (8 * c) * 33 + n;
        u32x4 o; o.x = pk2(s[0 * 33], s[1 * 33]); o.y = pk2(s[2 * 33], s[3 * 33]); o.z = pk2(s[4 * 33], s[5 * 33]); o.w = pk2(s[6 * 33], s[7 * 33]);
        *(u32x4*)(WT + (size_t)(drow0 + n) * ldk + k0 + 8 * c) = o; }
    asm volatile("s_waitcnt lgkmcnt(0)" ::: "memory");
}
__device__ __forceinline__ int win_row(int n0) {
    if (n0 < 384) return n0;
    if (n0 < 768) return n0 - 384 + 1536;
    if (n0 < 1152) return n0 - 768 + 2048;
    if (n0 < 1536) return n0 - 1152 + 384;
    if (n0 < 2304) return n0 - 1536 + 2560;
    if (n0 < 2560) return n0 - 2304 + 3328;
    if (n0 < 2944) return n0 - 2560 + 768;
    if (n0 < 3072) return n0 - 2944 + 1920;
    if (n0 < 3200) return n0 - 3072 + 2432;
    return n0 - 3200 + 1152;
}

__device__ __forceinline__ void phase_prologue(CKArgs& A, LAS unsigned char* lds, int bid, int nblk, int tid) {
    const int wave = __builtin_amdgcn_readfirstlane(tid >> 6), lane = tid & 63;
    const int gw = bid * 8 + wave, NGW = nblk * 8;
    unsigned char* ws = A.ws;
    {
        LAS float* scr = (LAS float*)(lds + wave * 16384);
        constexpr int I_IN = 16 * 112, I_OUT = 16 * 32, I_L = I_IN + I_OUT;
        for (int it = gw; it < DEPTH * I_L; it += NGW) {
            const int l = it / I_L; int r = it % I_L;
            if (r < I_IN) { const int kb = r / 112, nb = r % 112, n0 = nb * 32;
                transpose_item(A.w_in + (size_t)l * DM * NIN, DM, NIN, (bf16_t*)(ws + WS_WIN) + (size_t)l * NIN * DM, kb * 64, n0, win_row(n0), scr, lane); }
            else { r -= I_IN; const int kb = r / 32, nb = r % 32, n0 = nb * 32;
                transpose_item(A.w_out + (size_t)l * DM * DM, DM, DM, (bf16_t*)(ws + WS_WOUT) + (size_t)l * DM * DM, kb * 64, n0, n0, scr, lane); }
        }
    }
    {
        LAS float* scr = (LAS float*)(lds + wave * 16384);
        bf16_t* W3T = (bf16_t*)(ws + WS_W3T);
        for (int it = gw; it < DEPTH * 32; it += NGW) { const int l = it >> 5, nb = it & 31;
            transpose_item(A.hy_w3 + (size_t)l * 64 * 1024, 64, 1024, W3T + (size_t)l * 1024 * 64, 0, nb * 32, nb * 32, scr, lane); }
    }
    for (int idx = gw * 64 + lane; idx < 128 * 16; idx += NGW * 64) {
        const int p = idx >> 4, i = idx & 15;
        const float inv = powf(10000.0f, -(float)i / 16.0f);
        const float ang = (float)p * inv;
        ((float2*)(ws + WS_ROPE))[idx] = make_float2(cosf(ang), sinf(ang));
    }
    for (int it = gw; it < DEPTH * 528; it += NGW) {
        const int l = it / 528, g4 = it % 528, g = g4 >> 2, sub = g4 & 3;
        const int L = g < 128 ? SEQ : CTXL;
        const int n0 = (g < 128 ? g * 64 : (g - 128) * 64) + 16 * sub;
        float* outp = (float*)(ws + WS_H2C) + ((size_t)l * CTXL + n0) * 64;
        bf16_t* outb = (bf16_t*)(ws + WS_H2) + ((size_t)l * SEQ + n0) * 64;
        float w1c[33], w2c[64];
#pragma unroll
        for (int q = 0; q < 33; ++q) w1c[q] = A.hy_w1[((size_t)l * 33 + q) * 64 + lane];
#pragma unroll
        for (int j = 0; j < 64; ++j) w2c[j] = A.hy_w2[((size_t)l * 64 + j) * 64 + lane];
        const float b1 = A.hy_b1[l * 64 + lane], fr1 = A.hy_freq1[l * 64 + lane], b2 = A.hy_b2[l * 64 + lane], fr2 = A.hy_freq2[l * 64 + lane];
        const float tstep = 1.0f / (float)(L - 1), wstep = 6.283185307179586f / (float)L;
        const int fj = lane == 0 ? 0 : ((lane - 1) & 15);
        const float fq = 1e-4f + (float)fj * ((15.0f - 1e-4f) / 15.0f);
#pragma unroll 1
        for (int nn = 0; nn < 16; ++nn) {
            const int n = n0 + nn;
            const float t = (float)n * tstep, wa = (float)n * wstep;
            float zq;
            if (lane == 0) zq = t; else if (lane <= 16) zq = cosf(fq * wa); else if (lane <= 32) zq = -sinf(fq * wa); else zq = 0.f;
            float a1 = b1;
#pragma unroll
            for (int q = 0; q < 33; ++q) a1 += rdlane(zq, q) * w1c[q];
            const float h1 = sinf(fr1 * a1);
            float a2 = b2;
#pragma unroll
            for (int j = 0; j < 64; ++j) a2 += rdlane(h1, j) * w2c[j];
            const float h2 = sinf(fr2 * a2);
            if (g < 128) outb[nn * 64 + lane] = (bf16_t)(pk2(h2, 0.f) & 0xffffu);
            else outp[nn * 64 + lane] = h2;
        }
    }
    __syncthreads();
    {
        LAS float* red = (LAS float*)lds;
        LAS float* sv = (LAS float*)(lds + 8192);
        for (int i = tid; i < 3 * DM; i += NTHREADS) sv[i] = silu_f(i < 2 * DM ? A.c[i] : A.c_ctx[i - 2 * DM]);
        __syncthreads();
        for (int it = bid; it < DEPTH * 48; it += nblk) {
            const int l = it / 48, n = (it % 48) * 64 + lane;
            const float* W = A.w_ada + (size_t)l * DM * 3072 + n;
            float a0 = 0.f, a1 = 0.f, a2 = 0.f;
            const int kb = wave * 128;
#pragma unroll 1
            for (int k0 = 0; k0 < 128; k0 += 16) {
                float w[16];
#pragma unroll
                for (int k = 0; k < 16; ++k) w[k] = W[(size_t)(kb + k0 + k) * 3072];
#pragma unroll
                for (int k = 0; k < 16; ++k) { a0 += sv[kb + k0 + k] * w[k]; a1 += sv[DM + kb + k0 + k] * w[k]; a2 += sv[2 * DM + kb + k0 + k] * w[k]; }
            }
            red[(wave * 3 + 0) * 64 + lane] = a0; red[(wave * 3 + 1) * 64 + lane] = a1; red[(wave * 3 + 2) * 64 + lane] = a2;
            __syncthreads();
            if (tid < 192) { const int v = tid >> 6; float sacc = A.b_ada[l * 3072 + n];
#pragma unroll
                for (int w = 0; w < 8; ++w) sacc += red[(w * 3 + v) * 64 + lane];
                ((float*)(ws + WS_ADA))[((size_t)l * 3 + v) * 3072 + n] = sacc; }
            __syncthreads();
        }
    }
}

__device__ __forceinline__ void filt_items(CKArgs& A, int lf, int tid, int bid, int nblk, unsigned* ctr) {
    unsigned char* ws = A.ws;
    const int wave = __builtin_amdgcn_readfirstlane(tid >> 6), lane = tid & 63;
    const int gw = bid * 8 + wave, NGW = nblk * 8;
    const bf16_t* H2B = (const bf16_t*)(ws + WS_H2) + (size_t)lf * SEQ * 64;
    const bf16_t* W3T = (const bf16_t*)(ws + WS_W3T) + (size_t)lf * 1024 * 64;
    bf16_t* FILT = (bf16_t*)(ws + WS_FILT);
    const int fr = lane & 15, fq = lane >> 4;
    int it = gw;
#pragma unroll 1
    for (;;) {
        if (ctr) { unsigned t = 0; if (lane == 0) t = __hip_atomic_fetch_add(ctr, 1u, __ATOMIC_RELAXED, __HIP_MEMORY_SCOPE_AGENT); it = (int)__builtin_amdgcn_readfirstlane(t); }
        if (it >= 2048) break;
        const int n0 = (it >> 4) * 64, c0 = (it & 15) * 64;
        bf16x8 af[4][2];
#pragma unroll
        for (int j = 0; j < 4; ++j) { const bf16_t* ap = H2B + (size_t)(n0 + 16 * (fr >> 2) + 4 * j + (fr & 3)) * 64 + 8 * fq; af[j][0] = *(const bf16x8*)ap; af[j][1] = *(const bf16x8*)(ap + 32); }
#pragma unroll 1
        for (int ct = 0; ct < 4; ++ct) {
            const bf16_t* bp = W3T + (size_t)(c0 + 16 * ct + fr) * 64 + 8 * fq;
            const bf16x8 b0 = *(const bf16x8*)bp, b1 = *(const bf16x8*)(bp + 32);
            u32x4 o0, o1;
#pragma unroll
            for (int j = 0; j < 4; ++j) {
                f32x4 acc = {0.f, 0.f, 0.f, 0.f};
                acc = __builtin_amdgcn_mfma_f32_16x16x32_bf16(af[j][0], b0, acc, 0, 0, 0);
                acc = __builtin_amdgcn_mfma_f32_16x16x32_bf16(af[j][1], b1, acc, 0, 0, 0);
                const unsigned w0 = pk2(acc.x, acc.y), w1 = pk2(acc.z, acc.w);
                if (j == 0) { o0.x = w0; o0.y = w1; } else if (j == 1) { o0.z = w0; o0.w = w1; } else if (j == 2) { o1.x = w0; o1.y = w1; } else { o1.z = w0; o1.w = w1; }
            }
            bf16_t* dp = FILT + (size_t)(c0 + 16 * ct + fr) * SEQ + n0 + 16 * fq;
            *(u32x4*)dp = o0; *(u32x4*)(dp + 8) = o1;
        }
        if (!ctr) it += NGW;
    }
}

__device__ __forceinline__ void phase_norm(CKArgs& A, int l, int bid, int nblk, int tid) {
    const int wave = __builtin_amdgcn_readfirstlane(tid >> 6), lane = tid & 63;
    const int gw = bid * 8 + wave, NGW = nblk * 8;
    unsigned char* ws = A.ws;
    bf16_t* H = (bf16_t*)(ws + WS_HY);
    const float* ada = (const float*)(ws + WS_ADA) + (size_t)l * 3 * 3072;
    const float* g = A.norm_g + l * DM;
    for (int m = gw; m < MTOT; m += NGW) {
        const float* src; int v;
        if (m < MLAT) { src = (l == 0 ? A.x : A.out) + (size_t)m * DM; v = m >> 13; }
        else { src = (l == 0 ? A.ctx : (const float*)(ws + WS_CX)) + (size_t)(m - MLAT) * DM; v = 2; }
        const float* shp = ada + v * 3072; const float* scp = shp + DM;
        f32x4 xv[4]; float ss = 0.f;
#pragma unroll
        for (int j = 0; j < 4; ++j) { xv[j] = *(const f32x4*)(src + 4 * lane + 256 * j); ss += (xv[j].x * xv[j].x + xv[j].y * xv[j].y) + (xv[j].z * xv[j].z + xv[j].w * xv[j].w); }
        const float rinv = rsqrtf(wave_sum(ss, lane) * (1.0f / DM) + 1e-6f);
#pragma unroll
        for (int j = 0; j < 4; ++j) { const int col = 4 * lane + 256 * j;
            const f32x4 gv = *(const f32x4*)(g + col), sc = *(const f32x4*)(scp + col), sh = *(const f32x4*)(shp + col);
            const f32x4 h = xv[j] * rinv * gv * (sc + 1.0f) + sh;
            u32x2 o; o.x = pk2(h.x, h.y); o.y = pk2(h.z, h.w);
            *(u32x2*)(H + (size_t)m * DM + col) = o; }
    }
    if (l == 0) filt_items(A, 0, tid, bid, nblk, nullptr);
}

struct EpiIn {
    static constexpr bool PERM = true, AFTER_DRAIN = false;
    bf16_t* PT; bf16_t* KH; bf16_t* PCT; const float2* rope;
    __device__ __forceinline__ void operator()(const f32x4 (&acc)[2][2][4][2], const pg8::Unit& u, int wr, int wc, int fr, int fq) const {
        const int row0 = u.pm * 256 + wr * 64 + fr;
        if (u.pn < 10) {
#pragma unroll
            for (int bj = 0; bj < 2; ++bj) {
                const int blk = 2 * u.pn + bj;
                const bool rp = ((blk >= 6 && blk <= 8) || blk == 15) && (u.pm < 64);
                const int col0 = 256 * u.pn + 128 * bj + 32 * wc + 8 * fq;
                bf16_t* dst; size_t ld;
                if (u.pn < 6) { dst = PT + col0; ld = NTM; }
                else { const int n2 = col0 - 1536; dst = KH + (size_t)(n2 >> 6) * MTOT * 64 + (n2 & 63); ld = 64; }
#pragma unroll
                for (int ai = 0; ai < 2; ++ai)
#pragma unroll
                    for (int m = 0; m < 4; ++m) {
                        const int r = row0 + 128 * ai + 16 * m;
                        f32x4 v0 = acc[ai][bj][m][0], v1 = acc[ai][bj][m][1];
                        if (rp) {
                            const int pos = r & (SEQ - 1);
                            const int p = (wc & 1) ? (pos & 63) : (pos >> 6);
                            const f32x4* tb = (const f32x4*)(rope + p * 16 + 8 * (fq & 1));
                            const int ln = fr + 16 * fq;
                            const float sg = (fq < 2) ? -1.0f : 1.0f;
                            { const f32x4 t0 = tb[0], t1 = tb[1];
                              const float qx = lane_xor(v0.x, ln, 32), qy = lane_xor(v0.y, ln, 32), qz = lane_xor(v0.z, ln, 32), qw = lane_xor(v0.w, ln, 32);
                              v0.x = v0.x * t0.x + sg * qx * t0.y; v0.y = v0.y * t0.z + sg * qy * t0.w; v0.z = v0.z * t1.x + sg * qz * t1.y; v0.w = v0.w * t1.z + sg * qw * t1.w; }
                            { const f32x4 t2 = tb[2], t3 = tb[3];
                              const float qx = lane_xor(v1.x, ln, 32), qy = lane_xor(v1.y, ln, 32), qz = lane_xor(v1.z, ln, 32), qw = lane_xor(v1.w, ln, 32);
                              v1.x = v1.x * t2.x + sg * qx * t2.y; v1.y = v1.y * t2.z + sg * qy * t2.w; v1.z = v1.z * t3.x + sg * qz * t3.y; v1.w = v1.w * t3.z + sg * qw * t3.w; }
                        }
                        u32x4 w; w.x = pk2(v0.x, v0.y); w.y = pk2(v0.z, v0.w); w.z = pk2(v1.x, v1.y); w.w = pk2(v1.z, v1.w);
                        *(u32x4*)(dst + (size_t)r * ld) = w;
                        asm volatile("" ::: "memory");
                    }
            }
        } else {
#pragma unroll
            for (int bj = 0; bj < 2; ++bj) {
                const int ch0 = 256 * (u.pn - 10) + 128 * bj + 32 * wc + 8 * fq;
#pragma unroll
                for (int ai = 0; ai < 2; ++ai)
#pragma unroll
                    for (int m = 0; m < 4; ++m) {
                        const int r = row0 + 128 * ai + 16 * m;
                        bf16_t* p = PCT + (size_t)ch0 * MTOT + r;
#pragma unroll
                        for (int n = 0; n < 2; ++n) {
                            const f32x4 v = acc[ai][bj][m][n];
                            bf16_t* q = p + (size_t)(4 * n) * MTOT;
                            const unsigned w0 = pk2(v.x, v.y), w1 = pk2(v.z, v.w);
                            q[0] = (bf16_t)(w0 & 0xffffu); q[MTOT] = (bf16_t)(w0 >> 16); q[2 * (size_t)MTOT] = (bf16_t)(w1 & 0xffffu); q[3 * (size_t)MTOT] = (bf16_t)(w1 >> 16);
                        }
                    }
            }
        }
    }
};
struct EpiFilt {
    static constexpr bool PERM = true, AFTER_DRAIN = false;
    bf16_t* O; int ldc;
    __device__ __forceinline__ void operator()(const f32x4 (&acc)[2][2][4][2], const pg8::Unit& u, int wr, int wc, int fr, int fq) const {
        const int row0 = u.pm * 256 + wr * 64 + fr;
#pragma unroll
        for (int bj = 0; bj < 2; ++bj) { const int col0 = 256 * u.pn + 128 * bj + 32 * wc + 8 * fq;
#pragma unroll
            for (int ai = 0; ai < 2; ++ai)
#pragma unroll
                for (int m = 0; m < 4; ++m) { const int r = row0 + 128 * ai + 16 * m; const f32x4 v0 = acc[ai][bj][m][0], v1 = acc[ai][bj][m][1];
                    u32x4 w; w.x = pk2(v0.x, v0.y); w.y = pk2(v0.z, v0.w); w.z = pk2(v1.x, v1.y); w.w = pk2(v1.z, v1.w);
                    *(u32x4*)(O + (size_t)r * ldc + col0) = w; } }
    }
};
struct EpiOut {
    static constexpr bool PERM = true, AFTER_DRAIN = false;
    const float* xsrc; float* xdst; const float* csrc; float* cdst; const float* ada;
    __device__ __forceinline__ void operator()(const f32x4 (&acc)[2][2][4][2], const pg8::Unit& u, int wr, int wc, int fr, int fq) const {
        const int row0 = u.pm * 256 + wr * 64 + fr;
        const bool lat = u.pm < 64;
#pragma unroll
        for (int bj = 0; bj < 2; ++bj) {
            const int col0 = 256 * u.pn + 128 * bj + 32 * wc + 8 * fq;
#pragma unroll
            for (int ai = 0; ai < 2; ++ai)
#pragma unroll
                for (int m = 0; m < 4; ++m) {
                    const int r = row0 + 128 * ai + 16 * m;
                    const int v = lat ? (r >> 13) : 2;
                    const float* gp = ada + v * 3072 + 2048 + col0;
                    const f32x4 g0 = *(const f32x4*)gp, g1 = *(const f32x4*)(gp + 4);
                    const size_t off = lat ? (size_t)r * DM + col0 : (size_t)(r - MLAT) * DM + col0;
                    const float* sp = (lat ? xsrc : csrc) + off; float* dp = (lat ? xdst : cdst) + off;
                    const f32x4 x0 = *(const f32x4*)sp, x1 = *(const f32x4*)(sp + 4);
                    *(f32x4*)dp = x0 + g0 * acc[ai][bj][m][0];
                    *(f32x4*)(dp + 4) = x1 + g1 * acc[ai][bj][m][1];
                    if (m & 1) asm volatile("" ::: "memory");
                }
        }
    }
};

struct EpiAll {
    static constexpr bool PERM = true, AFTER_DRAIN = false;
    int mode, l; CKArgs* Ap;
    __device__ __forceinline__ void operator()(const f32x4 (&acc)[2][2][4][2], const pg8::Unit& u, int wr, int wc, int fr, int fq) const {
        unsigned char* ws = Ap->ws;
        if (mode == 0) { const EpiIn E{(bf16_t*)(ws + WS_PT), (bf16_t*)(ws + WS_KH), (bf16_t*)(ws + WS_PCT), (const float2*)(ws + WS_ROPE)}; E(acc, u, wr, wc, fr, fq); }
        else { const EpiOut E{l == 0 ? Ap->x : Ap->out, Ap->out, l == 0 ? Ap->ctx : (const float*)(ws + WS_CX), (float*)(ws + WS_CX), (const float*)(ws + WS_ADA) + (size_t)l * 3 * 3072}; E(acc, u, wr, wc, fr, fq); }
    }
};
__device__ __forceinline__ float max3f(float a, float b, float c) { float r; asm("v_max3_f32 %0, %1, %2, %3" : "=v"(r) : "v"(a), "v"(b), "v"(c)); return r; }
__device__ __forceinline__ float max2f(float a, float b) { float r; asm("v_max_f32_e32 %0, %1, %2" : "=v"(r) : "v"(a), "v"(b)); return r; }
__device__ __forceinline__ void attn_tile(LAS const unsigned char* slot, int cs, const bf16x8 (&bq)[4], f32x16& o0, f32x16& o1, float& m_run, float& l_run,
                                          int r31, int hh, bool use_mask, int clo, int chi, bool use_bias, LAS const float* btab, int bidx) {
    const int kr = cs + r31;
    LAS const unsigned char* kp = slot + kr * 128;
    const int ksw = (kr >> 1) & 7;
    const bf16x8 ka0 = *(LAS const bf16x8*)(kp + 16 * ((0 + hh) ^ ksw)), ka1 = *(LAS const bf16x8*)(kp + 16 * ((2 + hh) ^ ksw));
    const bf16x8 ka2 = *(LAS const bf16x8*)(kp + 16 * ((4 + hh) ^ ksw)), ka3 = *(LAS const bf16x8*)(kp + 16 * ((6 + hh) ^ ksw));
    LAS const unsigned char* vp = slot + 8192 + r31 * 128;
    const int vsw = (r31 >> 1) & 15, g0 = (cs >> 2) + hh;
    const u32x2 a0l = *(LAS const u32x2*)(vp + 8 * ((g0) ^ vsw)), a0h = *(LAS const u32x2*)(vp + 8 * ((g0 + 2) ^ vsw));
    const u32x2 a1l = *(LAS const u32x2*)(vp + 8 * ((g0 + 4) ^ vsw)), a1h = *(LAS const u32x2*)(vp + 8 * ((g0 + 6) ^ vsw));
    const u32x2 b0l = *(LAS const u32x2*)(vp + 4096 + 8 * ((g0) ^ vsw)), b0h = *(LAS const u32x2*)(vp + 4096 + 8 * ((g0 + 2) ^ vsw));
    const u32x2 b1l = *(LAS const u32x2*)(vp + 4096 + 8 * ((g0 + 4) ^ vsw)), b1h = *(LAS const u32x2*)(vp + 4096 + 8 * ((g0 + 6) ^ vsw));
    f32x16 s, t;
#pragma unroll
    for (int i = 0; i < 16; ++i) { s[i] = 0.f; t[i] = 0.f; }
    s = __builtin_amdgcn_mfma_f32_32x32x16_bf16(ka0, bq[0], s, 0, 0, 0); t = __builtin_amdgcn_mfma_f32_32x32x16_bf16(ka1, bq[1], t, 0, 0, 0);
    s = __builtin_amdgcn_mfma_f32_32x32x16_bf16(ka2, bq[2], s, 0, 0, 0); t = __builtin_amdgcn_mfma_f32_32x32x16_bf16(ka3, bq[3], t, 0, 0, 0);
    if (use_bias) {
        LAS const float* bp = btab + bidx;
#pragma unroll
        for (int i = 0; i < 16; ++i) { const int c = (i & 3) + 8 * (i >> 2) + 4 * hh; s[i] = (s[i] + t[i]) * QK_SCALE + bp[c]; }
    } else {
#pragma unroll
        for (int i = 0; i < 16; ++i) s[i] = (s[i] + t[i]) * QK_SCALE;
    }
    if (use_mask) {
        const unsigned off = (unsigned)(4 * hh - clo), rng = (unsigned)(chi - clo);
        const bool any = chi >= clo;
#pragma unroll
        for (int i = 0; i < 16; ++i) { const unsigned c0 = (unsigned)((i & 3) + 8 * (i >> 2)); s[i] = (any && (c0 + off <= rng)) ? s[i] : -INFINITY; }
    }
    float tmax = max3f(s[0], s[1], s[2]);
#pragma unroll
    for (int i = 3; i < 15; i += 2) tmax = max3f(tmax, s[i], s[i + 1]);
    tmax = max2f(tmax, s[15]);
    tmax = max2f(tmax, lane_xor(tmax, r31 + 32 * hh, 32));
    if (__any(tmax - m_run > 8.0f)) {
        const float m_new = fmaxf(m_run, tmax);
        const float alpha = __builtin_amdgcn_exp2f(m_run - m_new);
        m_run = m_new; l_run *= alpha;
#pragma unroll
        for (int i = 0; i < 16; ++i) { o0[i] *= alpha; o1[i] *= alpha; }
    }
    float ps0 = 0.f, ps1 = 0.f;
#pragma unroll
    for (int i = 0; i < 16; i += 2) { const float p0 = __builtin_amdgcn_exp2f(s[i] - m_run), p1 = __builtin_amdgcn_exp2f(s[i + 1] - m_run); s[i] = p0; s[i + 1] = p1; ps0 += p0; ps1 += p1; }
    l_run += ps0 + ps1;
    u32x4 pw0, pw1;
    pw0.x = pk2(s[0], s[1]); pw0.y = pk2(s[2], s[3]); pw0.z = pk2(s[4], s[5]); pw0.w = pk2(s[6], s[7]);
    pw1.x = pk2(s[8], s[9]); pw1.y = pk2(s[10], s[11]); pw1.z = pk2(s[12], s[13]); pw1.w = pk2(s[14], s[15]);
    const bf16x8 pb0 = __builtin_bit_cast(bf16x8, pw0), pb1 = __builtin_bit_cast(bf16x8, pw1);
    u32x4 w;
    w.x = a0l.x; w.y = a0l.y; w.z = a0h.x; w.w = a0h.y; const bf16x8 va00 = __builtin_bit_cast(bf16x8, w);
    w.x = a1l.x; w.y = a1l.y; w.z = a1h.x; w.w = a1h.y; const bf16x8 va01 = __builtin_bit_cast(bf16x8, w);
    w.x = b0l.x; w.y = b0l.y; w.z = b0h.x; w.w = b0h.y; const bf16x8 va10 = __builtin_bit_cast(bf16x8, w);
    w.x = b1l.x; w.y = b1l.y; w.z = b1h.x; w.w = b1h.y; const bf16x8 va11 = __builtin_bit_cast(bf16x8, w);
    o0 = __builtin_amdgcn_mfma_f32_32x32x16_bf16(va00, pb0, o0, 0, 0, 0); o1 = __builtin_amdgcn_mfma_f32_32x32x16_bf16(va10, pb0, o1, 0, 0, 0);
    o0 = __builtin_amdgcn_mfma_f32_32x32x16_bf16(va01, pb1, o0, 0, 0, 0); o1 = __builtin_amdgcn_mfma_f32_32x32x16_bf16(va11, pb1, o1, 0, 0, 0);
}

__device__ __forceinline__ void attn_tile2(LAS const unsigned char* slot, const bf16x8 (&bq)[4], f32x16& o0, f32x16& o1, float& m_run, float& l_run,
                                           int r31, int hh, bool use_mask, int clo0, int chi0, int clo1, int chi1) {
    const int ksw = (r31 >> 1) & 7;
    LAS const unsigned char* kp = slot + r31 * 128;
    const bf16x8 ka0 = *(LAS const bf16x8*)(kp + 16 * ((0 + hh) ^ ksw)), ka1 = *(LAS const bf16x8*)(kp + 16 * ((2 + hh) ^ ksw));
    const bf16x8 ka2 = *(LAS const bf16x8*)(kp + 16 * ((4 + hh) ^ ksw)), ka3 = *(LAS const bf16x8*)(kp + 16 * ((6 + hh) ^ ksw));
    const bf16x8 kb0 = *(LAS const bf16x8*)(kp + 4096 + 16 * ((0 + hh) ^ ksw)), kb1 = *(LAS const bf16x8*)(kp + 4096 + 16 * ((2 + hh) ^ ksw));
    const bf16x8 kb2 = *(LAS const bf16x8*)(kp + 4096 + 16 * ((4 + hh) ^ ksw)), kb3 = *(LAS const bf16x8*)(kp + 4096 + 16 * ((6 + hh) ^ ksw));
    f32x16 s0, s1;
#pragma unroll
    for (int i = 0; i < 16; ++i) { s0[i] = 0.f; s1[i] = 0.f; }
    s0 = __builtin_amdgcn_mfma_f32_32x32x16_bf16(ka0, bq[0], s0, 0, 0, 0); s1 = __builtin_amdgcn_mfma_f32_32x32x16_bf16(kb0, bq[0], s1, 0, 0, 0);
    s0 = __builtin_amdgcn_mfma_f32_32x32x16_bf16(ka1, bq[1], s0, 0, 0, 0); s1 = __builtin_amdgcn_mfma_f32_32x32x16_bf16(kb1, bq[1], s1, 0, 0, 0);
    s0 = __builtin_amdgcn_mfma_f32_32x32x16_bf16(ka2, bq[2], s0, 0, 0, 0); s1 = __builtin_amdgcn_mfma_f32_32x32x16_bf16(kb2, bq[2], s1, 0, 0, 0);
    s0 = __builtin_amdgcn_mfma_f32_32x32x16_bf16(ka3, bq[3], s0, 0, 0, 0); s1 = __builtin_amdgcn_mfma_f32_32x32x16_bf16(kb3, bq[3], s1, 0, 0, 0);
    LAS const unsigned char* vp = slot + 8192 + r31 * 128;
    const int vsw = (r31 >> 1) & 15;
    u32x2 va[2][4][2];
#pragma unroll
    for (int db = 0; db < 2; ++db)
#pragma unroll
        for (int st = 0; st < 4; ++st) { va[db][st][0] = *(LAS const u32x2*)(vp + 4096 * db + 8 * ((4 * st + hh) ^ vsw)); va[db][st][1] = *(LAS const u32x2*)(vp + 4096 * db + 8 * ((4 * st + hh + 2) ^ vsw)); }
    if (use_mask) {
        const unsigned off0 = (unsigned)(4 * hh - clo0), rng0 = (unsigned)(chi0 - clo0), off1 = (unsigned)(4 * hh - clo1), rng1 = (unsigned)(chi1 - clo1);
#pragma unroll
        for (int i = 0; i < 16; ++i) { const unsigned c0 = (unsigned)((i & 3) + 8 * (i >> 2)); s0[i] = (c0 + off0 <= rng0) ? s0[i] : -INFINITY; s1[i] = (c0 + off1 <= rng1) ? s1[i] : -INFINITY; }
    }
    float tmax = max3f(s0[0], s0[1], s1[0]);
    tmax = max2f(tmax, s1[1]);
#pragma unroll
    for (int i = 2; i < 16; i += 2) { tmax = max3f(tmax, s0[i], s0[i + 1]); tmax = max3f(tmax, s1[i], s1[i + 1]); }
    tmax = max2f(tmax, lane_xor(tmax, r31 + 32 * hh, 32)) * QK_SCALE;
    if (__any(tmax - m_run > 8.0f)) {
        const float m_new = fmaxf(m_run, tmax);
        const float alpha = __builtin_amdgcn_exp2f(m_run - m_new);
        m_run = m_new; l_run *= alpha;
#pragma unroll
        for (int i = 0; i < 16; ++i) { o0[i] *= alpha; o1[i] *= alpha; }
    }
    float ps0 = 0.f, ps1 = 0.f;
    const float nm = -m_run;
#pragma unroll
    for (int i = 0; i < 16; ++i) { const float p0 = __builtin_amdgcn_exp2f(fmaf(s0[i], QK_SCALE, nm)), p1 = __builtin_amdgcn_exp2f(fmaf(s1[i], QK_SCALE, nm)); s0[i] = p0; s1[i] = p1; ps0 += p0; ps1 += p1; }
    l_run += ps0 + ps1;
    u32x4 pw;
    pw.x = pk2(s0[0], s0[1]); pw.y = pk2(s0[2], s0[3]); pw.z = pk2(s0[4], s0[5]); pw.w = pk2(s0[6], s0[7]); const bf16x8 p00 = __builtin_bit_cast(bf16x8, pw);
    pw.x = pk2(s0[8], s0[9]); pw.y = pk2(s0[10], s0[11]); pw.z = pk2(s0[12], s0[13]); pw.w = pk2(s0[14], s0[15]); const bf16x8 p01 = __builtin_bit_cast(bf16x8, pw);
    pw.x = pk2(s1[0], s1[1]); pw.y = pk2(s1[2], s1[3]); pw.z = pk2(s1[4], s1[5]); pw.w = pk2(s1[6], s1[7]); const bf16x8 p10 = __builtin_bit_cast(bf16x8, pw);
    pw.x = pk2(s1[8], s1[9]); pw.y = pk2(s1[10], s1[11]); pw.z = pk2(s1[12], s1[13]); pw.w = pk2(s1[14], s1[15]); const bf16x8 p11 = __builtin_bit_cast(bf16x8, pw);
#define VA8(db_, st_) __builtin_bit_cast(bf16x8, (u32x4){va[db_][st_][0].x, va[db_][st_][0].y, va[db_][st_][1].x, va[db_][st_][1].y})
    o0 = __builtin_amdgcn_mfma_f32_32x32x16_bf16(VA8(0, 0), p00, o0, 0, 0, 0); o1 = __builtin_amdgcn_mfma_f32_32x32x16_bf16(VA8(1, 0), p00, o1, 0, 0, 0);
    o0 = __builtin_amdgcn_mfma_f32_32x32x16_bf16(VA8(0, 1), p01, o0, 0, 0, 0); o1 = __builtin_amdgcn_mfma_f32_32x32x16_bf16(VA8(1, 1), p01, o1, 0, 0, 0);
    o0 = __builtin_amdgcn_mfma_f32_32x32x16_bf16(VA8(0, 2), p10, o0, 0, 0, 0); o1 = __builtin_amdgcn_mfma_f32_32x32x16_bf16(VA8(1, 2), p10, o1, 0, 0, 0);
    o0 = __builtin_amdgcn_mfma_f32_32x32x16_bf16(VA8(0, 3), p11, o0, 0, 0, 0); o1 = __builtin_amdgcn_mfma_f32_32x32x16_bf16(VA8(1, 3), p11, o1, 0, 0, 0);
#undef VA8
}

__device__ __forceinline__ void attn_block_item(CKArgs& A, int l, int MODE, int item, LAS unsigned char* lds, int tid) {
    asm volatile("" : "+v"(tid));
    unsigned char* ws = A.ws;
    const bf16_t* PT = (const bf16_t*)(ws + WS_PT);
    bf16_t* Y = (bf16_t*)(ws + WS_HY);
    const int wave = __builtin_amdgcn_readfirstlane(tid >> 6), lane = tid & 63;
    const int r31 = lane & 31, hh = lane >> 5;
    int b, h, qtok, qi = 0;
    int rp = 0, mg = 0, qg = 0;
    if (MODE == 0) { b = item / 192; const int rem = item % 192; h = rem >> 5; qi = rem & 31; rp = 2 * qi + (wave >> 2); mg = wave & 3;
        qtok = b * SEQ + (2 * rp + (r31 >> 4)) * 64 + 16 * mg + (r31 & 15); }
    else if (MODE == 1) { b = item / 192; const int rem = item % 192; h = rem >> 5; qi = rem & 31; qg = 8 * qi + wave; qtok = b * SEQ + 32 * qg + r31; }
    else { b = item / 6; h = item % 6; qg = wave; qtok = MLAT + b * CTXL + 32 * qg + r31; }
    const bool grpA = (MODE == 0 || MODE == 2);
    const int kvh = grpA ? h : h / 3;
    const int qcol = (grpA ? C_QA : C_QC) + h * 64, gcol = (grpA ? C_GA : C_GC) + h * 64, ycol = (grpA ? 0 : 640) + h * 64;
    const int kh = grpA ? h : 6 + kvh;
    bf16x8 bq[4];
    { const bf16_t* qp = PT + (size_t)qtok * NTM + qcol + 8 * hh;
#pragma unroll
      for (int s = 0; s < 4; ++s) bq[s] = *(const bf16x8*)(qp + 16 * s); }
    f32x16 o0, o1;
#pragma unroll
    for (int i = 0; i < 16; ++i) { o0[i] = 0.f; o1[i] = 0.f; }
    float m_run = -1e30f, l_run = 0.f;
    if (!grpA) { m_run = A.sink[l * 6 + h] * LOG2E; l_run = hh == 0 ? 1.0f : 0.f; }
    int wrow0 = 0, nwin = 0;
    if (MODE == 0) { const int a0 = min(max(4 * qi - 4, 0), 120), a1 = min(max(4 * qi - 1, 0), 120) + 7; wrow0 = a0; nwin = a1 - a0 + 1; }
    if (MODE == 1) { const int k0 = max(4 * qi - 2, 0), k1 = min(4 * qi + 5, 127); wrow0 = k0; nwin = k1 - k0 + 1; }
    const int nsteps = 4 + nwin;
    int ra = 0, rb = -1, cs = 0, rq = 0, jq = 0, r0 = 0, cmin = 0;
    LAS const float* btab = (LAS const float*)(lds + AUX_OFF + 2048);
    if (MODE == 0) { ra = min(max(2 * rp - 4, 0), 120); rb = min(max(2 * rp - 3, 0), 120) + 7; cs = min(max(16 * mg - 8, 0), 32);
        rq = 2 * rp + (r31 >> 4); jq = 16 * mg + (r31 & 15); r0 = min(max(rq - 4, 0), 120); cmin = min(max(jq - 8, 0), 48) - cs;
        }
    const int lr = tid >> 3, lc = tid & 7;
    const bf16_t* kg = (const bf16_t*)(ws + WS_KH) + (size_t)kh * MTOT * 64 + 8 * tid;
    const bf16_t* vg = (const bf16_t*)(ws + WS_VT) + (size_t)kh * MTOT * 64 + 8 * tid;
    const int kdst = lr * 128 + 16 * (lc ^ ((lr >> 1) & 7));
    const int vdstb = 8192 + (8 * lc) * 128 + 2 * (lr & 3), vg4 = lr >> 2, vs4 = (4 * lc) & 15;
#define ROW_TOK(i) ((i) < 4 ? MLAT + b * CTXL + 64 * (i) : b * SEQ + 64 * (wrow0 + (i) - 4))
#define LOAD_ROW(i, kr_, vr_) do { const int t0_ = ROW_TOK(i); kr_ = *(const u32x4*)(kg + (size_t)t0_ * 64); vr_ = *(const u32x4*)(vg + (size_t)t0_ * 64); } while (0)
#define WRITE_ROW(sl_, kr_, vr_) do { *(LAS u32x4*)((sl_) + kdst) = kr_; \
        _Pragma("unroll") for (int j_ = 0; j_ < 8; ++j_) { const unsigned w_ = j_ < 2 ? vr_.x : (j_ < 4 ? vr_.y : (j_ < 6 ? vr_.z : vr_.w)); \
            *(LAS bf16_t*)((sl_) + vdstb + j_ * 128 + 8 * (vg4 ^ ((vs4 + (j_ >> 1)) & 15))) = (bf16_t)((j_ & 1) ? (w_ >> 16) : (w_ & 0xffffu)); } } while (0)
    u32x4 k0, v0, k1, v1, k2, v2;
    LOAD_ROW(0, k0, v0); k1 = k0; v1 = v0; k2 = k0; v2 = v0;
    __syncthreads();
    if (MODE == 0 && tid < 465) ((LAS float*)(lds + AUX_OFF + 2048))[tid] = A.na_rpb[(size_t)(l * 6 + h) * 465 + tid] * LOG2E;
    WRITE_ROW(lds, k0, v0);
    __syncthreads();
#define ATT_STEP(i_, kL, vL, kW, vW) do { const int i = (i_); if (i < nsteps) { \
        LAS const unsigned char* slot = lds + (i & 1) * 16384; \
        { const int ir_ = min(i + 1, nsteps - 1); LOAD_ROW(ir_, kL, vL); }     \
        bool use2 = false, use1 = false, um = false, um1 = false, ub = false; int c1 = 0, lo0 = 0, hi0 = 31, lo1 = 0, hi1 = 31, bidx = 0; \
        if (i < 4) use2 = true; \
        else if (MODE == 0) { const int a = wrow0 + i - 4; use1 = (a >= ra) && (a <= rb); const bool rowok = (a >= r0) && (a < r0 + 8); \
            c1 = cs; lo0 = rowok ? cmin : 1; hi0 = rowok ? cmin + 15 : 0; ub = true; um1 = true; bidx = (a - rq + 7) * 31 + (cs - jq + 15); } \
        else if (MODE == 1) { const int rel0 = (64 * (wrow0 + i - 4) - (32 * qg - 128)) >> 5, rel1 = rel0 + 1;     \
            const bool a0 = (rel0 >= 0) && (rel0 <= 8), a1 = (rel1 >= 0) && (rel1 <= 8); \
            if (a0 && a1) { use2 = true; um = (rel0 == 0) || (rel1 == 8); lo0 = rel0 == 0 ? r31 : 0; hi1 = rel1 == 8 ? r31 : 31; } \
            else if (a0) { use1 = true; um1 = (rel0 == 0) || (rel0 == 8); lo0 = rel0 == 0 ? r31 : 0; hi0 = rel0 == 8 ? r31 : 31; } \
            else if (a1) { use1 = true; c1 = 32; um1 = (rel1 == 0) || (rel1 == 8); lo0 = rel1 == 0 ? r31 : 0; hi0 = rel1 == 8 ? r31 : 31; } } \
        if (use2) attn_tile2(slot, bq, o0, o1, m_run, l_run, r31, hh, um, lo0, hi0, lo1, hi1); \
        if (use1) attn_tile(slot, c1, bq, o0, o1, m_run, l_run, r31, hh, um1, lo0, hi0, ub, btab, bidx); \
        if (i + 1 < nsteps) { LAS unsigned char* nslot = lds + ((i + 1) & 1) * 16384; WRITE_ROW(nslot, kW, vW); } \
        __syncthreads(); } } while (0)
#pragma unroll 1
    for (int i3 = 0; i3 < nsteps; ++i3) {
        ATT_STEP(i3, k1, v1, k1, v1);
    }
#undef ATT_STEP
#undef LOAD_ROW
#undef WRITE_ROW
    const float ltot = l_run + lane_xor(l_run, lane, 32);
    const float inv = 1.0f / ltot;
    const bf16_t* gp = PT + (size_t)qtok * NTM + gcol + 4 * hh;
    bf16_t* yp = Y + (size_t)qtok * DM + ycol + 4 * hh;
#pragma unroll
    for (int db = 0; db < 2; ++db)
#pragma unroll
        for (int g4 = 0; g4 < 4; ++g4) {
            const int d0 = 32 * db + 8 * g4;
            const u32x2 gw = *(const u32x2*)(gp + d0);
            float v0, v1, v2, v3;
            if (db == 0) { v0 = o0[4 * g4]; v1 = o0[4 * g4 + 1]; v2 = o0[4 * g4 + 2]; v3 = o0[4 * g4 + 3]; }
            else { v0 = o1[4 * g4]; v1 = o1[4 * g4 + 1]; v2 = o1[4 * g4 + 2]; v3 = o1[4 * g4 + 3]; }
            v0 *= inv * silu_f(bflo(gw.x)); v1 *= inv * silu_f(bfhi(gw.x)); v2 *= inv * silu_f(bflo(gw.y)); v3 *= inv * silu_f(bfhi(gw.y));
            u32x2 o; o.x = pk2(v0, v1); o.y = pk2(v2, v3);
            *(u32x2*)(yp + d0) = o;
        }
}

typedef float cf2 __attribute__((ext_vector_type(2)));
__device__ __forceinline__ cf2 mk2(float x, float y) { cf2 r; r.x = x; r.y = y; return r; }
__device__ __forceinline__ cf2 cmul(cf2 a, cf2 b) { const cf2 bs = mk2(-b.y, b.x); return a.xx * b + a.yy * bs; }
#define PA(e) ((e) + (((e) >> 4) << 1))
struct cf2x4 { cf2 a, b, c, d; };
__device__ __forceinline__ cf2x4 bfly4_fwd(cf2 x0, cf2 x1, cf2 x2, cf2 x3, float a) {
    const cf2 w1 = mk2(__builtin_amdgcn_cosf(a), -__builtin_amdgcn_sinf(a));
    const cf2 w2 = cmul(w1, w1), w3 = cmul(w2, w1);
    const cf2 s02 = x0 + x2, d02 = x0 - x2, s13 = x1 + x3, d13 = x1 - x3;
    cf2x4 r;
    r.a = s02 + s13;
    r.b = cmul(s02 - s13, w2);
    r.c = cmul(mk2(d02.x + d13.y, d02.y - d13.x), w1);
    r.d = cmul(mk2(d02.x - d13.y, d02.y + d13.x), w3);
    return r;
}
__device__ __forceinline__ cf2x4 bfly4_inv(cf2 v0, cf2 v1, cf2 v2, cf2 v3, float a) {
    const cf2 w1 = mk2(__builtin_amdgcn_cosf(a), __builtin_amdgcn_sinf(a));
    const cf2 w2 = cmul(w1, w1);
    const cf2 bb = cmul(v1, w2), dd = cmul(v3, w2);
    const cf2 u0 = v0 + bb, u1 = v0 - bb, u2 = v2 + dd, u3 = v2 - dd;
    const cf2 e = cmul(u2, w1), f0 = cmul(u3, w1);
    const cf2 f = mk2(-f0.y, f0.x);
    cf2x4 r; r.a = u0 + e; r.c = u0 - e; r.b = u1 + f; r.d = u1 - f; return r;
}
__device__ __forceinline__ void fft_fwd_fused(LAS cf2* buf, int tid, int lsb, bool zero_hi = false) {
    const int sB = 1 << lsb, s = 4 << lsb;
    const float ra = 1.0f / (float)(16 << lsb), rb = 1.0f / (float)(4 << lsb);
    int poff[4][4];
#pragma unroll
    for (int a = 0; a < 4; ++a)
#pragma unroll
        for (int b = 0; b < 4; ++b) { const int off = a * s + b * sB; poff[a][b] = PA(off); }
#pragma unroll 1
    for (int gg = 0; gg < 2; ++gg) {
        const int g = tid + 512 * gg, i = g & (sB - 1), base = ((g >> lsb) << (lsb + 4)) + i;
        const int pbase = PA(base);
        cf2 x[4][4];
#pragma unroll
        for (int a = 0; a < 4; ++a)
#pragma unroll
            for (int b = 0; b < 4; ++b) x[a][b] = (zero_hi && a >= 2) ? mk2(0.f, 0.f) : buf[pbase + poff[a][b]];
#pragma unroll
        for (int b = 0; b < 4; ++b) { const cf2x4 r = bfly4_fwd(x[0][b], x[1][b], x[2][b], x[3][b], (float)(i + b * sB) * ra); x[0][b] = r.a; x[1][b] = r.b; x[2][b] = r.c; x[3][b] = r.d; }
        const float ab = (float)i * rb;
#pragma unroll
        for (int a = 0; a < 4; ++a) { const cf2x4 r = bfly4_fwd(x[a][0], x[a][1], x[a][2], x[a][3], ab); x[a][0] = r.a; x[a][1] = r.b; x[a][2] = r.c; x[a][3] = r.d; }
#pragma unroll
        for (int a = 0; a < 4; ++a)
#pragma unroll
            for (int b = 0; b < 4; ++b) buf[pbase + poff[a][b]] = x[a][b];
    }
    __syncthreads();
}
__device__ __forceinline__ void fft_inv_fused(LAS cf2* buf, int tid, int lsb) {
    const int sB = 1 << lsb, s = 4 << lsb;
    const float ra = 1.0f / (float)(16 << lsb), rb = 1.0f / (float)(4 << lsb);
    int poff[4][4];
#pragma unroll
    for (int a = 0; a < 4; ++a)
#pragma unroll
        for (int b = 0; b < 4; ++b) { const int off = a * s + b * sB; poff[a][b] = PA(off); }
#pragma unroll 1
    for (int gg = 0; gg < 2; ++gg) {
        const int g = tid + 512 * gg, i = g & (sB - 1), base = ((g >> lsb) << (lsb + 4)) + i;
        const int pbase = PA(base);
        cf2 x[4][4];
#pragma unroll
        for (int a = 0; a < 4; ++a)
#pragma unroll
            for (int b = 0; b < 4; ++b) x[a][b] = buf[pbase + poff[a][b]];
        const float ab = (float)i * rb;
#pragma unroll
        for (int a = 0; a < 4; ++a) { const cf2x4 r = bfly4_inv(x[a][0], x[a][1], x[a][2], x[a][3], ab); x[a][0] = r.a; x[a][1] = r.b; x[a][2] = r.c; x[a][3] = r.d; }
#pragma unroll
        for (int b = 0; b < 4; ++b) { const cf2x4 r = bfly4_inv(x[0][b], x[1][b], x[2][b], x[3][b], (float)(i + b * sB) * ra); x[0][b] = r.a; x[1][b] = r.b; x[2][b] = r.c; x[3][b] = r.d; }
#pragma unroll
        for (int a = 0; a < 4; ++a)
#pragma unroll
            for (int b = 0; b < 4; ++b) buf[pbase + poff[a][b]] = x[a][b];
    }
    __syncthreads();
}
__device__ __forceinline__ void fft_fwd(LAS cf2* buf, int tid, const unsigned* zk = nullptr, bool zero_hi = false) {
#pragma unroll 1
    for (int lsb = 10; lsb >= 2; lsb -= 4) fft_fwd_fused(buf, tid, lsb, zero_hi && lsb == 10);
#pragma unroll 4
    for (int k = 0; k < 8; ++k) {
        const int e0 = 4 * (tid + 512 * k), base = PA(e0);
        cf2 x0 = buf[base], x1 = buf[base + 1], x2 = buf[base + 2], x3 = buf[base + 3];
        const cf2 s02 = x0 + x2, d02 = x0 - x2, s13 = x1 + x3, d13 = x1 - x3;
        cf2 y0 = s02 + s13, y1 = s02 - s13, y2 = mk2(d02.x + d13.y, d02.y - d13.x), y3 = mk2(d02.x - d13.y, d02.y + d13.x);
        if (zk) { const u32x4 w = *(const u32x4*)(zk + (unsigned)e0);
            y0 = cmul(y0, mk2(bflo(w.x), bfhi(w.x))); y1 = cmul(y1, mk2(bflo(w.y), bfhi(w.y))); y2 = cmul(y2, mk2(bflo(w.z), bfhi(w.z))); y3 = cmul(y3, mk2(bflo(w.w), bfhi(w.w))); }
        buf[base] = y0; buf[base + 1] = y1; buf[base + 2] = y2; buf[base + 3] = y3;
    }
    __syncthreads();
}
__device__ __forceinline__ void fft_inv(LAS cf2* buf, int tid) {
#pragma unroll 1
    for (int lsb = 0; lsb <= 8; lsb += 4) fft_inv_fused(buf, tid, lsb);
#pragma unroll 4
    for (int k = 0; k < 8; ++k) {
        const int i = tid + 512 * k, pi = PA(tid) + 576 * k;
        cf2 v0 = buf[pi], v1 = buf[pi + 4608], v2 = buf[pi + 9216], v3 = buf[pi + 13824];
        const cf2x4 r = bfly4_inv(v0, v1, v2, v3, (float)i * (1.0f / 16384.0f));
        buf[pi] = r.a; buf[pi + 4608] = r.b;
    }
    __syncthreads();
}
__device__ __forceinline__ float hy_short(const bf16_t* prow, int tb, int t, int L, float w0, float w1, float w2, float bias) {
    const float pm = t > 0 ? bf2f(prow[tb + t - 1]) : 0.f;
    const float pc = bf2f(prow[tb + t]);
    const float pp = t < L - 1 ? bf2f(prow[tb + t + 1]) : 0.f;
    return w0 * pm + w1 * pc + w2 * pp + bias;
}
__device__ __forceinline__ float block_sum(float v, LAS float* red, int tid) {
    v = wave_sum(v, tid & 63);
    __syncthreads();
    if ((tid & 63) == 0) red[tid >> 6] = v;
    __syncthreads();
    float s = 0.f;
#pragma unroll
    for (int w = 0; w < 8; ++w) s += red[w];
    return s;
}

__device__ __forceinline__ void hyena_block(CKArgs& A, int l, int c, LAS unsigned char* lds, int tid) {
    asm volatile("" : "+v"(tid));
    unsigned char* ws = A.ws;
    LAS cf2* buf = (LAS cf2*)lds;
    LAS float* fs = (LAS float*)lds;
    LAS float* aux = (LAS float*)(lds + AUX_OFF);
    LAS float* red = aux + 256;
    const bf16_t* PCT = (const bf16_t*)(ws + WS_PCT);
    bf16_t* YBT = (bf16_t*)(ws + WS_YBT);
    const bf16_t* rowz = PCT + (size_t)(R_HZ + c) * MTOT;
    const bf16_t* rowx1 = rowz + (size_t)256 * MTOT;
    const bf16_t* rowx2 = rowz + (size_t)512 * MTOT;
    const bf16_t* rowg = PCT + (size_t)(R_GB + c) * MTOT;
    const float* cw = A.hy_conv_w + (size_t)l * 3 * 768; const float* cb = A.hy_conv_b + (size_t)l * 768;
    const float wz0 = cw[c], wz1 = cw[768 + c], wz2 = cw[1536 + c], bz = cb[c];
    const float wa0 = cw[256 + c], wa1 = cw[768 + 256 + c], wa2 = cw[1536 + 256 + c], ba = cb[256 + c];
    const float wb0 = cw[512 + c], wb1 = cw[768 + 512 + c], wb2 = cw[1536 + 512 + c], bb = cb[512 + c];
    const float d0 = A.hy_d[(l * 2 + 0) * 256 + c], d1 = A.hy_d[(l * 2 + 1) * 256 + c];
    const float dmin = -3.0701134573253945f, dmax = -15.350567286626973f;
    const float delta = fabsf(dmin + (float)c * ((dmax - dmin) / 255.0f));
    __syncthreads();
    if (tid < 256) { const int k = tid >> 6, j = tid & 63; aux[tid] = A.hy_w3[((size_t)l * 64 + j) * 1024 + k * 256 + c]; }
    __syncthreads();

    if (l < DEPTH - 1) {
        float ss0 = 0.f, ss1 = 0.f;
        if (tid < 256) {
            const int n = tid; const f32x4* hr = (const f32x4*)((const float*)(ws + WS_H2C) + ((size_t)l * CTXL + n) * 64);
            float f0 = 0.f, f1 = 0.f, b0 = 0.f, b1 = 0.f;
#pragma unroll 1
            for (int j4 = 0; j4 < 16; ++j4) { const f32x4 hv = hr[j4];
#pragma unroll
                for (int e = 0; e < 4; ++e) { const float hvv = hv[e]; const int j = 4 * j4 + e; f0 += hvv * aux[j]; f1 += hvv * aux[64 + j]; b0 += hvv * aux[128 + j]; b1 += hvv * aux[192 + j]; } }
            const float e = __expf(-((float)n * (1.0f / 255.0f)) * delta);
            f0 *= e; f1 *= e; b0 *= e; b1 *= e;
            fs[255 + n] = f0; fs[512 + 255 + n] = f1;
            if (n >= 1) { fs[255 - n] = b0; fs[512 + 255 - n] = b1; }
            ss0 = f0 * f0 + (n >= 1 ? b0 * b0 : 0.f); ss1 = f1 * f1 + (n >= 1 ? b1 * b1 : 0.f);
        }
        if (tid == 0) { fs[511] = 0.f; fs[1023] = 0.f; }
        const int b = tid >> 8, t = tid & 255, tok = MLAT + b * CTXL;
        const float z = hy_short(rowz, tok, t, CTXL, wz0, wz1, wz2, bz);
        const float x1 = hy_short(rowx1, tok, t, CTXL, wa0, wa1, wa2, ba);
        const float x2 = hy_short(rowx2, tok, t, CTXL, wb0, wb1, wb2, bb);
        const float gb = bf2f(rowg[tok + t]);
        fs[1024 + tid] = z;
        const float n0 = rsqrtf(block_sum(ss0, red, tid) + 1e-6f);
        const float n1 = rsqrtf(block_sum(ss1, red, tid) + 1e-6f);
        __syncthreads();
        float y = 0.f;
        { LAS const float* kc = fs + 255 + t; LAS const float* zz = fs + 1024 + b * 256;
#pragma unroll 8
          for (int s = 0; s < 256; ++s) y += zz[s] * kc[-s]; }
        const float z1 = x1 * (y * n0 + d0 * z);
        fs[1536 + tid] = z1;
        __syncthreads();
        float y2 = 0.f;
        { LAS const float* kc = fs + 512 + 255 + t; LAS const float* zz = fs + 1536 + b * 256;
#pragma unroll 8
          for (int s = 0; s < 256; ++s) y2 += zz[s] * kc[-s]; }
        const float o = x2 * (y2 * n1 + d1 * z1) * silu_f(gb);
        YBT[(size_t)c * MTOT + tok + t] = (bf16_t)(pk2(o, 0.f) & 0xffffu);
        __syncthreads();
    }

    unsigned* ZK = (unsigned*)(ws + WS_ZS) + (size_t)c * 2 * NFFT;
    const int lane = tid & 63;
    {
        float ss0 = 0.f, ss1 = 0.f;
        const bf16_t* F0 = (const bf16_t*)(ws + WS_FILT) + (size_t)c * SEQ;
#pragma unroll 4
        for (int k = 0; k < 16; ++k) {
            const int n = tid + 512 * k;
            const float e = __expf(-((float)n * (1.0f / 8191.0f)) * delta);
            const float f0 = bf2f(F0[n]) * e, f1 = bf2f(F0[(size_t)256 * SEQ + n]) * e, b0 = bf2f(F0[(size_t)512 * SEQ + n]) * e, b1 = bf2f(F0[(size_t)768 * SEQ + n]) * e;
            buf[PA(n)] = mk2(f0, f1); ss0 += f0 * f0; ss1 += f1 * f1;
            if (n >= 1) { buf[PA(NFFT - n)] = mk2(b0, b1); ss0 += b0 * b0; ss1 += b1 * b1; }
        }
        if (tid == 0) { const float zf = delta * 0.0f; buf[PA(SEQ)] = mk2(zf, zf); }
        const float nrm0 = rsqrtf(block_sum(ss0, red, tid) + 1e-6f) * (0.5f / NFFT);
        const float nrm1 = rsqrtf(block_sum(ss1, red, tid) + 1e-6f) * (0.5f / NFFT);
        __syncthreads();
        fft_fwd(buf, tid);
#pragma unroll 4
        for (int k = 0; k < 32; ++k) {
            const int p = tid + 512 * k; const int f = (int)(__brev((unsigned)p) >> 18); const int pp = (int)(__brev((unsigned)((NFFT - f) & (NFFT - 1))) >> 18);
            const cf2 za = buf[PA(p)], zb = buf[PA(pp)];
            ZK[p] = pk2((za.x + zb.x) * nrm0 + d0 * (1.0f / NFFT), (za.y - zb.y) * nrm0);
            ZK[NFFT + p] = pk2((za.y + zb.y) * nrm1 + d1 * (1.0f / NFFT), -(za.x - zb.x) * nrm1);
        }
        __syncthreads();
    }
    const int wv = __builtin_amdgcn_readfirstlane(tid >> 6), tw0 = wv * 1024 + lane, ptw = PA(tw0), ptid = PA(tid);
#define HY_ROW8(prow_, tb_, kb_, w0_, w1_, w2_, bias_, u_) do { \
        float own_[8]; const int p0_ = wv * 1024 + 64 * (kb_); \
        _Pragma("unroll") for (int k = 0; k < 8; ++k) own_[k] = bf2f((prow_)[(unsigned)((tb_) + p0_ + lane + 64 * k)]); \
        const float ep_ = p0_ > 0 ? bf2f((prow_)[(unsigned)((tb_) + p0_ - 1)]) : 0.f, en_ = p0_ + 512 < SEQ ? bf2f((prow_)[(unsigned)((tb_) + p0_ + 512)]) : 0.f; \
        _Pragma("unroll") for (int k = 0; k < 8; ++k) { const float a_ = lane_prev(own_[k], lane), b_ = lane_next(own_[k], lane); \
            const float pl_ = k > 0 ? rdlane(own_[k > 0 ? k - 1 : 0], 63) : ep_, nl_ = k < 7 ? rdlane(own_[k < 7 ? k + 1 : 7], 0) : en_; \
            const float m_ = lane == 0 ? pl_ : a_, q_ = lane == 63 ? nl_ : b_; (u_)[(kb_) + k] = (w0_) * m_ + (w1_) * own_[k] + (w2_) * q_ + (bias_); } \
        asm volatile("" ::: "memory"); __builtin_amdgcn_sched_barrier(0); } while (0)
#pragma unroll
    for (int hf = 0; hf < 2; ++hf) {
        float ua[16], ub[16];
        HY_ROW8(rowz, 0, 8 * hf, wz0, wz1, wz2, bz, ua);
        HY_ROW8(rowz, SEQ, 8 * hf, wz0, wz1, wz2, bz, ub);
#pragma unroll
        for (int k = 8 * hf; k < 8 * hf + 8; ++k) { const int t = tw0 + 64 * k; buf[ptw + 72 * k] = mk2(ua[k], ub[k]); }
        __builtin_amdgcn_sched_barrier(0);
    }
    __syncthreads();
    fft_fwd(buf, tid, ZK, true);
    fft_inv(buf, tid);
#pragma unroll
    for (int hf = 0; hf < 2; ++hf) {
        float xa[16], xb[16];
        HY_ROW8(rowx1, 0, 8 * hf, wa0, wa1, wa2, ba, xa);
        HY_ROW8(rowx1, SEQ, 8 * hf, wa0, wa1, wa2, ba, xb);
#pragma unroll
        for (int k = 8 * hf; k < 8 * hf + 8; ++k) { const int t = tw0 + 64 * k; const cf2 y = buf[ptw + 72 * k]; buf[ptw + 72 * k] = mk2(xa[k] * y.x, xb[k] * y.y); }
        __builtin_amdgcn_sched_barrier(0);
    }
    __syncthreads();
    fft_fwd(buf, tid, ZK + NFFT, true);
    fft_inv(buf, tid);
    {
        bf16_t* yrow = YBT + (size_t)c * MTOT;
#pragma unroll
        for (int hf = 0; hf < 2; ++hf) {
            float xa[16], xb[16], ga[8], gb[8];
#pragma unroll
            for (int k = 0; k < 8; ++k) { ga[k] = bf2f(rowg[(unsigned)(tw0 + 64 * (8 * hf + k))]); gb[k] = bf2f(rowg[(unsigned)(SEQ + tw0 + 64 * (8 * hf + k))]); }
            HY_ROW8(rowx2, 0, 8 * hf, wb0, wb1, wb2, bb, xa);
            HY_ROW8(rowx2, SEQ, 8 * hf, wb0, wb1, wb2, bb, xb);
#pragma unroll
            for (int k = 8 * hf; k < 8 * hf + 8; ++k) { const int t = tw0 + 64 * k; const cf2 y = buf[ptw + 72 * k];
                const float oa = xa[k] * y.x * silu_f(ga[k - 8 * hf]), ob = xb[k] * y.y * silu_f(gb[k - 8 * hf]);
                yrow[(unsigned)t] = (bf16_t)(pk2(oa, 0.f) & 0xffffu); yrow[(unsigned)(SEQ + t)] = (bf16_t)(pk2(ob, 0.f) & 0xffffu); }
            __builtin_amdgcn_sched_barrier(0);
        }
    }
#undef HY_ROW8
    __syncthreads();
}

__device__ __forceinline__ void phase_mix(CKArgs& A, int l, LAS unsigned char* lds, int bid, int nblk, int tid) {
    for (int c = bid; c < 256; c += nblk) hyena_block(A, l, c, lds, tid);
    const int nctx = (l < DEPTH - 1) ? 12 : 0;
    const int nitems = 768 + 2 * nctx;
#pragma unroll 1
    for (int it = bid; it < nitems; it += nblk) {
        int mode, item;
        if (it < 384) { mode = 0; item = it; } else if (it < 768) { mode = 1; item = it - 384; } else if (it < 768 + nctx) { mode = 2; item = it - 768; } else { mode = 3; item = it - 768 - nctx; }
        attn_block_item(A, l, mode, item, lds, tid);
    }
}

__device__ __forceinline__ void phase_tr(CKArgs& A, int l, LAS unsigned char* lds, int bid, int nblk, int tid) {
    const int wave = __builtin_amdgcn_readfirstlane(tid >> 6), lane = tid & 63;
    const int gw = bid * 8 + wave, NGW = nblk * 8;
    unsigned char* ws = A.ws;
    const bf16_t* YBT = (const bf16_t*)(ws + WS_YBT);
    bf16_t* Y = (bf16_t*)(ws + WS_HY);
    LAS bf16_t* scr = (LAS bf16_t*)(lds + wave * 16384);
    const int ntok = (l < DEPTH - 1) ? MTOT : MLAT;
    const int nitems = (ntok / 64) * 4;
#pragma unroll 1
    for (int it = gw; it < nitems; it += NGW) {
        const int tb = (it >> 2) * 64, cb = (it & 3) * 64;
#pragma unroll 8
        for (int i = 0; i < 64; ++i) scr[i * 66 + lane] = YBT[(size_t)(cb + i) * MTOT + tb + lane];
        asm volatile("s_waitcnt lgkmcnt(0)" ::: "memory");
        const int cc = (lane & 7) * 8;
#pragma unroll
        for (int k = 0; k < 8; ++k) {
            const int tq = (lane >> 3) + 8 * k;
            u32x4 o;
            o.x = (unsigned)scr[(cc + 0) * 66 + tq] | ((unsigned)scr[(cc + 1) * 66 + tq] << 16);
            o.y = (unsigned)scr[(cc + 2) * 66 + tq] | ((unsigned)scr[(cc + 3) * 66 + tq] << 16);
            o.z = (unsigned)scr[(cc + 4) * 66 + tq] | ((unsigned)scr[(cc + 5) * 66 + tq] << 16);
            o.w = (unsigned)scr[(cc + 6) * 66 + tq] | ((unsigned)scr[(cc + 7) * 66 + tq] << 16);
            *(u32x4*)(Y + (size_t)(tb + tq) * DM + 384 + cb + cc) = o;
        }
        asm volatile("s_waitcnt lgkmcnt(0)" ::: "memory");
    }
}

__device__ __forceinline__ void phase_final(CKArgs& A, int bid, int nblk, int tid) {
    const int wave = __builtin_amdgcn_readfirstlane(tid >> 6), lane = tid & 63;
    const int gw = bid * 8 + wave, NGW = nblk * 8;
    for (int m = gw; m < MLAT; m += NGW) {
        float* row = A.out + (size_t)m * DM;
        f32x4 xv[4]; float ss = 0.f;
#pragma unroll
        for (int j = 0; j < 4; ++j) { xv[j] = *(const f32x4*)(row + 4 * lane + 256 * j); ss += (xv[j].x * xv[j].x + xv[j].y * xv[j].y) + (xv[j].z * xv[j].z + xv[j].w * xv[j].w); }
        const float rinv = rsqrtf(wave_sum(ss, lane) * (1.0f / DM) + 1e-6f);
#pragma unroll
        for (int j = 0; j < 4; ++j) { const int col = 4 * lane + 256 * j; const f32x4 gv = *(const f32x4*)(A.final_g + col); *(f32x4*)(row + col) = xv[j] * rinv * gv; }
    }
}

#define XB_TMO      128
#define XB_XCNT(j)  (256  + 64 * (j))
#define XB_XSUB(j)  (1280 + 64 * (j))
#define XB_XGEN(j)  (2304 + 64 * (j))
#define XB_TOP      3328
#define XB_TOPGEN   3392
#define XCD_BAR_WORDS 3456
#define XB_SPIN_CAP (1u << 18)

__device__ __forceinline__ unsigned xb_ld(unsigned* p)              { return __hip_atomic_load(p, __ATOMIC_RELAXED, __HIP_MEMORY_SCOPE_AGENT); }
__device__ __forceinline__ unsigned xb_add(unsigned* p, unsigned v) { return __hip_atomic_fetch_add(p, v, __ATOMIC_RELAXED, __HIP_MEMORY_SCOPE_AGENT); }
__device__ __forceinline__ unsigned xb_xcc_id() { return (unsigned)__builtin_amdgcn_s_getreg((3 << 11) | 20) & 0xFu; }
#define XB_SPIN(cond, bar) do { unsigned _sp = 0; while (cond) { __builtin_amdgcn_s_sleep(1); \
    if ((++_sp & 255u) == 0u) { if (xb_ld(&(bar)[XB_TMO])) break; if (_sp > XB_SPIN_CAP) { atomicAdd(&(bar)[XB_TMO], 1u); break; } } } } while (0)

struct XcdBarrier {
    unsigned* bar; unsigned x;
    volatile LAS unsigned* st;
};

__device__ __forceinline__ XcdBarrier xcd_barrier_post(unsigned* bar, volatile LAS unsigned* st) {
    XcdBarrier b; b.bar = bar; b.x = xb_xcc_id(); b.st = st;
    if (threadIdx.x == 0) (void)xb_add(&bar[XB_XCNT(b.x)], 1u);
    return b;
}
__device__ __forceinline__ void xcd_barrier_complete(unsigned* bar, unsigned x, unsigned& nloc, unsigned& nx) {
    const unsigned G = gridDim.x * gridDim.y * gridDim.z;
    unsigned sum, cnt, mine, sp = 0u;
    for (;;) {
        sum = 0u; cnt = 0u; mine = 0u;
#pragma unroll
        for (unsigned j = 0; j < 16; ++j) { const unsigned c = xb_ld(&bar[XB_XCNT(j)]); sum += c; cnt += (c > 0u) ? 1u : 0u; mine = (j == x) ? c : mine; }
        if (sum == G) break;
        __builtin_amdgcn_s_sleep(1);
        if ((++sp & 255u) == 0u) { if (xb_ld(&bar[XB_TMO])) break; if (sp > XB_SPIN_CAP) { atomicAdd(&bar[XB_TMO], 1u); break; } }
    }
    nloc = mine > 0u ? mine : 1u; nx = cnt > 0u ? cnt : 1u;
}

__device__ __forceinline__ void xcd_barrier(const XcdBarrier& b) {
    asm volatile("s_waitcnt vmcnt(0)" ::: "memory");
    __syncthreads();
    if (threadIdx.x == 0) {
        unsigned* bar = b.bar;
        __builtin_amdgcn_s_waitcnt(0);
        unsigned nloc = b.st[0], nx = b.st[1];
        if (nloc == 0u) { xcd_barrier_complete(bar, b.x, nloc, nx); b.st[0] = nloc; b.st[1] = nx; }
        const unsigned old = xb_add(&bar[XB_XSUB(b.x)], 1u);
        const unsigned gen = old / nloc;
        if (old + 1u == (gen + 1u) * nloc) {
            __builtin_amdgcn_fence(__ATOMIC_RELEASE, "agent");
            asm volatile("s_waitcnt vmcnt(0)" ::: "memory");
            const unsigned og = xb_add(&bar[XB_TOP], 1u);
            const unsigned tg = og / nx;
            if (og + 1u == (tg + 1u) * nx) xb_add(&bar[XB_TOPGEN], 1u);
            else XB_SPIN(xb_ld(&bar[XB_TOPGEN]) == tg, bar);
            __builtin_amdgcn_fence(__ATOMIC_ACQUIRE, "agent");
            xb_add(&bar[XB_XGEN(b.x)], 1u);
            asm volatile("s_waitcnt vmcnt(0)" ::: "memory");
        } else {
            XB_SPIN(xb_ld(&bar[XB_XGEN(b.x)]) == gen, bar);
            __builtin_amdgcn_fence(__ATOMIC_ACQUIRE, "agent");
            asm volatile("s_waitcnt vmcnt(0)" ::: "memory");
        }
    }
    __syncthreads();
}


constexpr int NPHASE = 2 + 5 * DEPTH;
__global__ void __launch_bounds__(NTHREADS, 2) hybrid_fwd(KArgs Aval) {
    extern __shared__ __attribute__((aligned(16))) unsigned char lds_raw[];
    LAS unsigned char* lds = (LAS unsigned char*)lds_raw;
    const int tid0 = threadIdx.x, bid = blockIdx.x, nblk = gridDim.x;
#if !MK_MULTI
    volatile LAS unsigned* bst = (volatile LAS unsigned*)(lds + AUX_OFF + 8192);
    if (tid0 < 2) bst[tid0] = 0u;
    __syncthreads();
    const XcdBarrier bar = xcd_barrier_post((unsigned*)Aval.ws, bst);
#endif
#ifndef REP_PH
#define REP_PH 1000
#endif
#pragma unroll 1
    for (int pi = Aval.ph_lo; pi < Aval.ph_hi + (REP_PH < 1000 ? 1 : 0); ++pi) {
        const int ph = pi <= REP_PH ? pi : pi - 1;
#if !MK_MULTI
        if (pi > Aval.ph_lo) { if (Aval.ph_hi > 100000) cg::this_grid().sync(); else xcd_barrier(bar); }
#endif
#ifndef ONLY
#define ONLY -1
#endif
#define EN(k) (ONLY < 0 || ((ONLY >> (k)) & 1))
        int tid = tid0; asm volatile("" : "+v"(tid));
        CKArgs* Ap = (CKArgs*)__builtin_amdgcn_kernarg_segment_ptr(); asm volatile("" : "+s"(Ap));
        CKArgs& A = *Ap;
        unsigned char* ws = A.ws;
        if (ph == 0) { if (EN(0)) phase_prologue(A, lds, bid, nblk, tid); }
        else if (ph == NPHASE - 1) { if (EN(6)) phase_final(A, bid, nblk, tid); }
        else {
            const int l = (ph - 1) / 5, k = (ph - 1) % 5;
            if (k == 0) { if (EN(1)) phase_norm(A, l, bid, nblk, tid); }
            else if (k == 2) { if (EN(3)) phase_mix(A, l, lds, bid, nblk, tid); }
            else if (k == 3) { if (EN(4)) phase_tr(A, l, lds, bid, nblk, tid); }
            if (k == 1 || k == 4) {
                pg8::Gemm g; EpiAll E; E.l = l; E.Ap = Ap; g.A = (const bf16_t*)(ws + WS_HY); g.K = DM;
                if (k == 1) { g.Bt = (const bf16_t*)(ws + WS_WIN) + (size_t)l * NIN * DM; g.M = MTOT; g.N = NIN; E.mode = 0; }
                else { g.Bt = (const bf16_t*)(ws + WS_WOUT) + (size_t)l * DM * DM; g.M = (l < DEPTH - 1) ? MTOT : MLAT; g.N = DM; E.mode = 1; }
                pg8::StaticOrder S; S.init(g.M, g.N, nblk, bid);
                if (EN(2)) pg8::gemm_phase<EpiAll, pg8::StaticOrder, true, true>(lds, g, S, E, tid);
                if (k == 4 && l < DEPTH - 1 && bid >= 8) filt_items(A, l + 1, tid, bid - 8, nblk - 8, nullptr);
            }
        }
    }
}

extern "C" void kernel_launch(void* const* d_in, const int* in_sizes, int n_in, void* d_out, int out_size, void* d_ws, size_t ws_size, hipStream_t stream) {
    static int grid = 0;
    if (grid == 0) {
        if (n_in != 22 || ws_size < WS_END) { fprintf(stderr, "kernel_launch: unexpected inputs (n_in %d, ws %zu)\n", n_in, ws_size); grid = -1; return; }
        int dev = 0, cus = 0, per_cu = 0;
        if (hipGetDevice(&dev) != hipSuccess || hipDeviceGetAttribute(&cus, hipDeviceAttributeMultiprocessorCount, dev) != hipSuccess) { grid = -1; return; }
        if (hipFuncSetAttribute((const void*)hybrid_fwd, hipFuncAttributeMaxDynamicSharedMemorySize, LDS_BYTES) != hipSuccess) { fprintf(stderr, "kernel_launch: hipFuncSetAttribute failed\n"); grid = -1; return; }
        if (hipOccupancyMaxActiveBlocksPerMultiprocessor(&per_cu, (const void*)hybrid_fwd, NTHREADS, LDS_BYTES) != hipSuccess || per_cu < 1) { fprintf(stderr, "kernel_launch: occupancy query says %d\n", per_cu); per_cu = 1; }
        (void)hipGetLastError();
        grid = cus;
    }
    if (grid < 0) return;
    KArgs a{};
    a.x = (const float*)d_in[0]; a.c = (const float*)d_in[1]; a.ctx = (const float*)d_in[2]; a.c_ctx = (const float*)d_in[3]; a.norm_g = (const float*)d_in[4];
    a.w_ada = (const float*)d_in[5]; a.b_ada = (const float*)d_in[6]; a.w_in = (const float*)d_in[7]; a.w_out = (const float*)d_in[8]; a.na_rpb = (const float*)d_in[9];
    a.hy_conv_w = (const float*)d_in[10]; a.hy_conv_b = (const float*)d_in[11]; a.hy_w1 = (const float*)d_in[12]; a.hy_b1 = (const float*)d_in[13]; a.hy_freq1 = (const float*)d_in[14];
    a.hy_w2 = (const float*)d_in[15]; a.hy_b2 = (const float*)d_in[16]; a.hy_freq2 = (const float*)d_in[17]; a.hy_w3 = (const float*)d_in[18]; a.hy_d = (const float*)d_in[19];
    a.sink = (const float*)d_in[20]; a.final_g = (const float*)d_in[21];
    a.out = (float*)d_out; a.ws = (unsigned char*)d_ws;
#if MK_MULTI
    for (int ph = 0; ph < NPHASE; ++ph) {
        a.ph_lo = ph; a.ph_hi = ph + 1;
        hipLaunchKernelGGL(hybrid_fwd, dim3(grid), dim3(NTHREADS), LDS_BYTES, stream, a);
    }
#else
    if (hipMemsetAsync(d_ws, 0, 16384, stream) != hipSuccess) { fprintf(stderr, "kernel_launch: memset of the barrier words failed\n"); return; }
    a.ph_lo = 0; a.ph_hi = NPHASE;
    void* args[] = {&a};
    hipError_t e = hipLaunchCooperativeKernel((const void*)hybrid_fwd, dim3(grid), dim3(NTHREADS), args, LDS_BYTES, stream);
    if (e != hipSuccess) fprintf(stderr, "cooperative launch failed: %s (grid %d)\n", hipGetErrorString(e), grid);
#endif
}
```

```cpp
#include <hip/hip_runtime.h>
#include <hip/hip_cooperative_groups.h>
#include <cstdio>
#include <cstdint>
namespace cg = cooperative_groups;

#ifndef MK_MULTI
#define MK_MULTI 0
#endif

namespace pg8 {
#define PG8_LAS __attribute__((address_space(3)))
typedef unsigned short bf16_t;
typedef short bf16x8 __attribute__((ext_vector_type(8)));
typedef float f32x4 __attribute__((ext_vector_type(4)));
typedef unsigned u32x4 __attribute__((ext_vector_type(4)));
constexpr int BM = 256, BK = 64, HALF = 128, HTB = HALF * BK * 2  , STAGE_BYTES = 8 * HTB, NXCD = 8, WGM = 8;

__host__ __device__ __forceinline__ int lds_byte(int r, int c) { const int st = (r >> 4) * 2 + (c >> 5), rr = r & 15, cc = c & 31, ob = rr * 64 + cc * 2; return st * 1024 + (ob ^ (((ob >> 9) & 1) << 5)); }
__host__ __device__ __forceinline__ void stage_rc(int b, int& R, int& C) { const int st = b / 1024, sb = b % 1024, swz = sb ^ (((sb >> 9) & 1) << 5); R = (st >> 1) * 16 + swz / 64; C = (st & 1) * 32 + (swz % 64) / 2; }
__host__ __device__ __forceinline__ int perm32(int rho) { const int n = rho >> 4, i = rho & 15; return 8 * (i >> 2) + 4 * n + (i & 3); }

struct Unit { int pm, pn; };
struct Gemm { const bf16_t* A; const bf16_t* Bt; int M, N, K; };

struct StaticOrder {
    int nM, nN, nwg, G, c;
    __host__ __device__ void init(int M, int N, int G_, int c_) { nM = M / BM; nN = N / BM; nwg = nM * nN; G = G_; c = c_; }
    __host__ __device__ bool next(int i, Unit& u) const {
        const long L = (long)i * G + c; if (L >= nwg) return false;
        int wgid = (int)L; { const int q = nwg / NXCD, r = nwg % NXCD, xcd = wgid % NXCD, off = wgid / NXCD; wgid = (xcd < r ? xcd * (q + 1) : r * (q + 1) + (xcd - r) * q) + off; }
        const int nig = WGM * nN, gid = wgid / nig, fm = gid * WGM, gsz = (nM - fm) < WGM ? (nM - fm) : WGM;
        u.pm = fm + ((wgid % nig) % gsz); u.pn = (wgid % nig) / gsz; return true;
    }
    __device__ __forceinline__ void a_ready(const Unit&) const {}
    __device__ __forceinline__ void done(const Unit&) const {}
};

template <class Epi, class Sched, bool ALIGN_EPI = false, bool SP2 = false>
__device__ __forceinline__ void gemm_phase(PG8_LAS unsigned char* lds, const Gemm g, const Sched& S, const Epi& E, const int tid) {
    const int wid = __builtin_amdgcn_readfirstlane(tid >> 6), lane = tid & 63, wr = wid >> 2, wc = wid & 3, fr = lane & 15, fq = lane >> 4;
    const int K = g.K, nt = K / BK;
    unsigned voffA[2], voffB[2];
#pragma unroll
    for (int i = 0; i < 2; ++i) { int R, C; stage_rc(tid * 16 + i * 8192, R, C); const int Rb = Epi::PERM ? ((R & ~31) + perm32(R & 31)) : R;
        voffA[i] = (unsigned)(R * K + C) * 2u; voffB[i] = (unsigned)(Rb * K + C) * 2u; }
    const size_t kstep = (size_t)(BK * 2);
    const size_t hstep = (size_t)HALF * K * 2;
    const size_t tstep = 2 * hstep;
    const unsigned ldsw = (unsigned)wid * 1024u;
    const int aoff = lds_byte(wr * 64 + fr, fq * 8), boff = lds_byte(wc * 32 + fr, fq * 8);
#define PG8_SA(b, h) (((b) * 2 + (h)) * HTB)
#define PG8_SB(b, h) ((4 + (b) * 2 + (h)) * HTB)
#define PG8_STAGE(bufoff, gbase, voff) do { _Pragma("unroll") for (int _i = 0; _i < 2; ++_i) \
        __builtin_amdgcn_global_load_lds((const unsigned*)((const char*)(gbase) + (voff)[_i]), (PG8_LAS unsigned*)(lds + (bufoff) + ldsw + _i * 8192), 16, 0, 0); } while (0)
#define PG8_LDA(dst, b, h) do { _Pragma("unroll") for (int m = 0; m < 4; ++m) _Pragma("unroll") for (int k = 0; k < 2; ++k) dst[m][k] = *(const PG8_LAS bf16x8*)(lds + PG8_SA(b, h) + aoff + m * 2048 + k * 1024); } while (0)
#define PG8_LDB(dst, b, h) do { _Pragma("unroll") for (int n = 0; n < 2; ++n) _Pragma("unroll") for (int k = 0; k < 2; ++k) dst[n][k] = *(const PG8_LAS bf16x8*)(lds + PG8_SB(b, h) + boff + n * 2048 + k * 1024); } while (0)
#define PG8_MMA(ai, bj, At, Bt) do { __builtin_amdgcn_s_setprio(1); _Pragma("unroll") for (int m = 0; m < 4; ++m) _Pragma("unroll") for (int n = 0; n < 2; ++n) _Pragma("unroll") for (int k = 0; k < 2; ++k) \
        acc[ai][bj][m][n] = __builtin_amdgcn_mfma_f32_16x16x32_bf16(Bt[n][k], At[m][k], acc[ai][bj][m][n], 0, 0, 0); __builtin_amdgcn_s_setprio(0); } while (0)
#define PG8_WAIT_V(n) asm volatile("s_waitcnt vmcnt(" #n ")" ::: "memory")
#define PG8_WAIT_L(n) asm volatile("s_waitcnt lgkmcnt(" #n ")" ::: "memory")
#define PG8_BAR __builtin_amdgcn_s_barrier()
#define PG8_SCHED __builtin_amdgcn_sched_barrier(0)
    Unit cur, nxt; int ui = 0;
    if (!S.next(0, cur)) return;
    f32x4 acc[2][2][4][2];
#pragma unroll
    for (int a = 0; a < 2; ++a)
#pragma unroll
        for (int b = 0; b < 2; ++b)
#pragma unroll
            for (int m = 0; m < 4; ++m)
#pragma unroll
                for (int n = 0; n < 2; ++n) acc[a][b][m][n] = (f32x4){0.f, 0.f, 0.f, 0.f};
    bf16x8 At[4][2], B0[2][2], B1[2][2];
    const char* cA = (const char*)g.A + (size_t)cur.pm * tstep; const char* cB = (const char*)g.Bt + (size_t)cur.pn * tstep;
    S.a_ready(cur);
    if constexpr (SP2) {
        PG8_STAGE(PG8_SB(0, 0), cB, voffB); PG8_STAGE(PG8_SB(0, 1), cB + hstep, voffB); PG8_STAGE(PG8_SA(0, 0), cA, voffA); PG8_STAGE(PG8_SA(0, 1), cA + hstep, voffA);
        if (wr == 1) PG8_BAR;
        PG8_WAIT_V(2); PG8_BAR;
        PG8_STAGE(PG8_SB(1, 0), cB + kstep, voffB); PG8_STAGE(PG8_SA(1, 0), cA + kstep, voffA); PG8_STAGE(PG8_SB(1, 1), cB + hstep + kstep, voffB);
        PG8_WAIT_V(6); PG8_BAR;
    } else {
        PG8_STAGE(PG8_SB(0, 0), cB, voffB); PG8_STAGE(PG8_SA(0, 0), cA, voffA); PG8_STAGE(PG8_SB(0, 1), cB + hstep, voffB); PG8_STAGE(PG8_SA(0, 1), cA + hstep, voffA);
        if (wr == 1) PG8_BAR;
        PG8_WAIT_V(4); PG8_BAR;
        PG8_STAGE(PG8_SB(1, 0), cB + kstep, voffB); PG8_STAGE(PG8_SA(1, 0), cA + kstep, voffA); PG8_STAGE(PG8_SB(1, 1), cB + hstep + kstep, voffB);
        PG8_WAIT_V(6); PG8_BAR;
    }
    for (;;) {
        const bool has_next = S.next(ui + 1, nxt);
        const char* nA = has_next ? (const char*)g.A + (size_t)nxt.pm * tstep : cA; const char* nB = has_next ? (const char*)g.Bt + (size_t)nxt.pn * tstep : cB;
        for (int t = 0; t < nt; t += 2) {
            const bool last = (t == nt - 2);
            const char* a1 = cA + (size_t)(t + 1) * kstep;
            const char* a2 = last ? nA : cA + (size_t)(t + 2) * kstep; const char* b2 = last ? nB : cB + (size_t)(t + 2) * kstep;
            const char* a3 = a2 + kstep; const char* b3 = b2 + kstep;
            if (last && has_next) S.a_ready(nxt);
            if constexpr (SP2) {
            PG8_LDB(B0, 0, 0); PG8_LDB(B1, 0, 1); PG8_SCHED; PG8_LDA(At, 0, 0); PG8_STAGE(PG8_SA(1, 1), a1 + hstep, voffA);
            PG8_WAIT_V(8); PG8_WAIT_L(0); PG8_BAR; PG8_MMA(0, 0, At, B0); PG8_MMA(0, 1, At, B1); PG8_BAR; PG8_SCHED;
            PG8_LDA(At, 0, 1); PG8_STAGE(PG8_SB(0, 0), b2, voffB); PG8_STAGE(PG8_SB(0, 1), b2 + hstep, voffB); PG8_STAGE(PG8_SA(0, 0), a2, voffA);
            PG8_WAIT_V(8); PG8_WAIT_L(0); PG8_BAR; PG8_MMA(1, 0, At, B0); PG8_MMA(1, 1, At, B1); PG8_BAR; PG8_SCHED;
            PG8_LDB(B0, 1, 0); PG8_LDB(B1, 1, 1); PG8_SCHED; PG8_LDA(At, 1, 0); PG8_STAGE(PG8_SA(0, 1), a2 + hstep, voffA);
            PG8_WAIT_V(8); PG8_WAIT_L(0); PG8_BAR; PG8_MMA(0, 0, At, B0); PG8_MMA(0, 1, At, B1); PG8_BAR; PG8_SCHED;
            PG8_LDA(At, 1, 1); PG8_STAGE(PG8_SB(1, 0), b3, voffB); PG8_STAGE(PG8_SB(1, 1), b3 + hstep, voffB); PG8_STAGE(PG8_SA(1, 0), a3, voffA);
            PG8_WAIT_V(8); PG8_WAIT_L(0); PG8_BAR; PG8_MMA(1, 0, At, B0); PG8_MMA(1, 1, At, B1); PG8_BAR; PG8_SCHED;
            } else {
            PG8_LDB(B0, 0, 0); PG8_SCHED; PG8_LDA(At, 0, 0); PG8_STAGE(PG8_SA(1, 1), a1 + hstep, voffA);
            PG8_WAIT_L(8); PG8_BAR; PG8_WAIT_L(0); PG8_MMA(0, 0, At, B0); PG8_BAR; PG8_SCHED;
            PG8_LDB(B1, 0, 1); PG8_STAGE(PG8_SB(0, 0), b2, voffB);
            PG8_BAR; PG8_WAIT_L(0); PG8_MMA(0, 1, At, B1); PG8_BAR;
            PG8_LDA(At, 0, 1); PG8_STAGE(PG8_SA(0, 0), a2, voffA);
            PG8_BAR; PG8_WAIT_L(0); PG8_MMA(1, 0, At, B0); PG8_BAR; PG8_SCHED;
            PG8_STAGE(PG8_SB(0, 1), b2 + hstep, voffB);
            PG8_WAIT_V(6); PG8_BAR; PG8_MMA(1, 1, At, B1); PG8_BAR;
            PG8_LDB(B0, 1, 0); PG8_SCHED; PG8_LDA(At, 1, 0); PG8_STAGE(PG8_SA(0, 1), a2 + hstep, voffA);
            PG8_WAIT_L(8); PG8_BAR; PG8_WAIT_L(0); PG8_MMA(0, 0, At, B0); PG8_BAR; PG8_SCHED;
            PG8_LDB(B1, 1, 1); PG8_STAGE(PG8_SB(1, 0), b3, voffB);
            PG8_BAR; PG8_WAIT_L(0); PG8_MMA(0, 1, At, B1); PG8_BAR;
            PG8_LDA(At, 1, 1); PG8_STAGE(PG8_SA(1, 0), a3, voffA);
            PG8_BAR; PG8_WAIT_L(0); PG8_MMA(1, 0, At, B0); PG8_BAR; PG8_SCHED;
            PG8_STAGE(PG8_SB(1, 1), b3 + hstep, voffB);
            PG8_WAIT_V(6); PG8_BAR; PG8_MMA(1, 1, At, B1); PG8_BAR;
            }
        }
        if constexpr (ALIGN_EPI) { if (wr == 0) PG8_BAR; }
        if constexpr (!Epi::AFTER_DRAIN) { E(acc, cur, wr, wc, fr, fq); S.done(cur); }
        if (!has_next) break;
#pragma unroll
        for (int a = 0; a < 2; ++a)
#pragma unroll
            for (int b = 0; b < 2; ++b)
#pragma unroll
                for (int m = 0; m < 4; ++m)
#pragma unroll
                    for (int n = 0; n < 2; ++n) acc[a][b][m][n] = (f32x4){0.f, 0.f, 0.f, 0.f};
        cur = nxt; cA = nA; cB = nB; ++ui;
        if constexpr (ALIGN_EPI) { if (wr == 1) PG8_BAR; }
    }
    PG8_WAIT_V(0);
    if constexpr (!ALIGN_EPI) { if (wr == 0) PG8_BAR; }
    PG8_BAR;
    if constexpr (Epi::AFTER_DRAIN) { E.fused(acc, cur, wr, wc, fr, fq, lds, wid, lane); S.done(cur); }
#undef PG8_SA
#undef PG8_SB
#undef PG8_STAGE
#undef PG8_LDA
#undef PG8_LDB
#undef PG8_MMA
#undef PG8_WAIT_V
#undef PG8_WAIT_L
#undef PG8_BAR
#undef PG8_SCHED
}
}

#define LAS __attribute__((address_space(3)))
typedef unsigned short bf16_t;
typedef short bf16x8 __attribute__((ext_vector_type(8)));
typedef float f32x4 __attribute__((ext_vector_type(4)));
typedef float f32x16 __attribute__((ext_vector_type(16)));
typedef unsigned u32x2 __attribute__((ext_vector_type(2)));
typedef unsigned u32x4 __attribute__((ext_vector_type(4)));
typedef float f32x2_t __attribute__((ext_vector_type(2)));
typedef __bf16 bf16x2_t __attribute__((ext_vector_type(2)));

constexpr int DM = 1024, NBATCH = 2, SEQ = 8192, DEPTH = 4, CTXL = 256;
constexpr int MLAT = NBATCH * SEQ, MCTX = NBATCH * CTXL, MTOT = MLAT + MCTX;
constexpr int NIN = 3584, NTM = 1536, NCM = 1024, NTB = MTOT / 64;
constexpr int C_QA = 0, C_GA = 384, C_QC = 768, C_GC = 1152;
constexpr int R_HZ = 0, R_GB = 768;
constexpr int NFFT = 16384;
constexpr float LOG2E = 1.4426950408889634f;
constexpr float QK_SCALE = 0.125f * LOG2E;

constexpr size_t MiB = 1u << 20;
constexpr size_t WS_ADA = 1 * MiB;
constexpr size_t WS_ROPE = 1 * MiB + 256 * 1024;
constexpr size_t WS_H2C = 1 * MiB + 512 * 1024;
constexpr size_t WS_CX = 2 * MiB;
constexpr size_t WS_H2 = 4 * MiB;
constexpr size_t WS_WIN = 12 * MiB;
constexpr size_t WS_WOUT = 40 * MiB;
constexpr size_t WS_HY = 48 * MiB;
constexpr size_t WS_PT = 81 * MiB;
constexpr size_t WS_KH = 130 * MiB + 512 * 1024;
constexpr size_t WS_VT = 147 * MiB;
constexpr size_t WS_PCT = 163 * MiB + 512 * 1024;
constexpr size_t WS_YBT = 197 * MiB;
constexpr size_t WS_ZS = 206 * MiB;
constexpr size_t WS_W3T = 238 * MiB;
constexpr size_t WS_FILT = 239 * MiB;
constexpr size_t WS_END = 255 * MiB;
static_assert(WS_PT + (size_t)MTOT * NTM * 2 <= WS_KH && WS_KH + (size_t)8 * MTOT * 128 <= WS_VT && WS_VT + (size_t)8 * MTOT * 128 <= WS_PCT && WS_PCT + (size_t)NCM * MTOT * 2 <= WS_YBT, "d_ws map");

constexpr int AUX_OFF = 147456;
constexpr int LDS_BYTES = 163840;
constexpr int NTHREADS = 512;

struct KArgs {
    const float* x; const float* c; const float* ctx; const float* c_ctx; const float* norm_g; const float* w_ada; const float* b_ada;
    const float* w_in; const float* w_out; const float* na_rpb; const float* hy_conv_w; const float* hy_conv_b;
    const float* hy_w1; const float* hy_b1; const float* hy_freq1; const float* hy_w2; const float* hy_b2; const float* hy_freq2; const float* hy_w3;
    const float* hy_d; const float* sink; const float* final_g;
    float* out; unsigned char* ws;
    int ph_lo, ph_hi;
};

typedef const __attribute__((address_space(4))) KArgs CKArgs;
__device__ __forceinline__ unsigned pk2(float lo, float hi) { f32x2_t v = {lo, hi}; bf16x2_t b = __builtin_convertvector(v, bf16x2_t); return __builtin_bit_cast(unsigned, b); }
__device__ __forceinline__ float bf2f(unsigned short u) { return __uint_as_float(((unsigned)u) << 16); }
__device__ __forceinline__ float bflo(unsigned w) { return __uint_as_float(w << 16); }
__device__ __forceinline__ float bfhi(unsigned w) { return __uint_as_float(w & 0xffff0000u); }
__device__ __forceinline__ float silu_f(float x) { return x / (1.0f + __expf(-x)); }
__device__ __forceinline__ float lane_xor(float v, int lane, int m) { return __int_as_float(__builtin_amdgcn_ds_bpermute((lane ^ m) << 2, __float_as_int(v))); }
__device__ __forceinline__ float lane_prev(float v, int lane) { return __int_as_float(__builtin_amdgcn_ds_bpermute(((lane - 1) & 63) << 2, __float_as_int(v))); }
__device__ __forceinline__ float lane_next(float v, int lane) { return __int_as_float(__builtin_amdgcn_ds_bpermute(((lane + 1) & 63) << 2, __float_as_int(v))); }
__device__ __forceinline__ float wave_sum(float v, int lane) {
#pragma unroll
    for (int o = 1; o < 64; o <<= 1) v += lane_xor(v, lane, o);
    return v;
}
__device__ __forceinline__ float rdlane(float v, int l) { return __uint_as_float(__builtin_amdgcn_readlane(__float_as_uint(v), l)); }

__device__ __forceinline__ void transpose_item(const float* W, int K, int N, bf16_t* WT, int k0, int n0, int drow0, LAS float* scr, int lane, int ldk = 0) {
    if (ldk == 0) ldk = K;
#pragma unroll 8
    for (int i = 0; i < 32; ++i) { const int kk = 2 * i + (lane >> 5); scr[kk * 33 + (lane & 31)] = W[(size_t)(k0 + kk) * N + n0 + (lane & 31)]; }
    asm volatile("s_waitcnt lgkmcnt(0)" ::: "memory");
    const int c = lane & 7;
#pragma unroll
    for (int j = 0; j < 4; ++j) { const int n = (lane >> 3) + 8 * j; const LAS float* s = scr + (8 * c) * 33 + n;
        u32x4 o; o.x = pk2(s[0 * 33], s[1 * 33]); o.y = pk2(s[2 * 33], s[3 * 33]); o.z = pk2(s[4 * 33], s[5 * 33]); o.w = pk2(s[6 * 33], s[7 * 33]);
        *(u32x4*)(WT + (size_t)(drow0 + n) * ldk + k0 + 8 * c) = o; }
    asm volatile("s_waitcnt lgkmcnt(0)" ::: "memory");
}
__device__ __forceinline__ int win_row(int n0) {
    if (n0 < 384) return n0;
    if (n0 < 768) return n0 - 384 + 1536;
    if (n0 < 1152) return n0 - 768 + 2048;
    if (n0 < 1536) return n0 - 1152 + 384;
    if (n0 < 2304) return n0 - 1536 + 2560;
    if (n0 < 2560) return n0 - 2304 + 3328;
    if (n0 < 2944) return n0 - 2560 + 768;
    if (n0 < 3072) return n0 - 2944 + 1920;
    if (n0 < 3200) return n0 - 3072 + 2432;
    return n0 - 3200 + 1152;
}

__device__ __forceinline__ void phase_prologue(CKArgs& A, LAS unsigned char* lds, int bid, int nblk, int tid) {
    const int wave = __builtin_amdgcn_readfirstlane(tid >> 6), lane = tid & 63;
    const int gw = bid * 8 + wave, NGW = nblk * 8;
    unsigned char* ws = A.ws;
    {
        LAS float* scr = (LAS float*)(lds + wave * 16384);
        constexpr int I_IN = 16 * 112, I_OUT = 16 * 32, I_L = I_IN + I_OUT;
        for (int it = gw; it < DEPTH * I_L; it += NGW) {
            const int l = it / I_L; int r = it % I_L;
            if (r < I_IN) { const int kb = r / 112, nb = r % 112, n0 = nb * 32;
                transpose_item(A.w_in + (size_t)l * DM * NIN, DM, NIN, (bf16_t*)(ws + WS_WIN) + (size_t)l * NIN * DM, kb * 64, n0, win_row(n0), scr, lane); }
            else { r -= I_IN; const int kb = r / 32, nb = r % 32, n0 = nb * 32;
                transpose_item(A.w_out + (size_t)l * DM * DM, DM, DM, (bf16_t*)(ws + WS_WOUT) + (size_t)l * DM * DM, kb * 64, n0, n0, scr, lane); }
        }
    }
    {
        LAS float* scr = (LAS float*)(lds + wave * 16384);
        bf16_t* W3T = (bf16_t*)(ws + WS_W3T);
        for (int it = gw; it < DEPTH * 32; it += NGW) { const int l = it >> 5, nb = it & 31;
            transpose_item(A.hy_w3 + (size_t)l * 64 * 1024, 64, 1024, W3T + (size_t)l * 1024 * 64, 0, nb * 32, nb * 32, scr, lane); }
    }
    for (int idx = gw * 64 + lane; idx < 128 * 16; idx += NGW * 64) {
        const int p = idx >> 4, i = idx & 15;
        const float inv = powf(10000.0f, -(float)i / 16.0f);
        const float ang = (float)p * inv;
        ((float2*)(ws + WS_ROPE))[idx] = make_float2(cosf(ang), sinf(ang));
    }
    for (int it = gw; it < DEPTH * 528; it += NGW) {
        const int l = it / 528, g4 = it % 528, g = g4 >> 2, sub = g4 & 3;
        const int L = g < 128 ? SEQ : CTXL;
        const int n0 = (g < 128 ? g * 64 : (g - 128) * 64) + 16 * sub;
        float* outp = (float*)(ws + WS_H2C) + ((size_t)l * CTXL + n0) * 64;
        bf16_t* outb = (bf16_t*)(ws + WS_H2) + ((size_t)l * SEQ + n0) * 64;
        float w1c[33], w2c[64];
#pragma unroll
        for (int q = 0; q < 33; ++q) w1c[q] = A.hy_w1[((size_t)l * 33 + q) * 64 + lane];
#pragma unroll
        for (int j = 0; j < 64; ++j) w2c[j] = A.hy_w2[((size_t)l * 64 + j) * 64 + lane];
        const float b1 = A.hy_b1[l * 64 + lane], fr1 = A.hy_freq1[l * 64 + lane], b2 = A.hy_b2[l * 64 + lane], fr2 = A.hy_freq2[l * 64 + lane];
        const float tstep = 1.0f / (float)(L - 1);
        const int fj = lane == 0 ? 0 : ((lane - 1) & 15);
        const float fq = 1e-4f + (float)fj * ((15.0f - 1e-4f) / 15.0f);
#pragma unroll 1
        for (int nn = 0; nn < 16; ++nn) {
            const int n = n0 + nn;
            const float t = (float)n * tstep;
            const float rev = fq * ((float)n * (1.0f / (float)L)) + (lane <= 16 ? 0.25f : 0.5f);
            float zq = __builtin_amdgcn_sinf(rev - floorf(rev));
            if (lane == 0) zq = t; if (lane > 32) zq = 0.f;
            float a1 = b1;
#pragma unroll
            for (int q = 0; q < 33; ++q) a1 += rdlane(zq, q) * w1c[q];
            const float x1 = fr1 * a1 * 0.15915494309189535f;
            const float h1 = __builtin_amdgcn_sinf(x1 - floorf(x1));
            float a2 = b2;
#pragma unroll
            for (int j = 0; j < 64; ++j) a2 += rdlane(h1, j) * w2c[j];
            const float x2 = fr2 * a2 * 0.15915494309189535f;
            const float h2 = __builtin_amdgcn_sinf(x2 - floorf(x2));
            if (g < 128) outb[nn * 64 + lane] = (bf16_t)(pk2(h2, 0.f) & 0xffffu);
            else outp[nn * 64 + lane] = h2;
        }
    }
    __syncthreads();
    {
        LAS float* red = (LAS float*)lds;
        LAS float* sv = (LAS float*)(lds + 8192);
        for (int i = tid; i < 3 * DM; i += NTHREADS) sv[i] = silu_f(i < 2 * DM ? A.c[i] : A.c_ctx[i - 2 * DM]);
        __syncthreads();
        for (int it = bid; it < DEPTH * 48; it += nblk) {
            const int l = it / 48, n = (it % 48) * 64 + lane;
            const float* W = A.w_ada + (size_t)l * DM * 3072 + n;
            float a0 = 0.f, a1 = 0.f, a2 = 0.f;
            const int kb = wave * 128;
#pragma unroll 1
            for (int k0 = 0; k0 < 128; k0 += 16) {
                float w[16];
#pragma unroll
                for (int k = 0; k < 16; ++k) w[k] = W[(size_t)(kb + k0 + k) * 3072];
#pragma unroll
                for (int k = 0; k < 16; ++k) { a0 += sv[kb + k0 + k] * w[k]; a1 += sv[DM + kb + k0 + k] * w[k]; a2 += sv[2 * DM + kb + k0 + k] * w[k]; }
            }
            red[(wave * 3 + 0) * 64 + lane] = a0; red[(wave * 3 + 1) * 64 + lane] = a1; red[(wave * 3 + 2) * 64 + lane] = a2;
            __syncthreads();
            if (tid < 192) { const int v = tid >> 6; float sacc = A.b_ada[l * 3072 + n];
#pragma unroll
                for (int w = 0; w < 8; ++w) sacc += red[(w * 3 + v) * 64 + lane];
                ((float*)(ws + WS_ADA))[((size_t)l * 3 + v) * 3072 + n] = sacc; }
            __syncthreads();
        }
    }
}

__device__ __forceinline__ void filt_items(CKArgs& A, int lf, int tid, int bid, int nblk, unsigned* ctr) {
    unsigned char* ws = A.ws;
    const int wave = __builtin_amdgcn_readfirstlane(tid >> 6), lane = tid & 63;
    const int gw = bid * 8 + wave, NGW = nblk * 8;
    const bf16_t* H2B = (const bf16_t*)(ws + WS_H2) + (size_t)lf * SEQ * 64;
    const bf16_t* W3T = (const bf16_t*)(ws + WS_W3T) + (size_t)lf * 1024 * 64;
    bf16_t* FILT = (bf16_t*)(ws + WS_FILT);
    const int fr = lane & 15, fq = lane >> 4;
    int it = gw;
#pragma unroll 1
    for (;;) {
        if (ctr) { unsigned t = 0; if (lane == 0) t = __hip_atomic_fetch_add(ctr, 1u, __ATOMIC_RELAXED, __HIP_MEMORY_SCOPE_AGENT); it = (int)__builtin_amdgcn_readfirstlane(t); }
        if (it >= 2048) break;
        const int n0 = (it >> 4) * 64, c0 = (it & 15) * 64;
        bf16x8 af[4][2];
#pragma unroll
        for (int j = 0; j < 4; ++j) { const bf16_t* ap = H2B + (size_t)(n0 + 16 * (fr >> 2) + 4 * j + (fr & 3)) * 64 + 8 * fq; af[j][0] = *(const bf16x8*)ap; af[j][1] = *(const bf16x8*)(ap + 32); }
#pragma unroll 1
        for (int ct = 0; ct < 4; ++ct) {
            const bf16_t* bp = W3T + (size_t)(c0 + 16 * ct + fr) * 64 + 8 * fq;
            const bf16x8 b0 = *(const bf16x8*)bp, b1 = *(const bf16x8*)(bp + 32);
            u32x4 o0, o1;
#pragma unroll
            for (int j = 0; j < 4; ++j) {
                f32x4 acc = {0.f, 0.f, 0.f, 0.f};
                acc = __builtin_amdgcn_mfma_f32_16x16x32_bf16(af[j][0], b0, acc, 0, 0, 0);
                acc = __builtin_amdgcn_mfma_f32_16x16x32_bf16(af[j][1], b1, acc, 0, 0, 0);
                const unsigned w0 = pk2(acc.x, acc.y), w1 = pk2(acc.z, acc.w);
                if (j == 0) { o0.x = w0; o0.y = w1; } else if (j == 1) { o0.z = w0; o0.w = w1; } else if (j == 2) { o1.x = w0; o1.y = w1; } else { o1.z = w0; o1.w = w1; }
            }
            bf16_t* dp = FILT + (size_t)(c0 + 16 * ct + fr) * SEQ + n0 + 16 * fq;
            *(u32x4*)dp = o0; *(u32x4*)(dp + 8) = o1;
        }
        if (!ctr) it += NGW;
    }
}

__device__ __forceinline__ void ctx_outproj_items(CKArgs& A, int l, int tid, int bid, int nblk) {
    unsigned char* ws = A.ws;
    const int wave = __builtin_amdgcn_readfirstlane(tid >> 6), lane = tid & 63;
    const int gw = bid * 8 + wave, NGW = nblk * 8;
    const bf16_t* Y = (const bf16_t*)(ws + WS_HY) + (size_t)MLAT * DM;
    const bf16_t* WT = (const bf16_t*)(ws + WS_WOUT) + (size_t)l * DM * DM;
    const float* gate = (const float*)(ws + WS_ADA) + ((size_t)l * 3 + 2) * 3072 + 2048;
    const float* csrc = l == 0 ? A.ctx : (const float*)(ws + WS_CX);
    float* cdst = (float*)(ws + WS_CX);
    const int fr = lane & 15, fq = lane >> 4;
#pragma unroll 1
    for (int it = gw; it < 2048; it += NGW) {
        const int r0 = (it >> 6) * 16, c0 = (it & 63) * 16;
        const bf16_t* ap = Y + (size_t)(r0 + fr) * DM + 8 * fq;
        const bf16_t* bp = WT + (size_t)(c0 + fr) * DM + 8 * fq;
        f32x4 acc0 = {0.f, 0.f, 0.f, 0.f}, acc1 = {0.f, 0.f, 0.f, 0.f};
#pragma unroll 1
        for (int k0 = 0; k0 < 32; k0 += 8) {
            bf16x8 a[8], b[8];
#pragma unroll
            for (int k = 0; k < 8; ++k) { a[k] = *(const bf16x8*)(ap + 32 * (k0 + k)); b[k] = *(const bf16x8*)(bp + 32 * (k0 + k)); }
#pragma unroll
            for (int k = 0; k < 8; k += 2) { acc0 = __builtin_amdgcn_mfma_f32_16x16x32_bf16(a[k], b[k], acc0, 0, 0, 0); acc1 = __builtin_amdgcn_mfma_f32_16x16x32_bf16(a[k + 1], b[k + 1], acc1, 0, 0, 0); }
        }
        const float g = gate[c0 + fr];
#pragma unroll
        for (int i = 0; i < 4; ++i) { const size_t off = (size_t)(r0 + 4 * fq + i) * DM + c0 + fr; cdst[off] = csrc[off] + g * (acc0[i] + acc1[i]); }
    }
}

__device__ __forceinline__ void phase_norm(CKArgs& A, int l, int bid, int nblk, int tid) {
    const int wave = __builtin_amdgcn_readfirstlane(tid >> 6), lane = tid & 63;
    const int gw = bid * 8 + wave, NGW = nblk * 8;
    unsigned char* ws = A.ws;
    bf16_t* H = (bf16_t*)(ws + WS_HY);
    const float* ada = (const float*)(ws + WS_ADA) + (size_t)l * 3 * 3072;
    const float* g = A.norm_g + l * DM;
    for (int m = gw; m < MTOT; m += NGW) {
        const float* src; int v;
        if (m < MLAT) { src = (l == 0 ? A.x : A.out) + (size_t)m * DM; v = m >> 13; }
        else { src = (l == 0 ? A.ctx : (const float*)(ws + WS_CX)) + (size_t)(m - MLAT) * DM; v = 2; }
        const float* shp = ada + v * 3072; const float* scp = shp + DM;
        f32x4 xv[4]; float ss = 0.f;
#pragma unroll
        for (int j = 0; j < 4; ++j) { xv[j] = *(const f32x4*)(src + 4 * lane + 256 * j); ss += (xv[j].x * xv[j].x + xv[j].y * xv[j].y) + (xv[j].z * xv[j].z + xv[j].w * xv[j].w); }
        const float rinv = rsqrtf(wave_sum(ss, lane) * (1.0f / DM) + 1e-6f);
#pragma unroll
        for (int j = 0; j < 4; ++j) { const int col = 4 * lane + 256 * j;
            const f32x4 gv = *(const f32x4*)(g + col), sc = *(const f32x4*)(scp + col), sh = *(const f32x4*)(shp + col);
            const f32x4 h = xv[j] * rinv * gv * (sc + 1.0f) + sh;
            u32x2 o; o.x = pk2(h.x, h.y); o.y = pk2(h.z, h.w);
            *(u32x2*)(H + (size_t)m * DM + col) = o; }
    }
    if (l == 0) filt_items(A, 0, tid, bid, nblk, nullptr);
}

struct EpiIn {
    static constexpr bool PERM = true, AFTER_DRAIN = false;
    bf16_t* PT; bf16_t* KH; bf16_t* PCT; const float2* rope;
    __device__ __forceinline__ void operator()(const f32x4 (&acc)[2][2][4][2], const pg8::Unit& u, int wr, int wc, int fr, int fq) const {
        const int row0 = u.pm * 256 + wr * 64 + fr;
        if (u.pn < 10) {
#pragma unroll
            for (int bj = 0; bj < 2; ++bj) {
                const int blk = 2 * u.pn + bj;
                const bool rp = ((blk >= 6 && blk <= 8) || blk == 15) && (u.pm < 64);
                const int col0 = 256 * u.pn + 128 * bj + 32 * wc + 8 * fq;
                bf16_t* dst; size_t ld;
                if (u.pn < 6) { dst = PT + col0; ld = NTM; }
                else { const int n2 = col0 - 1536; dst = KH + (size_t)(n2 >> 6) * MTOT * 64 + (n2 & 63); ld = 64; }
#pragma unroll
                for (int ai = 0; ai < 2; ++ai)
#pragma unroll
                    for (int m = 0; m < 4; ++m) {
                        const int r = row0 + 128 * ai + 16 * m;
                        f32x4 v0 = acc[ai][bj][m][0], v1 = acc[ai][bj][m][1];
                        if (rp) {
                            const int pos = r & (SEQ - 1);
                            const int p = (wc & 1) ? (pos & 63) : (pos >> 6);
                            const f32x4* tb = (const f32x4*)(rope + p * 16 + 8 * (fq & 1));
                            const int ln = fr + 16 * fq;
                            const float sg = (fq < 2) ? -1.0f : 1.0f;
                            { const f32x4 t0 = tb[0], t1 = tb[1];
                              const float qx = lane_xor(v0.x, ln, 32), qy = lane_xor(v0.y, ln, 32), qz = lane_xor(v0.z, ln, 32), qw = lane_xor(v0.w, ln, 32);
                              v0.x = v0.x * t0.x + sg * qx * t0.y; v0.y = v0.y * t0.z + sg * qy * t0.w; v0.z = v0.z * t1.x + sg * qz * t1.y; v0.w = v0.w * t1.z + sg * qw * t1.w; }
                            { const f32x4 t2 = tb[2], t3 = tb[3];
                              const float qx = lane_xor(v1.x, ln, 32), qy = lane_xor(v1.y, ln, 32), qz = lane_xor(v1.z, ln, 32), qw = lane_xor(v1.w, ln, 32);
                              v1.x = v1.x * t2.x + sg * qx * t2.y; v1.y = v1.y * t2.z + sg * qy * t2.w; v1.z = v1.z * t3.x + sg * qz * t3.y; v1.w = v1.w * t3.z + sg * qw * t3.w; }
                        }
                        u32x4 w; w.x = pk2(v0.x, v0.y); w.y = pk2(v0.z, v0.w); w.z = pk2(v1.x, v1.y); w.w = pk2(v1.z, v1.w);
                        *(u32x4*)(dst + (size_t)r * ld) = w;
                        asm volatile("" ::: "memory");
                    }
            }
        } else {
#pragma unroll
            for (int bj = 0; bj < 2; ++bj) {
                const int ch0 = 256 * (u.pn - 10) + 128 * bj + 32 * wc + 8 * fq;
#pragma unroll
                for (int ai = 0; ai < 2; ++ai)
#pragma unroll
                    for (int m = 0; m < 4; ++m) {
                        const int r = row0 + 128 * ai + 16 * m;
                        bf16_t* p = PCT + (size_t)ch0 * MTOT + r;
#pragma unroll
                        for (int n = 0; n < 2; ++n) {
                            const f32x4 v = acc[ai][bj][m][n];
                            bf16_t* q = p + (size_t)(4 * n) * MTOT;
                            const unsigned w0 = pk2(v.x, v.y), w1 = pk2(v.z, v.w);
                            q[0] = (bf16_t)(w0 & 0xffffu); q[MTOT] = (bf16_t)(w0 >> 16); q[2 * (size_t)MTOT] = (bf16_t)(w1 & 0xffffu); q[3 * (size_t)MTOT] = (bf16_t)(w1 >> 16);
                        }
                    }
            }
        }
    }
};
struct EpiFilt {
    static constexpr bool PERM = true, AFTER_DRAIN = false;
    bf16_t* O; int ldc;
    __device__ __forceinline__ void operator()(const f32x4 (&acc)[2][2][4][2], const pg8::Unit& u, int wr, int wc, int fr, int fq) const {
        const int row0 = u.pm * 256 + wr * 64 + fr;
#pragma unroll
        for (int bj = 0; bj < 2; ++bj) { const int col0 = 256 * u.pn + 128 * bj + 32 * wc + 8 * fq;
#pragma unroll
            for (int ai = 0; ai < 2; ++ai)
#pragma unroll
                for (int m = 0; m < 4; ++m) { const int r = row0 + 128 * ai + 16 * m; const f32x4 v0 = acc[ai][bj][m][0], v1 = acc[ai][bj][m][1];
                    u32x4 w; w.x = pk2(v0.x, v0.y); w.y = pk2(v0.z, v0.w); w.z = pk2(v1.x, v1.y); w.w = pk2(v1.z, v1.w);
                    *(u32x4*)(O + (size_t)r * ldc + col0) = w; } }
    }
};
struct EpiOut {
    static constexpr bool PERM = true, AFTER_DRAIN = false;
    const float* xsrc; float* xdst; const float* csrc; float* cdst; const float* ada;
    __device__ __forceinline__ void operator()(const f32x4 (&acc)[2][2][4][2], const pg8::Unit& u, int wr, int wc, int fr, int fq) const {
        const int row0 = u.pm * 256 + wr * 64 + fr;
        const bool lat = u.pm < 64;
        const int v = lat ? (row0 >> 13) : 2;
        const float* sbase = lat ? xsrc + (size_t)row0 * DM : csrc + (size_t)(row0 - MLAT) * DM;
        float* dbase = lat ? xdst + (size_t)row0 * DM : cdst + (size_t)(row0 - MLAT) * DM;
#pragma unroll
        for (int bj = 0; bj < 2; ++bj) {
            const int col0 = 256 * u.pn + 128 * bj + 32 * wc + 8 * fq;
            const float* gp = ada + v * 3072 + 2048 + col0;
            const f32x4 g0 = *(const f32x4*)gp, g1 = *(const f32x4*)(gp + 4);
#pragma unroll
            for (int ai = 0; ai < 2; ++ai) {
                f32x4 x0[4], x1[4];
#pragma unroll
                for (int m = 0; m < 4; ++m) { const float* sp = sbase + (size_t)(128 * ai + 16 * m) * DM + col0; x0[m] = *(const f32x4*)sp; x1[m] = *(const f32x4*)(sp + 4); }
#pragma unroll
                for (int m = 0; m < 4; ++m) { float* dp = dbase + (size_t)(128 * ai + 16 * m) * DM + col0;
                    *(f32x4*)dp = x0[m] + g0 * acc[ai][bj][m][0];
                    *(f32x4*)(dp + 4) = x1[m] + g1 * acc[ai][bj][m][1]; }
                asm volatile("" ::: "memory");
            }
            asm volatile("" ::: "memory");
        }
    }
};
struct EpiAll {
    static constexpr bool PERM = true, AFTER_DRAIN = false;
    int mode, l; CKArgs* Ap;
    __device__ __forceinline__ void operator()(const f32x4 (&acc)[2][2][4][2], const pg8::Unit& u, int wr, int wc, int fr, int fq) const {
        unsigned char* ws = Ap->ws;
        if (mode == 0) { const EpiIn E{(bf16_t*)(ws + WS_PT), (bf16_t*)(ws + WS_KH), (bf16_t*)(ws + WS_PCT), (const float2*)(ws + WS_ROPE)}; E(acc, u, wr, wc, fr, fq); }
        else { const EpiOut E{l == 0 ? Ap->x : Ap->out, Ap->out, l == 0 ? Ap->ctx : (const float*)(ws + WS_CX), (float*)(ws + WS_CX), (const float*)(ws + WS_ADA) + (size_t)l * 3 * 3072}; E(acc, u, wr, wc, fr, fq); }
    }
};
__device__ __forceinline__ float max3f(float a, float b, float c) { float r; asm("v_max3_f32 %0, %1, %2, %3" : "=v"(r) : "v"(a), "v"(b), "v"(c)); return r; }
__device__ __forceinline__ float max2f(float a, float b) { float r; asm("v_max_f32_e32 %0, %1, %2" : "=v"(r) : "v"(a), "v"(b)); return r; }
__device__ __forceinline__ void attn_tile(LAS const unsigned char* slot, int cs, const bf16x8 (&bq)[4], f32x16& o0, f32x16& o1, float& m_run, float& l_run,
                                          int r31, int hh, bool use_mask, int clo, int chi, bool use_bias, LAS const float* btab, int bidx) {
    const int kr = cs + r31;
    LAS const unsigned char* kp = slot + kr * 128;
    const int ksw = (kr >> 1) & 7;
    const bf16x8 ka0 = *(LAS const bf16x8*)(kp + 16 * ((0 + hh) ^ ksw)), ka1 = *(LAS const bf16x8*)(kp + 16 * ((2 + hh) ^ ksw));
    const bf16x8 ka2 = *(LAS const bf16x8*)(kp + 16 * ((4 + hh) ^ ksw)), ka3 = *(LAS const bf16x8*)(kp + 16 * ((6 + hh) ^ ksw));
    LAS const unsigned char* vp = slot + 8192 + r31 * 128;
    const int vsw = (r31 >> 1) & 15, g0 = (cs >> 2) + hh;
    const u32x2 a0l = *(LAS const u32x2*)(vp + 8 * ((g0) ^ vsw)), a0h = *(LAS const u32x2*)(vp + 8 * ((g0 + 2) ^ vsw));
    const u32x2 a1l = *(LAS const u32x2*)(vp + 8 * ((g0 + 4) ^ vsw)), a1h = *(LAS const u32x2*)(vp + 8 * ((g0 + 6) ^ vsw));
    const u32x2 b0l = *(LAS const u32x2*)(vp + 4096 + 8 * ((g0) ^ vsw)), b0h = *(LAS const u32x2*)(vp + 4096 + 8 * ((g0 + 2) ^ vsw));
    const u32x2 b1l = *(LAS const u32x2*)(vp + 4096 + 8 * ((g0 + 4) ^ vsw)), b1h = *(LAS const u32x2*)(vp + 4096 + 8 * ((g0 + 6) ^ vsw));
    f32x16 s, t;
#pragma unroll
    for (int i = 0; i < 16; ++i) { s[i] = 0.f; t[i] = 0.f; }
    s = __builtin_amdgcn_mfma_f32_32x32x16_bf16(ka0, bq[0], s, 0, 0, 0); t = __builtin_amdgcn_mfma_f32_32x32x16_bf16(ka1, bq[1], t, 0, 0, 0);
    s = __builtin_amdgcn_mfma_f32_32x32x16_bf16(ka2, bq[2], s, 0, 0, 0); t = __builtin_amdgcn_mfma_f32_32x32x16_bf16(ka3, bq[3], t, 0, 0, 0);
    if (use_bias) {
        LAS const float* bp = btab + bidx;
#pragma unroll
        for (int i = 0; i < 16; ++i) { const int c = (i & 3) + 8 * (i >> 2) + 4 * hh; s[i] = (s[i] + t[i]) * QK_SCALE + bp[c]; }
    } else {
#pragma unroll
        for (int i = 0; i < 16; ++i) s[i] = (s[i] + t[i]) * QK_SCALE;
    }
    if (use_mask) {
        const unsigned off = (unsigned)(4 * hh - clo), rng = (unsigned)(chi - clo);
        const bool any = chi >= clo;
#pragma unroll
        for (int i = 0; i < 16; ++i) { const unsigned c0 = (unsigned)((i & 3) + 8 * (i >> 2)); s[i] = (any && (c0 + off <= rng)) ? s[i] : -INFINITY; }
    }
    float tmax = max3f(s[0], s[1], s[2]);
#pragma unroll
    for (int i = 3; i < 15; i += 2) tmax = max3f(tmax, s[i], s[i + 1]);
    tmax = max2f(tmax, s[15]);
    tmax = max2f(tmax, lane_xor(tmax, r31 + 32 * hh, 32));
    if (__any(tmax - m_run > 8.0f)) {
        const float m_new = fmaxf(m_run, tmax);
        const float alpha = __builtin_amdgcn_exp2f(m_run - m_new);
        m_run = m_new; l_run *= alpha;
#pragma unroll
        for (int i = 0; i < 16; ++i) { o0[i] *= alpha; o1[i] *= alpha; }
    }
    float ps0 = 0.f, ps1 = 0.f;
#pragma unroll
    for (int i = 0; i < 16; i += 2) { const float p0 = __builtin_amdgcn_exp2f(s[i] - m_run), p1 = __builtin_amdgcn_exp2f(s[i + 1] - m_run); s[i] = p0; s[i + 1] = p1; ps0 += p0; ps1 += p1; }
    l_run += ps0 + ps1;
    u32x4 pw0, pw1;
    pw0.x = pk2(s[0], s[1]); pw0.y = pk2(s[2], s[3]); pw0.z = pk2(s[4], s[5]); pw0.w = pk2(s[6], s[7]);
    pw1.x = pk2(s[8], s[9]); pw1.y = pk2(s[10], s[11]); pw1.z = pk2(s[12], s[13]); pw1.w = pk2(s[14], s[15]);
    const bf16x8 pb0 = __builtin_bit_cast(bf16x8, pw0), pb1 = __builtin_bit_cast(bf16x8, pw1);
    u32x4 w;
    w.x = a0l.x; w.y = a0l.y; w.z = a0h.x; w.w = a0h.y; const bf16x8 va00 = __builtin_bit_cast(bf16x8, w);
    w.x = a1l.x; w.y = a1l.y; w.z = a1h.x; w.w = a1h.y; const bf16x8 va01 = __builtin_bit_cast(bf16x8, w);
    w.x = b0l.x; w.y = b0l.y; w.z = b0h.x; w.w = b0h.y; const bf16x8 va10 = __builtin_bit_cast(bf16x8, w);
    w.x = b1l.x; w.y = b1l.y; w.z = b1h.x; w.w = b1h.y; const bf16x8 va11 = __builtin_bit_cast(bf16x8, w);
    o0 = __builtin_amdgcn_mfma_f32_32x32x16_bf16(va00, pb0, o0, 0, 0, 0); o1 = __builtin_amdgcn_mfma_f32_32x32x16_bf16(va10, pb0, o1, 0, 0, 0);
    o0 = __builtin_amdgcn_mfma_f32_32x32x16_bf16(va01, pb1, o0, 0, 0, 0); o1 = __builtin_amdgcn_mfma_f32_32x32x16_bf16(va11, pb1, o1, 0, 0, 0);
}

__device__ __forceinline__ void attn_tile2(LAS const unsigned char* slot, const bf16x8 (&bq)[4], f32x16& o0, f32x16& o1, float& m_run, float& l_run,
                                           int r31, int hh, bool use_mask, int clo0, int chi0, int clo1, int chi1) {
    const int ksw = (r31 >> 1) & 7;
    LAS const unsigned char* kp = slot + r31 * 128;
    const bf16x8 ka0 = *(LAS const bf16x8*)(kp + 16 * ((0 + hh) ^ ksw)), ka1 = *(LAS const bf16x8*)(kp + 16 * ((2 + hh) ^ ksw));
    const bf16x8 ka2 = *(LAS const bf16x8*)(kp + 16 * ((4 + hh) ^ ksw)), ka3 = *(LAS const bf16x8*)(kp + 16 * ((6 + hh) ^ ksw));
    const bf16x8 kb0 = *(LAS const bf16x8*)(kp + 4096 + 16 * ((0 + hh) ^ ksw)), kb1 = *(LAS const bf16x8*)(kp + 4096 + 16 * ((2 + hh) ^ ksw));
    const bf16x8 kb2 = *(LAS const bf16x8*)(kp + 4096 + 16 * ((4 + hh) ^ ksw)), kb3 = *(LAS const bf16x8*)(kp + 4096 + 16 * ((6 + hh) ^ ksw));
    f32x16 s0, s1;
#pragma unroll
    for (int i = 0; i < 16; ++i) { s0[i] = 0.f; s1[i] = 0.f; }
    s0 = __builtin_amdgcn_mfma_f32_32x32x16_bf16(ka0, bq[0], s0, 0, 0, 0); s1 = __builtin_amdgcn_mfma_f32_32x32x16_bf16(kb0, bq[0], s1, 0, 0, 0);
    s0 = __builtin_amdgcn_mfma_f32_32x32x16_bf16(ka1, bq[1], s0, 0, 0, 0); s1 = __builtin_amdgcn_mfma_f32_32x32x16_bf16(kb1, bq[1], s1, 0, 0, 0);
    s0 = __builtin_amdgcn_mfma_f32_32x32x16_bf16(ka2, bq[2], s0, 0, 0, 0); s1 = __builtin_amdgcn_mfma_f32_32x32x16_bf16(kb2, bq[2], s1, 0, 0, 0);
    s0 = __builtin_amdgcn_mfma_f32_32x32x16_bf16(ka3, bq[3], s0, 0, 0, 0); s1 = __builtin_amdgcn_mfma_f32_32x32x16_bf16(kb3, bq[3], s1, 0, 0, 0);
    LAS const unsigned char* vp = slot + 8192 + r31 * 128;
    const int vsw = (r31 >> 1) & 15;
    u32x2 va[2][4][2];
#pragma unroll
    for (int db = 0; db < 2; ++db)
#pragma unroll
        for (int st = 0; st < 4; ++st) { va[db][st][0] = *(LAS const u32x2*)(vp + 4096 * db + 8 * ((4 * st + hh) ^ vsw)); va[db][st][1] = *(LAS const u32x2*)(vp + 4096 * db + 8 * ((4 * st + hh + 2) ^ vsw)); }
    if (use_mask) {
        const unsigned off0 = (unsigned)(4 * hh - clo0), rng0 = (unsigned)(chi0 - clo0), off1 = (unsigned)(4 * hh - clo1), rng1 = (unsigned)(chi1 - clo1);
#pragma unroll
        for (int i = 0; i < 16; ++i) { const unsigned c0 = (unsigned)((i & 3) + 8 * (i >> 2)); s0[i] = (c0 + off0 <= rng0) ? s0[i] : -INFINITY; s1[i] = (c0 + off1 <= rng1) ? s1[i] : -INFINITY; }
    }
    float tmax = max3f(s0[0], s0[1], s1[0]);
    tmax = max2f(tmax, s1[1]);
#pragma unroll
    for (int i = 2; i < 16; i += 2) { tmax = max3f(tmax, s0[i], s0[i + 1]); tmax = max3f(tmax, s1[i], s1[i + 1]); }
    tmax = max2f(tmax, lane_xor(tmax, r31 + 32 * hh, 32)) * QK_SCALE;
    if (__any(tmax - m_run > 8.0f)) {
        const float m_new = fmaxf(m_run, tmax);
        const float alpha = __builtin_amdgcn_exp2f(m_run - m_new);
        m_run = m_new; l_run *= alpha;
#pragma unroll
        for (int i = 0; i < 16; ++i) { o0[i] *= alpha; o1[i] *= alpha; }
    }
    float ps0 = 0.f, ps1 = 0.f;
    const float nm = -m_run;
#pragma unroll
    for (int i = 0; i < 16; ++i) { const float p0 = __builtin_amdgcn_exp2f(fmaf(s0[i], QK_SCALE, nm)), p1 = __builtin_amdgcn_exp2f(fmaf(s1[i], QK_SCALE, nm)); s0[i] = p0; s1[i] = p1; ps0 += p0; ps1 += p1; }
    l_run += ps0 + ps1;
    u32x4 pw;
    pw.x = pk2(s0[0], s0[1]); pw.y = pk2(s0[2], s0[3]); pw.z = pk2(s0[4], s0[5]); pw.w = pk2(s0[6], s0[7]); const bf16x8 p00 = __builtin_bit_cast(bf16x8, pw);
    pw.x = pk2(s0[8], s0[9]); pw.y = pk2(s0[10], s0[11]); pw.z = pk2(s0[12], s0[13]); pw.w = pk2(s0[14], s0[15]); const bf16x8 p01 = __builtin_bit_cast(bf16x8, pw);
    pw.x = pk2(s1[0], s1[1]); pw.y = pk2(s1[2], s1[3]); pw.z = pk2(s1[4], s1[5]); pw.w = pk2(s1[6], s1[7]); const bf16x8 p10 = __builtin_bit_cast(bf16x8, pw);
    pw.x = pk2(s1[8], s1[9]); pw.y = pk2(s1[10], s1[11]); pw.z = pk2(s1[12], s1[13]); pw.w = pk2(s1[14], s1[15]); const bf16x8 p11 = __builtin_bit_cast(bf16x8, pw);
#define VA8(db_, st_) __builtin_bit_cast(bf16x8, (u32x4){va[db_][st_][0].x, va[db_][st_][0].y, va[db_][st_][1].x, va[db_][st_][1].y})
    o0 = __builtin_amdgcn_mfma_f32_32x32x16_bf16(VA8(0, 0), p00, o0, 0, 0, 0); o1 = __builtin_amdgcn_mfma_f32_32x32x16_bf16(VA8(1, 0), p00, o1, 0, 0, 0);
    o0 = __builtin_amdgcn_mfma_f32_32x32x16_bf16(VA8(0, 1), p01, o0, 0, 0, 0); o1 = __builtin_amdgcn_mfma_f32_32x32x16_bf16(VA8(1, 1), p01, o1, 0, 0, 0);
    o0 = __builtin_amdgcn_mfma_f32_32x32x16_bf16(VA8(0, 2), p10, o0, 0, 0, 0); o1 = __builtin_amdgcn_mfma_f32_32x32x16_bf16(VA8(1, 2), p10, o1, 0, 0, 0);
    o0 = __builtin_amdgcn_mfma_f32_32x32x16_bf16(VA8(0, 3), p11, o0, 0, 0, 0); o1 = __builtin_amdgcn_mfma_f32_32x32x16_bf16(VA8(1, 3), p11, o1, 0, 0, 0);
#undef VA8
}

__device__ __forceinline__ void attn_block_item(CKArgs& A, int l, int MODE, int item, LAS unsigned char* lds, int tid) {
    asm volatile("" : "+v"(tid));
    unsigned char* ws = A.ws;
    const bf16_t* PT = (const bf16_t*)(ws + WS_PT);
    bf16_t* Y = (bf16_t*)(ws + WS_HY);
    const int wave = __builtin_amdgcn_readfirstlane(tid >> 6), lane = tid & 63;
    const int r31 = lane & 31, hh = lane >> 5;
    int b, h, qtok, qi = 0;
    int rp = 0, mg = 0, qg = 0;
    if (MODE == 0) { b = item / 192; const int rem = item % 192; h = rem >> 5; qi = rem & 31; rp = 2 * qi + (wave >> 2); mg = wave & 3;
        qtok = b * SEQ + (2 * rp + (r31 >> 4)) * 64 + 16 * mg + (r31 & 15); }
    else if (MODE == 1) { b = item / 192; const int rem = item % 192; h = rem >> 5; qi = rem & 31; qg = 8 * qi + wave; qtok = b * SEQ + 32 * qg + r31; }
    else { b = item / 6; h = item % 6; qg = wave; qtok = MLAT + b * CTXL + 32 * qg + r31; }
    const bool grpA = (MODE == 0 || MODE == 2);
    const int kvh = grpA ? h : h / 3;
    const int qcol = (grpA ? C_QA : C_QC) + h * 64, gcol = (grpA ? C_GA : C_GC) + h * 64, ycol = (grpA ? 0 : 640) + h * 64;
    const int kh = grpA ? h : 6 + kvh;
    bf16x8 bq[4];
    { const bf16_t* qp = PT + (size_t)qtok * NTM + qcol + 8 * hh;
#pragma unroll
      for (int s = 0; s < 4; ++s) bq[s] = *(const bf16x8*)(qp + 16 * s); }
    f32x16 o0, o1;
#pragma unroll
    for (int i = 0; i < 16; ++i) { o0[i] = 0.f; o1[i] = 0.f; }
    float m_run = -1e30f, l_run = 0.f;
    if (!grpA) { m_run = A.sink[l * 6 + h] * LOG2E; l_run = hh == 0 ? 1.0f : 0.f; }
    int wrow0 = 0, nwin = 0;
    if (MODE == 0) { const int a0 = min(max(4 * qi - 4, 0), 120), a1 = min(max(4 * qi - 1, 0), 120) + 7; wrow0 = a0; nwin = a1 - a0 + 1; }
    if (MODE == 1) { const int k0 = max(4 * qi - 2, 0), k1 = min(4 * qi + 5, 127); wrow0 = k0; nwin = k1 - k0 + 1; }
    const int nsteps = 4 + nwin;
    int ra = 0, rb = -1, cs = 0, rq = 0, jq = 0, r0 = 0, cmin = 0;
    LAS const float* btab = (LAS const float*)(lds + AUX_OFF + 2048);
    if (MODE == 0) { ra = min(max(2 * rp - 4, 0), 120); rb = min(max(2 * rp - 3, 0), 120) + 7; cs = min(max(16 * mg - 8, 0), 32);
        rq = 2 * rp + (r31 >> 4); jq = 16 * mg + (r31 & 15); r0 = min(max(rq - 4, 0), 120); cmin = min(max(jq - 8, 0), 48) - cs;
        }
    const int lr = tid >> 3, lc = tid & 7;
    const bf16_t* kg = (const bf16_t*)(ws + WS_KH) + (size_t)kh * MTOT * 64 + 8 * tid;
    const bf16_t* vg = (const bf16_t*)(ws + WS_VT) + (size_t)kh * MTOT * 64 + 8 * tid;
    const int kdst = lr * 128 + 16 * (lc ^ ((lr >> 1) & 7));
    const int vdstb = 8192 + (8 * lc) * 128 + 2 * (lr & 3), vg4 = lr >> 2, vs4 = (4 * lc) & 15;
#define ROW_TOK(i) ((i) < 4 ? MLAT + b * CTXL + 64 * (i) : b * SEQ + 64 * (wrow0 + (i) - 4))
#define LOAD_ROW(i, kr_, vr_) do { const int t0_ = ROW_TOK(i); kr_ = *(const u32x4*)(kg + (size_t)t0_ * 64); vr_ = *(const u32x4*)(vg + (size_t)t0_ * 64); } while (0)
#define WRITE_ROW(sl_, kr_, vr_) do { *(LAS u32x4*)((sl_) + kdst) = kr_; \
        _Pragma("unroll") for (int j_ = 0; j_ < 8; ++j_) { const unsigned w_ = j_ < 2 ? vr_.x : (j_ < 4 ? vr_.y : (j_ < 6 ? vr_.z : vr_.w)); \
            *(LAS bf16_t*)((sl_) + vdstb + j_ * 128 + 8 * (vg4 ^ ((vs4 + (j_ >> 1)) & 15))) = (bf16_t)((j_ & 1) ? (w_ >> 16) : (w_ & 0xffffu)); } } while (0)
    u32x4 k0, v0, k1, v1, k2, v2;
    LOAD_ROW(0, k0, v0); k1 = k0; v1 = v0; k2 = k0; v2 = v0;
    __syncthreads();
    if (MODE == 0 && tid < 465) ((LAS float*)(lds + AUX_OFF + 2048))[tid] = A.na_rpb[(size_t)(l * 6 + h) * 465 + tid] * LOG2E;
    WRITE_ROW(lds, k0, v0);
    __syncthreads();
#define ATT_STEP(i_, kL, vL, kW, vW) do { const int i = (i_); if (i < nsteps) { \
        LAS const unsigned char* slot = lds + (i & 1) * 16384; \
        { const int ir_ = min(i + 1, nsteps - 1); LOAD_ROW(ir_, kL, vL); }     \
        bool use2 = false, use1 = false, um = false, um1 = false, ub = false; int c1 = 0, lo0 = 0, hi0 = 31, lo1 = 0, hi1 = 31, bidx = 0; \
        if (i < 4) use2 = true; \
        else if (MODE == 0) { const int a = wrow0 + i - 4; use1 = (a >= ra) && (a <= rb); const bool rowok = (a >= r0) && (a < r0 + 8); \
            c1 = cs; lo0 = rowok ? cmin : 1; hi0 = rowok ? cmin + 15 : 0; ub = true; um1 = true; bidx = (a - rq + 7) * 31 + (cs - jq + 15); } \
        else if (MODE == 1) { const int rel0 = (64 * (wrow0 + i - 4) - (32 * qg - 128)) >> 5, rel1 = rel0 + 1;     \
            const bool a0 = (rel0 >= 0) && (rel0 <= 8), a1 = (rel1 >= 0) && (rel1 <= 8); \
            if (a0 && a1) { use2 = true; um = (rel0 == 0) || (rel1 == 8); lo0 = rel0 == 0 ? r31 : 0; hi1 = rel1 == 8 ? r31 : 31; } \
            else if (a0) { use1 = true; um1 = (rel0 == 0) || (rel0 == 8); lo0 = rel0 == 0 ? r31 : 0; hi0 = rel0 == 8 ? r31 : 31; } \
            else if (a1) { use1 = true; c1 = 32; um1 = (rel1 == 0) || (rel1 == 8); lo0 = rel1 == 0 ? r31 : 0; hi0 = rel1 == 8 ? r31 : 31; } } \
        if (use2) attn_tile2(slot, bq, o0, o1, m_run, l_run, r31, hh, um, lo0, hi0, lo1, hi1); \
        if (use1) attn_tile(slot, c1, bq, o0, o1, m_run, l_run, r31, hh, um1, lo0, hi0, ub, btab, bidx); \
        if (i + 1 < nsteps) { LAS unsigned char* nslot = lds + ((i + 1) & 1) * 16384; WRITE_ROW(nslot, kW, vW); } \
        __syncthreads(); } } while (0)
#pragma unroll 1
    for (int i3 = 0; i3 < nsteps; ++i3) {
        ATT_STEP(i3, k1, v1, k1, v1);
    }
#undef ATT_STEP
#undef LOAD_ROW
#undef WRITE_ROW
    const float ltot = l_run + lane_xor(l_run, lane, 32);
    const float inv = 1.0f / ltot;
    const bf16_t* gp = PT + (size_t)qtok * NTM + gcol + 4 * hh;
    bf16_t* yp = Y + (size_t)qtok * DM + ycol + 4 * hh;
#pragma unroll
    for (int db = 0; db < 2; ++db)
#pragma unroll
        for (int g4 = 0; g4 < 4; ++g4) {
            const int d0 = 32 * db + 8 * g4;
            const u32x2 gw = *(const u32x2*)(gp + d0);
            float v0, v1, v2, v3;
            if (db == 0) { v0 = o0[4 * g4]; v1 = o0[4 * g4 + 1]; v2 = o0[4 * g4 + 2]; v3 = o0[4 * g4 + 3]; }
            else { v0 = o1[4 * g4]; v1 = o1[4 * g4 + 1]; v2 = o1[4 * g4 + 2]; v3 = o1[4 * g4 + 3]; }
            v0 *= inv * silu_f(bflo(gw.x)); v1 *= inv * silu_f(bfhi(gw.x)); v2 *= inv * silu_f(bflo(gw.y)); v3 *= inv * silu_f(bfhi(gw.y));
            u32x2 o; o.x = pk2(v0, v1); o.y = pk2(v2, v3);
            *(u32x2*)(yp + d0) = o;
        }
}

typedef float cf2 __attribute__((ext_vector_type(2)));
__device__ __forceinline__ cf2 mk2(float x, float y) { cf2 r; r.x = x; r.y = y; return r; }
__device__ __forceinline__ cf2 cmul(cf2 a, cf2 b) { const cf2 bs = mk2(-b.y, b.x); return a.xx * b + a.yy * bs; }
#define PA(e) ((e) + (((e) >> 4) << 1))
struct cf2x4 { cf2 a, b, c, d; };
__device__ __forceinline__ cf2x4 bfly4_fwd(cf2 x0, cf2 x1, cf2 x2, cf2 x3, float a) {
    const cf2 w1 = mk2(__builtin_amdgcn_cosf(a), -__builtin_amdgcn_sinf(a));
    const cf2 w2 = cmul(w1, w1), w3 = cmul(w2, w1);
    const cf2 s02 = x0 + x2, d02 = x0 - x2, s13 = x1 + x3, d13 = x1 - x3;
    cf2x4 r;
    r.a = s02 + s13;
    r.b = cmul(s02 - s13, w2);
    r.c = cmul(mk2(d02.x + d13.y, d02.y - d13.x), w1);
    r.d = cmul(mk2(d02.x - d13.y, d02.y + d13.x), w3);
    return r;
}
__device__ __forceinline__ cf2x4 bfly4_inv(cf2 v0, cf2 v1, cf2 v2, cf2 v3, float a) {
    const cf2 w1 = mk2(__builtin_amdgcn_cosf(a), __builtin_amdgcn_sinf(a));
    const cf2 w2 = cmul(w1, w1);
    const cf2 bb = cmul(v1, w2), dd = cmul(v3, w2);
    const cf2 u0 = v0 + bb, u1 = v0 - bb, u2 = v2 + dd, u3 = v2 - dd;
    const cf2 e = cmul(u2, w1), f0 = cmul(u3, w1);
    const cf2 f = mk2(-f0.y, f0.x);
    cf2x4 r; r.a = u0 + e; r.c = u0 - e; r.b = u1 + f; r.d = u1 - f; return r;
}
__device__ __forceinline__ void fft_fwd_fused(LAS cf2* buf, int tid, int lsb, bool zero_hi = false) {
    const int sB = 1 << lsb, s = 4 << lsb;
    const float ra = 1.0f / (float)(16 << lsb), rb = 1.0f / (float)(4 << lsb);
    int poff[4][4];
#pragma unroll
    for (int a = 0; a < 4; ++a)
#pragma unroll
        for (int b = 0; b < 4; ++b) { const int off = a * s + b * sB; poff[a][b] = PA(off); }
#pragma unroll 1
    for (int gg = 0; gg < 2; ++gg) {
        const int g = tid + 512 * gg, i = g & (sB - 1), base = ((g >> lsb) << (lsb + 4)) + i;
        const int pbase = PA(base);
        cf2 x[4][4];
#pragma unroll
        for (int a = 0; a < 4; ++a)
#pragma unroll
            for (int b = 0; b < 4; ++b) x[a][b] = (zero_hi && a >= 2) ? mk2(0.f, 0.f) : buf[pbase + poff[a][b]];
#pragma unroll
        for (int b = 0; b < 4; ++b) { const cf2x4 r = bfly4_fwd(x[0][b], x[1][b], x[2][b], x[3][b], (float)(i + b * sB) * ra); x[0][b] = r.a; x[1][b] = r.b; x[2][b] = r.c; x[3][b] = r.d; }
        const float ab = (float)i * rb;
#pragma unroll
        for (int a = 0; a < 4; ++a) { const cf2x4 r = bfly4_fwd(x[a][0], x[a][1], x[a][2], x[a][3], ab); x[a][0] = r.a; x[a][1] = r.b; x[a][2] = r.c; x[a][3] = r.d; }
#pragma unroll
        for (int a = 0; a < 4; ++a)
#pragma unroll
            for (int b = 0; b < 4; ++b) buf[pbase + poff[a][b]] = x[a][b];
    }
    __syncthreads();
}
__device__ __forceinline__ void fft_inv_fused(LAS cf2* buf, int tid, int lsb) {
    const int sB = 1 << lsb, s = 4 << lsb;
    const float ra = 1.0f / (float)(16 << lsb), rb = 1.0f / (float)(4 << lsb);
    int poff[4][4];
#pragma unroll
    for (int a = 0; a < 4; ++a)
#pragma unroll
        for (int b = 0; b < 4; ++b) { const int off = a * s + b * sB; poff[a][b] = PA(off); }
#pragma unroll 1
    for (int gg = 0; gg < 2; ++gg) {
        const int g = tid + 512 * gg, i = g & (sB - 1), base = ((g >> lsb) << (lsb + 4)) + i;
        const int pbase = PA(base);
        cf2 x[4][4];
#pragma unroll
        for (int a = 0; a < 4; ++a)
#pragma unroll
            for (int b = 0; b < 4; ++b) x[a][b] = buf[pbase + poff[a][b]];
        const float ab = (float)i * rb;
#pragma unroll
        for (int a = 0; a < 4; ++a) { const cf2x4 r = bfly4_inv(x[a][0], x[a][1], x[a][2], x[a][3], ab); x[a][0] = r.a; x[a][1] = r.b; x[a][2] = r.c; x[a][3] = r.d; }
#pragma unroll
        for (int b = 0; b < 4; ++b) { const cf2x4 r = bfly4_inv(x[0][b], x[1][b], x[2][b], x[3][b], (float)(i + b * sB) * ra); x[0][b] = r.a; x[1][b] = r.b; x[2][b] = r.c; x[3][b] = r.d; }
#pragma unroll
        for (int a = 0; a < 4; ++a)
#pragma unroll
            for (int b = 0; b < 4; ++b) buf[pbase + poff[a][b]] = x[a][b];
    }
    __syncthreads();
}
__device__ __forceinline__ void fft_fwd(LAS cf2* buf, int tid, const unsigned* zk = nullptr, bool zero_hi = false) {
#pragma unroll 1
    for (int lsb = 10; lsb >= 2; lsb -= 4) fft_fwd_fused(buf, tid, lsb, zero_hi && lsb == 10);
#pragma unroll 4
    for (int k = 0; k < 8; ++k) {
        const int e0 = 4 * (tid + 512 * k), base = PA(e0);
        cf2 x0 = buf[base], x1 = buf[base + 1], x2 = buf[base + 2], x3 = buf[base + 3];
        const cf2 s02 = x0 + x2, d02 = x0 - x2, s13 = x1 + x3, d13 = x1 - x3;
        cf2 y0 = s02 + s13, y1 = s02 - s13, y2 = mk2(d02.x + d13.y, d02.y - d13.x), y3 = mk2(d02.x - d13.y, d02.y + d13.x);
        if (zk) { const u32x4 w = *(const u32x4*)(zk + (unsigned)e0);
            y0 = cmul(y0, mk2(bflo(w.x), bfhi(w.x))); y1 = cmul(y1, mk2(bflo(w.y), bfhi(w.y))); y2 = cmul(y2, mk2(bflo(w.z), bfhi(w.z))); y3 = cmul(y3, mk2(bflo(w.w), bfhi(w.w))); }
        buf[base] = y0; buf[base + 1] = y1; buf[base + 2] = y2; buf[base + 3] = y3;
    }
    __syncthreads();
}
__device__ __forceinline__ void fft_inv(LAS cf2* buf, int tid) {
#pragma unroll 1
    for (int lsb = 0; lsb <= 8; lsb += 4) fft_inv_fused(buf, tid, lsb);
#pragma unroll 4
    for (int k = 0; k < 8; ++k) {
        const int i = tid + 512 * k, pi = PA(tid) + 576 * k;
        cf2 v0 = buf[pi], v1 = buf[pi + 4608], v2 = buf[pi + 9216], v3 = buf[pi + 13824];
        const cf2x4 r = bfly4_inv(v0, v1, v2, v3, (float)i * (1.0f / 16384.0f));
        buf[pi] = r.a; buf[pi + 4608] = r.b;
    }
    __syncthreads();
}
__device__ __forceinline__ float hy_short(const bf16_t* prow, int tb, int t, int L, float w0, float w1, float w2, float bias) {
    const float pm = t > 0 ? bf2f(prow[tb + t - 1]) : 0.f;
    const float pc = bf2f(prow[tb + t]);
    const float pp = t < L - 1 ? bf2f(prow[tb + t + 1]) : 0.f;
    return w0 * pm + w1 * pc + w2 * pp + bias;
}
__device__ __forceinline__ float block_sum(float v, LAS float* red, int tid) {
    v = wave_sum(v, tid & 63);
    __syncthreads();
    if ((tid & 63) == 0) red[tid >> 6] = v;
    __syncthreads();
    float s = 0.f;
#pragma unroll
    for (int w = 0; w < 8; ++w) s += red[w];
    return s;
}

__device__ __forceinline__ void hyena_block(CKArgs& A, int l, int c, LAS unsigned char* lds, int tid) {
    asm volatile("" : "+v"(tid));
    unsigned char* ws = A.ws;
    LAS cf2* buf = (LAS cf2*)lds;
    LAS float* fs = (LAS float*)lds;
    LAS float* aux = (LAS float*)(lds + AUX_OFF);
    LAS float* red = aux + 256;
    const bf16_t* PCT = (const bf16_t*)(ws + WS_PCT);
    bf16_t* YBT = (bf16_t*)(ws + WS_YBT);
    const bf16_t* rowz = PCT + (size_t)(R_HZ + c) * MTOT;
    const bf16_t* rowx1 = rowz + (size_t)256 * MTOT;
    const bf16_t* rowx2 = rowz + (size_t)512 * MTOT;
    const bf16_t* rowg = PCT + (size_t)(R_GB + c) * MTOT;
    const float* cw = A.hy_conv_w + (size_t)l * 3 * 768; const float* cb = A.hy_conv_b + (size_t)l * 768;
    const float wz0 = cw[c], wz1 = cw[768 + c], wz2 = cw[1536 + c], bz = cb[c];
    const float wa0 = cw[256 + c], wa1 = cw[768 + 256 + c], wa2 = cw[1536 + 256 + c], ba = cb[256 + c];
    const float wb0 = cw[512 + c], wb1 = cw[768 + 512 + c], wb2 = cw[1536 + 512 + c], bb = cb[512 + c];
    const float d0 = A.hy_d[(l * 2 + 0) * 256 + c], d1 = A.hy_d[(l * 2 + 1) * 256 + c];
    const float dmin = -3.0701134573253945f, dmax = -15.350567286626973f;
    const float delta = fabsf(dmin + (float)c * ((dmax - dmin) / 255.0f));
    __syncthreads();
    if (tid < 256) { const int k = tid >> 6, j = tid & 63; aux[tid] = A.hy_w3[((size_t)l * 64 + j) * 1024 + k * 256 + c]; }
    __syncthreads();

    if (l < DEPTH - 1) {
        float ss0 = 0.f, ss1 = 0.f;
        if (tid < 256) {
            const int n = tid; const f32x4* hr = (const f32x4*)((const float*)(ws + WS_H2C) + ((size_t)l * CTXL + n) * 64);
            float f0 = 0.f, f1 = 0.f, b0 = 0.f, b1 = 0.f;
#pragma unroll 1
            for (int j4 = 0; j4 < 16; ++j4) { const f32x4 hv = hr[j4];
#pragma unroll
                for (int e = 0; e < 4; ++e) { const float hvv = hv[e]; const int j = 4 * j4 + e; f0 += hvv * aux[j]; f1 += hvv * aux[64 + j]; b0 += hvv * aux[128 + j]; b1 += hvv * aux[192 + j]; } }
            const float e = __expf(-((float)n * (1.0f / 255.0f)) * delta);
            f0 *= e; f1 *= e; b0 *= e; b1 *= e;
            fs[255 + n] = f0; fs[512 + 255 + n] = f1;
            if (n >= 1) { fs[255 - n] = b0; fs[512 + 255 - n] = b1; }
            ss0 = f0 * f0 + (n >= 1 ? b0 * b0 : 0.f); ss1 = f1 * f1 + (n >= 1 ? b1 * b1 : 0.f);
        }
        if (tid == 0) { fs[511] = 0.f; fs[1023] = 0.f; }
        const int b = tid >> 8, t = tid & 255, tok = MLAT + b * CTXL;
        const float z = hy_short(rowz, tok, t, CTXL, wz0, wz1, wz2, bz);
        const float x1 = hy_short(rowx1, tok, t, CTXL, wa0, wa1, wa2, ba);
        const float x2 = hy_short(rowx2, tok, t, CTXL, wb0, wb1, wb2, bb);
        const float gb = bf2f(rowg[tok + t]);
        fs[1024 + tid] = z;
        const float n0 = rsqrtf(block_sum(ss0, red, tid) + 1e-6f);
        const float n1 = rsqrtf(block_sum(ss1, red, tid) + 1e-6f);
        __syncthreads();
        float y = 0.f;
        { LAS const float* kc = fs + 255 + t; LAS const float* zz = fs + 1024 + b * 256;
#pragma unroll 8
          for (int s = 0; s < 256; ++s) y += zz[s] * kc[-s]; }
        const float z1 = x1 * (y * n0 + d0 * z);
        fs[1536 + tid] = z1;
        __syncthreads();
        float y2 = 0.f;
        { LAS const float* kc = fs + 512 + 255 + t; LAS const float* zz = fs + 1536 + b * 256;
#pragma unroll 8
          for (int s = 0; s < 256; ++s) y2 += zz[s] * kc[-s]; }
        const float o = x2 * (y2 * n1 + d1 * z1) * silu_f(gb);
        YBT[(size_t)c * MTOT + tok + t] = (bf16_t)(pk2(o, 0.f) & 0xffffu);
        __syncthreads();
    }

    unsigned* ZK = (unsigned*)(ws + WS_ZS) + (size_t)c * 2 * NFFT;
    const int lane = tid & 63;
    {
        float ss0 = 0.f, ss1 = 0.f;
        const bf16_t* F0 = (const bf16_t*)(ws + WS_FILT) + (size_t)c * SEQ;
#pragma unroll 4
        for (int k = 0; k < 16; ++k) {
            const int n = tid + 512 * k;
            const float e = __expf(-((float)n * (1.0f / 8191.0f)) * delta);
            const float f0 = bf2f(F0[n]) * e, f1 = bf2f(F0[(size_t)256 * SEQ + n]) * e, b0 = bf2f(F0[(size_t)512 * SEQ + n]) * e, b1 = bf2f(F0[(size_t)768 * SEQ + n]) * e;
            buf[PA(n)] = mk2(f0, f1); ss0 += f0 * f0; ss1 += f1 * f1;
            if (n >= 1) { buf[PA(NFFT - n)] = mk2(b0, b1); ss0 += b0 * b0; ss1 += b1 * b1; }
        }
        if (tid == 0) { const float zf = delta * 0.0f; buf[PA(SEQ)] = mk2(zf, zf); }
        const float nrm0 = rsqrtf(block_sum(ss0, red, tid) + 1e-6f) * (0.5f / NFFT);
        const float nrm1 = rsqrtf(block_sum(ss1, red, tid) + 1e-6f) * (0.5f / NFFT);
        __syncthreads();
        fft_fwd(buf, tid);
#pragma unroll 4
        for (int k = 0; k < 32; ++k) {
            const int p = tid + 512 * k; const int f = (int)(__brev((unsigned)p) >> 18); const int pp = (int)(__brev((unsigned)((NFFT - f) & (NFFT - 1))) >> 18);
            const cf2 za = buf[PA(p)], zb = buf[PA(pp)];
            ZK[p] = pk2((za.x + zb.x) * nrm0 + d0 * (1.0f / NFFT), (za.y - zb.y) * nrm0);
            ZK[NFFT + p] = pk2((za.y + zb.y) * nrm1 + d1 * (1.0f / NFFT), -(za.x - zb.x) * nrm1);
        }
        __syncthreads();
    }
    const int wv = __builtin_amdgcn_readfirstlane(tid >> 6), tw0 = wv * 1024 + lane, ptw = PA(tw0), ptid = PA(tid);
#define HY_ROW8(prow_, tb_, kb_, w0_, w1_, w2_, bias_, u_) do { \
        float own_[8]; const int p0_ = wv * 1024 + 64 * (kb_); \
        _Pragma("unroll") for (int k = 0; k < 8; ++k) own_[k] = bf2f((prow_)[(unsigned)((tb_) + p0_ + lane + 64 * k)]); \
        const float ep_ = p0_ > 0 ? bf2f((prow_)[(unsigned)((tb_) + p0_ - 1)]) : 0.f, en_ = p0_ + 512 < SEQ ? bf2f((prow_)[(unsigned)((tb_) + p0_ + 512)]) : 0.f; \
        _Pragma("unroll") for (int k = 0; k < 8; ++k) { const float a_ = lane_prev(own_[k], lane), b_ = lane_next(own_[k], lane); \
            const float pl_ = k > 0 ? rdlane(own_[k > 0 ? k - 1 : 0], 63) : ep_, nl_ = k < 7 ? rdlane(own_[k < 7 ? k + 1 : 7], 0) : en_; \
            const float m_ = lane == 0 ? pl_ : a_, q_ = lane == 63 ? nl_ : b_; (u_)[(kb_) + k] = (w0_) * m_ + (w1_) * own_[k] + (w2_) * q_ + (bias_); } \
        asm volatile("" ::: "memory"); __builtin_amdgcn_sched_barrier(0); } while (0)
#pragma unroll
    for (int hf = 0; hf < 2; ++hf) {
        float ua[16], ub[16];
        HY_ROW8(rowz, 0, 8 * hf, wz0, wz1, wz2, bz, ua);
        HY_ROW8(rowz, SEQ, 8 * hf, wz0, wz1, wz2, bz, ub);
#pragma unroll
        for (int k = 8 * hf; k < 8 * hf + 8; ++k) { const int t = tw0 + 64 * k; buf[ptw + 72 * k] = mk2(ua[k], ub[k]); }
        __builtin_amdgcn_sched_barrier(0);
    }
    __syncthreads();
    fft_fwd(buf, tid, ZK, true);
    fft_inv(buf, tid);
#pragma unroll
    for (int hf = 0; hf < 2; ++hf) {
        float xa[16], xb[16];
        HY_ROW8(rowx1, 0, 8 * hf, wa0, wa1, wa2, ba, xa);
        HY_ROW8(rowx1, SEQ, 8 * hf, wa0, wa1, wa2, ba, xb);
#pragma unroll
        for (int k = 8 * hf; k < 8 * hf + 8; ++k) { const int t = tw0 + 64 * k; const cf2 y = buf[ptw + 72 * k]; buf[ptw + 72 * k] = mk2(xa[k] * y.x, xb[k] * y.y); }
        __builtin_amdgcn_sched_barrier(0);
    }
    __syncthreads();
    fft_fwd(buf, tid, ZK + NFFT, true);
    fft_inv(buf, tid);
    {
        bf16_t* yrow = YBT + (size_t)c * MTOT;
#pragma unroll
        for (int hf = 0; hf < 2; ++hf) {
            float xa[16], xb[16], ga[8], gb[8];
#pragma unroll
            for (int k = 0; k < 8; ++k) { ga[k] = bf2f(rowg[(unsigned)(tw0 + 64 * (8 * hf + k))]); gb[k] = bf2f(rowg[(unsigned)(SEQ + tw0 + 64 * (8 * hf + k))]); }
            HY_ROW8(rowx2, 0, 8 * hf, wb0, wb1, wb2, bb, xa);
            HY_ROW8(rowx2, SEQ, 8 * hf, wb0, wb1, wb2, bb, xb);
#pragma unroll
            for (int k = 8 * hf; k < 8 * hf + 8; ++k) { const int t = tw0 + 64 * k; const cf2 y = buf[ptw + 72 * k];
                const float oa = xa[k] * y.x * silu_f(ga[k - 8 * hf]), ob = xb[k] * y.y * silu_f(gb[k - 8 * hf]);
                yrow[(unsigned)t] = (bf16_t)(pk2(oa, 0.f) & 0xffffu); yrow[(unsigned)(SEQ + t)] = (bf16_t)(pk2(ob, 0.f) & 0xffffu); }
            __builtin_amdgcn_sched_barrier(0);
        }
    }
#undef HY_ROW8
    __syncthreads();
}

__device__ __forceinline__ void phase_mix(CKArgs& A, int l, LAS unsigned char* lds, int bid, int nblk, int tid) {
    for (int c = bid; c < 256; c += nblk) hyena_block(A, l, c, lds, tid);
    const int nctx = (l < DEPTH - 1) ? 12 : 0;
    const int nitems = 768 + 2 * nctx;
#pragma unroll 1
    for (int it = bid; it < nitems; it += nblk) {
        int mode, item;
        if (it < 384) { mode = 0; item = it; } else if (it < 768) { mode = 1; item = it - 384; } else if (it < 768 + nctx) { mode = 2; item = it - 768; } else { mode = 3; item = it - 768 - nctx; }
        attn_block_item(A, l, mode, item, lds, tid);
    }
}

__device__ __forceinline__ void phase_tr(CKArgs& A, int l, LAS unsigned char* lds, int bid, int nblk, int tid) {
    const int wave = __builtin_amdgcn_readfirstlane(tid >> 6), lane = tid & 63;
    const int gw = bid * 8 + wave, NGW = nblk * 8;
    unsigned char* ws = A.ws;
    const bf16_t* YBT = (const bf16_t*)(ws + WS_YBT);
    bf16_t* Y = (bf16_t*)(ws + WS_HY);
    LAS bf16_t* scr = (LAS bf16_t*)(lds + wave * 16384);
    const int ntok = (l < DEPTH - 1) ? MTOT : MLAT;
    const int nitems = (ntok / 64) * 4;
#pragma unroll 1
    for (int it = gw; it < nitems; it += NGW) {
        const int tb = (it >> 2) * 64, cb = (it & 3) * 64;
#pragma unroll 8
        for (int i = 0; i < 64; ++i) scr[i * 66 + lane] = YBT[(size_t)(cb + i) * MTOT + tb + lane];
        asm volatile("s_waitcnt lgkmcnt(0)" ::: "memory");
        const int cc = (lane & 7) * 8;
#pragma unroll
        for (int k = 0; k < 8; ++k) {
            const int tq = (lane >> 3) + 8 * k;
            u32x4 o;
            o.x = (unsigned)scr[(cc + 0) * 66 + tq] | ((unsigned)scr[(cc + 1) * 66 + tq] << 16);
            o.y = (unsigned)scr[(cc + 2) * 66 + tq] | ((unsigned)scr[(cc + 3) * 66 + tq] << 16);
            o.z = (unsigned)scr[(cc + 4) * 66 + tq] | ((unsigned)scr[(cc + 5) * 66 + tq] << 16);
            o.w = (unsigned)scr[(cc + 6) * 66 + tq] | ((unsigned)scr[(cc + 7) * 66 + tq] << 16);
            *(u32x4*)(Y + (size_t)(tb + tq) * DM + 384 + cb + cc) = o;
        }
        asm volatile("s_waitcnt lgkmcnt(0)" ::: "memory");
    }
}

__device__ __forceinline__ void phase_final(CKArgs& A, int bid, int nblk, int tid) {
    const int wave = __builtin_amdgcn_readfirstlane(tid >> 6), lane = tid & 63;
    const int gw = bid * 8 + wave, NGW = nblk * 8;
    for (int m = gw; m < MLAT; m += NGW) {
        float* row = A.out + (size_t)m * DM;
        f32x4 xv[4]; float ss = 0.f;
#pragma unroll
        for (int j = 0; j < 4; ++j) { xv[j] = *(const f32x4*)(row + 4 * lane + 256 * j); ss += (xv[j].x * xv[j].x + xv[j].y * xv[j].y) + (xv[j].z * xv[j].z + xv[j].w * xv[j].w); }
        const float rinv = rsqrtf(wave_sum(ss, lane) * (1.0f / DM) + 1e-6f);
#pragma unroll
        for (int j = 0; j < 4; ++j) { const int col = 4 * lane + 256 * j; const f32x4 gv = *(const f32x4*)(A.final_g + col); *(f32x4*)(row + col) = xv[j] * rinv * gv; }
    }
}

#define XB_TMO      128
#define XB_XCNT(j)  (256  + 64 * (j))
#define XB_XSUB(j)  (1280 + 64 * (j))
#define XB_XGEN(j)  (2304 + 64 * (j))
#define XB_TOP      3328
#define XB_TOPGEN   3392
#define XCD_BAR_WORDS 3456
#define XB_SPIN_CAP (1u << 18)

__device__ __forceinline__ unsigned xb_ld(unsigned* p)              { return __hip_atomic_load(p, __ATOMIC_RELAXED, __HIP_MEMORY_SCOPE_AGENT); }
__device__ __forceinline__ unsigned xb_add(unsigned* p, unsigned v) { return __hip_atomic_fetch_add(p, v, __ATOMIC_RELAXED, __HIP_MEMORY_SCOPE_AGENT); }
__device__ __forceinline__ unsigned xb_xcc_id() { return (unsigned)__builtin_amdgcn_s_getreg((3 << 11) | 20) & 0xFu; }
#define XB_SPIN(cond, bar) do { unsigned _sp = 0; while (cond) { __builtin_amdgcn_s_sleep(1); \
    if ((++_sp & 255u) == 0u) { if (xb_ld(&(bar)[XB_TMO])) break; if (_sp > XB_SPIN_CAP) { atomicAdd(&(bar)[XB_TMO], 1u); break; } } } } while (0)

struct XcdBarrier {
    unsigned* bar; unsigned x;
    volatile LAS unsigned* st;
};

__device__ __forceinline__ XcdBarrier xcd_barrier_post(unsigned* bar, volatile LAS unsigned* st) {
    XcdBarrier b; b.bar = bar; b.x = xb_xcc_id(); b.st = st;
    if (threadIdx.x == 0) (void)xb_add(&bar[XB_XCNT(b.x)], 1u);
    return b;
}
__device__ __forceinline__ void xcd_barrier_complete(unsigned* bar, unsigned x, unsigned& nloc, unsigned& nx) {
    const unsigned G = gridDim.x * gridDim.y * gridDim.z;
    unsigned sum, cnt, mine, sp = 0u;
    for (;;) {
        sum = 0u; cnt = 0u; mine = 0u;
#pragma unroll
        for (unsigned j = 0; j < 16; ++j) { const unsigned c = xb_ld(&bar[XB_XCNT(j)]); sum += c; cnt += (c > 0u) ? 1u : 0u; mine = (j == x) ? c : mine; }
        if (sum == G) break;
        __builtin_amdgcn_s_sleep(1);
        if ((++sp & 255u) == 0u) { if (xb_ld(&bar[XB_TMO])) break; if (sp > XB_SPIN_CAP) { atomicAdd(&bar[XB_TMO], 1u); break; } }
    }
    nloc = mine > 0u ? mine : 1u; nx = cnt > 0u ? cnt : 1u;
}

__device__ __forceinline__ void xcd_barrier(const XcdBarrier& b) {
    asm volatile("s_waitcnt vmcnt(0)" ::: "memory");
    __syncthreads();
    if (threadIdx.x == 0) {
        unsigned* bar = b.bar;
        __builtin_amdgcn_s_waitcnt(0);
        unsigned nloc = b.st[0], nx = b.st[1];
        if (nloc == 0u) { xcd_barrier_complete(bar, b.x, nloc, nx); b.st[0] = nloc; b.st[1] = nx; }
        const unsigned old = xb_add(&bar[XB_XSUB(b.x)], 1u);
        const unsigned gen = old / nloc;
        if (old + 1u == (gen + 1u) * nloc) {
            __builtin_amdgcn_fence(__ATOMIC_RELEASE, "agent");
            asm volatile("s_waitcnt vmcnt(0)" ::: "memory");
            const unsigned og = xb_add(&bar[XB_TOP], 1u);
            const unsigned tg = og / nx;
            if (og + 1u == (tg + 1u) * nx) xb_add(&bar[XB_TOPGEN], 1u);
            else XB_SPIN(xb_ld(&bar[XB_TOPGEN]) == tg, bar);
            __builtin_amdgcn_fence(__ATOMIC_ACQUIRE, "agent");
            xb_add(&bar[XB_XGEN(b.x)], 1u);
            asm volatile("s_waitcnt vmcnt(0)" ::: "memory");
        } else {
            XB_SPIN(xb_ld(&bar[XB_XGEN(b.x)]) == gen, bar);
            __builtin_amdgcn_fence(__ATOMIC_ACQUIRE, "agent");
            asm volatile("s_waitcnt vmcnt(0)" ::: "memory");
        }
    }
    __syncthreads();
}


constexpr int NPHASE = 2 + 5 * DEPTH;
__global__ void __launch_bounds__(NTHREADS, 2) hybrid_fwd(KArgs Aval) {
    extern __shared__ __attribute__((aligned(16))) unsigned char lds_raw[];
    LAS unsigned char* lds = (LAS unsigned char*)lds_raw;
    const int tid0 = threadIdx.x, bid = blockIdx.x, nblk = gridDim.x;
#if !MK_MULTI
    volatile LAS unsigned* bst = (volatile LAS unsigned*)(lds + AUX_OFF + 8192);
    if (tid0 < 2) bst[tid0] = 0u;
    __syncthreads();
    const XcdBarrier bar = xcd_barrier_post((unsigned*)Aval.ws, bst);
#endif
#ifndef REP_PH
#define REP_PH 1000
#endif
#pragma unroll 1
    for (int pi = Aval.ph_lo; pi < Aval.ph_hi + (REP_PH < 1000 ? 1 : 0); ++pi) {
        const int ph = pi <= REP_PH ? pi : pi - 1;
#if !MK_MULTI
        if (pi > Aval.ph_lo) { if (Aval.ph_hi > 100000) cg::this_grid().sync(); else xcd_barrier(bar); }
#endif
#ifndef ONLY
#define ONLY -1
#endif
#define EN(k) (ONLY < 0 || ((ONLY >> (k)) & 1))
        int tid = tid0; asm volatile("" : "+v"(tid));
        CKArgs* Ap = (CKArgs*)__builtin_amdgcn_kernarg_segment_ptr(); asm volatile("" : "+s"(Ap));
        CKArgs& A = *Ap;
        unsigned char* ws = A.ws;
        if (ph == 0) { if (EN(0)) phase_prologue(A, lds, bid, nblk, tid); }
        else if (ph == NPHASE - 1) { if (EN(6)) phase_final(A, bid, nblk, tid); }
        else {
            const int l = (ph - 1) / 5, k = (ph - 1) % 5;
            if (k == 0) { if (EN(1)) phase_norm(A, l, bid, nblk, tid); }
            else if (k == 2) { if (EN(3)) phase_mix(A, l, lds, bid, nblk, tid); }
            else if (k == 3) { if (EN(4)) phase_tr(A, l, lds, bid, nblk, tid); }
            if (k == 1 || k == 4) {
                pg8::Gemm g; EpiAll E; E.l = l; E.Ap = Ap; g.A = (const bf16_t*)(ws + WS_HY); g.K = DM;
                if (k == 1) { g.Bt = (const bf16_t*)(ws + WS_WIN) + (size_t)l * NIN * DM; g.M = MTOT; g.N = NIN; E.mode = 0; }
                else { g.Bt = (const bf16_t*)(ws + WS_WOUT) + (size_t)l * DM * DM; g.M = MLAT; g.N = DM; E.mode = 1; }
                pg8::StaticOrder S; S.init(g.M, g.N, nblk, bid);
                if (EN(2)) pg8::gemm_phase<EpiAll, pg8::StaticOrder, true, true>(lds, g, S, E, tid);
                if (k == 4 && l < DEPTH - 1) { ctx_outproj_items(A, l, tid, bid, nblk); filt_items(A, l + 1, tid, bid, nblk, nullptr); }
            }
        }
    }
}

extern "C" void kernel_launch(void* const* d_in, const int* in_sizes, int n_in, void* d_out, int out_size, void* d_ws, size_t ws_size, hipStream_t stream) {
    static int grid = 0;
    if (grid == 0) {
        if (n_in != 22 || ws_size < WS_END) { fprintf(stderr, "kernel_launch: unexpected inputs (n_in %d, ws %zu)\n", n_in, ws_size); grid = -1; return; }
        int dev = 0, cus = 0, per_cu = 0;
        if (hipGetDevice(&dev) != hipSuccess || hipDeviceGetAttribute(&cus, hipDeviceAttributeMultiprocessorCount, dev) != hipSuccess) { grid = -1; return; }
        if (hipFuncSetAttribute((const void*)hybrid_fwd, hipFuncAttributeMaxDynamicSharedMemorySize, LDS_BYTES) != hipSuccess) { fprintf(stderr, "kernel_launch: hipFuncSetAttribute failed\n"); grid = -1; return; }
        if (hipOccupancyMaxActiveBlocksPerMultiprocessor(&per_cu, (const void*)hybrid_fwd, NTHREADS, LDS_BYTES) != hipSuccess || per_cu < 1) { fprintf(stderr, "kernel_launch: occupancy query says %d\n", per_cu); per_cu = 1; }
        (void)hipGetLastError();
        grid = cus;
    }
    if (grid < 0) return;
    KArgs a{};
    a.x = (const float*)d_in[0]; a.c = (const float*)d_in[1]; a.ctx = (const float*)d_in[2]; a.c_ctx = (const float*)d_in[3]; a.norm_g = (const float*)d_in[4];
    a.w_ada = (const float*)d_in[5]; a.b_ada = (const float*)d_in[6]; a.w_in = (const float*)d_in[7]; a.w_out = (const float*)d_in[8]; a.na_rpb = (const float*)d_in[9];
    a.hy_conv_w = (const float*)d_in[10]; a.hy_conv_b = (const float*)d_in[11]; a.hy_w1 = (const float*)d_in[12]; a.hy_b1 = (const float*)d_in[13]; a.hy_freq1 = (const float*)d_in[14];
    a.hy_w2 = (const float*)d_in[15]; a.hy_b2 = (const float*)d_in[16]; a.hy_freq2 = (const float*)d_in[17]; a.hy_w3 = (const float*)d_in[18]; a.hy_d = (const float*)d_in[19];
    a.sink = (const float*)d_in[20]; a.final_g = (const float*)d_in[21];
    a.out = (float*)d_out; a.ws = (unsigned char*)d_ws;
#if MK_MULTI
    for (int ph = 0; ph < NPHASE; ++ph) {
        a.ph_lo = ph; a.ph_hi = ph + 1;
        hipLaunchKernelGGL(hybrid_fwd, dim3(grid), dim3(NTHREADS), LDS_BYTES, stream, a);
    }
#else
    if (hipMemsetAsync(d_ws, 0, 16384, stream) != hipSuccess) { fprintf(stderr, "kernel_launch: memset of the barrier words failed\n"); return; }
    a.ph_lo = 0; a.ph_hi = NPHASE;
    void* args[] = {&a};
    hipError_t e = hipLaunchCooperativeKernel((const void*)hybrid_fwd, dim3(grid), dim3(NTHREADS), args, LDS_BYTES, stream);
    if (e != hipSuccess) fprintf(stderr, "cooperative launch failed: %s (grid %d)\n", hipGetErrorString(e), grid);
#endif
}
```

```cpp
#include <hip/hip_runtime.h>
#include <hip/hip_cooperative_groups.h>
#include <cstdio>
#include <cstdint>
namespace cg = cooperative_groups;

#ifndef MK_MULTI
#define MK_MULTI 0
#endif

namespace pg8 {
#define PG8_LAS __attribute__((address_space(3)))
typedef unsigned short bf16_t;
typedef short bf16x8 __attribute__((ext_vector_type(8)));
typedef float f32x4 __attribute__((ext_vector_type(4)));
typedef unsigned u32x4 __attribute__((ext_vector_type(4)));
constexpr int BM = 256, BK = 64, HALF = 128, HTB = HALF * BK * 2  , STAGE_BYTES = 8 * HTB, NXCD = 8, WGM = 8;

__host__ __device__ __forceinline__ int lds_byte(int r, int c) { const int st = (r >> 4) * 2 + (c >> 5), rr = r & 15, cc = c & 31, ob = rr * 64 + cc * 2; return st * 1024 + (ob ^ (((ob >> 9) & 1) << 5)); }
__host__ __device__ __forceinline__ void stage_rc(int b, int& R, int& C) { const int st = b / 1024, sb = b % 1024, swz = sb ^ (((sb >> 9) & 1) << 5); R = (st >> 1) * 16 + swz / 64; C = (st & 1) * 32 + (swz % 64) / 2; }
__host__ __device__ __forceinline__ int perm32(int rho) { const int n = rho >> 4, i = rho & 15; return 8 * (i >> 2) + 4 * n + (i & 3); }

struct Unit { int pm, pn; };
struct Gemm { const bf16_t* A; const bf16_t* Bt; int M, N, K; };

struct StaticOrder {
    int nM, nN, nwg, G, c;
    __host__ __device__ void init(int M, int N, int G_, int c_) { nM = M / BM; nN = N / BM; nwg = nM * nN; G = G_; c = c_; }
    __host__ __device__ bool next(int i, Unit& u) const {
        const long L = (long)i * G + c; if (L >= nwg) return false;
        int wgid = (int)L; { const int q = nwg / NXCD, r = nwg % NXCD, xcd = wgid % NXCD, off = wgid / NXCD; wgid = (xcd < r ? xcd * (q + 1) : r * (q + 1) + (xcd - r) * q) + off; }
        const int nig = WGM * nN, gid = wgid / nig, fm = gid * WGM, gsz = (nM - fm) < WGM ? (nM - fm) : WGM;
        u.pm = fm + ((wgid % nig) % gsz); u.pn = (wgid % nig) / gsz; return true;
    }
    __device__ __forceinline__ void a_ready(const Unit&) const {}
    __device__ __forceinline__ void done(const Unit&) const {}
};

template <class Epi, class Sched, bool ALIGN_EPI = false, bool SP2 = false>
__device__ __forceinline__ void gemm_phase(PG8_LAS unsigned char* lds, const Gemm g, const Sched& S, const Epi& E, const int tid) {
    const int wid = __builtin_amdgcn_readfirstlane(tid >> 6), lane = tid & 63, wr = wid >> 2, wc = wid & 3, fr = lane & 15, fq = lane >> 4;
    const int K = g.K, nt = K / BK;
    unsigned voffA[2], voffB[2];
#pragma unroll
    for (int i = 0; i < 2; ++i) { int R, C; stage_rc(tid * 16 + i * 8192, R, C); const int Rb = Epi::PERM ? ((R & ~31) + perm32(R & 31)) : R;
        voffA[i] = (unsigned)(R * K + C) * 2u; voffB[i] = (unsigned)(Rb * K + C) * 2u; }
    const size_t kstep = (size_t)(BK * 2);
    const size_t hstep = (size_t)HALF * K * 2;
    const size_t tstep = 2 * hstep;
    const unsigned ldsw = (unsigned)wid * 1024u;
    const int aoff = lds_byte(wr * 64 + fr, fq * 8), boff = lds_byte(wc * 32 + fr, fq * 8);
#define PG8_SA(b, h) (((b) * 2 + (h)) * HTB)
#define PG8_SB(b, h) ((4 + (b) * 2 + (h)) * HTB)
#define PG8_STAGE(bufoff, gbase, voff) do { _Pragma("unroll") for (int _i = 0; _i < 2; ++_i) \
        __builtin_amdgcn_global_load_lds((const unsigned*)((const char*)(gbase) + (voff)[_i]), (PG8_LAS unsigned*)(lds + (bufoff) + ldsw + _i * 8192), 16, 0, 0); } while (0)
#define PG8_LDA(dst, b, h) do { _Pragma("unroll") for (int m = 0; m < 4; ++m) _Pragma("unroll") for (int k = 0; k < 2; ++k) dst[m][k] = *(const PG8_LAS bf16x8*)(lds + PG8_SA(b, h) + aoff + m * 2048 + k * 1024); } while (0)
#define PG8_LDB(dst, b, h) do { _Pragma("unroll") for (int n = 0; n < 2; ++n) _Pragma("unroll") for (int k = 0; k < 2; ++k) dst[n][k] = *(const PG8_LAS bf16x8*)(lds + PG8_SB(b, h) + boff + n * 2048 + k * 1024); } while (0)
#define PG8_MMA(ai, bj, At, Bt) do { __builtin_amdgcn_s_setprio(1); _Pragma("unroll") for (int m = 0; m < 4; ++m) _Pragma("unroll") for (int n = 0; n < 2; ++n) _Pragma("unroll") for (int k = 0; k < 2; ++k) \
        acc[ai][bj][m][n] = __builtin_amdgcn_mfma_f32_16x16x32_bf16(Bt[n][k], At[m][k], acc[ai][bj][m][n], 0, 0, 0); __builtin_amdgcn_s_setprio(0); } while (0)
#define PG8_WAIT_V(n) asm volatile("s_waitcnt vmcnt(" #n ")" ::: "memory")
#define PG8_WAIT_L(n) asm volatile("s_waitcnt lgkmcnt(" #n ")" ::: "memory")
#define PG8_BAR __builtin_amdgcn_s_barrier()
#define PG8_SCHED __builtin_amdgcn_sched_barrier(0)
    Unit cur, nxt; int ui = 0;
    if (!S.next(0, cur)) return;
    f32x4 acc[2][2][4][2];
#pragma unroll
    for (int a = 0; a < 2; ++a)
#pragma unroll
        for (int b = 0; b < 2; ++b)
#pragma unroll
            for (int m = 0; m < 4; ++m)
#pragma unroll
                for (int n = 0; n < 2; ++n) acc[a][b][m][n] = (f32x4){0.f, 0.f, 0.f, 0.f};
    bf16x8 At[4][2], B0[2][2], B1[2][2];
    const char* cA = (const char*)g.A + (size_t)cur.pm * tstep; const char* cB = (const char*)g.Bt + (size_t)cur.pn * tstep;
    S.a_ready(cur);
    if constexpr (SP2) {
        PG8_STAGE(PG8_SB(0, 0), cB, voffB); PG8_STAGE(PG8_SB(0, 1), cB + hstep, voffB); PG8_STAGE(PG8_SA(0, 0), cA, voffA); PG8_STAGE(PG8_SA(0, 1), cA + hstep, voffA);
        if (wr == 1) PG8_BAR;
        PG8_WAIT_V(2); PG8_BAR;
        PG8_STAGE(PG8_SB(1, 0), cB + kstep, voffB); PG8_STAGE(PG8_SA(1, 0), cA + kstep, voffA); PG8_STAGE(PG8_SB(1, 1), cB + hstep + kstep, voffB);
        PG8_WAIT_V(6); PG8_BAR;
    } else {
        PG8_STAGE(PG8_SB(0, 0), cB, voffB); PG8_STAGE(PG8_SA(0, 0), cA, voffA); PG8_STAGE(PG8_SB(0, 1), cB + hstep, voffB); PG8_STAGE(PG8_SA(0, 1), cA + hstep, voffA);
        if (wr == 1) PG8_BAR;
        PG8_WAIT_V(4); PG8_BAR;
        PG8_STAGE(PG8_SB(1, 0), cB + kstep, voffB); PG8_STAGE(PG8_SA(1, 0), cA + kstep, voffA); PG8_STAGE(PG8_SB(1, 1), cB + hstep + kstep, voffB);
        PG8_WAIT_V(6); PG8_BAR;
    }
    for (;;) {
        const bool has_next = S.next(ui + 1, nxt);
        const char* nA = has_next ? (const char*)g.A + (size_t)nxt.pm * tstep : cA; const char* nB = has_next ? (const char*)g.Bt + (size_t)nxt.pn * tstep : cB;
        for (int t = 0; t < nt; t += 2) {
            const bool last = (t == nt - 2);
            const char* a1 = cA + (size_t)(t + 1) * kstep;
            const char* a2 = last ? nA : cA + (size_t)(t + 2) * kstep; const char* b2 = last ? nB : cB + (size_t)(t + 2) * kstep;
            const char* a3 = a2 + kstep; const char* b3 = b2 + kstep;
            if (last && has_next) S.a_ready(nxt);
            if constexpr (SP2) {
            PG8_LDB(B0, 0, 0); PG8_LDB(B1, 0, 1); PG8_SCHED; PG8_LDA(At, 0, 0); PG8_STAGE(PG8_SA(1, 1), a1 + hstep, voffA);
            PG8_WAIT_V(8); PG8_WAIT_L(0); PG8_BAR; PG8_MMA(0, 0, At, B0); PG8_MMA(0, 1, At, B1); PG8_BAR; PG8_SCHED;
            PG8_LDA(At, 0, 1); PG8_STAGE(PG8_SB(0, 0), b2, voffB); PG8_STAGE(PG8_SB(0, 1), b2 + hstep, voffB); PG8_STAGE(PG8_SA(0, 0), a2, voffA);
            PG8_WAIT_V(8); PG8_WAIT_L(0); PG8_BAR; PG8_MMA(1, 0, At, B0); PG8_MMA(1, 1, At, B1); PG8_BAR; PG8_SCHED;
            PG8_LDB(B0, 1, 0); PG8_LDB(B1, 1, 1); PG8_SCHED; PG8_LDA(At, 1, 0); PG8_STAGE(PG8_SA(0, 1), a2 + hstep, voffA);
            PG8_WAIT_V(8); PG8_WAIT_L(0); PG8_BAR; PG8_MMA(0, 0, At, B0); PG8_MMA(0, 1, At, B1); PG8_BAR; PG8_SCHED;
            PG8_LDA(At, 1, 1); PG8_STAGE(PG8_SB(1, 0), b3, voffB); PG8_STAGE(PG8_SB(1, 1), b3 + hstep, voffB); PG8_STAGE(PG8_SA(1, 0), a3, voffA);
            PG8_WAIT_V(8); PG8_WAIT_L(0); PG8_BAR; PG8_MMA(1, 0, At, B0); PG8_MMA(1, 1, At, B1); PG8_BAR; PG8_SCHED;
            } else {
            PG8_LDB(B0, 0, 0); PG8_SCHED; PG8_LDA(At, 0, 0); PG8_STAGE(PG8_SA(1, 1), a1 + hstep, voffA);
            PG8_WAIT_L(8); PG8_BAR; PG8_WAIT_L(0); PG8_MMA(0, 0, At, B0); PG8_BAR; PG8_SCHED;
            PG8_LDB(B1, 0, 1); PG8_STAGE(PG8_SB(0, 0), b2, voffB);
            PG8_BAR; PG8_WAIT_L(0); PG8_MMA(0, 1, At, B1); PG8_BAR;
            PG8_LDA(At, 0, 1); PG8_STAGE(PG8_SA(0, 0), a2, voffA);
            PG8_BAR; PG8_WAIT_L(0); PG8_MMA(1, 0, At, B0); PG8_BAR; PG8_SCHED;
            PG8_STAGE(PG8_SB(0, 1), b2 + hstep, voffB);
            PG8_WAIT_V(6); PG8_BAR; PG8_MMA(1, 1, At, B1); PG8_BAR;
            PG8_LDB(B0, 1, 0); PG8_SCHED; PG8_LDA(At, 1, 0); PG8_STAGE(PG8_SA(0, 1), a2 + hstep, voffA);
            PG8_WAIT_L(8); PG8_BAR; PG8_WAIT_L(0); PG8_MMA(0, 0, At, B0); PG8_BAR; PG8_SCHED;
            PG8_LDB(B1, 1, 1); PG8_STAGE(PG8_SB(1, 0), b3, voffB);
            PG8_BAR; PG8_WAIT_L(0); PG8_MMA(0, 1, At, B1); PG8_BAR;
            PG8_LDA(At, 1, 1); PG8_STAGE(PG8_SA(1, 0), a3, voffA);
            PG8_BAR; PG8_WAIT_L(0); PG8_MMA(1, 0, At, B0); PG8_BAR; PG8_SCHED;
            PG8_STAGE(PG8_SB(1, 1), b3 + hstep, voffB);
            PG8_WAIT_V(6); PG8_BAR; PG8_MMA(1, 1, At, B1); PG8_BAR;
            }
        }
        if constexpr (ALIGN_EPI) { if (wr == 0) PG8_BAR; }
        if constexpr (!Epi::AFTER_DRAIN) { E(acc, cur, wr, wc, fr, fq); S.done(cur); }
        if (!has_next) break;
#pragma unroll
        for (int a = 0; a < 2; ++a)
#pragma unroll
            for (int b = 0; b < 2; ++b)
#pragma unroll
                for (int m = 0; m < 4; ++m)
#pragma unroll
                    for (int n = 0; n < 2; ++n) acc[a][b][m][n] = (f32x4){0.f, 0.f, 0.f, 0.f};
        cur = nxt; cA = nA; cB = nB; ++ui;
        if constexpr (ALIGN_EPI) { if (wr == 1) PG8_BAR; }
    }
    PG8_WAIT_V(0);
    if constexpr (!ALIGN_EPI) { if (wr == 0) PG8_BAR; }
    PG8_BAR;
    if constexpr (Epi::AFTER_DRAIN) { E.fused(acc, cur, wr, wc, fr, fq, lds, wid, lane); S.done(cur); }
#undef PG8_SA
#undef PG8_SB
#undef PG8_STAGE
#undef PG8_LDA
#undef PG8_LDB
#undef PG8_MMA
#undef PG8_WAIT_V
#undef PG8_WAIT_L
#undef PG8_BAR
#undef PG8_SCHED
}
}

#define LAS __attribute__((address_space(3)))
typedef unsigned short bf16_t;
typedef short bf16x8 __attribute__((ext_vector_type(8)));
typedef float f32x4 __attribute__((ext_vector_type(4)));
typedef float f32x16 __attribute__((ext_vector_type(16)));
typedef unsigned u32x2 __attribute__((ext_vector_type(2)));
typedef unsigned u32x4 __attribute__((ext_vector_type(4)));
typedef float f32x2_t __attribute__((ext_vector_type(2)));
typedef __bf16 bf16x2_t __attribute__((ext_vector_type(2)));

constexpr int DM = 1024, NBATCH = 2, SEQ = 8192, DEPTH = 4, CTXL = 256;
constexpr int MLAT = NBATCH * SEQ, MCTX = NBATCH * CTXL, MTOT = MLAT + MCTX;
constexpr int NIN = 3584, NTM = 1536, NCM = 1024, NTB = MTOT / 64;
constexpr int C_QA = 0, C_GA = 384, C_QC = 768, C_GC = 1152;
constexpr int R_HZ = 0, R_GB = 768;
constexpr int NFFT = 16384;
constexpr float LOG2E = 1.4426950408889634f;
constexpr float QK_SCALE = 0.125f * LOG2E;

constexpr size_t MiB = 1u << 20;
constexpr size_t WS_ADA = 1 * MiB;
constexpr size_t WS_ROPE = 1 * MiB + 256 * 1024;
constexpr size_t WS_H2C = 1 * MiB + 512 * 1024;
constexpr size_t WS_CX = 2 * MiB;
constexpr size_t WS_H2 = 4 * MiB;
constexpr size_t WS_WIN = 12 * MiB;
constexpr size_t WS_WOUT = 40 * MiB;
constexpr size_t WS_HY = 48 * MiB;
constexpr size_t WS_PT = 81 * MiB;
constexpr size_t WS_KH = 130 * MiB + 512 * 1024;
constexpr size_t WS_VT = 147 * MiB;
constexpr size_t WS_PCT = 163 * MiB + 512 * 1024;
constexpr size_t WS_YBT = 197 * MiB;
constexpr size_t WS_ZS = 206 * MiB;
constexpr size_t WS_W3T = 238 * MiB;
constexpr size_t WS_FILT = 239 * MiB;
constexpr size_t WS_END = 255 * MiB;
static_assert(WS_PT + (size_t)MTOT * NTM * 2 <= WS_KH && WS_KH + (size_t)8 * MTOT * 128 <= WS_VT && WS_VT + (size_t)8 * MTOT * 128 <= WS_PCT && WS_PCT + (size_t)NCM * MTOT * 2 <= WS_YBT, "d_ws map");

constexpr int AUX_OFF = 147456;
constexpr int LDS_BYTES = 163840;
constexpr int NTHREADS = 512;

struct KArgs {
    const float* x; const float* c; const float* ctx; const float* c_ctx; const float* norm_g; const float* w_ada; const float* b_ada;
    const float* w_in; const float* w_out; const float* na_rpb; const float* hy_conv_w; const float* hy_conv_b;
    const float* hy_w1; const float* hy_b1; const float* hy_freq1; const float* hy_w2; const float* hy_b2; const float* hy_freq2; const float* hy_w3;
    const float* hy_d; const float* sink; const float* final_g;
    float* out; unsigned char* ws;
    int ph_lo, ph_hi;
};

typedef const __attribute__((address_space(4))) KArgs CKArgs;
__device__ __forceinline__ unsigned pk2(float lo, float hi) { f32x2_t v = {lo, hi}; bf16x2_t b = __builtin_convertvector(v, bf16x2_t); return __builtin_bit_cast(unsigned, b); }
__device__ __forceinline__ float bf2f(unsigned short u) { return __uint_as_float(((unsigned)u) << 16); }
__device__ __forceinline__ float bflo(unsigned w) { return __uint_as_float(w << 16); }
__device__ __forceinline__ float bfhi(unsigned w) { return __uint_as_float(w & 0xffff0000u); }
__device__ __forceinline__ float silu_f(float x) { return x / (1.0f + __expf(-x)); }
__device__ __forceinline__ float lane_xor(float v, int lane, int m) { return __int_as_float(__builtin_amdgcn_ds_bpermute((lane ^ m) << 2, __float_as_int(v))); }
__device__ __forceinline__ float lane_prev(float v, int lane) { return __int_as_float(__builtin_amdgcn_ds_bpermute(((lane - 1) & 63) << 2, __float_as_int(v))); }
__device__ __forceinline__ float lane_next(float v, int lane) { return __int_as_float(__builtin_amdgcn_ds_bpermute(((lane + 1) & 63) << 2, __float_as_int(v))); }
__device__ __forceinline__ float wave_sum(float v, int lane) {
#pragma unroll
    for (int o = 1; o < 64; o <<= 1) v += lane_xor(v, lane, o);
    return v;
}
__device__ __forceinline__ float rdlane(float v, int l) { return __uint_as_float(__builtin_amdgcn_readlane(__float_as_uint(v), l)); }

__device__ __forceinline__ void transpose_item(const float* W, int K, int N, bf16_t* WT, int k0, int n0, int drow0, LAS float* scr, int lane, int ldk = 0) {
    if (ldk == 0) ldk = K;
#pragma unroll 8
    for (int i = 0; i < 32; ++i) { const int kk = 2 * i + (lane >> 5); scr[kk * 33 + (lane & 31)] = W[(size_t)(k0 + kk) * N + n0 + (lane & 31)]; }
    asm volatile("s_waitcnt lgkmcnt(0)" ::: "memory");
    const int c = lane & 7;
#pragma unroll
    for (int j = 0; j < 4; ++j) { const int n = (lane >> 3) + 8 * j; const LAS float* s = scr + (8 * c) * 33 + n;
        u32x4 o; o.x = pk2(s[0 * 33], s[1 * 33]); o.y = pk2(s[2 * 33], s[3 * 33]); o.z = pk2(s[4 * 33], s[5 * 33]); o.w = pk2(s[6 * 33], s[7 * 33]);
        *(u32x4*)(WT + (size_t)(drow0 + n) * ldk + k0 + 8 * c) = o; }
    asm volatile("s_waitcnt lgkmcnt(0)" ::: "memory");
}
__device__ __forceinline__ int win_row(int n0) {
    if (n0 < 384) return n0;
    if (n0 < 768) return n0 - 384 + 1536;
    if (n0 < 1152) return n0 - 768 + 2048;
    if (n0 < 1536) return n0 - 1152 + 384;
    if (n0 < 2304) return n0 - 1536 + 2560;
    if (n0 < 2560) return n0 - 2304 + 3328;
    if (n0 < 2944) return n0 - 2560 + 768;
    if (n0 < 3072) return n0 - 2944 + 1920;
    if (n0 < 3200) return n0 - 3072 + 2432;
    return n0 - 3200 + 1152;
}

__device__ __forceinline__ void phase_prologue(CKArgs& A, LAS unsigned char* lds, int bid, int nblk, int tid) {
    const int wave = __builtin_amdgcn_readfirstlane(tid >> 6), lane = tid & 63;
    const int gw = bid * 8 + wave, NGW = nblk * 8;
    unsigned char* ws = A.ws;
    {
        LAS float* scr = (LAS float*)(lds + wave * 16384);
        constexpr int I_IN = 16 * 112, I_OUT = 16 * 32, I_L = I_IN + I_OUT;
        for (int it = gw; it < DEPTH * I_L; it += NGW) {
            const int l = it / I_L; int r = it % I_L;
            if (r < I_IN) { const int kb = r / 112, nb = r % 112, n0 = nb * 32;
                transpose_item(A.w_in + (size_t)l * DM * NIN, DM, NIN, (bf16_t*)(ws + WS_WIN) + (size_t)l * NIN * DM, kb * 64, n0, win_row(n0), scr, lane); }
            else { r -= I_IN; const int kb = r / 32, nb = r % 32, n0 = nb * 32;
                transpose_item(A.w_out + (size_t)l * DM * DM, DM, DM, (bf16_t*)(ws + WS_WOUT) + (size_t)l * DM * DM, kb * 64, n0, n0, scr, lane); }
        }
    }
    {
        LAS float* scr = (LAS float*)(lds + wave * 16384);
        bf16_t* W3T = (bf16_t*)(ws + WS_W3T);
        for (int it = gw; it < DEPTH * 32; it += NGW) { const int l = it >> 5, nb = it & 31;
            transpose_item(A.hy_w3 + (size_t)l * 64 * 1024, 64, 1024, W3T + (size_t)l * 1024 * 64, 0, nb * 32, nb * 32, scr, lane); }
    }
    for (int idx = gw * 64 + lane; idx < 128 * 16; idx += NGW * 64) {
        const int p = idx >> 4, i = idx & 15;
        const float inv = powf(10000.0f, -(float)i / 16.0f);
        const float ang = (float)p * inv;
        ((float2*)(ws + WS_ROPE))[idx] = make_float2(cosf(ang), sinf(ang));
    }
    for (int it = gw; it < DEPTH * 528; it += NGW) {
        const int l = it / 528, g4 = it % 528, g = g4 >> 2, sub = g4 & 3;
        const int L = g < 128 ? SEQ : CTXL;
        const int n0 = (g < 128 ? g * 64 : (g - 128) * 64) + 16 * sub;
        float* outp = (float*)(ws + WS_H2C) + ((size_t)l * CTXL + n0) * 64;
        bf16_t* outb = (bf16_t*)(ws + WS_H2) + ((size_t)l * SEQ + n0) * 64;
        float w1c[33], w2c[64];
#pragma unroll
        for (int q = 0; q < 33; ++q) w1c[q] = A.hy_w1[((size_t)l * 33 + q) * 64 + lane];
#pragma unroll
        for (int j = 0; j < 64; ++j) w2c[j] = A.hy_w2[((size_t)l * 64 + j) * 64 + lane];
        const float b1 = A.hy_b1[l * 64 + lane], fr1 = A.hy_freq1[l * 64 + lane], b2 = A.hy_b2[l * 64 + lane], fr2 = A.hy_freq2[l * 64 + lane];
        const float tstep = 1.0f / (float)(L - 1);
        const int fj = lane == 0 ? 0 : ((lane - 1) & 15);
        const float fq = 1e-4f + (float)fj * ((15.0f - 1e-4f) / 15.0f);
#pragma unroll 1
        for (int nn = 0; nn < 16; ++nn) {
            const int n = n0 + nn;
            const float t = (float)n * tstep;
            const float rev = fq * ((float)n * (1.0f / (float)L)) + (lane <= 16 ? 0.25f : 0.5f);
            float zq = __builtin_amdgcn_sinf(rev - floorf(rev));
            if (lane == 0) zq = t; if (lane > 32) zq = 0.f;
            float a1 = b1;
#pragma unroll
            for (int q = 0; q < 33; ++q) a1 += rdlane(zq, q) * w1c[q];
            const float x1 = fr1 * a1 * 0.15915494309189535f;
            const float h1 = __builtin_amdgcn_sinf(x1 - floorf(x1));
            float a2 = b2;
#pragma unroll
            for (int j = 0; j < 64; ++j) a2 += rdlane(h1, j) * w2c[j];
            const float x2 = fr2 * a2 * 0.15915494309189535f;
            const float h2 = __builtin_amdgcn_sinf(x2 - floorf(x2));
            if (g < 128) outb[nn * 64 + lane] = (bf16_t)(pk2(h2, 0.f) & 0xffffu);
            else outp[nn * 64 + lane] = h2;
        }
    }
    __syncthreads();
    {
        LAS float* red = (LAS float*)lds;
        LAS float* sv = (LAS float*)(lds + 8192);
        for (int i = tid; i < 3 * DM; i += NTHREADS) sv[i] = silu_f(i < 2 * DM ? A.c[i] : A.c_ctx[i - 2 * DM]);
        __syncthreads();
        for (int it = bid; it < DEPTH * 48; it += nblk) {
            const int l = it / 48, n = (it % 48) * 64 + lane;
            const float* W = A.w_ada + (size_t)l * DM * 3072 + n;
            float a0 = 0.f, a1 = 0.f, a2 = 0.f;
            const int kb = wave * 128;
#pragma unroll 1
            for (int k0 = 0; k0 < 128; k0 += 16) {
                float w[16];
#pragma unroll
                for (int k = 0; k < 16; ++k) w[k] = W[(size_t)(kb + k0 + k) * 3072];
#pragma unroll
                for (int k = 0; k < 16; ++k) { a0 += sv[kb + k0 + k] * w[k]; a1 += sv[DM + kb + k0 + k] * w[k]; a2 += sv[2 * DM + kb + k0 + k] * w[k]; }
            }
            red[(wave * 3 + 0) * 64 + lane] = a0; red[(wave * 3 + 1) * 64 + lane] = a1; red[(wave * 3 + 2) * 64 + lane] = a2;
            __syncthreads();
            if (tid < 192) { const int v = tid >> 6; float sacc = A.b_ada[l * 3072 + n];
#pragma unroll
                for (int w = 0; w < 8; ++w) sacc += red[(w * 3 + v) * 64 + lane];
                ((float*)(ws + WS_ADA))[((size_t)l * 3 + v) * 3072 + n] = sacc; }
            __syncthreads();
        }
    }
}

__device__ __forceinline__ void filt_items(CKArgs& A, int lf, int tid, int bid, int nblk, unsigned* ctr) {
    unsigned char* ws = A.ws;
    const int wave = __builtin_amdgcn_readfirstlane(tid >> 6), lane = tid & 63;
    const int gw = bid * 8 + wave, NGW = nblk * 8;
    const bf16_t* H2B = (const bf16_t*)(ws + WS_H2) + (size_t)lf * SEQ * 64;
    const bf16_t* W3T = (const bf16_t*)(ws + WS_W3T) + (size_t)lf * 1024 * 64;
    bf16_t* FILT = (bf16_t*)(ws + WS_FILT);
    const int fr = lane & 15, fq = lane >> 4;
    int it = gw;
#pragma unroll 1
    for (;;) {
        if (ctr) { unsigned t = 0; if (lane == 0) t = __hip_atomic_fetch_add(ctr, 1u, __ATOMIC_RELAXED, __HIP_MEMORY_SCOPE_AGENT); it = (int)__builtin_amdgcn_readfirstlane(t); }
        if (it >= 2048) break;
        const int n0 = (it >> 4) * 64, c0 = (it & 15) * 64;
        bf16x8 af[4][2];
#pragma unroll
        for (int j = 0; j < 4; ++j) { const bf16_t* ap = H2B + (size_t)(n0 + 16 * (fr >> 2) + 4 * j + (fr & 3)) * 64 + 8 * fq; af[j][0] = *(const bf16x8*)ap; af[j][1] = *(const bf16x8*)(ap + 32); }
#pragma unroll 1
        for (int ct = 0; ct < 4; ++ct) {
            const bf16_t* bp = W3T + (size_t)(c0 + 16 * ct + fr) * 64 + 8 * fq;
            const bf16x8 b0 = *(const bf16x8*)bp, b1 = *(const bf16x8*)(bp + 32);
            u32x4 o0, o1;
#pragma unroll
            for (int j = 0; j < 4; ++j) {
                f32x4 acc = {0.f, 0.f, 0.f, 0.f};
                acc = __builtin_amdgcn_mfma_f32_16x16x32_bf16(af[j][0], b0, acc, 0, 0, 0);
                acc = __builtin_amdgcn_mfma_f32_16x16x32_bf16(af[j][1], b1, acc, 0, 0, 0);
                const unsigned w0 = pk2(acc.x, acc.y), w1 = pk2(acc.z, acc.w);
                if (j == 0) { o0.x = w0; o0.y = w1; } else if (j == 1) { o0.z = w0; o0.w = w1; } else if (j == 2) { o1.x = w0; o1.y = w1; } else { o1.z = w0; o1.w = w1; }
            }
            bf16_t* dp = FILT + (size_t)(c0 + 16 * ct + fr) * SEQ + n0 + 16 * fq;
            *(u32x4*)dp = o0; *(u32x4*)(dp + 8) = o1;
        }
        if (!ctr) it += NGW;
    }
}

__device__ __forceinline__ void ctx_outproj_items(CKArgs& A, int l, int tid, int bid, int nblk) {
    unsigned char* ws = A.ws;
    const int wave = __builtin_amdgcn_readfirstlane(tid >> 6), lane = tid & 63;
    const int gw = bid * 8 + wave, NGW = nblk * 8;
    const bf16_t* Y = (const bf16_t*)(ws + WS_HY) + (size_t)MLAT * DM;
    const bf16_t* WT = (const bf16_t*)(ws + WS_WOUT) + (size_t)l * DM * DM;
    const float* gate = (const float*)(ws + WS_ADA) + ((size_t)l * 3 + 2) * 3072 + 2048;
    const float* csrc = l == 0 ? A.ctx : (const float*)(ws + WS_CX);
    float* cdst = (float*)(ws + WS_CX);
    const int fr = lane & 15, fq = lane >> 4;
#pragma unroll 1
    for (int it = gw; it < 2048; it += NGW) {
        const int r0 = (it >> 6) * 16, c0 = (it & 63) * 16;
        const bf16_t* ap = Y + (size_t)(r0 + fr) * DM + 8 * fq;
        const bf16_t* bp = WT + (size_t)(c0 + fr) * DM + 8 * fq;
        f32x4 acc0 = {0.f, 0.f, 0.f, 0.f}, acc1 = {0.f, 0.f, 0.f, 0.f};
#pragma unroll 1
        for (int k0 = 0; k0 < 32; k0 += 8) {
            bf16x8 a[8], b[8];
#pragma unroll
            for (int k = 0; k < 8; ++k) { a[k] = *(const bf16x8*)(ap + 32 * (k0 + k)); b[k] = *(const bf16x8*)(bp + 32 * (k0 + k)); }
#pragma unroll
            for (int k = 0; k < 8; k += 2) { acc0 = __builtin_amdgcn_mfma_f32_16x16x32_bf16(a[k], b[k], acc0, 0, 0, 0); acc1 = __builtin_amdgcn_mfma_f32_16x16x32_bf16(a[k + 1], b[k + 1], acc1, 0, 0, 0); }
        }
        const float g = gate[c0 + fr];
#pragma unroll
        for (int i = 0; i < 4; ++i) { const size_t off = (size_t)(r0 + 4 * fq + i) * DM + c0 + fr; cdst[off] = csrc[off] + g * (acc0[i] + acc1[i]); }
    }
}

__device__ __forceinline__ void phase_norm(CKArgs& A, int l, int bid, int nblk, int tid) {
    const int wave = __builtin_amdgcn_readfirstlane(tid >> 6), lane = tid & 63;
    const int gw = bid * 8 + wave, NGW = nblk * 8;
    unsigned char* ws = A.ws;
    bf16_t* H = (bf16_t*)(ws + WS_HY);
    const float* ada = (const float*)(ws + WS_ADA) + (size_t)l * 3 * 3072;
    const float* g = A.norm_g + l * DM;
    for (int m = gw; m < MTOT; m += NGW) {
        const float* src; int v;
        if (m < MLAT) { src = (l == 0 ? A.x : A.out) + (size_t)m * DM; v = m >> 13; }
        else { src = (l == 0 ? A.ctx : (const float*)(ws + WS_CX)) + (size_t)(m - MLAT) * DM; v = 2; }
        const float* shp = ada + v * 3072; const float* scp = shp + DM;
        f32x4 xv[4]; float ss = 0.f;
#pragma unroll
        for (int j = 0; j < 4; ++j) { xv[j] = *(const f32x4*)(src + 4 * lane + 256 * j); ss += (xv[j].x * xv[j].x + xv[j].y * xv[j].y) + (xv[j].z * xv[j].z + xv[j].w * xv[j].w); }
        const float rinv = rsqrtf(wave_sum(ss, lane) * (1.0f / DM) + 1e-6f);
#pragma unroll
        for (int j = 0; j < 4; ++j) { const int col = 4 * lane + 256 * j;
            const f32x4 gv = *(const f32x4*)(g + col), sc = *(const f32x4*)(scp + col), sh = *(const f32x4*)(shp + col);
            const f32x4 h = xv[j] * rinv * gv * (sc + 1.0f) + sh;
            u32x2 o; o.x = pk2(h.x, h.y); o.y = pk2(h.z, h.w);
            *(u32x2*)(H + (size_t)m * DM + col) = o; }
    }
    if (l == 0) filt_items(A, 0, tid, bid, nblk, nullptr);
}

struct EpiIn {
    static constexpr bool PERM = true, AFTER_DRAIN = false;
    bf16_t* PT; bf16_t* KH; bf16_t* PCT; const float2* rope;
    __device__ __forceinline__ void operator()(const f32x4 (&acc)[2][2][4][2], const pg8::Unit& u, int wr, int wc, int fr, int fq) const {
        const int row0 = u.pm * 256 + wr * 64 + fr;
        if (u.pn < 10) {
#pragma unroll
            for (int bj = 0; bj < 2; ++bj) {
                const int blk = 2 * u.pn + bj;
                const bool rp = ((blk >= 6 && blk <= 8) || blk == 15) && (u.pm < 64);
                const int col0 = 256 * u.pn + 128 * bj + 32 * wc + 8 * fq;
                bf16_t* dst; size_t ld;
                if (u.pn < 6) { dst = PT + col0; ld = NTM; }
                else { const int n2 = col0 - 1536; dst = KH + (size_t)(n2 >> 6) * MTOT * 64 + (n2 & 63); ld = 64; }
#pragma unroll
                for (int ai = 0; ai < 2; ++ai)
#pragma unroll
                    for (int m = 0; m < 4; ++m) {
                        const int r = row0 + 128 * ai + 16 * m;
                        f32x4 v0 = acc[ai][bj][m][0], v1 = acc[ai][bj][m][1];
                        if (rp) {
                            const int pos = r & (SEQ - 1);
                            const int p = (wc & 1) ? (pos & 63) : (pos >> 6);
                            const f32x4* tb = (const f32x4*)(rope + p * 16 + 8 * (fq & 1));
                            const int ln = fr + 16 * fq;
                            const float sg = (fq < 2) ? -1.0f : 1.0f;
                            { const f32x4 t0 = tb[0], t1 = tb[1];
                              const float qx = lane_xor(v0.x, ln, 32), qy = lane_xor(v0.y, ln, 32), qz = lane_xor(v0.z, ln, 32), qw = lane_xor(v0.w, ln, 32);
                              v0.x = v0.x * t0.x + sg * qx * t0.y; v0.y = v0.y * t0.z + sg * qy * t0.w; v0.z = v0.z * t1.x + sg * qz * t1.y; v0.w = v0.w * t1.z + sg * qw * t1.w; }
                            { const f32x4 t2 = tb[2], t3 = tb[3];
                              const float qx = lane_xor(v1.x, ln, 32), qy = lane_xor(v1.y, ln, 32), qz = lane_xor(v1.z, ln, 32), qw = lane_xor(v1.w, ln, 32);
                              v1.x = v1.x * t2.x + sg * qx * t2.y; v1.y = v1.y * t2.z + sg * qy * t2.w; v1.z = v1.z * t3.x + sg * qz * t3.y; v1.w = v1.w * t3.z + sg * qw * t3.w; }
                        }
                        u32x4 w; w.x = pk2(v0.x, v0.y); w.y = pk2(v0.z, v0.w); w.z = pk2(v1.x, v1.y); w.w = pk2(v1.z, v1.w);
                        *(u32x4*)(dst + (size_t)r * ld) = w;
                        asm volatile("" ::: "memory");
                    }
            }
        } else {
#pragma unroll
            for (int bj = 0; bj < 2; ++bj) {
                const int ch0 = 256 * (u.pn - 10) + 128 * bj + 32 * wc + 8 * fq;
#pragma unroll
                for (int ai = 0; ai < 2; ++ai)
#pragma unroll
                    for (int m = 0; m < 4; ++m) {
                        const int r = row0 + 128 * ai + 16 * m;
                        bf16_t* p = PCT + (size_t)ch0 * MTOT + r;
#pragma unroll
                        for (int n = 0; n < 2; ++n) {
                            const f32x4 v = acc[ai][bj][m][n];
                            bf16_t* q = p + (size_t)(4 * n) * MTOT;
                            const unsigned w0 = pk2(v.x, v.y), w1 = pk2(v.z, v.w);
                            q[0] = (bf16_t)(w0 & 0xffffu); q[MTOT] = (bf16_t)(w0 >> 16); q[2 * (size_t)MTOT] = (bf16_t)(w1 & 0xffffu); q[3 * (size_t)MTOT] = (bf16_t)(w1 >> 16);
                        }
                    }
            }
        }
    }
};
struct EpiFilt {
    static constexpr bool PERM = true, AFTER_DRAIN = false;
    bf16_t* O; int ldc;
    __device__ __forceinline__ void operator()(const f32x4 (&acc)[2][2][4][2], const pg8::Unit& u, int wr, int wc, int fr, int fq) const {
        const int row0 = u.pm * 256 + wr * 64 + fr;
#pragma unroll
        for (int bj = 0; bj < 2; ++bj) { const int col0 = 256 * u.pn + 128 * bj + 32 * wc + 8 * fq;
#pragma unroll
            for (int ai = 0; ai < 2; ++ai)
#pragma unroll
                for (int m = 0; m < 4; ++m) { const int r = row0 + 128 * ai + 16 * m; const f32x4 v0 = acc[ai][bj][m][0], v1 = acc[ai][bj][m][1];
                    u32x4 w; w.x = pk2(v0.x, v0.y); w.y = pk2(v0.z, v0.w); w.z = pk2(v1.x, v1.y); w.w = pk2(v1.z, v1.w);
                    *(u32x4*)(O + (size_t)r * ldc + col0) = w; } }
    }
};
struct EpiOut {
    static constexpr bool PERM = true, AFTER_DRAIN = false;
    const float* xsrc; float* xdst; const float* csrc; float* cdst; const float* ada;
    __device__ __forceinline__ void operator()(const f32x4 (&acc)[2][2][4][2], const pg8::Unit& u, int wr, int wc, int fr, int fq) const {
        const int row0 = u.pm * 256 + wr * 64 + fr;
        const bool lat = u.pm < 64;
        const int v = lat ? (row0 >> 13) : 2;
        const float* sbase = lat ? xsrc + (size_t)row0 * DM : csrc + (size_t)(row0 - MLAT) * DM;
        float* dbase = lat ? xdst + (size_t)row0 * DM : cdst + (size_t)(row0 - MLAT) * DM;
#pragma unroll
        for (int bj = 0; bj < 2; ++bj) {
            const int col0 = 256 * u.pn + 128 * bj + 32 * wc + 8 * fq;
            const float* gp = ada + v * 3072 + 2048 + col0;
            const f32x4 g0 = *(const f32x4*)gp, g1 = *(const f32x4*)(gp + 4);
#pragma unroll
            for (int ai = 0; ai < 2; ++ai) {
                f32x4 x0[4], x1[4];
#pragma unroll
                for (int m = 0; m < 4; ++m) { const float* sp = sbase + (size_t)(128 * ai + 16 * m) * DM + col0; x0[m] = *(const f32x4*)sp; x1[m] = *(const f32x4*)(sp + 4); }
#pragma unroll
                for (int m = 0; m < 4; ++m) { float* dp = dbase + (size_t)(128 * ai + 16 * m) * DM + col0;
                    *(f32x4*)dp = x0[m] + g0 * acc[ai][bj][m][0];
                    *(f32x4*)(dp + 4) = x1[m] + g1 * acc[ai][bj][m][1]; }
                asm volatile("" ::: "memory");
            }
            asm volatile("" ::: "memory");
        }
    }
};
struct EpiAll {
    static constexpr bool PERM = true, AFTER_DRAIN = false;
    int mode, l; CKArgs* Ap;
    __device__ __forceinline__ void operator()(const f32x4 (&acc)[2][2][4][2], const pg8::Unit& u, int wr, int wc, int fr, int fq) const {
        unsigned char* ws = Ap->ws;
        if (mode == 0) { const EpiIn E{(bf16_t*)(ws + WS_PT), (bf16_t*)(ws + WS_KH), (bf16_t*)(ws + WS_PCT), (const float2*)(ws + WS_ROPE)}; E(acc, u, wr, wc, fr, fq); }
        else { const EpiOut E{l == 0 ? Ap->x : Ap->out, Ap->out, l == 0 ? Ap->ctx : (const float*)(ws + WS_CX), (float*)(ws + WS_CX), (const float*)(ws + WS_ADA) + (size_t)l * 3 * 3072}; E(acc, u, wr, wc, fr, fq); }
    }
};
__device__ __forceinline__ float max3f(float a, float b, float c) { float r; asm("v_max3_f32 %0, %1, %2, %3" : "=v"(r) : "v"(a), "v"(b), "v"(c)); return r; }
__device__ __forceinline__ float max2f(float a, float b) { float r; asm("v_max_f32_e32 %0, %1, %2" : "=v"(r) : "v"(a), "v"(b)); return r; }
__device__ __forceinline__ void attn_tile(LAS const unsigned char* slot, int cs, const bf16x8 (&bq)[4], f32x16& o0, f32x16& o1, float& m_run, float& l_run,
                                          int r31, int hh, bool use_mask, int clo, int chi, bool use_bias, LAS const float* btab, int bidx) {
    const int kr = cs + r31;
    LAS const unsigned char* kp = slot + kr * 128;
    const int ksw = (kr >> 1) & 7;
    const bf16x8 ka0 = *(LAS const bf16x8*)(kp + 16 * ((0 + hh) ^ ksw)), ka1 = *(LAS const bf16x8*)(kp + 16 * ((2 + hh) ^ ksw));
    const bf16x8 ka2 = *(LAS const bf16x8*)(kp + 16 * ((4 + hh) ^ ksw)), ka3 = *(LAS const bf16x8*)(kp + 16 * ((6 + hh) ^ ksw));
    LAS const unsigned char* vp = slot + 8192 + r31 * 128;
    const int vsw = (r31 >> 1) & 15, g0 = (cs >> 2) + hh;
    const u32x2 a0l = *(LAS const u32x2*)(vp + 8 * ((g0) ^ vsw)), a0h = *(LAS const u32x2*)(vp + 8 * ((g0 + 2) ^ vsw));
    const u32x2 a1l = *(LAS const u32x2*)(vp + 8 * ((g0 + 4) ^ vsw)), a1h = *(LAS const u32x2*)(vp + 8 * ((g0 + 6) ^ vsw));
    const u32x2 b0l = *(LAS const u32x2*)(vp + 4096 + 8 * ((g0) ^ vsw)), b0h = *(LAS const u32x2*)(vp + 4096 + 8 * ((g0 + 2) ^ vsw));
    const u32x2 b1l = *(LAS const u32x2*)(vp + 4096 + 8 * ((g0 + 4) ^ vsw)), b1h = *(LAS const u32x2*)(vp + 4096 + 8 * ((g0 + 6) ^ vsw));
    f32x16 s, t;
#pragma unroll
    for (int i = 0; i < 16; ++i) { s[i] = 0.f; t[i] = 0.f; }
    s = __builtin_amdgcn_mfma_f32_32x32x16_bf16(ka0, bq[0], s, 0, 0, 0); t = __builtin_amdgcn_mfma_f32_32x32x16_bf16(ka1, bq[1], t, 0, 0, 0);
    s = __builtin_amdgcn_mfma_f32_32x32x16_bf16(ka2, bq[2], s, 0, 0, 0); t = __builtin_amdgcn_mfma_f32_32x32x16_bf16(ka3, bq[3], t, 0, 0, 0);
    if (use_bias) {
        LAS const float* bp = btab + bidx;
#pragma unroll
        for (int i = 0; i < 16; ++i) { const int c = (i & 3) + 8 * (i >> 2) + 4 * hh; s[i] = (s[i] + t[i]) * QK_SCALE + bp[c]; }
    } else {
#pragma unroll
        for (int i = 0; i < 16; ++i) s[i] = (s[i] + t[i]) * QK_SCALE;
    }
    if (use_mask) {
        const unsigned off = (unsigned)(4 * hh - clo), rng = (unsigned)(chi - clo);
        const bool any = chi >= clo;
#pragma unroll
        for (int i = 0; i < 16; ++i) { const unsigned c0 = (unsigned)((i & 3) + 8 * (i >> 2)); s[i] = (any && (c0 + off <= rng)) ? s[i] : -INFINITY; }
    }
    float tmax = max3f(s[0], s[1], s[2]);
#pragma unroll
    for (int i = 3; i < 15; i += 2) tmax = max3f(tmax, s[i], s[i + 1]);
    tmax = max2f(tmax, s[15]);
    tmax = max2f(tmax, lane_xor(tmax, r31 + 32 * hh, 32));
    if (__any(tmax - m_run > 8.0f)) {
        const float m_new = fmaxf(m_run, tmax);
        const float alpha = __builtin_amdgcn_exp2f(m_run - m_new);
        m_run = m_new; l_run *= alpha;
#pragma unroll
        for (int i = 0; i < 16; ++i) { o0[i] *= alpha; o1[i] *= alpha; }
    }
    float ps0 = 0.f, ps1 = 0.f;
#pragma unroll
    for (int i = 0; i < 16; i += 2) { const float p0 = __builtin_amdgcn_exp2f(s[i] - m_run), p1 = __builtin_amdgcn_exp2f(s[i + 1] - m_run); s[i] = p0; s[i + 1] = p1; ps0 += p0; ps1 += p1; }
    l_run += ps0 + ps1;
    u32x4 pw0, pw1;
    pw0.x = pk2(s[0], s[1]); pw0.y = pk2(s[2], s[3]); pw0.z = pk2(s[4], s[5]); pw0.w = pk2(s[6], s[7]);
    pw1.x = pk2(s[8], s[9]); pw1.y = pk2(s[10], s[11]); pw1.z = pk2(s[12], s[13]); pw1.w = pk2(s[14], s[15]);
    const bf16x8 pb0 = __builtin_bit_cast(bf16x8, pw0), pb1 = __builtin_bit_cast(bf16x8, pw1);
    u32x4 w;
    w.x = a0l.x; w.y = a0l.y; w.z = a0h.x; w.w = a0h.y; const bf16x8 va00 = __builtin_bit_cast(bf16x8, w);
    w.x = a1l.x; w.y = a1l.y; w.z = a1h.x; w.w = a1h.y; const bf16x8 va01 = __builtin_bit_cast(bf16x8, w);
    w.x = b0l.x; w.y = b0l.y; w.z = b0h.x; w.w = b0h.y; const bf16x8 va10 = __builtin_bit_cast(bf16x8, w);
    w.x = b1l.x; w.y = b1l.y; w.z = b1h.x; w.w = b1h.y; const bf16x8 va11 = __builtin_bit_cast(bf16x8, w);
    o0 = __builtin_amdgcn_mfma_f32_32x32x16_bf16(va00, pb0, o0, 0, 0, 0); o1 = __builtin_amdgcn_mfma_f32_32x32x16_bf16(va10, pb0, o1, 0, 0, 0);
    o0 = __builtin_amdgcn_mfma_f32_32x32x16_bf16(va01, pb1, o0, 0, 0, 0); o1 = __builtin_amdgcn_mfma_f32_32x32x16_bf16(va11, pb1, o1, 0, 0, 0);
}

__device__ __forceinline__ void attn_tile2(LAS const unsigned char* slot, const bf16x8 (&bq)[4], f32x16& o0, f32x16& o1, float& m_run, float& l_run,
                                           int r31, int hh, bool use_mask, int clo0, int chi0, int clo1, int chi1) {
    const int ksw = (r31 >> 1) & 7;
    LAS const unsigned char* kp = slot + r31 * 128;
    const bf16x8 ka0 = *(LAS const bf16x8*)(kp + 16 * ((0 + hh) ^ ksw)), ka1 = *(LAS const bf16x8*)(kp + 16 * ((2 + hh) ^ ksw));
    const bf16x8 ka2 = *(LAS const bf16x8*)(kp + 16 * ((4 + hh) ^ ksw)), ka3 = *(LAS const bf16x8*)(kp + 16 * ((6 + hh) ^ ksw));
    const bf16x8 kb0 = *(LAS const bf16x8*)(kp + 4096 + 16 * ((0 + hh) ^ ksw)), kb1 = *(LAS const bf16x8*)(kp + 4096 + 16 * ((2 + hh) ^ ksw));
    const bf16x8 kb2 = *(LAS const bf16x8*)(kp + 4096 + 16 * ((4 + hh) ^ ksw)), kb3 = *(LAS const bf16x8*)(kp + 4096 + 16 * ((6 + hh) ^ ksw));
    f32x16 s0, s1;
#pragma unroll
    for (int i = 0; i < 16; ++i) { s0[i] = 0.f; s1[i] = 0.f; }
    s0 = __builtin_amdgcn_mfma_f32_32x32x16_bf16(ka0, bq[0], s0, 0, 0, 0); s1 = __builtin_amdgcn_mfma_f32_32x32x16_bf16(kb0, bq[0], s1, 0, 0, 0);
    s0 = __builtin_amdgcn_mfma_f32_32x32x16_bf16(ka1, bq[1], s0, 0, 0, 0); s1 = __builtin_amdgcn_mfma_f32_32x32x16_bf16(kb1, bq[1], s1, 0, 0, 0);
    s0 = __builtin_amdgcn_mfma_f32_32x32x16_bf16(ka2, bq[2], s0, 0, 0, 0); s1 = __builtin_amdgcn_mfma_f32_32x32x16_bf16(kb2, bq[2], s1, 0, 0, 0);
    s0 = __builtin_amdgcn_mfma_f32_32x32x16_bf16(ka3, bq[3], s0, 0, 0, 0); s1 = __builtin_amdgcn_mfma_f32_32x32x16_bf16(kb3, bq[3], s1, 0, 0, 0);
    LAS const unsigned char* vp = slot + 8192 + r31 * 128;
    const int vsw = (r31 >> 1) & 15;
    u32x2 va[2][4][2];
#pragma unroll
    for (int db = 0; db < 2; ++db)
#pragma unroll
        for (int st = 0; st < 4; ++st) { va[db][st][0] = *(LAS const u32x2*)(vp + 4096 * db + 8 * ((4 * st + hh) ^ vsw)); va[db][st][1] = *(LAS const u32x2*)(vp + 4096 * db + 8 * ((4 * st + hh + 2) ^ vsw)); }
    if (use_mask) {
        const unsigned off0 = (unsigned)(4 * hh - clo0), rng0 = (unsigned)(chi0 - clo0), off1 = (unsigned)(4 * hh - clo1), rng1 = (unsigned)(chi1 - clo1);
#pragma unroll
        for (int i = 0; i < 16; ++i) { const unsigned c0 = (unsigned)((i & 3) + 8 * (i >> 2)); s0[i] = (c0 + off0 <= rng0) ? s0[i] : -INFINITY; s1[i] = (c0 + off1 <= rng1) ? s1[i] : -INFINITY; }
    }
    float tmax = max3f(s0[0], s0[1], s1[0]);
    tmax = max2f(tmax, s1[1]);
#pragma unroll
    for (int i = 2; i < 16; i += 2) { tmax = max3f(tmax, s0[i], s0[i + 1]); tmax = max3f(tmax, s1[i], s1[i + 1]); }
    tmax = max2f(tmax, lane_xor(tmax, r31 + 32 * hh, 32)) * QK_SCALE;
    if (__any(tmax - m_run > 8.0f)) {
        const float m_new = fmaxf(m_run, tmax);
        const float alpha = __builtin_amdgcn_exp2f(m_run - m_new);
        m_run = m_new; l_run *= alpha;
#pragma unroll
        for (int i = 0; i < 16; ++i) { o0[i] *= alpha; o1[i] *= alpha; }
    }
    float ps0 = 0.f, ps1 = 0.f;
    const float nm = -m_run;
#pragma unroll
    for (int i = 0; i < 16; ++i) { const float p0 = __builtin_amdgcn_exp2f(fmaf(s0[i], QK_SCALE, nm)), p1 = __builtin_amdgcn_exp2f(fmaf(s1[i], QK_SCALE, nm)); s0[i] = p0; s1[i] = p1; ps0 += p0; ps1 += p1; }
    l_run += ps0 + ps1;
    u32x4 pw;
    pw.x = pk2(s0[0], s0[1]); pw.y = pk2(s0[2], s0[3]); pw.z = pk2(s0[4], s0[5]); pw.w = pk2(s0[6], s0[7]); const bf16x8 p00 = __builtin_bit_cast(bf16x8, pw);
    pw.x = pk2(s0[8], s0[9]); pw.y = pk2(s0[10], s0[11]); pw.z = pk2(s0[12], s0[13]); pw.w = pk2(s0[14], s0[15]); const bf16x8 p01 = __builtin_bit_cast(bf16x8, pw);
    pw.x = pk2(s1[0], s1[1]); pw.y = pk2(s1[2], s1[3]); pw.z = pk2(s1[4], s1[5]); pw.w = pk2(s1[6], s1[7]); const bf16x8 p10 = __builtin_bit_cast(bf16x8, pw);
    pw.x = pk2(s1[8], s1[9]); pw.y = pk2(s1[10], s1[11]); pw.z = pk2(s1[12], s1[13]); pw.w = pk2(s1[14], s1[15]); const bf16x8 p11 = __builtin_bit_cast(bf16x8, pw);
#define VA8(db_, st_) __builtin_bit_cast(bf16x8, (u32x4){va[db_][st_][0].x, va[db_][st_][0].y, va[db_][st_][1].x, va[db_][st_][1].y})
    o0 = __builtin_amdgcn_mfma_f32_32x32x16_bf16(VA8(0, 0), p00, o0, 0, 0, 0); o1 = __builtin_amdgcn_mfma_f32_32x32x16_bf16(VA8(1, 0), p00, o1, 0, 0, 0);
    o0 = __builtin_amdgcn_mfma_f32_32x32x16_bf16(VA8(0, 1), p01, o0, 0, 0, 0); o1 = __builtin_amdgcn_mfma_f32_32x32x16_bf16(VA8(1, 1), p01, o1, 0, 0, 0);
    o0 = __builtin_amdgcn_mfma_f32_32x32x16_bf16(VA8(0, 2), p10, o0, 0, 0, 0); o1 = __builtin_amdgcn_mfma_f32_32x32x16_bf16(VA8(1, 2), p10, o1, 0, 0, 0);
    o0 = __builtin_amdgcn_mfma_f32_32x32x16_bf16(VA8(0, 3), p11, o0, 0, 0, 0); o1 = __builtin_amdgcn_mfma_f32_32x32x16_bf16(VA8(1, 3), p11, o1, 0, 0, 0);
#undef VA8
}

__device__ __forceinline__ void attn_tile4(LAS const unsigned char* slotA, LAS const unsigned char* slotB, const bf16x8 (&bq)[4], f32x16& o0, f32x16& o1, float& m_run, float& l_run, int r31, int hh) {
    const int ksw = (r31 >> 1) & 7, vsw = (r31 >> 1) & 15;
    f32x16 s[4];
#pragma unroll
    for (int t = 0; t < 4; ++t)
#pragma unroll
        for (int i = 0; i < 16; ++i) s[t][i] = 0.f;
#pragma unroll
    for (int ks = 0; ks < 4; ++ks) {
        LAS const unsigned char* ka = slotA + r31 * 128 + 16 * ((2 * ks + hh) ^ ksw);
        LAS const unsigned char* kb = slotB + r31 * 128 + 16 * ((2 * ks + hh) ^ ksw);
        const bf16x8 k0 = *(LAS const bf16x8*)ka, k1 = *(LAS const bf16x8*)(ka + 4096), k2 = *(LAS const bf16x8*)kb, k3 = *(LAS const bf16x8*)(kb + 4096);
        s[0] = __builtin_amdgcn_mfma_f32_32x32x16_bf16(k0, bq[ks], s[0], 0, 0, 0); s[1] = __builtin_amdgcn_mfma_f32_32x32x16_bf16(k1, bq[ks], s[1], 0, 0, 0);
        s[2] = __builtin_amdgcn_mfma_f32_32x32x16_bf16(k2, bq[ks], s[2], 0, 0, 0); s[3] = __builtin_amdgcn_mfma_f32_32x32x16_bf16(k3, bq[ks], s[3], 0, 0, 0);
    }
    float tmax = max3f(s[0][0], s[1][0], s[2][0]);
    tmax = max2f(tmax, s[3][0]);
#pragma unroll
    for (int i = 1; i < 16; ++i) { tmax = max3f(tmax, s[0][i], s[1][i]); tmax = max3f(tmax, s[2][i], s[3][i]); }
    tmax = max2f(tmax, lane_xor(tmax, r31 + 32 * hh, 32)) * QK_SCALE;
    if (__any(tmax - m_run > 8.0f)) {
        const float m_new = fmaxf(m_run, tmax);
        const float alpha = __builtin_amdgcn_exp2f(m_run - m_new);
        m_run = m_new; l_run *= alpha;
#pragma unroll
        for (int i = 0; i < 16; ++i) { o0[i] *= alpha; o1[i] *= alpha; }
    }
    const float nm = -m_run;
    float ps0 = 0.f, ps1 = 0.f;
#pragma unroll
    for (int t = 0; t < 4; ++t)
#pragma unroll
        for (int i = 0; i < 16; i += 2) { const float p0 = __builtin_amdgcn_exp2f(fmaf(s[t][i], QK_SCALE, nm)), p1 = __builtin_amdgcn_exp2f(fmaf(s[t][i + 1], QK_SCALE, nm)); s[t][i] = p0; s[t][i + 1] = p1; ps0 += p0; ps1 += p1; }
    l_run += ps0 + ps1;
#pragma unroll
    for (int t = 0; t < 4; ++t) {
        LAS const unsigned char* vp = (t < 2 ? slotA : slotB) + 8192 + r31 * 128;
        const int g0 = 8 * (t & 1) + hh;
        u32x4 pw;
        pw.x = pk2(s[t][0], s[t][1]); pw.y = pk2(s[t][2], s[t][3]); pw.z = pk2(s[t][4], s[t][5]); pw.w = pk2(s[t][6], s[t][7]); const bf16x8 pa = __builtin_bit_cast(bf16x8, pw);
        pw.x = pk2(s[t][8], s[t][9]); pw.y = pk2(s[t][10], s[t][11]); pw.z = pk2(s[t][12], s[t][13]); pw.w = pk2(s[t][14], s[t][15]); const bf16x8 pb = __builtin_bit_cast(bf16x8, pw);
        const u32x2 a0l = *(LAS const u32x2*)(vp + 8 * ((g0) ^ vsw)), a0h = *(LAS const u32x2*)(vp + 8 * ((g0 + 2) ^ vsw));
        const u32x2 a1l = *(LAS const u32x2*)(vp + 8 * ((g0 + 4) ^ vsw)), a1h = *(LAS const u32x2*)(vp + 8 * ((g0 + 6) ^ vsw));
        const u32x2 b0l = *(LAS const u32x2*)(vp + 4096 + 8 * ((g0) ^ vsw)), b0h = *(LAS const u32x2*)(vp + 4096 + 8 * ((g0 + 2) ^ vsw));
        const u32x2 b1l = *(LAS const u32x2*)(vp + 4096 + 8 * ((g0 + 4) ^ vsw)), b1h = *(LAS const u32x2*)(vp + 4096 + 8 * ((g0 + 6) ^ vsw));
        o0 = __builtin_amdgcn_mfma_f32_32x32x16_bf16(__builtin_bit_cast(bf16x8, (u32x4){a0l.x, a0l.y, a0h.x, a0h.y}), pa, o0, 0, 0, 0);
        o1 = __builtin_amdgcn_mfma_f32_32x32x16_bf16(__builtin_bit_cast(bf16x8, (u32x4){b0l.x, b0l.y, b0h.x, b0h.y}), pa, o1, 0, 0, 0);
        o0 = __builtin_amdgcn_mfma_f32_32x32x16_bf16(__builtin_bit_cast(bf16x8, (u32x4){a1l.x, a1l.y, a1h.x, a1h.y}), pb, o0, 0, 0, 0);
        o1 = __builtin_amdgcn_mfma_f32_32x32x16_bf16(__builtin_bit_cast(bf16x8, (u32x4){b1l.x, b1l.y, b1h.x, b1h.y}), pb, o1, 0, 0, 0);
    }
}

__device__ __forceinline__ void attn_block_item(CKArgs& A, int l, int MODE, int item, LAS unsigned char* lds, int tid) {
    asm volatile("" : "+v"(tid));
    unsigned char* ws = A.ws;
    const bf16_t* PT = (const bf16_t*)(ws + WS_PT);
    bf16_t* Y = (bf16_t*)(ws + WS_HY);
    const int wave = __builtin_amdgcn_readfirstlane(tid >> 6), lane = tid & 63;
    const int r31 = lane & 31, hh = lane >> 5;
    int b, h, qtok, qi = 0;
    int rp = 0, mg = 0, qg = 0;
    if (MODE == 0) { b = item / 192; const int rem = item % 192; h = rem >> 5; qi = rem & 31; rp = 2 * qi + (wave >> 2); mg = wave & 3;
        qtok = b * SEQ + (2 * rp + (r31 >> 4)) * 64 + 16 * mg + (r31 & 15); }
    else if (MODE == 1) { b = item / 192; const int rem = item % 192; h = rem >> 5; qi = rem & 31; qg = 8 * qi + wave; qtok = b * SEQ + 32 * qg + r31; }
    else { b = item / 6; h = item % 6; qg = wave; qtok = MLAT + b * CTXL + 32 * qg + r31; }
    const bool grpA = (MODE == 0 || MODE == 2);
    const int kvh = grpA ? h : h / 3;
    const int qcol = (grpA ? C_QA : C_QC) + h * 64, gcol = (grpA ? C_GA : C_GC) + h * 64, ycol = (grpA ? 0 : 640) + h * 64;
    const int kh = grpA ? h : 6 + kvh;
    bf16x8 bq[4];
    { const bf16_t* qp = PT + (size_t)qtok * NTM + qcol + 8 * hh;
#pragma unroll
      for (int s = 0; s < 4; ++s) bq[s] = *(const bf16x8*)(qp + 16 * s); }
    f32x16 o0, o1;
#pragma unroll
    for (int i = 0; i < 16; ++i) { o0[i] = 0.f; o1[i] = 0.f; }
    float m_run = -1e30f, l_run = 0.f;
    if (!grpA) { m_run = A.sink[l * 6 + h] * LOG2E; l_run = hh == 0 ? 1.0f : 0.f; }
    int wrow0 = 0, nwin = 0;
    if (MODE == 0) { const int a0 = min(max(4 * qi - 4, 0), 120), a1 = min(max(4 * qi - 1, 0), 120) + 7; wrow0 = a0; nwin = a1 - a0 + 1; }
    if (MODE == 1) { const int k0 = max(4 * qi - 2, 0), k1 = min(4 * qi + 5, 127); wrow0 = k0; nwin = k1 - k0 + 1; }
    const int nsteps = 4 + nwin;
    int ra = 0, rb = -1, cs = 0, rq = 0, jq = 0, r0 = 0, cmin = 0;
    LAS const float* btab = (LAS const float*)(lds + AUX_OFF + 2048);
    if (MODE == 0) { ra = min(max(2 * rp - 4, 0), 120); rb = min(max(2 * rp - 3, 0), 120) + 7; cs = min(max(16 * mg - 8, 0), 32);
        rq = 2 * rp + (r31 >> 4); jq = 16 * mg + (r31 & 15); r0 = min(max(rq - 4, 0), 120); cmin = min(max(jq - 8, 0), 48) - cs;
        }
    const int lr = tid >> 3, lc = tid & 7;
    const bf16_t* kg = (const bf16_t*)(ws + WS_KH) + (size_t)kh * MTOT * 64 + 8 * tid;
    const bf16_t* vg = (const bf16_t*)(ws + WS_VT) + (size_t)kh * MTOT * 64 + 8 * tid;
    const int kdst = lr * 128 + 16 * (lc ^ ((lr >> 1) & 7));
    const int vdstb = 8192 + (8 * lc) * 128 + 2 * (lr & 3), vg4 = lr >> 2, vs4 = (4 * lc) & 15;
#define ROW_TOK(i) ((i) < 4 ? MLAT + b * CTXL + 64 * (i) : b * SEQ + 64 * (wrow0 + (i) - 4))
#define LOAD_ROW(i, kr_, vr_) do { const int t0_ = ROW_TOK(i); kr_ = *(const u32x4*)(kg + (size_t)t0_ * 64); vr_ = *(const u32x4*)(vg + (size_t)t0_ * 64); } while (0)
#define WRITE_ROW(sl_, kr_, vr_) do { *(LAS u32x4*)((sl_) + kdst) = kr_; \
        _Pragma("unroll") for (int j_ = 0; j_ < 8; ++j_) { const unsigned w_ = j_ < 2 ? vr_.x : (j_ < 4 ? vr_.y : (j_ < 6 ? vr_.z : vr_.w)); \
            *(LAS bf16_t*)((sl_) + vdstb + j_ * 128 + 8 * (vg4 ^ ((vs4 + (j_ >> 1)) & 15))) = (bf16_t)((j_ & 1) ? (w_ >> 16) : (w_ & 0xffffu)); } } while (0)
    u32x4 k0, v0, k1, v1, k2, v2;
    LOAD_ROW(0, k0, v0); LOAD_ROW(1, k2, v2);
    __syncthreads();
    if (MODE == 0 && tid < 465) ((LAS float*)(lds + AUX_OFF + 2048))[tid] = A.na_rpb[(size_t)(l * 6 + h) * 465 + tid] * LOG2E;
    WRITE_ROW(lds, k0, v0); WRITE_ROW(lds + 16384, k2, v2);
    __syncthreads();
#pragma unroll 1
    for (int pr = 0; pr < 2; ++pr) {
        { const int ra_ = pr == 0 ? 2 : min(4, nsteps - 1), rb_ = pr == 0 ? 3 : ra_; LOAD_ROW(ra_, k0, v0); LOAD_ROW(rb_, k2, v2); }
        attn_tile4(lds, lds + 16384, bq, o0, o1, m_run, l_run, r31, hh);
        __syncthreads();
        if (pr == 0) { WRITE_ROW(lds, k0, v0); WRITE_ROW(lds + 16384, k2, v2); } else if (nsteps > 4) { WRITE_ROW(lds, k0, v0); }
        __syncthreads();
    }
#define ATT_STEP(i_, kL, vL, kW, vW) do { const int i = (i_); if (i < nsteps) { \
        LAS const unsigned char* slot = lds + (i & 1) * 16384; \
        { const int ir_ = min(i + 1, nsteps - 1); LOAD_ROW(ir_, kL, vL); }     \
        bool use2 = false, use1 = false, um = false, um1 = false, ub = false; int c1 = 0, lo0 = 0, hi0 = 31, lo1 = 0, hi1 = 31, bidx = 0; \
        if (i < 4) use2 = true; \
        else if (MODE == 0) { const int a = wrow0 + i - 4; use1 = (a >= ra) && (a <= rb); const bool rowok = (a >= r0) && (a < r0 + 8); \
            c1 = cs; lo0 = rowok ? cmin : 1; hi0 = rowok ? cmin + 15 : 0; ub = true; um1 = true; bidx = (a - rq + 7) * 31 + (cs - jq + 15); } \
        else if (MODE == 1) { const int rel0 = (64 * (wrow0 + i - 4) - (32 * qg - 128)) >> 5, rel1 = rel0 + 1;     \
            const bool a0 = (rel0 >= 0) && (rel0 <= 8), a1 = (rel1 >= 0) && (rel1 <= 8); \
            if (a0 && a1) { use2 = true; um = (rel0 == 0) || (rel1 == 8); lo0 = rel0 == 0 ? r31 : 0; hi1 = rel1 == 8 ? r31 : 31; } \
            else if (a0) { use1 = true; um1 = (rel0 == 0) || (rel0 == 8); lo0 = rel0 == 0 ? r31 : 0; hi0 = rel0 == 8 ? r31 : 31; } \
            else if (a1) { use1 = true; c1 = 32; um1 = (rel1 == 0) || (rel1 == 8); lo0 = rel1 == 0 ? r31 : 0; hi0 = rel1 == 8 ? r31 : 31; } } \
        if (use2) attn_tile2(slot, bq, o0, o1, m_run, l_run, r31, hh, um, lo0, hi0, lo1, hi1); \
        if (use1) attn_tile(slot, c1, bq, o0, o1, m_run, l_run, r31, hh, um1, lo0, hi0, ub, btab, bidx); \
        if (i + 1 < nsteps) { LAS unsigned char* nslot = lds + ((i + 1) & 1) * 16384; WRITE_ROW(nslot, kW, vW); } \
        __syncthreads(); } } while (0)
#pragma unroll 1
    for (int i3 = 4; i3 < nsteps; ++i3) {
        ATT_STEP(i3, k1, v1, k1, v1);
    }
#undef ATT_STEP
#undef LOAD_ROW
#undef WRITE_ROW
    const float ltot = l_run + lane_xor(l_run, lane, 32);
    const float inv = 1.0f / ltot;
    const bf16_t* gp = PT + (size_t)qtok * NTM + gcol + 4 * hh;
    bf16_t* yp = Y + (size_t)qtok * DM + ycol + 4 * hh;
#pragma unroll
    for (int db = 0; db < 2; ++db)
#pragma unroll
        for (int g4 = 0; g4 < 4; ++g4) {
            const int d0 = 32 * db + 8 * g4;
            const u32x2 gw = *(const u32x2*)(gp + d0);
            float v0, v1, v2, v3;
            if (db == 0) { v0 = o0[4 * g4]; v1 = o0[4 * g4 + 1]; v2 = o0[4 * g4 + 2]; v3 = o0[4 * g4 + 3]; }
            else { v0 = o1[4 * g4]; v1 = o1[4 * g4 + 1]; v2 = o1[4 * g4 + 2]; v3 = o1[4 * g4 + 3]; }
            v0 *= inv * silu_f(bflo(gw.x)); v1 *= inv * silu_f(bfhi(gw.x)); v2 *= inv * silu_f(bflo(gw.y)); v3 *= inv * silu_f(bfhi(gw.y));
            u32x2 o; o.x = pk2(v0, v1); o.y = pk2(v2, v3);
            *(u32x2*)(yp + d0) = o;
        }
}

typedef float cf2 __attribute__((ext_vector_type(2)));
__device__ __forceinline__ cf2 mk2(float x, float y) { cf2 r; r.x = x; r.y = y; return r; }
__device__ __forceinline__ cf2 cmul(cf2 a, cf2 b) { const cf2 bs = mk2(-b.y, b.x); return a.xx * b + a.yy * bs; }
#define PA(e) ((e) + (((e) >> 4) << 1))
struct cf2x4 { cf2 a, b, c, d; };
__device__ __forceinline__ cf2x4 bfly4_fwd(cf2 x0, cf2 x1, cf2 x2, cf2 x3, float a) {
    const cf2 w1 = mk2(__builtin_amdgcn_cosf(a), -__builtin_amdgcn_sinf(a));
    const cf2 w2 = cmul(w1, w1), w3 = cmul(w2, w1);
    const cf2 s02 = x0 + x2, d02 = x0 - x2, s13 = x1 + x3, d13 = x1 - x3;
    cf2x4 r;
    r.a = s02 + s13;
    r.b = cmul(s02 - s13, w2);
    r.c = cmul(mk2(d02.x + d13.y, d02.y - d13.x), w1);
    r.d = cmul(mk2(d02.x - d13.y, d02.y + d13.x), w3);
    return r;
}
__device__ __forceinline__ cf2x4 bfly4_inv(cf2 v0, cf2 v1, cf2 v2, cf2 v3, float a) {
    const cf2 w1 = mk2(__builtin_amdgcn_cosf(a), __builtin_amdgcn_sinf(a));
    const cf2 w2 = cmul(w1, w1);
    const cf2 bb = cmul(v1, w2), dd = cmul(v3, w2);
    const cf2 u0 = v0 + bb, u1 = v0 - bb, u2 = v2 + dd, u3 = v2 - dd;
    const cf2 e = cmul(u2, w1), f0 = cmul(u3, w1);
    const cf2 f = mk2(-f0.y, f0.x);
    cf2x4 r; r.a = u0 + e; r.c = u0 - e; r.b = u1 + f; r.d = u1 - f; return r;
}
__device__ __forceinline__ void fft_fwd_fused(LAS cf2* buf, int tid, int lsb, bool zero_hi = false) {
    const int sB = 1 << lsb, s = 4 << lsb;
    const float ra = 1.0f / (float)(16 << lsb), rb = 1.0f / (float)(4 << lsb);
    int poff[4][4];
#pragma unroll
    for (int a = 0; a < 4; ++a)
#pragma unroll
        for (int b = 0; b < 4; ++b) { const int off = a * s + b * sB; poff[a][b] = PA(off); }
#pragma unroll 1
    for (int gg = 0; gg < 2; ++gg) {
        const int g = tid + 512 * gg, i = g & (sB - 1), base = ((g >> lsb) << (lsb + 4)) + i;
        const int pbase = PA(base);
        cf2 x[4][4];
#pragma unroll
        for (int a = 0; a < 4; ++a)
#pragma unroll
            for (int b = 0; b < 4; ++b) x[a][b] = (zero_hi && a >= 2) ? mk2(0.f, 0.f) : buf[pbase + poff[a][b]];
#pragma unroll
        for (int b = 0; b < 4; ++b) { const cf2x4 r = bfly4_fwd(x[0][b], x[1][b], x[2][b], x[3][b], (float)(i + b * sB) * ra); x[0][b] = r.a; x[1][b] = r.b; x[2][b] = r.c; x[3][b] = r.d; }
        const float ab = (float)i * rb;
#pragma unroll
        for (int a = 0; a < 4; ++a) { const cf2x4 r = bfly4_fwd(x[a][0], x[a][1], x[a][2], x[a][3], ab); x[a][0] = r.a; x[a][1] = r.b; x[a][2] = r.c; x[a][3] = r.d; }
#pragma unroll
        for (int a = 0; a < 4; ++a)
#pragma unroll
            for (int b = 0; b < 4; ++b) buf[pbase + poff[a][b]] = x[a][b];
    }
    __syncthreads();
}
__device__ __forceinline__ void fft_inv_fused(LAS cf2* buf, int tid, int lsb) {
    const int sB = 1 << lsb, s = 4 << lsb;
    const float ra = 1.0f / (float)(16 << lsb), rb = 1.0f / (float)(4 << lsb);
    int poff[4][4];
#pragma unroll
    for (int a = 0; a < 4; ++a)
#pragma unroll
        for (int b = 0; b < 4; ++b) { const int off = a * s + b * sB; poff[a][b] = PA(off); }
#pragma unroll 1
    for (int gg = 0; gg < 2; ++gg) {
        const int g = tid + 512 * gg, i = g & (sB - 1), base = ((g >> lsb) << (lsb + 4)) + i;
        const int pbase = PA(base);
        cf2 x[4][4];
#pragma unroll
        for (int a = 0; a < 4; ++a)
#pragma unroll
            for (int b = 0; b < 4; ++b) x[a][b] = buf[pbase + poff[a][b]];
        const float ab = (float)i * rb;
#pragma unroll
        for (int a = 0; a < 4; ++a) { const cf2x4 r = bfly4_inv(x[a][0], x[a][1], x[a][2], x[a][3], ab); x[a][0] = r.a; x[a][1] = r.b; x[a][2] = r.c; x[a][3] = r.d; }
#pragma unroll
        for (int b = 0; b < 4; ++b) { const cf2x4 r = bfly4_inv(x[0][b], x[1][b], x[2][b], x[3][b], (float)(i + b * sB) * ra); x[0][b] = r.a; x[1][b] = r.b; x[2][b] = r.c; x[3][b] = r.d; }
#pragma unroll
        for (int a = 0; a < 4; ++a)
#pragma unroll
            for (int b = 0; b < 4; ++b) buf[pbase + poff[a][b]] = x[a][b];
    }
    __syncthreads();
}
__device__ __forceinline__ void fft_fwd(LAS cf2* buf, int tid, const unsigned* zk = nullptr, bool zero_hi = false) {
#pragma unroll 1
    for (int lsb = 10; lsb >= 2; lsb -= 4) fft_fwd_fused(buf, tid, lsb, zero_hi && lsb == 10);
#pragma unroll 4
    for (int k = 0; k < 8; ++k) {
        const int e0 = 4 * (tid + 512 * k), base = PA(e0);
        cf2 x0 = buf[base], x1 = buf[base + 1], x2 = buf[base + 2], x3 = buf[base + 3];
        const cf2 s02 = x0 + x2, d02 = x0 - x2, s13 = x1 + x3, d13 = x1 - x3;
        cf2 y0 = s02 + s13, y1 = s02 - s13, y2 = mk2(d02.x + d13.y, d02.y - d13.x), y3 = mk2(d02.x - d13.y, d02.y + d13.x);
        if (zk) { const u32x4 w = *(const u32x4*)(zk + (unsigned)e0);
            y0 = cmul(y0, mk2(bflo(w.x), bfhi(w.x))); y1 = cmul(y1, mk2(bflo(w.y), bfhi(w.y))); y2 = cmul(y2, mk2(bflo(w.z), bfhi(w.z))); y3 = cmul(y3, mk2(bflo(w.w), bfhi(w.w))); }
        buf[base] = y0; buf[base + 1] = y1; buf[base + 2] = y2; buf[base + 3] = y3;
    }
    __syncthreads();
}
__device__ __forceinline__ void fft_inv(LAS cf2* buf, int tid) {
#pragma unroll 1
    for (int lsb = 0; lsb <= 8; lsb += 4) fft_inv_fused(buf, tid, lsb);
#pragma unroll 4
    for (int k = 0; k < 8; ++k) {
        const int i = tid + 512 * k, pi = PA(tid) + 576 * k;
        cf2 v0 = buf[pi], v1 = buf[pi + 4608], v2 = buf[pi + 9216], v3 = buf[pi + 13824];
        const cf2x4 r = bfly4_inv(v0, v1, v2, v3, (float)i * (1.0f / 16384.0f));
        buf[pi] = r.a; buf[pi + 4608] = r.b;
    }
    __syncthreads();
}
__device__ __forceinline__ float hy_short(const bf16_t* prow, int tb, int t, int L, float w0, float w1, float w2, float bias) {
    const float pm = t > 0 ? bf2f(prow[tb + t - 1]) : 0.f;
    const float pc = bf2f(prow[tb + t]);
    const float pp = t < L - 1 ? bf2f(prow[tb + t + 1]) : 0.f;
    return w0 * pm + w1 * pc + w2 * pp + bias;
}
__device__ __forceinline__ float block_sum(float v, LAS float* red, int tid) {
    v = wave_sum(v, tid & 63);
    __syncthreads();
    if ((tid & 63) == 0) red[tid >> 6] = v;
    __syncthreads();
    float s = 0.f;
#pragma unroll
    for (int w = 0; w < 8; ++w) s += red[w];
    return s;
}

__device__ __forceinline__ void hyena_block(CKArgs& A, int l, int c, LAS unsigned char* lds, int tid) {
    asm volatile("" : "+v"(tid));
    unsigned char* ws = A.ws;
    LAS cf2* buf = (LAS cf2*)lds;
    LAS float* fs = (LAS float*)lds;
    LAS float* aux = (LAS float*)(lds + AUX_OFF);
    LAS float* red = aux + 256;
    const bf16_t* PCT = (const bf16_t*)(ws + WS_PCT);
    bf16_t* YBT = (bf16_t*)(ws + WS_YBT);
    const bf16_t* rowz = PCT + (size_t)(R_HZ + c) * MTOT;
    const bf16_t* rowx1 = rowz + (size_t)256 * MTOT;
    const bf16_t* rowx2 = rowz + (size_t)512 * MTOT;
    const bf16_t* rowg = PCT + (size_t)(R_GB + c) * MTOT;
    const float* cw = A.hy_conv_w + (size_t)l * 3 * 768; const float* cb = A.hy_conv_b + (size_t)l * 768;
    const float wz0 = cw[c], wz1 = cw[768 + c], wz2 = cw[1536 + c], bz = cb[c];
    const float wa0 = cw[256 + c], wa1 = cw[768 + 256 + c], wa2 = cw[1536 + 256 + c], ba = cb[256 + c];
    const float wb0 = cw[512 + c], wb1 = cw[768 + 512 + c], wb2 = cw[1536 + 512 + c], bb = cb[512 + c];
    const float d0 = A.hy_d[(l * 2 + 0) * 256 + c], d1 = A.hy_d[(l * 2 + 1) * 256 + c];
    const float dmin = -3.0701134573253945f, dmax = -15.350567286626973f;
    const float delta = fabsf(dmin + (float)c * ((dmax - dmin) / 255.0f));
    __syncthreads();
    if (tid < 256) { const int k = tid >> 6, j = tid & 63; aux[tid] = A.hy_w3[((size_t)l * 64 + j) * 1024 + k * 256 + c]; }
    __syncthreads();

    if (l < DEPTH - 1) {
        float ss0 = 0.f, ss1 = 0.f;
        if (tid < 256) {
            const int n = tid; const f32x4* hr = (const f32x4*)((const float*)(ws + WS_H2C) + ((size_t)l * CTXL + n) * 64);
            float f0 = 0.f, f1 = 0.f, b0 = 0.f, b1 = 0.f;
#pragma unroll 1
            for (int j4 = 0; j4 < 16; ++j4) { const f32x4 hv = hr[j4];
#pragma unroll
                for (int e = 0; e < 4; ++e) { const float hvv = hv[e]; const int j = 4 * j4 + e; f0 += hvv * aux[j]; f1 += hvv * aux[64 + j]; b0 += hvv * aux[128 + j]; b1 += hvv * aux[192 + j]; } }
            const float e = __expf(-((float)n * (1.0f / 255.0f)) * delta);
            f0 *= e; f1 *= e; b0 *= e; b1 *= e;
            fs[255 + n] = f0; fs[512 + 255 + n] = f1;
            if (n >= 1) { fs[255 - n] = b0; fs[512 + 255 - n] = b1; }
            ss0 = f0 * f0 + (n >= 1 ? b0 * b0 : 0.f); ss1 = f1 * f1 + (n >= 1 ? b1 * b1 : 0.f);
        }
        if (tid == 0) { fs[511] = 0.f; fs[1023] = 0.f; }
        const int b = tid >> 8, t = tid & 255, tok = MLAT + b * CTXL;
        const float z = hy_short(rowz, tok, t, CTXL, wz0, wz1, wz2, bz);
        const float x1 = hy_short(rowx1, tok, t, CTXL, wa0, wa1, wa2, ba);
        const float x2 = hy_short(rowx2, tok, t, CTXL, wb0, wb1, wb2, bb);
        const float gb = bf2f(rowg[tok + t]);
        fs[1024 + tid] = z;
        const float n0 = rsqrtf(block_sum(ss0, red, tid) + 1e-6f);
        const float n1 = rsqrtf(block_sum(ss1, red, tid) + 1e-6f);
        __syncthreads();
        float y = 0.f;
        { LAS const float* kc = fs + 255 + t; LAS const float* zz = fs + 1024 + b * 256;
#pragma unroll 8
          for (int s = 0; s < 256; ++s) y += zz[s] * kc[-s]; }
        const float z1 = x1 * (y * n0 + d0 * z);
        fs[1536 + tid] = z1;
        __syncthreads();
        float y2 = 0.f;
        { LAS const float* kc = fs + 512 + 255 + t; LAS const float* zz = fs + 1536 + b * 256;
#pragma unroll 8
          for (int s = 0; s < 256; ++s) y2 += zz[s] * kc[-s]; }
        const float o = x2 * (y2 * n1 + d1 * z1) * silu_f(gb);
        YBT[(size_t)c * MTOT + tok + t] = (bf16_t)(pk2(o, 0.f) & 0xffffu);
        __syncthreads();
    }

    unsigned* ZK = (unsigned*)(ws + WS_ZS) + (size_t)c * 2 * NFFT;
    const int lane = tid & 63;
    {
        float ss0 = 0.f, ss1 = 0.f;
        const bf16_t* F0 = (const bf16_t*)(ws + WS_FILT) + (size_t)c * SEQ;
#pragma unroll 4
        for (int k = 0; k < 16; ++k) {
            const int n = tid + 512 * k;
            const float e = __expf(-((float)n * (1.0f / 8191.0f)) * delta);
            const float f0 = bf2f(F0[n]) * e, f1 = bf2f(F0[(size_t)256 * SEQ + n]) * e, b0 = bf2f(F0[(size_t)512 * SEQ + n]) * e, b1 = bf2f(F0[(size_t)768 * SEQ + n]) * e;
            buf[PA(n)] = mk2(f0, f1); ss0 += f0 * f0; ss1 += f1 * f1;
            if (n >= 1) { buf[PA(NFFT - n)] = mk2(b0, b1); ss0 += b0 * b0; ss1 += b1 * b1; }
        }
        if (tid == 0) { const float zf = delta * 0.0f; buf[PA(SEQ)] = mk2(zf, zf); }
        const float nrm0 = rsqrtf(block_sum(ss0, red, tid) + 1e-6f) * (0.5f / NFFT);
        const float nrm1 = rsqrtf(block_sum(ss1, red, tid) + 1e-6f) * (0.5f / NFFT);
        __syncthreads();
        fft_fwd(buf, tid);
#pragma unroll 4
        for (int k = 0; k < 32; ++k) {
            const int p = tid + 512 * k; const int f = (int)(__brev((unsigned)p) >> 18); const int pp = (int)(__brev((unsigned)((NFFT - f) & (NFFT - 1))) >> 18);
            const cf2 za = buf[PA(p)], zb = buf[PA(pp)];
            ZK[p] = pk2((za.x + zb.x) * nrm0 + d0 * (1.0f / NFFT), (za.y - zb.y) * nrm0);
            ZK[NFFT + p] = pk2((za.y + zb.y) * nrm1 + d1 * (1.0f / NFFT), -(za.x - zb.x) * nrm1);
        }
        __syncthreads();
    }
    const int wv = __builtin_amdgcn_readfirstlane(tid >> 6), tw0 = wv * 1024 + lane, ptw = PA(tw0), ptid = PA(tid);
#define HY_ROW8(prow_, tb_, kb_, w0_, w1_, w2_, bias_, u_) do { \
        float own_[8]; const int p0_ = wv * 1024 + 64 * (kb_); \
        _Pragma("unroll") for (int k = 0; k < 8; ++k) own_[k] = bf2f((prow_)[(unsigned)((tb_) + p0_ + lane + 64 * k)]); \
        const float ep_ = p0_ > 0 ? bf2f((prow_)[(unsigned)((tb_) + p0_ - 1)]) : 0.f, en_ = p0_ + 512 < SEQ ? bf2f((prow_)[(unsigned)((tb_) + p0_ + 512)]) : 0.f; \
        _Pragma("unroll") for (int k = 0; k < 8; ++k) { const float a_ = lane_prev(own_[k], lane), b_ = lane_next(own_[k], lane); \
            const float pl_ = k > 0 ? rdlane(own_[k > 0 ? k - 1 : 0], 63) : ep_, nl_ = k < 7 ? rdlane(own_[k < 7 ? k + 1 : 7], 0) : en_; \
            const float m_ = lane == 0 ? pl_ : a_, q_ = lane == 63 ? nl_ : b_; (u_)[(kb_) + k] = (w0_) * m_ + (w1_) * own_[k] + (w2_) * q_ + (bias_); } \
        asm volatile("" ::: "memory"); __builtin_amdgcn_sched_barrier(0); } while (0)
#pragma unroll
    for (int hf = 0; hf < 2; ++hf) {
        float ua[16], ub[16];
        HY_ROW8(rowz, 0, 8 * hf, wz0, wz1, wz2, bz, ua);
        HY_ROW8(rowz, SEQ, 8 * hf, wz0, wz1, wz2, bz, ub);
#pragma unroll
        for (int k = 8 * hf; k < 8 * hf + 8; ++k) { const int t = tw0 + 64 * k; buf[ptw + 72 * k] = mk2(ua[k], ub[k]); }
        __builtin_amdgcn_sched_barrier(0);
    }
    __syncthreads();
    fft_fwd(buf, tid, ZK, true);
    fft_inv(buf, tid);
#pragma unroll
    for (int hf = 0; hf < 2; ++hf) {
        float xa[16], xb[16];
        HY_ROW8(rowx1, 0, 8 * hf, wa0, wa1, wa2, ba, xa);
        HY_ROW8(rowx1, SEQ, 8 * hf, wa0, wa1, wa2, ba, xb);
#pragma unroll
        for (int k = 8 * hf; k < 8 * hf + 8; ++k) { const int t = tw0 + 64 * k; const cf2 y = buf[ptw + 72 * k]; buf[ptw + 72 * k] = mk2(xa[k] * y.x, xb[k] * y.y); }
        __builtin_amdgcn_sched_barrier(0);
    }
    __syncthreads();
    fft_fwd(buf, tid, ZK + NFFT, true);
    fft_inv(buf, tid);
    {
        bf16_t* yrow = YBT + (size_t)c * MTOT;
#pragma unroll
        for (int hf = 0; hf < 2; ++hf) {
            float xa[16], xb[16], ga[8], gb[8];
#pragma unroll
            for (int k = 0; k < 8; ++k) { ga[k] = bf2f(rowg[(unsigned)(tw0 + 64 * (8 * hf + k))]); gb[k] = bf2f(rowg[(unsigned)(SEQ + tw0 + 64 * (8 * hf + k))]); }
            HY_ROW8(rowx2, 0, 8 * hf, wb0, wb1, wb2, bb, xa);
            HY_ROW8(rowx2, SEQ, 8 * hf, wb0, wb1, wb2, bb, xb);
#pragma unroll
            for (int k = 8 * hf; k < 8 * hf + 8; ++k) { const int t = tw0 + 64 * k; const cf2 y = buf[ptw + 72 * k];
                const float oa = xa[k] * y.x * silu_f(ga[k - 8 * hf]), ob = xb[k] * y.y * silu_f(gb[k - 8 * hf]);
                yrow[(unsigned)t] = (bf16_t)(pk2(oa, 0.f) & 0xffffu); yrow[(unsigned)(SEQ + t)] = (bf16_t)(pk2(ob, 0.f) & 0xffffu); }
            __builtin_amdgcn_sched_barrier(0);
        }
    }
#undef HY_ROW8
    __syncthreads();
}

__device__ __forceinline__ void phase_mix(CKArgs& A, int l, LAS unsigned char* lds, int bid, int nblk, int tid) {
    for (int c = bid; c < 256; c += nblk) hyena_block(A, l, c, lds, tid);
    const int nctx = (l < DEPTH - 1) ? 12 : 0;
    const int nitems = 768 + 2 * nctx;
#pragma unroll 1
    for (int it = bid; it < nitems; it += nblk) {
        int mode, item;
        if (it < 384) { mode = 0; item = it; } else if (it < 768) { mode = 1; item = it - 384; } else if (it < 768 + nctx) { mode = 2; item = it - 768; } else { mode = 3; item = it - 768 - nctx; }
        attn_block_item(A, l, mode, item, lds, tid);
    }
}

__device__ __forceinline__ void phase_tr(CKArgs& A, int l, LAS unsigned char* lds, int bid, int nblk, int tid) {
    const int wave = __builtin_amdgcn_readfirstlane(tid >> 6), lane = tid & 63;
    const int gw = bid * 8 + wave, NGW = nblk * 8;
    unsigned char* ws = A.ws;
    const bf16_t* YBT = (const bf16_t*)(ws + WS_YBT);
    bf16_t* Y = (bf16_t*)(ws + WS_HY);
    LAS bf16_t* scr = (LAS bf16_t*)(lds + wave * 16384);
    const int ntok = (l < DEPTH - 1) ? MTOT : MLAT;
    const int nitems = (ntok / 64) * 4;
#pragma unroll 1
    for (int it = gw; it < nitems; it += NGW) {
        const int tb = (it >> 2) * 64, cb = (it & 3) * 64;
#pragma unroll 8
        for (int i = 0; i < 64; ++i) scr[i * 66 + lane] = YBT[(size_t)(cb + i) * MTOT + tb + lane];
        asm volatile("s_waitcnt lgkmcnt(0)" ::: "memory");
        const int cc = (lane & 7) * 8;
#pragma unroll
        for (int k = 0; k < 8; ++k) {
            const int tq = (lane >> 3) + 8 * k;
            u32x4 o;
            o.x = (unsigned)scr[(cc + 0) * 66 + tq] | ((unsigned)scr[(cc + 1) * 66 + tq] << 16);
            o.y = (unsigned)scr[(cc + 2) * 66 + tq] | ((unsigned)scr[(cc + 3) * 66 + tq] << 16);
            o.z = (unsigned)scr[(cc + 4) * 66 + tq] | ((unsigned)scr[(cc + 5) * 66 + tq] << 16);
            o.w = (unsigned)scr[(cc + 6) * 66 + tq] | ((unsigned)scr[(cc + 7) * 66 + tq] << 16);
            *(u32x4*)(Y + (size_t)(tb + tq) * DM + 384 + cb + cc) = o;
        }
        asm volatile("s_waitcnt lgkmcnt(0)" ::: "memory");
    }
}

__device__ __forceinline__ void phase_final(CKArgs& A, int bid, int nblk, int tid) {
    const int wave = __builtin_amdgcn_readfirstlane(tid >> 6), lane = tid & 63;
    const int gw = bid * 8 + wave, NGW = nblk * 8;
    for (int m = gw; m < MLAT; m += NGW) {
        float* row = A.out + (size_t)m * DM;
        f32x4 xv[4]; float ss = 0.f;
#pragma unroll
        for (int j = 0; j < 4; ++j) { xv[j] = *(const f32x4*)(row + 4 * lane + 256 * j); ss += (xv[j].x * xv[j].x + xv[j].y * xv[j].y) + (xv[j].z * xv[j].z + xv[j].w * xv[j].w); }
        const float rinv = rsqrtf(wave_sum(ss, lane) * (1.0f / DM) + 1e-6f);
#pragma unroll
        for (int j = 0; j < 4; ++j) { const int col = 4 * lane + 256 * j; const f32x4 gv = *(const f32x4*)(A.final_g + col); *(f32x4*)(row + col) = xv[j] * rinv * gv; }
    }
}

#define XB_TMO      128
#define XB_XCNT(j)  (256  + 64 * (j))
#define XB_XSUB(j)  (1280 + 64 * (j))
#define XB_XGEN(j)  (2304 + 64 * (j))
#define XB_TOP      3328
#define XB_TOPGEN   3392
#define XCD_BAR_WORDS 3456
#define XB_SPIN_CAP (1u << 18)

__device__ __forceinline__ unsigned xb_ld(unsigned* p)              { return __hip_atomic_load(p, __ATOMIC_RELAXED, __HIP_MEMORY_SCOPE_AGENT); }
__device__ __forceinline__ unsigned xb_add(unsigned* p, unsigned v) { return __hip_atomic_fetch_add(p, v, __ATOMIC_RELAXED, __HIP_MEMORY_SCOPE_AGENT); }
__device__ __forceinline__ unsigned xb_xcc_id() { return (unsigned)__builtin_amdgcn_s_getreg((3 << 11) | 20) & 0xFu; }
#define XB_SPIN(cond, bar) do { unsigned _sp = 0; while (cond) { __builtin_amdgcn_s_sleep(1); \
    if ((++_sp & 255u) == 0u) { if (xb_ld(&(bar)[XB_TMO])) break; if (_sp > XB_SPIN_CAP) { atomicAdd(&(bar)[XB_TMO], 1u); break; } } } } while (0)

struct XcdBarrier {
    unsigned* bar; unsigned x;
    volatile LAS unsigned* st;
};

__device__ __forceinline__ XcdBarrier xcd_barrier_post(unsigned* bar, volatile LAS unsigned* st) {
    XcdBarrier b; b.bar = bar; b.x = xb_xcc_id(); b.st = st;
    if (threadIdx.x == 0) (void)xb_add(&bar[XB_XCNT(b.x)], 1u);
    return b;
}
__device__ __forceinline__ void xcd_barrier_complete(unsigned* bar, unsigned x, unsigned& nloc, unsigned& nx) {
    const unsigned G = gridDim.x * gridDim.y * gridDim.z;
    unsigned sum, cnt, mine, sp = 0u;
    for (;;) {
        sum = 0u; cnt = 0u; mine = 0u;
#pragma unroll
        for (unsigned j = 0; j < 16; ++j) { const unsigned c = xb_ld(&bar[XB_XCNT(j)]); sum += c; cnt += (c > 0u) ? 1u : 0u; mine = (j == x) ? c : mine; }
        if (sum == G) break;
        __builtin_amdgcn_s_sleep(1);
        if ((++sp & 255u) == 0u) { if (xb_ld(&bar[XB_TMO])) break; if (sp > XB_SPIN_CAP) { atomicAdd(&bar[XB_TMO], 1u); break; } }
    }
    nloc = mine > 0u ? mine : 1u; nx = cnt > 0u ? cnt : 1u;
}

__device__ __forceinline__ void xcd_barrier(const XcdBarrier& b) {
    asm volatile("s_waitcnt vmcnt(0)" ::: "memory");
    __syncthreads();
    if (threadIdx.x == 0) {
        unsigned* bar = b.bar;
        __builtin_amdgcn_s_waitcnt(0);
        unsigned nloc = b.st[0], nx = b.st[1];
        if (nloc == 0u) { xcd_barrier_complete(bar, b.x, nloc, nx); b.st[0] = nloc; b.st[1] = nx; }
        const unsigned old = xb_add(&bar[XB_XSUB(b.x)], 1u);
        const unsigned gen = old / nloc;
        if (old + 1u == (gen + 1u) * nloc) {
            __builtin_amdgcn_fence(__ATOMIC_RELEASE, "agent");
            asm volatile("s_waitcnt vmcnt(0)" ::: "memory");
            const unsigned og = xb_add(&bar[XB_TOP], 1u);
            const unsigned tg = og / nx;
            if (og + 1u == (tg + 1u) * nx) xb_add(&bar[XB_TOPGEN], 1u);
            else XB_SPIN(xb_ld(&bar[XB_TOPGEN]) == tg, bar);
            __builtin_amdgcn_fence(__ATOMIC_ACQUIRE, "agent");
            xb_add(&bar[XB_XGEN(b.x)], 1u);
            asm volatile("s_waitcnt vmcnt(0)" ::: "memory");
        } else {
            XB_SPIN(xb_ld(&bar[XB_XGEN(b.x)]) == gen, bar);
            __builtin_amdgcn_fence(__ATOMIC_ACQUIRE, "agent");
            asm volatile("s_waitcnt vmcnt(0)" ::: "memory");
        }
    }
    __syncthreads();
}


constexpr int NPHASE = 2 + 5 * DEPTH;
__global__ void __launch_bounds__(NTHREADS, 2) hybrid_fwd(KArgs Aval) {
    extern __shared__ __attribute__((aligned(16))) unsigned char lds_raw[];
    LAS unsigned char* lds = (LAS unsigned char*)lds_raw;
    const int tid0 = threadIdx.x, bid = blockIdx.x, nblk = gridDim.x;
#if !MK_MULTI
    volatile LAS unsigned* bst = (volatile LAS unsigned*)(lds + AUX_OFF + 8192);
    if (tid0 < 2) bst[tid0] = 0u;
    __syncthreads();
    const XcdBarrier bar = xcd_barrier_post((unsigned*)Aval.ws, bst);
#endif
#ifndef REP_PH
#define REP_PH 1000
#endif
#pragma unroll 1
    for (int pi = Aval.ph_lo; pi < Aval.ph_hi + (REP_PH < 1000 ? 1 : 0); ++pi) {
        const int ph = pi <= REP_PH ? pi : pi - 1;
#if !MK_MULTI
        if (pi > Aval.ph_lo) { if (Aval.ph_hi > 100000) cg::this_grid().sync(); else xcd_barrier(bar); }
#endif
#ifndef ONLY
#define ONLY -1
#endif
#define EN(k) (ONLY < 0 || ((ONLY >> (k)) & 1))
        int tid = tid0; asm volatile("" : "+v"(tid));
        CKArgs* Ap = (CKArgs*)__builtin_amdgcn_kernarg_segment_ptr(); asm volatile("" : "+s"(Ap));
        CKArgs& A = *Ap;
        unsigned char* ws = A.ws;
        if (ph == 0) { if (EN(0)) phase_prologue(A, lds, bid, nblk, tid); }
        else if (ph == NPHASE - 1) { if (EN(6)) phase_final(A, bid, nblk, tid); }
        else {
            const int l = (ph - 1) / 5, k = (ph - 1) % 5;
            if (k == 0) { if (EN(1)) phase_norm(A, l, bid, nblk, tid); }
            else if (k == 2) { if (EN(3)) phase_mix(A, l, lds, bid, nblk, tid); }
            else if (k == 3) { if (EN(4)) phase_tr(A, l, lds, bid, nblk, tid); }
            if (k == 1 || k == 4) {
                pg8::Gemm g; EpiAll E; E.l = l; E.Ap = Ap; g.A = (const bf16_t*)(ws + WS_HY); g.K = DM;
                if (k == 1) { g.Bt = (const bf16_t*)(ws + WS_WIN) + (size_t)l * NIN * DM; g.M = MTOT; g.N = NIN; E.mode = 0; }
                else { g.Bt = (const bf16_t*)(ws + WS_WOUT) + (size_t)l * DM * DM; g.M = MLAT; g.N = DM; E.mode = 1; }
                pg8::StaticOrder S; S.init(g.M, g.N, nblk, bid);
                if (EN(2)) pg8::gemm_phase<EpiAll, pg8::StaticOrder, true, true>(lds, g, S, E, tid);
                if (k == 4 && l < DEPTH - 1) { ctx_outproj_items(A, l, tid, bid, nblk); filt_items(A, l + 1, tid, bid, nblk, nullptr); }
            }
        }
    }
}

extern "C" void kernel_launch(void* const* d_in, const int* in_sizes, int n_in, void* d_out, int out_size, void* d_ws, size_t ws_size, hipStream_t stream) {
    static int grid = 0;
    if (grid == 0) {
        if (n_in != 22 || ws_size < WS_END) { fprintf(stderr, "kernel_launch: unexpected inputs (n_in %d, ws %zu)\n", n_in, ws_size); grid = -1; return; }
        int dev = 0, cus = 0, per_cu = 0;
        if (hipGetDevice(&dev) != hipSuccess || hipDeviceGetAttribute(&cus, hipDeviceAttributeMultiprocessorCount, dev) != hipSuccess) { grid = -1; return; }
        if (hipFuncSetAttribute((const void*)hybrid_fwd, hipFuncAttributeMaxDynamicSharedMemorySize, LDS_BYTES) != hipSuccess) { fprintf(stderr, "kernel_launch: hipFuncSetAttribute failed\n"); grid = -1; return; }
        if (hipOccupancyMaxActiveBlocksPerMultiprocessor(&per_cu, (const void*)hybrid_fwd, NTHREADS, LDS_BYTES) != hipSuccess || per_cu < 1) { fprintf(stderr, "kernel_launch: occupancy query says %d\n", per_cu); per_cu = 1; }
        (void)hipGetLastError();
        grid = cus;
    }
    if (grid < 0) return;
    KArgs a{};
    a.x = (const float*)d_in[0]; a.c = (const float*)d_in[1]; a.ctx = (const float*)d_in[2]; a.c_ctx = (const float*)d_in[3]; a.norm_g = (const float*)d_in[4];
    a.w_ada = (const float*)d_in[5]; a.b_ada = (const float*)d_in[6]; a.w_in = (const float*)d_in[7]; a.w_out = (const float*)d_in[8]; a.na_rpb = (const float*)d_in[9];
    a.hy_conv_w = (const float*)d_in[10]; a.hy_conv_b = (const float*)d_in[11]; a.hy_w1 = (const float*)d_in[12]; a.hy_b1 = (const float*)d_in[13]; a.hy_freq1 = (const float*)d_in[14];
    a.hy_w2 = (const float*)d_in[15]; a.hy_b2 = (const float*)d_in[16]; a.hy_freq2 = (const float*)d_in[17]; a.hy_w3 = (const float*)d_in[18]; a.hy_d = (const float*)d_in[19];
    a.sink = (const float*)d_in[20]; a.final_g = (const float*)d_in[21];
    a.out = (float*)d_out; a.ws = (unsigned char*)d_ws;
#if MK_MULTI
    for (int ph = 0; ph < NPHASE; ++ph) {
        a.ph_lo = ph; a.ph_hi = ph + 1;
        hipLaunchKernelGGL(hybrid_fwd, dim3(grid), dim3(NTHREADS), LDS_BYTES, stream, a);
    }
#else
    if (hipMemsetAsync(d_ws, 0, 16384, stream) != hipSuccess) { fprintf(stderr, "kernel_launch: memset of the barrier words failed\n"); return; }
    a.ph_lo = 0; a.ph_hi = NPHASE;
    void* args[] = {&a};
    hipError_t e = hipLaunchCooperativeKernel((const void*)hybrid_fwd, dim3(grid), dim3(NTHREADS), args, LDS_BYTES, stream);
    if (e != hipSuccess) fprintf(stderr, "cooperative launch failed: %s (grid %d)\n", hipGetErrorString(e), grid);
#endif
}
```

```cpp
#include <hip/hip_runtime.h>
#include <hip/hip_cooperative_groups.h>
#include <cstdio>
#include <cstdint>
namespace cg = cooperative_groups;

#ifndef MK_MULTI
#define MK_MULTI 0
#endif

namespace pg8 {
#define PG8_LAS __attribute__((address_space(3)))
typedef unsigned short bf16_t;
typedef short bf16x8 __attribute__((ext_vector_type(8)));
typedef float f32x4 __attribute__((ext_vector_type(4)));
typedef unsigned u32x4 __attribute__((ext_vector_type(4)));
constexpr int BM = 256, BK = 64, HALF = 128, HTB = HALF * BK * 2  , STAGE_BYTES = 8 * HTB, NXCD = 8, WGM = 8;

__host__ __device__ __forceinline__ int lds_byte(int r, int c) { const int st = (r >> 4) * 2 + (c >> 5), rr = r & 15, cc = c & 31, ob = rr * 64 + cc * 2; return st * 1024 + (ob ^ (((ob >> 9) & 1) << 5)); }
__host__ __device__ __forceinline__ void stage_rc(int b, int& R, int& C) { const int st = b / 1024, sb = b % 1024, swz = sb ^ (((sb >> 9) & 1) << 5); R = (st >> 1) * 16 + swz / 64; C = (st & 1) * 32 + (swz % 64) / 2; }
__host__ __device__ __forceinline__ int perm32(int rho) { const int n = rho >> 4, i = rho & 15; return 8 * (i >> 2) + 4 * n + (i & 3); }

struct Unit { int pm, pn; };
struct Gemm { const bf16_t* A; const bf16_t* Bt; int M, N, K; };

struct StaticOrder {
    int nM, nN, nwg, G, c;
    __host__ __device__ void init(int M, int N, int G_, int c_) { nM = M / BM; nN = N / BM; nwg = nM * nN; G = G_; c = c_; }
    __host__ __device__ bool next(int i, Unit& u) const {
        const long L = (long)i * G + c; if (L >= nwg) return false;
        int wgid = (int)L; { const int q = nwg / NXCD, r = nwg % NXCD, xcd = wgid % NXCD, off = wgid / NXCD; wgid = (xcd < r ? xcd * (q + 1) : r * (q + 1) + (xcd - r) * q) + off; }
        const int nig = WGM * nN, gid = wgid / nig, fm = gid * WGM, gsz = (nM - fm) < WGM ? (nM - fm) : WGM;
        u.pm = fm + ((wgid % nig) % gsz); u.pn = (wgid % nig) / gsz; return true;
    }
    __device__ __forceinline__ void a_ready(const Unit&) const {}
    __device__ __forceinline__ void done(const Unit&) const {}
};

template <class Epi, class Sched, bool ALIGN_EPI = false, bool SP2 = false>
__device__ __forceinline__ void gemm_phase(PG8_LAS unsigned char* lds, const Gemm g, const Sched& S, const Epi& E, const int tid) {
    const int wid = __builtin_amdgcn_readfirstlane(tid >> 6), lane = tid & 63, wr = wid >> 2, wc = wid & 3, fr = lane & 15, fq = lane >> 4;
    const int K = g.K, nt = K / BK;
    unsigned voffA[2], voffB[2];
#pragma unroll
    for (int i = 0; i < 2; ++i) { int R, C; stage_rc(tid * 16 + i * 8192, R, C); const int Rb = Epi::PERM ? ((R & ~31) + perm32(R & 31)) : R;
        voffA[i] = (unsigned)(R * K + C) * 2u; voffB[i] = (unsigned)(Rb * K + C) * 2u; }
    const size_t kstep = (size_t)(BK * 2);
    const size_t hstep = (size_t)HALF * K * 2;
    const size_t tstep = 2 * hstep;
    const unsigned ldsw = (unsigned)wid * 1024u;
    const int aoff = lds_byte(wr * 64 + fr, fq * 8), boff = lds_byte(wc * 32 + fr, fq * 8);
#define PG8_SA(b, h) (((b) * 2 + (h)) * HTB)
#define PG8_SB(b, h) ((4 + (b) * 2 + (h)) * HTB)
#define PG8_STAGE(bufoff, gbase, voff) do { _Pragma("unroll") for (int _i = 0; _i < 2; ++_i) \
        __builtin_amdgcn_global_load_lds((const unsigned*)((const char*)(gbase) + (voff)[_i]), (PG8_LAS unsigned*)(lds + (bufoff) + ldsw + _i * 8192), 16, 0, 0); } while (0)
#define PG8_LDA(dst, b, h) do { _Pragma("unroll") for (int m = 0; m < 4; ++m) _Pragma("unroll") for (int k = 0; k < 2; ++k) dst[m][k] = *(const PG8_LAS bf16x8*)(lds + PG8_SA(b, h) + aoff + m * 2048 + k * 1024); } while (0)
#define PG8_LDB(dst, b, h) do { _Pragma("unroll") for (int n = 0; n < 2; ++n) _Pragma("unroll") for (int k = 0; k < 2; ++k) dst[n][k] = *(const PG8_LAS bf16x8*)(lds + PG8_SB(b, h) + boff + n * 2048 + k * 1024); } while (0)
#define PG8_MMA(ai, bj, At, Bt) do { __builtin_amdgcn_s_setprio(1); _Pragma("unroll") for (int m = 0; m < 4; ++m) _Pragma("unroll") for (int n = 0; n < 2; ++n) _Pragma("unroll") for (int k = 0; k < 2; ++k) \
        acc[ai][bj][m][n] = __builtin_amdgcn_mfma_f32_16x16x32_bf16(Bt[n][k], At[m][k], acc[ai][bj][m][n], 0, 0, 0); __builtin_amdgcn_s_setprio(0); } while (0)
#define PG8_WAIT_V(n) asm volatile("s_waitcnt vmcnt(" #n ")" ::: "memory")
#define PG8_WAIT_L(n) asm volatile("s_waitcnt lgkmcnt(" #n ")" ::: "memory")
#define PG8_BAR __builtin_amdgcn_s_barrier()
#define PG8_SCHED __builtin_amdgcn_sched_barrier(0)
    Unit cur, nxt; int ui = 0;
    if (!S.next(0, cur)) return;
    f32x4 acc[2][2][4][2];
#pragma unroll
    for (int a = 0; a < 2; ++a)
#pragma unroll
        for (int b = 0; b < 2; ++b)
#pragma unroll
            for (int m = 0; m < 4; ++m)
#pragma unroll
                for (int n = 0; n < 2; ++n) acc[a][b][m][n] = (f32x4){0.f, 0.f, 0.f, 0.f};
    bf16x8 At[4][2], B0[2][2], B1[2][2];
    const char* cA = (const char*)g.A + (size_t)cur.pm * tstep; const char* cB = (const char*)g.Bt + (size_t)cur.pn * tstep;
    S.a_ready(cur);
    if constexpr (SP2) {
        PG8_STAGE(PG8_SB(0, 0), cB, voffB); PG8_STAGE(PG8_SB(0, 1), cB + hstep, voffB); PG8_STAGE(PG8_SA(0, 0), cA, voffA); PG8_STAGE(PG8_SA(0, 1), cA + hstep, voffA);
        if (wr == 1) PG8_BAR;
        PG8_WAIT_V(2); PG8_BAR;
        PG8_STAGE(PG8_SB(1, 0), cB + kstep, voffB); PG8_STAGE(PG8_SA(1, 0), cA + kstep, voffA); PG8_STAGE(PG8_SB(1, 1), cB + hstep + kstep, voffB);
        PG8_WAIT_V(6); PG8_BAR;
    } else {
        PG8_STAGE(PG8_SB(0, 0), cB, voffB); PG8_STAGE(PG8_SA(0, 0), cA, voffA); PG8_STAGE(PG8_SB(0, 1), cB + hstep, voffB); PG8_STAGE(PG8_SA(0, 1), cA + hstep, voffA);
        if (wr == 1) PG8_BAR;
        PG8_WAIT_V(4); PG8_BAR;
        PG8_STAGE(PG8_SB(1, 0), cB + kstep, voffB); PG8_STAGE(PG8_SA(1, 0), cA + kstep, voffA); PG8_STAGE(PG8_SB(1, 1), cB + hstep + kstep, voffB);
        PG8_WAIT_V(6); PG8_BAR;
    }
    for (;;) {
        const bool has_next = S.next(ui + 1, nxt);
        const char* nA = has_next ? (const char*)g.A + (size_t)nxt.pm * tstep : cA; const char* nB = has_next ? (const char*)g.Bt + (size_t)nxt.pn * tstep : cB;
        for (int t = 0; t < nt; t += 2) {
            const bool last = (t == nt - 2);
            const char* a1 = cA + (size_t)(t + 1) * kstep;
            const char* a2 = last ? nA : cA + (size_t)(t + 2) * kstep; const char* b2 = last ? nB : cB + (size_t)(t + 2) * kstep;
            const char* a3 = a2 + kstep; const char* b3 = b2 + kstep;
            if (last && has_next) S.a_ready(nxt);
            if constexpr (SP2) {
            PG8_LDB(B0, 0, 0); PG8_LDB(B1, 0, 1); PG8_SCHED; PG8_LDA(At, 0, 0); PG8_STAGE(PG8_SA(1, 1), a1 + hstep, voffA);
            PG8_WAIT_V(8); PG8_WAIT_L(0); PG8_BAR; PG8_MMA(0, 0, At, B0); PG8_MMA(0, 1, At, B1); PG8_BAR; PG8_SCHED;
            PG8_LDA(At, 0, 1); PG8_STAGE(PG8_SB(0, 0), b2, voffB); PG8_STAGE(PG8_SB(0, 1), b2 + hstep, voffB); PG8_STAGE(PG8_SA(0, 0), a2, voffA);
            PG8_WAIT_V(8); PG8_WAIT_L(0); PG8_BAR; PG8_MMA(1, 0, At, B0); PG8_MMA(1, 1, At, B1); PG8_BAR; PG8_SCHED;
            PG8_LDB(B0, 1, 0); PG8_LDB(B1, 1, 1); PG8_SCHED; PG8_LDA(At, 1, 0); PG8_STAGE(PG8_SA(0, 1), a2 + hstep, voffA);
            PG8_WAIT_V(8); PG8_WAIT_L(0); PG8_BAR; PG8_MMA(0, 0, At, B0); PG8_MMA(0, 1, At, B1); PG8_BAR; PG8_SCHED;
            PG8_LDA(At, 1, 1); PG8_STAGE(PG8_SB(1, 0), b3, voffB); PG8_STAGE(PG8_SB(1, 1), b3 + hstep, voffB); PG8_STAGE(PG8_SA(1, 0), a3, voffA);
            PG8_WAIT_V(8); PG8_WAIT_L(0); PG8_BAR; PG8_MMA(1, 0, At, B0); PG8_MMA(1, 1, At, B1); PG8_BAR; PG8_SCHED;
            } else {
            PG8_LDB(B0, 0, 0); PG8_SCHED; PG8_LDA(At, 0, 0); PG8_STAGE(PG8_SA(1, 1), a1 + hstep, voffA);
            PG8_WAIT_L(8); PG8_BAR; PG8_WAIT_L(0); PG8_MMA(0, 0, At, B0); PG8_BAR; PG8_SCHED;
            PG8_LDB(B1, 0, 1); PG8_STAGE(PG8_SB(0, 0), b2, voffB);
            PG8_BAR; PG8_WAIT_L(0); PG8_MMA(0, 1, At, B1); PG8_BAR;
            PG8_LDA(At, 0, 1); PG8_STAGE(PG8_SA(0, 0), a2, voffA);
            PG8_BAR; PG8_WAIT_L(0); PG8_MMA(1, 0, At, B0); PG8_BAR; PG8_SCHED;
            PG8_STAGE(PG8_SB(0, 1), b2 + hstep, voffB);
            PG8_WAIT_V(6); PG8_BAR; PG8_MMA(1, 1, At, B1); PG8_BAR;
            PG8_LDB(B0, 1, 0); PG8_SCHED; PG8_LDA(At, 1, 0); PG8_STAGE(PG8_SA(0, 1), a2 + hstep, voffA);
            PG8_WAIT_L(8); PG8_BAR; PG8_WAIT_L(0); PG8_MMA(0, 0, At, B0); PG8_BAR; PG8_SCHED;
            PG8_LDB(B1, 1, 1); PG8_STAGE(PG8_SB(1, 0), b3, voffB);
            PG8_BAR; PG8_WAIT_L(0); PG8_MMA(0, 1, At, B1); PG8_BAR;
            PG8_LDA(At, 1, 1); PG8_STAGE(PG8_SA(1, 0), a3, voffA);
            PG8_BAR; PG8_WAIT_L(0); PG8_MMA(1, 0, At, B0); PG8_BAR; PG8_SCHED;
            PG8_STAGE(PG8_SB(1, 1), b3 + hstep, voffB);
            PG8_WAIT_V(6); PG8_BAR; PG8_MMA(1, 1, At, B1); PG8_BAR;
            }
        }
        if constexpr (ALIGN_EPI) { if (wr == 0) PG8_BAR; }
        if constexpr (!Epi::AFTER_DRAIN) { E(acc, cur, wr, wc, fr, fq); S.done(cur); }
        if (!has_next) break;
#pragma unroll
        for (int a = 0; a < 2; ++a)
#pragma unroll
            for (int b = 0; b < 2; ++b)
#pragma unroll
                for (int m = 0; m < 4; ++m)
#pragma unroll
                    for (int n = 0; n < 2; ++n) acc[a][b][m][n] = (f32x4){0.f, 0.f, 0.f, 0.f};
        cur = nxt; cA = nA; cB = nB; ++ui;
        if constexpr (ALIGN_EPI) { if (wr == 1) PG8_BAR; }
    }
    PG8_WAIT_V(0);
    if constexpr (!ALIGN_EPI) { if (wr == 0) PG8_BAR; }
    PG8_BAR;
    if constexpr (Epi::AFTER_DRAIN) { E.fused(acc, cur, wr, wc, fr, fq, lds, wid, lane); S.done(cur); }
#undef PG8_SA
#undef PG8_SB
#undef PG8_STAGE
#undef PG8_LDA
#undef PG8_LDB
#undef PG8_MMA
#undef PG8_WAIT_V
#undef PG8_WAIT_L
#undef PG8_BAR
#undef PG8_SCHED
}
}

#define LAS __attribute__((address_space(3)))
typedef unsigned short bf16_t;
typedef short bf16x8 __attribute__((ext_vector_type(8)));
typedef float f32x4 __attribute__((ext_vector_type(4)));
typedef float f32x16 __attribute__((ext_vector_type(16)));
typedef unsigned u32x2 __attribute__((ext_vector_type(2)));
typedef unsigned u32x4 __attribute__((ext_vector_type(4)));
typedef float f32x2_t __attribute__((ext_vector_type(2)));
typedef __bf16 bf16x2_t __attribute__((ext_vector_type(2)));

constexpr int DM = 1024, NBATCH = 2, SEQ = 8192, DEPTH = 4, CTXL = 256;
constexpr int MLAT = NBATCH * SEQ, MCTX = NBATCH * CTXL, MTOT = MLAT + MCTX;
constexpr int NIN = 3584, NTM = 1536, NCM = 1024, NTB = MTOT / 64;
constexpr int C_QA = 0, C_GA = 384, C_QC = 768, C_GC = 1152;
constexpr int R_HZ = 0, R_GB = 768;
constexpr int NFFT = 16384;
constexpr float LOG2E = 1.4426950408889634f;
constexpr float QK_SCALE = 0.125f * LOG2E;

constexpr size_t MiB = 1u << 20;
constexpr size_t WS_ADA = 1 * MiB;
constexpr size_t WS_ROPE = 1 * MiB + 256 * 1024;
constexpr size_t WS_H2C = 1 * MiB + 512 * 1024;
constexpr size_t WS_CX = 2 * MiB;
constexpr size_t WS_H2 = 4 * MiB;
constexpr size_t WS_WIN = 12 * MiB;
constexpr size_t WS_WOUT = 40 * MiB;
constexpr size_t WS_HY = 48 * MiB;
constexpr size_t WS_PT = 81 * MiB;
constexpr size_t WS_KH = 130 * MiB + 512 * 1024;
constexpr size_t WS_VT = 147 * MiB;
constexpr size_t WS_PCT = 163 * MiB + 512 * 1024;
constexpr size_t WS_YBT = 197 * MiB;
constexpr size_t WS_XB = 206 * MiB;
constexpr size_t OUT_ZS = 0;
constexpr size_t OUT_FILT = 32 * MiB;
constexpr size_t OUT_YBT = 48 * MiB;
constexpr size_t WS_W3T = 238 * MiB;
constexpr size_t WS_FILT = 239 * MiB;
constexpr size_t WS_END = 255 * MiB;
static_assert(WS_PT + (size_t)MTOT * NTM * 2 <= WS_KH && WS_KH + (size_t)8 * MTOT * 128 <= WS_VT && WS_VT + (size_t)8 * MTOT * 128 <= WS_PCT && WS_PCT + (size_t)NCM * MTOT * 2 <= WS_YBT, "d_ws map");

constexpr int AUX_OFF = 147456;
constexpr int LDS_BYTES = 163840;
constexpr int NTHREADS = 512;

struct KArgs {
    const float* x; const float* c; const float* ctx; const float* c_ctx; const float* norm_g; const float* w_ada; const float* b_ada;
    const float* w_in; const float* w_out; const float* na_rpb; const float* hy_conv_w; const float* hy_conv_b;
    const float* hy_w1; const float* hy_b1; const float* hy_freq1; const float* hy_w2; const float* hy_b2; const float* hy_freq2; const float* hy_w3;
    const float* hy_d; const float* sink; const float* final_g;
    float* out; unsigned char* ws;
    int ph_lo, ph_hi;
};

typedef const __attribute__((address_space(4))) KArgs CKArgs;
__device__ __forceinline__ unsigned pk2(float lo, float hi) { f32x2_t v = {lo, hi}; bf16x2_t b = __builtin_convertvector(v, bf16x2_t); return __builtin_bit_cast(unsigned, b); }
__device__ __forceinline__ float bf2f(unsigned short u) { return __uint_as_float(((unsigned)u) << 16); }
__device__ __forceinline__ float bflo(unsigned w) { return __uint_as_float(w << 16); }
__device__ __forceinline__ float bfhi(unsigned w) { return __uint_as_float(w & 0xffff0000u); }
__device__ __forceinline__ float silu_f(float x) { return x / (1.0f + __expf(-x)); }
__device__ __forceinline__ float lane_xor(float v, int lane, int m) { return __int_as_float(__builtin_amdgcn_ds_bpermute((lane ^ m) << 2, __float_as_int(v))); }
__device__ __forceinline__ float lane_prev(float v, int lane) { return __int_as_float(__builtin_amdgcn_ds_bpermute(((lane - 1) & 63) << 2, __float_as_int(v))); }
__device__ __forceinline__ float lane_next(float v, int lane) { return __int_as_float(__builtin_amdgcn_ds_bpermute(((lane + 1) & 63) << 2, __float_as_int(v))); }
__device__ __forceinline__ float wave_sum(float v, int lane) {
#pragma unroll
    for (int o = 1; o < 64; o <<= 1) v += lane_xor(v, lane, o);
    return v;
}
__device__ __forceinline__ float rdlane(float v, int l) { return __uint_as_float(__builtin_amdgcn_readlane(__float_as_uint(v), l)); }

__device__ __forceinline__ void transpose_item(const float* W, int K, int N, bf16_t* WT, int k0, int n0, int drow0, LAS float* scr, int lane, int ldk = 0) {
    if (ldk == 0) ldk = K;
#pragma unroll 8
    for (int i = 0; i < 32; ++i) { const int kk = 2 * i + (lane >> 5); scr[kk * 33 + (lane & 31)] = W[(size_t)(k0 + kk) * N + n0 + (lane & 31)]; }
    asm volatile("s_waitcnt lgkmcnt(0)" ::: "memory");
    const int c = lane & 7;
#pragma unroll
    for (int j = 0; j < 4; ++j) { const int n = (lane >> 3) + 8 * j; const LAS float* s = scr + (8 * c) * 33 + n;
        u32x4 o; o.x = pk2(s[0 * 33], s[1 * 33]); o.y = pk2(s[2 * 33], s[3 * 33]); o.z = pk2(s[4 * 33], s[5 * 33]); o.w = pk2(s[6 * 33], s[7 * 33]);
        *(u32x4*)(WT + (size_t)(drow0 + n) * ldk + k0 + 8 * c) = o; }
    asm volatile("s_waitcnt lgkmcnt(0)" ::: "memory");
}
__device__ __forceinline__ int win_row(int n0) {
    if (n0 < 384) return n0;
    if (n0 < 768) return n0 - 384 + 1536;
    if (n0 < 1152) return n0 - 768 + 2048;
    if (n0 < 1536) return n0 - 1152 + 384;
    if (n0 < 2304) return n0 - 1536 + 2560;
    if (n0 < 2560) return n0 - 2304 + 3328;
    if (n0 < 2944) return n0 - 2560 + 768;
    if (n0 < 3072) return n0 - 2944 + 1920;
    if (n0 < 3200) return n0 - 3072 + 2432;
    return n0 - 3200 + 1152;
}

__device__ __forceinline__ void phase_prologue(CKArgs& A, LAS unsigned char* lds, int bid, int nblk, int tid) {
    const int wave = __builtin_amdgcn_readfirstlane(tid >> 6), lane = tid & 63;
    const int gw = bid * 8 + wave, NGW = nblk * 8;
    unsigned char* ws = A.ws;
    {
        LAS float* scr = (LAS float*)(lds + wave * 16384);
        constexpr int I_IN = 16 * 112, I_OUT = 16 * 32, I_L = I_IN + I_OUT;
        for (int it = gw; it < DEPTH * I_L; it += NGW) {
            const int l = it / I_L; int r = it % I_L;
            if (r < I_IN) { const int kb = r / 112, nb = r % 112, n0 = nb * 32;
                transpose_item(A.w_in + (size_t)l * DM * NIN, DM, NIN, (bf16_t*)(ws + WS_WIN) + (size_t)l * NIN * DM, kb * 64, n0, win_row(n0), scr, lane); }
            else { r -= I_IN; const int kb = r / 32, nb = r % 32, n0 = nb * 32;
                transpose_item(A.w_out + (size_t)l * DM * DM, DM, DM, (bf16_t*)(ws + WS_WOUT) + (size_t)l * DM * DM, kb * 64, n0, n0, scr, lane); }
        }
    }
    {
        LAS float* scr = (LAS float*)(lds + wave * 16384);
        bf16_t* W3T = (bf16_t*)(ws + WS_W3T);
        for (int it = gw; it < DEPTH * 32; it += NGW) { const int l = it >> 5, nb = it & 31;
            transpose_item(A.hy_w3 + (size_t)l * 64 * 1024, 64, 1024, W3T + (size_t)l * 1024 * 64, 0, nb * 32, nb * 32, scr, lane); }
    }
    for (int idx = gw * 64 + lane; idx < 128 * 16; idx += NGW * 64) {
        const int p = idx >> 4, i = idx & 15;
        const float inv = powf(10000.0f, -(float)i / 16.0f);
        const float ang = (float)p * inv;
        ((float2*)(ws + WS_ROPE))[idx] = make_float2(cosf(ang), sinf(ang));
    }
    for (int it = gw; it < DEPTH * 528; it += NGW) {
        const int l = it / 528, g4 = it % 528, g = g4 >> 2, sub = g4 & 3;
        const int L = g < 128 ? SEQ : CTXL;
        const int n0 = (g < 128 ? g * 64 : (g - 128) * 64) + 16 * sub;
        float* outp = (float*)(ws + WS_H2C) + ((size_t)l * CTXL + n0) * 64;
        bf16_t* outb = (bf16_t*)(ws + WS_H2) + ((size_t)l * SEQ + n0) * 64;
        float w1c[33], w2c[64];
#pragma unroll
        for (int q = 0; q < 33; ++q) w1c[q] = A.hy_w1[((size_t)l * 33 + q) * 64 + lane];
#pragma unroll
        for (int j = 0; j < 64; ++j) w2c[j] = A.hy_w2[((size_t)l * 64 + j) * 64 + lane];
        const float b1 = A.hy_b1[l * 64 + lane], fr1 = A.hy_freq1[l * 64 + lane], b2 = A.hy_b2[l * 64 + lane], fr2 = A.hy_freq2[l * 64 + lane];
        const float tstep = 1.0f / (float)(L - 1);
        const int fj = lane == 0 ? 0 : ((lane - 1) & 15);
        const float fq = 1e-4f + (float)fj * ((15.0f - 1e-4f) / 15.0f);
#pragma unroll 1
        for (int nn = 0; nn < 16; ++nn) {
            const int n = n0 + nn;
            const float t = (float)n * tstep;
            const float rev = fq * ((float)n * (1.0f / (float)L)) + (lane <= 16 ? 0.25f : 0.5f);
            float zq = __builtin_amdgcn_sinf(rev - floorf(rev));
            if (lane == 0) zq = t; if (lane > 32) zq = 0.f;
            float a1 = b1;
#pragma unroll
            for (int q = 0; q < 33; ++q) a1 += rdlane(zq, q) * w1c[q];
            const float x1 = fr1 * a1 * 0.15915494309189535f;
            const float h1 = __builtin_amdgcn_sinf(x1 - floorf(x1));
            float a2 = b2;
#pragma unroll
            for (int j = 0; j < 64; ++j) a2 += rdlane(h1, j) * w2c[j];
            const float x2 = fr2 * a2 * 0.15915494309189535f;
            const float h2 = __builtin_amdgcn_sinf(x2 - floorf(x2));
            if (g < 128) outb[nn * 64 + lane] = (bf16_t)(pk2(h2, 0.f) & 0xffffu);
            else outp[nn * 64 + lane] = h2;
        }
    }
    __syncthreads();
    {
        LAS float* red = (LAS float*)lds;
        LAS float* sv = (LAS float*)(lds + 8192);
        for (int i = tid; i < 3 * DM; i += NTHREADS) sv[i] = silu_f(i < 2 * DM ? A.c[i] : A.c_ctx[i - 2 * DM]);
        __syncthreads();
        for (int it = bid; it < DEPTH * 48; it += nblk) {
            const int l = it / 48, n = (it % 48) * 64 + lane;
            const float* W = A.w_ada + (size_t)l * DM * 3072 + n;
            float a0 = 0.f, a1 = 0.f, a2 = 0.f;
            const int kb = wave * 128;
#pragma unroll 1
            for (int k0 = 0; k0 < 128; k0 += 16) {
                float w[16];
#pragma unroll
                for (int k = 0; k < 16; ++k) w[k] = W[(size_t)(kb + k0 + k) * 3072];
#pragma unroll
                for (int k = 0; k < 16; ++k) { a0 += sv[kb + k0 + k] * w[k]; a1 += sv[DM + kb + k0 + k] * w[k]; a2 += sv[2 * DM + kb + k0 + k] * w[k]; }
            }
            red[(wave * 3 + 0) * 64 + lane] = a0; red[(wave * 3 + 1) * 64 + lane] = a1; red[(wave * 3 + 2) * 64 + lane] = a2;
            __syncthreads();
            if (tid < 192) { const int v = tid >> 6; float sacc = A.b_ada[l * 3072 + n];
#pragma unroll
                for (int w = 0; w < 8; ++w) sacc += red[(w * 3 + v) * 64 + lane];
                ((float*)(ws + WS_ADA))[((size_t)l * 3 + v) * 3072 + n] = sacc; }
            __syncthreads();
        }
    }
}

__device__ __forceinline__ void filt_items(CKArgs& A, int lf, int tid, int bid, int nblk, unsigned* ctr) {
    unsigned char* ws = A.ws;
    const int wave = __builtin_amdgcn_readfirstlane(tid >> 6), lane = tid & 63;
    const int gw = bid * 8 + wave, NGW = nblk * 8;
    const bf16_t* H2B = (const bf16_t*)(ws + WS_H2) + (size_t)lf * SEQ * 64;
    const bf16_t* W3T = (const bf16_t*)(ws + WS_W3T) + (size_t)lf * 1024 * 64;
    bf16_t* FILT = (bf16_t*)((unsigned char*)A.out + OUT_FILT);
    const int fr = lane & 15, fq = lane >> 4;
    int it = gw;
#pragma unroll 1
    for (;;) {
        if (ctr) { unsigned t = 0; if (lane == 0) t = __hip_atomic_fetch_add(ctr, 1u, __ATOMIC_RELAXED, __HIP_MEMORY_SCOPE_AGENT); it = (int)__builtin_amdgcn_readfirstlane(t); }
        if (it >= 2048) break;
        const int n0 = (it >> 4) * 64, c0 = (it & 15) * 64;
        bf16x8 af[4][2];
#pragma unroll
        for (int j = 0; j < 4; ++j) { const bf16_t* ap = H2B + (size_t)(n0 + 16 * (fr >> 2) + 4 * j + (fr & 3)) * 64 + 8 * fq; af[j][0] = *(const bf16x8*)ap; af[j][1] = *(const bf16x8*)(ap + 32); }
#pragma unroll 1
        for (int ct = 0; ct < 4; ++ct) {
            const bf16_t* bp = W3T + (size_t)(c0 + 16 * ct + fr) * 64 + 8 * fq;
            const bf16x8 b0 = *(const bf16x8*)bp, b1 = *(const bf16x8*)(bp + 32);
            u32x4 o0, o1;
#pragma unroll
            for (int j = 0; j < 4; ++j) {
                f32x4 acc = {0.f, 0.f, 0.f, 0.f};
                acc = __builtin_amdgcn_mfma_f32_16x16x32_bf16(af[j][0], b0, acc, 0, 0, 0);
                acc = __builtin_amdgcn_mfma_f32_16x16x32_bf16(af[j][1], b1, acc, 0, 0, 0);
                const unsigned w0 = pk2(acc.x, acc.y), w1 = pk2(acc.z, acc.w);
                if (j == 0) { o0.x = w0; o0.y = w1; } else if (j == 1) { o0.z = w0; o0.w = w1; } else if (j == 2) { o1.x = w0; o1.y = w1; } else { o1.z = w0; o1.w = w1; }
            }
            bf16_t* dp = FILT + (size_t)(c0 + 16 * ct + fr) * SEQ + n0 + 16 * fq;
            *(u32x4*)dp = o0; *(u32x4*)(dp + 8) = o1;
        }
        if (!ctr) it += NGW;
    }
}

__device__ __forceinline__ void ctx_outproj_items(CKArgs& A, int l, int tid, int bid, int nblk) {
    unsigned char* ws = A.ws;
    const int wave = __builtin_amdgcn_readfirstlane(tid >> 6), lane = tid & 63;
    const int gw = bid * 8 + wave, NGW = nblk * 8;
    const bf16_t* Y = (const bf16_t*)(ws + WS_HY) + (size_t)MLAT * DM;
    const bf16_t* WT = (const bf16_t*)(ws + WS_WOUT) + (size_t)l * DM * DM;
    const float* gate = (const float*)(ws + WS_ADA) + ((size_t)l * 3 + 2) * 3072 + 2048;
    const float* csrc = l == 0 ? A.ctx : (const float*)(ws + WS_CX);
    float* cdst = (float*)(ws + WS_CX);
    const int fr = lane & 15, fq = lane >> 4;
#pragma unroll 1
    for (int it = gw; it < 2048; it += NGW) {
        const int r0 = (it >> 6) * 16, c0 = (it & 63) * 16;
        const bf16_t* ap = Y + (size_t)(r0 + fr) * DM + 8 * fq;
        const bf16_t* bp = WT + (size_t)(c0 + fr) * DM + 8 * fq;
        f32x4 acc0 = {0.f, 0.f, 0.f, 0.f}, acc1 = {0.f, 0.f, 0.f, 0.f};
#pragma unroll 1
        for (int k0 = 0; k0 < 32; k0 += 8) {
            bf16x8 a[8], b[8];
#pragma unroll
            for (int k = 0; k < 8; ++k) { a[k] = *(const bf16x8*)(ap + 32 * (k0 + k)); b[k] = *(const bf16x8*)(bp + 32 * (k0 + k)); }
#pragma unroll
            for (int k = 0; k < 8; k += 2) { acc0 = __builtin_amdgcn_mfma_f32_16x16x32_bf16(a[k], b[k], acc0, 0, 0, 0); acc1 = __builtin_amdgcn_mfma_f32_16x16x32_bf16(a[k + 1], b[k + 1], acc1, 0, 0, 0); }
        }
        const float g = gate[c0 + fr];
#pragma unroll
        for (int i = 0; i < 4; ++i) { const size_t off = (size_t)(r0 + 4 * fq + i) * DM + c0 + fr; cdst[off] = csrc[off] + g * (acc0[i] + acc1[i]); }
    }
}

__device__ __forceinline__ void phase_norm(CKArgs& A, int l, int bid, int nblk, int tid) {
    const int wave = __builtin_amdgcn_readfirstlane(tid >> 6), lane = tid & 63;
    const int gw = bid * 8 + wave, NGW = nblk * 8;
    unsigned char* ws = A.ws;
    bf16_t* H = (bf16_t*)(ws + WS_HY);
    const float* ada = (const float*)(ws + WS_ADA) + (size_t)l * 3 * 3072;
    const float* g = A.norm_g + l * DM;
    for (int m = gw; m < MTOT; m += NGW) {
        const float* src = nullptr; int v;
        const bool xb = (m < MLAT) && (l > 0);
        if (m < MLAT) { src = A.x + (size_t)m * DM; v = m >> 13; }
        else { src = (l == 0 ? A.ctx : (const float*)(ws + WS_CX)) + (size_t)(m - MLAT) * DM; v = 2; }
        const float* shp = ada + v * 3072; const float* scp = shp + DM;
        f32x4 xv[4]; float ss = 0.f;
        if (xb) { const bf16_t* sb = (const bf16_t*)(ws + WS_XB) + (size_t)m * DM;
#pragma unroll
            for (int j = 0; j < 4; ++j) { const u32x2 w = *(const u32x2*)(sb + 4 * lane + 256 * j); xv[j] = (f32x4){bflo(w.x), bfhi(w.x), bflo(w.y), bfhi(w.y)}; } }
        else {
#pragma unroll
            for (int j = 0; j < 4; ++j) xv[j] = *(const f32x4*)(src + 4 * lane + 256 * j); }
#pragma unroll
        for (int j = 0; j < 4; ++j) ss += (xv[j].x * xv[j].x + xv[j].y * xv[j].y) + (xv[j].z * xv[j].z + xv[j].w * xv[j].w);
        const float rinv = rsqrtf(wave_sum(ss, lane) * (1.0f / DM) + 1e-6f);
#pragma unroll
        for (int j = 0; j < 4; ++j) { const int col = 4 * lane + 256 * j;
            const f32x4 gv = *(const f32x4*)(g + col), sc = *(const f32x4*)(scp + col), sh = *(const f32x4*)(shp + col);
            const f32x4 h = xv[j] * rinv * gv * (sc + 1.0f) + sh;
            u32x2 o; o.x = pk2(h.x, h.y); o.y = pk2(h.z, h.w);
            *(u32x2*)(H + (size_t)m * DM + col) = o; }
    }
    if (l == 0) filt_items(A, 0, tid, bid, nblk, nullptr);
}

struct EpiIn {
    static constexpr bool PERM = true, AFTER_DRAIN = false;
    bf16_t* PT; bf16_t* KH; bf16_t* PCT; const float2* rope;
    __device__ __forceinline__ void operator()(const f32x4 (&acc)[2][2][4][2], const pg8::Unit& u, int wr, int wc, int fr, int fq) const {
        const int row0 = u.pm * 256 + wr * 64 + fr;
        if (u.pn < 10) {
#pragma unroll
            for (int bj = 0; bj < 2; ++bj) {
                const int blk = 2 * u.pn + bj;
                const bool rp = ((blk >= 6 && blk <= 8) || blk == 15) && (u.pm < 64);
                const int col0 = 256 * u.pn + 128 * bj + 32 * wc + 8 * fq;
                bf16_t* dst; size_t ld;
                if (u.pn < 6) { dst = PT + col0; ld = NTM; }
                else { const int n2 = col0 - 1536; dst = KH + (size_t)(n2 >> 6) * MTOT * 64 + (n2 & 63); ld = 64; }
#pragma unroll
                for (int ai = 0; ai < 2; ++ai)
#pragma unroll
                    for (int m = 0; m < 4; ++m) {
                        const int r = row0 + 128 * ai + 16 * m;
                        f32x4 v0 = acc[ai][bj][m][0], v1 = acc[ai][bj][m][1];
                        if (rp) {
                            const int pos = r & (SEQ - 1);
                            const int p = (wc & 1) ? (pos & 63) : (pos >> 6);
                            const f32x4* tb = (const f32x4*)(rope + p * 16 + 8 * (fq & 1));
                            const int ln = fr + 16 * fq;
                            const float sg = (fq < 2) ? -1.0f : 1.0f;
                            { const f32x4 t0 = tb[0], t1 = tb[1];
                              const float qx = lane_xor(v0.x, ln, 32), qy = lane_xor(v0.y, ln, 32), qz = lane_xor(v0.z, ln, 32), qw = lane_xor(v0.w, ln, 32);
                              v0.x = v0.x * t0.x + sg * qx * t0.y; v0.y = v0.y * t0.z + sg * qy * t0.w; v0.z = v0.z * t1.x + sg * qz * t1.y; v0.w = v0.w * t1.z + sg * qw * t1.w; }
                            { const f32x4 t2 = tb[2], t3 = tb[3];
                              const float qx = lane_xor(v1.x, ln, 32), qy = lane_xor(v1.y, ln, 32), qz = lane_xor(v1.z, ln, 32), qw = lane_xor(v1.w, ln, 32);
                              v1.x = v1.x * t2.x + sg * qx * t2.y; v1.y = v1.y * t2.z + sg * qy * t2.w; v1.z = v1.z * t3.x + sg * qz * t3.y; v1.w = v1.w * t3.z + sg * qw * t3.w; }
                        }
                        u32x4 w; w.x = pk2(v0.x, v0.y); w.y = pk2(v0.z, v0.w); w.z = pk2(v1.x, v1.y); w.w = pk2(v1.z, v1.w);
                        *(u32x4*)(dst + (size_t)r * ld) = w;
                        asm volatile("" ::: "memory");
                    }
            }
        } else {
#pragma unroll
            for (int bj = 0; bj < 2; ++bj) {
                const int ch0 = 256 * (u.pn - 10) + 128 * bj + 32 * wc + 8 * fq;
#pragma unroll
                for (int ai = 0; ai < 2; ++ai)
#pragma unroll
                    for (int m = 0; m < 4; ++m) {
                        const int r = row0 + 128 * ai + 16 * m;
                        bf16_t* p = PCT + (size_t)ch0 * MTOT + r;
#pragma unroll
                        for (int n = 0; n < 2; ++n) {
                            const f32x4 v = acc[ai][bj][m][n];
                            bf16_t* q = p + (size_t)(4 * n) * MTOT;
                            const unsigned w0 = pk2(v.x, v.y), w1 = pk2(v.z, v.w);
                            q[0] = (bf16_t)(w0 & 0xffffu); q[MTOT] = (bf16_t)(w0 >> 16); q[2 * (size_t)MTOT] = (bf16_t)(w1 & 0xffffu); q[3 * (size_t)MTOT] = (bf16_t)(w1 >> 16);
                        }
                    }
            }
        }
    }
};
struct EpiFilt {
    static constexpr bool PERM = true, AFTER_DRAIN = false;
    bf16_t* O; int ldc;
    __device__ __forceinline__ void operator()(const f32x4 (&acc)[2][2][4][2], const pg8::Unit& u, int wr, int wc, int fr, int fq) const {
        const int row0 = u.pm * 256 + wr * 64 + fr;
#pragma unroll
        for (int bj = 0; bj < 2; ++bj) { const int col0 = 256 * u.pn + 128 * bj + 32 * wc + 8 * fq;
#pragma unroll
            for (int ai = 0; ai < 2; ++ai)
#pragma unroll
                for (int m = 0; m < 4; ++m) { const int r = row0 + 128 * ai + 16 * m; const f32x4 v0 = acc[ai][bj][m][0], v1 = acc[ai][bj][m][1];
                    u32x4 w; w.x = pk2(v0.x, v0.y); w.y = pk2(v0.z, v0.w); w.z = pk2(v1.x, v1.y); w.w = pk2(v1.z, v1.w);
                    *(u32x4*)(O + (size_t)r * ldc + col0) = w; } }
    }
};
struct EpiOut {
    static constexpr bool PERM = true, AFTER_DRAIN = false;
    const float* xsrc; bf16_t* xb; float* xdst; const float* ada; bool src32, dst32;
    __device__ __forceinline__ void operator()(const f32x4 (&acc)[2][2][4][2], const pg8::Unit& u, int wr, int wc, int fr, int fq) const {
        const int row0 = u.pm * 256 + wr * 64 + fr;
        const int v = row0 >> 13;
#pragma unroll
        for (int bj = 0; bj < 2; ++bj) {
            const int col0 = 256 * u.pn + 128 * bj + 32 * wc + 8 * fq;
            const float* gp = ada + v * 3072 + 2048 + col0;
            const f32x4 g0 = *(const f32x4*)gp, g1 = *(const f32x4*)(gp + 4);
#pragma unroll
            for (int ai = 0; ai < 2; ++ai)
#pragma unroll
              for (int mh = 0; mh < 2; ++mh) {
                f32x4 x0[2], x1[2];
                if (src32) {
#pragma unroll
                    for (int mm = 0; mm < 2; ++mm) { const float* sp = xsrc + (size_t)(row0 + 128 * ai + 16 * (2 * mh + mm)) * DM + col0; x0[mm] = *(const f32x4*)sp; x1[mm] = *(const f32x4*)(sp + 4); }
                } else {
#pragma unroll
                    for (int mm = 0; mm < 2; ++mm) { const u32x4 w = *(const u32x4*)(xb + (size_t)(row0 + 128 * ai + 16 * (2 * mh + mm)) * DM + col0);
                        x0[mm] = (f32x4){bflo(w.x), bfhi(w.x), bflo(w.y), bfhi(w.y)}; x1[mm] = (f32x4){bflo(w.z), bfhi(w.z), bflo(w.w), bfhi(w.w)}; }
                }
#pragma unroll
                for (int mm = 0; mm < 2; ++mm) { const int m = 2 * mh + mm; const size_t off = (size_t)(row0 + 128 * ai + 16 * m) * DM + col0;
                    const f32x4 y0 = x0[mm] + g0 * acc[ai][bj][m][0], y1 = x1[mm] + g1 * acc[ai][bj][m][1];
                    if (dst32) { *(f32x4*)(xdst + off) = y0; *(f32x4*)(xdst + off + 4) = y1; }
                    else { u32x4 w; w.x = pk2(y0.x, y0.y); w.y = pk2(y0.z, y0.w); w.z = pk2(y1.x, y1.y); w.w = pk2(y1.z, y1.w); *(u32x4*)(xb + off) = w; } }
                asm volatile("" ::: "memory");
              }
        }
    }
};
struct EpiAll {
    static constexpr bool PERM = true, AFTER_DRAIN = false;
    int mode, l; CKArgs* Ap;
    __device__ __forceinline__ void operator()(const f32x4 (&acc)[2][2][4][2], const pg8::Unit& u, int wr, int wc, int fr, int fq) const {
        unsigned char* ws = Ap->ws;
        if (mode == 0) { const EpiIn E{(bf16_t*)(ws + WS_PT), (bf16_t*)(ws + WS_KH), (bf16_t*)(ws + WS_PCT), (const float2*)(ws + WS_ROPE)}; E(acc, u, wr, wc, fr, fq); }
        else { const EpiOut E{Ap->x, (bf16_t*)(ws + WS_XB), Ap->out, (const float*)(ws + WS_ADA) + (size_t)l * 3 * 3072, l == 0, l == DEPTH - 1}; E(acc, u, wr, wc, fr, fq); }
    }
};
__device__ __forceinline__ float max3f(float a, float b, float c) { float r; asm("v_max3_f32 %0, %1, %2, %3" : "=v"(r) : "v"(a), "v"(b), "v"(c)); return r; }
__device__ __forceinline__ float max2f(float a, float b) { float r; asm("v_max_f32_e32 %0, %1, %2" : "=v"(r) : "v"(a), "v"(b)); return r; }
__device__ __forceinline__ void attn_tile(LAS const unsigned char* slot, int cs, const bf16x8 (&bq)[4], f32x16& o0, f32x16& o1, float& m_run, float& l_run,
                                          int r31, int hh, bool use_mask, int clo, int chi, bool use_bias, LAS const float* btab, int bidx) {
    const int kr = cs + r31;
    LAS const unsigned char* kp = slot + kr * 128;
    const int ksw = (kr >> 1) & 7;
    const bf16x8 ka0 = *(LAS const bf16x8*)(kp + 16 * ((0 + hh) ^ ksw)), ka1 = *(LAS const bf16x8*)(kp + 16 * ((2 + hh) ^ ksw));
    const bf16x8 ka2 = *(LAS const bf16x8*)(kp + 16 * ((4 + hh) ^ ksw)), ka3 = *(LAS const bf16x8*)(kp + 16 * ((6 + hh) ^ ksw));
    LAS const unsigned char* vp = slot + 8192 + r31 * 128;
    const int vsw = (r31 >> 1) & 15, g0 = (cs >> 2) + hh;
    const u32x2 a0l = *(LAS const u32x2*)(vp + 8 * ((g0) ^ vsw)), a0h = *(LAS const u32x2*)(vp + 8 * ((g0 + 2) ^ vsw));
    const u32x2 a1l = *(LAS const u32x2*)(vp + 8 * ((g0 + 4) ^ vsw)), a1h = *(LAS const u32x2*)(vp + 8 * ((g0 + 6) ^ vsw));
    const u32x2 b0l = *(LAS const u32x2*)(vp + 4096 + 8 * ((g0) ^ vsw)), b0h = *(LAS const u32x2*)(vp + 4096 + 8 * ((g0 + 2) ^ vsw));
    const u32x2 b1l = *(LAS const u32x2*)(vp + 4096 + 8 * ((g0 + 4) ^ vsw)), b1h = *(LAS const u32x2*)(vp + 4096 + 8 * ((g0 + 6) ^ vsw));
    f32x16 s, t;
#pragma unroll
    for (int i = 0; i < 16; ++i) { s[i] = 0.f; t[i] = 0.f; }
    s = __builtin_amdgcn_mfma_f32_32x32x16_bf16(ka0, bq[0], s, 0, 0, 0); t = __builtin_amdgcn_mfma_f32_32x32x16_bf16(ka1, bq[1], t, 0, 0, 0);
    s = __builtin_amdgcn_mfma_f32_32x32x16_bf16(ka2, bq[2], s, 0, 0, 0); t = __builtin_amdgcn_mfma_f32_32x32x16_bf16(ka3, bq[3], t, 0, 0, 0);
    if (use_bias) {
        LAS const float* bp = btab + bidx;
#pragma unroll
        for (int i = 0; i < 16; ++i) { const int c = (i & 3) + 8 * (i >> 2) + 4 * hh; s[i] = (s[i] + t[i]) * QK_SCALE + bp[c]; }
    } else {
#pragma unroll
        for (int i = 0; i < 16; ++i) s[i] = (s[i] + t[i]) * QK_SCALE;
    }
    if (use_mask) {
        const unsigned off = (unsigned)(4 * hh - clo), rng = (unsigned)(chi - clo);
        const bool any = chi >= clo;
#pragma unroll
        for (int i = 0; i < 16; ++i) { const unsigned c0 = (unsigned)((i & 3) + 8 * (i >> 2)); s[i] = (any && (c0 + off <= rng)) ? s[i] : -INFINITY; }
    }
    float tmax = max3f(s[0], s[1], s[2]);
#pragma unroll
    for (int i = 3; i < 15; i += 2) tmax = max3f(tmax, s[i], s[i + 1]);
    tmax = max2f(tmax, s[15]);
    tmax = max2f(tmax, lane_xor(tmax, r31 + 32 * hh, 32));
    if (__any(tmax - m_run > 8.0f)) {
        const float m_new = fmaxf(m_run, tmax);
        const float alpha = __builtin_amdgcn_exp2f(m_run - m_new);
        m_run = m_new; l_run *= alpha;
#pragma unroll
        for (int i = 0; i < 16; ++i) { o0[i] *= alpha; o1[i] *= alpha; }
    }
    float ps0 = 0.f, ps1 = 0.f;
#pragma unroll
    for (int i = 0; i < 16; i += 2) { const float p0 = __builtin_amdgcn_exp2f(s[i] - m_run), p1 = __builtin_amdgcn_exp2f(s[i + 1] - m_run); s[i] = p0; s[i + 1] = p1; ps0 += p0; ps1 += p1; }
    l_run += ps0 + ps1;
    u32x4 pw0, pw1;
    pw0.x = pk2(s[0], s[1]); pw0.y = pk2(s[2], s[3]); pw0.z = pk2(s[4], s[5]); pw0.w = pk2(s[6], s[7]);
    pw1.x = pk2(s[8], s[9]); pw1.y = pk2(s[10], s[11]); pw1.z = pk2(s[12], s[13]); pw1.w = pk2(s[14], s[15]);
    const bf16x8 pb0 = __builtin_bit_cast(bf16x8, pw0), pb1 = __builtin_bit_cast(bf16x8, pw1);
    u32x4 w;
    w.x = a0l.x; w.y = a0l.y; w.z = a0h.x; w.w = a0h.y; const bf16x8 va00 = __builtin_bit_cast(bf16x8, w);
    w.x = a1l.x; w.y = a1l.y; w.z = a1h.x; w.w = a1h.y; const bf16x8 va01 = __builtin_bit_cast(bf16x8, w);
    w.x = b0l.x; w.y = b0l.y; w.z = b0h.x; w.w = b0h.y; const bf16x8 va10 = __builtin_bit_cast(bf16x8, w);
    w.x = b1l.x; w.y = b1l.y; w.z = b1h.x; w.w = b1h.y; const bf16x8 va11 = __builtin_bit_cast(bf16x8, w);
    o0 = __builtin_amdgcn_mfma_f32_32x32x16_bf16(va00, pb0, o0, 0, 0, 0); o1 = __builtin_amdgcn_mfma_f32_32x32x16_bf16(va10, pb0, o1, 0, 0, 0);
    o0 = __builtin_amdgcn_mfma_f32_32x32x16_bf16(va01, pb1, o0, 0, 0, 0); o1 = __builtin_amdgcn_mfma_f32_32x32x16_bf16(va11, pb1, o1, 0, 0, 0);
}

__device__ __forceinline__ void attn_tile2(LAS const unsigned char* slot, const bf16x8 (&bq)[4], f32x16& o0, f32x16& o1, float& m_run, float& l_run,
                                           int r31, int hh, bool use_mask, int clo0, int chi0, int clo1, int chi1) {
    const int ksw = (r31 >> 1) & 7;
    LAS const unsigned char* kp = slot + r31 * 128;
    const bf16x8 ka0 = *(LAS const bf16x8*)(kp + 16 * ((0 + hh) ^ ksw)), ka1 = *(LAS const bf16x8*)(kp + 16 * ((2 + hh) ^ ksw));
    const bf16x8 ka2 = *(LAS const bf16x8*)(kp + 16 * ((4 + hh) ^ ksw)), ka3 = *(LAS const bf16x8*)(kp + 16 * ((6 + hh) ^ ksw));
    const bf16x8 kb0 = *(LAS const bf16x8*)(kp + 4096 + 16 * ((0 + hh) ^ ksw)), kb1 = *(LAS const bf16x8*)(kp + 4096 + 16 * ((2 + hh) ^ ksw));
    const bf16x8 kb2 = *(LAS const bf16x8*)(kp + 4096 + 16 * ((4 + hh) ^ ksw)), kb3 = *(LAS const bf16x8*)(kp + 4096 + 16 * ((6 + hh) ^ ksw));
    f32x16 s0, s1;
#pragma unroll
    for (int i = 0; i < 16; ++i) { s0[i] = 0.f; s1[i] = 0.f; }
    s0 = __builtin_amdgcn_mfma_f32_32x32x16_bf16(ka0, bq[0], s0, 0, 0, 0); s1 = __builtin_amdgcn_mfma_f32_32x32x16_bf16(kb0, bq[0], s1, 0, 0, 0);
    s0 = __builtin_amdgcn_mfma_f32_32x32x16_bf16(ka1, bq[1], s0, 0, 0, 0); s1 = __builtin_amdgcn_mfma_f32_32x32x16_bf16(kb1, bq[1], s1, 0, 0, 0);
    s0 = __builtin_amdgcn_mfma_f32_32x32x16_bf16(ka2, bq[2], s0, 0, 0, 0); s1 = __builtin_amdgcn_mfma_f32_32x32x16_bf16(kb2, bq[2], s1, 0, 0, 0);
    s0 = __builtin_amdgcn_mfma_f32_32x32x16_bf16(ka3, bq[3], s0, 0, 0, 0); s1 = __builtin_amdgcn_mfma_f32_32x32x16_bf16(kb3, bq[3], s1, 0, 0, 0);
    LAS const unsigned char* vp = slot + 8192 + r31 * 128;
    const int vsw = (r31 >> 1) & 15;
    u32x2 va[2][4][2];
#pragma unroll
    for (int db = 0; db < 2; ++db)
#pragma unroll
        for (int st = 0; st < 4; ++st) { va[db][st][0] = *(LAS const u32x2*)(vp + 4096 * db + 8 * ((4 * st + hh) ^ vsw)); va[db][st][1] = *(LAS const u32x2*)(vp + 4096 * db + 8 * ((4 * st + hh + 2) ^ vsw)); }
    if (use_mask) {
        const unsigned off0 = (unsigned)(4 * hh - clo0), rng0 = (unsigned)(chi0 - clo0), off1 = (unsigned)(4 * hh - clo1), rng1 = (unsigned)(chi1 - clo1);
#pragma unroll
        for (int i = 0; i < 16; ++i) { const unsigned c0 = (unsigned)((i & 3) + 8 * (i >> 2)); s0[i] = (c0 + off0 <= rng0) ? s0[i] : -INFINITY; s1[i] = (c0 + off1 <= rng1) ? s1[i] : -INFINITY; }
    }
    float tmax = max3f(s0[0], s0[1], s1[0]);
    tmax = max2f(tmax, s1[1]);
#pragma unroll
    for (int i = 2; i < 16; i += 2) { tmax = max3f(tmax, s0[i], s0[i + 1]); tmax = max3f(tmax, s1[i], s1[i + 1]); }
    tmax = max2f(tmax, lane_xor(tmax, r31 + 32 * hh, 32)) * QK_SCALE;
    if (__any(tmax - m_run > 8.0f)) {
        const float m_new = fmaxf(m_run, tmax);
        const float alpha = __builtin_amdgcn_exp2f(m_run - m_new);
        m_run = m_new; l_run *= alpha;
#pragma unroll
        for (int i = 0; i < 16; ++i) { o0[i] *= alpha; o1[i] *= alpha; }
    }
    float ps0 = 0.f, ps1 = 0.f;
    const float nm = -m_run;
#pragma unroll
    for (int i = 0; i < 16; ++i) { const float p0 = __builtin_amdgcn_exp2f(fmaf(s0[i], QK_SCALE, nm)), p1 = __builtin_amdgcn_exp2f(fmaf(s1[i], QK_SCALE, nm)); s0[i] = p0; s1[i] = p1; ps0 += p0; ps1 += p1; }
    l_run += ps0 + ps1;
    u32x4 pw;
    pw.x = pk2(s0[0], s0[1]); pw.y = pk2(s0[2], s0[3]); pw.z = pk2(s0[4], s0[5]); pw.w = pk2(s0[6], s0[7]); const bf16x8 p00 = __builtin_bit_cast(bf16x8, pw);
    pw.x = pk2(s0[8], s0[9]); pw.y = pk2(s0[10], s0[11]); pw.z = pk2(s0[12], s0[13]); pw.w = pk2(s0[14], s0[15]); const bf16x8 p01 = __builtin_bit_cast(bf16x8, pw);
    pw.x = pk2(s1[0], s1[1]); pw.y = pk2(s1[2], s1[3]); pw.z = pk2(s1[4], s1[5]); pw.w = pk2(s1[6], s1[7]); const bf16x8 p10 = __builtin_bit_cast(bf16x8, pw);
    pw.x = pk2(s1[8], s1[9]); pw.y = pk2(s1[10], s1[11]); pw.z = pk2(s1[12], s1[13]); pw.w = pk2(s1[14], s1[15]); const bf16x8 p11 = __builtin_bit_cast(bf16x8, pw);
#define VA8(db_, st_) __builtin_bit_cast(bf16x8, (u32x4){va[db_][st_][0].x, va[db_][st_][0].y, va[db_][st_][1].x, va[db_][st_][1].y})
    o0 = __builtin_amdgcn_mfma_f32_32x32x16_bf16(VA8(0, 0), p00, o0, 0, 0, 0); o1 = __builtin_amdgcn_mfma_f32_32x32x16_bf16(VA8(1, 0), p00, o1, 0, 0, 0);
    o0 = __builtin_amdgcn_mfma_f32_32x32x16_bf16(VA8(0, 1), p01, o0, 0, 0, 0); o1 = __builtin_amdgcn_mfma_f32_32x32x16_bf16(VA8(1, 1), p01, o1, 0, 0, 0);
    o0 = __builtin_amdgcn_mfma_f32_32x32x16_bf16(VA8(0, 2), p10, o0, 0, 0, 0); o1 = __builtin_amdgcn_mfma_f32_32x32x16_bf16(VA8(1, 2), p10, o1, 0, 0, 0);
    o0 = __builtin_amdgcn_mfma_f32_32x32x16_bf16(VA8(0, 3), p11, o0, 0, 0, 0); o1 = __builtin_amdgcn_mfma_f32_32x32x16_bf16(VA8(1, 3), p11, o1, 0, 0, 0);
#undef VA8
}

__device__ __forceinline__ void attn_tile4(LAS const unsigned char* slotA, LAS const unsigned char* slotB, const bf16x8 (&bq)[4], f32x16& o0, f32x16& o1, float& m_run, float& l_run, int r31, int hh) {
    const int ksw = (r31 >> 1) & 7, vsw = (r31 >> 1) & 15;
    f32x16 s[4];
#pragma unroll
    for (int t = 0; t < 4; ++t)
#pragma unroll
        for (int i = 0; i < 16; ++i) s[t][i] = 0.f;
#pragma unroll
    for (int ks = 0; ks < 4; ++ks) {
        LAS const unsigned char* ka = slotA + r31 * 128 + 16 * ((2 * ks + hh) ^ ksw);
        LAS const unsigned char* kb = slotB + r31 * 128 + 16 * ((2 * ks + hh) ^ ksw);
        const bf16x8 k0 = *(LAS const bf16x8*)ka, k1 = *(LAS const bf16x8*)(ka + 4096), k2 = *(LAS const bf16x8*)kb, k3 = *(LAS const bf16x8*)(kb + 4096);
        s[0] = __builtin_amdgcn_mfma_f32_32x32x16_bf16(k0, bq[ks], s[0], 0, 0, 0); s[1] = __builtin_amdgcn_mfma_f32_32x32x16_bf16(k1, bq[ks], s[1], 0, 0, 0);
        s[2] = __builtin_amdgcn_mfma_f32_32x32x16_bf16(k2, bq[ks], s[2], 0, 0, 0); s[3] = __builtin_amdgcn_mfma_f32_32x32x16_bf16(k3, bq[ks], s[3], 0, 0, 0);
    }
    float tmax = max3f(s[0][0], s[1][0], s[2][0]);
    tmax = max2f(tmax, s[3][0]);
#pragma unroll
    for (int i = 1; i < 16; ++i) { tmax = max3f(tmax, s[0][i], s[1][i]); tmax = max3f(tmax, s[2][i], s[3][i]); }
    tmax = max2f(tmax, lane_xor(tmax, r31 + 32 * hh, 32)) * QK_SCALE;
    if (__any(tmax - m_run > 8.0f)) {
        const float m_new = fmaxf(m_run, tmax);
        const float alpha = __builtin_amdgcn_exp2f(m_run - m_new);
        m_run = m_new; l_run *= alpha;
#pragma unroll
        for (int i = 0; i < 16; ++i) { o0[i] *= alpha; o1[i] *= alpha; }
    }
    const float nm = -m_run;
    float ps0 = 0.f, ps1 = 0.f;
#pragma unroll
    for (int t = 0; t < 4; ++t)
#pragma unroll
        for (int i = 0; i < 16; i += 2) { const float p0 = __builtin_amdgcn_exp2f(fmaf(s[t][i], QK_SCALE, nm)), p1 = __builtin_amdgcn_exp2f(fmaf(s[t][i + 1], QK_SCALE, nm)); s[t][i] = p0; s[t][i + 1] = p1; ps0 += p0; ps1 += p1; }
    l_run += ps0 + ps1;
#pragma unroll
    for (int t = 0; t < 4; ++t) {
        LAS const unsigned char* vp = (t < 2 ? slotA : slotB) + 8192 + r31 * 128;
        const int g0 = 8 * (t & 1) + hh;
        u32x4 pw;
        pw.x = pk2(s[t][0], s[t][1]); pw.y = pk2(s[t][2], s[t][3]); pw.z = pk2(s[t][4], s[t][5]); pw.w = pk2(s[t][6], s[t][7]); const bf16x8 pa = __builtin_bit_cast(bf16x8, pw);
        pw.x = pk2(s[t][8], s[t][9]); pw.y = pk2(s[t][10], s[t][11]); pw.z = pk2(s[t][12], s[t][13]); pw.w = pk2(s[t][14], s[t][15]); const bf16x8 pb = __builtin_bit_cast(bf16x8, pw);
        const u32x2 a0l = *(LAS const u32x2*)(vp + 8 * ((g0) ^ vsw)), a0h = *(LAS const u32x2*)(vp + 8 * ((g0 + 2) ^ vsw));
        const u32x2 a1l = *(LAS const u32x2*)(vp + 8 * ((g0 + 4) ^ vsw)), a1h = *(LAS const u32x2*)(vp + 8 * ((g0 + 6) ^ vsw));
        const u32x2 b0l = *(LAS const u32x2*)(vp + 4096 + 8 * ((g0) ^ vsw)), b0h = *(LAS const u32x2*)(vp + 4096 + 8 * ((g0 + 2) ^ vsw));
        const u32x2 b1l = *(LAS const u32x2*)(vp + 4096 + 8 * ((g0 + 4) ^ vsw)), b1h = *(LAS const u32x2*)(vp + 4096 + 8 * ((g0 + 6) ^ vsw));
        o0 = __builtin_amdgcn_mfma_f32_32x32x16_bf16(__builtin_bit_cast(bf16x8, (u32x4){a0l.x, a0l.y, a0h.x, a0h.y}), pa, o0, 0, 0, 0);
        o1 = __builtin_amdgcn_mfma_f32_32x32x16_bf16(__builtin_bit_cast(bf16x8, (u32x4){b0l.x, b0l.y, b0h.x, b0h.y}), pa, o1, 0, 0, 0);
        o0 = __builtin_amdgcn_mfma_f32_32x32x16_bf16(__builtin_bit_cast(bf16x8, (u32x4){a1l.x, a1l.y, a1h.x, a1h.y}), pb, o0, 0, 0, 0);
        o1 = __builtin_amdgcn_mfma_f32_32x32x16_bf16(__builtin_bit_cast(bf16x8, (u32x4){b1l.x, b1l.y, b1h.x, b1h.y}), pb, o1, 0, 0, 0);
    }
}

__device__ __forceinline__ void attn_block_item(CKArgs& A, int l, int MODE, int item, LAS unsigned char* lds, int tid) {
    asm volatile("" : "+v"(tid));
    unsigned char* ws = A.ws;
    const bf16_t* PT = (const bf16_t*)(ws + WS_PT);
    bf16_t* Y = (bf16_t*)(ws + WS_HY);
    const int wave = __builtin_amdgcn_readfirstlane(tid >> 6), lane = tid & 63;
    const int r31 = lane & 31, hh = lane >> 5;
    int b, h, qtok, qi = 0;
    int rp = 0, mg = 0, qg = 0;
    if (MODE == 0) { b = item / 192; const int rem = item % 192; h = rem >> 5; qi = rem & 31; rp = 2 * qi + (wave >> 2); mg = wave & 3;
        qtok = b * SEQ + (2 * rp + (r31 >> 4)) * 64 + 16 * mg + (r31 & 15); }
    else if (MODE == 1) { b = item / 192; const int rem = item % 192; h = rem >> 5; qi = rem & 31; qg = 8 * qi + wave; qtok = b * SEQ + 32 * qg + r31; }
    else { b = item / 6; h = item % 6; qg = wave; qtok = MLAT + b * CTXL + 32 * qg + r31; }
    const bool grpA = (MODE == 0 || MODE == 2);
    const int kvh = grpA ? h : h / 3;
    const int qcol = (grpA ? C_QA : C_QC) + h * 64, gcol = (grpA ? C_GA : C_GC) + h * 64, ycol = (grpA ? 0 : 640) + h * 64;
    const int kh = grpA ? h : 6 + kvh;
    bf16x8 bq[4];
    { const bf16_t* qp = PT + (size_t)qtok * NTM + qcol + 8 * hh;
#pragma unroll
      for (int s = 0; s < 4; ++s) bq[s] = *(const bf16x8*)(qp + 16 * s); }
    f32x16 o0, o1;
#pragma unroll
    for (int i = 0; i < 16; ++i) { o0[i] = 0.f; o1[i] = 0.f; }
    float m_run = -1e30f, l_run = 0.f;
    if (!grpA) { m_run = A.sink[l * 6 + h] * LOG2E; l_run = hh == 0 ? 1.0f : 0.f; }
    int wrow0 = 0, nwin = 0;
    if (MODE == 0) { const int a0 = min(max(4 * qi - 4, 0), 120), a1 = min(max(4 * qi - 1, 0), 120) + 7; wrow0 = a0; nwin = a1 - a0 + 1; }
    if (MODE == 1) { const int k0 = max(4 * qi - 2, 0), k1 = min(4 * qi + 5, 127); wrow0 = k0; nwin = k1 - k0 + 1; }
    const int nsteps = 4 + nwin;
    int ra = 0, rb = -1, cs = 0, rq = 0, jq = 0, r0 = 0, cmin = 0;
    LAS const float* btab = (LAS const float*)(lds + AUX_OFF + 2048);
    if (MODE == 0) { ra = min(max(2 * rp - 4, 0), 120); rb = min(max(2 * rp - 3, 0), 120) + 7; cs = min(max(16 * mg - 8, 0), 32);
        rq = 2 * rp + (r31 >> 4); jq = 16 * mg + (r31 & 15); r0 = min(max(rq - 4, 0), 120); cmin = min(max(jq - 8, 0), 48) - cs;
        }
    const int lr = tid >> 3, lc = tid & 7;
    const bf16_t* kg = (const bf16_t*)(ws + WS_KH) + (size_t)kh * MTOT * 64 + 8 * tid;
    const bf16_t* vg = (const bf16_t*)(ws + WS_VT) + (size_t)kh * MTOT * 64 + 8 * tid;
    const int kdst = lr * 128 + 16 * (lc ^ ((lr >> 1) & 7));
    const int vdstb = 8192 + (8 * lc) * 128 + 2 * (lr & 3), vg4 = lr >> 2, vs4 = (4 * lc) & 15;
#define ROW_TOK(i) ((i) < 4 ? MLAT + b * CTXL + 64 * (i) : b * SEQ + 64 * (wrow0 + (i) - 4))
#define LOAD_ROW(i, kr_, vr_) do { const int t0_ = ROW_TOK(i); kr_ = *(const u32x4*)(kg + (size_t)t0_ * 64); vr_ = *(const u32x4*)(vg + (size_t)t0_ * 64); } while (0)
#define WRITE_ROW(sl_, kr_, vr_) do { *(LAS u32x4*)((sl_) + kdst) = kr_; \
        _Pragma("unroll") for (int j_ = 0; j_ < 8; ++j_) { const unsigned w_ = j_ < 2 ? vr_.x : (j_ < 4 ? vr_.y : (j_ < 6 ? vr_.z : vr_.w)); \
            *(LAS bf16_t*)((sl_) + vdstb + j_ * 128 + 8 * (vg4 ^ ((vs4 + (j_ >> 1)) & 15))) = (bf16_t)((j_ & 1) ? (w_ >> 16) : (w_ & 0xffffu)); } } while (0)
    u32x4 k0, v0, k1, v1, k2, v2;
    LOAD_ROW(0, k0, v0); LOAD_ROW(1, k2, v2);
    __syncthreads();
    if (MODE == 0 && tid < 465) ((LAS float*)(lds + AUX_OFF + 2048))[tid] = A.na_rpb[(size_t)(l * 6 + h) * 465 + tid] * LOG2E;
    WRITE_ROW(lds, k0, v0); WRITE_ROW(lds + 16384, k2, v2);
    __syncthreads();
#pragma unroll 1
    for (int pr = 0; pr < 2; ++pr) {
        { const int ra_ = pr == 0 ? 2 : min(4, nsteps - 1), rb_ = pr == 0 ? 3 : ra_; LOAD_ROW(ra_, k0, v0); LOAD_ROW(rb_, k2, v2); }
        attn_tile4(lds, lds + 16384, bq, o0, o1, m_run, l_run, r31, hh);
        __syncthreads();
        if (pr == 0) { WRITE_ROW(lds, k0, v0); WRITE_ROW(lds + 16384, k2, v2); } else if (nsteps > 4) { WRITE_ROW(lds, k0, v0); }
        __syncthreads();
    }
#define ATT_STEP(i_, kL, vL, kW, vW) do { const int i = (i_); if (i < nsteps) { \
        LAS const unsigned char* slot = lds + (i & 1) * 16384; \
        { const int ir_ = min(i + 1, nsteps - 1); LOAD_ROW(ir_, kL, vL); }     \
        bool use2 = false, use1 = false, um = false, um1 = false, ub = false; int c1 = 0, lo0 = 0, hi0 = 31, lo1 = 0, hi1 = 31, bidx = 0; \
        if (i < 4) use2 = true; \
        else if (MODE == 0) { const int a = wrow0 + i - 4; use1 = (a >= ra) && (a <= rb); const bool rowok = (a >= r0) && (a < r0 + 8); \
            c1 = cs; lo0 = rowok ? cmin : 1; hi0 = rowok ? cmin + 15 : 0; ub = true; um1 = true; bidx = (a - rq + 7) * 31 + (cs - jq + 15); } \
        else if (MODE == 1) { const int rel0 = (64 * (wrow0 + i - 4) - (32 * qg - 128)) >> 5, rel1 = rel0 + 1;     \
            const bool a0 = (rel0 >= 0) && (rel0 <= 8), a1 = (rel1 >= 0) && (rel1 <= 8); \
            if (a0 && a1) { use2 = true; um = (rel0 == 0) || (rel1 == 8); lo0 = rel0 == 0 ? r31 : 0; hi1 = rel1 == 8 ? r31 : 31; } \
            else if (a0) { use1 = true; um1 = (rel0 == 0) || (rel0 == 8); lo0 = rel0 == 0 ? r31 : 0; hi0 = rel0 == 8 ? r31 : 31; } \
            else if (a1) { use1 = true; c1 = 32; um1 = (rel1 == 0) || (rel1 == 8); lo0 = rel1 == 0 ? r31 : 0; hi0 = rel1 == 8 ? r31 : 31; } } \
        if (use2) attn_tile2(slot, bq, o0, o1, m_run, l_run, r31, hh, um, lo0, hi0, lo1, hi1); \
        if (use1) attn_tile(slot, c1, bq, o0, o1, m_run, l_run, r31, hh, um1, lo0, hi0, ub, btab, bidx); \
        if (i + 1 < nsteps) { LAS unsigned char* nslot = lds + ((i + 1) & 1) * 16384; WRITE_ROW(nslot, kW, vW); } \
        __syncthreads(); } } while (0)
#pragma unroll 1
    for (int i3 = 4; i3 < nsteps; ++i3) {
        ATT_STEP(i3, k1, v1, k1, v1);
    }
#undef ATT_STEP
#undef LOAD_ROW
#undef WRITE_ROW
    const float ltot = l_run + lane_xor(l_run, lane, 32);
    const float inv = 1.0f / ltot;
    const bf16_t* gp = PT + (size_t)qtok * NTM + gcol + 4 * hh;
    bf16_t* yp = Y + (size_t)qtok * DM + ycol + 4 * hh;
#pragma unroll
    for (int db = 0; db < 2; ++db)
#pragma unroll
        for (int g4 = 0; g4 < 4; ++g4) {
            const int d0 = 32 * db + 8 * g4;
            const u32x2 gw = *(const u32x2*)(gp + d0);
            float v0, v1, v2, v3;
            if (db == 0) { v0 = o0[4 * g4]; v1 = o0[4 * g4 + 1]; v2 = o0[4 * g4 + 2]; v3 = o0[4 * g4 + 3]; }
            else { v0 = o1[4 * g4]; v1 = o1[4 * g4 + 1]; v2 = o1[4 * g4 + 2]; v3 = o1[4 * g4 + 3]; }
            v0 *= inv * silu_f(bflo(gw.x)); v1 *= inv * silu_f(bfhi(gw.x)); v2 *= inv * silu_f(bflo(gw.y)); v3 *= inv * silu_f(bfhi(gw.y));
            u32x2 o; o.x = pk2(v0, v1); o.y = pk2(v2, v3);
            *(u32x2*)(yp + d0) = o;
        }
}

typedef float cf2 __attribute__((ext_vector_type(2)));
__device__ __forceinline__ cf2 mk2(float x, float y) { cf2 r; r.x = x; r.y = y; return r; }
__device__ __forceinline__ cf2 cmul(cf2 a, cf2 b) { const cf2 bs = mk2(-b.y, b.x); return a.xx * b + a.yy * bs; }
#define PA(e) ((e) + (((e) >> 4) << 1))
struct cf2x4 { cf2 a, b, c, d; };
__device__ __forceinline__ cf2x4 bfly4_fwd(cf2 x0, cf2 x1, cf2 x2, cf2 x3, float a) {
    const cf2 w1 = mk2(__builtin_amdgcn_cosf(a), -__builtin_amdgcn_sinf(a));
    const cf2 w2 = cmul(w1, w1), w3 = cmul(w2, w1);
    const cf2 s02 = x0 + x2, d02 = x0 - x2, s13 = x1 + x3, d13 = x1 - x3;
    cf2x4 r;
    r.a = s02 + s13;
    r.b = cmul(s02 - s13, w2);
    r.c = cmul(mk2(d02.x + d13.y, d02.y - d13.x), w1);
    r.d = cmul(mk2(d02.x - d13.y, d02.y + d13.x), w3);
    return r;
}
__device__ __forceinline__ cf2x4 bfly4_inv(cf2 v0, cf2 v1, cf2 v2, cf2 v3, float a) {
    const cf2 w1 = mk2(__builtin_amdgcn_cosf(a), __builtin_amdgcn_sinf(a));
    const cf2 w2 = cmul(w1, w1);
    const cf2 bb = cmul(v1, w2), dd = cmul(v3, w2);
    const cf2 u0 = v0 + bb, u1 = v0 - bb, u2 = v2 + dd, u3 = v2 - dd;
    const cf2 e = cmul(u2, w1), f0 = cmul(u3, w1);
    const cf2 f = mk2(-f0.y, f0.x);
    cf2x4 r; r.a = u0 + e; r.c = u0 - e; r.b = u1 + f; r.d = u1 - f; return r;
}
__device__ __forceinline__ void fft_fwd_fused(LAS cf2* buf, int tid, int lsb, bool zero_hi = false) {
    const int sB = 1 << lsb, s = 4 << lsb;
    const float ra = 1.0f / (float)(16 << lsb), rb = 1.0f / (float)(4 << lsb);
    int poff[4][4];
#pragma unroll
    for (int a = 0; a < 4; ++a)
#pragma unroll
        for (int b = 0; b < 4; ++b) { const int off = a * s + b * sB; poff[a][b] = PA(off); }
#pragma unroll 1
    for (int gg = 0; gg < 2; ++gg) {
        const int g = tid + 512 * gg, i = g & (sB - 1), base = ((g >> lsb) << (lsb + 4)) + i;
        const int pbase = PA(base);
        cf2 x[4][4];
#pragma unroll
        for (int a = 0; a < 4; ++a)
#pragma unroll
            for (int b = 0; b < 4; ++b) x[a][b] = (zero_hi && a >= 2) ? mk2(0.f, 0.f) : buf[pbase + poff[a][b]];
#pragma unroll
        for (int b = 0; b < 4; ++b) { const cf2x4 r = bfly4_fwd(x[0][b], x[1][b], x[2][b], x[3][b], (float)(i + b * sB) * ra); x[0][b] = r.a; x[1][b] = r.b; x[2][b] = r.c; x[3][b] = r.d; }
        const float ab = (float)i * rb;
#pragma unroll
        for (int a = 0; a < 4; ++a) { const cf2x4 r = bfly4_fwd(x[a][0], x[a][1], x[a][2], x[a][3], ab); x[a][0] = r.a; x[a][1] = r.b; x[a][2] = r.c; x[a][3] = r.d; }
#pragma unroll
        for (int a = 0; a < 4; ++a)
#pragma unroll
            for (int b = 0; b < 4; ++b) buf[pbase + poff[a][b]] = x[a][b];
    }
    __syncthreads();
}
__device__ __forceinline__ void fft_inv_fused(LAS cf2* buf, int tid, int lsb) {
    const int sB = 1 << lsb, s = 4 << lsb;
    const float ra = 1.0f / (float)(16 << lsb), rb = 1.0f / (float)(4 << lsb);
    int poff[4][4];
#pragma unroll
    for (int a = 0; a < 4; ++a)
#pragma unroll
        for (int b = 0; b < 4; ++b) { const int off = a * s + b * sB; poff[a][b] = PA(off); }
#pragma unroll 1
    for (int gg = 0; gg < 2; ++gg) {
        const int g = tid + 512 * gg, i = g & (sB - 1), base = ((g >> lsb) << (lsb + 4)) + i;
        const int pbase = PA(base);
        cf2 x[4][4];
#pragma unroll
        for (int a = 0; a < 4; ++a)
#pragma unroll
            for (int b = 0; b < 4; ++b) x[a][b] = buf[pbase + poff[a][b]];
        const float ab = (float)i * rb;
#pragma unroll
        for (int a = 0; a < 4; ++a) { const cf2x4 r = bfly4_inv(x[a][0], x[a][1], x[a][2], x[a][3], ab); x[a][0] = r.a; x[a][1] = r.b; x[a][2] = r.c; x[a][3] = r.d; }
#pragma unroll
        for (int b = 0; b < 4; ++b) { const cf2x4 r = bfly4_inv(x[0][b], x[1][b], x[2][b], x[3][b], (float)(i + b * sB) * ra); x[0][b] = r.a; x[1][b] = r.b; x[2][b] = r.c; x[3][b] = r.d; }
#pragma unroll
        for (int a = 0; a < 4; ++a)
#pragma unroll
            for (int b = 0; b < 4; ++b) buf[pbase + poff[a][b]] = x[a][b];
    }
    __syncthreads();
}
__device__ __forceinline__ void fft_fwd(LAS cf2* buf, int tid, const unsigned* zk = nullptr, bool zero_hi = false) {
#pragma unroll 1
    for (int lsb = 10; lsb >= 2; lsb -= 4) fft_fwd_fused(buf, tid, lsb, zero_hi && lsb == 10);
#pragma unroll 4
    for (int k = 0; k < 8; ++k) {
        const int e0 = 4 * (tid + 512 * k), base = PA(e0);
        cf2 x0 = buf[base], x1 = buf[base + 1], x2 = buf[base + 2], x3 = buf[base + 3];
        const cf2 s02 = x0 + x2, d02 = x0 - x2, s13 = x1 + x3, d13 = x1 - x3;
        cf2 y0 = s02 + s13, y1 = s02 - s13, y2 = mk2(d02.x + d13.y, d02.y - d13.x), y3 = mk2(d02.x - d13.y, d02.y + d13.x);
        if (zk) { const u32x4 w = *(const u32x4*)(zk + (unsigned)e0);
            y0 = cmul(y0, mk2(bflo(w.x), bfhi(w.x))); y1 = cmul(y1, mk2(bflo(w.y), bfhi(w.y))); y2 = cmul(y2, mk2(bflo(w.z), bfhi(w.z))); y3 = cmul(y3, mk2(bflo(w.w), bfhi(w.w))); }
        buf[base] = y0; buf[base + 1] = y1; buf[base + 2] = y2; buf[base + 3] = y3;
    }
    __syncthreads();
}
__device__ __forceinline__ void fft_inv(LAS cf2* buf, int tid) {
#pragma unroll 1
    for (int lsb = 0; lsb <= 8; lsb += 4) fft_inv_fused(buf, tid, lsb);
#pragma unroll 4
    for (int k = 0; k < 8; ++k) {
        const int i = tid + 512 * k, pi = PA(tid) + 576 * k;
        cf2 v0 = buf[pi], v1 = buf[pi + 4608], v2 = buf[pi + 9216], v3 = buf[pi + 13824];
        const cf2x4 r = bfly4_inv(v0, v1, v2, v3, (float)i * (1.0f / 16384.0f));
        buf[pi] = r.a; buf[pi + 4608] = r.b;
    }
    __syncthreads();
}
__device__ __forceinline__ float hy_short(const bf16_t* prow, int tb, int t, int L, float w0, float w1, float w2, float bias) {
    const float pm = t > 0 ? bf2f(prow[tb + t - 1]) : 0.f;
    const float pc = bf2f(prow[tb + t]);
    const float pp = t < L - 1 ? bf2f(prow[tb + t + 1]) : 0.f;
    return w0 * pm + w1 * pc + w2 * pp + bias;
}
__device__ __forceinline__ float block_sum(float v, LAS float* red, int tid) {
    v = wave_sum(v, tid & 63);
    __syncthreads();
    if ((tid & 63) == 0) red[tid >> 6] = v;
    __syncthreads();
    float s = 0.f;
#pragma unroll
    for (int w = 0; w < 8; ++w) s += red[w];
    return s;
}

__device__ __forceinline__ void hyena_block(CKArgs& A, int l, int c, LAS unsigned char* lds, int tid) {
    asm volatile("" : "+v"(tid));
    unsigned char* ws = A.ws;
    LAS cf2* buf = (LAS cf2*)lds;
    LAS float* fs = (LAS float*)lds;
    LAS float* aux = (LAS float*)(lds + AUX_OFF);
    LAS float* red = aux + 256;
    const bf16_t* PCT = (const bf16_t*)(ws + WS_PCT);
    bf16_t* YBT = (bf16_t*)((unsigned char*)A.out + OUT_YBT);
    const bf16_t* rowz = PCT + (size_t)(R_HZ + c) * MTOT;
    const bf16_t* rowx1 = rowz + (size_t)256 * MTOT;
    const bf16_t* rowx2 = rowz + (size_t)512 * MTOT;
    const bf16_t* rowg = PCT + (size_t)(R_GB + c) * MTOT;
    const float* cw = A.hy_conv_w + (size_t)l * 3 * 768; const float* cb = A.hy_conv_b + (size_t)l * 768;
    const float wz0 = cw[c], wz1 = cw[768 + c], wz2 = cw[1536 + c], bz = cb[c];
    const float wa0 = cw[256 + c], wa1 = cw[768 + 256 + c], wa2 = cw[1536 + 256 + c], ba = cb[256 + c];
    const float wb0 = cw[512 + c], wb1 = cw[768 + 512 + c], wb2 = cw[1536 + 512 + c], bb = cb[512 + c];
    const float d0 = A.hy_d[(l * 2 + 0) * 256 + c], d1 = A.hy_d[(l * 2 + 1) * 256 + c];
    const float dmin = -3.0701134573253945f, dmax = -15.350567286626973f;
    const float delta = fabsf(dmin + (float)c * ((dmax - dmin) / 255.0f));
    __syncthreads();
    if (tid < 256) { const int k = tid >> 6, j = tid & 63; aux[tid] = A.hy_w3[((size_t)l * 64 + j) * 1024 + k * 256 + c]; }
    __syncthreads();

    if (l < DEPTH - 1) {
        float ss0 = 0.f, ss1 = 0.f;
        if (tid < 256) {
            const int n = tid; const f32x4* hr = (const f32x4*)((const float*)(ws + WS_H2C) + ((size_t)l * CTXL + n) * 64);
            float f0 = 0.f, f1 = 0.f, b0 = 0.f, b1 = 0.f;
#pragma unroll 1
            for (int j4 = 0; j4 < 16; ++j4) { const f32x4 hv = hr[j4];
#pragma unroll
                for (int e = 0; e < 4; ++e) { const float hvv = hv[e]; const int j = 4 * j4 + e; f0 += hvv * aux[j]; f1 += hvv * aux[64 + j]; b0 += hvv * aux[128 + j]; b1 += hvv * aux[192 + j]; } }
            const float e = __expf(-((float)n * (1.0f / 255.0f)) * delta);
            f0 *= e; f1 *= e; b0 *= e; b1 *= e;
            fs[255 + n] = f0; fs[512 + 255 + n] = f1;
            if (n >= 1) { fs[255 - n] = b0; fs[512 + 255 - n] = b1; }
            ss0 = f0 * f0 + (n >= 1 ? b0 * b0 : 0.f); ss1 = f1 * f1 + (n >= 1 ? b1 * b1 : 0.f);
        }
        if (tid == 0) { fs[511] = 0.f; fs[1023] = 0.f; }
        const int b = tid >> 8, t = tid & 255, tok = MLAT + b * CTXL;
        const float z = hy_short(rowz, tok, t, CTXL, wz0, wz1, wz2, bz);
        const float x1 = hy_short(rowx1, tok, t, CTXL, wa0, wa1, wa2, ba);
        const float x2 = hy_short(rowx2, tok, t, CTXL, wb0, wb1, wb2, bb);
        const float gb = bf2f(rowg[tok + t]);
        fs[1024 + tid] = z;
        const float n0 = rsqrtf(block_sum(ss0, red, tid) + 1e-6f);
        const float n1 = rsqrtf(block_sum(ss1, red, tid) + 1e-6f);
        __syncthreads();
        float y = 0.f;
        { LAS const float* kc = fs + 255 + t; LAS const float* zz = fs + 1024 + b * 256;
#pragma unroll 8
          for (int s = 0; s < 256; ++s) y += zz[s] * kc[-s]; }
        const float z1 = x1 * (y * n0 + d0 * z);
        fs[1536 + tid] = z1;
        __syncthreads();
        float y2 = 0.f;
        { LAS const float* kc = fs + 512 + 255 + t; LAS const float* zz = fs + 1536 + b * 256;
#pragma unroll 8
          for (int s = 0; s < 256; ++s) y2 += zz[s] * kc[-s]; }
        const float o = x2 * (y2 * n1 + d1 * z1) * silu_f(gb);
        YBT[(size_t)c * MTOT + tok + t] = (bf16_t)(pk2(o, 0.f) & 0xffffu);
        __syncthreads();
    }

    unsigned* ZK = (unsigned*)((unsigned char*)A.out + OUT_ZS) + (size_t)c * 2 * NFFT;
    const int lane = tid & 63;
    {
        float ss0 = 0.f, ss1 = 0.f;
        const bf16_t* F0 = (const bf16_t*)((unsigned char*)A.out + OUT_FILT) + (size_t)c * SEQ;
        u32x4 fw[2][4];
#pragma unroll
        for (int j = 0; j < 2; ++j)
#pragma unroll
            for (int r = 0; r < 4; ++r) fw[j][r] = *(const u32x4*)(F0 + (size_t)(256 * r) * SEQ + 8 * (tid + 512 * j));
#pragma unroll
        for (int j = 0; j < 2; ++j)
#pragma unroll
            for (int e8 = 0; e8 < 8; ++e8) {
                const int n = 8 * (tid + 512 * j) + e8;
                const float e = __expf(-((float)n * (1.0f / 8191.0f)) * delta);
                const unsigned w0 = e8 < 2 ? fw[j][0].x : (e8 < 4 ? fw[j][0].y : (e8 < 6 ? fw[j][0].z : fw[j][0].w)), w1 = e8 < 2 ? fw[j][1].x : (e8 < 4 ? fw[j][1].y : (e8 < 6 ? fw[j][1].z : fw[j][1].w));
                const unsigned w2 = e8 < 2 ? fw[j][2].x : (e8 < 4 ? fw[j][2].y : (e8 < 6 ? fw[j][2].z : fw[j][2].w)), w3 = e8 < 2 ? fw[j][3].x : (e8 < 4 ? fw[j][3].y : (e8 < 6 ? fw[j][3].z : fw[j][3].w));
                const float f0 = ((e8 & 1) ? bfhi(w0) : bflo(w0)) * e, f1 = ((e8 & 1) ? bfhi(w1) : bflo(w1)) * e, b0 = ((e8 & 1) ? bfhi(w2) : bflo(w2)) * e, b1 = ((e8 & 1) ? bfhi(w3) : bflo(w3)) * e;
                buf[PA(n)] = mk2(f0, f1); ss0 += f0 * f0; ss1 += f1 * f1;
                if (n >= 1) { buf[PA(NFFT - n)] = mk2(b0, b1); ss0 += b0 * b0; ss1 += b1 * b1; }
            }
        if (tid == 0) { const float zf = delta * 0.0f; buf[PA(SEQ)] = mk2(zf, zf); }
        const float nrm0 = rsqrtf(block_sum(ss0, red, tid) + 1e-6f) * (0.5f / NFFT);
        const float nrm1 = rsqrtf(block_sum(ss1, red, tid) + 1e-6f) * (0.5f / NFFT);
        __syncthreads();
        fft_fwd(buf, tid);
#pragma unroll 4
        for (int k = 0; k < 32; ++k) {
            const int p = tid + 512 * k; const int f = (int)(__brev((unsigned)p) >> 18); const int pp = (int)(__brev((unsigned)((NFFT - f) & (NFFT - 1))) >> 18);
            const cf2 za = buf[PA(p)], zb = buf[PA(pp)];
            ZK[p] = pk2((za.x + zb.x) * nrm0 + d0 * (1.0f / NFFT), (za.y - zb.y) * nrm0);
            ZK[NFFT + p] = pk2((za.y + zb.y) * nrm1 + d1 * (1.0f / NFFT), -(za.x - zb.x) * nrm1);
        }
        __syncthreads();
    }
#define HY_RAW(prow_, j_, b_) (*(const u32x4*)((prow_) + (size_t)(b_) * SEQ + 8 * (tid + 512 * (j_))))
#define HY_CONV(prow_, raw_, j_, b_, w0_, w1_, w2_, bias_, u_) do { \
        const int q_ = tid + 512 * (j_); float own_[8]; \
        own_[0] = bflo((raw_).x); own_[1] = bfhi((raw_).x); own_[2] = bflo((raw_).y); own_[3] = bfhi((raw_).y); own_[4] = bflo((raw_).z); own_[5] = bfhi((raw_).z); own_[6] = bflo((raw_).w); own_[7] = bfhi((raw_).w); \
        float pl_ = lane_prev(own_[7], lane), nl_ = lane_next(own_[0], lane); \
        if (lane == 0) pl_ = q_ > 0 ? bf2f((prow_)[(size_t)(b_) * SEQ + 8 * q_ - 1]) : 0.f; \
        if (lane == 63) nl_ = 8 * q_ + 8 < SEQ ? bf2f((prow_)[(size_t)(b_) * SEQ + 8 * q_ + 8]) : 0.f; \
        _Pragma("unroll") for (int e = 0; e < 8; ++e) (u_)[e] = (w0_) * (e > 0 ? own_[e > 0 ? e - 1 : 0] : pl_) + (w1_) * own_[e] + (w2_) * (e < 7 ? own_[e < 7 ? e + 1 : 7] : nl_) + (bias_); } while (0)
    const int pq0 = PA(8 * tid), pq1 = PA(8 * (tid + 512));
    {
        const u32x4 r00 = HY_RAW(rowz, 0, 0), r01 = HY_RAW(rowz, 0, 1), r10 = HY_RAW(rowz, 1, 0), r11 = HY_RAW(rowz, 1, 1);
        float ua[8], ub[8];
        HY_CONV(rowz, r00, 0, 0, wz0, wz1, wz2, bz, ua); HY_CONV(rowz, r01, 0, 1, wz0, wz1, wz2, bz, ub);
#pragma unroll
        for (int e = 0; e < 8; ++e) buf[pq0 + e] = mk2(ua[e], ub[e]);
        HY_CONV(rowz, r10, 1, 0, wz0, wz1, wz2, bz, ua); HY_CONV(rowz, r11, 1, 1, wz0, wz1, wz2, bz, ub);
#pragma unroll
        for (int e = 0; e < 8; ++e) buf[pq1 + e] = mk2(ua[e], ub[e]);
    }
    __syncthreads();
    fft_fwd(buf, tid, ZK, true);
    fft_inv(buf, tid);
    {
        const u32x4 r00 = HY_RAW(rowx1, 0, 0), r01 = HY_RAW(rowx1, 0, 1), r10 = HY_RAW(rowx1, 1, 0), r11 = HY_RAW(rowx1, 1, 1);
        float xa[8], xb[8];
        HY_CONV(rowx1, r00, 0, 0, wa0, wa1, wa2, ba, xa); HY_CONV(rowx1, r01, 0, 1, wa0, wa1, wa2, ba, xb);
#pragma unroll
        for (int e = 0; e < 8; ++e) { const cf2 y = buf[pq0 + e]; buf[pq0 + e] = mk2(xa[e] * y.x, xb[e] * y.y); }
        HY_CONV(rowx1, r10, 1, 0, wa0, wa1, wa2, ba, xa); HY_CONV(rowx1, r11, 1, 1, wa0, wa1, wa2, ba, xb);
#pragma unroll
        for (int e = 0; e < 8; ++e) { const cf2 y = buf[pq1 + e]; buf[pq1 + e] = mk2(xa[e] * y.x, xb[e] * y.y); }
    }
    __syncthreads();
    fft_fwd(buf, tid, ZK + NFFT, true);
    fft_inv(buf, tid);
    {
        bf16_t* yrow = YBT + (size_t)c * MTOT;
        const u32x4 r00 = HY_RAW(rowx2, 0, 0), r01 = HY_RAW(rowx2, 0, 1), r10 = HY_RAW(rowx2, 1, 0), r11 = HY_RAW(rowx2, 1, 1);
        const u32x4 g00 = HY_RAW(rowg, 0, 0), g01 = HY_RAW(rowg, 0, 1), g10 = HY_RAW(rowg, 1, 0), g11 = HY_RAW(rowg, 1, 1);
        float xa[8], xb[8];
#define HY_OUT(pq_, ga_, gb_, j_) do { float oa_[8], ob_[8]; \
            const float gaf_[8] = {bflo((ga_).x), bfhi((ga_).x), bflo((ga_).y), bfhi((ga_).y), bflo((ga_).z), bfhi((ga_).z), bflo((ga_).w), bfhi((ga_).w)}; \
            const float gbf_[8] = {bflo((gb_).x), bfhi((gb_).x), bflo((gb_).y), bfhi((gb_).y), bflo((gb_).z), bfhi((gb_).z), bflo((gb_).w), bfhi((gb_).w)}; \
            _Pragma("unroll") for (int e = 0; e < 8; ++e) { const cf2 y = buf[(pq_) + e]; oa_[e] = xa[e] * y.x * silu_f(gaf_[e]); ob_[e] = xb[e] * y.y * silu_f(gbf_[e]); } \
            u32x4 wa_, wb_; wa_.x = pk2(oa_[0], oa_[1]); wa_.y = pk2(oa_[2], oa_[3]); wa_.z = pk2(oa_[4], oa_[5]); wa_.w = pk2(oa_[6], oa_[7]); \
            wb_.x = pk2(ob_[0], ob_[1]); wb_.y = pk2(ob_[2], ob_[3]); wb_.z = pk2(ob_[4], ob_[5]); wb_.w = pk2(ob_[6], ob_[7]); \
            *(u32x4*)(yrow + 8 * (tid + 512 * (j_))) = wa_; *(u32x4*)(yrow + SEQ + 8 * (tid + 512 * (j_))) = wb_; } while (0)
        HY_CONV(rowx2, r00, 0, 0, wb0, wb1, wb2, bb, xa); HY_CONV(rowx2, r01, 0, 1, wb0, wb1, wb2, bb, xb);
        HY_OUT(pq0, g00, g01, 0);
        HY_CONV(rowx2, r10, 1, 0, wb0, wb1, wb2, bb, xa); HY_CONV(rowx2, r11, 1, 1, wb0, wb1, wb2, bb, xb);
        HY_OUT(pq1, g10, g11, 1);
#undef HY_OUT
    }
#undef HY_RAW
#undef HY_CONV
    __syncthreads();
}

__device__ __forceinline__ void phase_mix(CKArgs& A, int l, LAS unsigned char* lds, int bid, int nblk, int tid) {
    for (int c = bid; c < 256; c += nblk) hyena_block(A, l, c, lds, tid);
    const int nctx = (l < DEPTH - 1) ? 12 : 0;
    const int nitems = 768 + 2 * nctx;
#pragma unroll 1
    for (int it = bid; it < nitems; it += nblk) {
        int mode, item;
        if (it < 384) { mode = 0; item = it; } else if (it < 768) { mode = 1; item = it - 384; } else if (it < 768 + nctx) { mode = 2; item = it - 768; } else { mode = 3; item = it - 768 - nctx; }
        attn_block_item(A, l, mode, item, lds, tid);
    }
}

__device__ __forceinline__ void phase_tr(CKArgs& A, int l, LAS unsigned char* lds, int bid, int nblk, int tid) {
    const int wave = __builtin_amdgcn_readfirstlane(tid >> 6), lane = tid & 63;
    const int gw = bid * 8 + wave, NGW = nblk * 8;
    unsigned char* ws = A.ws;
    const bf16_t* YBT = (const bf16_t*)((unsigned char*)A.out + OUT_YBT);
    bf16_t* Y = (bf16_t*)(ws + WS_HY);
    LAS bf16_t* scr = (LAS bf16_t*)(lds + wave * 16384);
    const int ntok = (l < DEPTH - 1) ? MTOT : MLAT;
    const int nitems = (ntok / 64) * 4;
#pragma unroll 1
    for (int it = gw; it < nitems; it += NGW) {
        const int tb = (it >> 2) * 64, cb = (it & 3) * 64;
        u32x4 ld[8];
#pragma unroll
        for (int j = 0; j < 8; ++j) { const int idx = lane + 64 * j; ld[j] = *(const u32x4*)(YBT + (size_t)(cb + (idx >> 3)) * MTOT + tb + 8 * (idx & 7)); }
#pragma unroll
        for (int j = 0; j < 8; ++j) { const int idx = lane + 64 * j, ch = idx >> 3, t8 = 8 * (idx & 7);
#pragma unroll
            for (int e = 0; e < 8; ++e) { const unsigned w = e < 2 ? ld[j].x : (e < 4 ? ld[j].y : (e < 6 ? ld[j].z : ld[j].w));
                scr[(t8 + e) * 68 + ch] = (bf16_t)((e & 1) ? (w >> 16) : (w & 0xffffu)); } }
        asm volatile("s_waitcnt lgkmcnt(0)" ::: "memory");
#pragma unroll
        for (int k = 0; k < 8; ++k) {
            const int tq = (lane >> 3) + 8 * k, cc = (lane & 7) * 8;
            const u32x2 a = *(LAS const u32x2*)(scr + tq * 68 + cc), b2 = *(LAS const u32x2*)(scr + tq * 68 + cc + 4);
            u32x4 o; o.x = a.x; o.y = a.y; o.z = b2.x; o.w = b2.y;
            *(u32x4*)(Y + (size_t)(tb + tq) * DM + 384 + cb + cc) = o;
        }
        asm volatile("s_waitcnt lgkmcnt(0)" ::: "memory");
    }
}

__device__ __forceinline__ void phase_final(CKArgs& A, int bid, int nblk, int tid) {
    const int wave = __builtin_amdgcn_readfirstlane(tid >> 6), lane = tid & 63;
    const int gw = bid * 8 + wave, NGW = nblk * 8;
    for (int m = gw; m < MLAT; m += NGW) {
        float* row = A.out + (size_t)m * DM;
        f32x4 xv[4]; float ss = 0.f;
#pragma unroll
        for (int j = 0; j < 4; ++j) { xv[j] = *(const f32x4*)(row + 4 * lane + 256 * j); ss += (xv[j].x * xv[j].x + xv[j].y * xv[j].y) + (xv[j].z * xv[j].z + xv[j].w * xv[j].w); }
        const float rinv = rsqrtf(wave_sum(ss, lane) * (1.0f / DM) + 1e-6f);
#pragma unroll
        for (int j = 0; j < 4; ++j) { const int col = 4 * lane + 256 * j; const f32x4 gv = *(const f32x4*)(A.final_g + col); *(f32x4*)(row + col) = xv[j] * rinv * gv; }
    }
}

#define XB_TMO      128
#define XB_XCNT(j)  (256  + 64 * (j))
#define XB_XSUB(j)  (1280 + 64 * (j))
#define XB_XGEN(j)  (2304 + 64 * (j))
#define XB_TOP      3328
#define XB_TOPGEN   3392
#define XCD_BAR_WORDS 3456
#define XB_SPIN_CAP (1u << 18)

__device__ __forceinline__ unsigned xb_ld(unsigned* p)              { return __hip_atomic_load(p, __ATOMIC_RELAXED, __HIP_MEMORY_SCOPE_AGENT); }
__device__ __forceinline__ unsigned xb_add(unsigned* p, unsigned v) { return __hip_atomic_fetch_add(p, v, __ATOMIC_RELAXED, __HIP_MEMORY_SCOPE_AGENT); }
__device__ __forceinline__ unsigned xb_xcc_id() { return (unsigned)__builtin_amdgcn_s_getreg((3 << 11) | 20) & 0xFu; }
#define XB_SPIN(cond, bar) do { unsigned _sp = 0; while (cond) { __builtin_amdgcn_s_sleep(1); \
    if ((++_sp & 255u) == 0u) { if (xb_ld(&(bar)[XB_TMO])) break; if (_sp > XB_SPIN_CAP) { atomicAdd(&(bar)[XB_TMO], 1u); break; } } } } while (0)

struct XcdBarrier {
    unsigned* bar; unsigned x;
    volatile LAS unsigned* st;
};

__device__ __forceinline__ XcdBarrier xcd_barrier_post(unsigned* bar, volatile LAS unsigned* st) {
    XcdBarrier b; b.bar = bar; b.x = xb_xcc_id(); b.st = st;
    if (threadIdx.x == 0) (void)xb_add(&bar[XB_XCNT(b.x)], 1u);
    return b;
}
__device__ __forceinline__ void xcd_barrier_complete(unsigned* bar, unsigned x, unsigned& nloc, unsigned& nx) {
    const unsigned G = gridDim.x * gridDim.y * gridDim.z;
    unsigned sum, cnt, mine, sp = 0u;
    for (;;) {
        sum = 0u; cnt = 0u; mine = 0u;
#pragma unroll
        for (unsigned j = 0; j < 16; ++j) { const unsigned c = xb_ld(&bar[XB_XCNT(j)]); sum += c; cnt += (c > 0u) ? 1u : 0u; mine = (j == x) ? c : mine; }
        if (sum == G) break;
        __builtin_amdgcn_s_sleep(1);
        if ((++sp & 255u) == 0u) { if (xb_ld(&bar[XB_TMO])) break; if (sp > XB_SPIN_CAP) { atomicAdd(&bar[XB_TMO], 1u); break; } }
    }
    nloc = mine > 0u ? mine : 1u; nx = cnt > 0u ? cnt : 1u;
}

__device__ __forceinline__ void xcd_barrier(const XcdBarrier& b) {
    asm volatile("s_waitcnt vmcnt(0)" ::: "memory");
    __syncthreads();
    if (threadIdx.x == 0) {
        unsigned* bar = b.bar;
        __builtin_amdgcn_s_waitcnt(0);
        unsigned nloc = b.st[0], nx = b.st[1];
        if (nloc == 0u) { xcd_barrier_complete(bar, b.x, nloc, nx); b.st[0] = nloc; b.st[1] = nx; }
        const unsigned old = xb_add(&bar[XB_XSUB(b.x)], 1u);
        const unsigned gen = old / nloc;
        if (old + 1u == (gen + 1u) * nloc) {
            __builtin_amdgcn_fence(__ATOMIC_RELEASE, "agent");
            asm volatile("s_waitcnt vmcnt(0)" ::: "memory");
            const unsigned og = xb_add(&bar[XB_TOP], 1u);
            const unsigned tg = og / nx;
            if (og + 1u == (tg + 1u) * nx) xb_add(&bar[XB_TOPGEN], 1u);
            else XB_SPIN(xb_ld(&bar[XB_TOPGEN]) == tg, bar);
            __builtin_amdgcn_fence(__ATOMIC_ACQUIRE, "agent");
            xb_add(&bar[XB_XGEN(b.x)], 1u);
            asm volatile("s_waitcnt vmcnt(0)" ::: "memory");
        } else {
            XB_SPIN(xb_ld(&bar[XB_XGEN(b.x)]) == gen, bar);
            __builtin_amdgcn_fence(__ATOMIC_ACQUIRE, "agent");
            asm volatile("s_waitcnt vmcnt(0)" ::: "memory");
        }
    }
    __syncthreads();
}


constexpr int NPHASE = 2 + 5 * DEPTH;
__global__ void __launch_bounds__(NTHREADS, 2) hybrid_fwd(KArgs Aval) {
    extern __shared__ __attribute__((aligned(16))) unsigned char lds_raw[];
    LAS unsigned char* lds = (LAS unsigned char*)lds_raw;
    const int tid0 = threadIdx.x, bid = blockIdx.x, nblk = gridDim.x;
    const int wave0 = __builtin_amdgcn_readfirstlane(tid0 >> 6);
#if !MK_MULTI
    volatile LAS unsigned* bst = (volatile LAS unsigned*)(lds + AUX_OFF + 8192);
    if (tid0 < 2) bst[tid0] = 0u;
    __syncthreads();
    const XcdBarrier bar = xcd_barrier_post((unsigned*)Aval.ws, bst);
#endif
#ifndef REP_PH
#define REP_PH 1000
#endif
#pragma unroll 1
    for (int pi = Aval.ph_lo; pi < Aval.ph_hi + (REP_PH < 1000 ? 1 : 0); ++pi) {
        const int ph = pi <= REP_PH ? pi : pi - 1;
#if !MK_MULTI
        if (pi > Aval.ph_lo) { if (Aval.ph_hi > 100000) cg::this_grid().sync(); else xcd_barrier(bar); }
#endif
#ifndef ONLY
#define ONLY -1
#endif
#define EN(k) (ONLY < 0 || ((ONLY >> (k)) & 1))
        int tid; asm volatile("v_mbcnt_lo_u32_b32 %0, -1, 0\n\tv_mbcnt_hi_u32_b32 %0, -1, %0" : "=v"(tid)); tid += wave0 * 64;
        CKArgs* Ap = (CKArgs*)__builtin_amdgcn_kernarg_segment_ptr(); asm volatile("" : "+s"(Ap));
        CKArgs& A = *Ap;
        unsigned char* ws = A.ws;
        if (ph == 0) { if (EN(0)) phase_prologue(A, lds, bid, nblk, tid); }
        else if (ph == NPHASE - 1) { if (EN(6)) phase_final(A, bid, nblk, tid); }
        else {
            const int l = (ph - 1) / 5, k = (ph - 1) % 5;
            if (k == 0) { if (EN(1)) phase_norm(A, l, bid, nblk, tid); }
            else if (k == 2) { if (EN(3)) phase_mix(A, l, lds, bid, nblk, tid); }
            else if (k == 3) { if (EN(4)) phase_tr(A, l, lds, bid, nblk, tid); }
            if (k == 1 || k == 4) {
                pg8::Gemm g; EpiAll E; E.l = l; E.Ap = Ap; g.A = (const bf16_t*)(ws + WS_HY); g.K = DM;
                if (k == 1) { g.Bt = (const bf16_t*)(ws + WS_WIN) + (size_t)l * NIN * DM; g.M = MTOT; g.N = NIN; E.mode = 0; }
                else { g.Bt = (const bf16_t*)(ws + WS_WOUT) + (size_t)l * DM * DM; g.M = MLAT; g.N = DM; E.mode = 1; }
                pg8::StaticOrder S; S.init(g.M, g.N, nblk, bid);
                if (EN(2)) pg8::gemm_phase<EpiAll, pg8::StaticOrder, true, true>(lds, g, S, E, tid);
                if (k == 4 && l < DEPTH - 1) { ctx_outproj_items(A, l, tid, bid, nblk); filt_items(A, l + 1, tid, bid, nblk, nullptr); }
            }
        }
    }
}

extern "C" void kernel_launch(void* const* d_in, const int* in_sizes, int n_in, void* d_out, int out_size, void* d_ws, size_t ws_size, hipStream_t stream) {
    static int grid = 0;
    if (grid == 0) {
        if (n_in != 22 || ws_size < WS_END) { fprintf(stderr, "kernel_launch: unexpected inputs (n_in %d, ws %zu)\n", n_in, ws_size); grid = -1; return; }
        int dev = 0, cus = 0, per_cu = 0;
        if (hipGetDevice(&dev) != hipSuccess || hipDeviceGetAttribute(&cus, hipDeviceAttributeMultiprocessorCount, dev) != hipSuccess) { grid = -1; return; }
        if (hipFuncSetAttribute((const void*)hybrid_fwd, hipFuncAttributeMaxDynamicSharedMemorySize, LDS_BYTES) != hipSuccess) { fprintf(stderr, "kernel_launch: hipFuncSetAttribute failed\n"); grid = -1; return; }
        if (hipOccupancyMaxActiveBlocksPerMultiprocessor(&per_cu, (const void*)hybrid_fwd, NTHREADS, LDS_BYTES) != hipSuccess || per_cu < 1) { fprintf(stderr, "kernel_launch: occupancy query says %d\n", per_cu); per_cu = 1; }
        (void)hipGetLastError();
        grid = cus;
    }
    if (grid < 0) return;
    KArgs a{};
    a.x = (const float*)d_in[0]; a.c = (const float*)d_in[1]; a.ctx = (const float*)d_in[2]; a.c_ctx = (const float*)d_in[3]; a.norm_g = (const float*)d_in[4];
    a.w_ada = (const float*)d_in[5]; a.b_ada = (const float*)d_in[6]; a.w_in = (const float*)d_in[7]; a.w_out = (const float*)d_in[8]; a.na_rpb = (const float*)d_in[9];
    a.hy_conv_w = (const float*)d_in[10]; a.hy_conv_b = (const float*)d_in[11]; a.hy_w1 = (const float*)d_in[12]; a.hy_b1 = (const float*)d_in[13]; a.hy_freq1 = (const float*)d_in[14];
    a.hy_w2 = (const float*)d_in[15]; a.hy_b2 = (const float*)d_in[16]; a.hy_freq2 = (const float*)d_in[17]; a.hy_w3 = (const float*)d_in[18]; a.hy_d = (const float*)d_in[19];
    a.sink = (const float*)d_in[20]; a.final_g = (const float*)d_in[21];
    a.out = (float*)d_out; a.ws = (unsigned char*)d_ws;
#if MK_MULTI
    for (int ph = 0; ph < NPHASE; ++ph) {
        a.ph_lo = ph; a.ph_hi = ph + 1;
        hipLaunchKernelGGL(hybrid_fwd, dim3(grid), dim3(NTHREADS), LDS_BYTES, stream, a);
    }
#else
    if (hipMemsetAsync(d_ws, 0, 16384, stream) != hipSuccess) { fprintf(stderr, "kernel_launch: memset of the barrier words failed\n"); return; }
    a.ph_lo = 0; a.ph_hi = NPHASE;
    void* args[] = {&a};
    hipError_t e = hipLaunchCooperativeKernel((const void*)hybrid_fwd, dim3(grid), dim3(NTHREADS), args, LDS_BYTES, stream);
    if (e != hipSuccess) fprintf(stderr, "cooperative launch failed: %s (grid %d)\n", hipGetErrorString(e), grid);
#endif
}
```

```cpp
#include <hip/hip_runtime.h>
#include <hip/hip_cooperative_groups.h>
#include <cstdio>
#include <cstdint>
namespace cg = cooperative_groups;

#ifndef MK_MULTI
#define MK_MULTI 0
#endif

namespace pg8 {
#define PG8_LAS __attribute__((address_space(3)))
typedef unsigned short bf16_t;
typedef short bf16x8 __attribute__((ext_vector_type(8)));
typedef float f32x4 __attribute__((ext_vector_type(4)));
typedef unsigned u32x4 __attribute__((ext_vector_type(4)));
constexpr int BM = 256, BK = 64, HALF = 128, HTB = HALF * BK * 2  , STAGE_BYTES = 8 * HTB, NXCD = 8, WGM = 8;

__host__ __device__ __forceinline__ int lds_byte(int r, int c) { const int st = (r >> 4) * 2 + (c >> 5), rr = r & 15, cc = c & 31, ob = rr * 64 + cc * 2; return st * 1024 + (ob ^ (((ob >> 9) & 1) << 5)); }
__host__ __device__ __forceinline__ void stage_rc(int b, int& R, int& C) { const int st = b / 1024, sb = b % 1024, swz = sb ^ (((sb >> 9) & 1) << 5); R = (st >> 1) * 16 + swz / 64; C = (st & 1) * 32 + (swz % 64) / 2; }
__host__ __device__ __forceinline__ int perm32(int rho) { const int n = rho >> 4, i = rho & 15; return 8 * (i >> 2) + 4 * n + (i & 3); }

struct Unit { int pm, pn; };
struct Gemm { const bf16_t* A; const bf16_t* Bt; int M, N, K; };

struct StaticOrder {
    int nM, nN, nwg, G, c;
    __host__ __device__ void init(int M, int N, int G_, int c_) { nM = M / BM; nN = N / BM; nwg = nM * nN; G = G_; c = c_; }
    __host__ __device__ bool next(int i, Unit& u) const {
        const long L = (long)i * G + c; if (L >= nwg) return false;
        int wgid = (int)L; { const int q = nwg / NXCD, r = nwg % NXCD, xcd = wgid % NXCD, off = wgid / NXCD; wgid = (xcd < r ? xcd * (q + 1) : r * (q + 1) + (xcd - r) * q) + off; }
        const int nig = WGM * nN, gid = wgid / nig, fm = gid * WGM, gsz = (nM - fm) < WGM ? (nM - fm) : WGM;
        u.pm = fm + ((wgid % nig) % gsz); u.pn = (wgid % nig) / gsz; return true;
    }
    __device__ __forceinline__ void a_ready(const Unit&) const {}
    __device__ __forceinline__ void done(const Unit&) const {}
};

template <class Epi, class Sched, bool ALIGN_EPI = false, bool SP2 = false>
__device__ __forceinline__ void gemm_phase(PG8_LAS unsigned char* lds, const Gemm g, const Sched& S, const Epi& E, const int tid) {
    const int wid = __builtin_amdgcn_readfirstlane(tid >> 6), lane = tid & 63, wr = wid >> 2, wc = wid & 3, fr = lane & 15, fq = lane >> 4;
    const int K = g.K, nt = K / BK;
    unsigned voffA[2], voffB[2];
#pragma unroll
    for (int i = 0; i < 2; ++i) { int R, C; stage_rc(tid * 16 + i * 8192, R, C); const int Rb = Epi::PERM ? ((R & ~31) + perm32(R & 31)) : R;
        voffA[i] = (unsigned)(R * K + C) * 2u; voffB[i] = (unsigned)(Rb * K + C) * 2u; }
    const size_t kstep = (size_t)(BK * 2);
    const size_t hstep = (size_t)HALF * K * 2;
    const size_t tstep = 2 * hstep;
    const unsigned ldsw = (unsigned)wid * 1024u;
    const int aoff = lds_byte(wr * 64 + fr, fq * 8), boff = lds_byte(wc * 32 + fr, fq * 8);
#define PG8_SA(b, h) (((b) * 2 + (h)) * HTB)
#define PG8_SB(b, h) ((4 + (b) * 2 + (h)) * HTB)
#define PG8_STAGE(bufoff, gbase, voff) do { _Pragma("unroll") for (int _i = 0; _i < 2; ++_i) \
        __builtin_amdgcn_global_load_lds((const unsigned*)((const char*)(gbase) + (voff)[_i]), (PG8_LAS unsigned*)(lds + (bufoff) + ldsw + _i * 8192), 16, 0, 0); } while (0)
#define PG8_LDA(dst, b, h) do { _Pragma("unroll") for (int m = 0; m < 4; ++m) _Pragma("unroll") for (int k = 0; k < 2; ++k) dst[m][k] = *(const PG8_LAS bf16x8*)(lds + PG8_SA(b, h) + aoff + m * 2048 + k * 1024); } while (0)
#define PG8_LDB(dst, b, h) do { _Pragma("unroll") for (int n = 0; n < 2; ++n) _Pragma("unroll") for (int k = 0; k < 2; ++k) dst[n][k] = *(const PG8_LAS bf16x8*)(lds + PG8_SB(b, h) + boff + n * 2048 + k * 1024); } while (0)
#define PG8_MMA(ai, bj, At, Bt) do { __builtin_amdgcn_s_setprio(1); _Pragma("unroll") for (int m = 0; m < 4; ++m) _Pragma("unroll") for (int n = 0; n < 2; ++n) _Pragma("unroll") for (int k = 0; k < 2; ++k) \
        acc[ai][bj][m][n] = __builtin_amdgcn_mfma_f32_16x16x32_bf16(Bt[n][k], At[m][k], acc[ai][bj][m][n], 0, 0, 0); __builtin_amdgcn_s_setprio(0); } while (0)
#define PG8_WAIT_V(n) asm volatile("s_waitcnt vmcnt(" #n ")" ::: "memory")
#define PG8_WAIT_L(n) asm volatile("s_waitcnt lgkmcnt(" #n ")" ::: "memory")
#define PG8_BAR __builtin_amdgcn_s_barrier()
#define PG8_SCHED __builtin_amdgcn_sched_barrier(0)
    Unit cur, nxt; int ui = 0;
    if (!S.next(0, cur)) return;
    f32x4 acc[2][2][4][2];
#pragma unroll
    for (int a = 0; a < 2; ++a)
#pragma unroll
        for (int b = 0; b < 2; ++b)
#pragma unroll
            for (int m = 0; m < 4; ++m)
#pragma unroll
                for (int n = 0; n < 2; ++n) acc[a][b][m][n] = (f32x4){0.f, 0.f, 0.f, 0.f};
    bf16x8 At[4][2], B0[2][2], B1[2][2];
    const char* cA = (const char*)g.A + (size_t)cur.pm * tstep; const char* cB = (const char*)g.Bt + (size_t)cur.pn * tstep;
    S.a_ready(cur);
    if constexpr (SP2) {
        PG8_STAGE(PG8_SB(0, 0), cB, voffB); PG8_STAGE(PG8_SB(0, 1), cB + hstep, voffB); PG8_STAGE(PG8_SA(0, 0), cA, voffA); PG8_STAGE(PG8_SA(0, 1), cA + hstep, voffA);
        if (wr == 1) PG8_BAR;
        PG8_WAIT_V(2); PG8_BAR;
        PG8_STAGE(PG8_SB(1, 0), cB + kstep, voffB); PG8_STAGE(PG8_SA(1, 0), cA + kstep, voffA); PG8_STAGE(PG8_SB(1, 1), cB + hstep + kstep, voffB);
        PG8_WAIT_V(6); PG8_BAR;
    } else {
        PG8_STAGE(PG8_SB(0, 0), cB, voffB); PG8_STAGE(PG8_SA(0, 0), cA, voffA); PG8_STAGE(PG8_SB(0, 1), cB + hstep, voffB); PG8_STAGE(PG8_SA(0, 1), cA + hstep, voffA);
        if (wr == 1) PG8_BAR;
        PG8_WAIT_V(4); PG8_BAR;
        PG8_STAGE(PG8_SB(1, 0), cB + kstep, voffB); PG8_STAGE(PG8_SA(1, 0), cA + kstep, voffA); PG8_STAGE(PG8_SB(1, 1), cB + hstep + kstep, voffB);
        PG8_WAIT_V(6); PG8_BAR;
    }
    for (;;) {
        const bool has_next = S.next(ui + 1, nxt);
        const char* nA = has_next ? (const char*)g.A + (size_t)nxt.pm * tstep : cA; const char* nB = has_next ? (const char*)g.Bt + (size_t)nxt.pn * tstep : cB;
        for (int t = 0; t < nt; t += 2) {
            const bool last = (t == nt - 2);
            const char* a1 = cA + (size_t)(t + 1) * kstep;
            const char* a2 = last ? nA : cA + (size_t)(t + 2) * kstep; const char* b2 = last ? nB : cB + (size_t)(t + 2) * kstep;
            const char* a3 = a2 + kstep; const char* b3 = b2 + kstep;
            if (last && has_next) S.a_ready(nxt);
            if constexpr (SP2) {
            PG8_LDB(B0, 0, 0); PG8_LDB(B1, 0, 1); PG8_SCHED; PG8_LDA(At, 0, 0); PG8_STAGE(PG8_SA(1, 1), a1 + hstep, voffA);
            PG8_WAIT_V(8); PG8_WAIT_L(0); PG8_BAR; PG8_MMA(0, 0, At, B0); PG8_MMA(0, 1, At, B1); PG8_BAR; PG8_SCHED;
            PG8_LDA(At, 0, 1); PG8_STAGE(PG8_SB(0, 0), b2, voffB); PG8_STAGE(PG8_SB(0, 1), b2 + hstep, voffB); PG8_STAGE(PG8_SA(0, 0), a2, voffA);
            PG8_WAIT_V(8); PG8_WAIT_L(0); PG8_BAR; PG8_MMA(1, 0, At, B0); PG8_MMA(1, 1, At, B1); PG8_BAR; PG8_SCHED;
            PG8_LDB(B0, 1, 0); PG8_LDB(B1, 1, 1); PG8_SCHED; PG8_LDA(At, 1, 0); PG8_STAGE(PG8_SA(0, 1), a2 + hstep, voffA);
            PG8_WAIT_V(8); PG8_WAIT_L(0); PG8_BAR; PG8_MMA(0, 0, At, B0); PG8_MMA(0, 1, At, B1); PG8_BAR; PG8_SCHED;
            PG8_LDA(At, 1, 1); PG8_STAGE(PG8_SB(1, 0), b3, voffB); PG8_STAGE(PG8_SB(1, 1), b3 + hstep, voffB); PG8_STAGE(PG8_SA(1, 0), a3, voffA);
            PG8_WAIT_V(8); PG8_WAIT_L(0); PG8_BAR; PG8_MMA(1, 0, At, B0); PG8_MMA(1, 1, At, B1); PG8_BAR; PG8_SCHED;
            } else {
            PG8_LDB(B0, 0, 0); PG8_SCHED; PG8_LDA(At, 0, 0); PG8_STAGE(PG8_SA(1, 1), a1 + hstep, voffA);
            PG8_WAIT_L(8); PG8_BAR; PG8_WAIT_L(0); PG8_MMA(0, 0, At, B0); PG8_BAR; PG8_SCHED;
            PG8_LDB(B1, 0, 1); PG8_STAGE(PG8_SB(0, 0), b2, voffB);
            PG8_BAR; PG8_WAIT_L(0); PG8_MMA(0, 1, At, B1); PG8_BAR;
            PG8_LDA(At, 0, 1); PG8_STAGE(PG8_SA(0, 0), a2, voffA);
            PG8_BAR; PG8_WAIT_L(0); PG8_MMA(1, 0, At, B0); PG8_BAR; PG8_SCHED;
            PG8_STAGE(PG8_SB(0, 1), b2 + hstep, voffB);
            PG8_WAIT_V(6); PG8_BAR; PG8_MMA(1, 1, At, B1); PG8_BAR;
            PG8_LDB(B0, 1, 0); PG8_SCHED; PG8_LDA(At, 1, 0); PG8_STAGE(PG8_SA(0, 1), a2 + hstep, voffA);
            PG8_WAIT_L(8); PG8_BAR; PG8_WAIT_L(0); PG8_MMA(0, 0, At, B0); PG8_BAR; PG8_SCHED;
            PG8_LDB(B1, 1, 1); PG8_STAGE(PG8_SB(1, 0), b3, voffB);
            PG8_BAR; PG8_WAIT_L(0); PG8_MMA(0, 1, At, B1); PG8_BAR;
            PG8_LDA(At, 1, 1); PG8_STAGE(PG8_SA(1, 0), a3, voffA);
            PG8_BAR; PG8_WAIT_L(0); PG8_MMA(1, 0, At, B0); PG8_BAR; PG8_SCHED;
            PG8_STAGE(PG8_SB(1, 1), b3 + hstep, voffB);
            PG8_WAIT_V(6); PG8_BAR; PG8_MMA(1, 1, At, B1); PG8_BAR;
            }
        }
        if constexpr (ALIGN_EPI) { if (wr == 0) PG8_BAR; }
        if constexpr (!Epi::AFTER_DRAIN) { E(acc, cur, wr, wc, fr, fq); S.done(cur); }
        if (!has_next) break;
#pragma unroll
        for (int a = 0; a < 2; ++a)
#pragma unroll
            for (int b = 0; b < 2; ++b)
#pragma unroll
                for (int m = 0; m < 4; ++m)
#pragma unroll
                    for (int n = 0; n < 2; ++n) acc[a][b][m][n] = (f32x4){0.f, 0.f, 0.f, 0.f};
        cur = nxt; cA = nA; cB = nB; ++ui;
        if constexpr (ALIGN_EPI) { if (wr == 1) PG8_BAR; }
    }
    PG8_WAIT_V(0);
    if constexpr (!ALIGN_EPI) { if (wr == 0) PG8_BAR; }
    PG8_BAR;
    if constexpr (Epi::AFTER_DRAIN) { E.fused(acc, cur, wr, wc, fr, fq, lds, wid, lane); S.done(cur); }
#undef PG8_SA
#undef PG8_SB
#undef PG8_STAGE
#undef PG8_LDA
#undef PG8_LDB
#undef PG8_MMA
#undef PG8_WAIT_V
#undef PG8_WAIT_L
#undef PG8_BAR
#undef PG8_SCHED
}
}

#define LAS __attribute__((address_space(3)))
typedef unsigned short bf16_t;
typedef short bf16x8 __attribute__((ext_vector_type(8)));
typedef float f32x4 __attribute__((ext_vector_type(4)));
typedef float f32x16 __attribute__((ext_vector_type(16)));
typedef unsigned u32x2 __attribute__((ext_vector_type(2)));
typedef unsigned u32x4 __attribute__((ext_vector_type(4)));
typedef float f32x2_t __attribute__((ext_vector_type(2)));
typedef __bf16 bf16x2_t __attribute__((ext_vector_type(2)));

constexpr int DM = 1024, NBATCH = 2, SEQ = 8192, DEPTH = 4, CTXL = 256;
constexpr int MLAT = NBATCH * SEQ, MCTX = NBATCH * CTXL, MTOT = MLAT + MCTX;
constexpr int NIN = 3584, NTM = 1536, NCM = 1024, NTB = MTOT / 64;
constexpr int C_QA = 0, C_GA = 384, C_QC = 768, C_GC = 1152;
constexpr int R_HZ = 0, R_GB = 768;
constexpr int NFFT = 16384;
constexpr float LOG2E = 1.4426950408889634f;
constexpr float QK_SCALE = 0.125f * LOG2E;

constexpr size_t MiB = 1u << 20;
constexpr size_t WS_ADA = 1 * MiB;
constexpr size_t WS_ROPE = 1 * MiB + 256 * 1024;
constexpr size_t WS_H2C = 1 * MiB + 512 * 1024;
constexpr size_t WS_CX = 2 * MiB;
constexpr size_t WS_H2 = 4 * MiB;
constexpr size_t WS_WIN = 12 * MiB;
constexpr size_t WS_WOUT = 40 * MiB;
constexpr size_t WS_HY = 48 * MiB;
constexpr size_t WS_PT = 81 * MiB;
constexpr size_t WS_KH = 130 * MiB + 512 * 1024;
constexpr size_t WS_VT = 147 * MiB;
constexpr size_t WS_PCT = 163 * MiB + 512 * 1024;
constexpr size_t WS_YBT = 197 * MiB;
constexpr size_t WS_XB = 206 * MiB;
constexpr size_t OUT_ZS = 0;
constexpr size_t OUT_FILT = 32 * MiB;
constexpr size_t OUT_YBT = 48 * MiB;
constexpr size_t WS_W3T = 238 * MiB;
constexpr size_t WS_FILT = 239 * MiB;
constexpr size_t WS_END = 255 * MiB;
static_assert(WS_PT + (size_t)MTOT * NTM * 2 <= WS_KH && WS_KH + (size_t)8 * MTOT * 128 <= WS_VT && WS_VT + (size_t)8 * MTOT * 128 <= WS_PCT && WS_PCT + (size_t)NCM * MTOT * 2 <= WS_YBT, "d_ws map");

constexpr int AUX_OFF = 147456;
constexpr int LDS_BYTES = 163840;
constexpr int NTHREADS = 512;

struct KArgs {
    const float* x; const float* c; const float* ctx; const float* c_ctx; const float* norm_g; const float* w_ada; const float* b_ada;
    const float* w_in; const float* w_out; const float* na_rpb; const float* hy_conv_w; const float* hy_conv_b;
    const float* hy_w1; const float* hy_b1; const float* hy_freq1; const float* hy_w2; const float* hy_b2; const float* hy_freq2; const float* hy_w3;
    const float* hy_d; const float* sink; const float* final_g;
    float* out; unsigned char* ws;
    int ph_lo, ph_hi;
};

typedef const __attribute__((address_space(4))) KArgs CKArgs;
__device__ __forceinline__ unsigned pk2(float lo, float hi) { f32x2_t v = {lo, hi}; bf16x2_t b = __builtin_convertvector(v, bf16x2_t); return __builtin_bit_cast(unsigned, b); }
__device__ __forceinline__ float bf2f(unsigned short u) { return __uint_as_float(((unsigned)u) << 16); }
__device__ __forceinline__ float bflo(unsigned w) { return __uint_as_float(w << 16); }
__device__ __forceinline__ float bfhi(unsigned w) { return __uint_as_float(w & 0xffff0000u); }
__device__ __forceinline__ float silu_f(float x) { return x / (1.0f + __expf(-x)); }
__device__ __forceinline__ float lane_xor(float v, int lane, int m) { return __int_as_float(__builtin_amdgcn_ds_bpermute((lane ^ m) << 2, __float_as_int(v))); }
__device__ __forceinline__ float lane_prev(float v, int lane) { return __int_as_float(__builtin_amdgcn_ds_bpermute(((lane - 1) & 63) << 2, __float_as_int(v))); }
__device__ __forceinline__ float lane_next(float v, int lane) { return __int_as_float(__builtin_amdgcn_ds_bpermute(((lane + 1) & 63) << 2, __float_as_int(v))); }
__device__ __forceinline__ float wave_sum(float v, int lane) {
#pragma unroll
    for (int o = 1; o < 64; o <<= 1) v += lane_xor(v, lane, o);
    return v;
}
__device__ __forceinline__ float rdlane(float v, int l) { return __uint_as_float(__builtin_amdgcn_readlane(__float_as_uint(v), l)); }

__device__ __forceinline__ void transpose_item(const float* W, int K, int N, bf16_t* WT, int k0, int n0, int drow0, LAS float* scr, int lane, int ldk = 0) {
    if (ldk == 0) ldk = K;
#pragma unroll 8
    for (int i = 0; i < 32; ++i) { const int kk = 2 * i + (lane >> 5); scr[kk * 33 + (lane & 31)] = W[(size_t)(k0 + kk) * N + n0 + (lane & 31)]; }
    asm volatile("s_waitcnt lgkmcnt(0)" ::: "memory");
    const int c = lane & 7;
#pragma unroll
    for (int j = 0; j < 4; ++j) { const int n = (lane >> 3) + 8 * j; const LAS float* s = scr + (8 * c) * 33 + n;
        u32x4 o; o.x = pk2(s[0 * 33], s[1 * 33]); o.y = pk2(s[2 * 33], s[3 * 33]); o.z = pk2(s[4 * 33], s[5 * 33]); o.w = pk2(s[6 * 33], s[7 * 33]);
        *(u32x4*)(WT + (size_t)(drow0 + n) * ldk + k0 + 8 * c) = o; }
    asm volatile("s_waitcnt lgkmcnt(0)" ::: "memory");
}
__device__ __forceinline__ int win_row(int n0) {
    if (n0 < 384) return n0;
    if (n0 < 768) return n0 - 384 + 1536;
    if (n0 < 1152) return n0 - 768 + 2048;
    if (n0 < 1536) return n0 - 1152 + 384;
    if (n0 < 2304) return n0 - 1536 + 2560;
    if (n0 < 2560) return n0 - 2304 + 3328;
    if (n0 < 2944) return n0 - 2560 + 768;
    if (n0 < 3072) return n0 - 2944 + 1920;
    if (n0 < 3200) return n0 - 3072 + 2432;
    return n0 - 3200 + 1152;
}

__device__ __forceinline__ void phase_prologue(CKArgs& A, LAS unsigned char* lds, int bid, int nblk, int tid) {
    const int wave = __builtin_amdgcn_readfirstlane(tid >> 6), lane = tid & 63;
    const int gw = bid * 8 + wave, NGW = nblk * 8;
    unsigned char* ws = A.ws;
    {
        LAS float* scr = (LAS float*)(lds + wave * 16384);
        constexpr int I_IN = 16 * 112, I_OUT = 16 * 32, I_L = I_IN + I_OUT;
        for (int it = gw; it < DEPTH * I_L; it += NGW) {
            const int l = it / I_L; int r = it % I_L;
            if (r < I_IN) { const int kb = r / 112, nb = r % 112, n0 = nb * 32;
                transpose_item(A.w_in + (size_t)l * DM * NIN, DM, NIN, (bf16_t*)(ws + WS_WIN) + (size_t)l * NIN * DM, kb * 64, n0, win_row(n0), scr, lane); }
            else { r -= I_IN; const int kb = r / 32, nb = r % 32, n0 = nb * 32;
                transpose_item(A.w_out + (size_t)l * DM * DM, DM, DM, (bf16_t*)(ws + WS_WOUT) + (size_t)l * DM * DM, kb * 64, n0, n0, scr, lane); }
        }
    }
    {
        LAS float* scr = (LAS float*)(lds + wave * 16384);
        bf16_t* W3T = (bf16_t*)(ws + WS_W3T);
        for (int it = gw; it < DEPTH * 32; it += NGW) { const int l = it >> 5, nb = it & 31;
            transpose_item(A.hy_w3 + (size_t)l * 64 * 1024, 64, 1024, W3T + (size_t)l * 1024 * 64, 0, nb * 32, nb * 32, scr, lane); }
    }
    for (int idx = gw * 64 + lane; idx < 128 * 16; idx += NGW * 64) {
        const int p = idx >> 4, i = idx & 15;
        const float inv = powf(10000.0f, -(float)i / 16.0f);
        const float ang = (float)p * inv;
        ((float2*)(ws + WS_ROPE))[idx] = make_float2(cosf(ang), sinf(ang));
    }
    for (int it = gw; it < DEPTH * 528; it += NGW) {
        const int l = it / 528, g4 = it % 528, g = g4 >> 2, sub = g4 & 3;
        const int L = g < 128 ? SEQ : CTXL;
        const int n0 = (g < 128 ? g * 64 : (g - 128) * 64) + 16 * sub;
        float* outp = (float*)(ws + WS_H2C) + ((size_t)l * CTXL + n0) * 64;
        bf16_t* outb = (bf16_t*)(ws + WS_H2) + ((size_t)l * SEQ + n0) * 64;
        float w1c[33], w2c[64];
#pragma unroll
        for (int q = 0; q < 33; ++q) w1c[q] = A.hy_w1[((size_t)l * 33 + q) * 64 + lane];
#pragma unroll
        for (int j = 0; j < 64; ++j) w2c[j] = A.hy_w2[((size_t)l * 64 + j) * 64 + lane];
        const float b1 = A.hy_b1[l * 64 + lane], fr1 = A.hy_freq1[l * 64 + lane], b2 = A.hy_b2[l * 64 + lane], fr2 = A.hy_freq2[l * 64 + lane];
        const float tstep = 1.0f / (float)(L - 1);
        const int fj = lane == 0 ? 0 : ((lane - 1) & 15);
        const float fq = 1e-4f + (float)fj * ((15.0f - 1e-4f) / 15.0f);
#pragma unroll 1
        for (int nn = 0; nn < 16; ++nn) {
            const int n = n0 + nn;
            const float t = (float)n * tstep;
            const float rev = fq * ((float)n * (1.0f / (float)L)) + (lane <= 16 ? 0.25f : 0.5f);
            float zq = __builtin_amdgcn_sinf(rev - floorf(rev));
            if (lane == 0) zq = t; if (lane > 32) zq = 0.f;
            float a1 = b1;
#pragma unroll
            for (int q = 0; q < 33; ++q) a1 += rdlane(zq, q) * w1c[q];
            const float x1 = fr1 * a1 * 0.15915494309189535f;
            const float h1 = __builtin_amdgcn_sinf(x1 - floorf(x1));
            float a2 = b2;
#pragma unroll
            for (int j = 0; j < 64; ++j) a2 += rdlane(h1, j) * w2c[j];
            const float x2 = fr2 * a2 * 0.15915494309189535f;
            const float h2 = __builtin_amdgcn_sinf(x2 - floorf(x2));
            if (g < 128) outb[nn * 64 + lane] = (bf16_t)(pk2(h2, 0.f) & 0xffffu);
            else outp[nn * 64 + lane] = h2;
        }
    }
    __syncthreads();
    {
        LAS float* red = (LAS float*)lds;
        LAS float* sv = (LAS float*)(lds + 8192);
        for (int i = tid; i < 3 * DM; i += NTHREADS) sv[i] = silu_f(i < 2 * DM ? A.c[i] : A.c_ctx[i - 2 * DM]);
        __syncthreads();
        for (int it = bid; it < DEPTH * 48; it += nblk) {
            const int l = it / 48, n = (it % 48) * 64 + lane;
            const float* W = A.w_ada + (size_t)l * DM * 3072 + n;
            float a0 = 0.f, a1 = 0.f, a2 = 0.f;
            const int kb = wave * 128;
#pragma unroll 1
            for (int k0 = 0; k0 < 128; k0 += 16) {
                float w[16];
#pragma unroll
                for (int k = 0; k < 16; ++k) w[k] = W[(size_t)(kb + k0 + k) * 3072];
#pragma unroll
                for (int k = 0; k < 16; ++k) { a0 += sv[kb + k0 + k] * w[k]; a1 += sv[DM + kb + k0 + k] * w[k]; a2 += sv[2 * DM + kb + k0 + k] * w[k]; }
            }
            red[(wave * 3 + 0) * 64 + lane] = a0; red[(wave * 3 + 1) * 64 + lane] = a1; red[(wave * 3 + 2) * 64 + lane] = a2;
            __syncthreads();
            if (tid < 192) { const int v = tid >> 6; float sacc = A.b_ada[l * 3072 + n];
#pragma unroll
                for (int w = 0; w < 8; ++w) sacc += red[(w * 3 + v) * 64 + lane];
                ((float*)(ws + WS_ADA))[((size_t)l * 3 + v) * 3072 + n] = sacc; }
            __syncthreads();
        }
    }
}

__device__ __forceinline__ void filt_items(CKArgs& A, int lf, int tid, int bid, int nblk, unsigned* ctr) {
    unsigned char* ws = A.ws;
    const int wave = __builtin_amdgcn_readfirstlane(tid >> 6), lane = tid & 63;
    const int gw = bid * 8 + wave, NGW = nblk * 8;
    const bf16_t* H2B = (const bf16_t*)(ws + WS_H2) + (size_t)lf * SEQ * 64;
    const bf16_t* W3T = (const bf16_t*)(ws + WS_W3T) + (size_t)lf * 1024 * 64;
    bf16_t* FILT = (bf16_t*)((unsigned char*)A.out + OUT_FILT);
    const int fr = lane & 15, fq = lane >> 4;
    int it = gw;
#pragma unroll 1
    for (;;) {
        if (ctr) { unsigned t = 0; if (lane == 0) t = __hip_atomic_fetch_add(ctr, 1u, __ATOMIC_RELAXED, __HIP_MEMORY_SCOPE_AGENT); it = (int)__builtin_amdgcn_readfirstlane(t); }
        if (it >= 2048) break;
        const int n0 = (it >> 4) * 64, c0 = (it & 15) * 64;
        bf16x8 af[4][2];
#pragma unroll
        for (int j = 0; j < 4; ++j) { const bf16_t* ap = H2B + (size_t)(n0 + 16 * (fr >> 2) + 4 * j + (fr & 3)) * 64 + 8 * fq; af[j][0] = *(const bf16x8*)ap; af[j][1] = *(const bf16x8*)(ap + 32); }
#pragma unroll 1
        for (int ct = 0; ct < 4; ++ct) {
            const bf16_t* bp = W3T + (size_t)(c0 + 16 * ct + fr) * 64 + 8 * fq;
            const bf16x8 b0 = *(const bf16x8*)bp, b1 = *(const bf16x8*)(bp + 32);
            u32x4 o0, o1;
#pragma unroll
            for (int j = 0; j < 4; ++j) {
                f32x4 acc = {0.f, 0.f, 0.f, 0.f};
                acc = __builtin_amdgcn_mfma_f32_16x16x32_bf16(af[j][0], b0, acc, 0, 0, 0);
                acc = __builtin_amdgcn_mfma_f32_16x16x32_bf16(af[j][1], b1, acc, 0, 0, 0);
                const unsigned w0 = pk2(acc.x, acc.y), w1 = pk2(acc.z, acc.w);
                if (j == 0) { o0.x = w0; o0.y = w1; } else if (j == 1) { o0.z = w0; o0.w = w1; } else if (j == 2) { o1.x = w0; o1.y = w1; } else { o1.z = w0; o1.w = w1; }
            }
            bf16_t* dp = FILT + (size_t)(c0 + 16 * ct + fr) * SEQ + n0 + 16 * fq;
            *(u32x4*)dp = o0; *(u32x4*)(dp + 8) = o1;
        }
        if (!ctr) it += NGW;
    }
}

__device__ __forceinline__ void ctx_outproj_items(CKArgs& A, int l, int tid, int bid, int nblk) {
    unsigned char* ws = A.ws;
    const int wave = __builtin_amdgcn_readfirstlane(tid >> 6), lane = tid & 63;
    const int gw = bid * 8 + wave, NGW = nblk * 8;
    const bf16_t* Y = (const bf16_t*)(ws + WS_HY) + (size_t)MLAT * DM;
    const bf16_t* WT = (const bf16_t*)(ws + WS_WOUT) + (size_t)l * DM * DM;
    const float* gate = (const float*)(ws + WS_ADA) + ((size_t)l * 3 + 2) * 3072 + 2048;
    const float* csrc = l == 0 ? A.ctx : (const float*)(ws + WS_CX);
    float* cdst = (float*)(ws + WS_CX);
    const int fr = lane & 15, fq = lane >> 4;
#pragma unroll 1
    for (int it = gw; it < 2048; it += NGW) {
        const int r0 = (it >> 6) * 16, c0 = (it & 63) * 16;
        const bf16_t* ap = Y + (size_t)(r0 + fr) * DM + 8 * fq;
        const bf16_t* bp = WT + (size_t)(c0 + fr) * DM + 8 * fq;
        f32x4 acc0 = {0.f, 0.f, 0.f, 0.f}, acc1 = {0.f, 0.f, 0.f, 0.f};
#pragma unroll 1
        for (int k0 = 0; k0 < 32; k0 += 8) {
            bf16x8 a[8], b[8];
#pragma unroll
            for (int k = 0; k < 8; ++k) { a[k] = *(const bf16x8*)(ap + 32 * (k0 + k)); b[k] = *(const bf16x8*)(bp + 32 * (k0 + k)); }
#pragma unroll
            for (int k = 0; k < 8; k += 2) { acc0 = __builtin_amdgcn_mfma_f32_16x16x32_bf16(a[k], b[k], acc0, 0, 0, 0); acc1 = __builtin_amdgcn_mfma_f32_16x16x32_bf16(a[k + 1], b[k + 1], acc1, 0, 0, 0); }
        }
        const float g = gate[c0 + fr];
#pragma unroll
        for (int i = 0; i < 4; ++i) { const size_t off = (size_t)(r0 + 4 * fq + i) * DM + c0 + fr; cdst[off] = csrc[off] + g * (acc0[i] + acc1[i]); }
    }
}

__device__ __forceinline__ void phase_norm(CKArgs& A, int l, int bid, int nblk, int tid) {
    const int wave = __builtin_amdgcn_readfirstlane(tid >> 6), lane = tid & 63;
    const int gw = bid * 8 + wave, NGW = nblk * 8;
    unsigned char* ws = A.ws;
    bf16_t* H = (bf16_t*)(ws + WS_HY);
    const float* ada = (const float*)(ws + WS_ADA) + (size_t)l * 3 * 3072;
    const float* g = A.norm_g + l * DM;
    for (int m = gw; m < MTOT; m += NGW) {
        const float* src = nullptr; int v;
        const bool xb = (m < MLAT) && (l > 0);
        if (m < MLAT) { src = A.x + (size_t)m * DM; v = m >> 13; }
        else { src = (l == 0 ? A.ctx : (const float*)(ws + WS_CX)) + (size_t)(m - MLAT) * DM; v = 2; }
        const float* shp = ada + v * 3072; const float* scp = shp + DM;
        f32x4 xv[4]; float ss = 0.f;
        if (xb) { const bf16_t* sb = (const bf16_t*)(ws + WS_XB) + (size_t)m * DM;
#pragma unroll
            for (int j = 0; j < 4; ++j) { const u32x2 w = *(const u32x2*)(sb + 4 * lane + 256 * j); xv[j] = (f32x4){bflo(w.x), bfhi(w.x), bflo(w.y), bfhi(w.y)}; } }
        else {
#pragma unroll
            for (int j = 0; j < 4; ++j) xv[j] = *(const f32x4*)(src + 4 * lane + 256 * j); }
#pragma unroll
        for (int j = 0; j < 4; ++j) ss += (xv[j].x * xv[j].x + xv[j].y * xv[j].y) + (xv[j].z * xv[j].z + xv[j].w * xv[j].w);
        const float rinv = rsqrtf(wave_sum(ss, lane) * (1.0f / DM) + 1e-6f);
#pragma unroll
        for (int j = 0; j < 4; ++j) { const int col = 4 * lane + 256 * j;
            const f32x4 gv = *(const f32x4*)(g + col), sc = *(const f32x4*)(scp + col), sh = *(const f32x4*)(shp + col);
            const f32x4 h = xv[j] * rinv * gv * (sc + 1.0f) + sh;
            u32x2 o; o.x = pk2(h.x, h.y); o.y = pk2(h.z, h.w);
            *(u32x2*)(H + (size_t)m * DM + col) = o; }
    }
    if (l == 0) filt_items(A, 0, tid, bid, nblk, nullptr);
}

struct EpiIn {
    static constexpr bool PERM = true, AFTER_DRAIN = false;
    bf16_t* PT; bf16_t* KH; bf16_t* PCT; const float2* rope;
    __device__ __forceinline__ void operator()(const f32x4 (&acc)[2][2][4][2], const pg8::Unit& u, int wr, int wc, int fr, int fq) const {
        const int row0 = u.pm * 256 + wr * 64 + fr;
        if (u.pn < 10) {
#pragma unroll
            for (int bj = 0; bj < 2; ++bj) {
                const int blk = 2 * u.pn + bj;
                const bool rp = ((blk >= 6 && blk <= 8) || blk == 15) && (u.pm < 64);
                const int col0 = 256 * u.pn + 128 * bj + 32 * wc + 8 * fq;
                bf16_t* dst; size_t ld;
                if (u.pn < 6) { dst = PT + col0; ld = NTM; }
                else { const int n2 = col0 - 1536; dst = KH + (size_t)(n2 >> 6) * MTOT * 64 + (n2 & 63); ld = 64; }
#pragma unroll
                for (int ai = 0; ai < 2; ++ai)
#pragma unroll
                    for (int m = 0; m < 4; ++m) {
                        const int r = row0 + 128 * ai + 16 * m;
                        f32x4 v0 = acc[ai][bj][m][0], v1 = acc[ai][bj][m][1];
                        if (rp) {
                            const int pos = r & (SEQ - 1);
                            const int p = (wc & 1) ? (pos & 63) : (pos >> 6);
                            const f32x4* tb = (const f32x4*)(rope + p * 16 + 8 * (fq & 1));
                            const int ln = fr + 16 * fq;
                            const float sg = (fq < 2) ? -1.0f : 1.0f;
                            { const f32x4 t0 = tb[0], t1 = tb[1];
                              const float qx = lane_xor(v0.x, ln, 32), qy = lane_xor(v0.y, ln, 32), qz = lane_xor(v0.z, ln, 32), qw = lane_xor(v0.w, ln, 32);
                              v0.x = v0.x * t0.x + sg * qx * t0.y; v0.y = v0.y * t0.z + sg * qy * t0.w; v0.z = v0.z * t1.x + sg * qz * t1.y; v0.w = v0.w * t1.z + sg * qw * t1.w; }
                            { const f32x4 t2 = tb[2], t3 = tb[3];
                              const float qx = lane_xor(v1.x, ln, 32), qy = lane_xor(v1.y, ln, 32), qz = lane_xor(v1.z, ln, 32), qw = lane_xor(v1.w, ln, 32);
                              v1.x = v1.x * t2.x + sg * qx * t2.y; v1.y = v1.y * t2.z + sg * qy * t2.w; v1.z = v1.z * t3.x + sg * qz * t3.y; v1.w = v1.w * t3.z + sg * qw * t3.w; }
                        }
                        u32x4 w; w.x = pk2(v0.x, v0.y); w.y = pk2(v0.z, v0.w); w.z = pk2(v1.x, v1.y); w.w = pk2(v1.z, v1.w);
                        *(u32x4*)(dst + (size_t)r * ld) = w;
                        asm volatile("" ::: "memory");
                    }
            }
        } else {
#pragma unroll
            for (int bj = 0; bj < 2; ++bj) {
                const int ch0 = 256 * (u.pn - 10) + 128 * bj + 32 * wc + 8 * fq;
#pragma unroll
                for (int ai = 0; ai < 2; ++ai)
#pragma unroll
                    for (int m = 0; m < 4; ++m) {
                        const int r = row0 + 128 * ai + 16 * m;
                        bf16_t* p = PCT + (size_t)ch0 * MTOT + r;
#pragma unroll
                        for (int n = 0; n < 2; ++n) {
                            const f32x4 v = acc[ai][bj][m][n];
                            bf16_t* q = p + (size_t)(4 * n) * MTOT;
                            const unsigned w0 = pk2(v.x, v.y), w1 = pk2(v.z, v.w);
                            q[0] = (bf16_t)(w0 & 0xffffu); q[MTOT] = (bf16_t)(w0 >> 16); q[2 * (size_t)MTOT] = (bf16_t)(w1 & 0xffffu); q[3 * (size_t)MTOT] = (bf16_t)(w1 >> 16);
                        }
                    }
            }
        }
    }
};
struct EpiFilt {
    static constexpr bool PERM = true, AFTER_DRAIN = false;
    bf16_t* O; int ldc;
    __device__ __forceinline__ void operator()(const f32x4 (&acc)[2][2][4][2], const pg8::Unit& u, int wr, int wc, int fr, int fq) const {
        const int row0 = u.pm * 256 + wr * 64 + fr;
#pragma unroll
        for (int bj = 0; bj < 2; ++bj) { const int col0 = 256 * u.pn + 128 * bj + 32 * wc + 8 * fq;
#pragma unroll
            for (int ai = 0; ai < 2; ++ai)
#pragma unroll
                for (int m = 0; m < 4; ++m) { const int r = row0 + 128 * ai + 16 * m; const f32x4 v0 = acc[ai][bj][m][0], v1 = acc[ai][bj][m][1];
                    u32x4 w; w.x = pk2(v0.x, v0.y); w.y = pk2(v0.z, v0.w); w.z = pk2(v1.x, v1.y); w.w = pk2(v1.z, v1.w);
                    *(u32x4*)(O + (size_t)r * ldc + col0) = w; } }
    }
};
struct EpiOut {
    static constexpr bool PERM = true, AFTER_DRAIN = false;
    const float* xsrc; bf16_t* xb; float* xdst; const float* ada; bool src32, dst32;
    __device__ __forceinline__ void operator()(const f32x4 (&acc)[2][2][4][2], const pg8::Unit& u, int wr, int wc, int fr, int fq) const {
        const int row0 = u.pm * 256 + wr * 64 + fr;
        const int v = row0 >> 13;
#pragma unroll
        for (int bj = 0; bj < 2; ++bj) {
            const int col0 = 256 * u.pn + 128 * bj + 32 * wc + 8 * fq;
            const float* gp = ada + v * 3072 + 2048 + col0;
            const f32x4 g0 = *(const f32x4*)gp, g1 = *(const f32x4*)(gp + 4);
#pragma unroll
            for (int ai = 0; ai < 2; ++ai)
#pragma unroll
              for (int mh = 0; mh < 2; ++mh) {
                f32x4 x0[2], x1[2];
                if (src32) {
#pragma unroll
                    for (int mm = 0; mm < 2; ++mm) { const float* sp = xsrc + (size_t)(row0 + 128 * ai + 16 * (2 * mh + mm)) * DM + col0; x0[mm] = *(const f32x4*)sp; x1[mm] = *(const f32x4*)(sp + 4); }
                } else {
#pragma unroll
                    for (int mm = 0; mm < 2; ++mm) { const u32x4 w = *(const u32x4*)(xb + (size_t)(row0 + 128 * ai + 16 * (2 * mh + mm)) * DM + col0);
                        x0[mm] = (f32x4){bflo(w.x), bfhi(w.x), bflo(w.y), bfhi(w.y)}; x1[mm] = (f32x4){bflo(w.z), bfhi(w.z), bflo(w.w), bfhi(w.w)}; }
                }
#pragma unroll
                for (int mm = 0; mm < 2; ++mm) { const int m = 2 * mh + mm; const size_t off = (size_t)(row0 + 128 * ai + 16 * m) * DM + col0;
                    const f32x4 y0 = x0[mm] + g0 * acc[ai][bj][m][0], y1 = x1[mm] + g1 * acc[ai][bj][m][1];
                    if (dst32) { *(f32x4*)(xdst + off) = y0; *(f32x4*)(xdst + off + 4) = y1; }
                    else { u32x4 w; w.x = pk2(y0.x, y0.y); w.y = pk2(y0.z, y0.w); w.z = pk2(y1.x, y1.y); w.w = pk2(y1.z, y1.w); *(u32x4*)(xb + off) = w; } }
                asm volatile("" ::: "memory");
              }
        }
    }
};
struct EpiAll {
    static constexpr bool PERM = true, AFTER_DRAIN = false;
    int mode, l; CKArgs* Ap;
    __device__ __forceinline__ void operator()(const f32x4 (&acc)[2][2][4][2], const pg8::Unit& u, int wr, int wc, int fr, int fq) const {
        unsigned char* ws = Ap->ws;
        if (mode == 0) { const EpiIn E{(bf16_t*)(ws + WS_PT), (bf16_t*)(ws + WS_KH), (bf16_t*)(ws + WS_PCT), (const float2*)(ws + WS_ROPE)}; E(acc, u, wr, wc, fr, fq); }
        else { const EpiOut E{Ap->x, (bf16_t*)(ws + WS_XB), Ap->out, (const float*)(ws + WS_ADA) + (size_t)l * 3 * 3072, l == 0, false}; E(acc, u, wr, wc, fr, fq); }
    }
};
__device__ __forceinline__ float max3f(float a, float b, float c) { float r; asm("v_max3_f32 %0, %1, %2, %3" : "=v"(r) : "v"(a), "v"(b), "v"(c)); return r; }
__device__ __forceinline__ float max2f(float a, float b) { float r; asm("v_max_f32_e32 %0, %1, %2" : "=v"(r) : "v"(a), "v"(b)); return r; }
__device__ __forceinline__ float max4f_mfma(float a, float b, float c, float d) { float r; asm("s_nop 15\n\ts_nop 7\n\tv_max3_f32 %0, %1, %2, %3\n\tv_max_f32_e32 %0, %0, %4" : "=&v"(r) : "v"(a), "v"(b), "v"(c), "v"(d)); return r; }
__device__ __forceinline__ void attn_tile(LAS const unsigned char* slot, int cs, const bf16x8 (&bq)[4], f32x16& o0, f32x16& o1, float& m_run, float& l_run,
                                          int r31, int hh, bool use_mask, int clo, int chi, bool use_bias, LAS const float* btab, int bidx) {
    const int kr = cs + r31;
    LAS const unsigned char* kp = slot + kr * 128;
    const int ksw = (kr >> 1) & 7;
    const bf16x8 ka0 = *(LAS const bf16x8*)(kp + 16 * ((0 + hh) ^ ksw)), ka1 = *(LAS const bf16x8*)(kp + 16 * ((2 + hh) ^ ksw));
    const bf16x8 ka2 = *(LAS const bf16x8*)(kp + 16 * ((4 + hh) ^ ksw)), ka3 = *(LAS const bf16x8*)(kp + 16 * ((6 + hh) ^ ksw));
    LAS const unsigned char* vp = slot + 8192 + r31 * 128;
    const int vsw = (r31 >> 1) & 15, g0 = (cs >> 2) + hh;
    const u32x2 a0l = *(LAS const u32x2*)(vp + 8 * ((g0) ^ vsw)), a0h = *(LAS const u32x2*)(vp + 8 * ((g0 + 2) ^ vsw));
    const u32x2 a1l = *(LAS const u32x2*)(vp + 8 * ((g0 + 4) ^ vsw)), a1h = *(LAS const u32x2*)(vp + 8 * ((g0 + 6) ^ vsw));
    const u32x2 b0l = *(LAS const u32x2*)(vp + 4096 + 8 * ((g0) ^ vsw)), b0h = *(LAS const u32x2*)(vp + 4096 + 8 * ((g0 + 2) ^ vsw));
    const u32x2 b1l = *(LAS const u32x2*)(vp + 4096 + 8 * ((g0 + 4) ^ vsw)), b1h = *(LAS const u32x2*)(vp + 4096 + 8 * ((g0 + 6) ^ vsw));
    f32x16 s, t;
#pragma unroll
    for (int i = 0; i < 16; ++i) { s[i] = 0.f; t[i] = 0.f; }
    s = __builtin_amdgcn_mfma_f32_32x32x16_bf16(ka0, bq[0], s, 0, 0, 0); t = __builtin_amdgcn_mfma_f32_32x32x16_bf16(ka1, bq[1], t, 0, 0, 0);
    s = __builtin_amdgcn_mfma_f32_32x32x16_bf16(ka2, bq[2], s, 0, 0, 0); t = __builtin_amdgcn_mfma_f32_32x32x16_bf16(ka3, bq[3], t, 0, 0, 0);
    if (use_bias) {
        LAS const float* bp = btab + bidx;
#pragma unroll
        for (int i = 0; i < 16; ++i) { const int c = (i & 3) + 8 * (i >> 2) + 4 * hh; s[i] = (s[i] + t[i]) * QK_SCALE + bp[c]; }
    } else {
#pragma unroll
        for (int i = 0; i < 16; ++i) s[i] = (s[i] + t[i]) * QK_SCALE;
    }
    if (use_mask) {
        const unsigned off = (unsigned)(4 * hh - clo), rng = (unsigned)(chi - clo);
        const bool any = chi >= clo;
#pragma unroll
        for (int i = 0; i < 16; ++i) { const unsigned c0 = (unsigned)((i & 3) + 8 * (i >> 2)); s[i] = (any && (c0 + off <= rng)) ? s[i] : -INFINITY; }
    }
    float tmax = max3f(s[0], s[1], s[2]);
#pragma unroll
    for (int i = 3; i < 15; i += 2) tmax = max3f(tmax, s[i], s[i + 1]);
    tmax = max2f(tmax, s[15]);
    tmax = max2f(tmax, lane_xor(tmax, r31 + 32 * hh, 32));
    if (__any(tmax - m_run > 8.0f)) {
        const float m_new = fmaxf(m_run, tmax);
        const float alpha = __builtin_amdgcn_exp2f(m_run - m_new);
        m_run = m_new; l_run *= alpha;
#pragma unroll
        for (int i = 0; i < 16; ++i) { o0[i] *= alpha; o1[i] *= alpha; }
    }
    float ps0 = 0.f, ps1 = 0.f;
#pragma unroll
    for (int i = 0; i < 16; i += 2) { const float p0 = __builtin_amdgcn_exp2f(s[i] - m_run), p1 = __builtin_amdgcn_exp2f(s[i + 1] - m_run); s[i] = p0; s[i + 1] = p1; ps0 += p0; ps1 += p1; }
    l_run += ps0 + ps1;
    u32x4 pw0, pw1;
    pw0.x = pk2(s[0], s[1]); pw0.y = pk2(s[2], s[3]); pw0.z = pk2(s[4], s[5]); pw0.w = pk2(s[6], s[7]);
    pw1.x = pk2(s[8], s[9]); pw1.y = pk2(s[10], s[11]); pw1.z = pk2(s[12], s[13]); pw1.w = pk2(s[14], s[15]);
    const bf16x8 pb0 = __builtin_bit_cast(bf16x8, pw0), pb1 = __builtin_bit_cast(bf16x8, pw1);
    u32x4 w;
    w.x = a0l.x; w.y = a0l.y; w.z = a0h.x; w.w = a0h.y; const bf16x8 va00 = __builtin_bit_cast(bf16x8, w);
    w.x = a1l.x; w.y = a1l.y; w.z = a1h.x; w.w = a1h.y; const bf16x8 va01 = __builtin_bit_cast(bf16x8, w);
    w.x = b0l.x; w.y = b0l.y; w.z = b0h.x; w.w = b0h.y; const bf16x8 va10 = __builtin_bit_cast(bf16x8, w);
    w.x = b1l.x; w.y = b1l.y; w.z = b1h.x; w.w = b1h.y; const bf16x8 va11 = __builtin_bit_cast(bf16x8, w);
    o0 = __builtin_amdgcn_mfma_f32_32x32x16_bf16(va00, pb0, o0, 0, 0, 0); o1 = __builtin_amdgcn_mfma_f32_32x32x16_bf16(va10, pb0, o1, 0, 0, 0);
    o0 = __builtin_amdgcn_mfma_f32_32x32x16_bf16(va01, pb1, o0, 0, 0, 0); o1 = __builtin_amdgcn_mfma_f32_32x32x16_bf16(va11, pb1, o1, 0, 0, 0);
}

__device__ __forceinline__ void attn_tile2(LAS const unsigned char* slot, const bf16x8 (&bq)[4], f32x16& o0, f32x16& o1, float& m_run, float& l_run,
                                           int r31, int hh, bool use_mask, int clo0, int chi0, int clo1, int chi1) {
    const int ksw = (r31 >> 1) & 7;
    LAS const unsigned char* kp = slot + r31 * 128;
    const bf16x8 ka0 = *(LAS const bf16x8*)(kp + 16 * ((0 + hh) ^ ksw)), ka1 = *(LAS const bf16x8*)(kp + 16 * ((2 + hh) ^ ksw));
    const bf16x8 ka2 = *(LAS const bf16x8*)(kp + 16 * ((4 + hh) ^ ksw)), ka3 = *(LAS const bf16x8*)(kp + 16 * ((6 + hh) ^ ksw));
    const bf16x8 kb0 = *(LAS const bf16x8*)(kp + 4096 + 16 * ((0 + hh) ^ ksw)), kb1 = *(LAS const bf16x8*)(kp + 4096 + 16 * ((2 + hh) ^ ksw));
    const bf16x8 kb2 = *(LAS const bf16x8*)(kp + 4096 + 16 * ((4 + hh) ^ ksw)), kb3 = *(LAS const bf16x8*)(kp + 4096 + 16 * ((6 + hh) ^ ksw));
    f32x16 s0, s1;
#pragma unroll
    for (int i = 0; i < 16; ++i) { s0[i] = 0.f; s1[i] = 0.f; }
    s0 = __builtin_amdgcn_mfma_f32_32x32x16_bf16(ka0, bq[0], s0, 0, 0, 0); s1 = __builtin_amdgcn_mfma_f32_32x32x16_bf16(kb0, bq[0], s1, 0, 0, 0);
    s0 = __builtin_amdgcn_mfma_f32_32x32x16_bf16(ka1, bq[1], s0, 0, 0, 0); s1 = __builtin_amdgcn_mfma_f32_32x32x16_bf16(kb1, bq[1], s1, 0, 0, 0);
    s0 = __builtin_amdgcn_mfma_f32_32x32x16_bf16(ka2, bq[2], s0, 0, 0, 0); s1 = __builtin_amdgcn_mfma_f32_32x32x16_bf16(kb2, bq[2], s1, 0, 0, 0);
    s0 = __builtin_amdgcn_mfma_f32_32x32x16_bf16(ka3, bq[3], s0, 0, 0, 0); s1 = __builtin_amdgcn_mfma_f32_32x32x16_bf16(kb3, bq[3], s1, 0, 0, 0);
    LAS const unsigned char* vp = slot + 8192 + r31 * 128;
    const int vsw = (r31 >> 1) & 15;
    u32x2 va[2][4][2];
#pragma unroll
    for (int db = 0; db < 2; ++db)
#pragma unroll
        for (int st = 0; st < 4; ++st) { va[db][st][0] = *(LAS const u32x2*)(vp + 4096 * db + 8 * ((4 * st + hh) ^ vsw)); va[db][st][1] = *(LAS const u32x2*)(vp + 4096 * db + 8 * ((4 * st + hh + 2) ^ vsw)); }
    if (use_mask) {
        const unsigned off0 = (unsigned)(4 * hh - clo0), rng0 = (unsigned)(chi0 - clo0), off1 = (unsigned)(4 * hh - clo1), rng1 = (unsigned)(chi1 - clo1);
#pragma unroll
        for (int i = 0; i < 16; ++i) { const unsigned c0 = (unsigned)((i & 3) + 8 * (i >> 2)); s0[i] = (c0 + off0 <= rng0) ? s0[i] : -INFINITY; s1[i] = (c0 + off1 <= rng1) ? s1[i] : -INFINITY; }
    }
    float tmax = max4f_mfma(s0[0], s0[1], s1[0], s1[1]);
#pragma unroll
    for (int i = 2; i < 16; i += 2) { tmax = max3f(tmax, s0[i], s0[i + 1]); tmax = max3f(tmax, s1[i], s1[i + 1]); }
    tmax = max2f(tmax, lane_xor(tmax, r31 + 32 * hh, 32)) * QK_SCALE;
    if (__any(tmax - m_run > 8.0f)) {
        const float m_new = fmaxf(m_run, tmax);
        const float alpha = __builtin_amdgcn_exp2f(m_run - m_new);
        m_run = m_new; l_run *= alpha;
#pragma unroll
        for (int i = 0; i < 16; ++i) { o0[i] *= alpha; o1[i] *= alpha; }
    }
    float ps0 = 0.f, ps1 = 0.f;
    const float nm = -m_run;
#pragma unroll
    for (int i = 0; i < 16; ++i) { const float p0 = __builtin_amdgcn_exp2f(fmaf(s0[i], QK_SCALE, nm)), p1 = __builtin_amdgcn_exp2f(fmaf(s1[i], QK_SCALE, nm)); s0[i] = p0; s1[i] = p1; ps0 += p0; ps1 += p1; }
    l_run += ps0 + ps1;
    u32x4 pw;
    pw.x = pk2(s0[0], s0[1]); pw.y = pk2(s0[2], s0[3]); pw.z = pk2(s0[4], s0[5]); pw.w = pk2(s0[6], s0[7]); const bf16x8 p00 = __builtin_bit_cast(bf16x8, pw);
    pw.x = pk2(s0[8], s0[9]); pw.y = pk2(s0[10], s0[11]); pw.z = pk2(s0[12], s0[13]); pw.w = pk2(s0[14], s0[15]); const bf16x8 p01 = __builtin_bit_cast(bf16x8, pw);
    pw.x = pk2(s1[0], s1[1]); pw.y = pk2(s1[2], s1[3]); pw.z = pk2(s1[4], s1[5]); pw.w = pk2(s1[6], s1[7]); const bf16x8 p10 = __builtin_bit_cast(bf16x8, pw);
    pw.x = pk2(s1[8], s1[9]); pw.y = pk2(s1[10], s1[11]); pw.z = pk2(s1[12], s1[13]); pw.w = pk2(s1[14], s1[15]); const bf16x8 p11 = __builtin_bit_cast(bf16x8, pw);
#define VA8(db_, st_) __builtin_bit_cast(bf16x8, (u32x4){va[db_][st_][0].x, va[db_][st_][0].y, va[db_][st_][1].x, va[db_][st_][1].y})
    o0 = __builtin_amdgcn_mfma_f32_32x32x16_bf16(VA8(0, 0), p00, o0, 0, 0, 0); o1 = __builtin_amdgcn_mfma_f32_32x32x16_bf16(VA8(1, 0), p00, o1, 0, 0, 0);
    o0 = __builtin_amdgcn_mfma_f32_32x32x16_bf16(VA8(0, 1), p01, o0, 0, 0, 0); o1 = __builtin_amdgcn_mfma_f32_32x32x16_bf16(VA8(1, 1), p01, o1, 0, 0, 0);
    o0 = __builtin_amdgcn_mfma_f32_32x32x16_bf16(VA8(0, 2), p10, o0, 0, 0, 0); o1 = __builtin_amdgcn_mfma_f32_32x32x16_bf16(VA8(1, 2), p10, o1, 0, 0, 0);
    o0 = __builtin_amdgcn_mfma_f32_32x32x16_bf16(VA8(0, 3), p11, o0, 0, 0, 0); o1 = __builtin_amdgcn_mfma_f32_32x32x16_bf16(VA8(1, 3), p11, o1, 0, 0, 0);
#undef VA8
}

__device__ __forceinline__ void attn_tile4(LAS const unsigned char* slotA, LAS const unsigned char* slotB, const bf16x8 (&bq)[4], f32x16& o0, f32x16& o1, float& m_run, float& l_run, int r31, int hh) {
    const int ksw = (r31 >> 1) & 7, vsw = (r31 >> 1) & 15;
    f32x16 s[4];
#pragma unroll
    for (int t = 0; t < 4; ++t)
#pragma unroll
        for (int i = 0; i < 16; ++i) s[t][i] = 0.f;
#pragma unroll
    for (int ks = 0; ks < 4; ++ks) {
        LAS const unsigned char* ka = slotA + r31 * 128 + 16 * ((2 * ks + hh) ^ ksw);
        LAS const unsigned char* kb = slotB + r31 * 128 + 16 * ((2 * ks + hh) ^ ksw);
        const bf16x8 k0 = *(LAS const bf16x8*)ka, k1 = *(LAS const bf16x8*)(ka + 4096), k2 = *(LAS const bf16x8*)kb, k3 = *(LAS const bf16x8*)(kb + 4096);
        s[0] = __builtin_amdgcn_mfma_f32_32x32x16_bf16(k0, bq[ks], s[0], 0, 0, 0); s[1] = __builtin_amdgcn_mfma_f32_32x32x16_bf16(k1, bq[ks], s[1], 0, 0, 0);
        s[2] = __builtin_amdgcn_mfma_f32_32x32x16_bf16(k2, bq[ks], s[2], 0, 0, 0); s[3] = __builtin_amdgcn_mfma_f32_32x32x16_bf16(k3, bq[ks], s[3], 0, 0, 0);
    }
    float tmax = max4f_mfma(s[0][0], s[1][0], s[2][0], s[3][0]);
#pragma unroll
    for (int i = 1; i < 16; ++i) { tmax = max3f(tmax, s[0][i], s[1][i]); tmax = max3f(tmax, s[2][i], s[3][i]); }
    tmax = max2f(tmax, lane_xor(tmax, r31 + 32 * hh, 32)) * QK_SCALE;
    if (__any(tmax - m_run > 8.0f)) {
        const float m_new = fmaxf(m_run, tmax);
        const float alpha = __builtin_amdgcn_exp2f(m_run - m_new);
        m_run = m_new; l_run *= alpha;
#pragma unroll
        for (int i = 0; i < 16; ++i) { o0[i] *= alpha; o1[i] *= alpha; }
    }
    const float nm = -m_run;
    float ps0 = 0.f, ps1 = 0.f;
#pragma unroll
    for (int t = 0; t < 4; ++t)
#pragma unroll
        for (int i = 0; i < 16; i += 2) { const float p0 = __builtin_amdgcn_exp2f(fmaf(s[t][i], QK_SCALE, nm)), p1 = __builtin_amdgcn_exp2f(fmaf(s[t][i + 1], QK_SCALE, nm)); s[t][i] = p0; s[t][i + 1] = p1; ps0 += p0; ps1 += p1; }
    l_run += ps0 + ps1;
#pragma unroll
    for (int t = 0; t < 4; ++t) {
        LAS const unsigned char* vp = (t < 2 ? slotA : slotB) + 8192 + r31 * 128;
        const int g0 = 8 * (t & 1) + hh;
        u32x4 pw;
        pw.x = pk2(s[t][0], s[t][1]); pw.y = pk2(s[t][2], s[t][3]); pw.z = pk2(s[t][4], s[t][5]); pw.w = pk2(s[t][6], s[t][7]); const bf16x8 pa = __builtin_bit_cast(bf16x8, pw);
        pw.x = pk2(s[t][8], s[t][9]); pw.y = pk2(s[t][10], s[t][11]); pw.z = pk2(s[t][12], s[t][13]); pw.w = pk2(s[t][14], s[t][15]); const bf16x8 pb = __builtin_bit_cast(bf16x8, pw);
        const u32x2 a0l = *(LAS const u32x2*)(vp + 8 * ((g0) ^ vsw)), a0h = *(LAS const u32x2*)(vp + 8 * ((g0 + 2) ^ vsw));
        const u32x2 a1l = *(LAS const u32x2*)(vp + 8 * ((g0 + 4) ^ vsw)), a1h = *(LAS const u32x2*)(vp + 8 * ((g0 + 6) ^ vsw));
        const u32x2 b0l = *(LAS const u32x2*)(vp + 4096 + 8 * ((g0) ^ vsw)), b0h = *(LAS const u32x2*)(vp + 4096 + 8 * ((g0 + 2) ^ vsw));
        const u32x2 b1l = *(LAS const u32x2*)(vp + 4096 + 8 * ((g0 + 4) ^ vsw)), b1h = *(LAS const u32x2*)(vp + 4096 + 8 * ((g0 + 6) ^ vsw));
        o0 = __builtin_amdgcn_mfma_f32_32x32x16_bf16(__builtin_bit_cast(bf16x8, (u32x4){a0l.x, a0l.y, a0h.x, a0h.y}), pa, o0, 0, 0, 0);
        o1 = __builtin_amdgcn_mfma_f32_32x32x16_bf16(__builtin_bit_cast(bf16x8, (u32x4){b0l.x, b0l.y, b0h.x, b0h.y}), pa, o1, 0, 0, 0);
        o0 = __builtin_amdgcn_mfma_f32_32x32x16_bf16(__builtin_bit_cast(bf16x8, (u32x4){a1l.x, a1l.y, a1h.x, a1h.y}), pb, o0, 0, 0, 0);
        o1 = __builtin_amdgcn_mfma_f32_32x32x16_bf16(__builtin_bit_cast(bf16x8, (u32x4){b1l.x, b1l.y, b1h.x, b1h.y}), pb, o1, 0, 0, 0);
    }
}

__device__ __forceinline__ void attn_block_item(CKArgs& A, int l, int MODE, int item, LAS unsigned char* lds, int tid) {
    asm volatile("" : "+v"(tid));
    unsigned char* ws = A.ws;
    const bf16_t* PT = (const bf16_t*)(ws + WS_PT);
    bf16_t* Y = (bf16_t*)(ws + WS_HY);
    const int wave = __builtin_amdgcn_readfirstlane(tid >> 6), lane = tid & 63;
    const int r31 = lane & 31, hh = lane >> 5;
    int b, h, qtok, qi = 0;
    int rp = 0, mg = 0, qg = 0;
    if (MODE == 0) { b = item / 192; const int rem = item % 192; h = rem >> 5; qi = rem & 31; rp = 2 * qi + (wave >> 2); mg = wave & 3;
        qtok = b * SEQ + (2 * rp + (r31 >> 4)) * 64 + 16 * mg + (r31 & 15); }
    else if (MODE == 1) { b = item / 192; const int rem = item % 192; h = rem >> 5; qi = rem & 31; qg = 8 * qi + wave; qtok = b * SEQ + 32 * qg + r31; }
    else { b = item / 6; h = item % 6; qg = wave; qtok = MLAT + b * CTXL + 32 * qg + r31; }
    const bool grpA = (MODE == 0 || MODE == 2);
    const int kvh = grpA ? h : h / 3;
    const int qcol = (grpA ? C_QA : C_QC) + h * 64, gcol = (grpA ? C_GA : C_GC) + h * 64, ycol = (grpA ? 0 : 640) + h * 64;
    const int kh = grpA ? h : 6 + kvh;
    bf16x8 bq[4];
    { const bf16_t* qp = PT + (size_t)qtok * NTM + qcol + 8 * hh;
#pragma unroll
      for (int s = 0; s < 4; ++s) bq[s] = *(const bf16x8*)(qp + 16 * s); }
    f32x16 o0, o1;
#pragma unroll
    for (int i = 0; i < 16; ++i) { o0[i] = 0.f; o1[i] = 0.f; }
    float m_run = -1e30f, l_run = 0.f;
    if (!grpA) { m_run = A.sink[l * 6 + h] * LOG2E; l_run = hh == 0 ? 1.0f : 0.f; }
    int wrow0 = 0, nwin = 0;
    if (MODE == 0) { const int a0 = min(max(4 * qi - 4, 0), 120), a1 = min(max(4 * qi - 1, 0), 120) + 7; wrow0 = a0; nwin = a1 - a0 + 1; }
    if (MODE == 1) { const int k0 = max(4 * qi - 2, 0), k1 = min(4 * qi + 5, 127); wrow0 = k0; nwin = k1 - k0 + 1; }
    const int nsteps = 4 + nwin;
    int ra = 0, rb = -1, cs = 0, rq = 0, jq = 0, r0 = 0, cmin = 0;
    LAS const float* btab = (LAS const float*)(lds + AUX_OFF + 2048);
    if (MODE == 0) { ra = min(max(2 * rp - 4, 0), 120); rb = min(max(2 * rp - 3, 0), 120) + 7; cs = min(max(16 * mg - 8, 0), 32);
        rq = 2 * rp + (r31 >> 4); jq = 16 * mg + (r31 & 15); r0 = min(max(rq - 4, 0), 120); cmin = min(max(jq - 8, 0), 48) - cs;
        }
    const int lr = tid >> 3, lc = tid & 7;
    const bf16_t* kg = (const bf16_t*)(ws + WS_KH) + (size_t)kh * MTOT * 64 + 8 * tid;
    const bf16_t* vg = (const bf16_t*)(ws + WS_VT) + (size_t)kh * MTOT * 64 + 8 * tid;
    const int kdst = lr * 128 + 16 * (lc ^ ((lr >> 1) & 7));
    const int vdstb = 8192 + (8 * lc) * 128 + 2 * (lr & 3), vg4 = lr >> 2, vs4 = (4 * lc) & 15;
#define ROW_TOK(i) ((i) < 4 ? MLAT + b * CTXL + 64 * (i) : b * SEQ + 64 * (wrow0 + (i) - 4))
#define LOAD_ROW(i, kr_, vr_) do { const int t0_ = ROW_TOK(i); kr_ = *(const u32x4*)(kg + (size_t)t0_ * 64); vr_ = *(const u32x4*)(vg + (size_t)t0_ * 64); } while (0)
#define WRITE_ROW(sl_, kr_, vr_) do { *(LAS u32x4*)((sl_) + kdst) = kr_; \
        _Pragma("unroll") for (int j_ = 0; j_ < 8; ++j_) { const unsigned w_ = j_ < 2 ? vr_.x : (j_ < 4 ? vr_.y : (j_ < 6 ? vr_.z : vr_.w)); \
            *(LAS bf16_t*)((sl_) + vdstb + j_ * 128 + 8 * (vg4 ^ ((vs4 + (j_ >> 1)) & 15))) = (bf16_t)((j_ & 1) ? (w_ >> 16) : (w_ & 0xffffu)); } } while (0)
    u32x4 k0, v0, k1, v1, k2, v2;
    LOAD_ROW(0, k0, v0); LOAD_ROW(1, k2, v2);
    __syncthreads();
    if (MODE == 0 && tid < 465) ((LAS float*)(lds + AUX_OFF + 2048))[tid] = A.na_rpb[(size_t)(l * 6 + h) * 465 + tid] * LOG2E;
    WRITE_ROW(lds, k0, v0); WRITE_ROW(lds + 16384, k2, v2);
    __syncthreads();
#pragma unroll 1
    for (int pr = 0; pr < 2; ++pr) {
        { const int ra_ = pr == 0 ? 2 : min(4, nsteps - 1), rb_ = pr == 0 ? 3 : ra_; LOAD_ROW(ra_, k0, v0); LOAD_ROW(rb_, k2, v2); }
        attn_tile4(lds, lds + 16384, bq, o0, o1, m_run, l_run, r31, hh);
        __syncthreads();
        if (pr == 0) { WRITE_ROW(lds, k0, v0); WRITE_ROW(lds + 16384, k2, v2); } else if (nsteps > 4) { WRITE_ROW(lds, k0, v0); }
        __syncthreads();
    }
#define ATT_STEP(i_, kL, vL, kW, vW) do { const int i = (i_); if (i < nsteps) { \
        LAS const unsigned char* slot = lds + (i & 1) * 16384; \
        { const int ir_ = min(i + 1, nsteps - 1); LOAD_ROW(ir_, kL, vL); }     \
        bool use2 = false, use1 = false, um = false, um1 = false, ub = false; int c1 = 0, lo0 = 0, hi0 = 31, lo1 = 0, hi1 = 31, bidx = 0; \
        if (i < 4) use2 = true; \
        else if (MODE == 0) { const int a = wrow0 + i - 4; use1 = (a >= ra) && (a <= rb); const bool rowok = (a >= r0) && (a < r0 + 8); \
            c1 = cs; lo0 = rowok ? cmin : 1; hi0 = rowok ? cmin + 15 : 0; ub = true; um1 = true; bidx = (a - rq + 7) * 31 + (cs - jq + 15); } \
        else if (MODE == 1) { const int rel0 = (64 * (wrow0 + i - 4) - (32 * qg - 128)) >> 5, rel1 = rel0 + 1;     \
            const bool a0 = (rel0 >= 0) && (rel0 <= 8), a1 = (rel1 >= 0) && (rel1 <= 8); \
            if (a0 && a1) { use2 = true; um = (rel0 == 0) || (rel1 == 8); lo0 = rel0 == 0 ? r31 : 0; hi1 = rel1 == 8 ? r31 : 31; } \
            else if (a0) { use1 = true; um1 = (rel0 == 0) || (rel0 == 8); lo0 = rel0 == 0 ? r31 : 0; hi0 = rel0 == 8 ? r31 : 31; } \
            else if (a1) { use1 = true; c1 = 32; um1 = (rel1 == 0) || (rel1 == 8); lo0 = rel1 == 0 ? r31 : 0; hi0 = rel1 == 8 ? r31 : 31; } } \
        if (use2) attn_tile2(slot, bq, o0, o1, m_run, l_run, r31, hh, um, lo0, hi0, lo1, hi1); \
        if (use1) attn_tile(slot, c1, bq, o0, o1, m_run, l_run, r31, hh, um1, lo0, hi0, ub, btab, bidx); \
        if (i + 1 < nsteps) { LAS unsigned char* nslot = lds + ((i + 1) & 1) * 16384; WRITE_ROW(nslot, kW, vW); } \
        __syncthreads(); } } while (0)
#pragma unroll 1
    for (int i3 = 4; i3 < nsteps; ++i3) {
        ATT_STEP(i3, k1, v1, k1, v1);
    }
#undef ATT_STEP
#undef LOAD_ROW
#undef WRITE_ROW
    const float ltot = l_run + lane_xor(l_run, lane, 32);
    const float inv = 1.0f / ltot;
    const bf16_t* gp = PT + (size_t)qtok * NTM + gcol + 4 * hh;
    bf16_t* yp = Y + (size_t)qtok * DM + ycol + 4 * hh;
#pragma unroll
    for (int db = 0; db < 2; ++db)
#pragma unroll
        for (int g4 = 0; g4 < 4; ++g4) {
            const int d0 = 32 * db + 8 * g4;
            const u32x2 gw = *(const u32x2*)(gp + d0);
            float v0, v1, v2, v3;
            if (db == 0) { v0 = o0[4 * g4]; v1 = o0[4 * g4 + 1]; v2 = o0[4 * g4 + 2]; v3 = o0[4 * g4 + 3]; }
            else { v0 = o1[4 * g4]; v1 = o1[4 * g4 + 1]; v2 = o1[4 * g4 + 2]; v3 = o1[4 * g4 + 3]; }
            v0 *= inv * silu_f(bflo(gw.x)); v1 *= inv * silu_f(bfhi(gw.x)); v2 *= inv * silu_f(bflo(gw.y)); v3 *= inv * silu_f(bfhi(gw.y));
            u32x2 o; o.x = pk2(v0, v1); o.y = pk2(v2, v3);
            *(u32x2*)(yp + d0) = o;
        }
}

typedef float cf2 __attribute__((ext_vector_type(2)));
__device__ __forceinline__ cf2 mk2(float x, float y) { cf2 r; r.x = x; r.y = y; return r; }
__device__ __forceinline__ cf2 cmul(cf2 a, cf2 b) { const cf2 bs = mk2(-b.y, b.x); return a.xx * b + a.yy * bs; }
#define PA(e) ((e) + (((e) >> 4) << 1))
struct cf2x4 { cf2 a, b, c, d; };
__device__ __forceinline__ cf2x4 bfly4_fwd(cf2 x0, cf2 x1, cf2 x2, cf2 x3, float a) {
    const cf2 w1 = mk2(__builtin_amdgcn_cosf(a), -__builtin_amdgcn_sinf(a));
    const cf2 w2 = cmul(w1, w1), w3 = cmul(w2, w1);
    const cf2 s02 = x0 + x2, d02 = x0 - x2, s13 = x1 + x3, d13 = x1 - x3;
    cf2x4 r;
    r.a = s02 + s13;
    r.b = cmul(s02 - s13, w2);
    r.c = cmul(mk2(d02.x + d13.y, d02.y - d13.x), w1);
    r.d = cmul(mk2(d02.x - d13.y, d02.y + d13.x), w3);
    return r;
}
__device__ __forceinline__ cf2x4 bfly4_inv(cf2 v0, cf2 v1, cf2 v2, cf2 v3, float a) {
    const cf2 w1 = mk2(__builtin_amdgcn_cosf(a), __builtin_amdgcn_sinf(a));
    const cf2 w2 = cmul(w1, w1);
    const cf2 bb = cmul(v1, w2), dd = cmul(v3, w2);
    const cf2 u0 = v0 + bb, u1 = v0 - bb, u2 = v2 + dd, u3 = v2 - dd;
    const cf2 e = cmul(u2, w1), f0 = cmul(u3, w1);
    const cf2 f = mk2(-f0.y, f0.x);
    cf2x4 r; r.a = u0 + e; r.c = u0 - e; r.b = u1 + f; r.d = u1 - f; return r;
}
__device__ __forceinline__ void fft_fwd_fused(LAS cf2* buf, int tid, int lsb, bool zero_hi = false) {
    const int sB = 1 << lsb, s = 4 << lsb;
    const float ra = 1.0f / (float)(16 << lsb), rb = 1.0f / (float)(4 << lsb);
    int poff[4][4];
#pragma unroll
    for (int a = 0; a < 4; ++a)
#pragma unroll
        for (int b = 0; b < 4; ++b) { const int off = a * s + b * sB; poff[a][b] = PA(off); }
#pragma unroll 1
    for (int gg = 0; gg < 2; ++gg) {
        const int g = tid + 512 * gg, i = g & (sB - 1), base = ((g >> lsb) << (lsb + 4)) + i;
        const int pbase = PA(base);
        cf2 x[4][4];
#pragma unroll
        for (int a = 0; a < 4; ++a)
#pragma unroll
            for (int b = 0; b < 4; ++b) x[a][b] = (zero_hi && a >= 2) ? mk2(0.f, 0.f) : buf[pbase + poff[a][b]];
#pragma unroll
        for (int b = 0; b < 4; ++b) { const cf2x4 r = bfly4_fwd(x[0][b], x[1][b], x[2][b], x[3][b], (float)(i + b * sB) * ra); x[0][b] = r.a; x[1][b] = r.b; x[2][b] = r.c; x[3][b] = r.d; }
        const float ab = (float)i * rb;
#pragma unroll
        for (int a = 0; a < 4; ++a) { const cf2x4 r = bfly4_fwd(x[a][0], x[a][1], x[a][2], x[a][3], ab); x[a][0] = r.a; x[a][1] = r.b; x[a][2] = r.c; x[a][3] = r.d; }
#pragma unroll
        for (int a = 0; a < 4; ++a)
#pragma unroll
            for (int b = 0; b < 4; ++b) buf[pbase + poff[a][b]] = x[a][b];
    }
    __syncthreads();
}
__device__ __forceinline__ void fft_inv_fused(LAS cf2* buf, int tid, int lsb) {
    const int sB = 1 << lsb, s = 4 << lsb;
    const float ra = 1.0f / (float)(16 << lsb), rb = 1.0f / (float)(4 << lsb);
    int poff[4][4];
#pragma unroll
    for (int a = 0; a < 4; ++a)
#pragma unroll
        for (int b = 0; b < 4; ++b) { const int off = a * s + b * sB; poff[a][b] = PA(off); }
#pragma unroll 1
    for (int gg = 0; gg < 2; ++gg) {
        const int g = tid + 512 * gg, i = g & (sB - 1), base = ((g >> lsb) << (lsb + 4)) + i;
        const int pbase = PA(base);
        cf2 x[4][4];
#pragma unroll
        for (int a = 0; a < 4; ++a)
#pragma unroll
            for (int b = 0; b < 4; ++b) x[a][b] = buf[pbase + poff[a][b]];
        const float ab = (float)i * rb;
#pragma unroll
        for (int a = 0; a < 4; ++a) { const cf2x4 r = bfly4_inv(x[a][0], x[a][1], x[a][2], x[a][3], ab); x[a][0] = r.a; x[a][1] = r.b; x[a][2] = r.c; x[a][3] = r.d; }
#pragma unroll
        for (int b = 0; b < 4; ++b) { const cf2x4 r = bfly4_inv(x[0][b], x[1][b], x[2][b], x[3][b], (float)(i + b * sB) * ra); x[0][b] = r.a; x[1][b] = r.b; x[2][b] = r.c; x[3][b] = r.d; }
#pragma unroll
        for (int a = 0; a < 4; ++a)
#pragma unroll
            for (int b = 0; b < 4; ++b) buf[pbase + poff[a][b]] = x[a][b];
    }
    __syncthreads();
}
__device__ __forceinline__ void fft_fwd(LAS cf2* buf, int tid, const unsigned* zk = nullptr, bool zero_hi = false) {
#pragma unroll 1
    for (int lsb = 10; lsb >= 2; lsb -= 4) fft_fwd_fused(buf, tid, lsb, zero_hi && lsb == 10);
#pragma unroll 4
    for (int k = 0; k < 8; ++k) {
        const int e0 = 4 * (tid + 512 * k), base = PA(e0);
        cf2 x0 = buf[base], x1 = buf[base + 1], x2 = buf[base + 2], x3 = buf[base + 3];
        const cf2 s02 = x0 + x2, d02 = x0 - x2, s13 = x1 + x3, d13 = x1 - x3;
        cf2 y0 = s02 + s13, y1 = s02 - s13, y2 = mk2(d02.x + d13.y, d02.y - d13.x), y3 = mk2(d02.x - d13.y, d02.y + d13.x);
        if (zk) { const u32x4 w = *(const u32x4*)(zk + (unsigned)e0);
            y0 = cmul(y0, mk2(bflo(w.x), bfhi(w.x))); y1 = cmul(y1, mk2(bflo(w.y), bfhi(w.y))); y2 = cmul(y2, mk2(bflo(w.z), bfhi(w.z))); y3 = cmul(y3, mk2(bflo(w.w), bfhi(w.w))); }
        buf[base] = y0; buf[base + 1] = y1; buf[base + 2] = y2; buf[base + 3] = y3;
    }
    __syncthreads();
}
__device__ __forceinline__ void fft_inv(LAS cf2* buf, int tid) {
#pragma unroll 1
    for (int lsb = 0; lsb <= 8; lsb += 4) fft_inv_fused(buf, tid, lsb);
#pragma unroll 4
    for (int k = 0; k < 8; ++k) {
        const int i = tid + 512 * k, pi = PA(tid) + 576 * k;
        cf2 v0 = buf[pi], v1 = buf[pi + 4608], v2 = buf[pi + 9216], v3 = buf[pi + 13824];
        const cf2x4 r = bfly4_inv(v0, v1, v2, v3, (float)i * (1.0f / 16384.0f));
        buf[pi] = r.a; buf[pi + 4608] = r.b;
    }
    __syncthreads();
}
__device__ __forceinline__ float hy_short(const bf16_t* prow, int tb, int t, int L, float w0, float w1, float w2, float bias) {
    const float pm = t > 0 ? bf2f(prow[tb + t - 1]) : 0.f;
    const float pc = bf2f(prow[tb + t]);
    const float pp = t < L - 1 ? bf2f(prow[tb + t + 1]) : 0.f;
    return w0 * pm + w1 * pc + w2 * pp + bias;
}
__device__ __forceinline__ float block_sum(float v, LAS float* red, int tid) {
    v = wave_sum(v, tid & 63);
    __syncthreads();
    if ((tid & 63) == 0) red[tid >> 6] = v;
    __syncthreads();
    float s = 0.f;
#pragma unroll
    for (int w = 0; w < 8; ++w) s += red[w];
    return s;
}

__device__ __forceinline__ void hyena_block(CKArgs& A, int l, int c, LAS unsigned char* lds, int tid) {
    asm volatile("" : "+v"(tid));
    unsigned char* ws = A.ws;
    LAS cf2* buf = (LAS cf2*)lds;
    LAS float* fs = (LAS float*)lds;
    LAS float* aux = (LAS float*)(lds + AUX_OFF);
    LAS float* red = aux + 256;
    const bf16_t* PCT = (const bf16_t*)(ws + WS_PCT);
    bf16_t* YBT = (bf16_t*)((unsigned char*)A.out + OUT_YBT);
    const bf16_t* rowz = PCT + (size_t)(R_HZ + c) * MTOT;
    const bf16_t* rowx1 = rowz + (size_t)256 * MTOT;
    const bf16_t* rowx2 = rowz + (size_t)512 * MTOT;
    const bf16_t* rowg = PCT + (size_t)(R_GB + c) * MTOT;
    const float* cw = A.hy_conv_w + (size_t)l * 3 * 768; const float* cb = A.hy_conv_b + (size_t)l * 768;
    const float wz0 = cw[c], wz1 = cw[768 + c], wz2 = cw[1536 + c], bz = cb[c];
    const float wa0 = cw[256 + c], wa1 = cw[768 + 256 + c], wa2 = cw[1536 + 256 + c], ba = cb[256 + c];
    const float wb0 = cw[512 + c], wb1 = cw[768 + 512 + c], wb2 = cw[1536 + 512 + c], bb = cb[512 + c];
    const float d0 = A.hy_d[(l * 2 + 0) * 256 + c], d1 = A.hy_d[(l * 2 + 1) * 256 + c];
    const float dmin = -3.0701134573253945f, dmax = -15.350567286626973f;
    const float delta = fabsf(dmin + (float)c * ((dmax - dmin) / 255.0f));
    __syncthreads();
    if (tid < 256) { const int k = tid >> 6, j = tid & 63; aux[tid] = A.hy_w3[((size_t)l * 64 + j) * 1024 + k * 256 + c]; }
    __syncthreads();

    if (l < DEPTH - 1) {
        float ss0 = 0.f, ss1 = 0.f;
        if (tid < 256) {
            const int n = tid; const f32x4* hr = (const f32x4*)((const float*)(ws + WS_H2C) + ((size_t)l * CTXL + n) * 64);
            float f0 = 0.f, f1 = 0.f, b0 = 0.f, b1 = 0.f;
#pragma unroll 1
            for (int j4 = 0; j4 < 16; ++j4) { const f32x4 hv = hr[j4];
#pragma unroll
                for (int e = 0; e < 4; ++e) { const float hvv = hv[e]; const int j = 4 * j4 + e; f0 += hvv * aux[j]; f1 += hvv * aux[64 + j]; b0 += hvv * aux[128 + j]; b1 += hvv * aux[192 + j]; } }
            const float e = __expf(-((float)n * (1.0f / 255.0f)) * delta);
            f0 *= e; f1 *= e; b0 *= e; b1 *= e;
            fs[255 + n] = f0; fs[512 + 255 + n] = f1;
            if (n >= 1) { fs[255 - n] = b0; fs[512 + 255 - n] = b1; }
            ss0 = f0 * f0 + (n >= 1 ? b0 * b0 : 0.f); ss1 = f1 * f1 + (n >= 1 ? b1 * b1 : 0.f);
        }
        if (tid == 0) { fs[511] = 0.f; fs[1023] = 0.f; }
        const int b = tid >> 8, t = tid & 255, tok = MLAT + b * CTXL;
        const float z = hy_short(rowz, tok, t, CTXL, wz0, wz1, wz2, bz);
        const float x1 = hy_short(rowx1, tok, t, CTXL, wa0, wa1, wa2, ba);
        const float x2 = hy_short(rowx2, tok, t, CTXL, wb0, wb1, wb2, bb);
        const float gb = bf2f(rowg[tok + t]);
        fs[1024 + tid] = z;
        const float n0 = rsqrtf(block_sum(ss0, red, tid) + 1e-6f);
        const float n1 = rsqrtf(block_sum(ss1, red, tid) + 1e-6f);
        __syncthreads();
        float y = 0.f;
        { LAS const float* kc = fs + 255 + t; LAS const float* zz = fs + 1024 + b * 256;
#pragma unroll 8
          for (int s = 0; s < 256; ++s) y += zz[s] * kc[-s]; }
        const float z1 = x1 * (y * n0 + d0 * z);
        fs[1536 + tid] = z1;
        __syncthreads();
        float y2 = 0.f;
        { LAS const float* kc = fs + 512 + 255 + t; LAS const float* zz = fs + 1536 + b * 256;
#pragma unroll 8
          for (int s = 0; s < 256; ++s) y2 += zz[s] * kc[-s]; }
        const float o = x2 * (y2 * n1 + d1 * z1) * silu_f(gb);
        YBT[(size_t)c * MTOT + tok + t] = (bf16_t)(pk2(o, 0.f) & 0xffffu);
        __syncthreads();
    }

    unsigned* ZK = (unsigned*)((unsigned char*)A.out + OUT_ZS) + (size_t)c * 2 * NFFT;
    const int lane = tid & 63;
    {
        float ss0 = 0.f, ss1 = 0.f;
        const bf16_t* F0 = (const bf16_t*)((unsigned char*)A.out + OUT_FILT) + (size_t)c * SEQ;
        u32x4 fw[2][4];
#pragma unroll
        for (int j = 0; j < 2; ++j)
#pragma unroll
            for (int r = 0; r < 4; ++r) fw[j][r] = *(const u32x4*)(F0 + (size_t)(256 * r) * SEQ + 8 * (tid + 512 * j));
#pragma unroll
        for (int j = 0; j < 2; ++j)
#pragma unroll
            for (int e8 = 0; e8 < 8; ++e8) {
                const int n = 8 * (tid + 512 * j) + e8;
                const float e = __expf(-((float)n * (1.0f / 8191.0f)) * delta);
                const unsigned w0 = e8 < 2 ? fw[j][0].x : (e8 < 4 ? fw[j][0].y : (e8 < 6 ? fw[j][0].z : fw[j][0].w)), w1 = e8 < 2 ? fw[j][1].x : (e8 < 4 ? fw[j][1].y : (e8 < 6 ? fw[j][1].z : fw[j][1].w));
                const unsigned w2 = e8 < 2 ? fw[j][2].x : (e8 < 4 ? fw[j][2].y : (e8 < 6 ? fw[j][2].z : fw[j][2].w)), w3 = e8 < 2 ? fw[j][3].x : (e8 < 4 ? fw[j][3].y : (e8 < 6 ? fw[j][3].z : fw[j][3].w));
                const float f0 = ((e8 & 1) ? bfhi(w0) : bflo(w0)) * e, f1 = ((e8 & 1) ? bfhi(w1) : bflo(w1)) * e, b0 = ((e8 & 1) ? bfhi(w2) : bflo(w2)) * e, b1 = ((e8 & 1) ? bfhi(w3) : bflo(w3)) * e;
                buf[PA(n)] = mk2(f0, f1); ss0 += f0 * f0; ss1 += f1 * f1;
                if (n >= 1) { buf[PA(NFFT - n)] = mk2(b0, b1); ss0 += b0 * b0; ss1 += b1 * b1; }
            }
        if (tid == 0) { const float zf = delta * 0.0f; buf[PA(SEQ)] = mk2(zf, zf); }
        const float nrm0 = rsqrtf(block_sum(ss0, red, tid) + 1e-6f) * (0.5f / NFFT);
        const float nrm1 = rsqrtf(block_sum(ss1, red, tid) + 1e-6f) * (0.5f / NFFT);
        __syncthreads();
        fft_fwd(buf, tid);
#pragma unroll 4
        for (int k = 0; k < 32; ++k) {
            const int p = tid + 512 * k; const int f = (int)(__brev((unsigned)p) >> 18); const int pp = (int)(__brev((unsigned)((NFFT - f) & (NFFT - 1))) >> 18);
            const cf2 za = buf[PA(p)], zb = buf[PA(pp)];
            ZK[p] = pk2((za.x + zb.x) * nrm0 + d0 * (1.0f / NFFT), (za.y - zb.y) * nrm0);
            ZK[NFFT + p] = pk2((za.y + zb.y) * nrm1 + d1 * (1.0f / NFFT), -(za.x - zb.x) * nrm1);
        }
        __syncthreads();
    }
#define HY_RAW(prow_, j_, b_) (*(const u32x4*)((prow_) + (size_t)(b_) * SEQ + 8 * (tid + 512 * (j_))))
#define HY_CONV(prow_, raw_, j_, b_, w0_, w1_, w2_, bias_, u_) do { \
        const int q_ = tid + 512 * (j_); float own_[8]; \
        own_[0] = bflo((raw_).x); own_[1] = bfhi((raw_).x); own_[2] = bflo((raw_).y); own_[3] = bfhi((raw_).y); own_[4] = bflo((raw_).z); own_[5] = bfhi((raw_).z); own_[6] = bflo((raw_).w); own_[7] = bfhi((raw_).w); \
        float pl_ = lane_prev(own_[7], lane), nl_ = lane_next(own_[0], lane); \
        if (lane == 0) pl_ = q_ > 0 ? bf2f((prow_)[(size_t)(b_) * SEQ + 8 * q_ - 1]) : 0.f; \
        if (lane == 63) nl_ = 8 * q_ + 8 < SEQ ? bf2f((prow_)[(size_t)(b_) * SEQ + 8 * q_ + 8]) : 0.f; \
        _Pragma("unroll") for (int e = 0; e < 8; ++e) (u_)[e] = (w0_) * (e > 0 ? own_[e > 0 ? e - 1 : 0] : pl_) + (w1_) * own_[e] + (w2_) * (e < 7 ? own_[e < 7 ? e + 1 : 7] : nl_) + (bias_); } while (0)
    const int pq0 = PA(8 * tid), pq1 = PA(8 * (tid + 512));
    {
        const u32x4 r00 = HY_RAW(rowz, 0, 0), r01 = HY_RAW(rowz, 0, 1), r10 = HY_RAW(rowz, 1, 0), r11 = HY_RAW(rowz, 1, 1);
        float ua[8], ub[8];
        HY_CONV(rowz, r00, 0, 0, wz0, wz1, wz2, bz, ua); HY_CONV(rowz, r01, 0, 1, wz0, wz1, wz2, bz, ub);
#pragma unroll
        for (int e = 0; e < 8; ++e) buf[pq0 + e] = mk2(ua[e], ub[e]);
        HY_CONV(rowz, r10, 1, 0, wz0, wz1, wz2, bz, ua); HY_CONV(rowz, r11, 1, 1, wz0, wz1, wz2, bz, ub);
#pragma unroll
        for (int e = 0; e < 8; ++e) buf[pq1 + e] = mk2(ua[e], ub[e]);
    }
    __syncthreads();
    fft_fwd(buf, tid, ZK, true);
    fft_inv(buf, tid);
    {
        const u32x4 r00 = HY_RAW(rowx1, 0, 0), r01 = HY_RAW(rowx1, 0, 1), r10 = HY_RAW(rowx1, 1, 0), r11 = HY_RAW(rowx1, 1, 1);
        float xa[8], xb[8];
        HY_CONV(rowx1, r00, 0, 0, wa0, wa1, wa2, ba, xa); HY_CONV(rowx1, r01, 0, 1, wa0, wa1, wa2, ba, xb);
#pragma unroll
        for (int e = 0; e < 8; ++e) { const cf2 y = buf[pq0 + e]; buf[pq0 + e] = mk2(xa[e] * y.x, xb[e] * y.y); }
        HY_CONV(rowx1, r10, 1, 0, wa0, wa1, wa2, ba, xa); HY_CONV(rowx1, r11, 1, 1, wa0, wa1, wa2, ba, xb);
#pragma unroll
        for (int e = 0; e < 8; ++e) { const cf2 y = buf[pq1 + e]; buf[pq1 + e] = mk2(xa[e] * y.x, xb[e] * y.y); }
    }
    __syncthreads();
    fft_fwd(buf, tid, ZK + NFFT, true);
    fft_inv(buf, tid);
    {
        bf16_t* yrow = YBT + (size_t)c * MTOT;
        const u32x4 r00 = HY_RAW(rowx2, 0, 0), r01 = HY_RAW(rowx2, 0, 1), r10 = HY_RAW(rowx2, 1, 0), r11 = HY_RAW(rowx2, 1, 1);
        const u32x4 g00 = HY_RAW(rowg, 0, 0), g01 = HY_RAW(rowg, 0, 1), g10 = HY_RAW(rowg, 1, 0), g11 = HY_RAW(rowg, 1, 1);
        float xa[8], xb[8];
#define HY_OUT(pq_, ga_, gb_, j_) do { float oa_[8], ob_[8]; \
            const float gaf_[8] = {bflo((ga_).x), bfhi((ga_).x), bflo((ga_).y), bfhi((ga_).y), bflo((ga_).z), bfhi((ga_).z), bflo((ga_).w), bfhi((ga_).w)}; \
            const float gbf_[8] = {bflo((gb_).x), bfhi((gb_).x), bflo((gb_).y), bfhi((gb_).y), bflo((gb_).z), bfhi((gb_).z), bflo((gb_).w), bfhi((gb_).w)}; \
            _Pragma("unroll") for (int e = 0; e < 8; ++e) { const cf2 y = buf[(pq_) + e]; oa_[e] = xa[e] * y.x * silu_f(gaf_[e]); ob_[e] = xb[e] * y.y * silu_f(gbf_[e]); } \
            u32x4 wa_, wb_; wa_.x = pk2(oa_[0], oa_[1]); wa_.y = pk2(oa_[2], oa_[3]); wa_.z = pk2(oa_[4], oa_[5]); wa_.w = pk2(oa_[6], oa_[7]); \
            wb_.x = pk2(ob_[0], ob_[1]); wb_.y = pk2(ob_[2], ob_[3]); wb_.z = pk2(ob_[4], ob_[5]); wb_.w = pk2(ob_[6], ob_[7]); \
            *(u32x4*)(yrow + 8 * (tid + 512 * (j_))) = wa_; *(u32x4*)(yrow + SEQ + 8 * (tid + 512 * (j_))) = wb_; } while (0)
        HY_CONV(rowx2, r00, 0, 0, wb0, wb1, wb2, bb, xa); HY_CONV(rowx2, r01, 0, 1, wb0, wb1, wb2, bb, xb);
        HY_OUT(pq0, g00, g01, 0);
        HY_CONV(rowx2, r10, 1, 0, wb0, wb1, wb2, bb, xa); HY_CONV(rowx2, r11, 1, 1, wb0, wb1, wb2, bb, xb);
        HY_OUT(pq1, g10, g11, 1);
#undef HY_OUT
    }
#undef HY_RAW
#undef HY_CONV
    __syncthreads();
}

__device__ __forceinline__ void phase_mix(CKArgs& A, int l, LAS unsigned char* lds, int bid, int nblk, int tid) {
    for (int c = bid; c < 256; c += nblk) hyena_block(A, l, c, lds, tid);
    const int nctx = (l < DEPTH - 1) ? 12 : 0;
    const int nitems = 768 + 2 * nctx;
#pragma unroll 1
    for (int it = bid; it < nitems; it += nblk) {
        int mode, item;
        if (it < 384) { mode = 0; item = it; } else if (it < 768) { mode = 1; item = it - 384; } else if (it < 768 + nctx) { mode = 2; item = it - 768; } else { mode = 3; item = it - 768 - nctx; }
        attn_block_item(A, l, mode, item, lds, tid);
    }
}

__device__ __forceinline__ void phase_tr(CKArgs& A, int l, LAS unsigned char* lds, int bid, int nblk, int tid) {
    const int wave = __builtin_amdgcn_readfirstlane(tid >> 6), lane = tid & 63;
    const int gw = bid * 8 + wave, NGW = nblk * 8;
    unsigned char* ws = A.ws;
    const bf16_t* YBT = (const bf16_t*)((unsigned char*)A.out + OUT_YBT);
    bf16_t* Y = (bf16_t*)(ws + WS_HY);
    LAS bf16_t* scr = (LAS bf16_t*)(lds + wave * 16384);
    const int ntok = (l < DEPTH - 1) ? MTOT : MLAT;
    const int nitems = (ntok / 64) * 4;
#pragma unroll 1
    for (int it = gw; it < nitems; it += NGW) {
        const int tb = (it >> 2) * 64, cb = (it & 3) * 64;
        u32x4 ld[8];
#pragma unroll
        for (int j = 0; j < 8; ++j) { const int idx = lane + 64 * j; ld[j] = *(const u32x4*)(YBT + (size_t)(cb + (idx >> 3)) * MTOT + tb + 8 * (idx & 7)); }
#pragma unroll
        for (int j = 0; j < 8; ++j) { const int idx = lane + 64 * j, ch = idx >> 3, t8 = 8 * (idx & 7);
#pragma unroll
            for (int e = 0; e < 8; ++e) { const unsigned w = e < 2 ? ld[j].x : (e < 4 ? ld[j].y : (e < 6 ? ld[j].z : ld[j].w));
                scr[(t8 + e) * 68 + ch] = (bf16_t)((e & 1) ? (w >> 16) : (w & 0xffffu)); } }
        asm volatile("s_waitcnt lgkmcnt(0)" ::: "memory");
#pragma unroll
        for (int k = 0; k < 8; ++k) {
            const int tq = (lane >> 3) + 8 * k, cc = (lane & 7) * 8;
            const u32x2 a = *(LAS const u32x2*)(scr + tq * 68 + cc), b2 = *(LAS const u32x2*)(scr + tq * 68 + cc + 4);
            u32x4 o; o.x = a.x; o.y = a.y; o.z = b2.x; o.w = b2.y;
            *(u32x4*)(Y + (size_t)(tb + tq) * DM + 384 + cb + cc) = o;
        }
        asm volatile("s_waitcnt lgkmcnt(0)" ::: "memory");
    }
}

__device__ __forceinline__ void phase_final(CKArgs& A, int bid, int nblk, int tid) {
    const int wave = __builtin_amdgcn_readfirstlane(tid >> 6), lane = tid & 63;
    const int gw = bid * 8 + wave, NGW = nblk * 8;
    const bf16_t* xb = (const bf16_t*)(A.ws + WS_XB);
    for (int m = gw; m < MLAT; m += NGW) {
        float* row = A.out + (size_t)m * DM;
        f32x4 xv[4]; float ss = 0.f;
#pragma unroll
        for (int j = 0; j < 4; ++j) { const u32x2 w = *(const u32x2*)(xb + (size_t)m * DM + 4 * lane + 256 * j); xv[j] = (f32x4){bflo(w.x), bfhi(w.x), bflo(w.y), bfhi(w.y)};
            ss += (xv[j].x * xv[j].x + xv[j].y * xv[j].y) + (xv[j].z * xv[j].z + xv[j].w * xv[j].w); }
        const float rinv = rsqrtf(wave_sum(ss, lane) * (1.0f / DM) + 1e-6f);
#pragma unroll
        for (int j = 0; j < 4; ++j) { const int col = 4 * lane + 256 * j; const f32x4 gv = *(const f32x4*)(A.final_g + col); *(f32x4*)(row + col) = xv[j] * rinv * gv; }
    }
}

#define XB_TMO      128
#define XB_XCNT(j)  (256  + 64 * (j))
#define XB_XSUB(j)  (1280 + 64 * (j))
#define XB_XGEN(j)  (2304 + 64 * (j))
#define XB_TOP      3328
#define XB_TOPGEN   3392
#define XCD_BAR_WORDS 3456
#define XB_SPIN_CAP (1u << 18)

__device__ __forceinline__ unsigned xb_ld(unsigned* p)              { return __hip_atomic_load(p, __ATOMIC_RELAXED, __HIP_MEMORY_SCOPE_AGENT); }
__device__ __forceinline__ unsigned xb_add(unsigned* p, unsigned v) { return __hip_atomic_fetch_add(p, v, __ATOMIC_RELAXED, __HIP_MEMORY_SCOPE_AGENT); }
__device__ __forceinline__ unsigned xb_xcc_id() { return (unsigned)__builtin_amdgcn_s_getreg((3 << 11) | 20) & 0xFu; }
#define XB_SPIN(cond, bar) do { unsigned _sp = 0; while (cond) { __builtin_amdgcn_s_sleep(1); \
    if ((++_sp & 255u) == 0u) { if (xb_ld(&(bar)[XB_TMO])) break; if (_sp > XB_SPIN_CAP) { atomicAdd(&(bar)[XB_TMO], 1u); break; } } } } while (0)

struct XcdBarrier {
    unsigned* bar; unsigned x;
    volatile LAS unsigned* st;
};

__device__ __forceinline__ XcdBarrier xcd_barrier_post(unsigned* bar, volatile LAS unsigned* st) {
    XcdBarrier b; b.bar = bar; b.x = xb_xcc_id(); b.st = st;
    if (threadIdx.x == 0) (void)xb_add(&bar[XB_XCNT(b.x)], 1u);
    return b;
}
__device__ __forceinline__ void xcd_barrier_complete(unsigned* bar, unsigned x, unsigned& nloc, unsigned& nx) {
    const unsigned G = gridDim.x * gridDim.y * gridDim.z;
    unsigned sum, cnt, mine, sp = 0u;
    for (;;) {
        sum = 0u; cnt = 0u; mine = 0u;
#pragma unroll
        for (unsigned j = 0; j < 16; ++j) { const unsigned c = xb_ld(&bar[XB_XCNT(j)]); sum += c; cnt += (c > 0u) ? 1u : 0u; mine = (j == x) ? c : mine; }
        if (sum == G) break;
        __builtin_amdgcn_s_sleep(1);
        if ((++sp & 255u) == 0u) { if (xb_ld(&bar[XB_TMO])) break; if (sp > XB_SPIN_CAP) { atomicAdd(&bar[XB_TMO], 1u); break; } }
    }
    nloc = mine > 0u ? mine : 1u; nx = cnt > 0u ? cnt : 1u;
}

__device__ __forceinline__ void xcd_barrier(const XcdBarrier& b) {
    asm volatile("s_waitcnt vmcnt(0)" ::: "memory");
    __syncthreads();
    if (threadIdx.x == 0) {
        unsigned* bar = b.bar;
        __builtin_amdgcn_s_waitcnt(0);
        unsigned nloc = b.st[0], nx = b.st[1];
        if (nloc == 0u) { xcd_barrier_complete(bar, b.x, nloc, nx); b.st[0] = nloc; b.st[1] = nx; }
        const unsigned old = xb_add(&bar[XB_XSUB(b.x)], 1u);
        const unsigned gen = old / nloc;
        if (old + 1u == (gen + 1u) * nloc) {
            __builtin_amdgcn_fence(__ATOMIC_RELEASE, "agent");
            asm volatile("s_waitcnt vmcnt(0)" ::: "memory");
            const unsigned og = xb_add(&bar[XB_TOP], 1u);
            const unsigned tg = og / nx;
            if (og + 1u == (tg + 1u) * nx) xb_add(&bar[XB_TOPGEN], 1u);
            else XB_SPIN(xb_ld(&bar[XB_TOPGEN]) == tg, bar);
            __builtin_amdgcn_fence(__ATOMIC_ACQUIRE, "agent");
            xb_add(&bar[XB_XGEN(b.x)], 1u);
            asm volatile("s_waitcnt vmcnt(0)" ::: "memory");
        } else {
            XB_SPIN(xb_ld(&bar[XB_XGEN(b.x)]) == gen, bar);
            __builtin_amdgcn_fence(__ATOMIC_ACQUIRE, "agent");
            asm volatile("s_waitcnt vmcnt(0)" ::: "memory");
        }
    }
    __syncthreads();
}


constexpr int NPHASE = 2 + 5 * DEPTH;
__global__ void __launch_bounds__(NTHREADS, 2) hybrid_fwd(KArgs Aval) {
    extern __shared__ __attribute__((aligned(16))) unsigned char lds_raw[];
    LAS unsigned char* lds = (LAS unsigned char*)lds_raw;
    const int tid0 = threadIdx.x, bid = blockIdx.x, nblk = gridDim.x;
    const int wave0 = __builtin_amdgcn_readfirstlane(tid0 >> 6);
#if !MK_MULTI
    volatile LAS unsigned* bst = (volatile LAS unsigned*)(lds + AUX_OFF + 8192);
    if (tid0 < 2) bst[tid0] = 0u;
    __syncthreads();
    const XcdBarrier bar = xcd_barrier_post((unsigned*)Aval.ws, bst);
#endif
#ifndef REP_PH
#define REP_PH 1000
#endif
#pragma unroll 1
    for (int pi = Aval.ph_lo; pi < Aval.ph_hi + (REP_PH < 1000 ? 1 : 0); ++pi) {
        const int ph = pi <= REP_PH ? pi : pi - 1;
#if !MK_MULTI
        if (pi > Aval.ph_lo) { if (Aval.ph_hi > 100000) cg::this_grid().sync(); else xcd_barrier(bar); }
#endif
#ifndef ONLY
#define ONLY -1
#endif
#define EN(k) (ONLY < 0 || ((ONLY >> (k)) & 1))
        int tid; asm volatile("v_mbcnt_lo_u32_b32 %0, -1, 0\n\tv_mbcnt_hi_u32_b32 %0, -1, %0" : "=v"(tid)); tid += wave0 * 64;
        CKArgs* Ap = (CKArgs*)__builtin_amdgcn_kernarg_segment_ptr(); asm volatile("" : "+s"(Ap));
        CKArgs& A = *Ap;
        unsigned char* ws = A.ws;
        if (ph == 0) { if (EN(0)) phase_prologue(A, lds, bid, nblk, tid); }
        else if (ph == NPHASE - 1) { if (EN(6)) phase_final(A, bid, nblk, tid); }
        else {
            const int l = (ph - 1) / 5, k = (ph - 1) % 5;
            if (k == 0) { if (EN(1)) phase_norm(A, l, bid, nblk, tid); }
            else if (k == 2) { if (EN(3)) phase_mix(A, l, lds, bid, nblk, tid); }
            else if (k == 3) { if (EN(4)) phase_tr(A, l, lds, bid, nblk, tid); }
            if (k == 1 || k == 4) {
                pg8::Gemm g; EpiAll E; E.l = l; E.Ap = Ap; g.A = (const bf16_t*)(ws + WS_HY); g.K = DM;
                if (k == 1) { g.Bt = (const bf16_t*)(ws + WS_WIN) + (size_t)l * NIN * DM; g.M = MTOT; g.N = NIN; E.mode = 0; }
                else { g.Bt = (const bf16_t*)(ws + WS_WOUT) + (size_t)l * DM * DM; g.M = MLAT; g.N = DM; E.mode = 1; }
                pg8::StaticOrder S; S.init(g.M, g.N, nblk, bid);
                if (EN(2)) pg8::gemm_phase<EpiAll, pg8::StaticOrder, true, true>(lds, g, S, E, tid);
                if (k == 4 && l < DEPTH - 1) { ctx_outproj_items(A, l, tid, bid, nblk); filt_items(A, l + 1, tid, bid, nblk, nullptr); }
            }
        }
    }
}

extern "C" void kernel_launch(void* const* d_in, const int* in_sizes, int n_in, void* d_out, int out_size, void* d_ws, size_t ws_size, hipStream_t stream) {
    static int grid = 0;
    if (grid == 0) {
        if (n_in != 22 || ws_size < WS_END) { fprintf(stderr, "kernel_launch: unexpected inputs (n_in %d, ws %zu)\n", n_in, ws_size); grid = -1; return; }
        int dev = 0, cus = 0, per_cu = 0;
        if (hipGetDevice(&dev) != hipSuccess || hipDeviceGetAttribute(&cus, hipDeviceAttributeMultiprocessorCount, dev) != hipSuccess) { grid = -1; return; }
        if (hipFuncSetAttribute((const void*)hybrid_fwd, hipFuncAttributeMaxDynamicSharedMemorySize, LDS_BYTES) != hipSuccess) { fprintf(stderr, "kernel_launch: hipFuncSetAttribute failed\n"); grid = -1; return; }
        if (hipOccupancyMaxActiveBlocksPerMultiprocessor(&per_cu, (const void*)hybrid_fwd, NTHREADS, LDS_BYTES) != hipSuccess || per_cu < 1) { fprintf(stderr, "kernel_launch: occupancy query says %d\n", per_cu); per_cu = 1; }
        (void)hipGetLastError();
        grid = cus;
    }
    if (grid < 0) return;
    KArgs a{};
    a.x = (const float*)d_in[0]; a.c = (const float*)d_in[1]; a.ctx = (const float*)d_in[2]; a.c_ctx = (const float*)d_in[3]; a.norm_g = (const float*)d_in[4];
    a.w_ada = (const float*)d_in[5]; a.b_ada = (const float*)d_in[6]; a.w_in = (const float*)d_in[7]; a.w_out = (const float*)d_in[8]; a.na_rpb = (const float*)d_in[9];
    a.hy_conv_w = (const float*)d_in[10]; a.hy_conv_b = (const float*)d_in[11]; a.hy_w1 = (const float*)d_in[12]; a.hy_b1 = (const float*)d_in[13]; a.hy_freq1 = (const float*)d_in[14];
    a.hy_w2 = (const float*)d_in[15]; a.hy_b2 = (const float*)d_in[16]; a.hy_freq2 = (const float*)d_in[17]; a.hy_w3 = (const float*)d_in[18]; a.hy_d = (const float*)d_in[19];
    a.sink = (const float*)d_in[20]; a.final_g = (const float*)d_in[21];
    a.out = (float*)d_out; a.ws = (unsigned char*)d_ws;
#if MK_MULTI
    for (int ph = 0; ph < NPHASE; ++ph) {
        a.ph_lo = ph; a.ph_hi = ph + 1;
        hipLaunchKernelGGL(hybrid_fwd, dim3(grid), dim3(NTHREADS), LDS_BYTES, stream, a);
    }
#else
    if (hipMemsetAsync(d_ws, 0, 16384, stream) != hipSuccess) { fprintf(stderr, "kernel_launch: memset of the barrier words failed\n"); return; }
    a.ph_lo = 0; a.ph_hi = NPHASE;
    void* args[] = {&a};
    hipError_t e = hipLaunchCooperativeKernel((const void*)hybrid_fwd, dim3(grid), dim3(NTHREADS), args, LDS_BYTES, stream);
    if (e != hipSuccess) fprintf(stderr, "cooperative launch failed: %s (grid %d)\n", hipGetErrorString(e), grid);
#endif
}
```

```cpp
#include <hip/hip_runtime.h>
#include <hip/hip_cooperative_groups.h>
#include <cstdio>
#include <cstdint>
namespace cg = cooperative_groups;

#ifndef MK_MULTI
#define MK_MULTI 0
#endif

namespace pg8 {
#define PG8_LAS __attribute__((address_space(3)))
typedef unsigned short bf16_t;
typedef short bf16x8 __attribute__((ext_vector_type(8)));
typedef float f32x4 __attribute__((ext_vector_type(4)));
typedef unsigned u32x4 __attribute__((ext_vector_type(4)));
constexpr int BM = 256, BK = 64, HALF = 128, HTB = HALF * BK * 2  , STAGE_BYTES = 8 * HTB, NXCD = 8, WGM = 8;

__host__ __device__ __forceinline__ int lds_byte(int r, int c) { const int st = (r >> 4) * 2 + (c >> 5), rr = r & 15, cc = c & 31, ob = rr * 64 + cc * 2; return st * 1024 + (ob ^ (((ob >> 9) & 1) << 5)); }
__host__ __device__ __forceinline__ void stage_rc(int b, int& R, int& C) { const int st = b / 1024, sb = b % 1024, swz = sb ^ (((sb >> 9) & 1) << 5); R = (st >> 1) * 16 + swz / 64; C = (st & 1) * 32 + (swz % 64) / 2; }
__host__ __device__ __forceinline__ int perm32(int rho) { const int n = rho >> 4, i = rho & 15; return 8 * (i >> 2) + 4 * n + (i & 3); }

struct Unit { int pm, pn; };
struct Gemm { const bf16_t* A; const bf16_t* Bt; int M, N, K; };

struct StaticOrder {
    int nM, nN, nwg, G, c;
    __host__ __device__ void init(int M, int N, int G_, int c_) { nM = M / BM; nN = N / BM; nwg = nM * nN; G = G_; c = c_; }
    __host__ __device__ bool next(int i, Unit& u) const {
        const long L = (long)i * G + c; if (L >= nwg) return false;
        int wgid = (int)L; { const int q = nwg / NXCD, r = nwg % NXCD, xcd = wgid % NXCD, off = wgid / NXCD; wgid = (xcd < r ? xcd * (q + 1) : r * (q + 1) + (xcd - r) * q) + off; }
        const int nig = WGM * nN, gid = wgid / nig, fm = gid * WGM, gsz = (nM - fm) < WGM ? (nM - fm) : WGM;
        u.pm = fm + ((wgid % nig) % gsz); u.pn = (wgid % nig) / gsz; return true;
    }
    __device__ __forceinline__ void a_ready(const Unit&) const {}
    __device__ __forceinline__ void done(const Unit&) const {}
};

template <class Epi, class Sched, bool ALIGN_EPI = false, bool SP2 = false>
__device__ __forceinline__ void gemm_phase(PG8_LAS unsigned char* lds, const Gemm g, const Sched& S, const Epi& E, const int tid) {
    const int wid = __builtin_amdgcn_readfirstlane(tid >> 6), lane = tid & 63, wr = wid >> 2, wc = wid & 3, fr = lane & 15, fq = lane >> 4;
    const int K = g.K, nt = K / BK;
    unsigned voffA[2], voffB[2];
#pragma unroll
    for (int i = 0; i < 2; ++i) { int R, C; stage_rc(tid * 16 + i * 8192, R, C); const int Rb = Epi::PERM ? ((R & ~31) + perm32(R & 31)) : R;
        voffA[i] = (unsigned)(R * K + C) * 2u; voffB[i] = (unsigned)(Rb * K + C) * 2u; }
    const size_t kstep = (size_t)(BK * 2);
    const size_t hstep = (size_t)HALF * K * 2;
    const size_t tstep = 2 * hstep;
    const unsigned ldsw = (unsigned)wid * 1024u;
    const int aoff = lds_byte(wr * 64 + fr, fq * 8), boff = lds_byte(wc * 32 + fr, fq * 8);
#define PG8_SA(b, h) (((b) * 2 + (h)) * HTB)
#define PG8_SB(b, h) ((4 + (b) * 2 + (h)) * HTB)
#define PG8_STAGE(bufoff, gbase, voff) do { _Pragma("unroll") for (int _i = 0; _i < 2; ++_i) \
        __builtin_amdgcn_global_load_lds((const unsigned*)((const char*)(gbase) + (voff)[_i]), (PG8_LAS unsigned*)(lds + (bufoff) + ldsw + _i * 8192), 16, 0, 0); } while (0)
#define PG8_LDA(dst, b, h) do { _Pragma("unroll") for (int m = 0; m < 4; ++m) _Pragma("unroll") for (int k = 0; k < 2; ++k) dst[m][k] = *(const PG8_LAS bf16x8*)(lds + PG8_SA(b, h) + aoff + m * 2048 + k * 1024); } while (0)
#define PG8_LDB(dst, b, h) do { _Pragma("unroll") for (int n = 0; n < 2; ++n) _Pragma("unroll") for (int k = 0; k < 2; ++k) dst[n][k] = *(const PG8_LAS bf16x8*)(lds + PG8_SB(b, h) + boff + n * 2048 + k * 1024); } while (0)
#define PG8_MMA(ai, bj, At, Bt) do { __builtin_amdgcn_s_setprio(1); _Pragma("unroll") for (int m = 0; m < 4; ++m) _Pragma("unroll") for (int n = 0; n < 2; ++n) _Pragma("unroll") for (int k = 0; k < 2; ++k) \
        acc[ai][bj][m][n] = __builtin_amdgcn_mfma_f32_16x16x32_bf16(Bt[n][k], At[m][k], acc[ai][bj][m][n], 0, 0, 0); __builtin_amdgcn_s_setprio(0); } while (0)
#define PG8_WAIT_V(n) asm volatile("s_waitcnt vmcnt(" #n ")" ::: "memory")
#define PG8_WAIT_L(n) asm volatile("s_waitcnt lgkmcnt(" #n ")" ::: "memory")
#define PG8_BAR __builtin_amdgcn_s_barrier()
#define PG8_SCHED __builtin_amdgcn_sched_barrier(0)
    Unit cur, nxt; int ui = 0;
    if (!S.next(0, cur)) return;
    f32x4 acc[2][2][4][2];
#pragma unroll
    for (int a = 0; a < 2; ++a)
#pragma unroll
        for (int b = 0; b < 2; ++b)
#pragma unroll
            for (int m = 0; m < 4; ++m)
#pragma unroll
                for (int n = 0; n < 2; ++n) acc[a][b][m][n] = (f32x4){0.f, 0.f, 0.f, 0.f};
    bf16x8 At[4][2], B0[2][2], B1[2][2];
    const char* cA = (const char*)g.A + (size_t)cur.pm * tstep; const char* cB = (const char*)g.Bt + (size_t)cur.pn * tstep;
    S.a_ready(cur);
    if constexpr (SP2) {
        PG8_STAGE(PG8_SB(0, 0), cB, voffB); PG8_STAGE(PG8_SB(0, 1), cB + hstep, voffB); PG8_STAGE(PG8_SA(0, 0), cA, voffA); PG8_STAGE(PG8_SA(0, 1), cA + hstep, voffA);
        if (wr == 1) PG8_BAR;
        PG8_WAIT_V(2); PG8_BAR;
        PG8_STAGE(PG8_SB(1, 0), cB + kstep, voffB); PG8_STAGE(PG8_SA(1, 0), cA + kstep, voffA); PG8_STAGE(PG8_SB(1, 1), cB + hstep + kstep, voffB);
        PG8_WAIT_V(6); PG8_BAR;
    } else {
        PG8_STAGE(PG8_SB(0, 0), cB, voffB); PG8_STAGE(PG8_SA(0, 0), cA, voffA); PG8_STAGE(PG8_SB(0, 1), cB + hstep, voffB); PG8_STAGE(PG8_SA(0, 1), cA + hstep, voffA);
        if (wr == 1) PG8_BAR;
        PG8_WAIT_V(4); PG8_BAR;
        PG8_STAGE(PG8_SB(1, 0), cB + kstep, voffB); PG8_STAGE(PG8_SA(1, 0), cA + kstep, voffA); PG8_STAGE(PG8_SB(1, 1), cB + hstep + kstep, voffB);
        PG8_WAIT_V(6); PG8_BAR;
    }
    for (;;) {
        const bool has_next = S.next(ui + 1, nxt);
        const char* nA = has_next ? (const char*)g.A + (size_t)nxt.pm * tstep : cA; const char* nB = has_next ? (const char*)g.Bt + (size_t)nxt.pn * tstep : cB;
        for (int t = 0; t < nt; t += 2) {
            const bool last = (t == nt - 2);
            const char* a1 = cA + (size_t)(t + 1) * kstep;
            const char* a2 = last ? nA : cA + (size_t)(t + 2) * kstep; const char* b2 = last ? nB : cB + (size_t)(t + 2) * kstep;
            const char* a3 = a2 + kstep; const char* b3 = b2 + kstep;
            if (last && has_next) S.a_ready(nxt);
            if constexpr (SP2) {
            PG8_LDB(B0, 0, 0); PG8_LDB(B1, 0, 1); PG8_SCHED; PG8_LDA(At, 0, 0); PG8_STAGE(PG8_SA(1, 1), a1 + hstep, voffA);
            PG8_WAIT_V(8); PG8_WAIT_L(0); PG8_BAR; PG8_MMA(0, 0, At, B0); PG8_MMA(0, 1, At, B1); PG8_BAR; PG8_SCHED;
            PG8_LDA(At, 0, 1); PG8_STAGE(PG8_SB(0, 0), b2, voffB); PG8_STAGE(PG8_SB(0, 1), b2 + hstep, voffB); PG8_STAGE(PG8_SA(0, 0), a2, voffA);
            PG8_WAIT_V(8); PG8_WAIT_L(0); PG8_BAR; PG8_MMA(1, 0, At, B0); PG8_MMA(1, 1, At, B1); PG8_BAR; PG8_SCHED;
            PG8_LDB(B0, 1, 0); PG8_LDB(B1, 1, 1); PG8_SCHED; PG8_LDA(At, 1, 0); PG8_STAGE(PG8_SA(0, 1), a2 + hstep, voffA);
            PG8_WAIT_V(8); PG8_WAIT_L(0); PG8_BAR; PG8_MMA(0, 0, At, B0); PG8_MMA(0, 1, At, B1); PG8_BAR; PG8_SCHED;
            PG8_LDA(At, 1, 1); PG8_STAGE(PG8_SB(1, 0), b3, voffB); PG8_STAGE(PG8_SB(1, 1), b3 + hstep, voffB); PG8_STAGE(PG8_SA(1, 0), a3, voffA);
            PG8_WAIT_V(8); PG8_WAIT_L(0); PG8_BAR; PG8_MMA(1, 0, At, B0); PG8_MMA(1, 1, At, B1); PG8_BAR; PG8_SCHED;
            } else {
            PG8_LDB(B0, 0, 0); PG8_SCHED; PG8_LDA(At, 0, 0); PG8_STAGE(PG8_SA(1, 1), a1 + hstep, voffA);
            PG8_WAIT_L(8); PG8_BAR; PG8_WAIT_L(0); PG8_MMA(0, 0, At, B0); PG8_BAR; PG8_SCHED;
            PG8_LDB(B1, 0, 1); PG8_STAGE(PG8_SB(0, 0), b2, voffB);
            PG8_BAR; PG8_WAIT_L(0); PG8_MMA(0, 1, At, B1); PG8_BAR;
            PG8_LDA(At, 0, 1); PG8_STAGE(PG8_SA(0, 0), a2, voffA);
            PG8_BAR; PG8_WAIT_L(0); PG8_MMA(1, 0, At, B0); PG8_BAR; PG8_SCHED;
            PG8_STAGE(PG8_SB(0, 1), b2 + hstep, voffB);
            PG8_WAIT_V(6); PG8_BAR; PG8_MMA(1, 1, At, B1); PG8_BAR;
            PG8_LDB(B0, 1, 0); PG8_SCHED; PG8_LDA(At, 1, 0); PG8_STAGE(PG8_SA(0, 1), a2 + hstep, voffA);
            PG8_WAIT_L(8); PG8_BAR; PG8_WAIT_L(0); PG8_MMA(0, 0, At, B0); PG8_BAR; PG8_SCHED;
            PG8_LDB(B1, 1, 1); PG8_STAGE(PG8_SB(1, 0), b3, voffB);
            PG8_BAR; PG8_WAIT_L(0); PG8_MMA(0, 1, At, B1); PG8_BAR;
            PG8_LDA(At, 1, 1); PG8_STAGE(PG8_SA(1, 0), a3, voffA);
            PG8_BAR; PG8_WAIT_L(0); PG8_MMA(1, 0, At, B0); PG8_BAR; PG8_SCHED;
            PG8_STAGE(PG8_SB(1, 1), b3 + hstep, voffB);
            PG8_WAIT_V(6); PG8_BAR; PG8_MMA(1, 1, At, B1); PG8_BAR;
            }
        }
        if constexpr (ALIGN_EPI) { if (wr == 0) PG8_BAR; }
        if constexpr (!Epi::AFTER_DRAIN) { E(acc, cur, wr, wc, fr, fq); S.done(cur); }
        if (!has_next) break;
#pragma unroll
        for (int a = 0; a < 2; ++a)
#pragma unroll
            for (int b = 0; b < 2; ++b)
#pragma unroll
                for (int m = 0; m < 4; ++m)
#pragma unroll
                    for (int n = 0; n < 2; ++n) acc[a][b][m][n] = (f32x4){0.f, 0.f, 0.f, 0.f};
        cur = nxt; cA = nA; cB = nB; ++ui;
        if constexpr (ALIGN_EPI) { if (wr == 1) PG8_BAR; }
    }
    PG8_WAIT_V(0);
    if constexpr (!ALIGN_EPI) { if (wr == 0) PG8_BAR; }
    PG8_BAR;
    if constexpr (Epi::AFTER_DRAIN) { E.fused(acc, cur, wr, wc, fr, fq, lds, wid, lane); S.done(cur); }
#undef PG8_SA
#undef PG8_SB
#undef PG8_STAGE
#undef PG8_LDA
#undef PG8_LDB
#undef PG8_MMA
#undef PG8_WAIT_V
#undef PG8_WAIT_L
#undef PG8_BAR
#undef PG8_SCHED
}
}

#define LAS __attribute__((address_space(3)))
typedef unsigned short bf16_t;
typedef short bf16x8 __attribute__((ext_vector_type(8)));
typedef float f32x4 __attribute__((ext_vector_type(4)));
typedef float f32x16 __attribute__((ext_vector_type(16)));
typedef unsigned u32x2 __attribute__((ext_vector_type(2)));
typedef unsigned u32x4 __attribute__((ext_vector_type(4)));
typedef float f32x2_t __attribute__((ext_vector_type(2)));
typedef __bf16 bf16x2_t __attribute__((ext_vector_type(2)));

constexpr int DM = 1024, NBATCH = 2, SEQ = 8192, DEPTH = 4, CTXL = 256;
constexpr int MLAT = NBATCH * SEQ, MCTX = NBATCH * CTXL, MTOT = MLAT + MCTX;
constexpr int NIN = 3584, NTM = 1536, NCM = 1024, NTB = MTOT / 64;
constexpr int C_QA = 0, C_GA = 384, C_QC = 768, C_GC = 1152;
constexpr int R_HZ = 0, R_GB = 768;
constexpr int NFFT = 16384;
constexpr float LOG2E = 1.4426950408889634f;
constexpr float QK_SCALE = 0.125f * LOG2E;

constexpr size_t MiB = 1u << 20;
constexpr size_t WS_ADA = 1 * MiB;
constexpr size_t WS_ROPE = 1 * MiB + 256 * 1024;
constexpr size_t WS_H2C = 1 * MiB + 512 * 1024;
constexpr size_t WS_CX = 2 * MiB;
constexpr size_t WS_H2 = 4 * MiB;
constexpr size_t WS_WIN = 12 * MiB;
constexpr size_t WS_WOUT = 40 * MiB;
constexpr size_t WS_HY = 48 * MiB;
constexpr size_t WS_PT = 81 * MiB;
constexpr size_t WS_KH = 130 * MiB + 512 * 1024;
constexpr size_t WS_VT = 147 * MiB;
constexpr size_t WS_PCT = 163 * MiB + 512 * 1024;
constexpr size_t WS_YBT = 197 * MiB;
constexpr size_t WS_XB = 206 * MiB;
constexpr size_t OUT_ZS = 0;
constexpr size_t OUT_FILT = 32 * MiB;
constexpr size_t OUT_YBT = 48 * MiB;
constexpr size_t WS_W3T = 238 * MiB;
constexpr size_t WS_FILT = 239 * MiB;
constexpr size_t WS_END = 255 * MiB;
static_assert(WS_PT + (size_t)MTOT * NTM * 2 <= WS_KH && WS_KH + (size_t)8 * MTOT * 128 <= WS_VT && WS_VT + (size_t)8 * MTOT * 128 <= WS_PCT && WS_PCT + (size_t)NCM * MTOT * 2 <= WS_YBT, "d_ws map");

constexpr int AUX_OFF = 147456;
constexpr int LDS_BYTES = 163840;
constexpr int NTHREADS = 512;

struct KArgs {
    const float* x; const float* c; const float* ctx; const float* c_ctx; const float* norm_g; const float* w_ada; const float* b_ada;
    const float* w_in; const float* w_out; const float* na_rpb; const float* hy_conv_w; const float* hy_conv_b;
    const float* hy_w1; const float* hy_b1; const float* hy_freq1; const float* hy_w2; const float* hy_b2; const float* hy_freq2; const float* hy_w3;
    const float* hy_d; const float* sink; const float* final_g;
    float* out; unsigned char* ws;
    int ph_lo, ph_hi;
};

typedef const __attribute__((address_space(4))) KArgs CKArgs;
__device__ __forceinline__ unsigned pk2(float lo, float hi) { f32x2_t v = {lo, hi}; bf16x2_t b = __builtin_convertvector(v, bf16x2_t); return __builtin_bit_cast(unsigned, b); }
__device__ __forceinline__ float bf2f(unsigned short u) { return __uint_as_float(((unsigned)u) << 16); }
__device__ __forceinline__ float bflo(unsigned w) { return __uint_as_float(w << 16); }
__device__ __forceinline__ float bfhi(unsigned w) { return __uint_as_float(w & 0xffff0000u); }
__device__ __forceinline__ float silu_f(float x) { return x / (1.0f + __expf(-x)); }
__device__ __forceinline__ float lane_xor(float v, int lane, int m) { return __int_as_float(__builtin_amdgcn_ds_bpermute((lane ^ m) << 2, __float_as_int(v))); }
__device__ __forceinline__ float lane_prev(float v, int lane) { return __int_as_float(__builtin_amdgcn_ds_bpermute(((lane - 1) & 63) << 2, __float_as_int(v))); }
__device__ __forceinline__ float lane_next(float v, int lane) { return __int_as_float(__builtin_amdgcn_ds_bpermute(((lane + 1) & 63) << 2, __float_as_int(v))); }
__device__ __forceinline__ float wave_sum(float v, int lane) {
#pragma unroll
    for (int o = 1; o < 64; o <<= 1) v += lane_xor(v, lane, o);
    return v;
}
__device__ __forceinline__ float rdlane(float v, int l) { return __uint_as_float(__builtin_amdgcn_readlane(__float_as_uint(v), l)); }

__device__ __forceinline__ void transpose_item(const float* W, int K, int N, bf16_t* WT, int k0, int n0, int drow0, LAS float* scr, int lane, int ldk = 0) {
    if (ldk == 0) ldk = K;
#pragma unroll 8
    for (int i = 0; i < 32; ++i) { const int kk = 2 * i + (lane >> 5); scr[kk * 33 + (lane & 31)] = W[(size_t)(k0 + kk) * N + n0 + (lane & 31)]; }
    asm volatile("s_waitcnt lgkmcnt(0)" ::: "memory");
    const int c = lane & 7;
#pragma unroll
    for (int j = 0; j < 4; ++j) { const int n = (lane >> 3) + 8 * j; const LAS float* s = scr + (8 * c) * 33 + n;
        u32x4 o; o.x = pk2(s[0 * 33], s[1 * 33]); o.y = pk2(s[2 * 33], s[3 * 33]); o.z = pk2(s[4 * 33], s[5 * 33]); o.w = pk2(s[6 * 33], s[7 * 33]);
        *(u32x4*)(WT + (size_t)(drow0 + n) * ldk + k0 + 8 * c) = o; }
    asm volatile("s_waitcnt lgkmcnt(0)" ::: "memory");
}
__device__ __forceinline__ int win_row(int n0) {
    if (n0 < 384) return n0;
    if (n0 < 768) return n0 - 384 + 1536;
    if (n0 < 1152) return n0 - 768 + 2048;
    if (n0 < 1536) return n0 - 1152 + 384;
    if (n0 < 2304) return n0 - 1536 + 2560;
    if (n0 < 2560) return n0 - 2304 + 3328;
    if (n0 < 2944) return n0 - 2560 + 768;
    if (n0 < 3072) return n0 - 2944 + 1920;
    if (n0 < 3200) return n0 - 3072 + 2432;
    return n0 - 3200 + 1152;
}

__device__ __forceinline__ void phase_prologue(CKArgs& A, LAS unsigned char* lds, int bid, int nblk, int tid) {
    const int wave = __builtin_amdgcn_readfirstlane(tid >> 6), lane = tid & 63;
    const int gw = bid * 8 + wave, NGW = nblk * 8;
    unsigned char* ws = A.ws;
    {
        LAS float* scr = (LAS float*)(lds + wave * 16384);
        constexpr int I_IN = 16 * 112, I_OUT = 16 * 32, I_L = I_IN + I_OUT;
        for (int it = gw; it < DEPTH * I_L; it += NGW) {
            const int l = it / I_L; int r = it % I_L;
            if (r < I_IN) { const int kb = r / 112, nb = r % 112, n0 = nb * 32;
                transpose_item(A.w_in + (size_t)l * DM * NIN, DM, NIN, (bf16_t*)(ws + WS_WIN) + (size_t)l * NIN * DM, kb * 64, n0, win_row(n0), scr, lane); }
            else { r -= I_IN; const int kb = r / 32, nb = r % 32, n0 = nb * 32;
                transpose_item(A.w_out + (size_t)l * DM * DM, DM, DM, (bf16_t*)(ws + WS_WOUT) + (size_t)l * DM * DM, kb * 64, n0, n0, scr, lane); }
        }
    }
    {
        LAS float* scr = (LAS float*)(lds + wave * 16384);
        bf16_t* W3T = (bf16_t*)(ws + WS_W3T);
        for (int it = gw; it < DEPTH * 32; it += NGW) { const int l = it >> 5, nb = it & 31;
            transpose_item(A.hy_w3 + (size_t)l * 64 * 1024, 64, 1024, W3T + (size_t)l * 1024 * 64, 0, nb * 32, nb * 32, scr, lane); }
    }
    for (int idx = gw * 64 + lane; idx < 128 * 16; idx += NGW * 64) {
        const int p = idx >> 4, i = idx & 15;
        const float inv = powf(10000.0f, -(float)i / 16.0f);
        const float ang = (float)p * inv;
        ((float2*)(ws + WS_ROPE))[idx] = make_float2(cosf(ang), sinf(ang));
    }
    for (int it = gw; it < DEPTH * 528; it += NGW) {
        const int l = it / 528, g4 = it % 528, g = g4 >> 2, sub = g4 & 3;
        const int L = g < 128 ? SEQ : CTXL;
        const int n0 = (g < 128 ? g * 64 : (g - 128) * 64) + 16 * sub;
        float* outp = (float*)(ws + WS_H2C) + ((size_t)l * CTXL + n0) * 64;
        bf16_t* outb = (bf16_t*)(ws + WS_H2) + ((size_t)l * SEQ + n0) * 64;
        float w1c[33], w2c[64];
#pragma unroll
        for (int q = 0; q < 33; ++q) w1c[q] = A.hy_w1[((size_t)l * 33 + q) * 64 + lane];
#pragma unroll
        for (int j = 0; j < 64; ++j) w2c[j] = A.hy_w2[((size_t)l * 64 + j) * 64 + lane];
        const float b1 = A.hy_b1[l * 64 + lane], fr1 = A.hy_freq1[l * 64 + lane], b2 = A.hy_b2[l * 64 + lane], fr2 = A.hy_freq2[l * 64 + lane];
        const float tstep = 1.0f / (float)(L - 1);
        const int fj = lane == 0 ? 0 : ((lane - 1) & 15);
        const float fq = 1e-4f + (float)fj * ((15.0f - 1e-4f) / 15.0f);
#pragma unroll 1
        for (int nn = 0; nn < 16; ++nn) {
            const int n = n0 + nn;
            const float t = (float)n * tstep;
            const float rev = fq * ((float)n * (1.0f / (float)L)) + (lane <= 16 ? 0.25f : 0.5f);
            float zq = __builtin_amdgcn_sinf(rev - floorf(rev));
            if (lane == 0) zq = t; if (lane > 32) zq = 0.f;
            float a1 = b1;
#pragma unroll
            for (int q = 0; q < 33; ++q) a1 += rdlane(zq, q) * w1c[q];
            const float x1 = fr1 * a1 * 0.15915494309189535f;
            const float h1 = __builtin_amdgcn_sinf(x1 - floorf(x1));
            float a2 = b2;
#pragma unroll
            for (int j = 0; j < 64; ++j) a2 += rdlane(h1, j) * w2c[j];
            const float x2 = fr2 * a2 * 0.15915494309189535f;
            const float h2 = __builtin_amdgcn_sinf(x2 - floorf(x2));
            if (g < 128) outb[nn * 64 + lane] = (bf16_t)(pk2(h2, 0.f) & 0xffffu);
            else outp[nn * 64 + lane] = h2;
        }
    }
    __syncthreads();
    {
        LAS float* red = (LAS float*)lds;
        LAS float* sv = (LAS float*)(lds + 8192);
        for (int i = tid; i < 3 * DM; i += NTHREADS) sv[i] = silu_f(i < 2 * DM ? A.c[i] : A.c_ctx[i - 2 * DM]);
        __syncthreads();
        for (int it = bid; it < DEPTH * 48; it += nblk) {
            const int l = it / 48, n = (it % 48) * 64 + lane;
            const float* W = A.w_ada + (size_t)l * DM * 3072 + n;
            float a0 = 0.f, a1 = 0.f, a2 = 0.f;
            const int kb = wave * 128;
#pragma unroll 1
            for (int k0 = 0; k0 < 128; k0 += 16) {
                float w[16];
#pragma unroll
                for (int k = 0; k < 16; ++k) w[k] = W[(size_t)(kb + k0 + k) * 3072];
#pragma unroll
                for (int k = 0; k < 16; ++k) { a0 += sv[kb + k0 + k] * w[k]; a1 += sv[DM + kb + k0 + k] * w[k]; a2 += sv[2 * DM + kb + k0 + k] * w[k]; }
            }
            red[(wave * 3 + 0) * 64 + lane] = a0; red[(wave * 3 + 1) * 64 + lane] = a1; red[(wave * 3 + 2) * 64 + lane] = a2;
            __syncthreads();
            if (tid < 192) { const int v = tid >> 6; float sacc = A.b_ada[l * 3072 + n];
#pragma unroll
                for (int w = 0; w < 8; ++w) sacc += red[(w * 3 + v) * 64 + lane];
                ((float*)(ws + WS_ADA))[((size_t)l * 3 + v) * 3072 + n] = sacc; }
            __syncthreads();
        }
    }
}

__device__ __forceinline__ void filt_items(CKArgs& A, int lf, int tid, int bid, int nblk, unsigned* ctr) {
    unsigned char* ws = A.ws;
    const int wave = __builtin_amdgcn_readfirstlane(tid >> 6), lane = tid & 63;
    const int gw = bid * 8 + wave, NGW = nblk * 8;
    const bf16_t* H2B = (const bf16_t*)(ws + WS_H2) + (size_t)lf * SEQ * 64;
    const bf16_t* W3T = (const bf16_t*)(ws + WS_W3T) + (size_t)lf * 1024 * 64;
    bf16_t* FILT = (bf16_t*)((unsigned char*)A.out + OUT_FILT);
    const int fr = lane & 15, fq = lane >> 4;
    int it = gw;
#pragma unroll 1
    for (;;) {
        if (ctr) { unsigned t = 0; if (lane == 0) t = __hip_atomic_fetch_add(ctr, 1u, __ATOMIC_RELAXED, __HIP_MEMORY_SCOPE_AGENT); it = (int)__builtin_amdgcn_readfirstlane(t); }
        if (it >= 2048) break;
        const int n0 = (it >> 4) * 64, c0 = (it & 15) * 64;
        bf16x8 af[4][2];
#pragma unroll
        for (int j = 0; j < 4; ++j) { const bf16_t* ap = H2B + (size_t)(n0 + 16 * (fr >> 2) + 4 * j + (fr & 3)) * 64 + 8 * fq; af[j][0] = *(const bf16x8*)ap; af[j][1] = *(const bf16x8*)(ap + 32); }
#pragma unroll 1
        for (int ct = 0; ct < 4; ++ct) {
            const bf16_t* bp = W3T + (size_t)(c0 + 16 * ct + fr) * 64 + 8 * fq;
            const bf16x8 b0 = *(const bf16x8*)bp, b1 = *(const bf16x8*)(bp + 32);
            u32x4 o0, o1;
#pragma unroll
            for (int j = 0; j < 4; ++j) {
                f32x4 acc = {0.f, 0.f, 0.f, 0.f};
                acc = __builtin_amdgcn_mfma_f32_16x16x32_bf16(af[j][0], b0, acc, 0, 0, 0);
                acc = __builtin_amdgcn_mfma_f32_16x16x32_bf16(af[j][1], b1, acc, 0, 0, 0);
                const unsigned w0 = pk2(acc.x, acc.y), w1 = pk2(acc.z, acc.w);
                if (j == 0) { o0.x = w0; o0.y = w1; } else if (j == 1) { o0.z = w0; o0.w = w1; } else if (j == 2) { o1.x = w0; o1.y = w1; } else { o1.z = w0; o1.w = w1; }
            }
            bf16_t* dp = FILT + (size_t)(c0 + 16 * ct + fr) * SEQ + n0 + 16 * fq;
            *(u32x4*)dp = o0; *(u32x4*)(dp + 8) = o1;
        }
        if (!ctr) it += NGW;
    }
}

__device__ __forceinline__ void ctx_outproj_items(CKArgs& A, int l, int tid, int bid, int nblk) {
    unsigned char* ws = A.ws;
    const int wave = __builtin_amdgcn_readfirstlane(tid >> 6), lane = tid & 63;
    const int gw = bid * 8 + wave, NGW = nblk * 8;
    const bf16_t* Y = (const bf16_t*)(ws + WS_HY) + (size_t)MLAT * DM;
    const bf16_t* WT = (const bf16_t*)(ws + WS_WOUT) + (size_t)l * DM * DM;
    const float* gate = (const float*)(ws + WS_ADA) + ((size_t)l * 3 + 2) * 3072 + 2048;
    const float* csrc = l == 0 ? A.ctx : (const float*)(ws + WS_CX);
    float* cdst = (float*)(ws + WS_CX);
    const int fr = lane & 15, fq = lane >> 4;
#pragma unroll 1
    for (int it = gw; it < 2048; it += NGW) {
        const int r0 = (it >> 6) * 16, c0 = (it & 63) * 16;
        const bf16_t* ap = Y + (size_t)(r0 + fr) * DM + 8 * fq;
        const bf16_t* bp = WT + (size_t)(c0 + fr) * DM + 8 * fq;
        f32x4 acc0 = {0.f, 0.f, 0.f, 0.f}, acc1 = {0.f, 0.f, 0.f, 0.f};
#pragma unroll 1
        for (int k0 = 0; k0 < 32; k0 += 8) {
            bf16x8 a[8], b[8];
#pragma unroll
            for (int k = 0; k < 8; ++k) { a[k] = *(const bf16x8*)(ap + 32 * (k0 + k)); b[k] = *(const bf16x8*)(bp + 32 * (k0 + k)); }
#pragma unroll
            for (int k = 0; k < 8; k += 2) { acc0 = __builtin_amdgcn_mfma_f32_16x16x32_bf16(a[k], b[k], acc0, 0, 0, 0); acc1 = __builtin_amdgcn_mfma_f32_16x16x32_bf16(a[k + 1], b[k + 1], acc1, 0, 0, 0); }
        }
        const float g = gate[c0 + fr];
#pragma unroll
        for (int i = 0; i < 4; ++i) { const size_t off = (size_t)(r0 + 4 * fq + i) * DM + c0 + fr; cdst[off] = csrc[off] + g * (acc0[i] + acc1[i]); }
    }
}

__device__ __forceinline__ void phase_norm(CKArgs& A, int l, int bid, int nblk, int tid) {
    const int wave = __builtin_amdgcn_readfirstlane(tid >> 6), lane = tid & 63;
    const int gw = bid * 8 + wave, NGW = nblk * 8;
    unsigned char* ws = A.ws;
    bf16_t* H = (bf16_t*)(ws + WS_HY);
    const float* ada = (const float*)(ws + WS_ADA) + (size_t)l * 3 * 3072;
    const float* g = A.norm_g + l * DM;
    for (int m = gw; m < MTOT; m += NGW) {
        const float* src = nullptr; int v;
        const bool xb = (m < MLAT) && (l > 0);
        if (m < MLAT) { src = A.x + (size_t)m * DM; v = m >> 13; }
        else { src = (l == 0 ? A.ctx : (const float*)(ws + WS_CX)) + (size_t)(m - MLAT) * DM; v = 2; }
        const float* shp = ada + v * 3072; const float* scp = shp + DM;
        f32x4 xv[4]; float ss = 0.f;
        if (xb) { const bf16_t* sb = (const bf16_t*)(ws + WS_XB) + (size_t)m * DM;
#pragma unroll
            for (int j = 0; j < 4; ++j) { const u32x2 w = *(const u32x2*)(sb + 4 * lane + 256 * j); xv[j] = (f32x4){bflo(w.x), bfhi(w.x), bflo(w.y), bfhi(w.y)}; } }
        else {
#pragma unroll
            for (int j = 0; j < 4; ++j) xv[j] = *(const f32x4*)(src + 4 * lane + 256 * j); }
#pragma unroll
        for (int j = 0; j < 4; ++j) ss += (xv[j].x * xv[j].x + xv[j].y * xv[j].y) + (xv[j].z * xv[j].z + xv[j].w * xv[j].w);
        const float rinv = rsqrtf(wave_sum(ss, lane) * (1.0f / DM) + 1e-6f);
#pragma unroll
        for (int j = 0; j < 4; ++j) { const int col = 4 * lane + 256 * j;
            const f32x4 gv = *(const f32x4*)(g + col), sc = *(const f32x4*)(scp + col), sh = *(const f32x4*)(shp + col);
            const f32x4 h = xv[j] * rinv * gv * (sc + 1.0f) + sh;
            u32x2 o; o.x = pk2(h.x, h.y); o.y = pk2(h.z, h.w);
            *(u32x2*)(H + (size_t)m * DM + col) = o; }
    }
}

struct EpiIn {
    static constexpr bool PERM = true, AFTER_DRAIN = false;
    bf16_t* PT; bf16_t* KH; bf16_t* PCT; const float2* rope;
    __device__ __forceinline__ void operator()(const f32x4 (&acc)[2][2][4][2], const pg8::Unit& u, int wr, int wc, int fr, int fq) const {
        const int row0 = u.pm * 256 + wr * 64 + fr;
        if (u.pn < 10) {
#pragma unroll
            for (int bj = 0; bj < 2; ++bj) {
                const int blk = 2 * u.pn + bj;
                const bool rp = ((blk >= 6 && blk <= 8) || blk == 15) && (u.pm < 64);
                const int col0 = 256 * u.pn + 128 * bj + 32 * wc + 8 * fq;
                bf16_t* dst; size_t ld;
                if (u.pn < 6) { dst = PT + col0; ld = NTM; }
                else { const int n2 = col0 - 1536; dst = KH + (size_t)(n2 >> 6) * MTOT * 64 + (n2 & 63); ld = 64; }
#pragma unroll
                for (int ai = 0; ai < 2; ++ai)
#pragma unroll
                    for (int m = 0; m < 4; ++m) {
                        const int r = row0 + 128 * ai + 16 * m;
                        f32x4 v0 = acc[ai][bj][m][0], v1 = acc[ai][bj][m][1];
                        if (rp) {
                            const int pos = r & (SEQ - 1);
                            const int p = (wc & 1) ? (pos & 63) : (pos >> 6);
                            const f32x4* tb = (const f32x4*)(rope + p * 16 + 8 * (fq & 1));
                            const int ln = fr + 16 * fq;
                            const float sg = (fq < 2) ? -1.0f : 1.0f;
                            { const f32x4 t0 = tb[0], t1 = tb[1];
                              const float qx = lane_xor(v0.x, ln, 32), qy = lane_xor(v0.y, ln, 32), qz = lane_xor(v0.z, ln, 32), qw = lane_xor(v0.w, ln, 32);
                              v0.x = v0.x * t0.x + sg * qx * t0.y; v0.y = v0.y * t0.z + sg * qy * t0.w; v0.z = v0.z * t1.x + sg * qz * t1.y; v0.w = v0.w * t1.z + sg * qw * t1.w; }
                            { const f32x4 t2 = tb[2], t3 = tb[3];
                              const float qx = lane_xor(v1.x, ln, 32), qy = lane_xor(v1.y, ln, 32), qz = lane_xor(v1.z, ln, 32), qw = lane_xor(v1.w, ln, 32);
                              v1.x = v1.x * t2.x + sg * qx * t2.y; v1.y = v1.y * t2.z + sg * qy * t2.w; v1.z = v1.z * t3.x + sg * qz * t3.y; v1.w = v1.w * t3.z + sg * qw * t3.w; }
                        }
                        u32x4 w; w.x = pk2(v0.x, v0.y); w.y = pk2(v0.z, v0.w); w.z = pk2(v1.x, v1.y); w.w = pk2(v1.z, v1.w);
                        *(u32x4*)(dst + (size_t)r * ld) = w;
                        asm volatile("" ::: "memory");
                    }
            }
        } else {
#pragma unroll
            for (int bj = 0; bj < 2; ++bj) {
                const int ch0 = 256 * (u.pn - 10) + 128 * bj + 32 * wc + 8 * fq;
#pragma unroll
                for (int ai = 0; ai < 2; ++ai)
#pragma unroll
                    for (int m = 0; m < 4; ++m) {
                        const int r = row0 + 128 * ai + 16 * m;
                        bf16_t* p = PCT + (size_t)ch0 * MTOT + r;
#pragma unroll
                        for (int n = 0; n < 2; ++n) {
                            const f32x4 v = acc[ai][bj][m][n];
                            bf16_t* q = p + (size_t)(4 * n) * MTOT;
                            const unsigned w0 = pk2(v.x, v.y), w1 = pk2(v.z, v.w);
                            q[0] = (bf16_t)(w0 & 0xffffu); q[MTOT] = (bf16_t)(w0 >> 16); q[2 * (size_t)MTOT] = (bf16_t)(w1 & 0xffffu); q[3 * (size_t)MTOT] = (bf16_t)(w1 >> 16);
                        }
                    }
            }
        }
    }
};
struct EpiFilt {
    static constexpr bool PERM = true, AFTER_DRAIN = false;
    bf16_t* O; int ldc;
    __device__ __forceinline__ void operator()(const f32x4 (&acc)[2][2][4][2], const pg8::Unit& u, int wr, int wc, int fr, int fq) const {
        const int row0 = u.pm * 256 + wr * 64 + fr;
#pragma unroll
        for (int bj = 0; bj < 2; ++bj) { const int col0 = 256 * u.pn + 128 * bj + 32 * wc + 8 * fq;
#pragma unroll
            for (int ai = 0; ai < 2; ++ai)
#pragma unroll
                for (int m = 0; m < 4; ++m) { const int r = row0 + 128 * ai + 16 * m; const f32x4 v0 = acc[ai][bj][m][0], v1 = acc[ai][bj][m][1];
                    u32x4 w; w.x = pk2(v0.x, v0.y); w.y = pk2(v0.z, v0.w); w.z = pk2(v1.x, v1.y); w.w = pk2(v1.z, v1.w);
                    *(u32x4*)(O + (size_t)r * ldc + col0) = w; } }
    }
};
struct EpiOut {
    static constexpr bool PERM = true, AFTER_DRAIN = false;
    const float* xsrc; bf16_t* xb; float* xdst; const float* ada; bool src32, dst32;
    __device__ __forceinline__ void operator()(const f32x4 (&acc)[2][2][4][2], const pg8::Unit& u, int wr, int wc, int fr, int fq) const {
        const int row0 = u.pm * 256 + wr * 64 + fr;
        const int v = row0 >> 13;
#pragma unroll
        for (int bj = 0; bj < 2; ++bj) {
            const int col0 = 256 * u.pn + 128 * bj + 32 * wc + 8 * fq;
            const float* gp = ada + v * 3072 + 2048 + col0;
            const f32x4 g0 = *(const f32x4*)gp, g1 = *(const f32x4*)(gp + 4);
#pragma unroll
            for (int ai = 0; ai < 2; ++ai)
#pragma unroll
              for (int mh = 0; mh < 2; ++mh) {
                f32x4 x0[2], x1[2];
                if (src32) {
#pragma unroll
                    for (int mm = 0; mm < 2; ++mm) { const float* sp = xsrc + (size_t)(row0 + 128 * ai + 16 * (2 * mh + mm)) * DM + col0; x0[mm] = *(const f32x4*)sp; x1[mm] = *(const f32x4*)(sp + 4); }
                } else {
#pragma unroll
                    for (int mm = 0; mm < 2; ++mm) { const u32x4 w = *(const u32x4*)(xb + (size_t)(row0 + 128 * ai + 16 * (2 * mh + mm)) * DM + col0);
                        x0[mm] = (f32x4){bflo(w.x), bfhi(w.x), bflo(w.y), bfhi(w.y)}; x1[mm] = (f32x4){bflo(w.z), bfhi(w.z), bflo(w.w), bfhi(w.w)}; }
                }
#pragma unroll
                for (int mm = 0; mm < 2; ++mm) { const int m = 2 * mh + mm; const size_t off = (size_t)(row0 + 128 * ai + 16 * m) * DM + col0;
                    const f32x4 y0 = x0[mm] + g0 * acc[ai][bj][m][0], y1 = x1[mm] + g1 * acc[ai][bj][m][1];
                    if (dst32) { *(f32x4*)(xdst + off) = y0; *(f32x4*)(xdst + off + 4) = y1; }
                    else { u32x4 w; w.x = pk2(y0.x, y0.y); w.y = pk2(y0.z, y0.w); w.z = pk2(y1.x, y1.y); w.w = pk2(y1.z, y1.w); *(u32x4*)(xb + off) = w; } }
                asm volatile("" ::: "memory");
              }
        }
    }
};
struct EpiAll {
    static constexpr bool PERM = true, AFTER_DRAIN = false;
    int mode, l; CKArgs* Ap;
    __device__ __forceinline__ void operator()(const f32x4 (&acc)[2][2][4][2], const pg8::Unit& u, int wr, int wc, int fr, int fq) const {
        unsigned char* ws = Ap->ws;
        if (mode == 0) { const EpiIn E{(bf16_t*)(ws + WS_PT), (bf16_t*)(ws + WS_KH), (bf16_t*)(ws + WS_PCT), (const float2*)(ws + WS_ROPE)}; E(acc, u, wr, wc, fr, fq); }
        else { const EpiOut E{Ap->x, (bf16_t*)(ws + WS_XB), Ap->out, (const float*)(ws + WS_ADA) + (size_t)l * 3 * 3072, l == 0, false}; E(acc, u, wr, wc, fr, fq); }
    }
};
__device__ __forceinline__ float max3f(float a, float b, float c) { float r; asm("v_max3_f32 %0, %1, %2, %3" : "=v"(r) : "v"(a), "v"(b), "v"(c)); return r; }
__device__ __forceinline__ float max2f(float a, float b) { float r; asm("v_max_f32_e32 %0, %1, %2" : "=v"(r) : "v"(a), "v"(b)); return r; }
__device__ __forceinline__ float max4f_mfma(float a, float b, float c, float d) { float r; asm("s_nop 15\n\ts_nop 7\n\tv_max3_f32 %0, %1, %2, %3\n\tv_max_f32_e32 %0, %0, %4" : "=&v"(r) : "v"(a), "v"(b), "v"(c), "v"(d)); return r; }
__device__ __forceinline__ void attn_tile(LAS const unsigned char* slot, int cs, const bf16x8 (&bq)[4], f32x16& o0, f32x16& o1, float& m_run, float& l_run,
                                          int r31, int hh, bool use_mask, int clo, int chi, bool use_bias, LAS const float* btab, int bidx) {
    const int kr = cs + r31;
    LAS const unsigned char* kp = slot + kr * 128;
    const int ksw = (kr >> 1) & 7;
    const bf16x8 ka0 = *(LAS const bf16x8*)(kp + 16 * ((0 + hh) ^ ksw)), ka1 = *(LAS const bf16x8*)(kp + 16 * ((2 + hh) ^ ksw));
    const bf16x8 ka2 = *(LAS const bf16x8*)(kp + 16 * ((4 + hh) ^ ksw)), ka3 = *(LAS const bf16x8*)(kp + 16 * ((6 + hh) ^ ksw));
    LAS const unsigned char* vp = slot + 8192 + r31 * 128;
    const int vsw = (r31 >> 1) & 15, g0 = (cs >> 2) + hh;
    const u32x2 a0l = *(LAS const u32x2*)(vp + 8 * ((g0) ^ vsw)), a0h = *(LAS const u32x2*)(vp + 8 * ((g0 + 2) ^ vsw));
    const u32x2 a1l = *(LAS const u32x2*)(vp + 8 * ((g0 + 4) ^ vsw)), a1h = *(LAS const u32x2*)(vp + 8 * ((g0 + 6) ^ vsw));
    const u32x2 b0l = *(LAS const u32x2*)(vp + 4096 + 8 * ((g0) ^ vsw)), b0h = *(LAS const u32x2*)(vp + 4096 + 8 * ((g0 + 2) ^ vsw));
    const u32x2 b1l = *(LAS const u32x2*)(vp + 4096 + 8 * ((g0 + 4) ^ vsw)), b1h = *(LAS const u32x2*)(vp + 4096 + 8 * ((g0 + 6) ^ vsw));
    f32x16 s, t;
#pragma unroll
    for (int i = 0; i < 16; ++i) { s[i] = 0.f; t[i] = 0.f; }
    s = __builtin_amdgcn_mfma_f32_32x32x16_bf16(ka0, bq[0], s, 0, 0, 0); t = __builtin_amdgcn_mfma_f32_32x32x16_bf16(ka1, bq[1], t, 0, 0, 0);
    s = __builtin_amdgcn_mfma_f32_32x32x16_bf16(ka2, bq[2], s, 0, 0, 0); t = __builtin_amdgcn_mfma_f32_32x32x16_bf16(ka3, bq[3], t, 0, 0, 0);
    if (use_bias) {
        LAS const float* bp = btab + bidx;
#pragma unroll
        for (int i = 0; i < 16; ++i) { const int c = (i & 3) + 8 * (i >> 2) + 4 * hh; s[i] = (s[i] + t[i]) * QK_SCALE + bp[c]; }
    } else {
#pragma unroll
        for (int i = 0; i < 16; ++i) s[i] = (s[i] + t[i]) * QK_SCALE;
    }
    if (use_mask) {
        const unsigned off = (unsigned)(4 * hh - clo), rng = (unsigned)(chi - clo);
        const bool any = chi >= clo;
#pragma unroll
        for (int i = 0; i < 16; ++i) { const unsigned c0 = (unsigned)((i & 3) + 8 * (i >> 2)); s[i] = (any && (c0 + off <= rng)) ? s[i] : -INFINITY; }
    }
    float tmax = max3f(s[0], s[1], s[2]);
#pragma unroll
    for (int i = 3; i < 15; i += 2) tmax = max3f(tmax, s[i], s[i + 1]);
    tmax = max2f(tmax, s[15]);
    tmax = max2f(tmax, lane_xor(tmax, r31 + 32 * hh, 32));
    if (__any(tmax - m_run > 8.0f)) {
        const float m_new = fmaxf(m_run, tmax);
        const float alpha = __builtin_amdgcn_exp2f(m_run - m_new);
        m_run = m_new; l_run *= alpha;
#pragma unroll
        for (int i = 0; i < 16; ++i) { o0[i] *= alpha; o1[i] *= alpha; }
    }
    float ps0 = 0.f, ps1 = 0.f;
#pragma unroll
    for (int i = 0; i < 16; i += 2) { const float p0 = __builtin_amdgcn_exp2f(s[i] - m_run), p1 = __builtin_amdgcn_exp2f(s[i + 1] - m_run); s[i] = p0; s[i + 1] = p1; ps0 += p0; ps1 += p1; }
    l_run += ps0 + ps1;
    u32x4 pw0, pw1;
    pw0.x = pk2(s[0], s[1]); pw0.y = pk2(s[2], s[3]); pw0.z = pk2(s[4], s[5]); pw0.w = pk2(s[6], s[7]);
    pw1.x = pk2(s[8], s[9]); pw1.y = pk2(s[10], s[11]); pw1.z = pk2(s[12], s[13]); pw1.w = pk2(s[14], s[15]);
    const bf16x8 pb0 = __builtin_bit_cast(bf16x8, pw0), pb1 = __builtin_bit_cast(bf16x8, pw1);
    u32x4 w;
    w.x = a0l.x; w.y = a0l.y; w.z = a0h.x; w.w = a0h.y; const bf16x8 va00 = __builtin_bit_cast(bf16x8, w);
    w.x = a1l.x; w.y = a1l.y; w.z = a1h.x; w.w = a1h.y; const bf16x8 va01 = __builtin_bit_cast(bf16x8, w);
    w.x = b0l.x; w.y = b0l.y; w.z = b0h.x; w.w = b0h.y; const bf16x8 va10 = __builtin_bit_cast(bf16x8, w);
    w.x = b1l.x; w.y = b1l.y; w.z = b1h.x; w.w = b1h.y; const bf16x8 va11 = __builtin_bit_cast(bf16x8, w);
    o0 = __builtin_amdgcn_mfma_f32_32x32x16_bf16(va00, pb0, o0, 0, 0, 0); o1 = __builtin_amdgcn_mfma_f32_32x32x16_bf16(va10, pb0, o1, 0, 0, 0);
    o0 = __builtin_amdgcn_mfma_f32_32x32x16_bf16(va01, pb1, o0, 0, 0, 0); o1 = __builtin_amdgcn_mfma_f32_32x32x16_bf16(va11, pb1, o1, 0, 0, 0);
}

__device__ __forceinline__ void attn_tile2(LAS const unsigned char* slot, const bf16x8 (&bq)[4], f32x16& o0, f32x16& o1, float& m_run, float& l_run,
                                           int r31, int hh, bool use_mask, int clo0, int chi0, int clo1, int chi1) {
    const int ksw = (r31 >> 1) & 7;
    LAS const unsigned char* kp = slot + r31 * 128;
    const bf16x8 ka0 = *(LAS const bf16x8*)(kp + 16 * ((0 + hh) ^ ksw)), ka1 = *(LAS const bf16x8*)(kp + 16 * ((2 + hh) ^ ksw));
    const bf16x8 ka2 = *(LAS const bf16x8*)(kp + 16 * ((4 + hh) ^ ksw)), ka3 = *(LAS const bf16x8*)(kp + 16 * ((6 + hh) ^ ksw));
    const bf16x8 kb0 = *(LAS const bf16x8*)(kp + 4096 + 16 * ((0 + hh) ^ ksw)), kb1 = *(LAS const bf16x8*)(kp + 4096 + 16 * ((2 + hh) ^ ksw));
    const bf16x8 kb2 = *(LAS const bf16x8*)(kp + 4096 + 16 * ((4 + hh) ^ ksw)), kb3 = *(LAS const bf16x8*)(kp + 4096 + 16 * ((6 + hh) ^ ksw));
    f32x16 s0, s1;
#pragma unroll
    for (int i = 0; i < 16; ++i) { s0[i] = 0.f; s1[i] = 0.f; }
    s0 = __builtin_amdgcn_mfma_f32_32x32x16_bf16(ka0, bq[0], s0, 0, 0, 0); s1 = __builtin_amdgcn_mfma_f32_32x32x16_bf16(kb0, bq[0], s1, 0, 0, 0);
    s0 = __builtin_amdgcn_mfma_f32_32x32x16_bf16(ka1, bq[1], s0, 0, 0, 0); s1 = __builtin_amdgcn_mfma_f32_32x32x16_bf16(kb1, bq[1], s1, 0, 0, 0);
    s0 = __builtin_amdgcn_mfma_f32_32x32x16_bf16(ka2, bq[2], s0, 0, 0, 0); s1 = __builtin_amdgcn_mfma_f32_32x32x16_bf16(kb2, bq[2], s1, 0, 0, 0);
    s0 = __builtin_amdgcn_mfma_f32_32x32x16_bf16(ka3, bq[3], s0, 0, 0, 0); s1 = __builtin_amdgcn_mfma_f32_32x32x16_bf16(kb3, bq[3], s1, 0, 0, 0);
    LAS const unsigned char* vp = slot + 8192 + r31 * 128;
    const int vsw = (r31 >> 1) & 15;
    u32x2 va[2][4][2];
#pragma unroll
    for (int db = 0; db < 2; ++db)
#pragma unroll
        for (int st = 0; st < 4; ++st) { va[db][st][0] = *(LAS const u32x2*)(vp + 4096 * db + 8 * ((4 * st + hh) ^ vsw)); va[db][st][1] = *(LAS const u32x2*)(vp + 4096 * db + 8 * ((4 * st + hh + 2) ^ vsw)); }
    if (use_mask) {
        const unsigned off0 = (unsigned)(4 * hh - clo0), rng0 = (unsigned)(chi0 - clo0), off1 = (unsigned)(4 * hh - clo1), rng1 = (unsigned)(chi1 - clo1);
#pragma unroll
        for (int i = 0; i < 16; ++i) { const unsigned c0 = (unsigned)((i & 3) + 8 * (i >> 2)); s0[i] = (c0 + off0 <= rng0) ? s0[i] : -INFINITY; s1[i] = (c0 + off1 <= rng1) ? s1[i] : -INFINITY; }
    }
    float tmax = max4f_mfma(s0[0], s0[1], s1[0], s1[1]);
#pragma unroll
    for (int i = 2; i < 16; i += 2) { tmax = max3f(tmax, s0[i], s0[i + 1]); tmax = max3f(tmax, s1[i], s1[i + 1]); }
    tmax = max2f(tmax, lane_xor(tmax, r31 + 32 * hh, 32)) * QK_SCALE;
    if (__any(tmax - m_run > 8.0f)) {
        const float m_new = fmaxf(m_run, tmax);
        const float alpha = __builtin_amdgcn_exp2f(m_run - m_new);
        m_run = m_new; l_run *= alpha;
#pragma unroll
        for (int i = 0; i < 16; ++i) { o0[i] *= alpha; o1[i] *= alpha; }
    }
    float ps0 = 0.f, ps1 = 0.f;
    const float nm = -m_run;
#pragma unroll
    for (int i = 0; i < 16; ++i) { const float p0 = __builtin_amdgcn_exp2f(fmaf(s0[i], QK_SCALE, nm)), p1 = __builtin_amdgcn_exp2f(fmaf(s1[i], QK_SCALE, nm)); s0[i] = p0; s1[i] = p1; ps0 += p0; ps1 += p1; }
    l_run += ps0 + ps1;
    u32x4 pw;
    pw.x = pk2(s0[0], s0[1]); pw.y = pk2(s0[2], s0[3]); pw.z = pk2(s0[4], s0[5]); pw.w = pk2(s0[6], s0[7]); const bf16x8 p00 = __builtin_bit_cast(bf16x8, pw);
    pw.x = pk2(s0[8], s0[9]); pw.y = pk2(s0[10], s0[11]); pw.z = pk2(s0[12], s0[13]); pw.w = pk2(s0[14], s0[15]); const bf16x8 p01 = __builtin_bit_cast(bf16x8, pw);
    pw.x = pk2(s1[0], s1[1]); pw.y = pk2(s1[2], s1[3]); pw.z = pk2(s1[4], s1[5]); pw.w = pk2(s1[6], s1[7]); const bf16x8 p10 = __builtin_bit_cast(bf16x8, pw);
    pw.x = pk2(s1[8], s1[9]); pw.y = pk2(s1[10], s1[11]); pw.z = pk2(s1[12], s1[13]); pw.w = pk2(s1[14], s1[15]); const bf16x8 p11 = __builtin_bit_cast(bf16x8, pw);
#define VA8(db_, st_) __builtin_bit_cast(bf16x8, (u32x4){va[db_][st_][0].x, va[db_][st_][0].y, va[db_][st_][1].x, va[db_][st_][1].y})
    o0 = __builtin_amdgcn_mfma_f32_32x32x16_bf16(VA8(0, 0), p00, o0, 0, 0, 0); o1 = __builtin_amdgcn_mfma_f32_32x32x16_bf16(VA8(1, 0), p00, o1, 0, 0, 0);
    o0 = __builtin_amdgcn_mfma_f32_32x32x16_bf16(VA8(0, 1), p01, o0, 0, 0, 0); o1 = __builtin_amdgcn_mfma_f32_32x32x16_bf16(VA8(1, 1), p01, o1, 0, 0, 0);
    o0 = __builtin_amdgcn_mfma_f32_32x32x16_bf16(VA8(0, 2), p10, o0, 0, 0, 0); o1 = __builtin_amdgcn_mfma_f32_32x32x16_bf16(VA8(1, 2), p10, o1, 0, 0, 0);
    o0 = __builtin_amdgcn_mfma_f32_32x32x16_bf16(VA8(0, 3), p11, o0, 0, 0, 0); o1 = __builtin_amdgcn_mfma_f32_32x32x16_bf16(VA8(1, 3), p11, o1, 0, 0, 0);
#undef VA8
}

__device__ __forceinline__ void attn_tile4(LAS const unsigned char* slotA, LAS const unsigned char* slotB, const bf16x8 (&bq)[4], f32x16& o0, f32x16& o1, float& m_run, float& l_run, int r31, int hh) {
    const int ksw = (r31 >> 1) & 7, vsw = (r31 >> 1) & 15;
    f32x16 s[4];
#pragma unroll
    for (int t = 0; t < 4; ++t)
#pragma unroll
        for (int i = 0; i < 16; ++i) s[t][i] = 0.f;
#pragma unroll
    for (int ks = 0; ks < 4; ++ks) {
        LAS const unsigned char* ka = slotA + r31 * 128 + 16 * ((2 * ks + hh) ^ ksw);
        LAS const unsigned char* kb = slotB + r31 * 128 + 16 * ((2 * ks + hh) ^ ksw);
        const bf16x8 k0 = *(LAS const bf16x8*)ka, k1 = *(LAS const bf16x8*)(ka + 4096), k2 = *(LAS const bf16x8*)kb, k3 = *(LAS const bf16x8*)(kb + 4096);
        s[0] = __builtin_amdgcn_mfma_f32_32x32x16_bf16(k0, bq[ks], s[0], 0, 0, 0); s[1] = __builtin_amdgcn_mfma_f32_32x32x16_bf16(k1, bq[ks], s[1], 0, 0, 0);
        s[2] = __builtin_amdgcn_mfma_f32_32x32x16_bf16(k2, bq[ks], s[2], 0, 0, 0); s[3] = __builtin_amdgcn_mfma_f32_32x32x16_bf16(k3, bq[ks], s[3], 0, 0, 0);
    }
    float tmax = max4f_mfma(s[0][0], s[1][0], s[2][0], s[3][0]);
#pragma unroll
    for (int i = 1; i < 16; ++i) { tmax = max3f(tmax, s[0][i], s[1][i]); tmax = max3f(tmax, s[2][i], s[3][i]); }
    tmax = max2f(tmax, lane_xor(tmax, r31 + 32 * hh, 32)) * QK_SCALE;
    if (__any(tmax - m_run > 8.0f)) {
        const float m_new = fmaxf(m_run, tmax);
        const float alpha = __builtin_amdgcn_exp2f(m_run - m_new);
        m_run = m_new; l_run *= alpha;
#pragma unroll
        for (int i = 0; i < 16; ++i) { o0[i] *= alpha; o1[i] *= alpha; }
    }
    const float nm = -m_run;
    float ps0 = 0.f, ps1 = 0.f;
#pragma unroll
    for (int t = 0; t < 4; ++t)
#pragma unroll
        for (int i = 0; i < 16; i += 2) { const float p0 = __builtin_amdgcn_exp2f(fmaf(s[t][i], QK_SCALE, nm)), p1 = __builtin_amdgcn_exp2f(fmaf(s[t][i + 1], QK_SCALE, nm)); s[t][i] = p0; s[t][i + 1] = p1; ps0 += p0; ps1 += p1; }
    l_run += ps0 + ps1;
#pragma unroll
    for (int t = 0; t < 4; ++t) {
        LAS const unsigned char* vp = (t < 2 ? slotA : slotB) + 8192 + r31 * 128;
        const int g0 = 8 * (t & 1) + hh;
        u32x4 pw;
        pw.x = pk2(s[t][0], s[t][1]); pw.y = pk2(s[t][2], s[t][3]); pw.z = pk2(s[t][4], s[t][5]); pw.w = pk2(s[t][6], s[t][7]); const bf16x8 pa = __builtin_bit_cast(bf16x8, pw);
        pw.x = pk2(s[t][8], s[t][9]); pw.y = pk2(s[t][10], s[t][11]); pw.z = pk2(s[t][12], s[t][13]); pw.w = pk2(s[t][14], s[t][15]); const bf16x8 pb = __builtin_bit_cast(bf16x8, pw);
        const u32x2 a0l = *(LAS const u32x2*)(vp + 8 * ((g0) ^ vsw)), a0h = *(LAS const u32x2*)(vp + 8 * ((g0 + 2) ^ vsw));
        const u32x2 a1l = *(LAS const u32x2*)(vp + 8 * ((g0 + 4) ^ vsw)), a1h = *(LAS const u32x2*)(vp + 8 * ((g0 + 6) ^ vsw));
        const u32x2 b0l = *(LAS const u32x2*)(vp + 4096 + 8 * ((g0) ^ vsw)), b0h = *(LAS const u32x2*)(vp + 4096 + 8 * ((g0 + 2) ^ vsw));
        const u32x2 b1l = *(LAS const u32x2*)(vp + 4096 + 8 * ((g0 + 4) ^ vsw)), b1h = *(LAS const u32x2*)(vp + 4096 + 8 * ((g0 + 6) ^ vsw));
        o0 = __builtin_amdgcn_mfma_f32_32x32x16_bf16(__builtin_bit_cast(bf16x8, (u32x4){a0l.x, a0l.y, a0h.x, a0h.y}), pa, o0, 0, 0, 0);
        o1 = __builtin_amdgcn_mfma_f32_32x32x16_bf16(__builtin_bit_cast(bf16x8, (u32x4){b0l.x, b0l.y, b0h.x, b0h.y}), pa, o1, 0, 0, 0);
        o0 = __builtin_amdgcn_mfma_f32_32x32x16_bf16(__builtin_bit_cast(bf16x8, (u32x4){a1l.x, a1l.y, a1h.x, a1h.y}), pb, o0, 0, 0, 0);
        o1 = __builtin_amdgcn_mfma_f32_32x32x16_bf16(__builtin_bit_cast(bf16x8, (u32x4){b1l.x, b1l.y, b1h.x, b1h.y}), pb, o1, 0, 0, 0);
    }
}

__device__ __forceinline__ void attn_block_item(CKArgs& A, int l, int MODE, int item, LAS unsigned char* lds, int tid) {
    asm volatile("" : "+v"(tid));
    unsigned char* ws = A.ws;
    const bf16_t* PT = (const bf16_t*)(ws + WS_PT);
    bf16_t* Y = (bf16_t*)(ws + WS_HY);
    const int wave = __builtin_amdgcn_readfirstlane(tid >> 6), lane = tid & 63;
    const int r31 = lane & 31, hh = lane >> 5;
    int b, h, qtok, qi = 0;
    int rp = 0, mg = 0, qg = 0;
    if (MODE == 0) { b = item / 192; const int rem = item % 192; h = rem >> 5; qi = rem & 31; rp = 2 * qi + (wave >> 2); mg = wave & 3;
        qtok = b * SEQ + (2 * rp + (r31 >> 4)) * 64 + 16 * mg + (r31 & 15); }
    else if (MODE == 1) { b = item / 192; const int rem = item % 192; h = rem >> 5; qi = rem & 31; qg = 8 * qi + wave; qtok = b * SEQ + 32 * qg + r31; }
    else { b = item / 6; h = item % 6; qg = wave; qtok = MLAT + b * CTXL + 32 * qg + r31; }
    const bool grpA = (MODE == 0 || MODE == 2);
    const int kvh = grpA ? h : h / 3;
    const int qcol = (grpA ? C_QA : C_QC) + h * 64, gcol = (grpA ? C_GA : C_GC) + h * 64, ycol = (grpA ? 0 : 640) + h * 64;
    const int kh = grpA ? h : 6 + kvh;
    bf16x8 bq[4];
    { const bf16_t* qp = PT + (size_t)qtok * NTM + qcol + 8 * hh;
#pragma unroll
      for (int s = 0; s < 4; ++s) bq[s] = *(const bf16x8*)(qp + 16 * s); }
    f32x16 o0, o1;
#pragma unroll
    for (int i = 0; i < 16; ++i) { o0[i] = 0.f; o1[i] = 0.f; }
    float m_run = -1e30f, l_run = 0.f;
    if (!grpA) { m_run = A.sink[l * 6 + h] * LOG2E; l_run = hh == 0 ? 1.0f : 0.f; }
    int wrow0 = 0, nwin = 0;
    if (MODE == 0) { const int a0 = min(max(4 * qi - 4, 0), 120), a1 = min(max(4 * qi - 1, 0), 120) + 7; wrow0 = a0; nwin = a1 - a0 + 1; }
    if (MODE == 1) { const int k0 = max(4 * qi - 2, 0), k1 = min(4 * qi + 5, 127); wrow0 = k0; nwin = k1 - k0 + 1; }
    const int nsteps = 4 + nwin;
    int ra = 0, rb = -1, cs = 0, rq = 0, jq = 0, r0 = 0, cmin = 0;
    LAS const float* btab = (LAS const float*)(lds + AUX_OFF + 2048);
    if (MODE == 0) { ra = min(max(2 * rp - 4, 0), 120); rb = min(max(2 * rp - 3, 0), 120) + 7; cs = min(max(16 * mg - 8, 0), 32);
        rq = 2 * rp + (r31 >> 4); jq = 16 * mg + (r31 & 15); r0 = min(max(rq - 4, 0), 120); cmin = min(max(jq - 8, 0), 48) - cs;
        }
    const int lr = tid >> 3, lc = tid & 7;
    const bf16_t* kg = (const bf16_t*)(ws + WS_KH) + (size_t)kh * MTOT * 64 + 8 * tid;
    const bf16_t* vg = (const bf16_t*)(ws + WS_VT) + (size_t)kh * MTOT * 64 + 8 * tid;
    const int kdst = lr * 128 + 16 * (lc ^ ((lr >> 1) & 7));
    const int vdstb = 8192 + (8 * lc) * 128 + 2 * (lr & 3), vg4 = lr >> 2, vs4 = (4 * lc) & 15;
#define ROW_TOK(i) ((i) < 4 ? MLAT + b * CTXL + 64 * (i) : b * SEQ + 64 * (wrow0 + (i) - 4))
#define LOAD_ROW(i, kr_, vr_) do { const int t0_ = ROW_TOK(i); kr_ = *(const u32x4*)(kg + (size_t)t0_ * 64); vr_ = *(const u32x4*)(vg + (size_t)t0_ * 64); } while (0)
#define WRITE_ROW(sl_, kr_, vr_) do { *(LAS u32x4*)((sl_) + kdst) = kr_; \
        _Pragma("unroll") for (int j_ = 0; j_ < 8; ++j_) { const unsigned w_ = j_ < 2 ? vr_.x : (j_ < 4 ? vr_.y : (j_ < 6 ? vr_.z : vr_.w)); \
            *(LAS bf16_t*)((sl_) + vdstb + j_ * 128 + 8 * (vg4 ^ ((vs4 + (j_ >> 1)) & 15))) = (bf16_t)((j_ & 1) ? (w_ >> 16) : (w_ & 0xffffu)); } } while (0)
    u32x4 k0, v0, k1, v1, k2, v2;
    LOAD_ROW(0, k0, v0); LOAD_ROW(1, k2, v2);
    __syncthreads();
    if (MODE == 0 && tid < 465) ((LAS float*)(lds + AUX_OFF + 2048))[tid] = A.na_rpb[(size_t)(l * 6 + h) * 465 + tid] * LOG2E;
    WRITE_ROW(lds, k0, v0); WRITE_ROW(lds + 16384, k2, v2);
    __syncthreads();
#pragma unroll 1
    for (int pr = 0; pr < 2; ++pr) {
        { const int ra_ = pr == 0 ? 2 : min(4, nsteps - 1), rb_ = pr == 0 ? 3 : ra_; LOAD_ROW(ra_, k0, v0); LOAD_ROW(rb_, k2, v2); }
        attn_tile4(lds, lds + 16384, bq, o0, o1, m_run, l_run, r31, hh);
        __syncthreads();
        if (pr == 0) { WRITE_ROW(lds, k0, v0); WRITE_ROW(lds + 16384, k2, v2); } else if (nsteps > 4) { WRITE_ROW(lds, k0, v0); }
        __syncthreads();
    }
#define ATT_STEP(i_, kL, vL, kW, vW) do { const int i = (i_); if (i < nsteps) { \
        LAS const unsigned char* slot = lds + (i & 1) * 16384; \
        { const int ir_ = min(i + 1, nsteps - 1); LOAD_ROW(ir_, kL, vL); }     \
        bool use2 = false, use1 = false, um = false, um1 = false, ub = false; int c1 = 0, lo0 = 0, hi0 = 31, lo1 = 0, hi1 = 31, bidx = 0; \
        if (i < 4) use2 = true; \
        else if (MODE == 0) { const int a = wrow0 + i - 4; use1 = (a >= ra) && (a <= rb); const bool rowok = (a >= r0) && (a < r0 + 8); \
            c1 = cs; lo0 = rowok ? cmin : 1; hi0 = rowok ? cmin + 15 : 0; ub = true; um1 = true; bidx = (a - rq + 7) * 31 + (cs - jq + 15); } \
        else if (MODE == 1) { const int rel0 = (64 * (wrow0 + i - 4) - (32 * qg - 128)) >> 5, rel1 = rel0 + 1;     \
            const bool a0 = (rel0 >= 0) && (rel0 <= 8), a1 = (rel1 >= 0) && (rel1 <= 8); \
            if (a0 && a1) { use2 = true; um = (rel0 == 0) || (rel1 == 8); lo0 = rel0 == 0 ? r31 : 0; hi1 = rel1 == 8 ? r31 : 31; } \
            else if (a0) { use1 = true; um1 = (rel0 == 0) || (rel0 == 8); lo0 = rel0 == 0 ? r31 : 0; hi0 = rel0 == 8 ? r31 : 31; } \
            else if (a1) { use1 = true; c1 = 32; um1 = (rel1 == 0) || (rel1 == 8); lo0 = rel1 == 0 ? r31 : 0; hi0 = rel1 == 8 ? r31 : 31; } } \
        if (use2) attn_tile2(slot, bq, o0, o1, m_run, l_run, r31, hh, um, lo0, hi0, lo1, hi1); \
        if (use1) attn_tile(slot, c1, bq, o0, o1, m_run, l_run, r31, hh, um1, lo0, hi0, ub, btab, bidx); \
        if (i + 1 < nsteps) { LAS unsigned char* nslot = lds + ((i + 1) & 1) * 16384; WRITE_ROW(nslot, kW, vW); } \
        __syncthreads(); } } while (0)
#pragma unroll 1
    for (int i3 = 4; i3 < nsteps; ++i3) {
        ATT_STEP(i3, k1, v1, k1, v1);
    }
#undef ATT_STEP
#undef LOAD_ROW
#undef WRITE_ROW
    const float ltot = l_run + lane_xor(l_run, lane, 32);
    const float inv = 1.0f / ltot;
    const bf16_t* gp = PT + (size_t)qtok * NTM + gcol + 4 * hh;
    bf16_t* yp = Y + (size_t)qtok * DM + ycol + 4 * hh;
#pragma unroll
    for (int db = 0; db < 2; ++db)
#pragma unroll
        for (int g4 = 0; g4 < 4; ++g4) {
            const int d0 = 32 * db + 8 * g4;
            const u32x2 gw = *(const u32x2*)(gp + d0);
            float v0, v1, v2, v3;
            if (db == 0) { v0 = o0[4 * g4]; v1 = o0[4 * g4 + 1]; v2 = o0[4 * g4 + 2]; v3 = o0[4 * g4 + 3]; }
            else { v0 = o1[4 * g4]; v1 = o1[4 * g4 + 1]; v2 = o1[4 * g4 + 2]; v3 = o1[4 * g4 + 3]; }
            v0 *= inv * silu_f(bflo(gw.x)); v1 *= inv * silu_f(bfhi(gw.x)); v2 *= inv * silu_f(bflo(gw.y)); v3 *= inv * silu_f(bfhi(gw.y));
            u32x2 o; o.x = pk2(v0, v1); o.y = pk2(v2, v3);
            *(u32x2*)(yp + d0) = o;
        }
}

typedef float cf2 __attribute__((ext_vector_type(2)));
__device__ __forceinline__ cf2 mk2(float x, float y) { cf2 r; r.x = x; r.y = y; return r; }
__device__ __forceinline__ cf2 cmul(cf2 a, cf2 b) { const cf2 bs = mk2(-b.y, b.x); return a.xx * b + a.yy * bs; }
#define PA(e) ((e) + (((e) >> 4) << 1))
struct cf2x4 { cf2 a, b, c, d; };
__device__ __forceinline__ cf2x4 bfly4_fwd(cf2 x0, cf2 x1, cf2 x2, cf2 x3, float a) {
    const cf2 w1 = mk2(__builtin_amdgcn_cosf(a), -__builtin_amdgcn_sinf(a));
    const cf2 w2 = cmul(w1, w1), w3 = cmul(w2, w1);
    const cf2 s02 = x0 + x2, d02 = x0 - x2, s13 = x1 + x3, d13 = x1 - x3;
    cf2x4 r;
    r.a = s02 + s13;
    r.b = cmul(s02 - s13, w2);
    r.c = cmul(mk2(d02.x + d13.y, d02.y - d13.x), w1);
    r.d = cmul(mk2(d02.x - d13.y, d02.y + d13.x), w3);
    return r;
}
__device__ __forceinline__ cf2x4 bfly4_inv(cf2 v0, cf2 v1, cf2 v2, cf2 v3, float a) {
    const cf2 w1 = mk2(__builtin_amdgcn_cosf(a), __builtin_amdgcn_sinf(a));
    const cf2 w2 = cmul(w1, w1);
    const cf2 bb = cmul(v1, w2), dd = cmul(v3, w2);
    const cf2 u0 = v0 + bb, u1 = v0 - bb, u2 = v2 + dd, u3 = v2 - dd;
    const cf2 e = cmul(u2, w1), f0 = cmul(u3, w1);
    const cf2 f = mk2(-f0.y, f0.x);
    cf2x4 r; r.a = u0 + e; r.c = u0 - e; r.b = u1 + f; r.d = u1 - f; return r;
}
__device__ __forceinline__ void fft_fwd_fused(LAS cf2* buf, int tid, int lsb, bool zero_hi = false) {
    const int sB = 1 << lsb, s = 4 << lsb;
    const float ra = 1.0f / (float)(16 << lsb), rb = 1.0f / (float)(4 << lsb);
    int poff[4][4];
#pragma unroll
    for (int a = 0; a < 4; ++a)
#pragma unroll
        for (int b = 0; b < 4; ++b) { const int off = a * s + b * sB; poff[a][b] = PA(off); }
#pragma unroll 1
    for (int gg = 0; gg < 2; ++gg) {
        const int g = tid + 512 * gg, i = g & (sB - 1), base = ((g >> lsb) << (lsb + 4)) + i;
        const int pbase = PA(base);
        cf2 x[4][4];
#pragma unroll
        for (int a = 0; a < 4; ++a)
#pragma unroll
            for (int b = 0; b < 4; ++b) x[a][b] = (zero_hi && a >= 2) ? mk2(0.f, 0.f) : buf[pbase + poff[a][b]];
#pragma unroll
        for (int b = 0; b < 4; ++b) { const cf2x4 r = bfly4_fwd(x[0][b], x[1][b], x[2][b], x[3][b], (float)(i + b * sB) * ra); x[0][b] = r.a; x[1][b] = r.b; x[2][b] = r.c; x[3][b] = r.d; }
        const float ab = (float)i * rb;
#pragma unroll
        for (int a = 0; a < 4; ++a) { const cf2x4 r = bfly4_fwd(x[a][0], x[a][1], x[a][2], x[a][3], ab); x[a][0] = r.a; x[a][1] = r.b; x[a][2] = r.c; x[a][3] = r.d; }
#pragma unroll
        for (int a = 0; a < 4; ++a)
#pragma unroll
            for (int b = 0; b < 4; ++b) buf[pbase + poff[a][b]] = x[a][b];
    }
    __syncthreads();
}
__device__ __forceinline__ void fft_inv_fused(LAS cf2* buf, int tid, int lsb) {
    const int sB = 1 << lsb, s = 4 << lsb;
    const float ra = 1.0f / (float)(16 << lsb), rb = 1.0f / (float)(4 << lsb);
    int poff[4][4];
#pragma unroll
    for (int a = 0; a < 4; ++a)
#pragma unroll
        for (int b = 0; b < 4; ++b) { const int off = a * s + b * sB; poff[a][b] = PA(off); }
#pragma unroll 1
    for (int gg = 0; gg < 2; ++gg) {
        const int g = tid + 512 * gg, i = g & (sB - 1), base = ((g >> lsb) << (lsb + 4)) + i;
        const int pbase = PA(base);
        cf2 x[4][4];
#pragma unroll
        for (int a = 0; a < 4; ++a)
#pragma unroll
            for (int b = 0; b < 4; ++b) x[a][b] = buf[pbase + poff[a][b]];
        const float ab = (float)i * rb;
#pragma unroll
        for (int a = 0; a < 4; ++a) { const cf2x4 r = bfly4_inv(x[a][0], x[a][1], x[a][2], x[a][3], ab); x[a][0] = r.a; x[a][1] = r.b; x[a][2] = r.c; x[a][3] = r.d; }
#pragma unroll
        for (int b = 0; b < 4; ++b) { const cf2x4 r = bfly4_inv(x[0][b], x[1][b], x[2][b], x[3][b], (float)(i + b * sB) * ra); x[0][b] = r.a; x[1][b] = r.b; x[2][b] = r.c; x[3][b] = r.d; }
#pragma unroll
        for (int a = 0; a < 4; ++a)
#pragma unroll
            for (int b = 0; b < 4; ++b) buf[pbase + poff[a][b]] = x[a][b];
    }
    __syncthreads();
}
__device__ __forceinline__ void fft_fwd(LAS cf2* buf, int tid, const unsigned* zk = nullptr, bool zero_hi = false) {
#pragma unroll 1
    for (int lsb = 10; lsb >= 2; lsb -= 4) fft_fwd_fused(buf, tid, lsb, zero_hi && lsb == 10);
#pragma unroll 4
    for (int k = 0; k < 8; ++k) {
        const int e0 = 4 * (tid + 512 * k), base = PA(e0);
        cf2 x0 = buf[base], x1 = buf[base + 1], x2 = buf[base + 2], x3 = buf[base + 3];
        const cf2 s02 = x0 + x2, d02 = x0 - x2, s13 = x1 + x3, d13 = x1 - x3;
        cf2 y0 = s02 + s13, y1 = s02 - s13, y2 = mk2(d02.x + d13.y, d02.y - d13.x), y3 = mk2(d02.x - d13.y, d02.y + d13.x);
        if (zk) { const u32x4 w = *(const u32x4*)(zk + (unsigned)e0);
            y0 = cmul(y0, mk2(bflo(w.x), bfhi(w.x))); y1 = cmul(y1, mk2(bflo(w.y), bfhi(w.y))); y2 = cmul(y2, mk2(bflo(w.z), bfhi(w.z))); y3 = cmul(y3, mk2(bflo(w.w), bfhi(w.w))); }
        buf[base] = y0; buf[base + 1] = y1; buf[base + 2] = y2; buf[base + 3] = y3;
    }
    __syncthreads();
}
__device__ __forceinline__ void fft_inv(LAS cf2* buf, int tid) {
#pragma unroll 1
    for (int lsb = 0; lsb <= 8; lsb += 4) fft_inv_fused(buf, tid, lsb);
#pragma unroll 4
    for (int k = 0; k < 8; ++k) {
        const int i = tid + 512 * k, pi = PA(tid) + 576 * k;
        cf2 v0 = buf[pi], v1 = buf[pi + 4608], v2 = buf[pi + 9216], v3 = buf[pi + 13824];
        const cf2x4 r = bfly4_inv(v0, v1, v2, v3, (float)i * (1.0f / 16384.0f));
        buf[pi] = r.a; buf[pi + 4608] = r.b;
    }
    __syncthreads();
}
__device__ __forceinline__ float hy_short(const bf16_t* prow, int tb, int t, int L, float w0, float w1, float w2, float bias) {
    const float pm = t > 0 ? bf2f(prow[tb + t - 1]) : 0.f;
    const float pc = bf2f(prow[tb + t]);
    const float pp = t < L - 1 ? bf2f(prow[tb + t + 1]) : 0.f;
    return w0 * pm + w1 * pc + w2 * pp + bias;
}
__device__ __forceinline__ float block_sum(float v, LAS float* red, int tid) {
    v = wave_sum(v, tid & 63);
    __syncthreads();
    if ((tid & 63) == 0) red[tid >> 6] = v;
    __syncthreads();
    float s = 0.f;
#pragma unroll
    for (int w = 0; w < 8; ++w) s += red[w];
    return s;
}

__device__ __forceinline__ void hyena_block(CKArgs& A, int l, int c, LAS unsigned char* lds, int tid) {
    asm volatile("" : "+v"(tid));
    unsigned char* ws = A.ws;
    LAS cf2* buf = (LAS cf2*)lds;
    LAS float* fs = (LAS float*)lds;
    LAS float* aux = (LAS float*)(lds + AUX_OFF);
    LAS float* red = aux + 256;
    const bf16_t* PCT = (const bf16_t*)(ws + WS_PCT);
    bf16_t* YBT = (bf16_t*)((unsigned char*)A.out + OUT_YBT);
    const bf16_t* rowz = PCT + (size_t)(R_HZ + c) * MTOT;
    const bf16_t* rowx1 = rowz + (size_t)256 * MTOT;
    const bf16_t* rowx2 = rowz + (size_t)512 * MTOT;
    const bf16_t* rowg = PCT + (size_t)(R_GB + c) * MTOT;
    const float* cw = A.hy_conv_w + (size_t)l * 3 * 768; const float* cb = A.hy_conv_b + (size_t)l * 768;
    const float wz0 = cw[c], wz1 = cw[768 + c], wz2 = cw[1536 + c], bz = cb[c];
    const float wa0 = cw[256 + c], wa1 = cw[768 + 256 + c], wa2 = cw[1536 + 256 + c], ba = cb[256 + c];
    const float wb0 = cw[512 + c], wb1 = cw[768 + 512 + c], wb2 = cw[1536 + 512 + c], bb = cb[512 + c];
    const float d0 = A.hy_d[(l * 2 + 0) * 256 + c], d1 = A.hy_d[(l * 2 + 1) * 256 + c];
    const float dmin = -3.0701134573253945f, dmax = -15.350567286626973f;
    const float delta = fabsf(dmin + (float)c * ((dmax - dmin) / 255.0f));
    __syncthreads();
    if (tid < 256) { const int k = tid >> 6, j = tid & 63; aux[tid] = A.hy_w3[((size_t)l * 64 + j) * 1024 + k * 256 + c]; }
    __syncthreads();

    if (l < DEPTH - 1) {
        float ss0 = 0.f, ss1 = 0.f;
        if (tid < 256) {
            const int n = tid; const f32x4* hr = (const f32x4*)((const float*)(ws + WS_H2C) + ((size_t)l * CTXL + n) * 64);
            float f0 = 0.f, f1 = 0.f, b0 = 0.f, b1 = 0.f;
#pragma unroll 1
            for (int j4 = 0; j4 < 16; ++j4) { const f32x4 hv = hr[j4];
#pragma unroll
                for (int e = 0; e < 4; ++e) { const float hvv = hv[e]; const int j = 4 * j4 + e; f0 += hvv * aux[j]; f1 += hvv * aux[64 + j]; b0 += hvv * aux[128 + j]; b1 += hvv * aux[192 + j]; } }
            const float e = __expf(-((float)n * (1.0f / 255.0f)) * delta);
            f0 *= e; f1 *= e; b0 *= e; b1 *= e;
            fs[255 + n] = f0; fs[512 + 255 + n] = f1;
            if (n >= 1) { fs[255 - n] = b0; fs[512 + 255 - n] = b1; }
            ss0 = f0 * f0 + (n >= 1 ? b0 * b0 : 0.f); ss1 = f1 * f1 + (n >= 1 ? b1 * b1 : 0.f);
        }
        if (tid == 0) { fs[511] = 0.f; fs[1023] = 0.f; }
        const int b = tid >> 8, t = tid & 255, tok = MLAT + b * CTXL;
        const float z = hy_short(rowz, tok, t, CTXL, wz0, wz1, wz2, bz);
        const float x1 = hy_short(rowx1, tok, t, CTXL, wa0, wa1, wa2, ba);
        const float x2 = hy_short(rowx2, tok, t, CTXL, wb0, wb1, wb2, bb);
        const float gb = bf2f(rowg[tok + t]);
        fs[1024 + tid] = z;
        const float n0 = rsqrtf(block_sum(ss0, red, tid) + 1e-6f);
        const float n1 = rsqrtf(block_sum(ss1, red, tid) + 1e-6f);
        __syncthreads();
        float y = 0.f;
        { LAS const float* kc = fs + 255 + t; LAS const float* zz = fs + 1024 + b * 256;
#pragma unroll 8
          for (int s = 0; s < 256; ++s) y += zz[s] * kc[-s]; }
        const float z1 = x1 * (y * n0 + d0 * z);
        fs[1536 + tid] = z1;
        __syncthreads();
        float y2 = 0.f;
        { LAS const float* kc = fs + 512 + 255 + t; LAS const float* zz = fs + 1536 + b * 256;
#pragma unroll 8
          for (int s = 0; s < 256; ++s) y2 += zz[s] * kc[-s]; }
        const float o = x2 * (y2 * n1 + d1 * z1) * silu_f(gb);
        YBT[(size_t)c * MTOT + tok + t] = (bf16_t)(pk2(o, 0.f) & 0xffffu);
        __syncthreads();
    }

    unsigned* ZK = (unsigned*)((unsigned char*)A.out + OUT_ZS) + (size_t)c * 2 * NFFT;
    const int lane = tid & 63;
    {
        float ss0 = 0.f, ss1 = 0.f;
        const bf16_t* F0 = (const bf16_t*)((unsigned char*)A.out + OUT_FILT) + (size_t)c * SEQ;
        u32x4 fw[2][4];
#pragma unroll
        for (int j = 0; j < 2; ++j)
#pragma unroll
            for (int r = 0; r < 4; ++r) fw[j][r] = *(const u32x4*)(F0 + (size_t)(256 * r) * SEQ + 8 * (tid + 512 * j));
#pragma unroll
        for (int j = 0; j < 2; ++j)
#pragma unroll
            for (int e8 = 0; e8 < 8; ++e8) {
                const int n = 8 * (tid + 512 * j) + e8;
                const float e = __expf(-((float)n * (1.0f / 8191.0f)) * delta);
                const unsigned w0 = e8 < 2 ? fw[j][0].x : (e8 < 4 ? fw[j][0].y : (e8 < 6 ? fw[j][0].z : fw[j][0].w)), w1 = e8 < 2 ? fw[j][1].x : (e8 < 4 ? fw[j][1].y : (e8 < 6 ? fw[j][1].z : fw[j][1].w));
                const unsigned w2 = e8 < 2 ? fw[j][2].x : (e8 < 4 ? fw[j][2].y : (e8 < 6 ? fw[j][2].z : fw[j][2].w)), w3 = e8 < 2 ? fw[j][3].x : (e8 < 4 ? fw[j][3].y : (e8 < 6 ? fw[j][3].z : fw[j][3].w));
                const float f0 = ((e8 & 1) ? bfhi(w0) : bflo(w0)) * e, f1 = ((e8 & 1) ? bfhi(w1) : bflo(w1)) * e, b0 = ((e8 & 1) ? bfhi(w2) : bflo(w2)) * e, b1 = ((e8 & 1) ? bfhi(w3) : bflo(w3)) * e;
                buf[PA(n)] = mk2(f0, f1); ss0 += f0 * f0; ss1 += f1 * f1;
                if (n >= 1) { buf[PA(NFFT - n)] = mk2(b0, b1); ss0 += b0 * b0; ss1 += b1 * b1; }
            }
        if (tid == 0) { const float zf = delta * 0.0f; buf[PA(SEQ)] = mk2(zf, zf); }
        const float nrm0 = rsqrtf(block_sum(ss0, red, tid) + 1e-6f) * (0.5f / NFFT);
        const float nrm1 = rsqrtf(block_sum(ss1, red, tid) + 1e-6f) * (0.5f / NFFT);
        __syncthreads();
        fft_fwd(buf, tid);
#pragma unroll 4
        for (int k = 0; k < 32; ++k) {
            const int p = tid + 512 * k; const int f = (int)(__brev((unsigned)p) >> 18); const int pp = (int)(__brev((unsigned)((NFFT - f) & (NFFT - 1))) >> 18);
            const cf2 za = buf[PA(p)], zb = buf[PA(pp)];
            ZK[p] = pk2((za.x + zb.x) * nrm0 + d0 * (1.0f / NFFT), (za.y - zb.y) * nrm0);
            ZK[NFFT + p] = pk2((za.y + zb.y) * nrm1 + d1 * (1.0f / NFFT), -(za.x - zb.x) * nrm1);
        }
        __syncthreads();
    }
#define HY_RAW(prow_, j_, b_) (*(const u32x4*)((prow_) + (size_t)(b_) * SEQ + 8 * (tid + 512 * (j_))))
#define HY_CONV(prow_, raw_, j_, b_, w0_, w1_, w2_, bias_, u_) do { \
        const int q_ = tid + 512 * (j_); float own_[8]; \
        own_[0] = bflo((raw_).x); own_[1] = bfhi((raw_).x); own_[2] = bflo((raw_).y); own_[3] = bfhi((raw_).y); own_[4] = bflo((raw_).z); own_[5] = bfhi((raw_).z); own_[6] = bflo((raw_).w); own_[7] = bfhi((raw_).w); \
        float pl_ = lane_prev(own_[7], lane), nl_ = lane_next(own_[0], lane); \
        if (lane == 0) pl_ = q_ > 0 ? bf2f((prow_)[(size_t)(b_) * SEQ + 8 * q_ - 1]) : 0.f; \
        if (lane == 63) nl_ = 8 * q_ + 8 < SEQ ? bf2f((prow_)[(size_t)(b_) * SEQ + 8 * q_ + 8]) : 0.f; \
        _Pragma("unroll") for (int e = 0; e < 8; ++e) (u_)[e] = (w0_) * (e > 0 ? own_[e > 0 ? e - 1 : 0] : pl_) + (w1_) * own_[e] + (w2_) * (e < 7 ? own_[e < 7 ? e + 1 : 7] : nl_) + (bias_); } while (0)
    const int pq0 = PA(8 * tid), pq1 = PA(8 * (tid + 512));
    {
        const u32x4 r00 = HY_RAW(rowz, 0, 0), r01 = HY_RAW(rowz, 0, 1), r10 = HY_RAW(rowz, 1, 0), r11 = HY_RAW(rowz, 1, 1);
        float ua[8], ub[8];
        HY_CONV(rowz, r00, 0, 0, wz0, wz1, wz2, bz, ua); HY_CONV(rowz, r01, 0, 1, wz0, wz1, wz2, bz, ub);
#pragma unroll
        for (int e = 0; e < 8; ++e) buf[pq0 + e] = mk2(ua[e], ub[e]);
        HY_CONV(rowz, r10, 1, 0, wz0, wz1, wz2, bz, ua); HY_CONV(rowz, r11, 1, 1, wz0, wz1, wz2, bz, ub);
#pragma unroll
        for (int e = 0; e < 8; ++e) buf[pq1 + e] = mk2(ua[e], ub[e]);
    }
    __syncthreads();
    fft_fwd(buf, tid, ZK, true);
    fft_inv(buf, tid);
    {
        const u32x4 r00 = HY_RAW(rowx1, 0, 0), r01 = HY_RAW(rowx1, 0, 1), r10 = HY_RAW(rowx1, 1, 0), r11 = HY_RAW(rowx1, 1, 1);
        float xa[8], xb[8];
        HY_CONV(rowx1, r00, 0, 0, wa0, wa1, wa2, ba, xa); HY_CONV(rowx1, r01, 0, 1, wa0, wa1, wa2, ba, xb);
#pragma unroll
        for (int e = 0; e < 8; ++e) { const cf2 y = buf[pq0 + e]; buf[pq0 + e] = mk2(xa[e] * y.x, xb[e] * y.y); }
        HY_CONV(rowx1, r10, 1, 0, wa0, wa1, wa2, ba, xa); HY_CONV(rowx1, r11, 1, 1, wa0, wa1, wa2, ba, xb);
#pragma unroll
        for (int e = 0; e < 8; ++e) { const cf2 y = buf[pq1 + e]; buf[pq1 + e] = mk2(xa[e] * y.x, xb[e] * y.y); }
    }
    __syncthreads();
    fft_fwd(buf, tid, ZK + NFFT, true);
    fft_inv(buf, tid);
    {
        bf16_t* yrow = YBT + (size_t)c * MTOT;
        const u32x4 r00 = HY_RAW(rowx2, 0, 0), r01 = HY_RAW(rowx2, 0, 1), r10 = HY_RAW(rowx2, 1, 0), r11 = HY_RAW(rowx2, 1, 1);
        const u32x4 g00 = HY_RAW(rowg, 0, 0), g01 = HY_RAW(rowg, 0, 1), g10 = HY_RAW(rowg, 1, 0), g11 = HY_RAW(rowg, 1, 1);
        float xa[8], xb[8];
#define HY_OUT(pq_, ga_, gb_, j_) do { float oa_[8], ob_[8]; \
            const float gaf_[8] = {bflo((ga_).x), bfhi((ga_).x), bflo((ga_).y), bfhi((ga_).y), bflo((ga_).z), bfhi((ga_).z), bflo((ga_).w), bfhi((ga_).w)}; \
            const float gbf_[8] = {bflo((gb_).x), bfhi((gb_).x), bflo((gb_).y), bfhi((gb_).y), bflo((gb_).z), bfhi((gb_).z), bflo((gb_).w), bfhi((gb_).w)}; \
            _Pragma("unroll") for (int e = 0; e < 8; ++e) { const cf2 y = buf[(pq_) + e]; oa_[e] = xa[e] * y.x * silu_f(gaf_[e]); ob_[e] = xb[e] * y.y * silu_f(gbf_[e]); } \
            u32x4 wa_, wb_; wa_.x = pk2(oa_[0], oa_[1]); wa_.y = pk2(oa_[2], oa_[3]); wa_.z = pk2(oa_[4], oa_[5]); wa_.w = pk2(oa_[6], oa_[7]); \
            wb_.x = pk2(ob_[0], ob_[1]); wb_.y = pk2(ob_[2], ob_[3]); wb_.z = pk2(ob_[4], ob_[5]); wb_.w = pk2(ob_[6], ob_[7]); \
            *(u32x4*)(yrow + 8 * (tid + 512 * (j_))) = wa_; *(u32x4*)(yrow + SEQ + 8 * (tid + 512 * (j_))) = wb_; } while (0)
        HY_CONV(rowx2, r00, 0, 0, wb0, wb1, wb2, bb, xa); HY_CONV(rowx2, r01, 0, 1, wb0, wb1, wb2, bb, xb);
        HY_OUT(pq0, g00, g01, 0);
        HY_CONV(rowx2, r10, 1, 0, wb0, wb1, wb2, bb, xa); HY_CONV(rowx2, r11, 1, 1, wb0, wb1, wb2, bb, xb);
        HY_OUT(pq1, g10, g11, 1);
#undef HY_OUT
    }
#undef HY_RAW
#undef HY_CONV
    __syncthreads();
}

__device__ __forceinline__ void phase_mix(CKArgs& A, int l, LAS unsigned char* lds, int bid, int nblk, int tid) {
    for (int c = bid; c < 256; c += nblk) hyena_block(A, l, c, lds, tid);
    const int nctx = (l < DEPTH - 1) ? 12 : 0;
    const int nitems = 768 + 2 * nctx;
#pragma unroll 1
    for (int it = bid; it < nitems; it += nblk) {
        int mode, item;
        if (it < 384) { mode = 0; item = it; } else if (it < 768) { mode = 1; item = it - 384; } else if (it < 768 + nctx) { mode = 2; item = it - 768; } else { mode = 3; item = it - 768 - nctx; }
        attn_block_item(A, l, mode, item, lds, tid);
    }
}

__device__ __forceinline__ void phase_tr(CKArgs& A, int l, LAS unsigned char* lds, int bid, int nblk, int tid) {
    const int wave = __builtin_amdgcn_readfirstlane(tid >> 6), lane = tid & 63;
    const int gw = bid * 8 + wave, NGW = nblk * 8;
    unsigned char* ws = A.ws;
    const bf16_t* YBT = (const bf16_t*)((unsigned char*)A.out + OUT_YBT);
    bf16_t* Y = (bf16_t*)(ws + WS_HY);
    LAS bf16_t* scr = (LAS bf16_t*)(lds + wave * 16384);
    const int ntok = (l < DEPTH - 1) ? MTOT : MLAT;
    const int nitems = (ntok / 64) * 4;
#pragma unroll 1
    for (int it = gw; it < nitems; it += NGW) {
        const int tb = (it >> 2) * 64, cb = (it & 3) * 64;
        u32x4 ld[8];
#pragma unroll
        for (int j = 0; j < 8; ++j) { const int idx = lane + 64 * j; ld[j] = *(const u32x4*)(YBT + (size_t)(cb + (idx >> 3)) * MTOT + tb + 8 * (idx & 7)); }
#pragma unroll
        for (int j = 0; j < 8; ++j) { const int idx = lane + 64 * j, ch = idx >> 3, t8 = 8 * (idx & 7);
#pragma unroll
            for (int e = 0; e < 8; ++e) { const unsigned w = e < 2 ? ld[j].x : (e < 4 ? ld[j].y : (e < 6 ? ld[j].z : ld[j].w));
                scr[(t8 + e) * 68 + ch] = (bf16_t)((e & 1) ? (w >> 16) : (w & 0xffffu)); } }
        asm volatile("s_waitcnt lgkmcnt(0)" ::: "memory");
#pragma unroll
        for (int k = 0; k < 8; ++k) {
            const int tq = (lane >> 3) + 8 * k, cc = (lane & 7) * 8;
            const u32x2 a = *(LAS const u32x2*)(scr + tq * 68 + cc), b2 = *(LAS const u32x2*)(scr + tq * 68 + cc + 4);
            u32x4 o; o.x = a.x; o.y = a.y; o.z = b2.x; o.w = b2.y;
            *(u32x4*)(Y + (size_t)(tb + tq) * DM + 384 + cb + cc) = o;
        }
        asm volatile("s_waitcnt lgkmcnt(0)" ::: "memory");
    }
}

__device__ __forceinline__ void phase_final(CKArgs& A, int bid, int nblk, int tid) {
    const int wave = __builtin_amdgcn_readfirstlane(tid >> 6), lane = tid & 63;
    const int gw = bid * 8 + wave, NGW = nblk * 8;
    const bf16_t* xb = (const bf16_t*)(A.ws + WS_XB);
    for (int m = gw; m < MLAT; m += NGW) {
        float* row = A.out + (size_t)m * DM;
        f32x4 xv[4]; float ss = 0.f;
#pragma unroll
        for (int j = 0; j < 4; ++j) { const u32x2 w = *(const u32x2*)(xb + (size_t)m * DM + 4 * lane + 256 * j); xv[j] = (f32x4){bflo(w.x), bfhi(w.x), bflo(w.y), bfhi(w.y)};
            ss += (xv[j].x * xv[j].x + xv[j].y * xv[j].y) + (xv[j].z * xv[j].z + xv[j].w * xv[j].w); }
        const float rinv = rsqrtf(wave_sum(ss, lane) * (1.0f / DM) + 1e-6f);
#pragma unroll
        for (int j = 0; j < 4; ++j) { const int col = 4 * lane + 256 * j; const f32x4 gv = *(const f32x4*)(A.final_g + col); *(f32x4*)(row + col) = xv[j] * rinv * gv; }
    }
}

#define XB_TMO      128
#define XB_XCNT(j)  (256  + 64 * (j))
#define XB_XSUB(j)  (1280 + 64 * (j))
#define XB_XGEN(j)  (2304 + 64 * (j))
#define XB_TOP      3328
#define XB_TOPGEN   3392
#define XCD_BAR_WORDS 3456
#define XB_SPIN_CAP (1u << 18)

__device__ __forceinline__ unsigned xb_ld(unsigned* p)              { return __hip_atomic_load(p, __ATOMIC_RELAXED, __HIP_MEMORY_SCOPE_AGENT); }
__device__ __forceinline__ unsigned xb_add(unsigned* p, unsigned v) { return __hip_atomic_fetch_add(p, v, __ATOMIC_RELAXED, __HIP_MEMORY_SCOPE_AGENT); }
__device__ __forceinline__ unsigned xb_xcc_id() { return (unsigned)__builtin_amdgcn_s_getreg((3 << 11) | 20) & 0xFu; }
#define XB_SPIN(cond, bar) do { unsigned _sp = 0; while (cond) { __builtin_amdgcn_s_sleep(1); \
    if ((++_sp & 255u) == 0u) { if (xb_ld(&(bar)[XB_TMO])) break; if (_sp > XB_SPIN_CAP) { atomicAdd(&(bar)[XB_TMO], 1u); break; } } } } while (0)

struct XcdBarrier {
    unsigned* bar; unsigned x;
    volatile LAS unsigned* st;
};

__device__ __forceinline__ XcdBarrier xcd_barrier_post(unsigned* bar, volatile LAS unsigned* st) {
    XcdBarrier b; b.bar = bar; b.x = xb_xcc_id(); b.st = st;
    if (threadIdx.x == 0) (void)xb_add(&bar[XB_XCNT(b.x)], 1u);
    return b;
}
__device__ __forceinline__ void xcd_barrier_complete(unsigned* bar, unsigned x, unsigned& nloc, unsigned& nx) {
    const unsigned G = gridDim.x * gridDim.y * gridDim.z;
    unsigned sum, cnt, mine, sp = 0u;
    for (;;) {
        sum = 0u; cnt = 0u; mine = 0u;
#pragma unroll
        for (unsigned j = 0; j < 16; ++j) { const unsigned c = xb_ld(&bar[XB_XCNT(j)]); sum += c; cnt += (c > 0u) ? 1u : 0u; mine = (j == x) ? c : mine; }
        if (sum == G) break;
        __builtin_amdgcn_s_sleep(1);
        if ((++sp & 255u) == 0u) { if (xb_ld(&bar[XB_TMO])) break; if (sp > XB_SPIN_CAP) { atomicAdd(&bar[XB_TMO], 1u); break; } }
    }
    nloc = mine > 0u ? mine : 1u; nx = cnt > 0u ? cnt : 1u;
}

__device__ __forceinline__ void xcd_barrier(const XcdBarrier& b) {
    asm volatile("s_waitcnt vmcnt(0)" ::: "memory");
    __syncthreads();
    if (threadIdx.x == 0) {
        unsigned* bar = b.bar;
        __builtin_amdgcn_s_waitcnt(0);
        unsigned nloc = b.st[0], nx = b.st[1];
        if (nloc == 0u) { xcd_barrier_complete(bar, b.x, nloc, nx); b.st[0] = nloc; b.st[1] = nx; }
        const unsigned old = xb_add(&bar[XB_XSUB(b.x)], 1u);
        const unsigned gen = old / nloc;
        if (old + 1u == (gen + 1u) * nloc) {
            __builtin_amdgcn_fence(__ATOMIC_RELEASE, "agent");
            asm volatile("s_waitcnt vmcnt(0)" ::: "memory");
            const unsigned og = xb_add(&bar[XB_TOP], 1u);
            const unsigned tg = og / nx;
            if (og + 1u == (tg + 1u) * nx) xb_add(&bar[XB_TOPGEN], 1u);
            else XB_SPIN(xb_ld(&bar[XB_TOPGEN]) == tg, bar);
            __builtin_amdgcn_fence(__ATOMIC_ACQUIRE, "agent");
            xb_add(&bar[XB_XGEN(b.x)], 1u);
            asm volatile("s_waitcnt vmcnt(0)" ::: "memory");
        } else {
            XB_SPIN(xb_ld(&bar[XB_XGEN(b.x)]) == gen, bar);
            __builtin_amdgcn_fence(__ATOMIC_ACQUIRE, "agent");
            asm volatile("s_waitcnt vmcnt(0)" ::: "memory");
        }
    }
    __syncthreads();
}


constexpr int NPHASE = 2 + 5 * DEPTH;
__global__ void __launch_bounds__(NTHREADS, 2) hybrid_fwd(KArgs Aval) {
    extern __shared__ __attribute__((aligned(16))) unsigned char lds_raw[];
    LAS unsigned char* lds = (LAS unsigned char*)lds_raw;
    const int tid0 = threadIdx.x, bid = blockIdx.x, nblk = gridDim.x;
    const int wave0 = __builtin_amdgcn_readfirstlane(tid0 >> 6);
#if !MK_MULTI
    volatile LAS unsigned* bst = (volatile LAS unsigned*)(lds + AUX_OFF + 8192);
    if (tid0 < 2) bst[tid0] = 0u;
    __syncthreads();
    const XcdBarrier bar = xcd_barrier_post((unsigned*)Aval.ws, bst);
#endif
#ifndef REP_PH
#define REP_PH 1000
#endif
#pragma unroll 1
    for (int pi = Aval.ph_lo; pi < Aval.ph_hi + (REP_PH < 1000 ? 1 : 0); ++pi) {
        const int ph = pi <= REP_PH ? pi : pi - 1;
#if !MK_MULTI
        if (pi > Aval.ph_lo) { if (Aval.ph_hi > 100000) cg::this_grid().sync(); else xcd_barrier(bar); }
#endif
#ifndef ONLY
#define ONLY -1
#endif
#define EN(k) (ONLY < 0 || ((ONLY >> (k)) & 1))
        int tid; asm volatile("v_mbcnt_lo_u32_b32 %0, -1, 0\n\tv_mbcnt_hi_u32_b32 %0, -1, %0" : "=v"(tid)); tid += wave0 * 64;
        CKArgs* Ap = (CKArgs*)__builtin_amdgcn_kernarg_segment_ptr(); asm volatile("" : "+s"(Ap));
        CKArgs& A = *Ap;
        unsigned char* ws = A.ws;
        if (ph == 0) { if (EN(0)) phase_prologue(A, lds, bid, nblk, tid); }
        else if (ph == NPHASE - 1) { if (EN(6)) phase_final(A, bid, nblk, tid); }
        else {
            const int l = (ph - 1) / 5, k = (ph - 1) % 5;
            if (k == 0) { if (EN(1)) phase_norm(A, l, bid, nblk, tid); }
            else if (k == 2) { if (EN(3)) phase_mix(A, l, lds, bid, nblk, tid); }
            else if (k == 3) { if (EN(4)) phase_tr(A, l, lds, bid, nblk, tid); }
            if (k == 1 || k == 4) {
                pg8::Gemm g; EpiAll E; E.l = l; E.Ap = Ap; g.A = (const bf16_t*)(ws + WS_HY); g.K = DM;
                if (k == 1) { g.Bt = (const bf16_t*)(ws + WS_WIN) + (size_t)l * NIN * DM; g.M = MTOT; g.N = NIN; E.mode = 0; }
                else { g.Bt = (const bf16_t*)(ws + WS_WOUT) + (size_t)l * DM * DM; g.M = MLAT; g.N = DM; E.mode = 1; }
                pg8::StaticOrder S; S.init(g.M, g.N, nblk, bid);
                if (EN(2)) pg8::gemm_phase<EpiAll, pg8::StaticOrder, true, true>(lds, g, S, E, tid);
                if (k == 1) {
                    const int nu = (MTOT / 256) * (NIN / 256), nfull = nu - ((nu - 1) / nblk) * nblk;
                    if (nfull >= nblk) filt_items(A, l, tid, bid, nblk, nullptr); else if (bid >= nfull) filt_items(A, l, tid, bid - nfull, nblk - nfull, nullptr);
                }
                if (k == 4 && l < DEPTH - 1) ctx_outproj_items(A, l, tid, bid, nblk);
            }
        }
    }
}

extern "C" void kernel_launch(void* const* d_in, const int* in_sizes, int n_in, void* d_out, int out_size, void* d_ws, size_t ws_size, hipStream_t stream) {
    static int grid = 0;
    if (grid == 0) {
        if (n_in != 22 || ws_size < WS_END) { fprintf(stderr, "kernel_launch: unexpected inputs (n_in %d, ws %zu)\n", n_in, ws_size); grid = -1; return; }
        int dev = 0, cus = 0, per_cu = 0;
        if (hipGetDevice(&dev) != hipSuccess || hipDeviceGetAttribute(&cus, hipDeviceAttributeMultiprocessorCount, dev) != hipSuccess) { grid = -1; return; }
        if (hipFuncSetAttribute((const void*)hybrid_fwd, hipFuncAttributeMaxDynamicSharedMemorySize, LDS_BYTES) != hipSuccess) { fprintf(stderr, "kernel_launch: hipFuncSetAttribute failed\n"); grid = -1; return; }
        if (hipOccupancyMaxActiveBlocksPerMultiprocessor(&per_cu, (const void*)hybrid_fwd, NTHREADS, LDS_BYTES) != hipSuccess || per_cu < 1) { fprintf(stderr, "kernel_launch: occupancy query says %d\n", per_cu); per_cu = 1; }
        (void)hipGetLastError();
        grid = cus;
    }
    if (grid < 0) return;
    KArgs a{};
    a.x = (const float*)d_in[0]; a.c = (const float*)d_in[1]; a.ctx = (const float*)d_in[2]; a.c_ctx = (const float*)d_in[3]; a.norm_g = (const float*)d_in[4];
    a.w_ada = (const float*)d_in[5]; a.b_ada = (const float*)d_in[6]; a.w_in = (const float*)d_in[7]; a.w_out = (const float*)d_in[8]; a.na_rpb = (const float*)d_in[9];
    a.hy_conv_w = (const float*)d_in[10]; a.hy_conv_b = (const float*)d_in[11]; a.hy_w1 = (const float*)d_in[12]; a.hy_b1 = (const float*)d_in[13]; a.hy_freq1 = (const float*)d_in[14];
    a.hy_w2 = (const float*)d_in[15]; a.hy_b2 = (const float*)d_in[16]; a.hy_freq2 = (const float*)d_in[17]; a.hy_w3 = (const float*)d_in[18]; a.hy_d = (const float*)d_in[19];
    a.sink = (const float*)d_in[20]; a.final_g = (const float*)d_in[21];
    a.out = (float*)d_out; a.ws = (unsigned char*)d_ws;
#if MK_MULTI
    for (int ph = 0; ph < NPHASE; ++ph) {
        a.ph_lo = ph; a.ph_hi = ph + 1;
        hipLaunchKernelGGL(hybrid_fwd, dim3(grid), dim3(NTHREADS), LDS_BYTES, stream, a);
    }
#else
    if (hipMemsetAsync(d_ws, 0, 16384, stream) != hipSuccess) { fprintf(stderr, "kernel_launch: memset of the barrier words failed\n"); return; }
    a.ph_lo = 0; a.ph_hi = NPHASE;
    void* args[] = {&a};
    hipError_t e = hipLaunchCooperativeKernel((const void*)hybrid_fwd, dim3(grid), dim3(NTHREADS), args, LDS_BYTES, stream);
    if (e != hipSuccess) fprintf(stderr, "cooperative launch failed: %s (grid %d)\n", hipGetErrorString(e), grid);
#endif
}
```

```cpp
#include <hip/hip_runtime.h>
#include <hip/hip_cooperative_groups.h>
#include <cstdio>
#include <cstdint>
namespace cg = cooperative_groups;

#ifndef MK_MULTI
#define MK_MULTI 0
#endif

namespace pg8 {
#define PG8_LAS __attribute__((address_space(3)))
typedef unsigned short bf16_t;
typedef short bf16x8 __attribute__((ext_vector_type(8)));
typedef float f32x4 __attribute__((ext_vector_type(4)));
typedef unsigned u32x4 __attribute__((ext_vector_type(4)));
constexpr int BM = 256, BK = 64, HALF = 128, HTB = HALF * BK * 2  , STAGE_BYTES = 8 * HTB, NXCD = 8, WGM = 8;

__host__ __device__ __forceinline__ int lds_byte(int r, int c) { const int st = (r >> 4) * 2 + (c >> 5), rr = r & 15, cc = c & 31, ob = rr * 64 + cc * 2; return st * 1024 + (ob ^ (((ob >> 9) & 1) << 5)); }
__host__ __device__ __forceinline__ void stage_rc(int b, int& R, int& C) { const int st = b / 1024, sb = b % 1024, swz = sb ^ (((sb >> 9) & 1) << 5); R = (st >> 1) * 16 + swz / 64; C = (st & 1) * 32 + (swz % 64) / 2; }
__host__ __device__ __forceinline__ int perm32(int rho) { const int n = rho >> 4, i = rho & 15; return 8 * (i >> 2) + 4 * n + (i & 3); }

struct Unit { int pm, pn; };
struct Gemm { const bf16_t* A; const bf16_t* Bt; int M, N, K; };

struct StaticOrder {
    int nM, nN, nwg, G, c;
    __host__ __device__ void init(int M, int N, int G_, int c_) { nM = M / BM; nN = N / BM; nwg = nM * nN; G = G_; c = c_; }
    __host__ __device__ bool next(int i, Unit& u) const {
        const long L = (long)i * G + c; if (L >= nwg) return false;
        int wgid = (int)L; { const int q = nwg / NXCD, r = nwg % NXCD, xcd = wgid % NXCD, off = wgid / NXCD; wgid = (xcd < r ? xcd * (q + 1) : r * (q + 1) + (xcd - r) * q) + off; }
        const int nig = WGM * nN, gid = wgid / nig, fm = gid * WGM, gsz = (nM - fm) < WGM ? (nM - fm) : WGM;
        u.pm = fm + ((wgid % nig) % gsz); u.pn = (wgid % nig) / gsz; return true;
    }
    __device__ __forceinline__ void a_ready(const Unit&) const {}
    __device__ __forceinline__ void done(const Unit&) const {}
};

template <class Epi, class Sched, bool ALIGN_EPI = false, bool SP2 = false>
__device__ __forceinline__ void gemm_phase(PG8_LAS unsigned char* lds, const Gemm g, const Sched& S, const Epi& E, const int tid) {
    const int wid = __builtin_amdgcn_readfirstlane(tid >> 6), lane = tid & 63, wr = wid >> 2, wc = wid & 3, fr = lane & 15, fq = lane >> 4;
    const int K = g.K, nt = K / BK;
    unsigned voffA[2], voffB[2];
#pragma unroll
    for (int i = 0; i < 2; ++i) { int R, C; stage_rc(tid * 16 + i * 8192, R, C); const int Rb = Epi::PERM ? ((R & ~31) + perm32(R & 31)) : R;
        voffA[i] = (unsigned)(R * K + C) * 2u; voffB[i] = (unsigned)(Rb * K + C) * 2u; }
    const size_t kstep = (size_t)(BK * 2);
    const size_t hstep = (size_t)HALF * K * 2;
    const size_t tstep = 2 * hstep;
    const unsigned ldsw = (unsigned)wid * 1024u;
    const int aoff = lds_byte(wr * 64 + fr, fq * 8), boff = lds_byte(wc * 32 + fr, fq * 8);
#define PG8_SA(b, h) (((b) * 2 + (h)) * HTB)
#define PG8_SB(b, h) ((4 + (b) * 2 + (h)) * HTB)
#define PG8_STAGE(bufoff, gbase, voff) do { _Pragma("unroll") for (int _i = 0; _i < 2; ++_i) \
        __builtin_amdgcn_global_load_lds((const unsigned*)((const char*)(gbase) + (voff)[_i]), (PG8_LAS unsigned*)(lds + (bufoff) + ldsw + _i * 8192), 16, 0, 0); } while (0)
#define PG8_LDA(dst, b, h) do { _Pragma("unroll") for (int m = 0; m < 4; ++m) _Pragma("unroll") for (int k = 0; k < 2; ++k) dst[m][k] = *(const PG8_LAS bf16x8*)(lds + PG8_SA(b, h) + aoff + m * 2048 + k * 1024); } while (0)
#define PG8_LDB(dst, b, h) do { _Pragma("unroll") for (int n = 0; n < 2; ++n) _Pragma("unroll") for (int k = 0; k < 2; ++k) dst[n][k] = *(const PG8_LAS bf16x8*)(lds + PG8_SB(b, h) + boff + n * 2048 + k * 1024); } while (0)
#define PG8_MMA(ai, bj, At, Bt) do { __builtin_amdgcn_s_setprio(1); _Pragma("unroll") for (int m = 0; m < 4; ++m) _Pragma("unroll") for (int n = 0; n < 2; ++n) _Pragma("unroll") for (int k = 0; k < 2; ++k) \
        acc[ai][bj][m][n] = __builtin_amdgcn_mfma_f32_16x16x32_bf16(Bt[n][k], At[m][k], acc[ai][bj][m][n], 0, 0, 0); __builtin_amdgcn_s_setprio(0); } while (0)
#define PG8_WAIT_V(n) asm volatile("s_waitcnt vmcnt(" #n ")" ::: "memory")
#define PG8_WAIT_L(n) asm volatile("s_waitcnt lgkmcnt(" #n ")" ::: "memory")
#define PG8_BAR __builtin_amdgcn_s_barrier()
#define PG8_SCHED __builtin_amdgcn_sched_barrier(0)
    Unit cur, nxt; int ui = 0;
    if (!S.next(0, cur)) return;
    f32x4 acc[2][2][4][2];
#pragma unroll
    for (int a = 0; a < 2; ++a)
#pragma unroll
        for (int b = 0; b < 2; ++b)
#pragma unroll
            for (int m = 0; m < 4; ++m)
#pragma unroll
                for (int n = 0; n < 2; ++n) acc[a][b][m][n] = (f32x4){0.f, 0.f, 0.f, 0.f};
    bf16x8 At[4][2], B0[2][2], B1[2][2];
    const char* cA = (const char*)g.A + (size_t)cur.pm * tstep; const char* cB = (const char*)g.Bt + (size_t)cur.pn * tstep;
    S.a_ready(cur);
    if constexpr (SP2) {
        PG8_STAGE(PG8_SB(0, 0), cB, voffB); PG8_STAGE(PG8_SB(0, 1), cB + hstep, voffB); PG8_STAGE(PG8_SA(0, 0), cA, voffA); PG8_STAGE(PG8_SA(0, 1), cA + hstep, voffA);
        if (wr == 1) PG8_BAR;
        PG8_WAIT_V(2); PG8_BAR;
        PG8_STAGE(PG8_SB(1, 0), cB + kstep, voffB); PG8_STAGE(PG8_SA(1, 0), cA + kstep, voffA); PG8_STAGE(PG8_SB(1, 1), cB + hstep + kstep, voffB);
        PG8_WAIT_V(6); PG8_BAR;
    } else {
        PG8_STAGE(PG8_SB(0, 0), cB, voffB); PG8_STAGE(PG8_SA(0, 0), cA, voffA); PG8_STAGE(PG8_SB(0, 1), cB + hstep, voffB); PG8_STAGE(PG8_SA(0, 1), cA + hstep, voffA);
        if (wr == 1) PG8_BAR;
        PG8_WAIT_V(4); PG8_BAR;
        PG8_STAGE(PG8_SB(1, 0), cB + kstep, voffB); PG8_STAGE(PG8_SA(1, 0), cA + kstep, voffA); PG8_STAGE(PG8_SB(1, 1), cB + hstep + kstep, voffB);
        PG8_WAIT_V(6); PG8_BAR;
    }
    for (;;) {
        const bool has_next = S.next(ui + 1, nxt);
        const char* nA = has_next ? (const char*)g.A + (size_t)nxt.pm * tstep : cA; const char* nB = has_next ? (const char*)g.Bt + (size_t)nxt.pn * tstep : cB;
        for (int t = 0; t < nt; t += 2) {
            const bool last = (t == nt - 2);
            const char* a1 = cA + (size_t)(t + 1) * kstep;
            const char* a2 = last ? nA : cA + (size_t)(t + 2) * kstep; const char* b2 = last ? nB : cB + (size_t)(t + 2) * kstep;
            const char* a3 = a2 + kstep; const char* b3 = b2 + kstep;
            if (last && has_next) S.a_ready(nxt);
            if constexpr (SP2) {
            PG8_LDB(B0, 0, 0); PG8_LDB(B1, 0, 1); PG8_SCHED; PG8_LDA(At, 0, 0); PG8_STAGE(PG8_SA(1, 1), a1 + hstep, voffA);
            PG8_WAIT_V(8); PG8_WAIT_L(0); PG8_BAR; PG8_MMA(0, 0, At, B0); PG8_MMA(0, 1, At, B1); PG8_BAR; PG8_SCHED;
            PG8_LDA(At, 0, 1); PG8_STAGE(PG8_SB(0, 0), b2, voffB); PG8_STAGE(PG8_SB(0, 1), b2 + hstep, voffB); PG8_STAGE(PG8_SA(0, 0), a2, voffA);
            PG8_WAIT_V(8); PG8_WAIT_L(0); PG8_BAR; PG8_MMA(1, 0, At, B0); PG8_MMA(1, 1, At, B1); PG8_BAR; PG8_SCHED;
            PG8_LDB(B0, 1, 0); PG8_LDB(B1, 1, 1); PG8_SCHED; PG8_LDA(At, 1, 0); PG8_STAGE(PG8_SA(0, 1), a2 + hstep, voffA);
            PG8_WAIT_V(8); PG8_WAIT_L(0); PG8_BAR; PG8_MMA(0, 0, At, B0); PG8_MMA(0, 1, At, B1); PG8_BAR; PG8_SCHED;
            PG8_LDA(At, 1, 1); PG8_STAGE(PG8_SB(1, 0), b3, voffB); PG8_STAGE(PG8_SB(1, 1), b3 + hstep, voffB); PG8_STAGE(PG8_SA(1, 0), a3, voffA);
            PG8_WAIT_V(8); PG8_WAIT_L(0); PG8_BAR; PG8_MMA(1, 0, At, B0); PG8_MMA(1, 1, At, B1); PG8_BAR; PG8_SCHED;
            } else {
            PG8_LDB(B0, 0, 0); PG8_SCHED; PG8_LDA(At, 0, 0); PG8_STAGE(PG8_SA(1, 1), a1 + hstep, voffA);
            PG8_WAIT_L(8); PG8_BAR; PG8_WAIT_L(0); PG8_MMA(0, 0, At, B0); PG8_BAR; PG8_SCHED;
            PG8_LDB(B1, 0, 1); PG8_STAGE(PG8_SB(0, 0), b2, voffB);
            PG8_BAR; PG8_WAIT_L(0); PG8_MMA(0, 1, At, B1); PG8_BAR;
            PG8_LDA(At, 0, 1); PG8_STAGE(PG8_SA(0, 0), a2, voffA);
            PG8_BAR; PG8_WAIT_L(0); PG8_MMA(1, 0, At, B0); PG8_BAR; PG8_SCHED;
            PG8_STAGE(PG8_SB(0, 1), b2 + hstep, voffB);
            PG8_WAIT_V(6); PG8_BAR; PG8_MMA(1, 1, At, B1); PG8_BAR;
            PG8_LDB(B0, 1, 0); PG8_SCHED; PG8_LDA(At, 1, 0); PG8_STAGE(PG8_SA(0, 1), a2 + hstep, voffA);
            PG8_WAIT_L(8); PG8_BAR; PG8_WAIT_L(0); PG8_MMA(0, 0, At, B0); PG8_BAR; PG8_SCHED;
            PG8_LDB(B1, 1, 1); PG8_STAGE(PG8_SB(1, 0), b3, voffB);
            PG8_BAR; PG8_WAIT_L(0); PG8_MMA(0, 1, At, B1); PG8_BAR;
            PG8_LDA(At, 1, 1); PG8_STAGE(PG8_SA(1, 0), a3, voffA);
            PG8_BAR; PG8_WAIT_L(0); PG8_MMA(1, 0, At, B0); PG8_BAR; PG8_SCHED;
            PG8_STAGE(PG8_SB(1, 1), b3 + hstep, voffB);
            PG8_WAIT_V(6); PG8_BAR; PG8_MMA(1, 1, At, B1); PG8_BAR;
            }
        }
        if constexpr (ALIGN_EPI) { if (wr == 0) PG8_BAR; }
        if constexpr (!Epi::AFTER_DRAIN) { E(acc, cur, wr, wc, fr, fq); S.done(cur); }
        if (!has_next) break;
#pragma unroll
        for (int a = 0; a < 2; ++a)
#pragma unroll
            for (int b = 0; b < 2; ++b)
#pragma unroll
                for (int m = 0; m < 4; ++m)
#pragma unroll
                    for (int n = 0; n < 2; ++n) acc[a][b][m][n] = (f32x4){0.f, 0.f, 0.f, 0.f};
        cur = nxt; cA = nA; cB = nB; ++ui;
        if constexpr (ALIGN_EPI) { if (wr == 1) PG8_BAR; }
    }
    PG8_WAIT_V(0);
    if constexpr (!ALIGN_EPI) { if (wr == 0) PG8_BAR; }
    PG8_BAR;
    if constexpr (Epi::AFTER_DRAIN) { E.fused(acc, cur, wr, wc, fr, fq, lds, wid, lane); S.done(cur); }
#undef PG8_SA
#undef PG8_SB
#undef PG8_STAGE
#undef PG8_LDA
#undef PG8_LDB
#undef PG8_MMA
#undef PG8_WAIT_V
#undef PG8_WAIT_L
#undef PG8_BAR
#undef PG8_SCHED
}
}

#define LAS __attribute__((address_space(3)))
typedef unsigned short bf16_t;
typedef short bf16x8 __attribute__((ext_vector_type(8)));
typedef float f32x4 __attribute__((ext_vector_type(4)));
typedef float f32x16 __attribute__((ext_vector_type(16)));
typedef unsigned u32x2 __attribute__((ext_vector_type(2)));
typedef unsigned u32x4 __attribute__((ext_vector_type(4)));
typedef float f32x2_t __attribute__((ext_vector_type(2)));
typedef __bf16 bf16x2_t __attribute__((ext_vector_type(2)));

constexpr int DM = 1024, NBATCH = 2, SEQ = 8192, DEPTH = 4, CTXL = 256;
constexpr int MLAT = NBATCH * SEQ, MCTX = NBATCH * CTXL, MTOT = MLAT + MCTX;
constexpr int NIN = 3584, NTM = 1536, NCM = 1024, NTB = MTOT / 64;
constexpr int C_QA = 0, C_GA = 384, C_QC = 768, C_GC = 1152;
constexpr int R_HZ = 0, R_GB = 768;
constexpr int NFFT = 16384;
constexpr float LOG2E = 1.4426950408889634f;
constexpr float QK_SCALE = 0.125f * LOG2E;

constexpr size_t MiB = 1u << 20;
constexpr size_t WS_ADA = 1 * MiB;
constexpr size_t WS_ROPE = 1 * MiB + 256 * 1024;
constexpr size_t WS_H2C = 1 * MiB + 512 * 1024;
constexpr size_t WS_CX = 2 * MiB;
constexpr size_t WS_H2 = 4 * MiB;
constexpr size_t WS_WIN = 12 * MiB;
constexpr size_t WS_WOUT = 40 * MiB;
constexpr size_t WS_HY = 48 * MiB;
constexpr size_t WS_PT = 81 * MiB;
constexpr size_t WS_KH = 130 * MiB + 512 * 1024;
constexpr size_t WS_VT = 147 * MiB;
constexpr size_t WS_PCT = 163 * MiB + 512 * 1024;
constexpr size_t WS_YBT = 197 * MiB;
constexpr size_t WS_XB = 206 * MiB;
constexpr size_t OUT_ZS = 0;
constexpr size_t OUT_FILT = 32 * MiB;
constexpr size_t OUT_YBT = 48 * MiB;
constexpr size_t WS_W3T = 238 * MiB;
constexpr size_t WS_FILT = 239 * MiB;
constexpr size_t WS_END = 255 * MiB;
static_assert(WS_PT + (size_t)MTOT * NTM * 2 <= WS_KH && WS_KH + (size_t)8 * MTOT * 128 <= WS_VT && WS_VT + (size_t)8 * MTOT * 128 <= WS_PCT && WS_PCT + (size_t)NCM * MTOT * 2 <= WS_YBT, "d_ws map");

constexpr int AUX_OFF = 147456;
constexpr int LDS_BYTES = 163840;
constexpr int NTHREADS = 512;

struct KArgs {
    const float* x; const float* c; const float* ctx; const float* c_ctx; const float* norm_g; const float* w_ada; const float* b_ada;
    const float* w_in; const float* w_out; const float* na_rpb; const float* hy_conv_w; const float* hy_conv_b;
    const float* hy_w1; const float* hy_b1; const float* hy_freq1; const float* hy_w2; const float* hy_b2; const float* hy_freq2; const float* hy_w3;
    const float* hy_d; const float* sink; const float* final_g;
    float* out; unsigned char* ws;
    int ph_lo, ph_hi;
};

typedef const __attribute__((address_space(4))) KArgs CKArgs;
__device__ __forceinline__ unsigned pk2(float lo, float hi) { f32x2_t v = {lo, hi}; bf16x2_t b = __builtin_convertvector(v, bf16x2_t); return __builtin_bit_cast(unsigned, b); }
__device__ __forceinline__ float bf2f(unsigned short u) { return __uint_as_float(((unsigned)u) << 16); }
__device__ __forceinline__ float bflo(unsigned w) { return __uint_as_float(w << 16); }
__device__ __forceinline__ float bfhi(unsigned w) { return __uint_as_float(w & 0xffff0000u); }
__device__ __forceinline__ float silu_f(float x) { return x / (1.0f + __expf(-x)); }
__device__ __forceinline__ float lane_xor(float v, int lane, int m) { return __int_as_float(__builtin_amdgcn_ds_bpermute((lane ^ m) << 2, __float_as_int(v))); }
__device__ __forceinline__ float lane_prev(float v, int lane) { return __int_as_float(__builtin_amdgcn_ds_bpermute(((lane - 1) & 63) << 2, __float_as_int(v))); }
__device__ __forceinline__ float lane_next(float v, int lane) { return __int_as_float(__builtin_amdgcn_ds_bpermute(((lane + 1) & 63) << 2, __float_as_int(v))); }
__device__ __forceinline__ float wave_sum(float v, int lane) {
#pragma unroll
    for (int o = 1; o < 64; o <<= 1) v += lane_xor(v, lane, o);
    return v;
}
__device__ __forceinline__ float rdlane(float v, int l) { return __uint_as_float(__builtin_amdgcn_readlane(__float_as_uint(v), l)); }

__device__ __forceinline__ void transpose_item(const float* W, int K, int N, bf16_t* WT, int k0, int n0, int drow0, LAS float* scr, int lane, int ldk = 0) {
    if (ldk == 0) ldk = K;
#pragma unroll 8
    for (int i = 0; i < 32; ++i) { const int kk = 2 * i + (lane >> 5); scr[kk * 33 + (lane & 31)] = W[(size_t)(k0 + kk) * N + n0 + (lane & 31)]; }
    asm volatile("s_waitcnt lgkmcnt(0)" ::: "memory");
    const int c = lane & 7;
#pragma unroll
    for (int j = 0; j < 4; ++j) { const int n = (lane >> 3) + 8 * j; const LAS float* s = scr + (8 * c) * 33 + n;
        u32x4 o; o.x = pk2(s[0 * 33], s[1 * 33]); o.y = pk2(s[2 * 33], s[3 * 33]); o.z = pk2(s[4 * 33], s[5 * 33]); o.w = pk2(s[6 * 33], s[7 * 33]);
        *(u32x4*)(WT + (size_t)(drow0 + n) * ldk + k0 + 8 * c) = o; }
    asm volatile("s_waitcnt lgkmcnt(0)" ::: "memory");
}
__device__ __forceinline__ int win_row(int n0) {
    if (n0 < 384) return n0;
    if (n0 < 768) return n0 - 384 + 1536;
    if (n0 < 1152) return n0 - 768 + 2048;
    if (n0 < 1536) return n0 - 1152 + 384;
    if (n0 < 2304) return n0 - 1536 + 2560;
    if (n0 < 2560) return n0 - 2304 + 3328;
    if (n0 < 2944) return n0 - 2560 + 768;
    if (n0 < 3072) return n0 - 2944 + 1920;
    if (n0 < 3200) return n0 - 3072 + 2432;
    return n0 - 3200 + 1152;
}

__device__ __forceinline__ void phase_prologue(CKArgs& A, LAS unsigned char* lds, int bid, int nblk, int tid) {
    const int wave = __builtin_amdgcn_readfirstlane(tid >> 6), lane = tid & 63;
    const int gw = bid * 8 + wave, NGW = nblk * 8;
    unsigned char* ws = A.ws;
    {
        LAS float* scr = (LAS float*)(lds + wave * 16384);
        constexpr int I_IN = 16 * 112, I_OUT = 16 * 32, I_L = I_IN + I_OUT;
        for (int it = gw; it < DEPTH * I_L; it += NGW) {
            const int l = it / I_L; int r = it % I_L;
            if (r < I_IN) { const int kb = r / 112, nb = r % 112, n0 = nb * 32;
                transpose_item(A.w_in + (size_t)l * DM * NIN, DM, NIN, (bf16_t*)(ws + WS_WIN) + (size_t)l * NIN * DM, kb * 64, n0, win_row(n0), scr, lane); }
            else { r -= I_IN; const int kb = r / 32, nb = r % 32, n0 = nb * 32;
                transpose_item(A.w_out + (size_t)l * DM * DM, DM, DM, (bf16_t*)(ws + WS_WOUT) + (size_t)l * DM * DM, kb * 64, n0, n0, scr, lane); }
        }
    }
    {
        LAS float* scr = (LAS float*)(lds + wave * 16384);
        bf16_t* W3T = (bf16_t*)(ws + WS_W3T);
        for (int it = gw; it < DEPTH * 32; it += NGW) { const int l = it >> 5, nb = it & 31;
            transpose_item(A.hy_w3 + (size_t)l * 64 * 1024, 64, 1024, W3T + (size_t)l * 1024 * 64, 0, nb * 32, nb * 32, scr, lane); }
    }
    for (int idx = gw * 64 + lane; idx < 128 * 16; idx += NGW * 64) {
        const int p = idx >> 4, i = idx & 15;
        const float inv = powf(10000.0f, -(float)i / 16.0f);
        const float ang = (float)p * inv;
        ((float2*)(ws + WS_ROPE))[idx] = make_float2(cosf(ang), sinf(ang));
    }
    for (int it = gw; it < DEPTH * 528; it += NGW) {
        const int l = it / 528, g4 = it % 528, g = g4 >> 2, sub = g4 & 3;
        const int L = g < 128 ? SEQ : CTXL;
        const int n0 = (g < 128 ? g * 64 : (g - 128) * 64) + 16 * sub;
        float* outp = (float*)(ws + WS_H2C) + ((size_t)l * CTXL + n0) * 64;
        bf16_t* outb = (bf16_t*)(ws + WS_H2) + ((size_t)l * SEQ + n0) * 64;
        float w1c[33], w2c[64];
#pragma unroll
        for (int q = 0; q < 33; ++q) w1c[q] = A.hy_w1[((size_t)l * 33 + q) * 64 + lane];
#pragma unroll
        for (int j = 0; j < 64; ++j) w2c[j] = A.hy_w2[((size_t)l * 64 + j) * 64 + lane];
        const float b1 = A.hy_b1[l * 64 + lane], fr1 = A.hy_freq1[l * 64 + lane], b2 = A.hy_b2[l * 64 + lane], fr2 = A.hy_freq2[l * 64 + lane];
        const float tstep = 1.0f / (float)(L - 1);
        const int fj = lane == 0 ? 0 : ((lane - 1) & 15);
        const float fq = 1e-4f + (float)fj * ((15.0f - 1e-4f) / 15.0f);
#pragma unroll 1
        for (int nn = 0; nn < 16; ++nn) {
            const int n = n0 + nn;
            const float t = (float)n * tstep;
            const float rev = fq * ((float)n * (1.0f / (float)L)) + (lane <= 16 ? 0.25f : 0.5f);
            float zq = __builtin_amdgcn_sinf(rev - floorf(rev));
            if (lane == 0) zq = t; if (lane > 32) zq = 0.f;
            float a1 = b1;
#pragma unroll
            for (int q = 0; q < 33; ++q) a1 += rdlane(zq, q) * w1c[q];
            const float x1 = fr1 * a1 * 0.15915494309189535f;
            const float h1 = __builtin_amdgcn_sinf(x1 - floorf(x1));
            float a2 = b2;
#pragma unroll
            for (int j = 0; j < 64; ++j) a2 += rdlane(h1, j) * w2c[j];
            const float x2 = fr2 * a2 * 0.15915494309189535f;
            const float h2 = __builtin_amdgcn_sinf(x2 - floorf(x2));
            if (g < 128) outb[nn * 64 + lane] = (bf16_t)(pk2(h2, 0.f) & 0xffffu);
            else outp[nn * 64 + lane] = h2;
        }
    }
    __syncthreads();
    {
        LAS float* red = (LAS float*)lds;
        LAS float* sv = (LAS float*)(lds + 8192);
        for (int i = tid; i < 3 * DM; i += NTHREADS) sv[i] = silu_f(i < 2 * DM ? A.c[i] : A.c_ctx[i - 2 * DM]);
        __syncthreads();
        for (int it = bid; it < DEPTH * 48; it += nblk) {
            const int l = it / 48, n = (it % 48) * 64 + lane;
            const float* W = A.w_ada + (size_t)l * DM * 3072 + n;
            float a0 = 0.f, a1 = 0.f, a2 = 0.f;
            const int kb = wave * 128;
#pragma unroll 1
            for (int k0 = 0; k0 < 128; k0 += 16) {
                float w[16];
#pragma unroll
                for (int k = 0; k < 16; ++k) w[k] = W[(size_t)(kb + k0 + k) * 3072];
#pragma unroll
                for (int k = 0; k < 16; ++k) { a0 += sv[kb + k0 + k] * w[k]; a1 += sv[DM + kb + k0 + k] * w[k]; a2 += sv[2 * DM + kb + k0 + k] * w[k]; }
            }
            red[(wave * 3 + 0) * 64 + lane] = a0; red[(wave * 3 + 1) * 64 + lane] = a1; red[(wave * 3 + 2) * 64 + lane] = a2;
            __syncthreads();
            if (tid < 192) { const int v = tid >> 6; float sacc = A.b_ada[l * 3072 + n];
#pragma unroll
                for (int w = 0; w < 8; ++w) sacc += red[(w * 3 + v) * 64 + lane];
                ((float*)(ws + WS_ADA))[((size_t)l * 3 + v) * 3072 + n] = sacc; }
            __syncthreads();
        }
    }
}

__device__ __forceinline__ void filt_items(CKArgs& A, int lf, int tid, int bid, int nblk, unsigned* ctr) {
    unsigned char* ws = A.ws;
    const int wave = __builtin_amdgcn_readfirstlane(tid >> 6), lane = tid & 63;
    const int gw = bid * 8 + wave, NGW = nblk * 8;
    const bf16_t* H2B = (const bf16_t*)(ws + WS_H2) + (size_t)lf * SEQ * 64;
    const bf16_t* W3T = (const bf16_t*)(ws + WS_W3T) + (size_t)lf * 1024 * 64;
    bf16_t* FILT = (bf16_t*)((unsigned char*)A.out + OUT_FILT);
    const int fr = lane & 15, fq = lane >> 4;
    int it = gw;
#pragma unroll 1
    for (;;) {
        if (ctr) { unsigned t = 0; if (lane == 0) t = __hip_atomic_fetch_add(ctr, 1u, __ATOMIC_RELAXED, __HIP_MEMORY_SCOPE_AGENT); it = (int)__builtin_amdgcn_readfirstlane(t); }
        if (it >= 2048) break;
        const int n0 = (it >> 4) * 64, c0 = (it & 15) * 64;
        bf16x8 af[4][2];
#pragma unroll
        for (int j = 0; j < 4; ++j) { const bf16_t* ap = H2B + (size_t)(n0 + 16 * (fr >> 2) + 4 * j + (fr & 3)) * 64 + 8 * fq; af[j][0] = *(const bf16x8*)ap; af[j][1] = *(const bf16x8*)(ap + 32); }
#pragma unroll 1
        for (int ct = 0; ct < 4; ++ct) {
            const bf16_t* bp = W3T + (size_t)(c0 + 16 * ct + fr) * 64 + 8 * fq;
            const bf16x8 b0 = *(const bf16x8*)bp, b1 = *(const bf16x8*)(bp + 32);
            u32x4 o0, o1;
#pragma unroll
            for (int j = 0; j < 4; ++j) {
                f32x4 acc = {0.f, 0.f, 0.f, 0.f};
                acc = __builtin_amdgcn_mfma_f32_16x16x32_bf16(af[j][0], b0, acc, 0, 0, 0);
                acc = __builtin_amdgcn_mfma_f32_16x16x32_bf16(af[j][1], b1, acc, 0, 0, 0);
                const unsigned w0 = pk2(acc.x, acc.y), w1 = pk2(acc.z, acc.w);
                if (j == 0) { o0.x = w0; o0.y = w1; } else if (j == 1) { o0.z = w0; o0.w = w1; } else if (j == 2) { o1.x = w0; o1.y = w1; } else { o1.z = w0; o1.w = w1; }
            }
            bf16_t* dp = FILT + (size_t)(c0 + 16 * ct + fr) * SEQ + n0 + 16 * fq;
            *(u32x4*)dp = o0; *(u32x4*)(dp + 8) = o1;
        }
        if (!ctr) it += NGW;
    }
}

__device__ __forceinline__ void ctx_outproj_items(CKArgs& A, int l, int tid, int bid, int nblk) {
    unsigned char* ws = A.ws;
    const int wave = __builtin_amdgcn_readfirstlane(tid >> 6), lane = tid & 63;
    const int gw = bid * 8 + wave, NGW = nblk * 8;
    const bf16_t* Y = (const bf16_t*)(ws + WS_HY) + (size_t)MLAT * DM;
    const bf16_t* WT = (const bf16_t*)(ws + WS_WOUT) + (size_t)l * DM * DM;
    const float* gate = (const float*)(ws + WS_ADA) + ((size_t)l * 3 + 2) * 3072 + 2048;
    const float* csrc = l == 0 ? A.ctx : (const float*)(ws + WS_CX);
    float* cdst = (float*)(ws + WS_CX);
    const int fr = lane & 15, fq = lane >> 4;
#pragma unroll 1
    for (int it = gw; it < 2048; it += NGW) {
        const int r0 = (it >> 6) * 16, c0 = (it & 63) * 16;
        const bf16_t* ap = Y + (size_t)(r0 + fr) * DM + 8 * fq;
        const bf16_t* bp = WT + (size_t)(c0 + fr) * DM + 8 * fq;
        f32x4 acc0 = {0.f, 0.f, 0.f, 0.f}, acc1 = {0.f, 0.f, 0.f, 0.f};
#pragma unroll 1
        for (int k0 = 0; k0 < 32; k0 += 8) {
            bf16x8 a[8], b[8];
#pragma unroll
            for (int k = 0; k < 8; ++k) { a[k] = *(const bf16x8*)(ap + 32 * (k0 + k)); b[k] = *(const bf16x8*)(bp + 32 * (k0 + k)); }
#pragma unroll
            for (int k = 0; k < 8; k += 2) { acc0 = __builtin_amdgcn_mfma_f32_16x16x32_bf16(a[k], b[k], acc0, 0, 0, 0); acc1 = __builtin_amdgcn_mfma_f32_16x16x32_bf16(a[k + 1], b[k + 1], acc1, 0, 0, 0); }
        }
        const float g = gate[c0 + fr];
#pragma unroll
        for (int i = 0; i < 4; ++i) { const size_t off = (size_t)(r0 + 4 * fq + i) * DM + c0 + fr; cdst[off] = csrc[off] + g * (acc0[i] + acc1[i]); }
    }
}

__device__ __forceinline__ void norm_load_row(CKArgs& A, int l, int m, int lane, f32x4 (&xv)[4]) {
    unsigned char* ws = A.ws;
    if ((m < MLAT) && (l > 0)) {
        const bf16_t* sb = (const bf16_t*)(ws + WS_XB) + (size_t)m * DM;
#pragma unroll
        for (int j = 0; j < 4; ++j) { const u32x2 w = *(const u32x2*)(sb + 4 * lane + 256 * j); xv[j] = (f32x4){bflo(w.x), bfhi(w.x), bflo(w.y), bfhi(w.y)}; }
    } else {
        const float* src = (m < MLAT) ? A.x + (size_t)m * DM : (l == 0 ? A.ctx : (const float*)(ws + WS_CX)) + (size_t)(m - MLAT) * DM;
#pragma unroll
        for (int j = 0; j < 4; ++j) xv[j] = *(const f32x4*)(src + 4 * lane + 256 * j);
    }
}
__device__ __forceinline__ float norm_sumsq(const f32x4 (&xv)[4]) {
    float ss = 0.f;
#pragma unroll
    for (int j = 0; j < 4; ++j) ss += (xv[j].x * xv[j].x + xv[j].y * xv[j].y) + (xv[j].z * xv[j].z + xv[j].w * xv[j].w);
    return ss;
}
__device__ __forceinline__ void phase_norm(CKArgs& A, int l, int bid, int nblk, int tid) {
    const int wave = __builtin_amdgcn_readfirstlane(tid >> 6), lane = tid & 63;
    const int gw = bid * 8 + wave, NGW = nblk * 8;
    unsigned char* ws = A.ws;
    bf16_t* H = (bf16_t*)(ws + WS_HY);
    const float* ada = (const float*)(ws + WS_ADA) + (size_t)l * 3 * 3072;
    const float* g = A.norm_g + l * DM;
#pragma unroll 1
    for (int m0 = gw; m0 < MTOT; m0 += 2 * NGW) {
        const int m1 = m0 + NGW; const bool has1 = m1 < MTOT; const int m1c = has1 ? m1 : m0;
        f32x4 xa[4], xc[4];
        norm_load_row(A, l, m0, lane, xa); norm_load_row(A, l, m1c, lane, xc);
        const float* sh0 = ada + (m0 < MLAT ? m0 >> 13 : 2) * 3072; const float* sh1 = ada + (m1c < MLAT ? m1c >> 13 : 2) * 3072;
        const float ra = rsqrtf(wave_sum(norm_sumsq(xa), lane) * (1.0f / DM) + 1e-6f);
        const float rc = rsqrtf(wave_sum(norm_sumsq(xc), lane) * (1.0f / DM) + 1e-6f);
#pragma unroll
        for (int j = 0; j < 4; ++j) { const int col = 4 * lane + 256 * j;
            const f32x4 gv = *(const f32x4*)(g + col);
            { const f32x4 sc = *(const f32x4*)(sh0 + DM + col), sh = *(const f32x4*)(sh0 + col);
              const f32x4 h = xa[j] * ra * gv * (sc + 1.0f) + sh;
              u32x2 o; o.x = pk2(h.x, h.y); o.y = pk2(h.z, h.w);
              *(u32x2*)(H + (size_t)m0 * DM + col) = o; }
            if (has1) { const f32x4 sc = *(const f32x4*)(sh1 + DM + col), sh = *(const f32x4*)(sh1 + col);
              const f32x4 h = xc[j] * rc * gv * (sc + 1.0f) + sh;
              u32x2 o; o.x = pk2(h.x, h.y); o.y = pk2(h.z, h.w);
              *(u32x2*)(H + (size_t)m1 * DM + col) = o; }
        }
    }
}

struct EpiIn {
    static constexpr bool PERM = true, AFTER_DRAIN = false;
    bf16_t* PT; bf16_t* KH; bf16_t* PCT; const float2* rope;
    __device__ __forceinline__ void operator()(const f32x4 (&acc)[2][2][4][2], const pg8::Unit& u, int wr, int wc, int fr, int fq) const {
        const int row0 = u.pm * 256 + wr * 64 + fr;
        if (u.pn < 10) {
#pragma unroll
            for (int bj = 0; bj < 2; ++bj) {
                const int blk = 2 * u.pn + bj;
                const bool rp = ((blk >= 6 && blk <= 8) || blk == 15) && (u.pm < 64);
                const int col0 = 256 * u.pn + 128 * bj + 32 * wc + 8 * fq;
                bf16_t* dst; size_t ld;
                if (u.pn < 6) { dst = PT + col0; ld = NTM; }
                else { const int n2 = col0 - 1536; dst = KH + (size_t)(n2 >> 6) * MTOT * 64 + (n2 & 63); ld = 64; }
#pragma unroll
                for (int ai = 0; ai < 2; ++ai)
#pragma unroll
                    for (int m = 0; m < 4; ++m) {
                        const int r = row0 + 128 * ai + 16 * m;
                        f32x4 v0 = acc[ai][bj][m][0], v1 = acc[ai][bj][m][1];
                        if (rp) {
                            const int pos = r & (SEQ - 1);
                            const int p = (wc & 1) ? (pos & 63) : (pos >> 6);
                            const f32x4* tb = (const f32x4*)(rope + p * 16 + 8 * (fq & 1));
                            const int ln = fr + 16 * fq;
                            const float sg = (fq < 2) ? -1.0f : 1.0f;
                            { const f32x4 t0 = tb[0], t1 = tb[1];
                              const float qx = lane_xor(v0.x, ln, 32), qy = lane_xor(v0.y, ln, 32), qz = lane_xor(v0.z, ln, 32), qw = lane_xor(v0.w, ln, 32);
                              v0.x = v0.x * t0.x + sg * qx * t0.y; v0.y = v0.y * t0.z + sg * qy * t0.w; v0.z = v0.z * t1.x + sg * qz * t1.y; v0.w = v0.w * t1.z + sg * qw * t1.w; }
                            { const f32x4 t2 = tb[2], t3 = tb[3];
                              const float qx = lane_xor(v1.x, ln, 32), qy = lane_xor(v1.y, ln, 32), qz = lane_xor(v1.z, ln, 32), qw = lane_xor(v1.w, ln, 32);
                              v1.x = v1.x * t2.x + sg * qx * t2.y; v1.y = v1.y * t2.z + sg * qy * t2.w; v1.z = v1.z * t3.x + sg * qz * t3.y; v1.w = v1.w * t3.z + sg * qw * t3.w; }
                        }
                        u32x4 w; w.x = pk2(v0.x, v0.y); w.y = pk2(v0.z, v0.w); w.z = pk2(v1.x, v1.y); w.w = pk2(v1.z, v1.w);
                        *(u32x4*)(dst + (size_t)r * ld) = w;
                        asm volatile("" ::: "memory");
                    }
            }
        } else {
#pragma unroll
            for (int bj = 0; bj < 2; ++bj) {
                const int ch0 = 256 * (u.pn - 10) + 128 * bj + 32 * wc + 8 * fq;
#pragma unroll
                for (int ai = 0; ai < 2; ++ai)
#pragma unroll
                    for (int m = 0; m < 4; ++m) {
                        const int r = row0 + 128 * ai + 16 * m;
                        bf16_t* p = PCT + (size_t)ch0 * MTOT + r;
#pragma unroll
                        for (int n = 0; n < 2; ++n) {
                            const f32x4 v = acc[ai][bj][m][n];
                            bf16_t* q = p + (size_t)(4 * n) * MTOT;
                            const unsigned w0 = pk2(v.x, v.y), w1 = pk2(v.z, v.w);
                            q[0] = (bf16_t)(w0 & 0xffffu); q[MTOT] = (bf16_t)(w0 >> 16); q[2 * (size_t)MTOT] = (bf16_t)(w1 & 0xffffu); q[3 * (size_t)MTOT] = (bf16_t)(w1 >> 16);
                        }
                    }
            }
        }
    }
};
struct EpiFilt {
    static constexpr bool PERM = true, AFTER_DRAIN = false;
    bf16_t* O; int ldc;
    __device__ __forceinline__ void operator()(const f32x4 (&acc)[2][2][4][2], const pg8::Unit& u, int wr, int wc, int fr, int fq) const {
        const int row0 = u.pm * 256 + wr * 64 + fr;
#pragma unroll
        for (int bj = 0; bj < 2; ++bj) { const int col0 = 256 * u.pn + 128 * bj + 32 * wc + 8 * fq;
#pragma unroll
            for (int ai = 0; ai < 2; ++ai)
#pragma unroll
                for (int m = 0; m < 4; ++m) { const int r = row0 + 128 * ai + 16 * m; const f32x4 v0 = acc[ai][bj][m][0], v1 = acc[ai][bj][m][1];
                    u32x4 w; w.x = pk2(v0.x, v0.y); w.y = pk2(v0.z, v0.w); w.z = pk2(v1.x, v1.y); w.w = pk2(v1.z, v1.w);
                    *(u32x4*)(O + (size_t)r * ldc + col0) = w; } }
    }
};
struct EpiOut {
    static constexpr bool PERM = true, AFTER_DRAIN = false;
    const float* xsrc; bf16_t* xb; float* xdst; const float* ada; bool src32, dst32;
    __device__ __forceinline__ void operator()(const f32x4 (&acc)[2][2][4][2], const pg8::Unit& u, int wr, int wc, int fr, int fq) const {
        const int row0 = u.pm * 256 + wr * 64 + fr;
        const int v = row0 >> 13;
#pragma unroll
        for (int bj = 0; bj < 2; ++bj) {
            const int col0 = 256 * u.pn + 128 * bj + 32 * wc + 8 * fq;
            const float* gp = ada + v * 3072 + 2048 + col0;
            const f32x4 g0 = *(const f32x4*)gp, g1 = *(const f32x4*)(gp + 4);
#pragma unroll
            for (int ai = 0; ai < 2; ++ai)
#pragma unroll
              for (int mh = 0; mh < 2; ++mh) {
                f32x4 x0[2], x1[2];
                if (src32) {
#pragma unroll
                    for (int mm = 0; mm < 2; ++mm) { const float* sp = xsrc + (size_t)(row0 + 128 * ai + 16 * (2 * mh + mm)) * DM + col0; x0[mm] = *(const f32x4*)sp; x1[mm] = *(const f32x4*)(sp + 4); }
                } else {
#pragma unroll
                    for (int mm = 0; mm < 2; ++mm) { const u32x4 w = *(const u32x4*)(xb + (size_t)(row0 + 128 * ai + 16 * (2 * mh + mm)) * DM + col0);
                        x0[mm] = (f32x4){bflo(w.x), bfhi(w.x), bflo(w.y), bfhi(w.y)}; x1[mm] = (f32x4){bflo(w.z), bfhi(w.z), bflo(w.w), bfhi(w.w)}; }
                }
#pragma unroll
                for (int mm = 0; mm < 2; ++mm) { const int m = 2 * mh + mm; const size_t off = (size_t)(row0 + 128 * ai + 16 * m) * DM + col0;
                    const f32x4 y0 = x0[mm] + g0 * acc[ai][bj][m][0], y1 = x1[mm] + g1 * acc[ai][bj][m][1];
                    if (dst32) { *(f32x4*)(xdst + off) = y0; *(f32x4*)(xdst + off + 4) = y1; }
                    else { u32x4 w; w.x = pk2(y0.x, y0.y); w.y = pk2(y0.z, y0.w); w.z = pk2(y1.x, y1.y); w.w = pk2(y1.z, y1.w); *(u32x4*)(xb + off) = w; } }
                asm volatile("" ::: "memory");
              }
        }
    }
};
struct EpiAll {
    static constexpr bool PERM = true, AFTER_DRAIN = false;
    int mode, l; CKArgs* Ap;
    __device__ __forceinline__ void operator()(const f32x4 (&acc)[2][2][4][2], const pg8::Unit& u, int wr, int wc, int fr, int fq) const {
        unsigned char* ws = Ap->ws;
        if (mode == 0) { const EpiIn E{(bf16_t*)(ws + WS_PT), (bf16_t*)(ws + WS_KH), (bf16_t*)(ws + WS_PCT), (const float2*)(ws + WS_ROPE)}; E(acc, u, wr, wc, fr, fq); }
        else { const EpiOut E{Ap->x, (bf16_t*)(ws + WS_XB), Ap->out, (const float*)(ws + WS_ADA) + (size_t)l * 3 * 3072, l == 0, false}; E(acc, u, wr, wc, fr, fq); }
    }
};
__device__ __forceinline__ float max3f(float a, float b, float c) { float r; asm("v_max3_f32 %0, %1, %2, %3" : "=v"(r) : "v"(a), "v"(b), "v"(c)); return r; }
__device__ __forceinline__ float max2f(float a, float b) { float r; asm("v_max_f32_e32 %0, %1, %2" : "=v"(r) : "v"(a), "v"(b)); return r; }
__device__ __forceinline__ float max4f_mfma(float a, float b, float c, float d) { float r; asm("s_nop 15\n\ts_nop 7\n\tv_max3_f32 %0, %1, %2, %3\n\tv_max_f32_e32 %0, %0, %4" : "=&v"(r) : "v"(a), "v"(b), "v"(c), "v"(d)); return r; }
__device__ __forceinline__ void attn_tile(LAS const unsigned char* slot, int cs, const bf16x8 (&bq)[4], f32x16& o0, f32x16& o1, float& m_run, float& l_run,
                                          int r31, int hh, bool use_mask, int clo, int chi, bool use_bias, LAS const float* btab, int bidx) {
    const int kr = cs + r31;
    LAS const unsigned char* kp = slot + kr * 128;
    const int ksw = (kr >> 1) & 7;
    const bf16x8 ka0 = *(LAS const bf16x8*)(kp + 16 * ((0 + hh) ^ ksw)), ka1 = *(LAS const bf16x8*)(kp + 16 * ((2 + hh) ^ ksw));
    const bf16x8 ka2 = *(LAS const bf16x8*)(kp + 16 * ((4 + hh) ^ ksw)), ka3 = *(LAS const bf16x8*)(kp + 16 * ((6 + hh) ^ ksw));
    LAS const unsigned char* vp = slot + 8192 + r31 * 128;
    const int vsw = (r31 >> 1) & 15, g0 = (cs >> 2) + hh;
    const u32x2 a0l = *(LAS const u32x2*)(vp + 8 * ((g0) ^ vsw)), a0h = *(LAS const u32x2*)(vp + 8 * ((g0 + 2) ^ vsw));
    const u32x2 a1l = *(LAS const u32x2*)(vp + 8 * ((g0 + 4) ^ vsw)), a1h = *(LAS const u32x2*)(vp + 8 * ((g0 + 6) ^ vsw));
    const u32x2 b0l = *(LAS const u32x2*)(vp + 4096 + 8 * ((g0) ^ vsw)), b0h = *(LAS const u32x2*)(vp + 4096 + 8 * ((g0 + 2) ^ vsw));
    const u32x2 b1l = *(LAS const u32x2*)(vp + 4096 + 8 * ((g0 + 4) ^ vsw)), b1h = *(LAS const u32x2*)(vp + 4096 + 8 * ((g0 + 6) ^ vsw));
    f32x16 s, t;
#pragma unroll
    for (int i = 0; i < 16; ++i) { s[i] = 0.f; t[i] = 0.f; }
    s = __builtin_amdgcn_mfma_f32_32x32x16_bf16(ka0, bq[0], s, 0, 0, 0); t = __builtin_amdgcn_mfma_f32_32x32x16_bf16(ka1, bq[1], t, 0, 0, 0);
    s = __builtin_amdgcn_mfma_f32_32x32x16_bf16(ka2, bq[2], s, 0, 0, 0); t = __builtin_amdgcn_mfma_f32_32x32x16_bf16(ka3, bq[3], t, 0, 0, 0);
    if (use_bias) {
        LAS const float* bp = btab + bidx;
#pragma unroll
        for (int i = 0; i < 16; ++i) { const int c = (i & 3) + 8 * (i >> 2) + 4 * hh; s[i] = (s[i] + t[i]) * QK_SCALE + bp[c]; }
    } else {
#pragma unroll
        for (int i = 0; i < 16; ++i) s[i] = (s[i] + t[i]) * QK_SCALE;
    }
    if (use_mask) {
        const unsigned off = (unsigned)(4 * hh - clo), rng = (unsigned)(chi - clo);
        const bool any = chi >= clo;
#pragma unroll
        for (int i = 0; i < 16; ++i) { const unsigned c0 = (unsigned)((i & 3) + 8 * (i >> 2)); s[i] = (any && (c0 + off <= rng)) ? s[i] : -INFINITY; }
    }
    float tmax = max3f(s[0], s[1], s[2]);
#pragma unroll
    for (int i = 3; i < 15; i += 2) tmax = max3f(tmax, s[i], s[i + 1]);
    tmax = max2f(tmax, s[15]);
    tmax = max2f(tmax, lane_xor(tmax, r31 + 32 * hh, 32));
    if (__any(tmax - m_run > 8.0f)) {
        const float m_new = fmaxf(m_run, tmax);
        const float alpha = __builtin_amdgcn_exp2f(m_run - m_new);
        m_run = m_new; l_run *= alpha;
#pragma unroll
        for (int i = 0; i < 16; ++i) { o0[i] *= alpha; o1[i] *= alpha; }
    }
    float ps0 = 0.f, ps1 = 0.f;
#pragma unroll
    for (int i = 0; i < 16; i += 2) { const float p0 = __builtin_amdgcn_exp2f(s[i] - m_run), p1 = __builtin_amdgcn_exp2f(s[i + 1] - m_run); s[i] = p0; s[i + 1] = p1; ps0 += p0; ps1 += p1; }
    l_run += ps0 + ps1;
    u32x4 pw0, pw1;
    pw0.x = pk2(s[0], s[1]); pw0.y = pk2(s[2], s[3]); pw0.z = pk2(s[4], s[5]); pw0.w = pk2(s[6], s[7]);
    pw1.x = pk2(s[8], s[9]); pw1.y = pk2(s[10], s[11]); pw1.z = pk2(s[12], s[13]); pw1.w = pk2(s[14], s[15]);
    const bf16x8 pb0 = __builtin_bit_cast(bf16x8, pw0), pb1 = __builtin_bit_cast(bf16x8, pw1);
    u32x4 w;
    w.x = a0l.x; w.y = a0l.y; w.z = a0h.x; w.w = a0h.y; const bf16x8 va00 = __builtin_bit_cast(bf16x8, w);
    w.x = a1l.x; w.y = a1l.y; w.z = a1h.x; w.w = a1h.y; const bf16x8 va01 = __builtin_bit_cast(bf16x8, w);
    w.x = b0l.x; w.y = b0l.y; w.z = b0h.x; w.w = b0h.y; const bf16x8 va10 = __builtin_bit_cast(bf16x8, w);
    w.x = b1l.x; w.y = b1l.y; w.z = b1h.x; w.w = b1h.y; const bf16x8 va11 = __builtin_bit_cast(bf16x8, w);
    o0 = __builtin_amdgcn_mfma_f32_32x32x16_bf16(va00, pb0, o0, 0, 0, 0); o1 = __builtin_amdgcn_mfma_f32_32x32x16_bf16(va10, pb0, o1, 0, 0, 0);
    o0 = __builtin_amdgcn_mfma_f32_32x32x16_bf16(va01, pb1, o0, 0, 0, 0); o1 = __builtin_amdgcn_mfma_f32_32x32x16_bf16(va11, pb1, o1, 0, 0, 0);
}

__device__ __forceinline__ void attn_tile2(LAS const unsigned char* slot, const bf16x8 (&bq)[4], f32x16& o0, f32x16& o1, float& m_run, float& l_run,
                                           int r31, int hh, bool use_mask, int clo0, int chi0, int clo1, int chi1) {
    const int ksw = (r31 >> 1) & 7;
    LAS const unsigned char* kp = slot + r31 * 128;
    const bf16x8 ka0 = *(LAS const bf16x8*)(kp + 16 * ((0 + hh) ^ ksw)), ka1 = *(LAS const bf16x8*)(kp + 16 * ((2 + hh) ^ ksw));
    const bf16x8 ka2 = *(LAS const bf16x8*)(kp + 16 * ((4 + hh) ^ ksw)), ka3 = *(LAS const bf16x8*)(kp + 16 * ((6 + hh) ^ ksw));
    const bf16x8 kb0 = *(LAS const bf16x8*)(kp + 4096 + 16 * ((0 + hh) ^ ksw)), kb1 = *(LAS const bf16x8*)(kp + 4096 + 16 * ((2 + hh) ^ ksw));
    const bf16x8 kb2 = *(LAS const bf16x8*)(kp + 4096 + 16 * ((4 + hh) ^ ksw)), kb3 = *(LAS const bf16x8*)(kp + 4096 + 16 * ((6 + hh) ^ ksw));
    f32x16 s0, s1;
#pragma unroll
    for (int i = 0; i < 16; ++i) { s0[i] = 0.f; s1[i] = 0.f; }
    s0 = __builtin_amdgcn_mfma_f32_32x32x16_bf16(ka0, bq[0], s0, 0, 0, 0); s1 = __builtin_amdgcn_mfma_f32_32x32x16_bf16(kb0, bq[0], s1, 0, 0, 0);
    s0 = __builtin_amdgcn_mfma_f32_32x32x16_bf16(ka1, bq[1], s0, 0, 0, 0); s1 = __builtin_amdgcn_mfma_f32_32x32x16_bf16(kb1, bq[1], s1, 0, 0, 0);
    s0 = __builtin_amdgcn_mfma_f32_32x32x16_bf16(ka2, bq[2], s0, 0, 0, 0); s1 = __builtin_amdgcn_mfma_f32_32x32x16_bf16(kb2, bq[2], s1, 0, 0, 0);
    s0 = __builtin_amdgcn_mfma_f32_32x32x16_bf16(ka3, bq[3], s0, 0, 0, 0); s1 = __builtin_amdgcn_mfma_f32_32x32x16_bf16(kb3, bq[3], s1, 0, 0, 0);
    LAS const unsigned char* vp = slot + 8192 + r31 * 128;
    const int vsw = (r31 >> 1) & 15;
    u32x2 va[2][4][2];
#pragma unroll
    for (int db = 0; db < 2; ++db)
#pragma unroll
        for (int st = 0; st < 4; ++st) { va[db][st][0] = *(LAS const u32x2*)(vp + 4096 * db + 8 * ((4 * st + hh) ^ vsw)); va[db][st][1] = *(LAS const u32x2*)(vp + 4096 * db + 8 * ((4 * st + hh + 2) ^ vsw)); }
    if (use_mask) {
        const unsigned off0 = (unsigned)(4 * hh - clo0), rng0 = (unsigned)(chi0 - clo0), off1 = (unsigned)(4 * hh - clo1), rng1 = (unsigned)(chi1 - clo1);
#pragma unroll
        for (int i = 0; i < 16; ++i) { const unsigned c0 = (unsigned)((i & 3) + 8 * (i >> 2)); s0[i] = (c0 + off0 <= rng0) ? s0[i] : -INFINITY; s1[i] = (c0 + off1 <= rng1) ? s1[i] : -INFINITY; }
    }
    float tmax = max4f_mfma(s0[0], s0[1], s1[0], s1[1]);
#pragma unroll
    for (int i = 2; i < 16; i += 2) { tmax = max3f(tmax, s0[i], s0[i + 1]); tmax = max3f(tmax, s1[i], s1[i + 1]); }
    tmax = max2f(tmax, lane_xor(tmax, r31 + 32 * hh, 32)) * QK_SCALE;
    if (__any(tmax - m_run > 8.0f)) {
        const float m_new = fmaxf(m_run, tmax);
        const float alpha = __builtin_amdgcn_exp2f(m_run - m_new);
        m_run = m_new; l_run *= alpha;
#pragma unroll
        for (int i = 0; i < 16; ++i) { o0[i] *= alpha; o1[i] *= alpha; }
    }
    float ps0 = 0.f, ps1 = 0.f;
    const float nm = -m_run;
#pragma unroll
    for (int i = 0; i < 16; ++i) { const float p0 = __builtin_amdgcn_exp2f(fmaf(s0[i], QK_SCALE, nm)), p1 = __builtin_amdgcn_exp2f(fmaf(s1[i], QK_SCALE, nm)); s0[i] = p0; s1[i] = p1; ps0 += p0; ps1 += p1; }
    l_run += ps0 + ps1;
    u32x4 pw;
    pw.x = pk2(s0[0], s0[1]); pw.y = pk2(s0[2], s0[3]); pw.z = pk2(s0[4], s0[5]); pw.w = pk2(s0[6], s0[7]); const bf16x8 p00 = __builtin_bit_cast(bf16x8, pw);
    pw.x = pk2(s0[8], s0[9]); pw.y = pk2(s0[10], s0[11]); pw.z = pk2(s0[12], s0[13]); pw.w = pk2(s0[14], s0[15]); const bf16x8 p01 = __builtin_bit_cast(bf16x8, pw);
    pw.x = pk2(s1[0], s1[1]); pw.y = pk2(s1[2], s1[3]); pw.z = pk2(s1[4], s1[5]); pw.w = pk2(s1[6], s1[7]); const bf16x8 p10 = __builtin_bit_cast(bf16x8, pw);
    pw.x = pk2(s1[8], s1[9]); pw.y = pk2(s1[10], s1[11]); pw.z = pk2(s1[12], s1[13]); pw.w = pk2(s1[14], s1[15]); const bf16x8 p11 = __builtin_bit_cast(bf16x8, pw);
#define VA8(db_, st_) __builtin_bit_cast(bf16x8, (u32x4){va[db_][st_][0].x, va[db_][st_][0].y, va[db_][st_][1].x, va[db_][st_][1].y})
    o0 = __builtin_amdgcn_mfma_f32_32x32x16_bf16(VA8(0, 0), p00, o0, 0, 0, 0); o1 = __builtin_amdgcn_mfma_f32_32x32x16_bf16(VA8(1, 0), p00, o1, 0, 0, 0);
    o0 = __builtin_amdgcn_mfma_f32_32x32x16_bf16(VA8(0, 1), p01, o0, 0, 0, 0); o1 = __builtin_amdgcn_mfma_f32_32x32x16_bf16(VA8(1, 1), p01, o1, 0, 0, 0);
    o0 = __builtin_amdgcn_mfma_f32_32x32x16_bf16(VA8(0, 2), p10, o0, 0, 0, 0); o1 = __builtin_amdgcn_mfma_f32_32x32x16_bf16(VA8(1, 2), p10, o1, 0, 0, 0);
    o0 = __builtin_amdgcn_mfma_f32_32x32x16_bf16(VA8(0, 3), p11, o0, 0, 0, 0); o1 = __builtin_amdgcn_mfma_f32_32x32x16_bf16(VA8(1, 3), p11, o1, 0, 0, 0);
#undef VA8
}

__device__ __forceinline__ void attn_tile4(LAS const unsigned char* slotA, LAS const unsigned char* slotB, const bf16x8 (&bq)[4], f32x16& o0, f32x16& o1, float& m_run, float& l_run, int r31, int hh) {
    const int ksw = (r31 >> 1) & 7, vsw = (r31 >> 1) & 15;
    f32x16 s[4];
#pragma unroll
    for (int t = 0; t < 4; ++t)
#pragma unroll
        for (int i = 0; i < 16; ++i) s[t][i] = 0.f;
#pragma unroll
    for (int ks = 0; ks < 4; ++ks) {
        LAS const unsigned char* ka = slotA + r31 * 128 + 16 * ((2 * ks + hh) ^ ksw);
        LAS const unsigned char* kb = slotB + r31 * 128 + 16 * ((2 * ks + hh) ^ ksw);
        const bf16x8 k0 = *(LAS const bf16x8*)ka, k1 = *(LAS const bf16x8*)(ka + 4096), k2 = *(LAS const bf16x8*)kb, k3 = *(LAS const bf16x8*)(kb + 4096);
        s[0] = __builtin_amdgcn_mfma_f32_32x32x16_bf16(k0, bq[ks], s[0], 0, 0, 0); s[1] = __builtin_amdgcn_mfma_f32_32x32x16_bf16(k1, bq[ks], s[1], 0, 0, 0);
        s[2] = __builtin_amdgcn_mfma_f32_32x32x16_bf16(k2, bq[ks], s[2], 0, 0, 0); s[3] = __builtin_amdgcn_mfma_f32_32x32x16_bf16(k3, bq[ks], s[3], 0, 0, 0);
    }
    float tmax = max4f_mfma(s[0][0], s[1][0], s[2][0], s[3][0]);
#pragma unroll
    for (int i = 1; i < 16; ++i) { tmax = max3f(tmax, s[0][i], s[1][i]); tmax = max3f(tmax, s[2][i], s[3][i]); }
    tmax = max2f(tmax, lane_xor(tmax, r31 + 32 * hh, 32)) * QK_SCALE;
    if (__any(tmax - m_run > 8.0f)) {
        const float m_new = fmaxf(m_run, tmax);
        const float alpha = __builtin_amdgcn_exp2f(m_run - m_new);
        m_run = m_new; l_run *= alpha;
#pragma unroll
        for (int i = 0; i < 16; ++i) { o0[i] *= alpha; o1[i] *= alpha; }
    }
    const float nm = -m_run;
    float ps0 = 0.f, ps1 = 0.f;
#pragma unroll
    for (int t = 0; t < 4; ++t)
#pragma unroll
        for (int i = 0; i < 16; i += 2) { const float p0 = __builtin_amdgcn_exp2f(fmaf(s[t][i], QK_SCALE, nm)), p1 = __builtin_amdgcn_exp2f(fmaf(s[t][i + 1], QK_SCALE, nm)); s[t][i] = p0; s[t][i + 1] = p1; ps0 += p0; ps1 += p1; }
    l_run += ps0 + ps1;
#pragma unroll
    for (int t = 0; t < 4; ++t) {
        LAS const unsigned char* vp = (t < 2 ? slotA : slotB) + 8192 + r31 * 128;
        const int g0 = 8 * (t & 1) + hh;
        u32x4 pw;
        pw.x = pk2(s[t][0], s[t][1]); pw.y = pk2(s[t][2], s[t][3]); pw.z = pk2(s[t][4], s[t][5]); pw.w = pk2(s[t][6], s[t][7]); const bf16x8 pa = __builtin_bit_cast(bf16x8, pw);
        pw.x = pk2(s[t][8], s[t][9]); pw.y = pk2(s[t][10], s[t][11]); pw.z = pk2(s[t][12], s[t][13]); pw.w = pk2(s[t][14], s[t][15]); const bf16x8 pb = __builtin_bit_cast(bf16x8, pw);
        const u32x2 a0l = *(LAS const u32x2*)(vp + 8 * ((g0) ^ vsw)), a0h = *(LAS const u32x2*)(vp + 8 * ((g0 + 2) ^ vsw));
        const u32x2 a1l = *(LAS const u32x2*)(vp + 8 * ((g0 + 4) ^ vsw)), a1h = *(LAS const u32x2*)(vp + 8 * ((g0 + 6) ^ vsw));
        const u32x2 b0l = *(LAS const u32x2*)(vp + 4096 + 8 * ((g0) ^ vsw)), b0h = *(LAS const u32x2*)(vp + 4096 + 8 * ((g0 + 2) ^ vsw));
        const u32x2 b1l = *(LAS const u32x2*)(vp + 4096 + 8 * ((g0 + 4) ^ vsw)), b1h = *(LAS const u32x2*)(vp + 4096 + 8 * ((g0 + 6) ^ vsw));
        o0 = __builtin_amdgcn_mfma_f32_32x32x16_bf16(__builtin_bit_cast(bf16x8, (u32x4){a0l.x, a0l.y, a0h.x, a0h.y}), pa, o0, 0, 0, 0);
        o1 = __builtin_amdgcn_mfma_f32_32x32x16_bf16(__builtin_bit_cast(bf16x8, (u32x4){b0l.x, b0l.y, b0h.x, b0h.y}), pa, o1, 0, 0, 0);
        o0 = __builtin_amdgcn_mfma_f32_32x32x16_bf16(__builtin_bit_cast(bf16x8, (u32x4){a1l.x, a1l.y, a1h.x, a1h.y}), pb, o0, 0, 0, 0);
        o1 = __builtin_amdgcn_mfma_f32_32x32x16_bf16(__builtin_bit_cast(bf16x8, (u32x4){b1l.x, b1l.y, b1h.x, b1h.y}), pb, o1, 0, 0, 0);
    }
}

__device__ __forceinline__ void attn_block_item(CKArgs& A, int l, int MODE, int item, LAS unsigned char* lds, int tid) {
    asm volatile("" : "+v"(tid));
    unsigned char* ws = A.ws;
    const bf16_t* PT = (const bf16_t*)(ws + WS_PT);
    bf16_t* Y = (bf16_t*)(ws + WS_HY);
    const int wave = __builtin_amdgcn_readfirstlane(tid >> 6), lane = tid & 63;
    const int r31 = lane & 31, hh = lane >> 5;
    int b, h, qtok, qi = 0;
    int rp = 0, mg = 0, qg = 0;
    if (MODE == 0) { b = item / 192; const int rem = item % 192; h = rem >> 5; qi = rem & 31; rp = 2 * qi + (wave >> 2); mg = wave & 3;
        qtok = b * SEQ + (2 * rp + (r31 >> 4)) * 64 + 16 * mg + (r31 & 15); }
    else if (MODE == 1) { b = item / 192; const int rem = item % 192; h = rem >> 5; qi = rem & 31; qg = 8 * qi + wave; qtok = b * SEQ + 32 * qg + r31; }
    else { b = item / 6; h = item % 6; qg = wave; qtok = MLAT + b * CTXL + 32 * qg + r31; }
    const bool grpA = (MODE == 0 || MODE == 2);
    const int kvh = grpA ? h : h / 3;
    const int qcol = (grpA ? C_QA : C_QC) + h * 64, gcol = (grpA ? C_GA : C_GC) + h * 64, ycol = (grpA ? 0 : 640) + h * 64;
    const int kh = grpA ? h : 6 + kvh;
    bf16x8 bq[4];
    { const bf16_t* qp = PT + (size_t)qtok * NTM + qcol + 8 * hh;
#pragma unroll
      for (int s = 0; s < 4; ++s) bq[s] = *(const bf16x8*)(qp + 16 * s); }
    f32x16 o0, o1;
#pragma unroll
    for (int i = 0; i < 16; ++i) { o0[i] = 0.f; o1[i] = 0.f; }
    float m_run = -1e30f, l_run = 0.f;
    if (!grpA) { m_run = A.sink[l * 6 + h] * LOG2E; l_run = hh == 0 ? 1.0f : 0.f; }
    int wrow0 = 0, nwin = 0;
    if (MODE == 0) { const int a0 = min(max(4 * qi - 4, 0), 120), a1 = min(max(4 * qi - 1, 0), 120) + 7; wrow0 = a0; nwin = a1 - a0 + 1; }
    if (MODE == 1) { const int k0 = max(4 * qi - 2, 0), k1 = min(4 * qi + 5, 127); wrow0 = k0; nwin = k1 - k0 + 1; }
    const int nsteps = 4 + nwin;
    int ra = 0, rb = -1, cs = 0, rq = 0, jq = 0, r0 = 0, cmin = 0;
    LAS const float* btab = (LAS const float*)(lds + AUX_OFF + 2048);
    if (MODE == 0) { ra = min(max(2 * rp - 4, 0), 120); rb = min(max(2 * rp - 3, 0), 120) + 7; cs = min(max(16 * mg - 8, 0), 32);
        rq = 2 * rp + (r31 >> 4); jq = 16 * mg + (r31 & 15); r0 = min(max(rq - 4, 0), 120); cmin = min(max(jq - 8, 0), 48) - cs;
        }
    const int lr = tid >> 3, lc = tid & 7;
    const bf16_t* kg = (const bf16_t*)(ws + WS_KH) + (size_t)kh * MTOT * 64 + 8 * tid;
    const bf16_t* vg = (const bf16_t*)(ws + WS_VT) + (size_t)kh * MTOT * 64 + 8 * tid;
    const int kdst = lr * 128 + 16 * (lc ^ ((lr >> 1) & 7));
    const int vdstb = 8192 + (8 * lc) * 128 + 2 * (lr & 3), vg4 = lr >> 2, vs4 = (4 * lc) & 15;
#define ROW_TOK(i) ((i) < 4 ? MLAT + b * CTXL + 64 * (i) : b * SEQ + 64 * (wrow0 + (i) - 4))
#define LOAD_ROW(i, kr_, vr_) do { const int t0_ = ROW_TOK(i); kr_ = *(const u32x4*)(kg + (size_t)t0_ * 64); vr_ = *(const u32x4*)(vg + (size_t)t0_ * 64); } while (0)
#define WRITE_ROW(sl_, kr_, vr_) do { *(LAS u32x4*)((sl_) + kdst) = kr_; \
        _Pragma("unroll") for (int j_ = 0; j_ < 8; ++j_) { const unsigned w_ = j_ < 2 ? vr_.x : (j_ < 4 ? vr_.y : (j_ < 6 ? vr_.z : vr_.w)); \
            *(LAS bf16_t*)((sl_) + vdstb + j_ * 128 + 8 * (vg4 ^ ((vs4 + (j_ >> 1)) & 15))) = (bf16_t)((j_ & 1) ? (w_ >> 16) : (w_ & 0xffffu)); } } while (0)
    u32x4 k0, v0, k1, v1, k2, v2;
    LOAD_ROW(0, k0, v0); LOAD_ROW(1, k2, v2);
    __syncthreads();
    if (MODE == 0 && tid < 465) ((LAS float*)(lds + AUX_OFF + 2048))[tid] = A.na_rpb[(size_t)(l * 6 + h) * 465 + tid] * LOG2E;
    WRITE_ROW(lds, k0, v0); WRITE_ROW(lds + 16384, k2, v2);
    __syncthreads();
#pragma unroll 1
    for (int pr = 0; pr < 2; ++pr) {
        { const int ra_ = pr == 0 ? 2 : min(4, nsteps - 1), rb_ = pr == 0 ? 3 : ra_; LOAD_ROW(ra_, k0, v0); LOAD_ROW(rb_, k2, v2); }
        attn_tile4(lds, lds + 16384, bq, o0, o1, m_run, l_run, r31, hh);
        __syncthreads();
        if (pr == 0) { WRITE_ROW(lds, k0, v0); WRITE_ROW(lds + 16384, k2, v2); } else if (nsteps > 4) { WRITE_ROW(lds, k0, v0); }
        __syncthreads();
    }
#define ATT_STEP(i_, kL, vL, kW, vW) do { const int i = (i_); if (i < nsteps) { \
        LAS const unsigned char* slot = lds + (i & 1) * 16384; \
        { const int ir_ = min(i + 1, nsteps - 1); LOAD_ROW(ir_, kL, vL); }     \
        bool use2 = false, use1 = false, um = false, um1 = false, ub = false; int c1 = 0, lo0 = 0, hi0 = 31, lo1 = 0, hi1 = 31, bidx = 0; \
        if (i < 4) use2 = true; \
        else if (MODE == 0) { const int a = wrow0 + i - 4; use1 = (a >= ra) && (a <= rb); const bool rowok = (a >= r0) && (a < r0 + 8); \
            c1 = cs; lo0 = rowok ? cmin : 1; hi0 = rowok ? cmin + 15 : 0; ub = true; um1 = true; bidx = (a - rq + 7) * 31 + (cs - jq + 15); } \
        else if (MODE == 1) { const int rel0 = (64 * (wrow0 + i - 4) - (32 * qg - 128)) >> 5, rel1 = rel0 + 1;     \
            const bool a0 = (rel0 >= 0) && (rel0 <= 8), a1 = (rel1 >= 0) && (rel1 <= 8); \
            if (a0 && a1) { use2 = true; um = (rel0 == 0) || (rel1 == 8); lo0 = rel0 == 0 ? r31 : 0; hi1 = rel1 == 8 ? r31 : 31; } \
            else if (a0) { use1 = true; um1 = (rel0 == 0) || (rel0 == 8); lo0 = rel0 == 0 ? r31 : 0; hi0 = rel0 == 8 ? r31 : 31; } \
            else if (a1) { use1 = true; c1 = 32; um1 = (rel1 == 0) || (rel1 == 8); lo0 = rel1 == 0 ? r31 : 0; hi0 = rel1 == 8 ? r31 : 31; } } \
        if (use2) attn_tile2(slot, bq, o0, o1, m_run, l_run, r31, hh, um, lo0, hi0, lo1, hi1); \
        if (use1) attn_tile(slot, c1, bq, o0, o1, m_run, l_run, r31, hh, um1, lo0, hi0, ub, btab, bidx); \
        if (i + 1 < nsteps) { LAS unsigned char* nslot = lds + ((i + 1) & 1) * 16384; WRITE_ROW(nslot, kW, vW); } \
        __syncthreads(); } } while (0)
#pragma unroll 1
    for (int i3 = 4; i3 < nsteps; ++i3) {
        ATT_STEP(i3, k1, v1, k1, v1);
    }
#undef ATT_STEP
#undef LOAD_ROW
#undef WRITE_ROW
    const float ltot = l_run + lane_xor(l_run, lane, 32);
    const float inv = 1.0f / ltot;
    const bf16_t* gp = PT + (size_t)qtok * NTM + gcol + 4 * hh;
    bf16_t* yp = Y + (size_t)qtok * DM + ycol + 4 * hh;
#pragma unroll
    for (int db = 0; db < 2; ++db)
#pragma unroll
        for (int g4 = 0; g4 < 4; ++g4) {
            const int d0 = 32 * db + 8 * g4;
            const u32x2 gw = *(const u32x2*)(gp + d0);
            float v0, v1, v2, v3;
            if (db == 0) { v0 = o0[4 * g4]; v1 = o0[4 * g4 + 1]; v2 = o0[4 * g4 + 2]; v3 = o0[4 * g4 + 3]; }
            else { v0 = o1[4 * g4]; v1 = o1[4 * g4 + 1]; v2 = o1[4 * g4 + 2]; v3 = o1[4 * g4 + 3]; }
            v0 *= inv * silu_f(bflo(gw.x)); v1 *= inv * silu_f(bfhi(gw.x)); v2 *= inv * silu_f(bflo(gw.y)); v3 *= inv * silu_f(bfhi(gw.y));
            u32x2 o; o.x = pk2(v0, v1); o.y = pk2(v2, v3);
            *(u32x2*)(yp + d0) = o;
        }
}

typedef float cf2 __attribute__((ext_vector_type(2)));
__device__ __forceinline__ cf2 mk2(float x, float y) { cf2 r; r.x = x; r.y = y; return r; }
__device__ __forceinline__ cf2 cmul(cf2 a, cf2 b) { const cf2 bs = mk2(-b.y, b.x); return a.xx * b + a.yy * bs; }
#define PA(e) ((e) + (((e) >> 4) << 1))
struct cf2x4 { cf2 a, b, c, d; };
__device__ __forceinline__ cf2x4 bfly4_fwd(cf2 x0, cf2 x1, cf2 x2, cf2 x3, float a) {
    const cf2 w1 = mk2(__builtin_amdgcn_cosf(a), -__builtin_amdgcn_sinf(a));
    const cf2 w2 = cmul(w1, w1), w3 = cmul(w2, w1);
    const cf2 s02 = x0 + x2, d02 = x0 - x2, s13 = x1 + x3, d13 = x1 - x3;
    cf2x4 r;
    r.a = s02 + s13;
    r.b = cmul(s02 - s13, w2);
    r.c = cmul(mk2(d02.x + d13.y, d02.y - d13.x), w1);
    r.d = cmul(mk2(d02.x - d13.y, d02.y + d13.x), w3);
    return r;
}
__device__ __forceinline__ cf2x4 bfly4_inv(cf2 v0, cf2 v1, cf2 v2, cf2 v3, float a) {
    const cf2 w1 = mk2(__builtin_amdgcn_cosf(a), __builtin_amdgcn_sinf(a));
    const cf2 w2 = cmul(w1, w1);
    const cf2 bb = cmul(v1, w2), dd = cmul(v3, w2);
    const cf2 u0 = v0 + bb, u1 = v0 - bb, u2 = v2 + dd, u3 = v2 - dd;
    const cf2 e = cmul(u2, w1), f0 = cmul(u3, w1);
    const cf2 f = mk2(-f0.y, f0.x);
    cf2x4 r; r.a = u0 + e; r.c = u0 - e; r.b = u1 + f; r.d = u1 - f; return r;
}
__device__ __forceinline__ void fft_fwd_fused(LAS cf2* buf, int tid, int lsb, bool zero_hi = false) {
    const int sB = 1 << lsb, s = 4 << lsb;
    const float ra = 1.0f / (float)(16 << lsb), rb = 1.0f / (float)(4 << lsb);
    int poff[4][4];
#pragma unroll
    for (int a = 0; a < 4; ++a)
#pragma unroll
        for (int b = 0; b < 4; ++b) { const int off = a * s + b * sB; poff[a][b] = PA(off); }
#pragma unroll 1
    for (int gg = 0; gg < 2; ++gg) {
        const int g = tid + 512 * gg, i = g & (sB - 1), base = ((g >> lsb) << (lsb + 4)) + i;
        const int pbase = PA(base);
        cf2 x[4][4];
#pragma unroll
        for (int a = 0; a < 4; ++a)
#pragma unroll
            for (int b = 0; b < 4; ++b) x[a][b] = (zero_hi && a >= 2) ? mk2(0.f, 0.f) : buf[pbase + poff[a][b]];
#pragma unroll
        for (int b = 0; b < 4; ++b) { const cf2x4 r = bfly4_fwd(x[0][b], x[1][b], x[2][b], x[3][b], (float)(i + b * sB) * ra); x[0][b] = r.a; x[1][b] = r.b; x[2][b] = r.c; x[3][b] = r.d; }
        const float ab = (float)i * rb;
#pragma unroll
        for (int a = 0; a < 4; ++a) { const cf2x4 r = bfly4_fwd(x[a][0], x[a][1], x[a][2], x[a][3], ab); x[a][0] = r.a; x[a][1] = r.b; x[a][2] = r.c; x[a][3] = r.d; }
#pragma unroll
        for (int a = 0; a < 4; ++a)
#pragma unroll
            for (int b = 0; b < 4; ++b) buf[pbase + poff[a][b]] = x[a][b];
    }
    __syncthreads();
}
__device__ __forceinline__ void fft_inv_fused(LAS cf2* buf, int tid, int lsb) {
    const int sB = 1 << lsb, s = 4 << lsb;
    const float ra = 1.0f / (float)(16 << lsb), rb = 1.0f / (float)(4 << lsb);
    int poff[4][4];
#pragma unroll
    for (int a = 0; a < 4; ++a)
#pragma unroll
        for (int b = 0; b < 4; ++b) { const int off = a * s + b * sB; poff[a][b] = PA(off); }
#pragma unroll 1
    for (int gg = 0; gg < 2; ++gg) {
        const int g = tid + 512 * gg, i = g & (sB - 1), base = ((g >> lsb) << (lsb + 4)) + i;
        const int pbase = PA(base);
        cf2 x[4][4];
#pragma unroll
        for (int a = 0; a < 4; ++a)
#pragma unroll
            for (int b = 0; b < 4; ++b) x[a][b] = buf[pbase + poff[a][b]];
        const float ab = (float)i * rb;
#pragma unroll
        for (int a = 0; a < 4; ++a) { const cf2x4 r = bfly4_inv(x[a][0], x[a][1], x[a][2], x[a][3], ab); x[a][0] = r.a; x[a][1] = r.b; x[a][2] = r.c; x[a][3] = r.d; }
#pragma unroll
        for (int b = 0; b < 4; ++b) { const cf2x4 r = bfly4_inv(x[0][b], x[1][b], x[2][b], x[3][b], (float)(i + b * sB) * ra); x[0][b] = r.a; x[1][b] = r.b; x[2][b] = r.c; x[3][b] = r.d; }
#pragma unroll
        for (int a = 0; a < 4; ++a)
#pragma unroll
            for (int b = 0; b < 4; ++b) buf[pbase + poff[a][b]] = x[a][b];
    }
    __syncthreads();
}
__device__ __forceinline__ void fft_fwd(LAS cf2* buf, int tid, const unsigned* zk = nullptr, bool zero_hi = false) {
#pragma unroll 1
    for (int lsb = 10; lsb >= 2; lsb -= 4) fft_fwd_fused(buf, tid, lsb, zero_hi && lsb == 10);
#pragma unroll 4
    for (int k = 0; k < 8; ++k) {
        const int e0 = 4 * (tid + 512 * k), base = PA(e0);
        cf2 x0 = buf[base], x1 = buf[base + 1], x2 = buf[base + 2], x3 = buf[base + 3];
        const cf2 s02 = x0 + x2, d02 = x0 - x2, s13 = x1 + x3, d13 = x1 - x3;
        cf2 y0 = s02 + s13, y1 = s02 - s13, y2 = mk2(d02.x + d13.y, d02.y - d13.x), y3 = mk2(d02.x - d13.y, d02.y + d13.x);
        if (zk) { const u32x4 w = *(const u32x4*)(zk + (unsigned)e0);
            y0 = cmul(y0, mk2(bflo(w.x), bfhi(w.x))); y1 = cmul(y1, mk2(bflo(w.y), bfhi(w.y))); y2 = cmul(y2, mk2(bflo(w.z), bfhi(w.z))); y3 = cmul(y3, mk2(bflo(w.w), bfhi(w.w))); }
        buf[base] = y0; buf[base + 1] = y1; buf[base + 2] = y2; buf[base + 3] = y3;
    }
    __syncthreads();
}
__device__ __forceinline__ void fft_inv(LAS cf2* buf, int tid) {
#pragma unroll 1
    for (int lsb = 0; lsb <= 8; lsb += 4) fft_inv_fused(buf, tid, lsb);
#pragma unroll 4
    for (int k = 0; k < 8; ++k) {
        const int i = tid + 512 * k, pi = PA(tid) + 576 * k;
        cf2 v0 = buf[pi], v1 = buf[pi + 4608], v2 = buf[pi + 9216], v3 = buf[pi + 13824];
        const cf2x4 r = bfly4_inv(v0, v1, v2, v3, (float)i * (1.0f / 16384.0f));
        buf[pi] = r.a; buf[pi + 4608] = r.b;
    }
    __syncthreads();
}
__device__ __forceinline__ float hy_short(const bf16_t* prow, int tb, int t, int L, float w0, float w1, float w2, float bias) {
    const float pm = t > 0 ? bf2f(prow[tb + t - 1]) : 0.f;
    const float pc = bf2f(prow[tb + t]);
    const float pp = t < L - 1 ? bf2f(prow[tb + t + 1]) : 0.f;
    return w0 * pm + w1 * pc + w2 * pp + bias;
}
__device__ __forceinline__ float block_sum(float v, LAS float* red, int tid) {
    v = wave_sum(v, tid & 63);
    __syncthreads();
    if ((tid & 63) == 0) red[tid >> 6] = v;
    __syncthreads();
    float s = 0.f;
#pragma unroll
    for (int w = 0; w < 8; ++w) s += red[w];
    return s;
}

__device__ __forceinline__ void hyena_block(CKArgs& A, int l, int c, LAS unsigned char* lds, int tid) {
    asm volatile("" : "+v"(tid));
    unsigned char* ws = A.ws;
    LAS cf2* buf = (LAS cf2*)lds;
    LAS float* fs = (LAS float*)lds;
    LAS float* aux = (LAS float*)(lds + AUX_OFF);
    LAS float* red = aux + 256;
    const bf16_t* PCT = (const bf16_t*)(ws + WS_PCT);
    bf16_t* YBT = (bf16_t*)((unsigned char*)A.out + OUT_YBT);
    const bf16_t* rowz = PCT + (size_t)(R_HZ + c) * MTOT;
    const bf16_t* rowx1 = rowz + (size_t)256 * MTOT;
    const bf16_t* rowx2 = rowz + (size_t)512 * MTOT;
    const bf16_t* rowg = PCT + (size_t)(R_GB + c) * MTOT;
    const float* cw = A.hy_conv_w + (size_t)l * 3 * 768; const float* cb = A.hy_conv_b + (size_t)l * 768;
    const float wz0 = cw[c], wz1 = cw[768 + c], wz2 = cw[1536 + c], bz = cb[c];
    const float wa0 = cw[256 + c], wa1 = cw[768 + 256 + c], wa2 = cw[1536 + 256 + c], ba = cb[256 + c];
    const float wb0 = cw[512 + c], wb1 = cw[768 + 512 + c], wb2 = cw[1536 + 512 + c], bb = cb[512 + c];
    const float d0 = A.hy_d[(l * 2 + 0) * 256 + c], d1 = A.hy_d[(l * 2 + 1) * 256 + c];
    const float dmin = -3.0701134573253945f, dmax = -15.350567286626973f;
    const float delta = fabsf(dmin + (float)c * ((dmax - dmin) / 255.0f));
    __syncthreads();
    if (tid < 256) { const int k = tid >> 6, j = tid & 63; aux[tid] = A.hy_w3[((size_t)l * 64 + j) * 1024 + k * 256 + c]; }
    __syncthreads();

    if (l < DEPTH - 1) {
        float ss0 = 0.f, ss1 = 0.f;
        if (tid < 256) {
            const int n = tid; const f32x4* hr = (const f32x4*)((const float*)(ws + WS_H2C) + ((size_t)l * CTXL + n) * 64);
            float f0 = 0.f, f1 = 0.f, b0 = 0.f, b1 = 0.f;
#pragma unroll 1
            for (int j4 = 0; j4 < 16; ++j4) { const f32x4 hv = hr[j4];
#pragma unroll
                for (int e = 0; e < 4; ++e) { const float hvv = hv[e]; const int j = 4 * j4 + e; f0 += hvv * aux[j]; f1 += hvv * aux[64 + j]; b0 += hvv * aux[128 + j]; b1 += hvv * aux[192 + j]; } }
            const float e = __expf(-((float)n * (1.0f / 255.0f)) * delta);
            f0 *= e; f1 *= e; b0 *= e; b1 *= e;
            fs[255 + n] = f0; fs[512 + 255 + n] = f1;
            if (n >= 1) { fs[255 - n] = b0; fs[512 + 255 - n] = b1; }
            ss0 = f0 * f0 + (n >= 1 ? b0 * b0 : 0.f); ss1 = f1 * f1 + (n >= 1 ? b1 * b1 : 0.f);
        }
        if (tid == 0) { fs[511] = 0.f; fs[1023] = 0.f; }
        const int b = tid >> 8, t = tid & 255, tok = MLAT + b * CTXL;
        const float z = hy_short(rowz, tok, t, CTXL, wz0, wz1, wz2, bz);
        const float x1 = hy_short(rowx1, tok, t, CTXL, wa0, wa1, wa2, ba);
        const float x2 = hy_short(rowx2, tok, t, CTXL, wb0, wb1, wb2, bb);
        const float gb = bf2f(rowg[tok + t]);
        fs[1024 + tid] = z;
        const float n0 = rsqrtf(block_sum(ss0, red, tid) + 1e-6f);
        const float n1 = rsqrtf(block_sum(ss1, red, tid) + 1e-6f);
        __syncthreads();
        float y = 0.f;
        { LAS const float* kc = fs + 255 + t; LAS const float* zz = fs + 1024 + b * 256;
#pragma unroll 8
          for (int s = 0; s < 256; ++s) y += zz[s] * kc[-s]; }
        const float z1 = x1 * (y * n0 + d0 * z);
        fs[1536 + tid] = z1;
        __syncthreads();
        float y2 = 0.f;
        { LAS const float* kc = fs + 512 + 255 + t; LAS const float* zz = fs + 1536 + b * 256;
#pragma unroll 8
          for (int s = 0; s < 256; ++s) y2 += zz[s] * kc[-s]; }
        const float o = x2 * (y2 * n1 + d1 * z1) * silu_f(gb);
        YBT[(size_t)c * MTOT + tok + t] = (bf16_t)(pk2(o, 0.f) & 0xffffu);
        __syncthreads();
    }

    unsigned* ZK = (unsigned*)((unsigned char*)A.out + OUT_ZS) + (size_t)c * 2 * NFFT;
    const int lane = tid & 63;
    {
        float ss0 = 0.f, ss1 = 0.f;
        const bf16_t* F0 = (const bf16_t*)((unsigned char*)A.out + OUT_FILT) + (size_t)c * SEQ;
        u32x4 fw[2][4];
#pragma unroll
        for (int j = 0; j < 2; ++j)
#pragma unroll
            for (int r = 0; r < 4; ++r) fw[j][r] = *(const u32x4*)(F0 + (size_t)(256 * r) * SEQ + 8 * (tid + 512 * j));
#pragma unroll
        for (int j = 0; j < 2; ++j)
#pragma unroll
            for (int e8 = 0; e8 < 8; ++e8) {
                const int n = 8 * (tid + 512 * j) + e8;
                const float e = __expf(-((float)n * (1.0f / 8191.0f)) * delta);
                const unsigned w0 = e8 < 2 ? fw[j][0].x : (e8 < 4 ? fw[j][0].y : (e8 < 6 ? fw[j][0].z : fw[j][0].w)), w1 = e8 < 2 ? fw[j][1].x : (e8 < 4 ? fw[j][1].y : (e8 < 6 ? fw[j][1].z : fw[j][1].w));
                const unsigned w2 = e8 < 2 ? fw[j][2].x : (e8 < 4 ? fw[j][2].y : (e8 < 6 ? fw[j][2].z : fw[j][2].w)), w3 = e8 < 2 ? fw[j][3].x : (e8 < 4 ? fw[j][3].y : (e8 < 6 ? fw[j][3].z : fw[j][3].w));
                const float f0 = ((e8 & 1) ? bfhi(w0) : bflo(w0)) * e, f1 = ((e8 & 1) ? bfhi(w1) : bflo(w1)) * e, b0 = ((e8 & 1) ? bfhi(w2) : bflo(w2)) * e, b1 = ((e8 & 1) ? bfhi(w3) : bflo(w3)) * e;
                buf[PA(n)] = mk2(f0, f1); ss0 += f0 * f0; ss1 += f1 * f1;
                if (n >= 1) { buf[PA(NFFT - n)] = mk2(b0, b1); ss0 += b0 * b0; ss1 += b1 * b1; }
            }
        if (tid == 0) { const float zf = delta * 0.0f; buf[PA(SEQ)] = mk2(zf, zf); }
        const float nrm0 = rsqrtf(block_sum(ss0, red, tid) + 1e-6f) * (0.5f / NFFT);
        const float nrm1 = rsqrtf(block_sum(ss1, red, tid) + 1e-6f) * (0.5f / NFFT);
        __syncthreads();
        fft_fwd(buf, tid);
#pragma unroll 4
        for (int k = 0; k < 32; ++k) {
            const int p = tid + 512 * k; const int f = (int)(__brev((unsigned)p) >> 18); const int pp = (int)(__brev((unsigned)((NFFT - f) & (NFFT - 1))) >> 18);
            const cf2 za = buf[PA(p)], zb = buf[PA(pp)];
            ZK[p] = pk2((za.x + zb.x) * nrm0 + d0 * (1.0f / NFFT), (za.y - zb.y) * nrm0);
            ZK[NFFT + p] = pk2((za.y + zb.y) * nrm1 + d1 * (1.0f / NFFT), -(za.x - zb.x) * nrm1);
        }
        __syncthreads();
    }
#define HY_RAW(prow_, j_, b_) (*(const u32x4*)((prow_) + (size_t)(b_) * SEQ + 8 * (tid + 512 * (j_))))
#define HY_CONV(prow_, raw_, j_, b_, w0_, w1_, w2_, bias_, u_) do { \
        const int q_ = tid + 512 * (j_); float own_[8]; \
        own_[0] = bflo((raw_).x); own_[1] = bfhi((raw_).x); own_[2] = bflo((raw_).y); own_[3] = bfhi((raw_).y); own_[4] = bflo((raw_).z); own_[5] = bfhi((raw_).z); own_[6] = bflo((raw_).w); own_[7] = bfhi((raw_).w); \
        float pl_ = lane_prev(own_[7], lane), nl_ = lane_next(own_[0], lane); \
        if (lane == 0) pl_ = q_ > 0 ? bf2f((prow_)[(size_t)(b_) * SEQ + 8 * q_ - 1]) : 0.f; \
        if (lane == 63) nl_ = 8 * q_ + 8 < SEQ ? bf2f((prow_)[(size_t)(b_) * SEQ + 8 * q_ + 8]) : 0.f; \
        _Pragma("unroll") for (int e = 0; e < 8; ++e) (u_)[e] = (w0_) * (e > 0 ? own_[e > 0 ? e - 1 : 0] : pl_) + (w1_) * own_[e] + (w2_) * (e < 7 ? own_[e < 7 ? e + 1 : 7] : nl_) + (bias_); } while (0)
    const int pq0 = PA(8 * tid), pq1 = PA(8 * (tid + 512));
    {
        const u32x4 r00 = HY_RAW(rowz, 0, 0), r01 = HY_RAW(rowz, 0, 1), r10 = HY_RAW(rowz, 1, 0), r11 = HY_RAW(rowz, 1, 1);
        float ua[8], ub[8];
        HY_CONV(rowz, r00, 0, 0, wz0, wz1, wz2, bz, ua); HY_CONV(rowz, r01, 0, 1, wz0, wz1, wz2, bz, ub);
#pragma unroll
        for (int e = 0; e < 8; ++e) buf[pq0 + e] = mk2(ua[e], ub[e]);
        HY_CONV(rowz, r10, 1, 0, wz0, wz1, wz2, bz, ua); HY_CONV(rowz, r11, 1, 1, wz0, wz1, wz2, bz, ub);
#pragma unroll
        for (int e = 0; e < 8; ++e) buf[pq1 + e] = mk2(ua[e], ub[e]);
    }
    __syncthreads();
    fft_fwd(buf, tid, ZK, true);
    fft_inv(buf, tid);
    {
        const u32x4 r00 = HY_RAW(rowx1, 0, 0), r01 = HY_RAW(rowx1, 0, 1), r10 = HY_RAW(rowx1, 1, 0), r11 = HY_RAW(rowx1, 1, 1);
        float xa[8], xb[8];
        HY_CONV(rowx1, r00, 0, 0, wa0, wa1, wa2, ba, xa); HY_CONV(rowx1, r01, 0, 1, wa0, wa1, wa2, ba, xb);
#pragma unroll
        for (int e = 0; e < 8; ++e) { const cf2 y = buf[pq0 + e]; buf[pq0 + e] = mk2(xa[e] * y.x, xb[e] * y.y); }
        HY_CONV(rowx1, r10, 1, 0, wa0, wa1, wa2, ba, xa); HY_CONV(rowx1, r11, 1, 1, wa0, wa1, wa2, ba, xb);
#pragma unroll
        for (int e = 0; e < 8; ++e) { const cf2 y = buf[pq1 + e]; buf[pq1 + e] = mk2(xa[e] * y.x, xb[e] * y.y); }
    }
    __syncthreads();
    fft_fwd(buf, tid, ZK + NFFT, true);
    fft_inv(buf, tid);
    {
        bf16_t* yrow = YBT + (size_t)c * MTOT;
        const u32x4 r00 = HY_RAW(rowx2, 0, 0), r01 = HY_RAW(rowx2, 0, 1), r10 = HY_RAW(rowx2, 1, 0), r11 = HY_RAW(rowx2, 1, 1);
        const u32x4 g00 = HY_RAW(rowg, 0, 0), g01 = HY_RAW(rowg, 0, 1), g10 = HY_RAW(rowg, 1, 0), g11 = HY_RAW(rowg, 1, 1);
        float xa[8], xb[8];
#define HY_OUT(pq_, ga_, gb_, j_) do { float oa_[8], ob_[8]; \
            const float gaf_[8] = {bflo((ga_).x), bfhi((ga_).x), bflo((ga_).y), bfhi((ga_).y), bflo((ga_).z), bfhi((ga_).z), bflo((ga_).w), bfhi((ga_).w)}; \
            const float gbf_[8] = {bflo((gb_).x), bfhi((gb_).x), bflo((gb_).y), bfhi((gb_).y), bflo((gb_).z), bfhi((gb_).z), bflo((gb_).w), bfhi((gb_).w)}; \
            _Pragma("unroll") for (int e = 0; e < 8; ++e) { const cf2 y = buf[(pq_) + e]; oa_[e] = xa[e] * y.x * silu_f(gaf_[e]); ob_[e] = xb[e] * y.y * silu_f(gbf_[e]); } \
            u32x4 wa_, wb_; wa_.x = pk2(oa_[0], oa_[1]); wa_.y = pk2(oa_[2], oa_[3]); wa_.z = pk2(oa_[4], oa_[5]); wa_.w = pk2(oa_[6], oa_[7]); \
            wb_.x = pk2(ob_[0], ob_[1]); wb_.y = pk2(ob_[2], ob_[3]); wb_.z = pk2(ob_[4], ob_[5]); wb_.w = pk2(ob_[6], ob_[7]); \
            *(u32x4*)(yrow + 8 * (tid + 512 * (j_))) = wa_; *(u32x4*)(yrow + SEQ + 8 * (tid + 512 * (j_))) = wb_; } while (0)
        HY_CONV(rowx2, r00, 0, 0, wb0, wb1, wb2, bb, xa); HY_CONV(rowx2, r01, 0, 1, wb0, wb1, wb2, bb, xb);
        HY_OUT(pq0, g00, g01, 0);
        HY_CONV(rowx2, r10, 1, 0, wb0, wb1, wb2, bb, xa); HY_CONV(rowx2, r11, 1, 1, wb0, wb1, wb2, bb, xb);
        HY_OUT(pq1, g10, g11, 1);
#undef HY_OUT
    }
#undef HY_RAW
#undef HY_CONV
    __syncthreads();
}

__device__ __forceinline__ void phase_mix(CKArgs& A, int l, LAS unsigned char* lds, int bid, int nblk, int tid) {
    for (int c = bid; c < 256; c += nblk) hyena_block(A, l, c, lds, tid);
    const int nctx = (l < DEPTH - 1) ? 12 : 0;
    const int nitems = 768 + 2 * nctx;
#pragma unroll 1
    for (int it = bid; it < nitems; it += nblk) {
        int mode, item;
        if (it < 384) { mode = 0; item = it; } else if (it < 768) { mode = 1; item = it - 384; } else if (it < 768 + nctx) { mode = 2; item = it - 768; } else { mode = 3; item = it - 768 - nctx; }
        attn_block_item(A, l, mode, item, lds, tid);
    }
}

__device__ __forceinline__ void phase_tr(CKArgs& A, int l, LAS unsigned char* lds, int bid, int nblk, int tid) {
    const int wave = __builtin_amdgcn_readfirstlane(tid >> 6), lane = tid & 63;
    const int gw = bid * 8 + wave, NGW = nblk * 8;
    unsigned char* ws = A.ws;
    const bf16_t* YBT = (const bf16_t*)((unsigned char*)A.out + OUT_YBT);
    bf16_t* Y = (bf16_t*)(ws + WS_HY);
    LAS bf16_t* scr = (LAS bf16_t*)(lds + wave * 16384);
    const int ntok = (l < DEPTH - 1) ? MTOT : MLAT;
    const int nitems = (ntok / 64) * 4;
#pragma unroll 1
    for (int it = gw; it < nitems; it += NGW) {
        const int tb = (it >> 2) * 64, cb = (it & 3) * 64;
        u32x4 ld[8];
#pragma unroll
        for (int j = 0; j < 8; ++j) { const int idx = lane + 64 * j; ld[j] = *(const u32x4*)(YBT + (size_t)(cb + (idx >> 3)) * MTOT + tb + 8 * (idx & 7)); }
#pragma unroll
        for (int j = 0; j < 8; ++j) { const int idx = lane + 64 * j, ch = idx >> 3, t8 = 8 * (idx & 7);
#pragma unroll
            for (int e = 0; e < 8; ++e) { const unsigned w = e < 2 ? ld[j].x : (e < 4 ? ld[j].y : (e < 6 ? ld[j].z : ld[j].w));
                scr[(t8 + e) * 68 + ch] = (bf16_t)((e & 1) ? (w >> 16) : (w & 0xffffu)); } }
        asm volatile("s_waitcnt lgkmcnt(0)" ::: "memory");
#pragma unroll
        for (int k = 0; k < 8; ++k) {
            const int tq = (lane >> 3) + 8 * k, cc = (lane & 7) * 8;
            const u32x2 a = *(LAS const u32x2*)(scr + tq * 68 + cc), b2 = *(LAS const u32x2*)(scr + tq * 68 + cc + 4);
            u32x4 o; o.x = a.x; o.y = a.y; o.z = b2.x; o.w = b2.y;
            *(u32x4*)(Y + (size_t)(tb + tq) * DM + 384 + cb + cc) = o;
        }
        asm volatile("s_waitcnt lgkmcnt(0)" ::: "memory");
    }
}

__device__ __forceinline__ void phase_final(CKArgs& A, int bid, int nblk, int tid) {
    const int wave = __builtin_amdgcn_readfirstlane(tid >> 6), lane = tid & 63;
    const int gw = bid * 8 + wave, NGW = nblk * 8;
    const bf16_t* xb = (const bf16_t*)(A.ws + WS_XB);
#pragma unroll 1
    for (int m0 = gw; m0 < MLAT; m0 += 2 * NGW) {
        const int m1 = m0 + NGW; const bool has1 = m1 < MLAT; const int m1c = has1 ? m1 : m0;
        f32x4 xa[4], xc[4];
#pragma unroll
        for (int j = 0; j < 4; ++j) { const u32x2 w = *(const u32x2*)(xb + (size_t)m0 * DM + 4 * lane + 256 * j); xa[j] = (f32x4){bflo(w.x), bfhi(w.x), bflo(w.y), bfhi(w.y)}; }
#pragma unroll
        for (int j = 0; j < 4; ++j) { const u32x2 w = *(const u32x2*)(xb + (size_t)m1c * DM + 4 * lane + 256 * j); xc[j] = (f32x4){bflo(w.x), bfhi(w.x), bflo(w.y), bfhi(w.y)}; }
        const float ra = rsqrtf(wave_sum(norm_sumsq(xa), lane) * (1.0f / DM) + 1e-6f);
        const float rc = rsqrtf(wave_sum(norm_sumsq(xc), lane) * (1.0f / DM) + 1e-6f);
#pragma unroll
        for (int j = 0; j < 4; ++j) { const int col = 4 * lane + 256 * j; const f32x4 gv = *(const f32x4*)(A.final_g + col);
            *(f32x4*)(A.out + (size_t)m0 * DM + col) = xa[j] * ra * gv;
            if (has1) *(f32x4*)(A.out + (size_t)m1 * DM + col) = xc[j] * rc * gv; }
    }
}

#define XB_TMO      128
#define XB_XCNT(j)  (256  + 64 * (j))
#define XB_XSUB(j)  (1280 + 64 * (j))
#define XB_XGEN(j)  (2304 + 64 * (j))
#define XB_TOP      3328
#define XB_TOPGEN   3392
#define XCD_BAR_WORDS 3456
#define XB_SPIN_CAP (1u << 18)

__device__ __forceinline__ unsigned xb_ld(unsigned* p)              { return __hip_atomic_load(p, __ATOMIC_RELAXED, __HIP_MEMORY_SCOPE_AGENT); }
__device__ __forceinline__ unsigned xb_add(unsigned* p, unsigned v) { return __hip_atomic_fetch_add(p, v, __ATOMIC_RELAXED, __HIP_MEMORY_SCOPE_AGENT); }
__device__ __forceinline__ unsigned xb_xcc_id() { return (unsigned)__builtin_amdgcn_s_getreg((3 << 11) | 20) & 0xFu; }
#define XB_SPIN(cond, bar) do { unsigned _sp = 0; while (cond) { __builtin_amdgcn_s_sleep(1); \
    if ((++_sp & 255u) == 0u) { if (xb_ld(&(bar)[XB_TMO])) break; if (_sp > XB_SPIN_CAP) { atomicAdd(&(bar)[XB_TMO], 1u); break; } } } } while (0)

struct XcdBarrier {
    unsigned* bar; unsigned x;
    volatile LAS unsigned* st;
};

__device__ __forceinline__ XcdBarrier xcd_barrier_post(unsigned* bar, volatile LAS unsigned* st) {
    XcdBarrier b; b.bar = bar; b.x = xb_xcc_id(); b.st = st;
    if (threadIdx.x == 0) (void)xb_add(&bar[XB_XCNT(b.x)], 1u);
    return b;
}
__device__ __forceinline__ void xcd_barrier_complete(unsigned* bar, unsigned x, unsigned& nloc, unsigned& nx) {
    const unsigned G = gridDim.x * gridDim.y * gridDim.z;
    unsigned sum, cnt, mine, sp = 0u;
    for (;;) {
        sum = 0u; cnt = 0u; mine = 0u;
#pragma unroll
        for (unsigned j = 0; j < 16; ++j) { const unsigned c = xb_ld(&bar[XB_XCNT(j)]); sum += c; cnt += (c > 0u) ? 1u : 0u; mine = (j == x) ? c : mine; }
        if (sum == G) break;
        __builtin_amdgcn_s_sleep(1);
        if ((++sp & 255u) == 0u) { if (xb_ld(&bar[XB_TMO])) break; if (sp > XB_SPIN_CAP) { atomicAdd(&bar[XB_TMO], 1u); break; } }
    }
    nloc = mine > 0u ? mine : 1u; nx = cnt > 0u ? cnt : 1u;
}

__device__ __forceinline__ void xcd_barrier(const XcdBarrier& b) {
    asm volatile("s_waitcnt vmcnt(0)" ::: "memory");
    __syncthreads();
    if (threadIdx.x == 0) {
        unsigned* bar = b.bar;
        __builtin_amdgcn_s_waitcnt(0);
        unsigned nloc = b.st[0], nx = b.st[1];
        if (nloc == 0u) { xcd_barrier_complete(bar, b.x, nloc, nx); b.st[0] = nloc; b.st[1] = nx; }
        const unsigned old = xb_add(&bar[XB_XSUB(b.x)], 1u);
        const unsigned gen = old / nloc;
        if (old + 1u == (gen + 1u) * nloc) {
            __builtin_amdgcn_fence(__ATOMIC_RELEASE, "agent");
            asm volatile("s_waitcnt vmcnt(0)" ::: "memory");
            const unsigned og = xb_add(&bar[XB_TOP], 1u);
            const unsigned tg = og / nx;
            if (og + 1u == (tg + 1u) * nx) xb_add(&bar[XB_TOPGEN], 1u);
            else XB_SPIN(xb_ld(&bar[XB_TOPGEN]) == tg, bar);
            __builtin_amdgcn_fence(__ATOMIC_ACQUIRE, "agent");
            xb_add(&bar[XB_XGEN(b.x)], 1u);
            asm volatile("s_waitcnt vmcnt(0)" ::: "memory");
        } else {
            XB_SPIN(xb_ld(&bar[XB_XGEN(b.x)]) == gen, bar);
            __builtin_amdgcn_fence(__ATOMIC_ACQUIRE, "agent");
            asm volatile("s_waitcnt vmcnt(0)" ::: "memory");
        }
    }
    __syncthreads();
}


constexpr int NPHASE = 2 + 5 * DEPTH;
__global__ void __launch_bounds__(NTHREADS, 2) hybrid_fwd(KArgs Aval) {
    extern __shared__ __attribute__((aligned(16))) unsigned char lds_raw[];
    LAS unsigned char* lds = (LAS unsigned char*)lds_raw;
    const int tid0 = threadIdx.x, bid = blockIdx.x, nblk = gridDim.x;
    const int wave0 = __builtin_amdgcn_readfirstlane(tid0 >> 6);
#if !MK_MULTI
    volatile LAS unsigned* bst = (volatile LAS unsigned*)(lds + AUX_OFF + 8192);
    if (tid0 < 2) bst[tid0] = 0u;
    __syncthreads();
    const XcdBarrier bar = xcd_barrier_post((unsigned*)Aval.ws, bst);
#endif
#ifndef REP_PH
#define REP_PH 1000
#endif
#pragma unroll 1
    for (int pi = Aval.ph_lo; pi < Aval.ph_hi + (REP_PH < 1000 ? 1 : 0); ++pi) {
        const int ph = pi <= REP_PH ? pi : pi - 1;
#if !MK_MULTI
        if (pi > Aval.ph_lo) { if (Aval.ph_hi > 100000) cg::this_grid().sync(); else xcd_barrier(bar); }
#endif
#ifndef ONLY
#define ONLY -1
#endif
#define EN(k) (ONLY < 0 || ((ONLY >> (k)) & 1))
        int tid; asm volatile("v_mbcnt_lo_u32_b32 %0, -1, 0\n\tv_mbcnt_hi_u32_b32 %0, -1, %0" : "=v"(tid)); tid += wave0 * 64;
        CKArgs* Ap = (CKArgs*)__builtin_amdgcn_kernarg_segment_ptr(); asm volatile("" : "+s"(Ap));
        CKArgs& A = *Ap;
        unsigned char* ws = A.ws;
        if (ph == 0) { if (EN(0)) phase_prologue(A, lds, bid, nblk, tid); }
        else if (ph == NPHASE - 1) { if (EN(6)) phase_final(A, bid, nblk, tid); }
        else {
            const int l = (ph - 1) / 5, k = (ph - 1) % 5;
            if (k == 0) { if (EN(1)) phase_norm(A, l, bid, nblk, tid); }
            else if (k == 2) { if (EN(3)) phase_mix(A, l, lds, bid, nblk, tid); }
            else if (k == 3) { if (EN(4)) phase_tr(A, l, lds, bid, nblk, tid); }
            if (k == 1 || k == 4) {
                pg8::Gemm g; EpiAll E; E.l = l; E.Ap = Ap; g.A = (const bf16_t*)(ws + WS_HY); g.K = DM;
                if (k == 1) { g.Bt = (const bf16_t*)(ws + WS_WIN) + (size_t)l * NIN * DM; g.M = MTOT; g.N = NIN; E.mode = 0; }
                else { g.Bt = (const bf16_t*)(ws + WS_WOUT) + (size_t)l * DM * DM; g.M = MLAT; g.N = DM; E.mode = 1; }
                pg8::StaticOrder S; S.init(g.M, g.N, nblk, bid);
                if (EN(2)) pg8::gemm_phase<EpiAll, pg8::StaticOrder, true, true>(lds, g, S, E, tid);
                if (k == 1) {
                    const int nu = (MTOT / 256) * (NIN / 256), nfull = nu - ((nu - 1) / nblk) * nblk;
                    if (nfull >= nblk) filt_items(A, l, tid, bid, nblk, nullptr); else if (bid >= nfull) filt_items(A, l, tid, bid - nfull, nblk - nfull, nullptr);
                }
                if (k == 4 && l < DEPTH - 1) ctx_outproj_items(A, l, tid, bid, nblk);
            }
        }
    }
}

extern "C" void kernel_launch(void* const* d_in, const int* in_sizes, int n_in, void* d_out, int out_size, void* d_ws, size_t ws_size, hipStream_t stream) {
    static int grid = 0;
    if (grid == 0) {
        if (n_in != 22 || ws_size < WS_END) { fprintf(stderr, "kernel_launch: unexpected inputs (n_in %d, ws %zu)\n", n_in, ws_size); grid = -1; return; }
        int dev = 0, cus = 0, per_cu = 0;
        if (hipGetDevice(&dev) != hipSuccess || hipDeviceGetAttribute(&cus, hipDeviceAttributeMultiprocessorCount, dev) != hipSuccess) { grid = -1; return; }
        if (hipFuncSetAttribute((const void*)hybrid_fwd, hipFuncAttributeMaxDynamicSharedMemorySize, LDS_BYTES) != hipSuccess) { fprintf(stderr, "kernel_launch: hipFuncSetAttribute failed\n"); grid = -1; return; }
        if (hipOccupancyMaxActiveBlocksPerMultiprocessor(&per_cu, (const void*)hybrid_fwd, NTHREADS, LDS_BYTES) != hipSuccess || per_cu < 1) { fprintf(stderr, "kernel_launch: occupancy query says %d\n", per_cu); per_cu = 1; }
        (void)hipGetLastError();
        grid = cus;
    }
    if (grid < 0) return;
    KArgs a{};
    a.x = (const float*)d_in[0]; a.c = (const float*)d_in[1]; a.ctx = (const float*)d_in[2]; a.c_ctx = (const float*)d_in[3]; a.norm_g = (const float*)d_in[4];
    a.w_ada = (const float*)d_in[5]; a.b_ada = (const float*)d_in[6]; a.w_in = (const float*)d_in[7]; a.w_out = (const float*)d_in[8]; a.na_rpb = (const float*)d_in[9];
    a.hy_conv_w = (const float*)d_in[10]; a.hy_conv_b = (const float*)d_in[11]; a.hy_w1 = (const float*)d_in[12]; a.hy_b1 = (const float*)d_in[13]; a.hy_freq1 = (const float*)d_in[14];
    a.hy_w2 = (const float*)d_in[15]; a.hy_b2 = (const float*)d_in[16]; a.hy_freq2 = (const float*)d_in[17]; a.hy_w3 = (const float*)d_in[18]; a.hy_d = (const float*)d_in[19];
    a.sink = (const float*)d_in[20]; a.final_g = (const float*)d_in[21];
    a.out = (float*)d_out; a.ws = (unsigned char*)d_ws;
#if MK_MULTI
    for (int ph = 0; ph < NPHASE; ++ph) {
        a.ph_lo = ph; a.ph_hi = ph + 1;
        hipLaunchKernelGGL(hybrid_fwd, dim3(grid), dim3(NTHREADS), LDS_BYTES, stream, a);
    }
#else
    if (hipMemsetAsync(d_ws, 0, 16384, stream) != hipSuccess) { fprintf(stderr, "kernel_launch: memset of the barrier words failed\n"); return; }
    a.ph_lo = 0; a.ph_hi = NPHASE;
    void* args[] = {&a};
    hipError_t e = hipLaunchCooperativeKernel((const void*)hybrid_fwd, dim3(grid), dim3(NTHREADS), args, LDS_BYTES, stream);
    if (e != hipSuccess) fprintf(stderr, "cooperative launch failed: %s (grid %d)\n", hipGetErrorString(e), grid);
#endif
}
```

```cpp
#include <hip/hip_runtime.h>
#include <hip/hip_cooperative_groups.h>
#include <cstdio>
#include <cstdint>
namespace cg = cooperative_groups;

#ifndef MK_MULTI
#define MK_MULTI 0
#endif

namespace pg8 {
#define PG8_LAS __attribute__((address_space(3)))
typedef unsigned short bf16_t;
typedef short bf16x8 __attribute__((ext_vector_type(8)));
typedef float f32x4 __attribute__((ext_vector_type(4)));
typedef unsigned u32x4 __attribute__((ext_vector_type(4)));
constexpr int BM = 256, BK = 64, HALF = 128, HTB = HALF * BK * 2  , STAGE_BYTES = 8 * HTB, NXCD = 8, WGM = 8;

__host__ __device__ __forceinline__ int lds_byte(int r, int c) { const int st = (r >> 4) * 2 + (c >> 5), rr = r & 15, cc = c & 31, ob = rr * 64 + cc * 2; return st * 1024 + (ob ^ (((ob >> 9) & 1) << 5)); }
__host__ __device__ __forceinline__ void stage_rc(int b, int& R, int& C) { const int st = b / 1024, sb = b % 1024, swz = sb ^ (((sb >> 9) & 1) << 5); R = (st >> 1) * 16 + swz / 64; C = (st & 1) * 32 + (swz % 64) / 2; }
__host__ __device__ __forceinline__ int perm32(int rho) { const int n = rho >> 4, i = rho & 15; return 8 * (i >> 2) + 4 * n + (i & 3); }

struct Unit { int pm, pn; };
struct Gemm { const bf16_t* A; const bf16_t* Bt; int M, N, K; };

struct StaticOrder {
    int nM, nN, nwg, G, c;
    __host__ __device__ void init(int M, int N, int G_, int c_) { nM = M / BM; nN = N / BM; nwg = nM * nN; G = G_; c = c_; }
    __host__ __device__ bool next(int i, Unit& u) const {
        const long L = (long)i * G + c; if (L >= nwg) return false;
        int wgid = (int)L; { const int q = nwg / NXCD, r = nwg % NXCD, xcd = wgid % NXCD, off = wgid / NXCD; wgid = (xcd < r ? xcd * (q + 1) : r * (q + 1) + (xcd - r) * q) + off; }
        const int nig = WGM * nN, gid = wgid / nig, fm = gid * WGM, gsz = (nM - fm) < WGM ? (nM - fm) : WGM;
        u.pm = fm + ((wgid % nig) % gsz); u.pn = (wgid % nig) / gsz; return true;
    }
    __device__ __forceinline__ void a_ready(const Unit&) const {}
    __device__ __forceinline__ void done(const Unit&) const {}
};

template <class Epi, class Sched, bool ALIGN_EPI = false, bool SP2 = false>
__device__ __forceinline__ void gemm_phase(PG8_LAS unsigned char* lds, const Gemm g, const Sched& S, const Epi& E, const int tid) {
    const int wid = __builtin_amdgcn_readfirstlane(tid >> 6), lane = tid & 63, wr = wid >> 2, wc = wid & 3, fr = lane & 15, fq = lane >> 4;
    const int K = g.K, nt = K / BK;
    unsigned voffA[2], voffB[2];
#pragma unroll
    for (int i = 0; i < 2; ++i) { int R, C; stage_rc(tid * 16 + i * 8192, R, C); const int Rb = Epi::PERM ? ((R & ~31) + perm32(R & 31)) : R;
        voffA[i] = (unsigned)(R * K + C) * 2u; voffB[i] = (unsigned)(Rb * K + C) * 2u; }
    const size_t kstep = (size_t)(BK * 2);
    const size_t hstep = (size_t)HALF * K * 2;
    const size_t tstep = 2 * hstep;
    const unsigned ldsw = (unsigned)wid * 1024u;
    const int aoff = lds_byte(wr * 64 + fr, fq * 8), boff = lds_byte(wc * 32 + fr, fq * 8);
#define PG8_SA(b, h) (((b) * 2 + (h)) * HTB)
#define PG8_SB(b, h) ((4 + (b) * 2 + (h)) * HTB)
#define PG8_STAGE(bufoff, gbase, voff) do { _Pragma("unroll") for (int _i = 0; _i < 2; ++_i) \
        __builtin_amdgcn_global_load_lds((const unsigned*)((const char*)(gbase) + (voff)[_i]), (PG8_LAS unsigned*)(lds + (bufoff) + ldsw + _i * 8192), 16, 0, 0); } while (0)
#define PG8_LDA(dst, b, h) do { _Pragma("unroll") for (int m = 0; m < 4; ++m) _Pragma("unroll") for (int k = 0; k < 2; ++k) dst[m][k] = *(const PG8_LAS bf16x8*)(lds + PG8_SA(b, h) + aoff + m * 2048 + k * 1024); } while (0)
#define PG8_LDB(dst, b, h) do { _Pragma("unroll") for (int n = 0; n < 2; ++n) _Pragma("unroll") for (int k = 0; k < 2; ++k) dst[n][k] = *(const PG8_LAS bf16x8*)(lds + PG8_SB(b, h) + boff + n * 2048 + k * 1024); } while (0)
#define PG8_MMA(ai, bj, At, Bt) do { __builtin_amdgcn_s_setprio(1); _Pragma("unroll") for (int m = 0; m < 4; ++m) _Pragma("unroll") for (int n = 0; n < 2; ++n) _Pragma("unroll") for (int k = 0; k < 2; ++k) \
        acc[ai][bj][m][n] = __builtin_amdgcn_mfma_f32_16x16x32_bf16(Bt[n][k], At[m][k], acc[ai][bj][m][n], 0, 0, 0); __builtin_amdgcn_s_setprio(0); } while (0)
#define PG8_WAIT_V(n) asm volatile("s_waitcnt vmcnt(" #n ")" ::: "memory")
#define PG8_WAIT_L(n) asm volatile("s_waitcnt lgkmcnt(" #n ")" ::: "memory")
#define PG8_BAR __builtin_amdgcn_s_barrier()
#define PG8_SCHED __builtin_amdgcn_sched_barrier(0)
    Unit cur, nxt; int ui = 0;
    if (!S.next(0, cur)) return;
    f32x4 acc[2][2][4][2];
#pragma unroll
    for (int a = 0; a < 2; ++a)
#pragma unroll
        for (int b = 0; b < 2; ++b)
#pragma unroll
            for (int m = 0; m < 4; ++m)
#pragma unroll
                for (int n = 0; n < 2; ++n) acc[a][b][m][n] = (f32x4){0.f, 0.f, 0.f, 0.f};
    bf16x8 At[4][2], B0[2][2], B1[2][2];
    const char* cA = (const char*)g.A + (size_t)cur.pm * tstep; const char* cB = (const char*)g.Bt + (size_t)cur.pn * tstep;
    S.a_ready(cur);
    if constexpr (SP2) {
        PG8_STAGE(PG8_SB(0, 0), cB, voffB); PG8_STAGE(PG8_SB(0, 1), cB + hstep, voffB); PG8_STAGE(PG8_SA(0, 0), cA, voffA); PG8_STAGE(PG8_SA(0, 1), cA + hstep, voffA);
        if (wr == 1) PG8_BAR;
        PG8_WAIT_V(2); PG8_BAR;
        PG8_STAGE(PG8_SB(1, 0), cB + kstep, voffB); PG8_STAGE(PG8_SA(1, 0), cA + kstep, voffA); PG8_STAGE(PG8_SB(1, 1), cB + hstep + kstep, voffB);
        PG8_WAIT_V(6); PG8_BAR;
    } else {
        PG8_STAGE(PG8_SB(0, 0), cB, voffB); PG8_STAGE(PG8_SA(0, 0), cA, voffA); PG8_STAGE(PG8_SB(0, 1), cB + hstep, voffB); PG8_STAGE(PG8_SA(0, 1), cA + hstep, voffA);
        if (wr == 1) PG8_BAR;
        PG8_WAIT_V(4); PG8_BAR;
        PG8_STAGE(PG8_SB(1, 0), cB + kstep, voffB); PG8_STAGE(PG8_SA(1, 0), cA + kstep, voffA); PG8_STAGE(PG8_SB(1, 1), cB + hstep + kstep, voffB);
        PG8_WAIT_V(6); PG8_BAR;
    }
    for (;;) {
        const bool has_next = S.next(ui + 1, nxt);
        const char* nA = has_next ? (const char*)g.A + (size_t)nxt.pm * tstep : cA; const char* nB = has_next ? (const char*)g.Bt + (size_t)nxt.pn * tstep : cB;
        for (int t = 0; t < nt; t += 2) {
            const bool last = (t == nt - 2);
            const char* a1 = cA + (size_t)(t + 1) * kstep;
            const char* a2 = last ? nA : cA + (size_t)(t + 2) * kstep; const char* b2 = last ? nB : cB + (size_t)(t + 2) * kstep;
            const char* a3 = a2 + kstep; const char* b3 = b2 + kstep;
            if (last && has_next) S.a_ready(nxt);
            if constexpr (SP2) {
            PG8_LDB(B0, 0, 0); PG8_LDB(B1, 0, 1); PG8_SCHED; PG8_LDA(At, 0, 0); PG8_STAGE(PG8_SA(1, 1), a1 + hstep, voffA);
            PG8_WAIT_V(8); PG8_WAIT_L(0); PG8_BAR; PG8_MMA(0, 0, At, B0); PG8_MMA(0, 1, At, B1); PG8_BAR; PG8_SCHED;
            PG8_LDA(At, 0, 1); PG8_STAGE(PG8_SB(0, 0), b2, voffB); PG8_STAGE(PG8_SB(0, 1), b2 + hstep, voffB); PG8_STAGE(PG8_SA(0, 0), a2, voffA);
            PG8_WAIT_V(8); PG8_WAIT_L(0); PG8_BAR; PG8_MMA(1, 0, At, B0); PG8_MMA(1, 1, At, B1); PG8_BAR; PG8_SCHED;
            PG8_LDB(B0, 1, 0); PG8_LDB(B1, 1, 1); PG8_SCHED; PG8_LDA(At, 1, 0); PG8_STAGE(PG8_SA(0, 1), a2 + hstep, voffA);
            PG8_WAIT_V(8); PG8_WAIT_L(0); PG8_BAR; PG8_MMA(0, 0, At, B0); PG8_MMA(0, 1, At, B1); PG8_BAR; PG8_SCHED;
            PG8_LDA(At, 1, 1); PG8_STAGE(PG8_SB(1, 0), b3, voffB); PG8_STAGE(PG8_SB(1, 1), b3 + hstep, voffB); PG8_STAGE(PG8_SA(1, 0), a3, voffA);
            PG8_WAIT_V(8); PG8_WAIT_L(0); PG8_BAR; PG8_MMA(1, 0, At, B0); PG8_MMA(1, 1, At, B1); PG8_BAR; PG8_SCHED;
            } else {
            PG8_LDB(B0, 0, 0); PG8_SCHED; PG8_LDA(At, 0, 0); PG8_STAGE(PG8_SA(1, 1), a1 + hstep, voffA);
            PG8_WAIT_L(8); PG8_BAR; PG8_WAIT_L(0); PG8_MMA(0, 0, At, B0); PG8_BAR; PG8_SCHED;
            PG8_LDB(B1, 0, 1); PG8_STAGE(PG8_SB(0, 0), b2, voffB);
            PG8_BAR; PG8_WAIT_L(0); PG8_MMA(0, 1, At, B1); PG8_BAR;
            PG8_LDA(At, 0, 1); PG8_STAGE(PG8_SA(0, 0), a2, voffA);
            PG8_BAR; PG8_WAIT_L(0); PG8_MMA(1, 0, At, B0); PG8_BAR; PG8_SCHED;
            PG8_STAGE(PG8_SB(0, 1), b2 + hstep, voffB);
            PG8_WAIT_V(6); PG8_BAR; PG8_MMA(1, 1, At, B1); PG8_BAR;
            PG8_LDB(B0, 1, 0); PG8_SCHED; PG8_LDA(At, 1, 0); PG8_STAGE(PG8_SA(0, 1), a2 + hstep, voffA);
            PG8_WAIT_L(8); PG8_BAR; PG8_WAIT_L(0); PG8_MMA(0, 0, At, B0); PG8_BAR; PG8_SCHED;
            PG8_LDB(B1, 1, 1); PG8_STAGE(PG8_SB(1, 0), b3, voffB);
            PG8_BAR; PG8_WAIT_L(0); PG8_MMA(0, 1, At, B1); PG8_BAR;
            PG8_LDA(At, 1, 1); PG8_STAGE(PG8_SA(1, 0), a3, voffA);
            PG8_BAR; PG8_WAIT_L(0); PG8_MMA(1, 0, At, B0); PG8_BAR; PG8_SCHED;
            PG8_STAGE(PG8_SB(1, 1), b3 + hstep, voffB);
            PG8_WAIT_V(6); PG8_BAR; PG8_MMA(1, 1, At, B1); PG8_BAR;
            }
        }
        if constexpr (ALIGN_EPI) { if (wr == 0) PG8_BAR; }
        if constexpr (!Epi::AFTER_DRAIN) { E(acc, cur, wr, wc, fr, fq); S.done(cur); }
        if (!has_next) break;
#pragma unroll
        for (int a = 0; a < 2; ++a)
#pragma unroll
            for (int b = 0; b < 2; ++b)
#pragma unroll
                for (int m = 0; m < 4; ++m)
#pragma unroll
                    for (int n = 0; n < 2; ++n) acc[a][b][m][n] = (f32x4){0.f, 0.f, 0.f, 0.f};
        cur = nxt; cA = nA; cB = nB; ++ui;
        if constexpr (ALIGN_EPI) { if (wr == 1) PG8_BAR; }
    }
    PG8_WAIT_V(0);
    if constexpr (!ALIGN_EPI) { if (wr == 0) PG8_BAR; }
    PG8_BAR;
    if constexpr (Epi::AFTER_DRAIN) { E.fused(acc, cur, wr, wc, fr, fq, lds, wid, lane); S.done(cur); }
#undef PG8_SA
#undef PG8_SB
#undef PG8_STAGE
#undef PG8_LDA
#undef PG8_LDB
#undef PG8_MMA
#undef PG8_WAIT_V
#undef PG8_WAIT_L
#undef PG8_BAR
#undef PG8_SCHED
}
}

#define LAS __attribute__((address_space(3)))
typedef unsigned short bf16_t;
typedef short bf16x8 __attribute__((ext_vector_type(8)));
typedef float f32x4 __attribute__((ext_vector_type(4)));
typedef float f32x16 __attribute__((ext_vector_type(16)));
typedef unsigned u32x2 __attribute__((ext_vector_type(2)));
typedef unsigned u32x4 __attribute__((ext_vector_type(4)));
typedef float f32x2_t __attribute__((ext_vector_type(2)));
typedef __bf16 bf16x2_t __attribute__((ext_vector_type(2)));

constexpr int DM = 1024, NBATCH = 2, SEQ = 8192, DEPTH = 4, CTXL = 256;
constexpr int MLAT = NBATCH * SEQ, MCTX = NBATCH * CTXL, MTOT = MLAT + MCTX;
constexpr int NIN = 3584, NTM = 1536, NCM = 1024, NTB = MTOT / 64;
constexpr int C_QA = 0, C_GA = 384, C_QC = 768, C_GC = 1152;
constexpr int R_HZ = 0, R_GB = 768;
constexpr int NFFT = 16384;
constexpr float LOG2E = 1.4426950408889634f;
constexpr float QK_SCALE = 0.125f * LOG2E;

constexpr size_t MiB = 1u << 20;
constexpr size_t WS_ADA = 1 * MiB;
constexpr size_t WS_ROPE = 1 * MiB + 256 * 1024;
constexpr size_t WS_H2C = 1 * MiB + 512 * 1024;
constexpr size_t WS_CX = 2 * MiB;
constexpr size_t WS_H2 = 4 * MiB;
constexpr size_t WS_WIN = 12 * MiB;
constexpr size_t WS_WOUT = 40 * MiB;
constexpr size_t WS_HY = 48 * MiB;
constexpr size_t WS_PT = 81 * MiB;
constexpr size_t WS_KH = 130 * MiB + 512 * 1024;
constexpr size_t WS_VT = 147 * MiB;
constexpr size_t WS_PCT = 163 * MiB + 512 * 1024;
constexpr size_t WS_YBT = 197 * MiB;
constexpr size_t WS_XB = 206 * MiB;
constexpr size_t OUT_ZS = 0;
constexpr size_t OUT_FILT = 32 * MiB;
constexpr size_t OUT_YBT = 48 * MiB;
constexpr size_t WS_W3T = 238 * MiB;
constexpr size_t WS_FILT = 239 * MiB;
constexpr size_t WS_END = 255 * MiB;
static_assert(WS_PT + (size_t)MTOT * NTM * 2 <= WS_KH && WS_KH + (size_t)8 * MTOT * 128 <= WS_VT && WS_VT + (size_t)8 * MTOT * 128 <= WS_PCT && WS_PCT + (size_t)NCM * MTOT * 2 <= WS_YBT, "d_ws map");

constexpr int AUX_OFF = 147456;
constexpr int LDS_BYTES = 163840;
constexpr int NTHREADS = 512;

struct KArgs {
    const float* x; const float* c; const float* ctx; const float* c_ctx; const float* norm_g; const float* w_ada; const float* b_ada;
    const float* w_in; const float* w_out; const float* na_rpb; const float* hy_conv_w; const float* hy_conv_b;
    const float* hy_w1; const float* hy_b1; const float* hy_freq1; const float* hy_w2; const float* hy_b2; const float* hy_freq2; const float* hy_w3;
    const float* hy_d; const float* sink; const float* final_g;
    float* out; unsigned char* ws;
    int ph_lo, ph_hi;
};

typedef const __attribute__((address_space(4))) KArgs CKArgs;
__device__ __forceinline__ unsigned pk2(float lo, float hi) { f32x2_t v = {lo, hi}; bf16x2_t b = __builtin_convertvector(v, bf16x2_t); return __builtin_bit_cast(unsigned, b); }
__device__ __forceinline__ float bf2f(unsigned short u) { return __uint_as_float(((unsigned)u) << 16); }
__device__ __forceinline__ float bflo(unsigned w) { return __uint_as_float(w << 16); }
__device__ __forceinline__ float bfhi(unsigned w) { return __uint_as_float(w & 0xffff0000u); }
__device__ __forceinline__ float silu_f(float x) { return x / (1.0f + __expf(-x)); }
__device__ __forceinline__ float lane_xor(float v, int lane, int m) { return __int_as_float(__builtin_amdgcn_ds_bpermute((lane ^ m) << 2, __float_as_int(v))); }
__device__ __forceinline__ float lane_prev(float v, int lane) { return __int_as_float(__builtin_amdgcn_ds_bpermute(((lane - 1) & 63) << 2, __float_as_int(v))); }
__device__ __forceinline__ float lane_next(float v, int lane) { return __int_as_float(__builtin_amdgcn_ds_bpermute(((lane + 1) & 63) << 2, __float_as_int(v))); }
__device__ __forceinline__ float wave_sum(float v, int lane) {
#pragma unroll
    for (int o = 1; o < 64; o <<= 1) v += lane_xor(v, lane, o);
    return v;
}
__device__ __forceinline__ float rdlane(float v, int l) { return __uint_as_float(__builtin_amdgcn_readlane(__float_as_uint(v), l)); }

__device__ __forceinline__ void transpose_item(const float* W, int K, int N, bf16_t* WT, int k0, int n0, int drow0, LAS float* scr, int lane, int ldk = 0) {
    if (ldk == 0) ldk = K;
#pragma unroll 8
    for (int i = 0; i < 32; ++i) { const int kk = 2 * i + (lane >> 5); scr[kk * 33 + (lane & 31)] = W[(size_t)(k0 + kk) * N + n0 + (lane & 31)]; }
    asm volatile("s_waitcnt lgkmcnt(0)" ::: "memory");
    const int c = lane & 7;
#pragma unroll
    for (int j = 0; j < 4; ++j) { const int n = (lane >> 3) + 8 * j; const LAS float* s = scr + (8 * c) * 33 + n;
        u32x4 o; o.x = pk2(s[0 * 33], s[1 * 33]); o.y = pk2(s[2 * 33], s[3 * 33]); o.z = pk2(s[4 * 33], s[5 * 33]); o.w = pk2(s[6 * 33], s[7 * 33]);
        *(u32x4*)(WT + (size_t)(drow0 + n) * ldk + k0 + 8 * c) = o; }
    asm volatile("s_waitcnt lgkmcnt(0)" ::: "memory");
}
__device__ __forceinline__ int win_row(int n0) {
    if (n0 < 384) return n0;
    if (n0 < 768) return n0 - 384 + 1536;
    if (n0 < 1152) return n0 - 768 + 2048;
    if (n0 < 1536) return n0 - 1152 + 384;
    if (n0 < 2304) return n0 - 1536 + 2560;
    if (n0 < 2560) return n0 - 2304 + 3328;
    if (n0 < 2944) return n0 - 2560 + 768;
    if (n0 < 3072) return n0 - 2944 + 1920;
    if (n0 < 3200) return n0 - 3072 + 2432;
    return n0 - 3200 + 1152;
}

__device__ __forceinline__ void phase_prologue(CKArgs& A, LAS unsigned char* lds, int bid, int nblk, int tid) {
    const int wave = __builtin_amdgcn_readfirstlane(tid >> 6), lane = tid & 63;
    const int gw = bid * 8 + wave, NGW = nblk * 8;
    unsigned char* ws = A.ws;
    {
        LAS float* scr = (LAS float*)(lds + wave * 16384);
        constexpr int I_IN = 16 * 112, I_OUT = 16 * 32, I_L = I_IN + I_OUT;
        for (int it = gw; it < DEPTH * I_L; it += NGW) {
            const int l = it / I_L; int r = it % I_L;
            if (r < I_IN) { const int kb = r / 112, nb = r % 112, n0 = nb * 32;
                transpose_item(A.w_in + (size_t)l * DM * NIN, DM, NIN, (bf16_t*)(ws + WS_WIN) + (size_t)l * NIN * DM, kb * 64, n0, win_row(n0), scr, lane); }
            else { r -= I_IN; const int kb = r / 32, nb = r % 32, n0 = nb * 32;
                transpose_item(A.w_out + (size_t)l * DM * DM, DM, DM, (bf16_t*)(ws + WS_WOUT) + (size_t)l * DM * DM, kb * 64, n0, n0, scr, lane); }
        }
    }
    {
        LAS float* scr = (LAS float*)(lds + wave * 16384);
        bf16_t* W3T = (bf16_t*)(ws + WS_W3T);
        for (int it = gw; it < DEPTH * 32; it += NGW) { const int l = it >> 5, nb = it & 31;
            transpose_item(A.hy_w3 + (size_t)l * 64 * 1024, 64, 1024, W3T + (size_t)l * 1024 * 64, 0, nb * 32, nb * 32, scr, lane); }
    }
    for (int idx = gw * 64 + lane; idx < 128 * 16; idx += NGW * 64) {
        const int p = idx >> 4, i = idx & 15;
        const float inv = powf(10000.0f, -(float)i / 16.0f);
        const float ang = (float)p * inv;
        ((float2*)(ws + WS_ROPE))[idx] = make_float2(cosf(ang), sinf(ang));
    }
    for (int it = gw; it < DEPTH * 528; it += NGW) {
        const int l = it / 528, g4 = it % 528, g = g4 >> 2, sub = g4 & 3;
        const int L = g < 128 ? SEQ : CTXL;
        const int n0 = (g < 128 ? g * 64 : (g - 128) * 64) + 16 * sub;
        float* outp = (float*)(ws + WS_H2C) + ((size_t)l * CTXL + n0) * 64;
        bf16_t* outb = (bf16_t*)(ws + WS_H2) + ((size_t)l * SEQ + n0) * 64;
        float w1c[33], w2c[64];
#pragma unroll
        for (int q = 0; q < 33; ++q) w1c[q] = A.hy_w1[((size_t)l * 33 + q) * 64 + lane];
#pragma unroll
        for (int j = 0; j < 64; ++j) w2c[j] = A.hy_w2[((size_t)l * 64 + j) * 64 + lane];
        const float b1 = A.hy_b1[l * 64 + lane], fr1 = A.hy_freq1[l * 64 + lane], b2 = A.hy_b2[l * 64 + lane], fr2 = A.hy_freq2[l * 64 + lane];
        const float tstep = 1.0f / (float)(L - 1);
        const int fj = lane == 0 ? 0 : ((lane - 1) & 15);
        const float fq = 1e-4f + (float)fj * ((15.0f - 1e-4f) / 15.0f);
#pragma unroll 1
        for (int nn = 0; nn < 16; ++nn) {
            const int n = n0 + nn;
            const float t = (float)n * tstep;
            const float rev = fq * ((float)n * (1.0f / (float)L)) + (lane <= 16 ? 0.25f : 0.5f);
            float zq = __builtin_amdgcn_sinf(rev - floorf(rev));
            if (lane == 0) zq = t; if (lane > 32) zq = 0.f;
            float a1 = b1;
#pragma unroll
            for (int q = 0; q < 33; ++q) a1 += rdlane(zq, q) * w1c[q];
            const float x1 = fr1 * a1 * 0.15915494309189535f;
            const float h1 = __builtin_amdgcn_sinf(x1 - floorf(x1));
            float a2 = b2;
#pragma unroll
            for (int j = 0; j < 64; ++j) a2 += rdlane(h1, j) * w2c[j];
            const float x2 = fr2 * a2 * 0.15915494309189535f;
            const float h2 = __builtin_amdgcn_sinf(x2 - floorf(x2));
            if (g < 128) outb[nn * 64 + lane] = (bf16_t)(pk2(h2, 0.f) & 0xffffu);
            else outp[nn * 64 + lane] = h2;
        }
    }
    __syncthreads();
    {
        LAS float* red = (LAS float*)lds;
        LAS float* sv = (LAS float*)(lds + 8192);
        for (int i = tid; i < 3 * DM; i += NTHREADS) sv[i] = silu_f(i < 2 * DM ? A.c[i] : A.c_ctx[i - 2 * DM]);
        __syncthreads();
        for (int it = bid; it < DEPTH * 48; it += nblk) {
            const int l = it / 48, n = (it % 48) * 64 + lane;
            const float* W = A.w_ada + (size_t)l * DM * 3072 + n;
            float a0 = 0.f, a1 = 0.f, a2 = 0.f;
            const int kb = wave * 128;
#pragma unroll 1
            for (int k0 = 0; k0 < 128; k0 += 16) {
                float w[16];
#pragma unroll
                for (int k = 0; k < 16; ++k) w[k] = W[(size_t)(kb + k0 + k) * 3072];
#pragma unroll
                for (int k = 0; k < 16; ++k) { a0 += sv[kb + k0 + k] * w[k]; a1 += sv[DM + kb + k0 + k] * w[k]; a2 += sv[2 * DM + kb + k0 + k] * w[k]; }
            }
            red[(wave * 3 + 0) * 64 + lane] = a0; red[(wave * 3 + 1) * 64 + lane] = a1; red[(wave * 3 + 2) * 64 + lane] = a2;
            __syncthreads();
            if (tid < 192) { const int v = tid >> 6; float sacc = A.b_ada[l * 3072 + n];
#pragma unroll
                for (int w = 0; w < 8; ++w) sacc += red[(w * 3 + v) * 64 + lane];
                ((float*)(ws + WS_ADA))[((size_t)l * 3 + v) * 3072 + n] = sacc; }
            __syncthreads();
        }
    }
}

__device__ __forceinline__ void filt_items(CKArgs& A, int lf, int tid, int bid, int nblk, unsigned* ctr) {
    unsigned char* ws = A.ws;
    const int wave = __builtin_amdgcn_readfirstlane(tid >> 6), lane = tid & 63;
    const int gw = bid * 8 + wave, NGW = nblk * 8;
    const bf16_t* H2B = (const bf16_t*)(ws + WS_H2) + (size_t)lf * SEQ * 64;
    const bf16_t* W3T = (const bf16_t*)(ws + WS_W3T) + (size_t)lf * 1024 * 64;
    bf16_t* FILT = (bf16_t*)((unsigned char*)A.out + OUT_FILT);
    const int fr = lane & 15, fq = lane >> 4;
    int it = gw;
#pragma unroll 1
    for (;;) {
        if (ctr) { unsigned t = 0; if (lane == 0) t = __hip_atomic_fetch_add(ctr, 1u, __ATOMIC_RELAXED, __HIP_MEMORY_SCOPE_AGENT); it = (int)__builtin_amdgcn_readfirstlane(t); }
        if (it >= 2048) break;
        const int n0 = (it >> 4) * 64, c0 = (it & 15) * 64;
        bf16x8 af[4][2];
#pragma unroll
        for (int j = 0; j < 4; ++j) { const bf16_t* ap = H2B + (size_t)(n0 + 16 * (fr >> 2) + 4 * j + (fr & 3)) * 64 + 8 * fq; af[j][0] = *(const bf16x8*)ap; af[j][1] = *(const bf16x8*)(ap + 32); }
#pragma unroll 1
        for (int ct = 0; ct < 4; ++ct) {
            const bf16_t* bp = W3T + (size_t)(c0 + 16 * ct + fr) * 64 + 8 * fq;
            const bf16x8 b0 = *(const bf16x8*)bp, b1 = *(const bf16x8*)(bp + 32);
            u32x4 o0, o1;
#pragma unroll
            for (int j = 0; j < 4; ++j) {
                f32x4 acc = {0.f, 0.f, 0.f, 0.f};
                acc = __builtin_amdgcn_mfma_f32_16x16x32_bf16(af[j][0], b0, acc, 0, 0, 0);
                acc = __builtin_amdgcn_mfma_f32_16x16x32_bf16(af[j][1], b1, acc, 0, 0, 0);
                const unsigned w0 = pk2(acc.x, acc.y), w1 = pk2(acc.z, acc.w);
                if (j == 0) { o0.x = w0; o0.y = w1; } else if (j == 1) { o0.z = w0; o0.w = w1; } else if (j == 2) { o1.x = w0; o1.y = w1; } else { o1.z = w0; o1.w = w1; }
            }
            bf16_t* dp = FILT + (size_t)(c0 + 16 * ct + fr) * SEQ + n0 + 16 * fq;
            *(u32x4*)dp = o0; *(u32x4*)(dp + 8) = o1;
        }
        if (!ctr) it += NGW;
    }
}

__device__ __forceinline__ void ctx_outproj_items(CKArgs& A, int l, int tid, int bid, int nblk) {
    unsigned char* ws = A.ws;
    const int wave = __builtin_amdgcn_readfirstlane(tid >> 6), lane = tid & 63;
    const int gw = bid * 8 + wave, NGW = nblk * 8;
    const bf16_t* Y = (const bf16_t*)(ws + WS_HY) + (size_t)MLAT * DM;
    const bf16_t* WT = (const bf16_t*)(ws + WS_WOUT) + (size_t)l * DM * DM;
    const float* gate = (const float*)(ws + WS_ADA) + ((size_t)l * 3 + 2) * 3072 + 2048;
    const float* csrc = l == 0 ? A.ctx : (const float*)(ws + WS_CX);
    float* cdst = (float*)(ws + WS_CX);
    const int fr = lane & 15, fq = lane >> 4;
#pragma unroll 1
    for (int it = gw; it < 2048; it += NGW) {
        const int r0 = (it >> 6) * 16, c0 = (it & 63) * 16;
        const bf16_t* ap = Y + (size_t)(r0 + fr) * DM + 8 * fq;
        const bf16_t* bp = WT + (size_t)(c0 + fr) * DM + 8 * fq;
        f32x4 acc0 = {0.f, 0.f, 0.f, 0.f}, acc1 = {0.f, 0.f, 0.f, 0.f};
#pragma unroll 1
        for (int k0 = 0; k0 < 32; k0 += 8) {
            bf16x8 a[8], b[8];
#pragma unroll
            for (int k = 0; k < 8; ++k) { a[k] = *(const bf16x8*)(ap + 32 * (k0 + k)); b[k] = *(const bf16x8*)(bp + 32 * (k0 + k)); }
#pragma unroll
            for (int k = 0; k < 8; k += 2) { acc0 = __builtin_amdgcn_mfma_f32_16x16x32_bf16(a[k], b[k], acc0, 0, 0, 0); acc1 = __builtin_amdgcn_mfma_f32_16x16x32_bf16(a[k + 1], b[k + 1], acc1, 0, 0, 0); }
        }
        const float g = gate[c0 + fr];
#pragma unroll
        for (int i = 0; i < 4; ++i) { const size_t off = (size_t)(r0 + 4 * fq + i) * DM + c0 + fr; cdst[off] = csrc[off] + g * (acc0[i] + acc1[i]); }
    }
}

__device__ __forceinline__ void norm_load_row(CKArgs& A, int l, int m, int lane, f32x4 (&xv)[4]) {
    unsigned char* ws = A.ws;
    if ((m < MLAT) && (l > 0)) {
        const bf16_t* sb = (const bf16_t*)(ws + WS_XB) + (size_t)m * DM;
#pragma unroll
        for (int j = 0; j < 4; ++j) { const u32x2 w = *(const u32x2*)(sb + 4 * lane + 256 * j); xv[j] = (f32x4){bflo(w.x), bfhi(w.x), bflo(w.y), bfhi(w.y)}; }
    } else {
        const float* src = (m < MLAT) ? A.x + (size_t)m * DM : (l == 0 ? A.ctx : (const float*)(ws + WS_CX)) + (size_t)(m - MLAT) * DM;
#pragma unroll
        for (int j = 0; j < 4; ++j) xv[j] = *(const f32x4*)(src + 4 * lane + 256 * j);
    }
}
__device__ __forceinline__ float norm_sumsq(const f32x4 (&xv)[4]) {
    float ss = 0.f;
#pragma unroll
    for (int j = 0; j < 4; ++j) ss += (xv[j].x * xv[j].x + xv[j].y * xv[j].y) + (xv[j].z * xv[j].z + xv[j].w * xv[j].w);
    return ss;
}
__device__ __forceinline__ void phase_norm(CKArgs& A, int l, int bid, int nblk, int tid) {
    const int wave = __builtin_amdgcn_readfirstlane(tid >> 6), lane = tid & 63;
    const int gw = bid * 8 + wave, NGW = nblk * 8;
    unsigned char* ws = A.ws;
    bf16_t* H = (bf16_t*)(ws + WS_HY);
    const float* ada = (const float*)(ws + WS_ADA) + (size_t)l * 3 * 3072;
    const float* g = A.norm_g + l * DM;
#pragma unroll 1
    for (int m0 = gw; m0 < MTOT; m0 += 2 * NGW) {
        const int m1 = m0 + NGW; const bool has1 = m1 < MTOT; const int m1c = has1 ? m1 : m0;
        f32x4 xa[4], xc[4];
        norm_load_row(A, l, m0, lane, xa); norm_load_row(A, l, m1c, lane, xc);
        const float* sh0 = ada + (m0 < MLAT ? m0 >> 13 : 2) * 3072; const float* sh1 = ada + (m1c < MLAT ? m1c >> 13 : 2) * 3072;
        const float ra = rsqrtf(wave_sum(norm_sumsq(xa), lane) * (1.0f / DM) + 1e-6f);
        const float rc = rsqrtf(wave_sum(norm_sumsq(xc), lane) * (1.0f / DM) + 1e-6f);
#pragma unroll
        for (int j = 0; j < 4; ++j) { const int col = 4 * lane + 256 * j;
            const f32x4 gv = *(const f32x4*)(g + col);
            { const f32x4 sc = *(const f32x4*)(sh0 + DM + col), sh = *(const f32x4*)(sh0 + col);
              const f32x4 h = xa[j] * ra * gv * (sc + 1.0f) + sh;
              u32x2 o; o.x = pk2(h.x, h.y); o.y = pk2(h.z, h.w);
              *(u32x2*)(H + (size_t)m0 * DM + col) = o; }
            if (has1) { const f32x4 sc = *(const f32x4*)(sh1 + DM + col), sh = *(const f32x4*)(sh1 + col);
              const f32x4 h = xc[j] * rc * gv * (sc + 1.0f) + sh;
              u32x2 o; o.x = pk2(h.x, h.y); o.y = pk2(h.z, h.w);
              *(u32x2*)(H + (size_t)m1 * DM + col) = o; }
        }
    }
}

struct EpiIn {
    static constexpr bool PERM = true, AFTER_DRAIN = false;
    bf16_t* PT; bf16_t* KH; bf16_t* PCT; const float2* rope;
    __device__ __forceinline__ void operator()(const f32x4 (&acc)[2][2][4][2], const pg8::Unit& u, int wr, int wc, int fr, int fq) const {
        const int row0 = u.pm * 256 + wr * 64 + fr;
        if (u.pn < 10) {
#pragma unroll
            for (int bj = 0; bj < 2; ++bj) {
                const int blk = 2 * u.pn + bj;
                const bool rp = ((blk >= 6 && blk <= 8) || blk == 15) && (u.pm < 64);
                const int col0 = 256 * u.pn + 128 * bj + 32 * wc + 8 * fq;
                bf16_t* dst; size_t ld;
                if (u.pn < 6) { dst = PT + col0; ld = NTM; }
                else { const int n2 = col0 - 1536; dst = KH + (size_t)(n2 >> 6) * MTOT * 64 + (n2 & 63); ld = 64; }
#pragma unroll
                for (int ai = 0; ai < 2; ++ai)
#pragma unroll
                    for (int m = 0; m < 4; ++m) {
                        const int r = row0 + 128 * ai + 16 * m;
                        f32x4 v0 = acc[ai][bj][m][0], v1 = acc[ai][bj][m][1];
                        if (rp) {
                            const int pos = r & (SEQ - 1);
                            const int p = (wc & 1) ? (pos & 63) : (pos >> 6);
                            const f32x4* tb = (const f32x4*)(rope + p * 16 + 8 * (fq & 1));
                            const int ln = fr + 16 * fq;
                            const float sg = (fq < 2) ? -1.0f : 1.0f;
                            { const f32x4 t0 = tb[0], t1 = tb[1];
                              const float qx = lane_xor(v0.x, ln, 32), qy = lane_xor(v0.y, ln, 32), qz = lane_xor(v0.z, ln, 32), qw = lane_xor(v0.w, ln, 32);
                              v0.x = v0.x * t0.x + sg * qx * t0.y; v0.y = v0.y * t0.z + sg * qy * t0.w; v0.z = v0.z * t1.x + sg * qz * t1.y; v0.w = v0.w * t1.z + sg * qw * t1.w; }
                            { const f32x4 t2 = tb[2], t3 = tb[3];
                              const float qx = lane_xor(v1.x, ln, 32), qy = lane_xor(v1.y, ln, 32), qz = lane_xor(v1.z, ln, 32), qw = lane_xor(v1.w, ln, 32);
                              v1.x = v1.x * t2.x + sg * qx * t2.y; v1.y = v1.y * t2.z + sg * qy * t2.w; v1.z = v1.z * t3.x + sg * qz * t3.y; v1.w = v1.w * t3.z + sg * qw * t3.w; }
                        }
                        u32x4 w; w.x = pk2(v0.x, v0.y); w.y = pk2(v0.z, v0.w); w.z = pk2(v1.x, v1.y); w.w = pk2(v1.z, v1.w);
                        *(u32x4*)(dst + (size_t)r * ld) = w;
                        asm volatile("" ::: "memory");
                    }
            }
        } else {
#pragma unroll
            for (int bj = 0; bj < 2; ++bj) {
                const int ch0 = 256 * (u.pn - 10) + 128 * bj + 32 * wc + 8 * fq;
#pragma unroll
                for (int ai = 0; ai < 2; ++ai)
#pragma unroll
                    for (int m = 0; m < 4; ++m) {
                        const int r = row0 + 128 * ai + 16 * m;
                        bf16_t* p = PCT + (size_t)ch0 * MTOT + r;
#pragma unroll
                        for (int n = 0; n < 2; ++n) {
                            const f32x4 v = acc[ai][bj][m][n];
                            bf16_t* q = p + (size_t)(4 * n) * MTOT;
                            const unsigned w0 = pk2(v.x, v.y), w1 = pk2(v.z, v.w);
                            q[0] = (bf16_t)(w0 & 0xffffu); q[MTOT] = (bf16_t)(w0 >> 16); q[2 * (size_t)MTOT] = (bf16_t)(w1 & 0xffffu); q[3 * (size_t)MTOT] = (bf16_t)(w1 >> 16);
                        }
                    }
            }
        }
    }
};
struct EpiFilt {
    static constexpr bool PERM = true, AFTER_DRAIN = false;
    bf16_t* O; int ldc;
    __device__ __forceinline__ void operator()(const f32x4 (&acc)[2][2][4][2], const pg8::Unit& u, int wr, int wc, int fr, int fq) const {
        const int row0 = u.pm * 256 + wr * 64 + fr;
#pragma unroll
        for (int bj = 0; bj < 2; ++bj) { const int col0 = 256 * u.pn + 128 * bj + 32 * wc + 8 * fq;
#pragma unroll
            for (int ai = 0; ai < 2; ++ai)
#pragma unroll
                for (int m = 0; m < 4; ++m) { const int r = row0 + 128 * ai + 16 * m; const f32x4 v0 = acc[ai][bj][m][0], v1 = acc[ai][bj][m][1];
                    u32x4 w; w.x = pk2(v0.x, v0.y); w.y = pk2(v0.z, v0.w); w.z = pk2(v1.x, v1.y); w.w = pk2(v1.z, v1.w);
                    *(u32x4*)(O + (size_t)r * ldc + col0) = w; } }
    }
};
struct EpiOut {
    static constexpr bool PERM = true, AFTER_DRAIN = false;
    const float* xsrc; bf16_t* xb; float* xdst; const float* ada; bool src32, dst32;
    __device__ __forceinline__ void operator()(const f32x4 (&acc)[2][2][4][2], const pg8::Unit& u, int wr, int wc, int fr, int fq) const {
        const int row0 = u.pm * 256 + wr * 64 + fr;
        const int v = row0 >> 13;
#pragma unroll
        for (int bj = 0; bj < 2; ++bj) {
            const int col0 = 256 * u.pn + 128 * bj + 32 * wc + 8 * fq;
            const float* gp = ada + v * 3072 + 2048 + col0;
            const f32x4 g0 = *(const f32x4*)gp, g1 = *(const f32x4*)(gp + 4);
#pragma unroll
            for (int ai = 0; ai < 2; ++ai)
#pragma unroll
              for (int mh = 0; mh < 2; ++mh) {
                f32x4 x0[2], x1[2];
                if (src32) {
#pragma unroll
                    for (int mm = 0; mm < 2; ++mm) { const float* sp = xsrc + (size_t)(row0 + 128 * ai + 16 * (2 * mh + mm)) * DM + col0; x0[mm] = *(const f32x4*)sp; x1[mm] = *(const f32x4*)(sp + 4); }
                } else {
#pragma unroll
                    for (int mm = 0; mm < 2; ++mm) { const u32x4 w = *(const u32x4*)(xb + (size_t)(row0 + 128 * ai + 16 * (2 * mh + mm)) * DM + col0);
                        x0[mm] = (f32x4){bflo(w.x), bfhi(w.x), bflo(w.y), bfhi(w.y)}; x1[mm] = (f32x4){bflo(w.z), bfhi(w.z), bflo(w.w), bfhi(w.w)}; }
                }
#pragma unroll
                for (int mm = 0; mm < 2; ++mm) { const int m = 2 * mh + mm; const size_t off = (size_t)(row0 + 128 * ai + 16 * m) * DM + col0;
                    const f32x4 y0 = x0[mm] + g0 * acc[ai][bj][m][0], y1 = x1[mm] + g1 * acc[ai][bj][m][1];
                    if (dst32) { *(f32x4*)(xdst + off) = y0; *(f32x4*)(xdst + off + 4) = y1; }
                    else { u32x4 w; w.x = pk2(y0.x, y0.y); w.y = pk2(y0.z, y0.w); w.z = pk2(y1.x, y1.y); w.w = pk2(y1.z, y1.w); *(u32x4*)(xb + off) = w; } }
                asm volatile("" ::: "memory");
              }
        }
    }
};
struct EpiAll {
    static constexpr bool PERM = true, AFTER_DRAIN = false;
    int mode, l; CKArgs* Ap;
    __device__ __forceinline__ void operator()(const f32x4 (&acc)[2][2][4][2], const pg8::Unit& u, int wr, int wc, int fr, int fq) const {
        unsigned char* ws = Ap->ws;
        if (mode == 0) { const EpiIn E{(bf16_t*)(ws + WS_PT), (bf16_t*)(ws + WS_KH), (bf16_t*)(ws + WS_PCT), (const float2*)(ws + WS_ROPE)}; E(acc, u, wr, wc, fr, fq); }
        else { const EpiOut E{Ap->x, (bf16_t*)(ws + WS_XB), Ap->out, (const float*)(ws + WS_ADA) + (size_t)l * 3 * 3072, l == 0, false}; E(acc, u, wr, wc, fr, fq); }
    }
};
__device__ __forceinline__ float max3f(float a, float b, float c) { float r; asm("v_max3_f32 %0, %1, %2, %3" : "=v"(r) : "v"(a), "v"(b), "v"(c)); return r; }
__device__ __forceinline__ float max2f(float a, float b) { float r; asm("v_max_f32_e32 %0, %1, %2" : "=v"(r) : "v"(a), "v"(b)); return r; }
__device__ __forceinline__ float max4f_mfma(float a, float b, float c, float d) { float r; asm("s_nop 15\n\ts_nop 7\n\tv_max3_f32 %0, %1, %2, %3\n\tv_max_f32_e32 %0, %0, %4" : "=&v"(r) : "v"(a), "v"(b), "v"(c), "v"(d)); return r; }
__device__ __forceinline__ void attn_tile(LAS const unsigned char* slot, int cs, const bf16x8 (&bq)[4], f32x16& o0, f32x16& o1, float& m_run, float& l_run,
                                          int r31, int hh, bool use_mask, int clo, int chi, bool use_bias, LAS const float* btab, int bidx) {
    const int kr = cs + r31;
    LAS const unsigned char* kp = slot + kr * 128;
    const int ksw = (kr >> 1) & 7;
    const bf16x8 ka0 = *(LAS const bf16x8*)(kp + 16 * ((0 + hh) ^ ksw)), ka1 = *(LAS const bf16x8*)(kp + 16 * ((2 + hh) ^ ksw));
    const bf16x8 ka2 = *(LAS const bf16x8*)(kp + 16 * ((4 + hh) ^ ksw)), ka3 = *(LAS const bf16x8*)(kp + 16 * ((6 + hh) ^ ksw));
    LAS const unsigned char* vp = slot + 8192 + r31 * 128;
    const int vsw = (r31 >> 1) & 15, g0 = (cs >> 2) + hh;
    const u32x2 a0l = *(LAS const u32x2*)(vp + 8 * ((g0) ^ vsw)), a0h = *(LAS const u32x2*)(vp + 8 * ((g0 + 2) ^ vsw));
    const u32x2 a1l = *(LAS const u32x2*)(vp + 8 * ((g0 + 4) ^ vsw)), a1h = *(LAS const u32x2*)(vp + 8 * ((g0 + 6) ^ vsw));
    const u32x2 b0l = *(LAS const u32x2*)(vp + 4096 + 8 * ((g0) ^ vsw)), b0h = *(LAS const u32x2*)(vp + 4096 + 8 * ((g0 + 2) ^ vsw));
    const u32x2 b1l = *(LAS const u32x2*)(vp + 4096 + 8 * ((g0 + 4) ^ vsw)), b1h = *(LAS const u32x2*)(vp + 4096 + 8 * ((g0 + 6) ^ vsw));
    f32x16 s, t;
#pragma unroll
    for (int i = 0; i < 16; ++i) { s[i] = 0.f; t[i] = 0.f; }
    s = __builtin_amdgcn_mfma_f32_32x32x16_bf16(ka0, bq[0], s, 0, 0, 0); t = __builtin_amdgcn_mfma_f32_32x32x16_bf16(ka1, bq[1], t, 0, 0, 0);
    s = __builtin_amdgcn_mfma_f32_32x32x16_bf16(ka2, bq[2], s, 0, 0, 0); t = __builtin_amdgcn_mfma_f32_32x32x16_bf16(ka3, bq[3], t, 0, 0, 0);
    if (use_bias) {
        LAS const float* bp = btab + bidx;
#pragma unroll
        for (int i = 0; i < 16; ++i) { const int c = (i & 3) + 8 * (i >> 2) + 4 * hh; s[i] = (s[i] + t[i]) * QK_SCALE + bp[c]; }
    } else {
#pragma unroll
        for (int i = 0; i < 16; ++i) s[i] = (s[i] + t[i]) * QK_SCALE;
    }
    if (use_mask) {
        const unsigned off = (unsigned)(4 * hh - clo), rng = (unsigned)(chi - clo);
        const bool any = chi >= clo;
#pragma unroll
        for (int i = 0; i < 16; ++i) { const unsigned c0 = (unsigned)((i & 3) + 8 * (i >> 2)); s[i] = (any && (c0 + off <= rng)) ? s[i] : -INFINITY; }
    }
    float tmax = max3f(s[0], s[1], s[2]);
#pragma unroll
    for (int i = 3; i < 15; i += 2) tmax = max3f(tmax, s[i], s[i + 1]);
    tmax = max2f(tmax, s[15]);
    tmax = max2f(tmax, lane_xor(tmax, r31 + 32 * hh, 32));
    if (__any(tmax - m_run > 8.0f)) {
        const float m_new = fmaxf(m_run, tmax);
        const float alpha = __builtin_amdgcn_exp2f(m_run - m_new);
        m_run = m_new; l_run *= alpha;
#pragma unroll
        for (int i = 0; i < 16; ++i) { o0[i] *= alpha; o1[i] *= alpha; }
    }
    float ps0 = 0.f, ps1 = 0.f;
#pragma unroll
    for (int i = 0; i < 16; i += 2) { const float p0 = __builtin_amdgcn_exp2f(s[i] - m_run), p1 = __builtin_amdgcn_exp2f(s[i + 1] - m_run); s[i] = p0; s[i + 1] = p1; ps0 += p0; ps1 += p1; }
    l_run += ps0 + ps1;
    u32x4 pw0, pw1;
    pw0.x = pk2(s[0], s[1]); pw0.y = pk2(s[2], s[3]); pw0.z = pk2(s[4], s[5]); pw0.w = pk2(s[6], s[7]);
    pw1.x = pk2(s[8], s[9]); pw1.y = pk2(s[10], s[11]); pw1.z = pk2(s[12], s[13]); pw1.w = pk2(s[14], s[15]);
    const bf16x8 pb0 = __builtin_bit_cast(bf16x8, pw0), pb1 = __builtin_bit_cast(bf16x8, pw1);
    u32x4 w;
    w.x = a0l.x; w.y = a0l.y; w.z = a0h.x; w.w = a0h.y; const bf16x8 va00 = __builtin_bit_cast(bf16x8, w);
    w.x = a1l.x; w.y = a1l.y; w.z = a1h.x; w.w = a1h.y; const bf16x8 va01 = __builtin_bit_cast(bf16x8, w);
    w.x = b0l.x; w.y = b0l.y; w.z = b0h.x; w.w = b0h.y; const bf16x8 va10 = __builtin_bit_cast(bf16x8, w);
    w.x = b1l.x; w.y = b1l.y; w.z = b1h.x; w.w = b1h.y; const bf16x8 va11 = __builtin_bit_cast(bf16x8, w);
    o0 = __builtin_amdgcn_mfma_f32_32x32x16_bf16(va00, pb0, o0, 0, 0, 0); o1 = __builtin_amdgcn_mfma_f32_32x32x16_bf16(va10, pb0, o1, 0, 0, 0);
    o0 = __builtin_amdgcn_mfma_f32_32x32x16_bf16(va01, pb1, o0, 0, 0, 0); o1 = __builtin_amdgcn_mfma_f32_32x32x16_bf16(va11, pb1, o1, 0, 0, 0);
}

__device__ __forceinline__ void attn_tile2(LAS const unsigned char* slot, const bf16x8 (&bq)[4], f32x16& o0, f32x16& o1, float& m_run, float& l_run,
                                           int r31, int hh, bool use_mask, int clo0, int chi0, int clo1, int chi1) {
    const int ksw = (r31 >> 1) & 7;
    LAS const unsigned char* kp = slot + r31 * 128;
    const bf16x8 ka0 = *(LAS const bf16x8*)(kp + 16 * ((0 + hh) ^ ksw)), ka1 = *(LAS const bf16x8*)(kp + 16 * ((2 + hh) ^ ksw));
    const bf16x8 ka2 = *(LAS const bf16x8*)(kp + 16 * ((4 + hh) ^ ksw)), ka3 = *(LAS const bf16x8*)(kp + 16 * ((6 + hh) ^ ksw));
    const bf16x8 kb0 = *(LAS const bf16x8*)(kp + 4096 + 16 * ((0 + hh) ^ ksw)), kb1 = *(LAS const bf16x8*)(kp + 4096 + 16 * ((2 + hh) ^ ksw));
    const bf16x8 kb2 = *(LAS const bf16x8*)(kp + 4096 + 16 * ((4 + hh) ^ ksw)), kb3 = *(LAS const bf16x8*)(kp + 4096 + 16 * ((6 + hh) ^ ksw));
    f32x16 s0, s1;
#pragma unroll
    for (int i = 0; i < 16; ++i) { s0[i] = 0.f; s1[i] = 0.f; }
    s0 = __builtin_amdgcn_mfma_f32_32x32x16_bf16(ka0, bq[0], s0, 0, 0, 0); s1 = __builtin_amdgcn_mfma_f32_32x32x16_bf16(kb0, bq[0], s1, 0, 0, 0);
    s0 = __builtin_amdgcn_mfma_f32_32x32x16_bf16(ka1, bq[1], s0, 0, 0, 0); s1 = __builtin_amdgcn_mfma_f32_32x32x16_bf16(kb1, bq[1], s1, 0, 0, 0);
    s0 = __builtin_amdgcn_mfma_f32_32x32x16_bf16(ka2, bq[2], s0, 0, 0, 0); s1 = __builtin_amdgcn_mfma_f32_32x32x16_bf16(kb2, bq[2], s1, 0, 0, 0);
    s0 = __builtin_amdgcn_mfma_f32_32x32x16_bf16(ka3, bq[3], s0, 0, 0, 0); s1 = __builtin_amdgcn_mfma_f32_32x32x16_bf16(kb3, bq[3], s1, 0, 0, 0);
    LAS const unsigned char* vp = slot + 8192 + r31 * 128;
    const int vsw = (r31 >> 1) & 15;
    u32x2 va[2][4][2];
#pragma unroll
    for (int db = 0; db < 2; ++db)
#pragma unroll
        for (int st = 0; st < 4; ++st) { va[db][st][0] = *(LAS const u32x2*)(vp + 4096 * db + 8 * ((4 * st + hh) ^ vsw)); va[db][st][1] = *(LAS const u32x2*)(vp + 4096 * db + 8 * ((4 * st + hh + 2) ^ vsw)); }
    if (use_mask) {
        const unsigned off0 = (unsigned)(4 * hh - clo0), rng0 = (unsigned)(chi0 - clo0), off1 = (unsigned)(4 * hh - clo1), rng1 = (unsigned)(chi1 - clo1);
#pragma unroll
        for (int i = 0; i < 16; ++i) { const unsigned c0 = (unsigned)((i & 3) + 8 * (i >> 2)); s0[i] = (c0 + off0 <= rng0) ? s0[i] : -INFINITY; s1[i] = (c0 + off1 <= rng1) ? s1[i] : -INFINITY; }
    }
    float tmax = max4f_mfma(s0[0], s0[1], s1[0], s1[1]);
#pragma unroll
    for (int i = 2; i < 16; i += 2) { tmax = max3f(tmax, s0[i], s0[i + 1]); tmax = max3f(tmax, s1[i], s1[i + 1]); }
    tmax = max2f(tmax, lane_xor(tmax, r31 + 32 * hh, 32)) * QK_SCALE;
    if (__any(tmax - m_run > 8.0f)) {
        const float m_new = fmaxf(m_run, tmax);
        const float alpha = __builtin_amdgcn_exp2f(m_run - m_new);
        m_run = m_new; l_run *= alpha;
#pragma unroll
        for (int i = 0; i < 16; ++i) { o0[i] *= alpha; o1[i] *= alpha; }
    }
    float ps0 = 0.f, ps1 = 0.f;
    const float nm = -m_run;
#pragma unroll
    for (int i = 0; i < 16; ++i) { const float p0 = __builtin_amdgcn_exp2f(fmaf(s0[i], QK_SCALE, nm)), p1 = __builtin_amdgcn_exp2f(fmaf(s1[i], QK_SCALE, nm)); s0[i] = p0; s1[i] = p1; ps0 += p0; ps1 += p1; }
    l_run += ps0 + ps1;
    u32x4 pw;
    pw.x = pk2(s0[0], s0[1]); pw.y = pk2(s0[2], s0[3]); pw.z = pk2(s0[4], s0[5]); pw.w = pk2(s0[6], s0[7]); const bf16x8 p00 = __builtin_bit_cast(bf16x8, pw);
    pw.x = pk2(s0[8], s0[9]); pw.y = pk2(s0[10], s0[11]); pw.z = pk2(s0[12], s0[13]); pw.w = pk2(s0[14], s0[15]); const bf16x8 p01 = __builtin_bit_cast(bf16x8, pw);
    pw.x = pk2(s1[0], s1[1]); pw.y = pk2(s1[2], s1[3]); pw.z = pk2(s1[4], s1[5]); pw.w = pk2(s1[6], s1[7]); const bf16x8 p10 = __builtin_bit_cast(bf16x8, pw);
    pw.x = pk2(s1[8], s1[9]); pw.y = pk2(s1[10], s1[11]); pw.z = pk2(s1[12], s1[13]); pw.w = pk2(s1[14], s1[15]); const bf16x8 p11 = __builtin_bit_cast(bf16x8, pw);
#define VA8(db_, st_) __builtin_bit_cast(bf16x8, (u32x4){va[db_][st_][0].x, va[db_][st_][0].y, va[db_][st_][1].x, va[db_][st_][1].y})
    o0 = __builtin_amdgcn_mfma_f32_32x32x16_bf16(VA8(0, 0), p00, o0, 0, 0, 0); o1 = __builtin_amdgcn_mfma_f32_32x32x16_bf16(VA8(1, 0), p00, o1, 0, 0, 0);
    o0 = __builtin_amdgcn_mfma_f32_32x32x16_bf16(VA8(0, 1), p01, o0, 0, 0, 0); o1 = __builtin_amdgcn_mfma_f32_32x32x16_bf16(VA8(1, 1), p01, o1, 0, 0, 0);
    o0 = __builtin_amdgcn_mfma_f32_32x32x16_bf16(VA8(0, 2), p10, o0, 0, 0, 0); o1 = __builtin_amdgcn_mfma_f32_32x32x16_bf16(VA8(1, 2), p10, o1, 0, 0, 0);
    o0 = __builtin_amdgcn_mfma_f32_32x32x16_bf16(VA8(0, 3), p11, o0, 0, 0, 0); o1 = __builtin_amdgcn_mfma_f32_32x32x16_bf16(VA8(1, 3), p11, o1, 0, 0, 0);
#undef VA8
}

__device__ __forceinline__ void attn_tile4(LAS const unsigned char* slotA, LAS const unsigned char* slotB, const bf16x8 (&bq)[4], f32x16& o0, f32x16& o1, float& m_run, float& l_run, int r31, int hh) {
    const int ksw = (r31 >> 1) & 7, vsw = (r31 >> 1) & 15;
    f32x16 s[4];
#pragma unroll
    for (int t = 0; t < 4; ++t)
#pragma unroll
        for (int i = 0; i < 16; ++i) s[t][i] = 0.f;
#pragma unroll
    for (int ks = 0; ks < 4; ++ks) {
        LAS const unsigned char* ka = slotA + r31 * 128 + 16 * ((2 * ks + hh) ^ ksw);
        LAS const unsigned char* kb = slotB + r31 * 128 + 16 * ((2 * ks + hh) ^ ksw);
        const bf16x8 k0 = *(LAS const bf16x8*)ka, k1 = *(LAS const bf16x8*)(ka + 4096), k2 = *(LAS const bf16x8*)kb, k3 = *(LAS const bf16x8*)(kb + 4096);
        s[0] = __builtin_amdgcn_mfma_f32_32x32x16_bf16(k0, bq[ks], s[0], 0, 0, 0); s[1] = __builtin_amdgcn_mfma_f32_32x32x16_bf16(k1, bq[ks], s[1], 0, 0, 0);
        s[2] = __builtin_amdgcn_mfma_f32_32x32x16_bf16(k2, bq[ks], s[2], 0, 0, 0); s[3] = __builtin_amdgcn_mfma_f32_32x32x16_bf16(k3, bq[ks], s[3], 0, 0, 0);
    }
    float tmax = max4f_mfma(s[0][0], s[1][0], s[2][0], s[3][0]);
#pragma unroll
    for (int i = 1; i < 16; ++i) { tmax = max3f(tmax, s[0][i], s[1][i]); tmax = max3f(tmax, s[2][i], s[3][i]); }
    tmax = max2f(tmax, lane_xor(tmax, r31 + 32 * hh, 32)) * QK_SCALE;
    if (__any(tmax - m_run > 8.0f)) {
        const float m_new = fmaxf(m_run, tmax);
        const float alpha = __builtin_amdgcn_exp2f(m_run - m_new);
        m_run = m_new; l_run *= alpha;
#pragma unroll
        for (int i = 0; i < 16; ++i) { o0[i] *= alpha; o1[i] *= alpha; }
    }
    const float nm = -m_run;
    float ps0 = 0.f, ps1 = 0.f;
#pragma unroll
    for (int t = 0; t < 4; ++t)
#pragma unroll
        for (int i = 0; i < 16; i += 2) { const float p0 = __builtin_amdgcn_exp2f(fmaf(s[t][i], QK_SCALE, nm)), p1 = __builtin_amdgcn_exp2f(fmaf(s[t][i + 1], QK_SCALE, nm)); s[t][i] = p0; s[t][i + 1] = p1; ps0 += p0; ps1 += p1; }
    l_run += ps0 + ps1;
#pragma unroll
    for (int t = 0; t < 4; ++t) {
        LAS const unsigned char* vp = (t < 2 ? slotA : slotB) + 8192 + r31 * 128;
        const int g0 = 8 * (t & 1) + hh;
        u32x4 pw;
        pw.x = pk2(s[t][0], s[t][1]); pw.y = pk2(s[t][2], s[t][3]); pw.z = pk2(s[t][4], s[t][5]); pw.w = pk2(s[t][6], s[t][7]); const bf16x8 pa = __builtin_bit_cast(bf16x8, pw);
        pw.x = pk2(s[t][8], s[t][9]); pw.y = pk2(s[t][10], s[t][11]); pw.z = pk2(s[t][12], s[t][13]); pw.w = pk2(s[t][14], s[t][15]); const bf16x8 pb = __builtin_bit_cast(bf16x8, pw);
        const u32x2 a0l = *(LAS const u32x2*)(vp + 8 * ((g0) ^ vsw)), a0h = *(LAS const u32x2*)(vp + 8 * ((g0 + 2) ^ vsw));
        const u32x2 a1l = *(LAS const u32x2*)(vp + 8 * ((g0 + 4) ^ vsw)), a1h = *(LAS const u32x2*)(vp + 8 * ((g0 + 6) ^ vsw));
        const u32x2 b0l = *(LAS const u32x2*)(vp + 4096 + 8 * ((g0) ^ vsw)), b0h = *(LAS const u32x2*)(vp + 4096 + 8 * ((g0 + 2) ^ vsw));
        const u32x2 b1l = *(LAS const u32x2*)(vp + 4096 + 8 * ((g0 + 4) ^ vsw)), b1h = *(LAS const u32x2*)(vp + 4096 + 8 * ((g0 + 6) ^ vsw));
        o0 = __builtin_amdgcn_mfma_f32_32x32x16_bf16(__builtin_bit_cast(bf16x8, (u32x4){a0l.x, a0l.y, a0h.x, a0h.y}), pa, o0, 0, 0, 0);
        o1 = __builtin_amdgcn_mfma_f32_32x32x16_bf16(__builtin_bit_cast(bf16x8, (u32x4){b0l.x, b0l.y, b0h.x, b0h.y}), pa, o1, 0, 0, 0);
        o0 = __builtin_amdgcn_mfma_f32_32x32x16_bf16(__builtin_bit_cast(bf16x8, (u32x4){a1l.x, a1l.y, a1h.x, a1h.y}), pb, o0, 0, 0, 0);
        o1 = __builtin_amdgcn_mfma_f32_32x32x16_bf16(__builtin_bit_cast(bf16x8, (u32x4){b1l.x, b1l.y, b1h.x, b1h.y}), pb, o1, 0, 0, 0);
    }
}

__device__ __forceinline__ void attn_block_item(CKArgs& A, int l, int MODE, int item, LAS unsigned char* lds, int tid) {
    asm volatile("" : "+v"(tid));
    unsigned char* ws = A.ws;
    const bf16_t* PT = (const bf16_t*)(ws + WS_PT);
    bf16_t* Y = (bf16_t*)(ws + WS_HY);
    const int wave = __builtin_amdgcn_readfirstlane(tid >> 6), lane = tid & 63;
    const int r31 = lane & 31, hh = lane >> 5;
    int b, h, qtok, qi = 0;
    int rp = 0, mg = 0, qg = 0;
    if (MODE == 0) { b = item / 192; const int rem = item % 192; h = rem >> 5; qi = rem & 31; rp = 2 * qi + (wave >> 2); mg = wave & 3;
        qtok = b * SEQ + (2 * rp + (r31 >> 4)) * 64 + 16 * mg + (r31 & 15); }
    else if (MODE == 1) { b = item / 192; const int rem = item % 192; h = rem >> 5; qi = rem & 31; qg = 8 * qi + wave; qtok = b * SEQ + 32 * qg + r31; }
    else { b = item / 6; h = item % 6; qg = wave; qtok = MLAT + b * CTXL + 32 * qg + r31; }
    const bool grpA = (MODE == 0 || MODE == 2);
    const int kvh = grpA ? h : h / 3;
    const int qcol = (grpA ? C_QA : C_QC) + h * 64, gcol = (grpA ? C_GA : C_GC) + h * 64, ycol = (grpA ? 0 : 640) + h * 64;
    const int kh = grpA ? h : 6 + kvh;
    bf16x8 bq[4];
    { const bf16_t* qp = PT + (size_t)qtok * NTM + qcol + 8 * hh;
#pragma unroll
      for (int s = 0; s < 4; ++s) bq[s] = *(const bf16x8*)(qp + 16 * s); }
    f32x16 o0, o1;
#pragma unroll
    for (int i = 0; i < 16; ++i) { o0[i] = 0.f; o1[i] = 0.f; }
    float m_run = -1e30f, l_run = 0.f;
    if (!grpA) { m_run = A.sink[l * 6 + h] * LOG2E; l_run = hh == 0 ? 1.0f : 0.f; }
    int wrow0 = 0, nwin = 0;
    if (MODE == 0) { const int a0 = min(max(4 * qi - 4, 0), 120), a1 = min(max(4 * qi - 1, 0), 120) + 7; wrow0 = a0; nwin = a1 - a0 + 1; }
    if (MODE == 1) { const int k0 = max(4 * qi - 2, 0), k1 = min(4 * qi + 5, 127); wrow0 = k0; nwin = k1 - k0 + 1; }
    const int nsteps = 4 + nwin;
    int ra = 0, rb = -1, cs = 0, rq = 0, jq = 0, r0 = 0, cmin = 0;
    LAS const float* btab = (LAS const float*)(lds + AUX_OFF + 2048);
    if (MODE == 0) { ra = min(max(2 * rp - 4, 0), 120); rb = min(max(2 * rp - 3, 0), 120) + 7; cs = min(max(16 * mg - 8, 0), 32);
        rq = 2 * rp + (r31 >> 4); jq = 16 * mg + (r31 & 15); r0 = min(max(rq - 4, 0), 120); cmin = min(max(jq - 8, 0), 48) - cs;
        }
    const int lr = tid >> 3, lc = tid & 7;
    const bf16_t* kg = (const bf16_t*)(ws + WS_KH) + (size_t)kh * MTOT * 64 + 8 * tid;
    const bf16_t* vg = (const bf16_t*)(ws + WS_VT) + (size_t)kh * MTOT * 64 + 8 * tid;
    const int kdst = lr * 128 + 16 * (lc ^ ((lr >> 1) & 7));
    const int vdstb = 8192 + (8 * lc) * 128 + 2 * (lr & 3), vg4 = lr >> 2, vs4 = (4 * lc) & 15;
#define ROW_TOK(i) ((i) < 4 ? MLAT + b * CTXL + 64 * (i) : b * SEQ + 64 * (wrow0 + (i) - 4))
#define LOAD_ROW(i, kr_, vr_) do { const int t0_ = ROW_TOK(i); kr_ = *(const u32x4*)(kg + (size_t)t0_ * 64); vr_ = *(const u32x4*)(vg + (size_t)t0_ * 64); } while (0)
#define WRITE_ROW(sl_, kr_, vr_) do { *(LAS u32x4*)((sl_) + kdst) = kr_; \
        _Pragma("unroll") for (int j_ = 0; j_ < 8; ++j_) { const unsigned w_ = j_ < 2 ? vr_.x : (j_ < 4 ? vr_.y : (j_ < 6 ? vr_.z : vr_.w)); \
            *(LAS bf16_t*)((sl_) + vdstb + j_ * 128 + 8 * (vg4 ^ ((vs4 + (j_ >> 1)) & 15))) = (bf16_t)((j_ & 1) ? (w_ >> 16) : (w_ & 0xffffu)); } } while (0)
    u32x4 k0, v0, k1, v1, k2, v2;
    LOAD_ROW(0, k0, v0); LOAD_ROW(1, k2, v2);
    __syncthreads();
    if (MODE == 0 && tid < 465) ((LAS float*)(lds + AUX_OFF + 2048))[tid] = A.na_rpb[(size_t)(l * 6 + h) * 465 + tid] * LOG2E;
    WRITE_ROW(lds, k0, v0); WRITE_ROW(lds + 16384, k2, v2);
    __syncthreads();
#pragma unroll 1
    for (int pr = 0; pr < 2; ++pr) {
        { const int ra_ = pr == 0 ? 2 : min(4, nsteps - 1), rb_ = pr == 0 ? 3 : ra_; LOAD_ROW(ra_, k0, v0); LOAD_ROW(rb_, k2, v2); }
        attn_tile4(lds, lds + 16384, bq, o0, o1, m_run, l_run, r31, hh);
        __syncthreads();
        if (pr == 0) { WRITE_ROW(lds, k0, v0); WRITE_ROW(lds + 16384, k2, v2); } else if (nsteps > 4) { WRITE_ROW(lds, k0, v0); }
        __syncthreads();
    }
#define ATT_STEP(i_, kL, vL, kW, vW) do { const int i = (i_); if (i < nsteps) { \
        LAS const unsigned char* slot = lds + (i & 1) * 16384; \
        { const int ir_ = min(i + 1, nsteps - 1); LOAD_ROW(ir_, kL, vL); }     \
        bool use2 = false, use1 = false, um = false, um1 = false, ub = false; int c1 = 0, lo0 = 0, hi0 = 31, lo1 = 0, hi1 = 31, bidx = 0; \
        if (i < 4) use2 = true; \
        else if (MODE == 0) { const int a = wrow0 + i - 4; use1 = (a >= ra) && (a <= rb); const bool rowok = (a >= r0) && (a < r0 + 8); \
            c1 = cs; lo0 = rowok ? cmin : 1; hi0 = rowok ? cmin + 15 : 0; ub = true; um1 = true; bidx = (a - rq + 7) * 31 + (cs - jq + 15); } \
        else if (MODE == 1) { const int rel0 = (64 * (wrow0 + i - 4) - (32 * qg - 128)) >> 5, rel1 = rel0 + 1;     \
            const bool a0 = (rel0 >= 0) && (rel0 <= 8), a1 = (rel1 >= 0) && (rel1 <= 8); \
            if (a0 && a1) { use2 = true; um = (rel0 == 0) || (rel1 == 8); lo0 = rel0 == 0 ? r31 : 0; hi1 = rel1 == 8 ? r31 : 31; } \
            else if (a0) { use1 = true; um1 = (rel0 == 0) || (rel0 == 8); lo0 = rel0 == 0 ? r31 : 0; hi0 = rel0 == 8 ? r31 : 31; } \
            else if (a1) { use1 = true; c1 = 32; um1 = (rel1 == 0) || (rel1 == 8); lo0 = rel1 == 0 ? r31 : 0; hi0 = rel1 == 8 ? r31 : 31; } } \
        if (use2) attn_tile2(slot, bq, o0, o1, m_run, l_run, r31, hh, um, lo0, hi0, lo1, hi1); \
        if (use1) attn_tile(slot, c1, bq, o0, o1, m_run, l_run, r31, hh, um1, lo0, hi0, ub, btab, bidx); \
        if (i + 1 < nsteps) { LAS unsigned char* nslot = lds + ((i + 1) & 1) * 16384; WRITE_ROW(nslot, kW, vW); } \
        __syncthreads(); } } while (0)
#pragma unroll 1
    for (int i3 = 4; i3 < nsteps; ++i3) {
        ATT_STEP(i3, k1, v1, k1, v1);
    }
#undef ATT_STEP
#undef LOAD_ROW
#undef WRITE_ROW
    const float ltot = l_run + lane_xor(l_run, lane, 32);
    const float inv = 1.0f / ltot;
    const bf16_t* gp = PT + (size_t)qtok * NTM + gcol + 4 * hh;
    bf16_t* yp = Y + (size_t)qtok * DM + ycol + 4 * hh;
#pragma unroll
    for (int db = 0; db < 2; ++db)
#pragma unroll
        for (int g4 = 0; g4 < 4; ++g4) {
            const int d0 = 32 * db + 8 * g4;
            const u32x2 gw = *(const u32x2*)(gp + d0);
            float v0, v1, v2, v3;
            if (db == 0) { v0 = o0[4 * g4]; v1 = o0[4 * g4 + 1]; v2 = o0[4 * g4 + 2]; v3 = o0[4 * g4 + 3]; }
            else { v0 = o1[4 * g4]; v1 = o1[4 * g4 + 1]; v2 = o1[4 * g4 + 2]; v3 = o1[4 * g4 + 3]; }
            v0 *= inv * silu_f(bflo(gw.x)); v1 *= inv * silu_f(bfhi(gw.x)); v2 *= inv * silu_f(bflo(gw.y)); v3 *= inv * silu_f(bfhi(gw.y));
            u32x2 o; o.x = pk2(v0, v1); o.y = pk2(v2, v3);
            *(u32x2*)(yp + d0) = o;
        }
}

typedef float cf2 __attribute__((ext_vector_type(2)));
__device__ __forceinline__ cf2 mk2(float x, float y) { cf2 r; r.x = x; r.y = y; return r; }
__device__ __forceinline__ cf2 cmul(cf2 a, cf2 b) { const cf2 bs = mk2(-b.y, b.x); return a.xx * b + a.yy * bs; }
#define PA(e) ((e) + (((e) >> 4) << 1))
struct cf2x4 { cf2 a, b, c, d; };
__device__ __forceinline__ cf2x4 bfly4_fwd(cf2 x0, cf2 x1, cf2 x2, cf2 x3, float a) {
    const cf2 w1 = mk2(__builtin_amdgcn_cosf(a), -__builtin_amdgcn_sinf(a));
    const cf2 w2 = cmul(w1, w1), w3 = cmul(w2, w1);
    const cf2 s02 = x0 + x2, d02 = x0 - x2, s13 = x1 + x3, d13 = x1 - x3;
    cf2x4 r;
    r.a = s02 + s13;
    r.b = cmul(s02 - s13, w2);
    r.c = cmul(mk2(d02.x + d13.y, d02.y - d13.x), w1);
    r.d = cmul(mk2(d02.x - d13.y, d02.y + d13.x), w3);
    return r;
}
__device__ __forceinline__ cf2x4 bfly4_inv(cf2 v0, cf2 v1, cf2 v2, cf2 v3, float a) {
    const cf2 w1 = mk2(__builtin_amdgcn_cosf(a), __builtin_amdgcn_sinf(a));
    const cf2 w2 = cmul(w1, w1);
    const cf2 bb = cmul(v1, w2), dd = cmul(v3, w2);
    const cf2 u0 = v0 + bb, u1 = v0 - bb, u2 = v2 + dd, u3 = v2 - dd;
    const cf2 e = cmul(u2, w1), f0 = cmul(u3, w1);
    const cf2 f = mk2(-f0.y, f0.x);
    cf2x4 r; r.a = u0 + e; r.c = u0 - e; r.b = u1 + f; r.d = u1 - f; return r;
}
__device__ __forceinline__ void fft_fwd_fused(LAS cf2* buf, int tid, int lsb, bool zero_hi = false) {
    const int sB = 1 << lsb, s = 4 << lsb;
    const float ra = 1.0f / (float)(16 << lsb), rb = 1.0f / (float)(4 << lsb);
    int poff[4][4];
#pragma unroll
    for (int a = 0; a < 4; ++a)
#pragma unroll
        for (int b = 0; b < 4; ++b) { const int off = a * s + b * sB; poff[a][b] = PA(off); }
#pragma unroll 1
    for (int gg = 0; gg < 2; ++gg) {
        const int g = tid + 512 * gg, i = g & (sB - 1), base = ((g >> lsb) << (lsb + 4)) + i;
        const int pbase = PA(base);
        cf2 x[4][4];
#pragma unroll
        for (int a = 0; a < 4; ++a)
#pragma unroll
            for (int b = 0; b < 4; ++b) x[a][b] = (zero_hi && a >= 2) ? mk2(0.f, 0.f) : buf[pbase + poff[a][b]];
#pragma unroll
        for (int b = 0; b < 4; ++b) { const cf2x4 r = bfly4_fwd(x[0][b], x[1][b], x[2][b], x[3][b], (float)(i + b * sB) * ra); x[0][b] = r.a; x[1][b] = r.b; x[2][b] = r.c; x[3][b] = r.d; }
        const float ab = (float)i * rb;
#pragma unroll
        for (int a = 0; a < 4; ++a) { const cf2x4 r = bfly4_fwd(x[a][0], x[a][1], x[a][2], x[a][3], ab); x[a][0] = r.a; x[a][1] = r.b; x[a][2] = r.c; x[a][3] = r.d; }
#pragma unroll
        for (int a = 0; a < 4; ++a)
#pragma unroll
            for (int b = 0; b < 4; ++b) buf[pbase + poff[a][b]] = x[a][b];
    }
    __syncthreads();
}
__device__ __forceinline__ void fft_inv_fused(LAS cf2* buf, int tid, int lsb) {
    const int sB = 1 << lsb, s = 4 << lsb;
    const float ra = 1.0f / (float)(16 << lsb), rb = 1.0f / (float)(4 << lsb);
    int poff[4][4];
#pragma unroll
    for (int a = 0; a < 4; ++a)
#pragma unroll
        for (int b = 0; b < 4; ++b) { const int off = a * s + b * sB; poff[a][b] = PA(off); }
#pragma unroll 1
    for (int gg = 0; gg < 2; ++gg) {
        const int g = tid + 512 * gg, i = g & (sB - 1), base = ((g >> lsb) << (lsb + 4)) + i;
        const int pbase = PA(base);
        cf2 x[4][4];
#pragma unroll
        for (int a = 0; a < 4; ++a)
#pragma unroll
            for (int b = 0; b < 4; ++b) x[a][b] = buf[pbase + poff[a][b]];
        const float ab = (float)i * rb;
#pragma unroll
        for (int a = 0; a < 4; ++a) { const cf2x4 r = bfly4_inv(x[a][0], x[a][1], x[a][2], x[a][3], ab); x[a][0] = r.a; x[a][1] = r.b; x[a][2] = r.c; x[a][3] = r.d; }
#pragma unroll
        for (int b = 0; b < 4; ++b) { const cf2x4 r = bfly4_inv(x[0][b], x[1][b], x[2][b], x[3][b], (float)(i + b * sB) * ra); x[0][b] = r.a; x[1][b] = r.b; x[2][b] = r.c; x[3][b] = r.d; }
#pragma unroll
        for (int a = 0; a < 4; ++a)
#pragma unroll
            for (int b = 0; b < 4; ++b) buf[pbase + poff[a][b]] = x[a][b];
    }
    __syncthreads();
}
__device__ __forceinline__ void fft_fwd(LAS cf2* buf, int tid, const unsigned* zk = nullptr, bool zero_hi = false) {
#pragma unroll 1
    for (int lsb = 10; lsb >= 2; lsb -= 4) fft_fwd_fused(buf, tid, lsb, zero_hi && lsb == 10);
#pragma unroll 4
    for (int k = 0; k < 8; ++k) {
        const int e0 = 4 * (tid + 512 * k), base = PA(e0);
        cf2 x0 = buf[base], x1 = buf[base + 1], x2 = buf[base + 2], x3 = buf[base + 3];
        const cf2 s02 = x0 + x2, d02 = x0 - x2, s13 = x1 + x3, d13 = x1 - x3;
        cf2 y0 = s02 + s13, y1 = s02 - s13, y2 = mk2(d02.x + d13.y, d02.y - d13.x), y3 = mk2(d02.x - d13.y, d02.y + d13.x);
        if (zk) { const u32x4 w = *(const u32x4*)(zk + (unsigned)e0);
            y0 = cmul(y0, mk2(bflo(w.x), bfhi(w.x))); y1 = cmul(y1, mk2(bflo(w.y), bfhi(w.y))); y2 = cmul(y2, mk2(bflo(w.z), bfhi(w.z))); y3 = cmul(y3, mk2(bflo(w.w), bfhi(w.w))); }
        buf[base] = y0; buf[base + 1] = y1; buf[base + 2] = y2; buf[base + 3] = y3;
    }
    __syncthreads();
}
__device__ __forceinline__ void fft_inv(LAS cf2* buf, int tid) {
#pragma unroll 1
    for (int lsb = 0; lsb <= 8; lsb += 4) fft_inv_fused(buf, tid, lsb);
#pragma unroll 4
    for (int k = 0; k < 8; ++k) {
        const int i = tid + 512 * k, pi = PA(tid) + 576 * k;
        cf2 v0 = buf[pi], v1 = buf[pi + 4608], v2 = buf[pi + 9216], v3 = buf[pi + 13824];
        const cf2x4 r = bfly4_inv(v0, v1, v2, v3, (float)i * (1.0f / 16384.0f));
        buf[pi] = r.a; buf[pi + 4608] = r.b;
    }
    __syncthreads();
}
__device__ __forceinline__ float hy_short(const bf16_t* prow, int tb, int t, int L, float w0, float w1, float w2, float bias) {
    const float pm = t > 0 ? bf2f(prow[tb + t - 1]) : 0.f;
    const float pc = bf2f(prow[tb + t]);
    const float pp = t < L - 1 ? bf2f(prow[tb + t + 1]) : 0.f;
    return w0 * pm + w1 * pc + w2 * pp + bias;
}
__device__ __forceinline__ float block_sum(float v, LAS float* red, int tid) {
    v = wave_sum(v, tid & 63);
    __syncthreads();
    if ((tid & 63) == 0) red[tid >> 6] = v;
    __syncthreads();
    float s = 0.f;
#pragma unroll
    for (int w = 0; w < 8; ++w) s += red[w];
    return s;
}

__device__ __forceinline__ void hyena_block(CKArgs& A, int l, int c, LAS unsigned char* lds, int tid) {
    asm volatile("" : "+v"(tid));
    unsigned char* ws = A.ws;
    LAS cf2* buf = (LAS cf2*)lds;
    LAS float* fs = (LAS float*)lds;
    LAS float* aux = (LAS float*)(lds + AUX_OFF);
    LAS float* red = aux + 256;
    const bf16_t* PCT = (const bf16_t*)(ws + WS_PCT);
    bf16_t* YBT = (bf16_t*)((unsigned char*)A.out + OUT_YBT);
    const bf16_t* rowz = PCT + (size_t)(R_HZ + c) * MTOT;
    const bf16_t* rowx1 = rowz + (size_t)256 * MTOT;
    const bf16_t* rowx2 = rowz + (size_t)512 * MTOT;
    const bf16_t* rowg = PCT + (size_t)(R_GB + c) * MTOT;
    const float* cw = A.hy_conv_w + (size_t)l * 3 * 768; const float* cb = A.hy_conv_b + (size_t)l * 768;
    const float wz0 = cw[c], wz1 = cw[768 + c], wz2 = cw[1536 + c], bz = cb[c];
    const float wa0 = cw[256 + c], wa1 = cw[768 + 256 + c], wa2 = cw[1536 + 256 + c], ba = cb[256 + c];
    const float wb0 = cw[512 + c], wb1 = cw[768 + 512 + c], wb2 = cw[1536 + 512 + c], bb = cb[512 + c];
    const float d0 = A.hy_d[(l * 2 + 0) * 256 + c], d1 = A.hy_d[(l * 2 + 1) * 256 + c];
    const float dmin = -3.0701134573253945f, dmax = -15.350567286626973f;
    const float delta = fabsf(dmin + (float)c * ((dmax - dmin) / 255.0f));
    __syncthreads();
    if (tid < 256) { const int k = tid >> 6, j = tid & 63; aux[tid] = A.hy_w3[((size_t)l * 64 + j) * 1024 + k * 256 + c]; }
    __syncthreads();

    if (l < DEPTH - 1) {
        float ss0 = 0.f, ss1 = 0.f;
        if (tid < 256) {
            const int n = tid; const f32x4* hr = (const f32x4*)((const float*)(ws + WS_H2C) + ((size_t)l * CTXL + n) * 64);
            float f0 = 0.f, f1 = 0.f, b0 = 0.f, b1 = 0.f;
#pragma unroll 1
            for (int j4 = 0; j4 < 16; ++j4) { const f32x4 hv = hr[j4];
#pragma unroll
                for (int e = 0; e < 4; ++e) { const float hvv = hv[e]; const int j = 4 * j4 + e; f0 += hvv * aux[j]; f1 += hvv * aux[64 + j]; b0 += hvv * aux[128 + j]; b1 += hvv * aux[192 + j]; } }
            const float e = __expf(-((float)n * (1.0f / 255.0f)) * delta);
            f0 *= e; f1 *= e; b0 *= e; b1 *= e;
            fs[255 + n] = f0; fs[512 + 255 + n] = f1;
            if (n >= 1) { fs[255 - n] = b0; fs[512 + 255 - n] = b1; }
            ss0 = f0 * f0 + (n >= 1 ? b0 * b0 : 0.f); ss1 = f1 * f1 + (n >= 1 ? b1 * b1 : 0.f);
        }
        if (tid == 0) { fs[511] = 0.f; fs[1023] = 0.f; }
        const int b = tid >> 8, t = tid & 255, tok = MLAT + b * CTXL;
        const float z = hy_short(rowz, tok, t, CTXL, wz0, wz1, wz2, bz);
        const float x1 = hy_short(rowx1, tok, t, CTXL, wa0, wa1, wa2, ba);
        const float x2 = hy_short(rowx2, tok, t, CTXL, wb0, wb1, wb2, bb);
        const float gb = bf2f(rowg[tok + t]);
        fs[1024 + tid] = z;
        const float n0 = rsqrtf(block_sum(ss0, red, tid) + 1e-6f);
        const float n1 = rsqrtf(block_sum(ss1, red, tid) + 1e-6f);
        __syncthreads();
        float y = 0.f;
        { LAS const float* kc = fs + 255 + t; LAS const float* zz = fs + 1024 + b * 256;
#pragma unroll 8
          for (int s = 0; s < 256; ++s) y += zz[s] * kc[-s]; }
        const float z1 = x1 * (y * n0 + d0 * z);
        fs[1536 + tid] = z1;
        __syncthreads();
        float y2 = 0.f;
        { LAS const float* kc = fs + 512 + 255 + t; LAS const float* zz = fs + 1536 + b * 256;
#pragma unroll 8
          for (int s = 0; s < 256; ++s) y2 += zz[s] * kc[-s]; }
        const float o = x2 * (y2 * n1 + d1 * z1) * silu_f(gb);
        YBT[(size_t)c * MTOT + tok + t] = (bf16_t)(pk2(o, 0.f) & 0xffffu);
        __syncthreads();
    }

    unsigned* ZK = (unsigned*)((unsigned char*)A.out + OUT_ZS) + (size_t)c * 2 * NFFT;
    const int lane = tid & 63;
    {
        float ss0 = 0.f, ss1 = 0.f;
        const bf16_t* F0 = (const bf16_t*)((unsigned char*)A.out + OUT_FILT) + (size_t)c * SEQ;
        u32x4 fw[2][4];
#pragma unroll
        for (int j = 0; j < 2; ++j)
#pragma unroll
            for (int r = 0; r < 4; ++r) fw[j][r] = *(const u32x4*)(F0 + (size_t)(256 * r) * SEQ + 8 * (tid + 512 * j));
#pragma unroll
        for (int j = 0; j < 2; ++j)
#pragma unroll
            for (int e8 = 0; e8 < 8; ++e8) {
                const int n = 8 * (tid + 512 * j) + e8;
                const float e = __expf(-((float)n * (1.0f / 8191.0f)) * delta);
                const unsigned w0 = e8 < 2 ? fw[j][0].x : (e8 < 4 ? fw[j][0].y : (e8 < 6 ? fw[j][0].z : fw[j][0].w)), w1 = e8 < 2 ? fw[j][1].x : (e8 < 4 ? fw[j][1].y : (e8 < 6 ? fw[j][1].z : fw[j][1].w));
                const unsigned w2 = e8 < 2 ? fw[j][2].x : (e8 < 4 ? fw[j][2].y : (e8 < 6 ? fw[j][2].z : fw[j][2].w)), w3 = e8 < 2 ? fw[j][3].x : (e8 < 4 ? fw[j][3].y : (e8 < 6 ? fw[j][3].z : fw[j][3].w));
                const float f0 = ((e8 & 1) ? bfhi(w0) : bflo(w0)) * e, f1 = ((e8 & 1) ? bfhi(w1) : bflo(w1)) * e, b0 = ((e8 & 1) ? bfhi(w2) : bflo(w2)) * e, b1 = ((e8 & 1) ? bfhi(w3) : bflo(w3)) * e;
                buf[PA(n)] = mk2(f0, f1); ss0 += f0 * f0; ss1 += f1 * f1;
                if (n >= 1) { buf[PA(NFFT - n)] = mk2(b0, b1); ss0 += b0 * b0; ss1 += b1 * b1; }
            }
        if (tid == 0) { const float zf = delta * 0.0f; buf[PA(SEQ)] = mk2(zf, zf); }
        const float nrm0 = rsqrtf(block_sum(ss0, red, tid) + 1e-6f) * (0.5f / NFFT);
        const float nrm1 = rsqrtf(block_sum(ss1, red, tid) + 1e-6f) * (0.5f / NFFT);
        __syncthreads();
        fft_fwd(buf, tid);
#pragma unroll 4
        for (int k = 0; k < 32; ++k) {
            const int p = tid + 512 * k; const int f = (int)(__brev((unsigned)p) >> 18); const int pp = (int)(__brev((unsigned)((NFFT - f) & (NFFT - 1))) >> 18);
            const cf2 za = buf[PA(p)], zb = buf[PA(pp)];
            ZK[p] = pk2((za.x + zb.x) * nrm0 + d0 * (1.0f / NFFT), (za.y - zb.y) * nrm0);
            ZK[NFFT + p] = pk2((za.y + zb.y) * nrm1 + d1 * (1.0f / NFFT), -(za.x - zb.x) * nrm1);
        }
        __syncthreads();
    }
#define HY_RAW(prow_, j_, b_) (*(const u32x4*)((prow_) + (size_t)(b_) * SEQ + 8 * (tid + 512 * (j_))))
#define HY_CONV(prow_, raw_, j_, b_, w0_, w1_, w2_, bias_, u_) do { \
        const int q_ = tid + 512 * (j_); float own_[8]; \
        own_[0] = bflo((raw_).x); own_[1] = bfhi((raw_).x); own_[2] = bflo((raw_).y); own_[3] = bfhi((raw_).y); own_[4] = bflo((raw_).z); own_[5] = bfhi((raw_).z); own_[6] = bflo((raw_).w); own_[7] = bfhi((raw_).w); \
        float pl_ = lane_prev(own_[7], lane), nl_ = lane_next(own_[0], lane); \
        if (lane == 0) pl_ = q_ > 0 ? bf2f((prow_)[(size_t)(b_) * SEQ + 8 * q_ - 1]) : 0.f; \
        if (lane == 63) nl_ = 8 * q_ + 8 < SEQ ? bf2f((prow_)[(size_t)(b_) * SEQ + 8 * q_ + 8]) : 0.f; \
        _Pragma("unroll") for (int e = 0; e < 8; ++e) (u_)[e] = (w0_) * (e > 0 ? own_[e > 0 ? e - 1 : 0] : pl_) + (w1_) * own_[e] + (w2_) * (e < 7 ? own_[e < 7 ? e + 1 : 7] : nl_) + (bias_); } while (0)
    const int pq0 = PA(8 * tid), pq1 = PA(8 * (tid + 512));
    {
        const u32x4 r00 = HY_RAW(rowz, 0, 0), r01 = HY_RAW(rowz, 0, 1), r10 = HY_RAW(rowz, 1, 0), r11 = HY_RAW(rowz, 1, 1);
        float ua[8], ub[8];
        HY_CONV(rowz, r00, 0, 0, wz0, wz1, wz2, bz, ua); HY_CONV(rowz, r01, 0, 1, wz0, wz1, wz2, bz, ub);
#pragma unroll
        for (int e = 0; e < 8; ++e) buf[pq0 + e] = mk2(ua[e], ub[e]);
        HY_CONV(rowz, r10, 1, 0, wz0, wz1, wz2, bz, ua); HY_CONV(rowz, r11, 1, 1, wz0, wz1, wz2, bz, ub);
#pragma unroll
        for (int e = 0; e < 8; ++e) buf[pq1 + e] = mk2(ua[e], ub[e]);
    }
    __syncthreads();
    fft_fwd(buf, tid, ZK, true);
    fft_inv(buf, tid);
    {
        const u32x4 r00 = HY_RAW(rowx1, 0, 0), r01 = HY_RAW(rowx1, 0, 1), r10 = HY_RAW(rowx1, 1, 0), r11 = HY_RAW(rowx1, 1, 1);
        float xa[8], xb[8];
        HY_CONV(rowx1, r00, 0, 0, wa0, wa1, wa2, ba, xa); HY_CONV(rowx1, r01, 0, 1, wa0, wa1, wa2, ba, xb);
#pragma unroll
        for (int e = 0; e < 8; ++e) { const cf2 y = buf[pq0 + e]; buf[pq0 + e] = mk2(xa[e] * y.x, xb[e] * y.y); }
        HY_CONV(rowx1, r10, 1, 0, wa0, wa1, wa2, ba, xa); HY_CONV(rowx1, r11, 1, 1, wa0, wa1, wa2, ba, xb);
#pragma unroll
        for (int e = 0; e < 8; ++e) { const cf2 y = buf[pq1 + e]; buf[pq1 + e] = mk2(xa[e] * y.x, xb[e] * y.y); }
    }
    __syncthreads();
    fft_fwd(buf, tid, ZK + NFFT, true);
    fft_inv(buf, tid);
    {
        bf16_t* yrow = YBT + (size_t)c * MTOT;
        const u32x4 r00 = HY_RAW(rowx2, 0, 0), r01 = HY_RAW(rowx2, 0, 1), r10 = HY_RAW(rowx2, 1, 0), r11 = HY_RAW(rowx2, 1, 1);
        const u32x4 g00 = HY_RAW(rowg, 0, 0), g01 = HY_RAW(rowg, 0, 1), g10 = HY_RAW(rowg, 1, 0), g11 = HY_RAW(rowg, 1, 1);
        float xa[8], xb[8];
#define HY_OUT(pq_, ga_, gb_, j_) do { float oa_[8], ob_[8]; \
            const float gaf_[8] = {bflo((ga_).x), bfhi((ga_).x), bflo((ga_).y), bfhi((ga_).y), bflo((ga_).z), bfhi((ga_).z), bflo((ga_).w), bfhi((ga_).w)}; \
            const float gbf_[8] = {bflo((gb_).x), bfhi((gb_).x), bflo((gb_).y), bfhi((gb_).y), bflo((gb_).z), bfhi((gb_).z), bflo((gb_).w), bfhi((gb_).w)}; \
            _Pragma("unroll") for (int e = 0; e < 8; ++e) { const cf2 y = buf[(pq_) + e]; oa_[e] = xa[e] * y.x * silu_f(gaf_[e]); ob_[e] = xb[e] * y.y * silu_f(gbf_[e]); } \
            u32x4 wa_, wb_; wa_.x = pk2(oa_[0], oa_[1]); wa_.y = pk2(oa_[2], oa_[3]); wa_.z = pk2(oa_[4], oa_[5]); wa_.w = pk2(oa_[6], oa_[7]); \
            wb_.x = pk2(ob_[0], ob_[1]); wb_.y = pk2(ob_[2], ob_[3]); wb_.z = pk2(ob_[4], ob_[5]); wb_.w = pk2(ob_[6], ob_[7]); \
            *(u32x4*)(yrow + 8 * (tid + 512 * (j_))) = wa_; *(u32x4*)(yrow + SEQ + 8 * (tid + 512 * (j_))) = wb_; } while (0)
        HY_CONV(rowx2, r00, 0, 0, wb0, wb1, wb2, bb, xa); HY_CONV(rowx2, r01, 0, 1, wb0, wb1, wb2, bb, xb);
        HY_OUT(pq0, g00, g01, 0);
        HY_CONV(rowx2, r10, 1, 0, wb0, wb1, wb2, bb, xa); HY_CONV(rowx2, r11, 1, 1, wb0, wb1, wb2, bb, xb);
        HY_OUT(pq1, g10, g11, 1);
#undef HY_OUT
    }
#undef HY_RAW
#undef HY_CONV
    __syncthreads();
}

__device__ __forceinline__ void phase_mix(CKArgs& A, int l, LAS unsigned char* lds, int bid, int nblk, int tid) {
    for (int c = bid; c < 256; c += nblk) hyena_block(A, l, c, lds, tid);
    const int nctx = (l < DEPTH - 1) ? 12 : 0;
    const int nlr = (768 + nblk - 1) / nblk, ncr = (2 * nctx + nblk - 1) / nblk;
#pragma unroll 1
    for (int r = 0; r < nlr + ncr; ++r) {
        int it;
        if (r < nlr) { it = r * nblk + bid; if (it >= 768) continue; }
        else { const int j = (nblk - 1 - bid) + (r - nlr) * nblk; if (j >= 2 * nctx) continue; it = 768 + j; }
        int mode, item;
        if (it < 384) { mode = 0; item = it; } else if (it < 768) { mode = 1; item = it - 384; } else if (it < 768 + nctx) { mode = 2; item = it - 768; } else { mode = 3; item = it - 768 - nctx; }
        attn_block_item(A, l, mode, item, lds, tid);
    }
}

__device__ __forceinline__ void phase_tr(CKArgs& A, int l, LAS unsigned char* lds, int bid, int nblk, int tid) {
    const int wave = __builtin_amdgcn_readfirstlane(tid >> 6), lane = tid & 63;
    const int gw = bid * 8 + wave, NGW = nblk * 8;
    unsigned char* ws = A.ws;
    const bf16_t* YBT = (const bf16_t*)((unsigned char*)A.out + OUT_YBT);
    bf16_t* Y = (bf16_t*)(ws + WS_HY);
    LAS bf16_t* scr = (LAS bf16_t*)(lds + wave * 16384);
    const int ntok = (l < DEPTH - 1) ? MTOT : MLAT;
    const int nitems = (ntok / 64) * 4;
#pragma unroll 1
    for (int it = gw; it < nitems; it += NGW) {
        const int tb = (it >> 2) * 64, cb = (it & 3) * 64;
        u32x4 ld[8];
#pragma unroll
        for (int j = 0; j < 8; ++j) { const int idx = lane + 64 * j; ld[j] = *(const u32x4*)(YBT + (size_t)(cb + (idx >> 3)) * MTOT + tb + 8 * (idx & 7)); }
#pragma unroll
        for (int j = 0; j < 8; ++j) { const int idx = lane + 64 * j, ch = idx >> 3, t8 = 8 * (idx & 7);
#pragma unroll
            for (int e = 0; e < 8; ++e) { const unsigned w = e < 2 ? ld[j].x : (e < 4 ? ld[j].y : (e < 6 ? ld[j].z : ld[j].w));
                scr[(t8 + e) * 68 + ch] = (bf16_t)((e & 1) ? (w >> 16) : (w & 0xffffu)); } }
        asm volatile("s_waitcnt lgkmcnt(0)" ::: "memory");
#pragma unroll
        for (int k = 0; k < 8; ++k) {
            const int tq = (lane >> 3) + 8 * k, cc = (lane & 7) * 8;
            const u32x2 a = *(LAS const u32x2*)(scr + tq * 68 + cc), b2 = *(LAS const u32x2*)(scr + tq * 68 + cc + 4);
            u32x4 o; o.x = a.x; o.y = a.y; o.z = b2.x; o.w = b2.y;
            *(u32x4*)(Y + (size_t)(tb + tq) * DM + 384 + cb + cc) = o;
        }
        asm volatile("s_waitcnt lgkmcnt(0)" ::: "memory");
    }
}

__device__ __forceinline__ void phase_final(CKArgs& A, int bid, int nblk, int tid) {
    const int wave = __builtin_amdgcn_readfirstlane(tid >> 6), lane = tid & 63;
    const int gw = bid * 8 + wave, NGW = nblk * 8;
    const bf16_t* xb = (const bf16_t*)(A.ws + WS_XB);
#pragma unroll 1
    for (int m0 = gw; m0 < MLAT; m0 += 2 * NGW) {
        const int m1 = m0 + NGW; const bool has1 = m1 < MLAT; const int m1c = has1 ? m1 : m0;
        f32x4 xa[4], xc[4];
#pragma unroll
        for (int j = 0; j < 4; ++j) { const u32x2 w = *(const u32x2*)(xb + (size_t)m0 * DM + 4 * lane + 256 * j); xa[j] = (f32x4){bflo(w.x), bfhi(w.x), bflo(w.y), bfhi(w.y)}; }
#pragma unroll
        for (int j = 0; j < 4; ++j) { const u32x2 w = *(const u32x2*)(xb + (size_t)m1c * DM + 4 * lane + 256 * j); xc[j] = (f32x4){bflo(w.x), bfhi(w.x), bflo(w.y), bfhi(w.y)}; }
        const float ra = rsqrtf(wave_sum(norm_sumsq(xa), lane) * (1.0f / DM) + 1e-6f);
        const float rc = rsqrtf(wave_sum(norm_sumsq(xc), lane) * (1.0f / DM) + 1e-6f);
#pragma unroll
        for (int j = 0; j < 4; ++j) { const int col = 4 * lane + 256 * j; const f32x4 gv = *(const f32x4*)(A.final_g + col);
            *(f32x4*)(A.out + (size_t)m0 * DM + col) = xa[j] * ra * gv;
            if (has1) *(f32x4*)(A.out + (size_t)m1 * DM + col) = xc[j] * rc * gv; }
    }
}

#define XB_TMO      128
#define XB_XCNT(j)  (256  + 64 * (j))
#define XB_XSUB(j)  (1280 + 64 * (j))
#define XB_XGEN(j)  (2304 + 64 * (j))
#define XB_TOP      3328
#define XB_TOPGEN   3392
#define XCD_BAR_WORDS 3456
#define XB_SPIN_CAP (1u << 18)

__device__ __forceinline__ unsigned xb_ld(unsigned* p)              { return __hip_atomic_load(p, __ATOMIC_RELAXED, __HIP_MEMORY_SCOPE_AGENT); }
__device__ __forceinline__ unsigned xb_add(unsigned* p, unsigned v) { return __hip_atomic_fetch_add(p, v, __ATOMIC_RELAXED, __HIP_MEMORY_SCOPE_AGENT); }
__device__ __forceinline__ unsigned xb_xcc_id() { return (unsigned)__builtin_amdgcn_s_getreg((3 << 11) | 20) & 0xFu; }
#define XB_SPIN(cond, bar) do { unsigned _sp = 0; while (cond) { __builtin_amdgcn_s_sleep(1); \
    if ((++_sp & 255u) == 0u) { if (xb_ld(&(bar)[XB_TMO])) break; if (_sp > XB_SPIN_CAP) { atomicAdd(&(bar)[XB_TMO], 1u); break; } } } } while (0)

struct XcdBarrier {
    unsigned* bar; unsigned x;
    volatile LAS unsigned* st;
};

__device__ __forceinline__ XcdBarrier xcd_barrier_post(unsigned* bar, volatile LAS unsigned* st) {
    XcdBarrier b; b.bar = bar; b.x = xb_xcc_id(); b.st = st;
    if (threadIdx.x == 0) (void)xb_add(&bar[XB_XCNT(b.x)], 1u);
    return b;
}
__device__ __forceinline__ void xcd_barrier_complete(unsigned* bar, unsigned x, unsigned& nloc, unsigned& nx) {
    const unsigned G = gridDim.x * gridDim.y * gridDim.z;
    unsigned sum, cnt, mine, sp = 0u;
    for (;;) {
        sum = 0u; cnt = 0u; mine = 0u;
#pragma unroll
        for (unsigned j = 0; j < 16; ++j) { const unsigned c = xb_ld(&bar[XB_XCNT(j)]); sum += c; cnt += (c > 0u) ? 1u : 0u; mine = (j == x) ? c : mine; }
        if (sum == G) break;
        __builtin_amdgcn_s_sleep(1);
        if ((++sp & 255u) == 0u) { if (xb_ld(&bar[XB_TMO])) break; if (sp > XB_SPIN_CAP) { atomicAdd(&bar[XB_TMO], 1u); break; } }
    }
    nloc = mine > 0u ? mine : 1u; nx = cnt > 0u ? cnt : 1u;
}

__device__ __forceinline__ void xcd_barrier(const XcdBarrier& b) {
    asm volatile("s_waitcnt vmcnt(0)" ::: "memory");
    __syncthreads();
    if (threadIdx.x == 0) {
        unsigned* bar = b.bar;
        __builtin_amdgcn_s_waitcnt(0);
        unsigned nloc = b.st[0], nx = b.st[1];
        if (nloc == 0u) { xcd_barrier_complete(bar, b.x, nloc, nx); b.st[0] = nloc; b.st[1] = nx; }
        const unsigned old = xb_add(&bar[XB_XSUB(b.x)], 1u);
        const unsigned gen = old / nloc;
        if (old + 1u == (gen + 1u) * nloc) {
            __builtin_amdgcn_fence(__ATOMIC_RELEASE, "agent");
            asm volatile("s_waitcnt vmcnt(0)" ::: "memory");
            const unsigned og = xb_add(&bar[XB_TOP], 1u);
            const unsigned tg = og / nx;
            if (og + 1u == (tg + 1u) * nx) xb_add(&bar[XB_TOPGEN], 1u);
            else XB_SPIN(xb_ld(&bar[XB_TOPGEN]) == tg, bar);
            __builtin_amdgcn_fence(__ATOMIC_ACQUIRE, "agent");
            xb_add(&bar[XB_XGEN(b.x)], 1u);
            asm volatile("s_waitcnt vmcnt(0)" ::: "memory");
        } else {
            XB_SPIN(xb_ld(&bar[XB_XGEN(b.x)]) == gen, bar);
            __builtin_amdgcn_fence(__ATOMIC_ACQUIRE, "agent");
            asm volatile("s_waitcnt vmcnt(0)" ::: "memory");
        }
    }
    __syncthreads();
}


constexpr int NPHASE = 2 + 5 * DEPTH;
__global__ void __launch_bounds__(NTHREADS, 2) hybrid_fwd(KArgs Aval) {
    extern __shared__ __attribute__((aligned(16))) unsigned char lds_raw[];
    LAS unsigned char* lds = (LAS unsigned char*)lds_raw;
    const int tid0 = threadIdx.x, bid = blockIdx.x, nblk = gridDim.x;
    const int wave0 = __builtin_amdgcn_readfirstlane(tid0 >> 6);
#if !MK_MULTI
    volatile LAS unsigned* bst = (volatile LAS unsigned*)(lds + AUX_OFF + 8192);
    if (tid0 < 2) bst[tid0] = 0u;
    __syncthreads();
    const XcdBarrier bar = xcd_barrier_post((unsigned*)Aval.ws, bst);
#endif
#ifndef REP_PH
#define REP_PH 1000
#endif
#pragma unroll 1
    for (int pi = Aval.ph_lo; pi < Aval.ph_hi + (REP_PH < 1000 ? 1 : 0); ++pi) {
        const int ph = pi <= REP_PH ? pi : pi - 1;
#if !MK_MULTI
        if (pi > Aval.ph_lo) { if (Aval.ph_hi > 100000) cg::this_grid().sync(); else xcd_barrier(bar); }
#endif
#ifndef ONLY
#define ONLY -1
#endif
#define EN(k) (ONLY < 0 || ((ONLY >> (k)) & 1))
        int tid; asm volatile("v_mbcnt_lo_u32_b32 %0, -1, 0\n\tv_mbcnt_hi_u32_b32 %0, -1, %0" : "=v"(tid)); tid += wave0 * 64;
        CKArgs* Ap = (CKArgs*)__builtin_amdgcn_kernarg_segment_ptr(); asm volatile("" : "+s"(Ap));
        CKArgs& A = *Ap;
        unsigned char* ws = A.ws;
        if (ph == 0) { if (EN(0)) phase_prologue(A, lds, bid, nblk, tid); }
        else if (ph == NPHASE - 1) { if (EN(6)) phase_final(A, bid, nblk, tid); }
        else {
            const int l = (ph - 1) / 5, k = (ph - 1) % 5;
            if (k == 0) { if (EN(1)) phase_norm(A, l, bid, nblk, tid); }
            else if (k == 2) { if (EN(3)) phase_mix(A, l, lds, bid, nblk, tid); }
            else if (k == 3) { if (EN(4)) phase_tr(A, l, lds, bid, nblk, tid); }
            if (k == 1 || k == 4) {
                pg8::Gemm g; EpiAll E; E.l = l; E.Ap = Ap; g.A = (const bf16_t*)(ws + WS_HY); g.K = DM;
                if (k == 1) { g.Bt = (const bf16_t*)(ws + WS_WIN) + (size_t)l * NIN * DM; g.M = MTOT; g.N = NIN; E.mode = 0; }
                else { g.Bt = (const bf16_t*)(ws + WS_WOUT) + (size_t)l * DM * DM; g.M = MLAT; g.N = DM; E.mode = 1; }
                pg8::StaticOrder S; S.init(g.M, g.N, nblk, bid);
                if (EN(2)) pg8::gemm_phase<EpiAll, pg8::StaticOrder, true, true>(lds, g, S, E, tid);
                if (k == 1) {
                    const int nu = (MTOT / 256) * (NIN / 256), nfull = nu - ((nu - 1) / nblk) * nblk;
                    if (nfull >= nblk) filt_items(A, l, tid, bid, nblk, nullptr); else if (bid >= nfull) filt_items(A, l, tid, bid - nfull, nblk - nfull, nullptr);
                }
                if (k == 4 && l < DEPTH - 1) ctx_outproj_items(A, l, tid, bid, nblk);
            }
        }
    }
}

extern "C" void kernel_launch(void* const* d_in, const int* in_sizes, int n_in, void* d_out, int out_size, void* d_ws, size_t ws_size, hipStream_t stream) {
    static int grid = 0;
    if (grid == 0) {
        if (n_in != 22 || ws_size < WS_END) { fprintf(stderr, "kernel_launch: unexpected inputs (n_in %d, ws %zu)\n", n_in, ws_size); grid = -1; return; }
        int dev = 0, cus = 0, per_cu = 0;
        if (hipGetDevice(&dev) != hipSuccess || hipDeviceGetAttribute(&cus, hipDeviceAttributeMultiprocessorCount, dev) != hipSuccess) { grid = -1; return; }
        if (hipFuncSetAttribute((const void*)hybrid_fwd, hipFuncAttributeMaxDynamicSharedMemorySize, LDS_BYTES) != hipSuccess) { fprintf(stderr, "kernel_launch: hipFuncSetAttribute failed\n"); grid = -1; return; }
        if (hipOccupancyMaxActiveBlocksPerMultiprocessor(&per_cu, (const void*)hybrid_fwd, NTHREADS, LDS_BYTES) != hipSuccess || per_cu < 1) { fprintf(stderr, "kernel_launch: occupancy query says %d\n", per_cu); per_cu = 1; }
        (void)hipGetLastError();
        grid = cus;
    }
    if (grid < 0) return;
    KArgs a{};
    a.x = (const float*)d_in[0]; a.c = (const float*)d_in[1]; a.ctx = (const float*)d_in[2]; a.c_ctx = (const float*)d_in[3]; a.norm_g = (const float*)d_in[4];
    a.w_ada = (const float*)d_in[5]; a.b_ada = (const float*)d_in[6]; a.w_in = (const float*)d_in[7]; a.w_out = (const float*)d_in[8]; a.na_rpb = (const float*)d_in[9];
    a.hy_conv_w = (const float*)d_in[10]; a.hy_conv_b = (const float*)d_in[11]; a.hy_w1 = (const float*)d_in[12]; a.hy_b1 = (const float*)d_in[13]; a.hy_freq1 = (const float*)d_in[14];
    a.hy_w2 = (const float*)d_in[15]; a.hy_b2 = (const float*)d_in[16]; a.hy_freq2 = (const float*)d_in[17]; a.hy_w3 = (const float*)d_in[18]; a.hy_d = (const float*)d_in[19];
    a.sink = (const float*)d_in[20]; a.final_g = (const float*)d_in[21];
    a.out = (float*)d_out; a.ws = (unsigned char*)d_ws;
#if MK_MULTI
    for (int ph = 0; ph < NPHASE; ++ph) {
        a.ph_lo = ph; a.ph_hi = ph + 1;
        hipLaunchKernelGGL(hybrid_fwd, dim3(grid), dim3(NTHREADS), LDS_BYTES, stream, a);
    }
#else
    if (hipMemsetAsync(d_ws, 0, 16384, stream) != hipSuccess) { fprintf(stderr, "kernel_launch: memset of the barrier words failed\n"); return; }
    a.ph_lo = 0; a.ph_hi = NPHASE;
    void* args[] = {&a};
    hipError_t e = hipLaunchCooperativeKernel((const void*)hybrid_fwd, dim3(grid), dim3(NTHREADS), args, LDS_BYTES, stream);
    if (e != hipSuccess) fprintf(stderr, "cooperative launch failed: %s (grid %d)\n", hipGetErrorString(e), grid);
#endif
}
```

```cpp
#include <hip/hip_runtime.h>
#include <hip/hip_cooperative_groups.h>
#include <cstdio>
#include <cstdint>
namespace cg = cooperative_groups;

#ifndef MK_MULTI
#define MK_MULTI 0
#endif

namespace pg8 {
#define PG8_LAS __attribute__((address_space(3)))
typedef unsigned short bf16_t;
typedef short bf16x8 __attribute__((ext_vector_type(8)));
typedef float f32x4 __attribute__((ext_vector_type(4)));
typedef unsigned u32x4 __attribute__((ext_vector_type(4)));
constexpr int BM = 256, BK = 64, HALF = 128, HTB = HALF * BK * 2  , STAGE_BYTES = 8 * HTB, NXCD = 8, WGM = 8;

__host__ __device__ __forceinline__ int lds_byte(int r, int c) { const int st = (r >> 4) * 2 + (c >> 5), rr = r & 15, cc = c & 31, ob = rr * 64 + cc * 2; return st * 1024 + (ob ^ (((ob >> 9) & 1) << 5)); }
__host__ __device__ __forceinline__ void stage_rc(int b, int& R, int& C) { const int st = b / 1024, sb = b % 1024, swz = sb ^ (((sb >> 9) & 1) << 5); R = (st >> 1) * 16 + swz / 64; C = (st & 1) * 32 + (swz % 64) / 2; }
__host__ __device__ __forceinline__ int perm32(int rho) { const int n = rho >> 4, i = rho & 15; return 8 * (i >> 2) + 4 * n + (i & 3); }

struct Unit { int pm, pn; };
struct Gemm { const bf16_t* A; const bf16_t* Bt; int M, N, K; };

struct StaticOrder {
    int nM, nN, nwg, G, c;
    __host__ __device__ void init(int M, int N, int G_, int c_) { nM = M / BM; nN = N / BM; nwg = nM * nN; G = G_; c = c_; }
    __host__ __device__ bool next(int i, Unit& u) const {
        const long L = (long)i * G + c; if (L >= nwg) return false;
        int wgid = (int)L; { const int q = nwg / NXCD, r = nwg % NXCD, xcd = wgid % NXCD, off = wgid / NXCD; wgid = (xcd < r ? xcd * (q + 1) : r * (q + 1) + (xcd - r) * q) + off; }
        const int nig = WGM * nN, gid = wgid / nig, fm = gid * WGM, gsz = (nM - fm) < WGM ? (nM - fm) : WGM;
        u.pm = fm + ((wgid % nig) % gsz); u.pn = (wgid % nig) / gsz; return true;
    }
    __device__ __forceinline__ void a_ready(const Unit&) const {}
    __device__ __forceinline__ void done(const Unit&) const {}
};

template <class Epi, class Sched, bool ALIGN_EPI = false, bool SP2 = false>
__device__ __forceinline__ void gemm_phase(PG8_LAS unsigned char* lds, const Gemm g, const Sched& S, const Epi& E, const int tid) {
    const int wid = __builtin_amdgcn_readfirstlane(tid >> 6), lane = tid & 63, wr = wid >> 2, wc = wid & 3, fr = lane & 15, fq = lane >> 4;
    const int K = g.K, nt = K / BK;
    unsigned voffA[2], voffB[2];
#pragma unroll
    for (int i = 0; i < 2; ++i) { int R, C; stage_rc(tid * 16 + i * 8192, R, C); const int Rb = Epi::PERM ? ((R & ~31) + perm32(R & 31)) : R;
        voffA[i] = (unsigned)(R * K + C) * 2u; voffB[i] = (unsigned)(Rb * K + C) * 2u; }
    const size_t kstep = (size_t)(BK * 2);
    const size_t hstep = (size_t)HALF * K * 2;
    const size_t tstep = 2 * hstep;
    const unsigned ldsw = (unsigned)wid * 1024u;
    const int aoff = lds_byte(wr * 64 + fr, fq * 8), boff = lds_byte(wc * 32 + fr, fq * 8);
#define PG8_SA(b, h) (((b) * 2 + (h)) * HTB)
#define PG8_SB(b, h) ((4 + (b) * 2 + (h)) * HTB)
#define PG8_STAGE(bufoff, gbase, voff) do { _Pragma("unroll") for (int _i = 0; _i < 2; ++_i) \
        __builtin_amdgcn_global_load_lds((const unsigned*)((const char*)(gbase) + (voff)[_i]), (PG8_LAS unsigned*)(lds + (bufoff) + ldsw + _i * 8192), 16, 0, 0); } while (0)
#define PG8_LDA(dst, b, h) do { _Pragma("unroll") for (int m = 0; m < 4; ++m) _Pragma("unroll") for (int k = 0; k < 2; ++k) dst[m][k] = *(const PG8_LAS bf16x8*)(lds + PG8_SA(b, h) + aoff + m * 2048 + k * 1024); } while (0)
#define PG8_LDB(dst, b, h) do { _Pragma("unroll") for (int n = 0; n < 2; ++n) _Pragma("unroll") for (int k = 0; k < 2; ++k) dst[n][k] = *(const PG8_LAS bf16x8*)(lds + PG8_SB(b, h) + boff + n * 2048 + k * 1024); } while (0)
#define PG8_MMA(ai, bj, At, Bt) do { __builtin_amdgcn_s_setprio(1); _Pragma("unroll") for (int m = 0; m < 4; ++m) _Pragma("unroll") for (int n = 0; n < 2; ++n) _Pragma("unroll") for (int k = 0; k < 2; ++k) \
        acc[ai][bj][m][n] = __builtin_amdgcn_mfma_f32_16x16x32_bf16(Bt[n][k], At[m][k], acc[ai][bj][m][n], 0, 0, 0); __builtin_amdgcn_s_setprio(0); } while (0)
#define PG8_WAIT_V(n) asm volatile("s_waitcnt vmcnt(" #n ")" ::: "memory")
#define PG8_WAIT_L(n) asm volatile("s_waitcnt lgkmcnt(" #n ")" ::: "memory")
#define PG8_BAR __builtin_amdgcn_s_barrier()
#define PG8_SCHED __builtin_amdgcn_sched_barrier(0)
    Unit cur, nxt; int ui = 0;
    if (!S.next(0, cur)) return;
    f32x4 acc[2][2][4][2];
#pragma unroll
    for (int a = 0; a < 2; ++a)
#pragma unroll
        for (int b = 0; b < 2; ++b)
#pragma unroll
            for (int m = 0; m < 4; ++m)
#pragma unroll
                for (int n = 0; n < 2; ++n) acc[a][b][m][n] = (f32x4){0.f, 0.f, 0.f, 0.f};
    bf16x8 At[4][2], B0[2][2], B1[2][2];
    const char* cA = (const char*)g.A + (size_t)cur.pm * tstep; const char* cB = (const char*)g.Bt + (size_t)cur.pn * tstep;
    S.a_ready(cur);
    if constexpr (SP2) {
        PG8_STAGE(PG8_SB(0, 0), cB, voffB); PG8_STAGE(PG8_SB(0, 1), cB + hstep, voffB); PG8_STAGE(PG8_SA(0, 0), cA, voffA); PG8_STAGE(PG8_SA(0, 1), cA + hstep, voffA);
        if (wr == 1) PG8_BAR;
        PG8_WAIT_V(2); PG8_BAR;
        PG8_STAGE(PG8_SB(1, 0), cB + kstep, voffB); PG8_STAGE(PG8_SA(1, 0), cA + kstep, voffA); PG8_STAGE(PG8_SB(1, 1), cB + hstep + kstep, voffB);
        PG8_WAIT_V(6); PG8_BAR;
    } else {
        PG8_STAGE(PG8_SB(0, 0), cB, voffB); PG8_STAGE(PG8_SA(0, 0), cA, voffA); PG8_STAGE(PG8_SB(0, 1), cB + hstep, voffB); PG8_STAGE(PG8_SA(0, 1), cA + hstep, voffA);
        if (wr == 1) PG8_BAR;
        PG8_WAIT_V(4); PG8_BAR;
        PG8_STAGE(PG8_SB(1, 0), cB + kstep, voffB); PG8_STAGE(PG8_SA(1, 0), cA + kstep, voffA); PG8_STAGE(PG8_SB(1, 1), cB + hstep + kstep, voffB);
        PG8_WAIT_V(6); PG8_BAR;
    }
    for (;;) {
        const bool has_next = S.next(ui + 1, nxt);
        const char* nA = has_next ? (const char*)g.A + (size_t)nxt.pm * tstep : cA; const char* nB = has_next ? (const char*)g.Bt + (size_t)nxt.pn * tstep : cB;
        for (int t = 0; t < nt; t += 2) {
            const bool last = (t == nt - 2);
            const char* a1 = cA + (size_t)(t + 1) * kstep;
            const char* a2 = last ? nA : cA + (size_t)(t + 2) * kstep; const char* b2 = last ? nB : cB + (size_t)(t + 2) * kstep;
            const char* a3 = a2 + kstep; const char* b3 = b2 + kstep;
            if (last && has_next) S.a_ready(nxt);
            if constexpr (SP2) {
            PG8_LDB(B0, 0, 0); PG8_LDB(B1, 0, 1); PG8_SCHED; PG8_LDA(At, 0, 0); PG8_STAGE(PG8_SA(1, 1), a1 + hstep, voffA);
            PG8_WAIT_V(8); PG8_WAIT_L(0); PG8_BAR; PG8_MMA(0, 0, At, B0); PG8_MMA(0, 1, At, B1); PG8_BAR; PG8_SCHED;
            PG8_LDA(At, 0, 1); PG8_STAGE(PG8_SB(0, 0), b2, voffB); PG8_STAGE(PG8_SB(0, 1), b2 + hstep, voffB); PG8_STAGE(PG8_SA(0, 0), a2, voffA);
            PG8_WAIT_V(8); PG8_WAIT_L(0); PG8_BAR; PG8_MMA(1, 0, At, B0); PG8_MMA(1, 1, At, B1); PG8_BAR; PG8_SCHED;
            PG8_LDB(B0, 1, 0); PG8_LDB(B1, 1, 1); PG8_SCHED; PG8_LDA(At, 1, 0); PG8_STAGE(PG8_SA(0, 1), a2 + hstep, voffA);
            PG8_WAIT_V(8); PG8_WAIT_L(0); PG8_BAR; PG8_MMA(0, 0, At, B0); PG8_MMA(0, 1, At, B1); PG8_BAR; PG8_SCHED;
            PG8_LDA(At, 1, 1); PG8_STAGE(PG8_SB(1, 0), b3, voffB); PG8_STAGE(PG8_SB(1, 1), b3 + hstep, voffB); PG8_STAGE(PG8_SA(1, 0), a3, voffA);
            PG8_WAIT_V(8); PG8_WAIT_L(0); PG8_BAR; PG8_MMA(1, 0, At, B0); PG8_MMA(1, 1, At, B1); PG8_BAR; PG8_SCHED;
            } else {
            PG8_LDB(B0, 0, 0); PG8_SCHED; PG8_LDA(At, 0, 0); PG8_STAGE(PG8_SA(1, 1), a1 + hstep, voffA);
            PG8_WAIT_L(8); PG8_BAR; PG8_WAIT_L(0); PG8_MMA(0, 0, At, B0); PG8_BAR; PG8_SCHED;
            PG8_LDB(B1, 0, 1); PG8_STAGE(PG8_SB(0, 0), b2, voffB);
            PG8_BAR; PG8_WAIT_L(0); PG8_MMA(0, 1, At, B1); PG8_BAR;
            PG8_LDA(At, 0, 1); PG8_STAGE(PG8_SA(0, 0), a2, voffA);
            PG8_BAR; PG8_WAIT_L(0); PG8_MMA(1, 0, At, B0); PG8_BAR; PG8_SCHED;
            PG8_STAGE(PG8_SB(0, 1), b2 + hstep, voffB);
            PG8_WAIT_V(6); PG8_BAR; PG8_MMA(1, 1, At, B1); PG8_BAR;
            PG8_LDB(B0, 1, 0); PG8_SCHED; PG8_LDA(At, 1, 0); PG8_STAGE(PG8_SA(0, 1), a2 + hstep, voffA);
            PG8_WAIT_L(8); PG8_BAR; PG8_WAIT_L(0); PG8_MMA(0, 0, At, B0); PG8_BAR; PG8_SCHED;
            PG8_LDB(B1, 1, 1); PG8_STAGE(PG8_SB(1, 0), b3, voffB);
            PG8_BAR; PG8_WAIT_L(0); PG8_MMA(0, 1, At, B1); PG8_BAR;
            PG8_LDA(At, 1, 1); PG8_STAGE(PG8_SA(1, 0), a3, voffA);
            PG8_BAR; PG8_WAIT_L(0); PG8_MMA(1, 0, At, B0); PG8_BAR; PG8_SCHED;
            PG8_STAGE(PG8_SB(1, 1), b3 + hstep, voffB);
            PG8_WAIT_V(6); PG8_BAR; PG8_MMA(1, 1, At, B1); PG8_BAR;
            }
        }
        if constexpr (ALIGN_EPI) { if (wr == 0) PG8_BAR; }
        if constexpr (!Epi::AFTER_DRAIN) { E(acc, cur, wr, wc, fr, fq); S.done(cur); }
        if (!has_next) break;
#pragma unroll
        for (int a = 0; a < 2; ++a)
#pragma unroll
            for (int b = 0; b < 2; ++b)
#pragma unroll
                for (int m = 0; m < 4; ++m)
#pragma unroll
                    for (int n = 0; n < 2; ++n) acc[a][b][m][n] = (f32x4){0.f, 0.f, 0.f, 0.f};
        cur = nxt; cA = nA; cB = nB; ++ui;
        if constexpr (ALIGN_EPI) { if (wr == 1) PG8_BAR; }
    }
    PG8_WAIT_V(0);
    if constexpr (!ALIGN_EPI) { if (wr == 0) PG8_BAR; }
    PG8_BAR;
    if constexpr (Epi::AFTER_DRAIN) { E.fused(acc, cur, wr, wc, fr, fq, lds, wid, lane); S.done(cur); }
#undef PG8_SA
#undef PG8_SB
#undef PG8_STAGE
#undef PG8_LDA
#undef PG8_LDB
#undef PG8_MMA
#undef PG8_WAIT_V
#undef PG8_WAIT_L
#undef PG8_BAR
#undef PG8_SCHED
}
}

#define LAS __attribute__((address_space(3)))
typedef unsigned short bf16_t;
typedef short bf16x8 __attribute__((ext_vector_type(8)));
typedef float f32x4 __attribute__((ext_vector_type(4)));
typedef float f32x16 __attribute__((ext_vector_type(16)));
typedef unsigned u32x2 __attribute__((ext_vector_type(2)));
typedef unsigned u32x4 __attribute__((ext_vector_type(4)));
typedef float f32x2_t __attribute__((ext_vector_type(2)));
typedef __bf16 bf16x2_t __attribute__((ext_vector_type(2)));

constexpr int DM = 1024, NBATCH = 2, SEQ = 8192, DEPTH = 4, CTXL = 256;
constexpr int MLAT = NBATCH * SEQ, MCTX = NBATCH * CTXL, MTOT = MLAT + MCTX;
constexpr int NIN = 3584, NTM = 1536, NCM = 1024, NTB = MTOT / 64;
constexpr int C_QA = 0, C_GA = 384, C_QC = 768, C_GC = 1152;
constexpr int R_HZ = 0, R_GB = 768;
constexpr int NFFT = 16384;
constexpr float LOG2E = 1.4426950408889634f;
constexpr float QK_SCALE = 0.125f * LOG2E;

constexpr size_t MiB = 1u << 20;
constexpr size_t WS_ADA = 1 * MiB;
constexpr size_t WS_ROPE = 1 * MiB + 256 * 1024;
constexpr size_t WS_H2C = 1 * MiB + 512 * 1024;
constexpr size_t WS_CX = 2 * MiB;
constexpr size_t WS_H2 = 4 * MiB;
constexpr size_t WS_WIN = 12 * MiB;
constexpr size_t WS_WOUT = 40 * MiB;
constexpr size_t WS_HY = 48 * MiB;
constexpr size_t WS_PT = 81 * MiB;
constexpr size_t WS_KH = 130 * MiB + 512 * 1024;
constexpr size_t WS_VT = 147 * MiB;
constexpr size_t WS_PCT = 163 * MiB + 512 * 1024;
constexpr size_t WS_YBT = 197 * MiB;
constexpr size_t WS_XB = 206 * MiB;
constexpr size_t OUT_ZS = 0;
constexpr size_t OUT_FILT = 32 * MiB;
constexpr size_t OUT_YBT = 48 * MiB;
constexpr size_t WS_W3T = 238 * MiB;
constexpr size_t WS_FILT = 239 * MiB;
constexpr size_t WS_END = 255 * MiB;
static_assert(WS_PT + (size_t)MTOT * NTM * 2 <= WS_KH && WS_KH + (size_t)8 * MTOT * 128 <= WS_VT && WS_VT + (size_t)8 * MTOT * 128 <= WS_PCT && WS_PCT + (size_t)NCM * MTOT * 2 <= WS_YBT, "d_ws map");

constexpr int AUX_OFF = 147456;
constexpr int LDS_BYTES = 163840;
constexpr int NTHREADS = 512;

struct KArgs {
    const float* x; const float* c; const float* ctx; const float* c_ctx; const float* norm_g; const float* w_ada; const float* b_ada;
    const float* w_in; const float* w_out; const float* na_rpb; const float* hy_conv_w; const float* hy_conv_b;
    const float* hy_w1; const float* hy_b1; const float* hy_freq1; const float* hy_w2; const float* hy_b2; const float* hy_freq2; const float* hy_w3;
    const float* hy_d; const float* sink; const float* final_g;
    float* out; unsigned char* ws;
    int ph_lo, ph_hi;
};

typedef const __attribute__((address_space(4))) KArgs CKArgs;
__device__ __forceinline__ unsigned pk2(float lo, float hi) { f32x2_t v = {lo, hi}; bf16x2_t b = __builtin_convertvector(v, bf16x2_t); return __builtin_bit_cast(unsigned, b); }
__device__ __forceinline__ float bf2f(unsigned short u) { return __uint_as_float(((unsigned)u) << 16); }
__device__ __forceinline__ float bflo(unsigned w) { return __uint_as_float(w << 16); }
__device__ __forceinline__ float bfhi(unsigned w) { return __uint_as_float(w & 0xffff0000u); }
__device__ __forceinline__ float silu_f(float x) { return x / (1.0f + __expf(-x)); }
__device__ __forceinline__ float lane_xor(float v, int lane, int m) { return __int_as_float(__builtin_amdgcn_ds_bpermute((lane ^ m) << 2, __float_as_int(v))); }
__device__ __forceinline__ float lane_prev(float v, int lane) { return __int_as_float(__builtin_amdgcn_ds_bpermute(((lane - 1) & 63) << 2, __float_as_int(v))); }
__device__ __forceinline__ float lane_next(float v, int lane) { return __int_as_float(__builtin_amdgcn_ds_bpermute(((lane + 1) & 63) << 2, __float_as_int(v))); }
__device__ __forceinline__ float wave_sum(float v, int lane) {
#pragma unroll
    for (int o = 1; o < 64; o <<= 1) v += lane_xor(v, lane, o);
    return v;
}
__device__ __forceinline__ float rdlane(float v, int l) { return __uint_as_float(__builtin_amdgcn_readlane(__float_as_uint(v), l)); }

__device__ __forceinline__ void transpose_item(const float* W, int K, int N, bf16_t* WT, int k0, int n0, int drow0, LAS float* scr, int lane, int ldk = 0) {
    if (ldk == 0) ldk = K;
#pragma unroll 8
    for (int i = 0; i < 32; ++i) { const int kk = 2 * i + (lane >> 5); scr[kk * 33 + (lane & 31)] = W[(size_t)(k0 + kk) * N + n0 + (lane & 31)]; }
    asm volatile("s_waitcnt lgkmcnt(0)" ::: "memory");
    const int c = lane & 7;
#pragma unroll
    for (int j = 0; j < 4; ++j) { const int n = (lane >> 3) + 8 * j; const LAS float* s = scr + (8 * c) * 33 + n;
        u32x4 o; o.x = pk2(s[0 * 33], s[1 * 33]); o.y = pk2(s[2 * 33], s[3 * 33]); o.z = pk2(s[4 * 33], s[5 * 33]); o.w = pk2(s[6 * 33], s[7 * 33]);
        *(u32x4*)(WT + (size_t)(drow0 + n) * ldk + k0 + 8 * c) = o; }
    asm volatile("s_waitcnt lgkmcnt(0)" ::: "memory");
}
__device__ __forceinline__ int win_row(int n0) {
    if (n0 < 384) return n0;
    if (n0 < 768) return n0 - 384 + 1536;
    if (n0 < 1152) return n0 - 768 + 2048;
    if (n0 < 1536) return n0 - 1152 + 384;
    if (n0 < 2304) return n0 - 1536 + 2560;
    if (n0 < 2560) return n0 - 2304 + 3328;
    if (n0 < 2944) return n0 - 2560 + 768;
    if (n0 < 3072) return n0 - 2944 + 1920;
    if (n0 < 3200) return n0 - 3072 + 2432;
    return n0 - 3200 + 1152;
}

__device__ __forceinline__ void phase_prologue(CKArgs& A, LAS unsigned char* lds, int bid, int nblk, int tid) {
    const int wave = __builtin_amdgcn_readfirstlane(tid >> 6), lane = tid & 63;
    const int gw = bid * 8 + wave, NGW = nblk * 8;
    unsigned char* ws = A.ws;
    {
        LAS float* scr = (LAS float*)(lds + wave * 16384);
        constexpr int I_IN = 16 * 112, I_OUT = 16 * 32, I_L = I_IN + I_OUT;
        for (int it = gw; it < DEPTH * I_L; it += NGW) {
            const int l = it / I_L; int r = it % I_L;
            if (r < I_IN) { const int kb = r / 112, nb = r % 112, n0 = nb * 32;
                transpose_item(A.w_in + (size_t)l * DM * NIN, DM, NIN, (bf16_t*)(ws + WS_WIN) + (size_t)l * NIN * DM, kb * 64, n0, win_row(n0), scr, lane); }
            else { r -= I_IN; const int kb = r / 32, nb = r % 32, n0 = nb * 32;
                transpose_item(A.w_out + (size_t)l * DM * DM, DM, DM, (bf16_t*)(ws + WS_WOUT) + (size_t)l * DM * DM, kb * 64, n0, n0, scr, lane); }
        }
    }
    {
        LAS float* scr = (LAS float*)(lds + wave * 16384);
        bf16_t* W3T = (bf16_t*)(ws + WS_W3T);
        for (int it = gw; it < DEPTH * 32; it += NGW) { const int l = it >> 5, nb = it & 31;
            transpose_item(A.hy_w3 + (size_t)l * 64 * 1024, 64, 1024, W3T + (size_t)l * 1024 * 64, 0, nb * 32, nb * 32, scr, lane); }
    }
    for (int idx = gw * 64 + lane; idx < 128 * 16; idx += NGW * 64) {
        const int p = idx >> 4, i = idx & 15;
        const float inv = powf(10000.0f, -(float)i / 16.0f);
        const float ang = (float)p * inv;
        ((float2*)(ws + WS_ROPE))[idx] = make_float2(cosf(ang), sinf(ang));
    }
    for (int it = gw; it < DEPTH * 528; it += NGW) {
        const int l = it / 528, g4 = it % 528, g = g4 >> 2, sub = g4 & 3;
        const int L = g < 128 ? SEQ : CTXL;
        const int n0 = (g < 128 ? g * 64 : (g - 128) * 64) + 16 * sub;
        float* outp = (float*)(ws + WS_H2C) + ((size_t)l * CTXL + n0) * 64;
        bf16_t* outb = (bf16_t*)(ws + WS_H2) + ((size_t)l * SEQ + n0) * 64;
        float w1c[33], w2c[64];
#pragma unroll
        for (int q = 0; q < 33; ++q) w1c[q] = A.hy_w1[((size_t)l * 33 + q) * 64 + lane];
#pragma unroll
        for (int j = 0; j < 64; ++j) w2c[j] = A.hy_w2[((size_t)l * 64 + j) * 64 + lane];
        const float b1 = A.hy_b1[l * 64 + lane], fr1 = A.hy_freq1[l * 64 + lane], b2 = A.hy_b2[l * 64 + lane], fr2 = A.hy_freq2[l * 64 + lane];
        const float tstep = 1.0f / (float)(L - 1);
        const int fj = lane == 0 ? 0 : ((lane - 1) & 15);
        const float fq = 1e-4f + (float)fj * ((15.0f - 1e-4f) / 15.0f);
#pragma unroll 1
        for (int nn = 0; nn < 16; ++nn) {
            const int n = n0 + nn;
            const float t = (float)n * tstep;
            const float rev = fq * ((float)n * (1.0f / (float)L)) + (lane <= 16 ? 0.25f : 0.5f);
            float zq = __builtin_amdgcn_sinf(rev - floorf(rev));
            if (lane == 0) zq = t; if (lane > 32) zq = 0.f;
            float a1 = b1;
#pragma unroll
            for (int q = 0; q < 33; ++q) a1 += rdlane(zq, q) * w1c[q];
            const float x1 = fr1 * a1 * 0.15915494309189535f;
            const float h1 = __builtin_amdgcn_sinf(x1 - floorf(x1));
            float a2 = b2;
#pragma unroll
            for (int j = 0; j < 64; ++j) a2 += rdlane(h1, j) * w2c[j];
            const float x2 = fr2 * a2 * 0.15915494309189535f;
            const float h2 = __builtin_amdgcn_sinf(x2 - floorf(x2));
            if (g < 128) outb[nn * 64 + lane] = (bf16_t)(pk2(h2, 0.f) & 0xffffu);
            else outp[nn * 64 + lane] = h2;
        }
    }
    __syncthreads();
    {
        LAS float* red = (LAS float*)lds;
        LAS float* sv = (LAS float*)(lds + 8192);
        for (int i = tid; i < 3 * DM; i += NTHREADS) sv[i] = silu_f(i < 2 * DM ? A.c[i] : A.c_ctx[i - 2 * DM]);
        __syncthreads();
        for (int it = bid; it < DEPTH * 48; it += nblk) {
            const int l = it / 48, n = (it % 48) * 64 + lane;
            const float* W = A.w_ada + (size_t)l * DM * 3072 + n;
            float a0 = 0.f, a1 = 0.f, a2 = 0.f;
            const int kb = wave * 128;
#pragma unroll 1
            for (int k0 = 0; k0 < 128; k0 += 16) {
                float w[16];
#pragma unroll
                for (int k = 0; k < 16; ++k) w[k] = W[(size_t)(kb + k0 + k) * 3072];
#pragma unroll
                for (int k = 0; k < 16; ++k) { a0 += sv[kb + k0 + k] * w[k]; a1 += sv[DM + kb + k0 + k] * w[k]; a2 += sv[2 * DM + kb + k0 + k] * w[k]; }
            }
            red[(wave * 3 + 0) * 64 + lane] = a0; red[(wave * 3 + 1) * 64 + lane] = a1; red[(wave * 3 + 2) * 64 + lane] = a2;
            __syncthreads();
            if (tid < 192) { const int v = tid >> 6; float sacc = A.b_ada[l * 3072 + n];
#pragma unroll
                for (int w = 0; w < 8; ++w) sacc += red[(w * 3 + v) * 64 + lane];
                ((float*)(ws + WS_ADA))[((size_t)l * 3 + v) * 3072 + n] = sacc; }
            __syncthreads();
        }
    }
}

__device__ __forceinline__ void filt_items(CKArgs& A, int lf, int tid, int bid, int nblk, unsigned* ctr) {
    unsigned char* ws = A.ws;
    const int wave = __builtin_amdgcn_readfirstlane(tid >> 6), lane = tid & 63;
    const int gw = bid * 8 + wave, NGW = nblk * 8;
    const bf16_t* H2B = (const bf16_t*)(ws + WS_H2) + (size_t)lf * SEQ * 64;
    const bf16_t* W3T = (const bf16_t*)(ws + WS_W3T) + (size_t)lf * 1024 * 64;
    bf16_t* FILT = (bf16_t*)((unsigned char*)A.out + OUT_FILT);
    const int fr = lane & 15, fq = lane >> 4;
    int it = gw;
#pragma unroll 1
    for (;;) {
        if (ctr) { unsigned t = 0; if (lane == 0) t = __hip_atomic_fetch_add(ctr, 1u, __ATOMIC_RELAXED, __HIP_MEMORY_SCOPE_AGENT); it = (int)__builtin_amdgcn_readfirstlane(t); }
        if (it >= 2048) break;
        const int n0 = (it >> 4) * 64, c0 = (it & 15) * 64;
        bf16x8 af[4][2];
#pragma unroll
        for (int j = 0; j < 4; ++j) { const bf16_t* ap = H2B + (size_t)(n0 + 16 * (fr >> 2) + 4 * j + (fr & 3)) * 64 + 8 * fq; af[j][0] = *(const bf16x8*)ap; af[j][1] = *(const bf16x8*)(ap + 32); }
#pragma unroll 1
        for (int ct = 0; ct < 4; ++ct) {
            const bf16_t* bp = W3T + (size_t)(c0 + 16 * ct + fr) * 64 + 8 * fq;
            const bf16x8 b0 = *(const bf16x8*)bp, b1 = *(const bf16x8*)(bp + 32);
            u32x4 o0, o1;
#pragma unroll
            for (int j = 0; j < 4; ++j) {
                f32x4 acc = {0.f, 0.f, 0.f, 0.f};
                acc = __builtin_amdgcn_mfma_f32_16x16x32_bf16(af[j][0], b0, acc, 0, 0, 0);
                acc = __builtin_amdgcn_mfma_f32_16x16x32_bf16(af[j][1], b1, acc, 0, 0, 0);
                const unsigned w0 = pk2(acc.x, acc.y), w1 = pk2(acc.z, acc.w);
                if (j == 0) { o0.x = w0; o0.y = w1; } else if (j == 1) { o0.z = w0; o0.w = w1; } else if (j == 2) { o1.x = w0; o1.y = w1; } else { o1.z = w0; o1.w = w1; }
            }
            bf16_t* dp = FILT + (size_t)(c0 + 16 * ct + fr) * SEQ + n0 + 16 * fq;
            *(u32x4*)dp = o0; *(u32x4*)(dp + 8) = o1;
        }
        if (!ctr) it += NGW;
    }
}

__device__ __forceinline__ void ctx_outproj_items(CKArgs& A, int l, LAS unsigned char* lds, int tid, int bid, int nblk) {
    unsigned char* ws = A.ws;
    const int wave = __builtin_amdgcn_readfirstlane(tid >> 6), lane = tid & 63;
    const bf16_t* Y = (const bf16_t*)(ws + WS_HY) + (size_t)MLAT * DM;
    const bf16_t* WT = (const bf16_t*)(ws + WS_WOUT) + (size_t)l * DM * DM;
    const float* gate = (const float*)(ws + WS_ADA) + ((size_t)l * 3 + 2) * 3072 + 2048;
    const float* csrc = l == 0 ? A.ctx : (const float*)(ws + WS_CX);
    float* cdst = (float*)(ws + WS_CX);
    const int r31 = lane & 31, hh = lane >> 5;
    LAS float* part = (LAS float*)lds;
#pragma unroll 1
    for (int it = bid; it < 256; it += nblk) {
        const int T = 2 * it + (wave >> 2), kq = wave & 3;
        const int r0 = (T >> 5) * 32, c0 = (T & 31) * 32;
        const bf16_t* ap = WT + (size_t)(c0 + r31) * DM + 256 * kq + 8 * hh;
        const bf16_t* bp = Y + (size_t)(r0 + r31) * DM + 256 * kq + 8 * hh;
        f32x16 acc;
#pragma unroll
        for (int i = 0; i < 16; ++i) acc[i] = 0.f;
#pragma unroll 1
        for (int k0 = 0; k0 < 16; k0 += 8) {
            bf16x8 a[8], b[8];
#pragma unroll
            for (int k = 0; k < 8; ++k) { a[k] = *(const bf16x8*)(ap + 16 * (k0 + k)); b[k] = *(const bf16x8*)(bp + 16 * (k0 + k)); }
#pragma unroll
            for (int k = 0; k < 8; ++k) acc = __builtin_amdgcn_mfma_f32_32x32x16_bf16(a[k], b[k], acc, 0, 0, 0);
        }
        __syncthreads();
        LAS float* pw = part + wave * (32 * 36) + r31 * 36 + 4 * hh;
#pragma unroll
        for (int g = 0; g < 4; ++g) *(LAS f32x4*)(pw + 8 * g) = (f32x4){acc[4 * g], acc[4 * g + 1], acc[4 * g + 2], acc[4 * g + 3]};
        __syncthreads();
        {
            const int tt = tid >> 8, row = (tid & 255) >> 3, col = 4 * (tid & 7);
            const int T2 = 2 * it + tt, rr = (T2 >> 5) * 32 + row, cc = (T2 & 31) * 32 + col;
            LAS const float* pr = part + (4 * tt) * (32 * 36) + row * 36 + col;
            const f32x4 s = (*(LAS const f32x4*)pr + *(LAS const f32x4*)(pr + 32 * 36)) + (*(LAS const f32x4*)(pr + 2 * 32 * 36) + *(LAS const f32x4*)(pr + 3 * 32 * 36));
            const f32x4 g = *(const f32x4*)(gate + cc);
            const size_t off = (size_t)rr * DM + cc;
            *(f32x4*)(cdst + off) = *(const f32x4*)(csrc + off) + g * s;
        }
    }
}

__device__ __forceinline__ void norm_load_row(CKArgs& A, int l, int m, int lane, f32x4 (&xv)[4]) {
    unsigned char* ws = A.ws;
    if ((m < MLAT) && (l > 0)) {
        const bf16_t* sb = (const bf16_t*)(ws + WS_XB) + (size_t)m * DM;
#pragma unroll
        for (int j = 0; j < 4; ++j) { const u32x2 w = *(const u32x2*)(sb + 4 * lane + 256 * j); xv[j] = (f32x4){bflo(w.x), bfhi(w.x), bflo(w.y), bfhi(w.y)}; }
    } else {
        const float* src = (m < MLAT) ? A.x + (size_t)m * DM : (l == 0 ? A.ctx : (const float*)(ws + WS_CX)) + (size_t)(m - MLAT) * DM;
#pragma unroll
        for (int j = 0; j < 4; ++j) xv[j] = *(const f32x4*)(src + 4 * lane + 256 * j);
    }
}
__device__ __forceinline__ float norm_sumsq(const f32x4 (&xv)[4]) {
    float ss = 0.f;
#pragma unroll
    for (int j = 0; j < 4; ++j) ss += (xv[j].x * xv[j].x + xv[j].y * xv[j].y) + (xv[j].z * xv[j].z + xv[j].w * xv[j].w);
    return ss;
}
__device__ __forceinline__ void phase_norm(CKArgs& A, int l, int bid, int nblk, int tid) {
    const int wave = __builtin_amdgcn_readfirstlane(tid >> 6), lane = tid & 63;
    const int gw = bid * 8 + wave, NGW = nblk * 8;
    unsigned char* ws = A.ws;
    bf16_t* H = (bf16_t*)(ws + WS_HY);
    const float* ada = (const float*)(ws + WS_ADA) + (size_t)l * 3 * 3072;
    const float* g = A.norm_g + l * DM;
#pragma unroll 1
    for (int m0 = gw; m0 < MTOT; m0 += 2 * NGW) {
        const int m1 = m0 + NGW; const bool has1 = m1 < MTOT; const int m1c = has1 ? m1 : m0;
        f32x4 xa[4], xc[4];
        norm_load_row(A, l, m0, lane, xa); norm_load_row(A, l, m1c, lane, xc);
        const float* sh0 = ada + (m0 < MLAT ? m0 >> 13 : 2) * 3072; const float* sh1 = ada + (m1c < MLAT ? m1c >> 13 : 2) * 3072;
        const float ra = rsqrtf(wave_sum(norm_sumsq(xa), lane) * (1.0f / DM) + 1e-6f);
        const float rc = rsqrtf(wave_sum(norm_sumsq(xc), lane) * (1.0f / DM) + 1e-6f);
#pragma unroll
        for (int j = 0; j < 4; ++j) { const int col = 4 * lane + 256 * j;
            const f32x4 gv = *(const f32x4*)(g + col);
            { const f32x4 sc = *(const f32x4*)(sh0 + DM + col), sh = *(const f32x4*)(sh0 + col);
              const f32x4 h = xa[j] * ra * gv * (sc + 1.0f) + sh;
              u32x2 o; o.x = pk2(h.x, h.y); o.y = pk2(h.z, h.w);
              *(u32x2*)(H + (size_t)m0 * DM + col) = o; }
            if (has1) { const f32x4 sc = *(const f32x4*)(sh1 + DM + col), sh = *(const f32x4*)(sh1 + col);
              const f32x4 h = xc[j] * rc * gv * (sc + 1.0f) + sh;
              u32x2 o; o.x = pk2(h.x, h.y); o.y = pk2(h.z, h.w);
              *(u32x2*)(H + (size_t)m1 * DM + col) = o; }
        }
    }
}

struct EpiIn {
    static constexpr bool PERM = true, AFTER_DRAIN = false;
    bf16_t* PT; bf16_t* KH; bf16_t* PCT; const float2* rope;
    __device__ __forceinline__ void operator()(const f32x4 (&acc)[2][2][4][2], const pg8::Unit& u, int wr, int wc, int fr, int fq) const {
        const int row0 = u.pm * 256 + wr * 64 + fr;
        if (u.pn < 10) {
#pragma unroll
            for (int bj = 0; bj < 2; ++bj) {
                const int blk = 2 * u.pn + bj;
                const bool rp = ((blk >= 6 && blk <= 8) || blk == 15) && (u.pm < 64);
                const int col0 = 256 * u.pn + 128 * bj + 32 * wc + 8 * fq;
                bf16_t* dst; size_t ld;
                if (u.pn < 6) { dst = PT + col0; ld = NTM; }
                else { const int n2 = col0 - 1536; dst = KH + (size_t)(n2 >> 6) * MTOT * 64 + (n2 & 63); ld = 64; }
#pragma unroll
                for (int ai = 0; ai < 2; ++ai)
#pragma unroll
                    for (int m = 0; m < 4; ++m) {
                        const int r = row0 + 128 * ai + 16 * m;
                        f32x4 v0 = acc[ai][bj][m][0], v1 = acc[ai][bj][m][1];
                        if (rp) {
                            const int pos = r & (SEQ - 1);
                            const int p = (wc & 1) ? (pos & 63) : (pos >> 6);
                            const f32x4* tb = (const f32x4*)(rope + p * 16 + 8 * (fq & 1));
                            const int ln = fr + 16 * fq;
                            const float sg = (fq < 2) ? -1.0f : 1.0f;
                            { const f32x4 t0 = tb[0], t1 = tb[1];
                              const float qx = lane_xor(v0.x, ln, 32), qy = lane_xor(v0.y, ln, 32), qz = lane_xor(v0.z, ln, 32), qw = lane_xor(v0.w, ln, 32);
                              v0.x = v0.x * t0.x + sg * qx * t0.y; v0.y = v0.y * t0.z + sg * qy * t0.w; v0.z = v0.z * t1.x + sg * qz * t1.y; v0.w = v0.w * t1.z + sg * qw * t1.w; }
                            { const f32x4 t2 = tb[2], t3 = tb[3];
                              const float qx = lane_xor(v1.x, ln, 32), qy = lane_xor(v1.y, ln, 32), qz = lane_xor(v1.z, ln, 32), qw = lane_xor(v1.w, ln, 32);
                              v1.x = v1.x * t2.x + sg * qx * t2.y; v1.y = v1.y * t2.z + sg * qy * t2.w; v1.z = v1.z * t3.x + sg * qz * t3.y; v1.w = v1.w * t3.z + sg * qw * t3.w; }
                        }
                        u32x4 w; w.x = pk2(v0.x, v0.y); w.y = pk2(v0.z, v0.w); w.z = pk2(v1.x, v1.y); w.w = pk2(v1.z, v1.w);
                        *(u32x4*)(dst + (size_t)r * ld) = w;
                        asm volatile("" ::: "memory");
                    }
            }
        } else {
#pragma unroll
            for (int bj = 0; bj < 2; ++bj) {
                const int ch0 = 256 * (u.pn - 10) + 128 * bj + 32 * wc + 8 * fq;
#pragma unroll
                for (int ai = 0; ai < 2; ++ai)
#pragma unroll
                    for (int m = 0; m < 4; ++m) {
                        const int r = row0 + 128 * ai + 16 * m;
                        bf16_t* p = PCT + (size_t)ch0 * MTOT + r;
#pragma unroll
                        for (int n = 0; n < 2; ++n) {
                            const f32x4 v = acc[ai][bj][m][n];
                            bf16_t* q = p + (size_t)(4 * n) * MTOT;
                            const unsigned w0 = pk2(v.x, v.y), w1 = pk2(v.z, v.w);
                            q[0] = (bf16_t)(w0 & 0xffffu); q[MTOT] = (bf16_t)(w0 >> 16); q[2 * (size_t)MTOT] = (bf16_t)(w1 & 0xffffu); q[3 * (size_t)MTOT] = (bf16_t)(w1 >> 16);
                        }
                    }
            }
        }
    }
};
struct EpiFilt {
    static constexpr bool PERM = true, AFTER_DRAIN = false;
    bf16_t* O; int ldc;
    __device__ __forceinline__ void operator()(const f32x4 (&acc)[2][2][4][2], const pg8::Unit& u, int wr, int wc, int fr, int fq) const {
        const int row0 = u.pm * 256 + wr * 64 + fr;
#pragma unroll
        for (int bj = 0; bj < 2; ++bj) { const int col0 = 256 * u.pn + 128 * bj + 32 * wc + 8 * fq;
#pragma unroll
            for (int ai = 0; ai < 2; ++ai)
#pragma unroll
                for (int m = 0; m < 4; ++m) { const int r = row0 + 128 * ai + 16 * m; const f32x4 v0 = acc[ai][bj][m][0], v1 = acc[ai][bj][m][1];
                    u32x4 w; w.x = pk2(v0.x, v0.y); w.y = pk2(v0.z, v0.w); w.z = pk2(v1.x, v1.y); w.w = pk2(v1.z, v1.w);
                    *(u32x4*)(O + (size_t)r * ldc + col0) = w; } }
    }
};
struct EpiOut {
    static constexpr bool PERM = true, AFTER_DRAIN = false;
    const float* xsrc; bf16_t* xb; float* xdst; const float* ada; bool src32, dst32;
    __device__ __forceinline__ void operator()(const f32x4 (&acc)[2][2][4][2], const pg8::Unit& u, int wr, int wc, int fr, int fq) const {
        const int row0 = u.pm * 256 + wr * 64 + fr;
        const int v = row0 >> 13;
#pragma unroll
        for (int bj = 0; bj < 2; ++bj) {
            const int col0 = 256 * u.pn + 128 * bj + 32 * wc + 8 * fq;
            const float* gp = ada + v * 3072 + 2048 + col0;
            const f32x4 g0 = *(const f32x4*)gp, g1 = *(const f32x4*)(gp + 4);
#pragma unroll
            for (int ai = 0; ai < 2; ++ai)
#pragma unroll
              for (int mh = 0; mh < 2; ++mh) {
                f32x4 x0[2], x1[2];
                if (src32) {
#pragma unroll
                    for (int mm = 0; mm < 2; ++mm) { const float* sp = xsrc + (size_t)(row0 + 128 * ai + 16 * (2 * mh + mm)) * DM + col0; x0[mm] = *(const f32x4*)sp; x1[mm] = *(const f32x4*)(sp + 4); }
                } else {
#pragma unroll
                    for (int mm = 0; mm < 2; ++mm) { const u32x4 w = *(const u32x4*)(xb + (size_t)(row0 + 128 * ai + 16 * (2 * mh + mm)) * DM + col0);
                        x0[mm] = (f32x4){bflo(w.x), bfhi(w.x), bflo(w.y), bfhi(w.y)}; x1[mm] = (f32x4){bflo(w.z), bfhi(w.z), bflo(w.w), bfhi(w.w)}; }
                }
#pragma unroll
                for (int mm = 0; mm < 2; ++mm) { const int m = 2 * mh + mm; const size_t off = (size_t)(row0 + 128 * ai + 16 * m) * DM + col0;
                    const f32x4 y0 = x0[mm] + g0 * acc[ai][bj][m][0], y1 = x1[mm] + g1 * acc[ai][bj][m][1];
                    if (dst32) { *(f32x4*)(xdst + off) = y0; *(f32x4*)(xdst + off + 4) = y1; }
                    else { u32x4 w; w.x = pk2(y0.x, y0.y); w.y = pk2(y0.z, y0.w); w.z = pk2(y1.x, y1.y); w.w = pk2(y1.z, y1.w); *(u32x4*)(xb + off) = w; } }
                asm volatile("" ::: "memory");
              }
        }
    }
};
struct EpiAll {
    static constexpr bool PERM = true, AFTER_DRAIN = false;
    int mode, l; CKArgs* Ap;
    __device__ __forceinline__ void operator()(const f32x4 (&acc)[2][2][4][2], const pg8::Unit& u, int wr, int wc, int fr, int fq) const {
        unsigned char* ws = Ap->ws;
        if (mode == 0) { const EpiIn E{(bf16_t*)(ws + WS_PT), (bf16_t*)(ws + WS_KH), (bf16_t*)(ws + WS_PCT), (const float2*)(ws + WS_ROPE)}; E(acc, u, wr, wc, fr, fq); }
        else { const EpiOut E{Ap->x, (bf16_t*)(ws + WS_XB), Ap->out, (const float*)(ws + WS_ADA) + (size_t)l * 3 * 3072, l == 0, false}; E(acc, u, wr, wc, fr, fq); }
    }
};
__device__ __forceinline__ float max3f(float a, float b, float c) { float r; asm("v_max3_f32 %0, %1, %2, %3" : "=v"(r) : "v"(a), "v"(b), "v"(c)); return r; }
__device__ __forceinline__ float max2f(float a, float b) { float r; asm("v_max_f32_e32 %0, %1, %2" : "=v"(r) : "v"(a), "v"(b)); return r; }
__device__ __forceinline__ float max4f_mfma(float a, float b, float c, float d) { float r; asm("s_nop 15\n\ts_nop 7\n\tv_max3_f32 %0, %1, %2, %3\n\tv_max_f32_e32 %0, %0, %4" : "=&v"(r) : "v"(a), "v"(b), "v"(c), "v"(d)); return r; }
__device__ __forceinline__ void attn_tile(LAS const unsigned char* slot, int cs, const bf16x8 (&bq)[4], f32x16& o0, f32x16& o1, float& m_run, float& l_run,
                                          int r31, int hh, bool use_mask, int clo, int chi, bool use_bias, LAS const float* btab, int bidx) {
    const int kr = cs + r31;
    LAS const unsigned char* kp = slot + kr * 128;
    const int ksw = (kr >> 1) & 7;
    const bf16x8 ka0 = *(LAS const bf16x8*)(kp + 16 * ((0 + hh) ^ ksw)), ka1 = *(LAS const bf16x8*)(kp + 16 * ((2 + hh) ^ ksw));
    const bf16x8 ka2 = *(LAS const bf16x8*)(kp + 16 * ((4 + hh) ^ ksw)), ka3 = *(LAS const bf16x8*)(kp + 16 * ((6 + hh) ^ ksw));
    LAS const unsigned char* vp = slot + 8192 + r31 * 128;
    const int vsw = (r31 >> 1) & 15, g0 = (cs >> 2) + hh;
    const u32x2 a0l = *(LAS const u32x2*)(vp + 8 * ((g0) ^ vsw)), a0h = *(LAS const u32x2*)(vp + 8 * ((g0 + 2) ^ vsw));
    const u32x2 a1l = *(LAS const u32x2*)(vp + 8 * ((g0 + 4) ^ vsw)), a1h = *(LAS const u32x2*)(vp + 8 * ((g0 + 6) ^ vsw));
    const u32x2 b0l = *(LAS const u32x2*)(vp + 4096 + 8 * ((g0) ^ vsw)), b0h = *(LAS const u32x2*)(vp + 4096 + 8 * ((g0 + 2) ^ vsw));
    const u32x2 b1l = *(LAS const u32x2*)(vp + 4096 + 8 * ((g0 + 4) ^ vsw)), b1h = *(LAS const u32x2*)(vp + 4096 + 8 * ((g0 + 6) ^ vsw));
    f32x16 s, t;
#pragma unroll
    for (int i = 0; i < 16; ++i) { s[i] = 0.f; t[i] = 0.f; }
    s = __builtin_amdgcn_mfma_f32_32x32x16_bf16(ka0, bq[0], s, 0, 0, 0); t = __builtin_amdgcn_mfma_f32_32x32x16_bf16(ka1, bq[1], t, 0, 0, 0);
    s = __builtin_amdgcn_mfma_f32_32x32x16_bf16(ka2, bq[2], s, 0, 0, 0); t = __builtin_amdgcn_mfma_f32_32x32x16_bf16(ka3, bq[3], t, 0, 0, 0);
    if (use_bias) {
        LAS const float* bp = btab + bidx;
#pragma unroll
        for (int i = 0; i < 16; ++i) { const int c = (i & 3) + 8 * (i >> 2) + 4 * hh; s[i] = (s[i] + t[i]) * QK_SCALE + bp[c]; }
    } else {
#pragma unroll
        for (int i = 0; i < 16; ++i) s[i] = (s[i] + t[i]) * QK_SCALE;
    }
    if (use_mask) {
        const unsigned off = (unsigned)(4 * hh - clo), rng = (unsigned)(chi - clo);
        const bool any = chi >= clo;
#pragma unroll
        for (int i = 0; i < 16; ++i) { const unsigned c0 = (unsigned)((i & 3) + 8 * (i >> 2)); s[i] = (any && (c0 + off <= rng)) ? s[i] : -INFINITY; }
    }
    float tmax = max3f(s[0], s[1], s[2]);
#pragma unroll
    for (int i = 3; i < 15; i += 2) tmax = max3f(tmax, s[i], s[i + 1]);
    tmax = max2f(tmax, s[15]);
    tmax = max2f(tmax, lane_xor(tmax, r31 + 32 * hh, 32));
    if (__any(tmax - m_run > 8.0f)) {
        const float m_new = fmaxf(m_run, tmax);
        const float alpha = __builtin_amdgcn_exp2f(m_run - m_new);
        m_run = m_new; l_run *= alpha;
#pragma unroll
        for (int i = 0; i < 16; ++i) { o0[i] *= alpha; o1[i] *= alpha; }
    }
    float ps0 = 0.f, ps1 = 0.f;
#pragma unroll
    for (int i = 0; i < 16; i += 2) { const float p0 = __builtin_amdgcn_exp2f(s[i] - m_run), p1 = __builtin_amdgcn_exp2f(s[i + 1] - m_run); s[i] = p0; s[i + 1] = p1; ps0 += p0; ps1 += p1; }
    l_run += ps0 + ps1;
    u32x4 pw0, pw1;
    pw0.x = pk2(s[0], s[1]); pw0.y = pk2(s[2], s[3]); pw0.z = pk2(s[4], s[5]); pw0.w = pk2(s[6], s[7]);
    pw1.x = pk2(s[8], s[9]); pw1.y = pk2(s[10], s[11]); pw1.z = pk2(s[12], s[13]); pw1.w = pk2(s[14], s[15]);
    const bf16x8 pb0 = __builtin_bit_cast(bf16x8, pw0), pb1 = __builtin_bit_cast(bf16x8, pw1);
    u32x4 w;
    w.x = a0l.x; w.y = a0l.y; w.z = a0h.x; w.w = a0h.y; const bf16x8 va00 = __builtin_bit_cast(bf16x8, w);
    w.x = a1l.x; w.y = a1l.y; w.z = a1h.x; w.w = a1h.y; const bf16x8 va01 = __builtin_bit_cast(bf16x8, w);
    w.x = b0l.x; w.y = b0l.y; w.z = b0h.x; w.w = b0h.y; const bf16x8 va10 = __builtin_bit_cast(bf16x8, w);
    w.x = b1l.x; w.y = b1l.y; w.z = b1h.x; w.w = b1h.y; const bf16x8 va11 = __builtin_bit_cast(bf16x8, w);
    o0 = __builtin_amdgcn_mfma_f32_32x32x16_bf16(va00, pb0, o0, 0, 0, 0); o1 = __builtin_amdgcn_mfma_f32_32x32x16_bf16(va10, pb0, o1, 0, 0, 0);
    o0 = __builtin_amdgcn_mfma_f32_32x32x16_bf16(va01, pb1, o0, 0, 0, 0); o1 = __builtin_amdgcn_mfma_f32_32x32x16_bf16(va11, pb1, o1, 0, 0, 0);
}

__device__ __forceinline__ void attn_tile2(LAS const unsigned char* slot, const bf16x8 (&bq)[4], f32x16& o0, f32x16& o1, float& m_run, float& l_run,
                                           int r31, int hh, bool use_mask, int clo0, int chi0, int clo1, int chi1) {
    const int ksw = (r31 >> 1) & 7;
    LAS const unsigned char* kp = slot + r31 * 128;
    const bf16x8 ka0 = *(LAS const bf16x8*)(kp + 16 * ((0 + hh) ^ ksw)), ka1 = *(LAS const bf16x8*)(kp + 16 * ((2 + hh) ^ ksw));
    const bf16x8 ka2 = *(LAS const bf16x8*)(kp + 16 * ((4 + hh) ^ ksw)), ka3 = *(LAS const bf16x8*)(kp + 16 * ((6 + hh) ^ ksw));
    const bf16x8 kb0 = *(LAS const bf16x8*)(kp + 4096 + 16 * ((0 + hh) ^ ksw)), kb1 = *(LAS const bf16x8*)(kp + 4096 + 16 * ((2 + hh) ^ ksw));
    const bf16x8 kb2 = *(LAS const bf16x8*)(kp + 4096 + 16 * ((4 + hh) ^ ksw)), kb3 = *(LAS const bf16x8*)(kp + 4096 + 16 * ((6 + hh) ^ ksw));
    f32x16 s0, s1;
#pragma unroll
    for (int i = 0; i < 16; ++i) { s0[i] = 0.f; s1[i] = 0.f; }
    s0 = __builtin_amdgcn_mfma_f32_32x32x16_bf16(ka0, bq[0], s0, 0, 0, 0); s1 = __builtin_amdgcn_mfma_f32_32x32x16_bf16(kb0, bq[0], s1, 0, 0, 0);
    s0 = __builtin_amdgcn_mfma_f32_32x32x16_bf16(ka1, bq[1], s0, 0, 0, 0); s1 = __builtin_amdgcn_mfma_f32_32x32x16_bf16(kb1, bq[1], s1, 0, 0, 0);
    s0 = __builtin_amdgcn_mfma_f32_32x32x16_bf16(ka2, bq[2], s0, 0, 0, 0); s1 = __builtin_amdgcn_mfma_f32_32x32x16_bf16(kb2, bq[2], s1, 0, 0, 0);
    s0 = __builtin_amdgcn_mfma_f32_32x32x16_bf16(ka3, bq[3], s0, 0, 0, 0); s1 = __builtin_amdgcn_mfma_f32_32x32x16_bf16(kb3, bq[3], s1, 0, 0, 0);
    LAS const unsigned char* vp = slot + 8192 + r31 * 128;
    const int vsw = (r31 >> 1) & 15;
    u32x2 va[2][4][2];
#pragma unroll
    for (int db = 0; db < 2; ++db)
#pragma unroll
        for (int st = 0; st < 4; ++st) { va[db][st][0] = *(LAS const u32x2*)(vp + 4096 * db + 8 * ((4 * st + hh) ^ vsw)); va[db][st][1] = *(LAS const u32x2*)(vp + 4096 * db + 8 * ((4 * st + hh + 2) ^ vsw)); }
    if (use_mask) {
        const unsigned off0 = (unsigned)(4 * hh - clo0), rng0 = (unsigned)(chi0 - clo0), off1 = (unsigned)(4 * hh - clo1), rng1 = (unsigned)(chi1 - clo1);
#pragma unroll
        for (int i = 0; i < 16; ++i) { const unsigned c0 = (unsigned)((i & 3) + 8 * (i >> 2)); s0[i] = (c0 + off0 <= rng0) ? s0[i] : -INFINITY; s1[i] = (c0 + off1 <= rng1) ? s1[i] : -INFINITY; }
    }
    float tmax = max4f_mfma(s0[0], s0[1], s1[0], s1[1]);
#pragma unroll
    for (int i = 2; i < 16; i += 2) { tmax = max3f(tmax, s0[i], s0[i + 1]); tmax = max3f(tmax, s1[i], s1[i + 1]); }
    tmax = max2f(tmax, lane_xor(tmax, r31 + 32 * hh, 32)) * QK_SCALE;
    if (__any(tmax - m_run > 8.0f)) {
        const float m_new = fmaxf(m_run, tmax);
        const float alpha = __builtin_amdgcn_exp2f(m_run - m_new);
        m_run = m_new; l_run *= alpha;
#pragma unroll
        for (int i = 0; i < 16; ++i) { o0[i] *= alpha; o1[i] *= alpha; }
    }
    float ps0 = 0.f, ps1 = 0.f;
    const float nm = -m_run;
#pragma unroll
    for (int i = 0; i < 16; ++i) { const float p0 = __builtin_amdgcn_exp2f(fmaf(s0[i], QK_SCALE, nm)), p1 = __builtin_amdgcn_exp2f(fmaf(s1[i], QK_SCALE, nm)); s0[i] = p0; s1[i] = p1; ps0 += p0; ps1 += p1; }
    l_run += ps0 + ps1;
    u32x4 pw;
    pw.x = pk2(s0[0], s0[1]); pw.y = pk2(s0[2], s0[3]); pw.z = pk2(s0[4], s0[5]); pw.w = pk2(s0[6], s0[7]); const bf16x8 p00 = __builtin_bit_cast(bf16x8, pw);
    pw.x = pk2(s0[8], s0[9]); pw.y = pk2(s0[10], s0[11]); pw.z = pk2(s0[12], s0[13]); pw.w = pk2(s0[14], s0[15]); const bf16x8 p01 = __builtin_bit_cast(bf16x8, pw);
    pw.x = pk2(s1[0], s1[1]); pw.y = pk2(s1[2], s1[3]); pw.z = pk2(s1[4], s1[5]); pw.w = pk2(s1[6], s1[7]); const bf16x8 p10 = __builtin_bit_cast(bf16x8, pw);
    pw.x = pk2(s1[8], s1[9]); pw.y = pk2(s1[10], s1[11]); pw.z = pk2(s1[12], s1[13]); pw.w = pk2(s1[14], s1[15]); const bf16x8 p11 = __builtin_bit_cast(bf16x8, pw);
#define VA8(db_, st_) __builtin_bit_cast(bf16x8, (u32x4){va[db_][st_][0].x, va[db_][st_][0].y, va[db_][st_][1].x, va[db_][st_][1].y})
    o0 = __builtin_amdgcn_mfma_f32_32x32x16_bf16(VA8(0, 0), p00, o0, 0, 0, 0); o1 = __builtin_amdgcn_mfma_f32_32x32x16_bf16(VA8(1, 0), p00, o1, 0, 0, 0);
    o0 = __builtin_amdgcn_mfma_f32_32x32x16_bf16(VA8(0, 1), p01, o0, 0, 0, 0); o1 = __builtin_amdgcn_mfma_f32_32x32x16_bf16(VA8(1, 1), p01, o1, 0, 0, 0);
    o0 = __builtin_amdgcn_mfma_f32_32x32x16_bf16(VA8(0, 2), p10, o0, 0, 0, 0); o1 = __builtin_amdgcn_mfma_f32_32x32x16_bf16(VA8(1, 2), p10, o1, 0, 0, 0);
    o0 = __builtin_amdgcn_mfma_f32_32x32x16_bf16(VA8(0, 3), p11, o0, 0, 0, 0); o1 = __builtin_amdgcn_mfma_f32_32x32x16_bf16(VA8(1, 3), p11, o1, 0, 0, 0);
#undef VA8
}

__device__ __forceinline__ void attn_tile4(LAS const unsigned char* slotA, LAS const unsigned char* slotB, const bf16x8 (&bq)[4], f32x16& o0, f32x16& o1, float& m_run, float& l_run, int r31, int hh) {
    const int ksw = (r31 >> 1) & 7, vsw = (r31 >> 1) & 15;
    f32x16 s[4];
#pragma unroll
    for (int t = 0; t < 4; ++t)
#pragma unroll
        for (int i = 0; i < 16; ++i) s[t][i] = 0.f;
#pragma unroll
    for (int ks = 0; ks < 4; ++ks) {
        LAS const unsigned char* ka = slotA + r31 * 128 + 16 * ((2 * ks + hh) ^ ksw);
        LAS const unsigned char* kb = slotB + r31 * 128 + 16 * ((2 * ks + hh) ^ ksw);
        const bf16x8 k0 = *(LAS const bf16x8*)ka, k1 = *(LAS const bf16x8*)(ka + 4096), k2 = *(LAS const bf16x8*)kb, k3 = *(LAS const bf16x8*)(kb + 4096);
        s[0] = __builtin_amdgcn_mfma_f32_32x32x16_bf16(k0, bq[ks], s[0], 0, 0, 0); s[1] = __builtin_amdgcn_mfma_f32_32x32x16_bf16(k1, bq[ks], s[1], 0, 0, 0);
        s[2] = __builtin_amdgcn_mfma_f32_32x32x16_bf16(k2, bq[ks], s[2], 0, 0, 0); s[3] = __builtin_amdgcn_mfma_f32_32x32x16_bf16(k3, bq[ks], s[3], 0, 0, 0);
    }
    float tmax = max4f_mfma(s[0][0], s[1][0], s[2][0], s[3][0]);
#pragma unroll
    for (int i = 1; i < 16; ++i) { tmax = max3f(tmax, s[0][i], s[1][i]); tmax = max3f(tmax, s[2][i], s[3][i]); }
    tmax = max2f(tmax, lane_xor(tmax, r31 + 32 * hh, 32)) * QK_SCALE;
    if (__any(tmax - m_run > 8.0f)) {
        const float m_new = fmaxf(m_run, tmax);
        const float alpha = __builtin_amdgcn_exp2f(m_run - m_new);
        m_run = m_new; l_run *= alpha;
#pragma unroll
        for (int i = 0; i < 16; ++i) { o0[i] *= alpha; o1[i] *= alpha; }
    }
    const float nm = -m_run;
    float ps0 = 0.f, ps1 = 0.f;
#pragma unroll
    for (int t = 0; t < 4; ++t)
#pragma unroll
        for (int i = 0; i < 16; i += 2) { const float p0 = __builtin_amdgcn_exp2f(fmaf(s[t][i], QK_SCALE, nm)), p1 = __builtin_amdgcn_exp2f(fmaf(s[t][i + 1], QK_SCALE, nm)); s[t][i] = p0; s[t][i + 1] = p1; ps0 += p0; ps1 += p1; }
    l_run += ps0 + ps1;
#pragma unroll
    for (int t = 0; t < 4; ++t) {
        LAS const unsigned char* vp = (t < 2 ? slotA : slotB) + 8192 + r31 * 128;
        const int g0 = 8 * (t & 1) + hh;
        u32x4 pw;
        pw.x = pk2(s[t][0], s[t][1]); pw.y = pk2(s[t][2], s[t][3]); pw.z = pk2(s[t][4], s[t][5]); pw.w = pk2(s[t][6], s[t][7]); const bf16x8 pa = __builtin_bit_cast(bf16x8, pw);
        pw.x = pk2(s[t][8], s[t][9]); pw.y = pk2(s[t][10], s[t][11]); pw.z = pk2(s[t][12], s[t][13]); pw.w = pk2(s[t][14], s[t][15]); const bf16x8 pb = __builtin_bit_cast(bf16x8, pw);
        const u32x2 a0l = *(LAS const u32x2*)(vp + 8 * ((g0) ^ vsw)), a0h = *(LAS const u32x2*)(vp + 8 * ((g0 + 2) ^ vsw));
        const u32x2 a1l = *(LAS const u32x2*)(vp + 8 * ((g0 + 4) ^ vsw)), a1h = *(LAS const u32x2*)(vp + 8 * ((g0 + 6) ^ vsw));
        const u32x2 b0l = *(LAS const u32x2*)(vp + 4096 + 8 * ((g0) ^ vsw)), b0h = *(LAS const u32x2*)(vp + 4096 + 8 * ((g0 + 2) ^ vsw));
        const u32x2 b1l = *(LAS const u32x2*)(vp + 4096 + 8 * ((g0 + 4) ^ vsw)), b1h = *(LAS const u32x2*)(vp + 4096 + 8 * ((g0 + 6) ^ vsw));
        o0 = __builtin_amdgcn_mfma_f32_32x32x16_bf16(__builtin_bit_cast(bf16x8, (u32x4){a0l.x, a0l.y, a0h.x, a0h.y}), pa, o0, 0, 0, 0);
        o1 = __builtin_amdgcn_mfma_f32_32x32x16_bf16(__builtin_bit_cast(bf16x8, (u32x4){b0l.x, b0l.y, b0h.x, b0h.y}), pa, o1, 0, 0, 0);
        o0 = __builtin_amdgcn_mfma_f32_32x32x16_bf16(__builtin_bit_cast(bf16x8, (u32x4){a1l.x, a1l.y, a1h.x, a1h.y}), pb, o0, 0, 0, 0);
        o1 = __builtin_amdgcn_mfma_f32_32x32x16_bf16(__builtin_bit_cast(bf16x8, (u32x4){b1l.x, b1l.y, b1h.x, b1h.y}), pb, o1, 0, 0, 0);
    }
}

__device__ __forceinline__ void attn_block_item(CKArgs& A, int l, int MODE, int item, LAS unsigned char* lds, int tid) {
    asm volatile("" : "+v"(tid));
    unsigned char* ws = A.ws;
    const bf16_t* PT = (const bf16_t*)(ws + WS_PT);
    bf16_t* Y = (bf16_t*)(ws + WS_HY);
    const int wave = __builtin_amdgcn_readfirstlane(tid >> 6), lane = tid & 63;
    const int r31 = lane & 31, hh = lane >> 5;
    int b, h, qtok, qi = 0;
    int rp = 0, mg = 0, qg = 0;
    if (MODE == 0) { b = item / 192; const int rem = item % 192; h = rem >> 5; qi = rem & 31; rp = 2 * qi + (wave >> 2); mg = wave & 3;
        qtok = b * SEQ + (2 * rp + (r31 >> 4)) * 64 + 16 * mg + (r31 & 15); }
    else if (MODE == 1) { b = item / 192; const int rem = item % 192; h = rem >> 5; qi = rem & 31; qg = 8 * qi + wave; qtok = b * SEQ + 32 * qg + r31; }
    else { b = item / 6; h = item % 6; qg = wave; qtok = MLAT + b * CTXL + 32 * qg + r31; }
    const bool grpA = (MODE == 0 || MODE == 2);
    const int kvh = grpA ? h : h / 3;
    const int qcol = (grpA ? C_QA : C_QC) + h * 64, gcol = (grpA ? C_GA : C_GC) + h * 64, ycol = (grpA ? 0 : 640) + h * 64;
    const int kh = grpA ? h : 6 + kvh;
    bf16x8 bq[4];
    { const bf16_t* qp = PT + (size_t)qtok * NTM + qcol + 8 * hh;
#pragma unroll
      for (int s = 0; s < 4; ++s) bq[s] = *(const bf16x8*)(qp + 16 * s); }
    f32x16 o0, o1;
#pragma unroll
    for (int i = 0; i < 16; ++i) { o0[i] = 0.f; o1[i] = 0.f; }
    float m_run = -1e30f, l_run = 0.f;
    if (!grpA) { m_run = A.sink[l * 6 + h] * LOG2E; l_run = hh == 0 ? 1.0f : 0.f; }
    int wrow0 = 0, nwin = 0;
    if (MODE == 0) { const int a0 = min(max(4 * qi - 4, 0), 120), a1 = min(max(4 * qi - 1, 0), 120) + 7; wrow0 = a0; nwin = a1 - a0 + 1; }
    if (MODE == 1) { const int k0 = max(4 * qi - 2, 0), k1 = min(4 * qi + 5, 127); wrow0 = k0; nwin = k1 - k0 + 1; }
    const int nsteps = 4 + nwin;
    int ra = 0, rb = -1, cs = 0, rq = 0, jq = 0, r0 = 0, cmin = 0;
    LAS const float* btab = (LAS const float*)(lds + AUX_OFF + 2048);
    if (MODE == 0) { ra = min(max(2 * rp - 4, 0), 120); rb = min(max(2 * rp - 3, 0), 120) + 7; cs = min(max(16 * mg - 8, 0), 32);
        rq = 2 * rp + (r31 >> 4); jq = 16 * mg + (r31 & 15); r0 = min(max(rq - 4, 0), 120); cmin = min(max(jq - 8, 0), 48) - cs;
        }
    const int lr = tid >> 3, lc = tid & 7;
    const bf16_t* kg = (const bf16_t*)(ws + WS_KH) + (size_t)kh * MTOT * 64 + 8 * tid;
    const bf16_t* vg = (const bf16_t*)(ws + WS_VT) + (size_t)kh * MTOT * 64 + 8 * tid;
    const int kdst = lr * 128 + 16 * (lc ^ ((lr >> 1) & 7));
    const int vdstb = 8192 + (8 * lc) * 128 + 2 * (lr & 3), vg4 = lr >> 2, vs4 = (4 * lc) & 15;
#define ROW_TOK(i) ((i) < 4 ? MLAT + b * CTXL + 64 * (i) : b * SEQ + 64 * (wrow0 + (i) - 4))
#define LOAD_ROW(i, kr_, vr_) do { const int t0_ = ROW_TOK(i); kr_ = *(const u32x4*)(kg + (size_t)t0_ * 64); vr_ = *(const u32x4*)(vg + (size_t)t0_ * 64); } while (0)
#define WRITE_ROW(sl_, kr_, vr_) do { *(LAS u32x4*)((sl_) + kdst) = kr_; \
        _Pragma("unroll") for (int j_ = 0; j_ < 8; ++j_) { const unsigned w_ = j_ < 2 ? vr_.x : (j_ < 4 ? vr_.y : (j_ < 6 ? vr_.z : vr_.w)); \
            *(LAS bf16_t*)((sl_) + vdstb + j_ * 128 + 8 * (vg4 ^ ((vs4 + (j_ >> 1)) & 15))) = (bf16_t)((j_ & 1) ? (w_ >> 16) : (w_ & 0xffffu)); } } while (0)
    u32x4 k0, v0, k1, v1, k2, v2;
    LOAD_ROW(0, k0, v0); LOAD_ROW(1, k2, v2);
    __syncthreads();
    if (MODE == 0 && tid < 465) ((LAS float*)(lds + AUX_OFF + 2048))[tid] = A.na_rpb[(size_t)(l * 6 + h) * 465 + tid] * LOG2E;
    WRITE_ROW(lds, k0, v0); WRITE_ROW(lds + 16384, k2, v2);
    __syncthreads();
#pragma unroll 1
    for (int pr = 0; pr < 2; ++pr) {
        { const int ra_ = pr == 0 ? 2 : min(4, nsteps - 1), rb_ = pr == 0 ? 3 : ra_; LOAD_ROW(ra_, k0, v0); LOAD_ROW(rb_, k2, v2); }
        attn_tile4(lds, lds + 16384, bq, o0, o1, m_run, l_run, r31, hh);
        __syncthreads();
        if (pr == 0) { WRITE_ROW(lds, k0, v0); WRITE_ROW(lds + 16384, k2, v2); } else if (nsteps > 4) { WRITE_ROW(lds, k0, v0); }
        __syncthreads();
    }
#define ATT_STEP(i_, kL, vL, kW, vW) do { const int i = (i_); if (i < nsteps) { \
        LAS const unsigned char* slot = lds + (i & 1) * 16384; \
        { const int ir_ = min(i + 1, nsteps - 1); LOAD_ROW(ir_, kL, vL); }     \
        bool use2 = false, use1 = false, um = false, um1 = false, ub = false; int c1 = 0, lo0 = 0, hi0 = 31, lo1 = 0, hi1 = 31, bidx = 0; \
        if (i < 4) use2 = true; \
        else if (MODE == 0) { const int a = wrow0 + i - 4; use1 = (a >= ra) && (a <= rb); const bool rowok = (a >= r0) && (a < r0 + 8); \
            c1 = cs; lo0 = rowok ? cmin : 1; hi0 = rowok ? cmin + 15 : 0; ub = true; um1 = true; bidx = (a - rq + 7) * 31 + (cs - jq + 15); } \
        else if (MODE == 1) { const int rel0 = (64 * (wrow0 + i - 4) - (32 * qg - 128)) >> 5, rel1 = rel0 + 1;     \
            const bool a0 = (rel0 >= 0) && (rel0 <= 8), a1 = (rel1 >= 0) && (rel1 <= 8); \
            if (a0 && a1) { use2 = true; um = (rel0 == 0) || (rel1 == 8); lo0 = rel0 == 0 ? r31 : 0; hi1 = rel1 == 8 ? r31 : 31; } \
            else if (a0) { use1 = true; um1 = (rel0 == 0) || (rel0 == 8); lo0 = rel0 == 0 ? r31 : 0; hi0 = rel0 == 8 ? r31 : 31; } \
            else if (a1) { use1 = true; c1 = 32; um1 = (rel1 == 0) || (rel1 == 8); lo0 = rel1 == 0 ? r31 : 0; hi0 = rel1 == 8 ? r31 : 31; } } \
        if (use2) attn_tile2(slot, bq, o0, o1, m_run, l_run, r31, hh, um, lo0, hi0, lo1, hi1); \
        if (use1) attn_tile(slot, c1, bq, o0, o1, m_run, l_run, r31, hh, um1, lo0, hi0, ub, btab, bidx); \
        if (i + 1 < nsteps) { LAS unsigned char* nslot = lds + ((i + 1) & 1) * 16384; WRITE_ROW(nslot, kW, vW); } \
        __syncthreads(); } } while (0)
#pragma unroll 1
    for (int i3 = 4; i3 < nsteps; ++i3) {
        ATT_STEP(i3, k1, v1, k1, v1);
    }
#undef ATT_STEP
#undef LOAD_ROW
#undef WRITE_ROW
    const float ltot = l_run + lane_xor(l_run, lane, 32);
    const float inv = 1.0f / ltot;
    const bf16_t* gp = PT + (size_t)qtok * NTM + gcol + 4 * hh;
    bf16_t* yp = Y + (size_t)qtok * DM + ycol + 4 * hh;
#pragma unroll
    for (int db = 0; db < 2; ++db)
#pragma unroll
        for (int g4 = 0; g4 < 4; ++g4) {
            const int d0 = 32 * db + 8 * g4;
            const u32x2 gw = *(const u32x2*)(gp + d0);
            float v0, v1, v2, v3;
            if (db == 0) { v0 = o0[4 * g4]; v1 = o0[4 * g4 + 1]; v2 = o0[4 * g4 + 2]; v3 = o0[4 * g4 + 3]; }
            else { v0 = o1[4 * g4]; v1 = o1[4 * g4 + 1]; v2 = o1[4 * g4 + 2]; v3 = o1[4 * g4 + 3]; }
            v0 *= inv * silu_f(bflo(gw.x)); v1 *= inv * silu_f(bfhi(gw.x)); v2 *= inv * silu_f(bflo(gw.y)); v3 *= inv * silu_f(bfhi(gw.y));
            u32x2 o; o.x = pk2(v0, v1); o.y = pk2(v2, v3);
            *(u32x2*)(yp + d0) = o;
        }
}

typedef float cf2 __attribute__((ext_vector_type(2)));
__device__ __forceinline__ cf2 mk2(float x, float y) { cf2 r; r.x = x; r.y = y; return r; }
__device__ __forceinline__ cf2 cmul(cf2 a, cf2 b) { const cf2 bs = mk2(-b.y, b.x); return a.xx * b + a.yy * bs; }
#define PA(e) ((e) + (((e) >> 4) << 1))
struct cf2x4 { cf2 a, b, c, d; };
__device__ __forceinline__ cf2x4 bfly4_fwd(cf2 x0, cf2 x1, cf2 x2, cf2 x3, float a) {
    const cf2 w1 = mk2(__builtin_amdgcn_cosf(a), -__builtin_amdgcn_sinf(a));
    const cf2 w2 = cmul(w1, w1), w3 = cmul(w2, w1);
    const cf2 s02 = x0 + x2, d02 = x0 - x2, s13 = x1 + x3, d13 = x1 - x3;
    cf2x4 r;
    r.a = s02 + s13;
    r.b = cmul(s02 - s13, w2);
    r.c = cmul(mk2(d02.x + d13.y, d02.y - d13.x), w1);
    r.d = cmul(mk2(d02.x - d13.y, d02.y + d13.x), w3);
    return r;
}
__device__ __forceinline__ cf2x4 bfly4_inv(cf2 v0, cf2 v1, cf2 v2, cf2 v3, float a) {
    const cf2 w1 = mk2(__builtin_amdgcn_cosf(a), __builtin_amdgcn_sinf(a));
    const cf2 w2 = cmul(w1, w1);
    const cf2 bb = cmul(v1, w2), dd = cmul(v3, w2);
    const cf2 u0 = v0 + bb, u1 = v0 - bb, u2 = v2 + dd, u3 = v2 - dd;
    const cf2 e = cmul(u2, w1), f0 = cmul(u3, w1);
    const cf2 f = mk2(-f0.y, f0.x);
    cf2x4 r; r.a = u0 + e; r.c = u0 - e; r.b = u1 + f; r.d = u1 - f; return r;
}
__device__ __forceinline__ void fft_fwd_fused(LAS cf2* buf, int tid, int lsb, bool zero_hi = false) {
    const int sB = 1 << lsb, s = 4 << lsb;
    const float ra = 1.0f / (float)(16 << lsb), rb = 1.0f / (float)(4 << lsb);
    int poff[4][4];
#pragma unroll
    for (int a = 0; a < 4; ++a)
#pragma unroll
        for (int b = 0; b < 4; ++b) { const int off = a * s + b * sB; poff[a][b] = PA(off); }
#pragma unroll 1
    for (int gg = 0; gg < 2; ++gg) {
        const int g = tid + 512 * gg, i = g & (sB - 1), base = ((g >> lsb) << (lsb + 4)) + i;
        const int pbase = PA(base);
        cf2 x[4][4];
#pragma unroll
        for (int a = 0; a < 4; ++a)
#pragma unroll
            for (int b = 0; b < 4; ++b) x[a][b] = (zero_hi && a >= 2) ? mk2(0.f, 0.f) : buf[pbase + poff[a][b]];
#pragma unroll
        for (int b = 0; b < 4; ++b) { const cf2x4 r = bfly4_fwd(x[0][b], x[1][b], x[2][b], x[3][b], (float)(i + b * sB) * ra); x[0][b] = r.a; x[1][b] = r.b; x[2][b] = r.c; x[3][b] = r.d; }
        const float ab = (float)i * rb;
#pragma unroll
        for (int a = 0; a < 4; ++a) { const cf2x4 r = bfly4_fwd(x[a][0], x[a][1], x[a][2], x[a][3], ab); x[a][0] = r.a; x[a][1] = r.b; x[a][2] = r.c; x[a][3] = r.d; }
#pragma unroll
        for (int a = 0; a < 4; ++a)
#pragma unroll
            for (int b = 0; b < 4; ++b) buf[pbase + poff[a][b]] = x[a][b];
    }
    __syncthreads();
}
__device__ __forceinline__ void fft_inv_fused(LAS cf2* buf, int tid, int lsb) {
    const int sB = 1 << lsb, s = 4 << lsb;
    const float ra = 1.0f / (float)(16 << lsb), rb = 1.0f / (float)(4 << lsb);
    int poff[4][4];
#pragma unroll
    for (int a = 0; a < 4; ++a)
#pragma unroll
        for (int b = 0; b < 4; ++b) { const int off = a * s + b * sB; poff[a][b] = PA(off); }
#pragma unroll 1
    for (int gg = 0; gg < 2; ++gg) {
        const int g = tid + 512 * gg, i = g & (sB - 1), base = ((g >> lsb) << (lsb + 4)) + i;
        const int pbase = PA(base);
        cf2 x[4][4];
#pragma unroll
        for (int a = 0; a < 4; ++a)
#pragma unroll
            for (int b = 0; b < 4; ++b) x[a][b] = buf[pbase + poff[a][b]];
        const float ab = (float)i * rb;
#pragma unroll
        for (int a = 0; a < 4; ++a) { const cf2x4 r = bfly4_inv(x[a][0], x[a][1], x[a][2], x[a][3], ab); x[a][0] = r.a; x[a][1] = r.b; x[a][2] = r.c; x[a][3] = r.d; }
#pragma unroll
        for (int b = 0; b < 4; ++b) { const cf2x4 r = bfly4_inv(x[0][b], x[1][b], x[2][b], x[3][b], (float)(i + b * sB) * ra); x[0][b] = r.a; x[1][b] = r.b; x[2][b] = r.c; x[3][b] = r.d; }
#pragma unroll
        for (int a = 0; a < 4; ++a)
#pragma unroll
            for (int b = 0; b < 4; ++b) buf[pbase + poff[a][b]] = x[a][b];
    }
    __syncthreads();
}
__device__ __forceinline__ void fft_fwd(LAS cf2* buf, int tid, const unsigned* zk = nullptr, bool zero_hi = false) {
#pragma unroll 1
    for (int lsb = 10; lsb >= 2; lsb -= 4) fft_fwd_fused(buf, tid, lsb, zero_hi && lsb == 10);
#pragma unroll 4
    for (int k = 0; k < 8; ++k) {
        const int e0 = 4 * (tid + 512 * k), base = PA(e0);
        cf2 x0 = buf[base], x1 = buf[base + 1], x2 = buf[base + 2], x3 = buf[base + 3];
        const cf2 s02 = x0 + x2, d02 = x0 - x2, s13 = x1 + x3, d13 = x1 - x3;
        cf2 y0 = s02 + s13, y1 = s02 - s13, y2 = mk2(d02.x + d13.y, d02.y - d13.x), y3 = mk2(d02.x - d13.y, d02.y + d13.x);
        if (zk) { const u32x4 w = *(const u32x4*)(zk + (unsigned)e0);
            y0 = cmul(y0, mk2(bflo(w.x), bfhi(w.x))); y1 = cmul(y1, mk2(bflo(w.y), bfhi(w.y))); y2 = cmul(y2, mk2(bflo(w.z), bfhi(w.z))); y3 = cmul(y3, mk2(bflo(w.w), bfhi(w.w))); }
        buf[base] = y0; buf[base + 1] = y1; buf[base + 2] = y2; buf[base + 3] = y3;
    }
    __syncthreads();
}
__device__ __forceinline__ void fft_inv(LAS cf2* buf, int tid) {
#pragma unroll 1
    for (int lsb = 0; lsb <= 8; lsb += 4) fft_inv_fused(buf, tid, lsb);
#pragma unroll 4
    for (int k = 0; k < 8; ++k) {
        const int i = tid + 512 * k, pi = PA(tid) + 576 * k;
        cf2 v0 = buf[pi], v1 = buf[pi + 4608], v2 = buf[pi + 9216], v3 = buf[pi + 13824];
        const cf2x4 r = bfly4_inv(v0, v1, v2, v3, (float)i * (1.0f / 16384.0f));
        buf[pi] = r.a; buf[pi + 4608] = r.b;
    }
    __syncthreads();
}
__device__ __forceinline__ float hy_short(const bf16_t* prow, int tb, int t, int L, float w0, float w1, float w2, float bias) {
    const float pm = t > 0 ? bf2f(prow[tb + t - 1]) : 0.f;
    const float pc = bf2f(prow[tb + t]);
    const float pp = t < L - 1 ? bf2f(prow[tb + t + 1]) : 0.f;
    return w0 * pm + w1 * pc + w2 * pp + bias;
}
__device__ __forceinline__ float block_sum(float v, LAS float* red, int tid) {
    v = wave_sum(v, tid & 63);
    __syncthreads();
    if ((tid & 63) == 0) red[tid >> 6] = v;
    __syncthreads();
    float s = 0.f;
#pragma unroll
    for (int w = 0; w < 8; ++w) s += red[w];
    return s;
}

__device__ __forceinline__ void hyena_block(CKArgs& A, int l, int c, LAS unsigned char* lds, int tid) {
    asm volatile("" : "+v"(tid));
    unsigned char* ws = A.ws;
    LAS cf2* buf = (LAS cf2*)lds;
    LAS float* fs = (LAS float*)lds;
    LAS float* aux = (LAS float*)(lds + AUX_OFF);
    LAS float* red = aux + 256;
    const bf16_t* PCT = (const bf16_t*)(ws + WS_PCT);
    bf16_t* YBT = (bf16_t*)((unsigned char*)A.out + OUT_YBT);
    const bf16_t* rowz = PCT + (size_t)(R_HZ + c) * MTOT;
    const bf16_t* rowx1 = rowz + (size_t)256 * MTOT;
    const bf16_t* rowx2 = rowz + (size_t)512 * MTOT;
    const bf16_t* rowg = PCT + (size_t)(R_GB + c) * MTOT;
    const float* cw = A.hy_conv_w + (size_t)l * 3 * 768; const float* cb = A.hy_conv_b + (size_t)l * 768;
    const float wz0 = cw[c], wz1 = cw[768 + c], wz2 = cw[1536 + c], bz = cb[c];
    const float wa0 = cw[256 + c], wa1 = cw[768 + 256 + c], wa2 = cw[1536 + 256 + c], ba = cb[256 + c];
    const float wb0 = cw[512 + c], wb1 = cw[768 + 512 + c], wb2 = cw[1536 + 512 + c], bb = cb[512 + c];
    const float d0 = A.hy_d[(l * 2 + 0) * 256 + c], d1 = A.hy_d[(l * 2 + 1) * 256 + c];
    const float dmin = -3.0701134573253945f, dmax = -15.350567286626973f;
    const float delta = fabsf(dmin + (float)c * ((dmax - dmin) / 255.0f));
    __syncthreads();
    if (tid < 256) { const int k = tid >> 6, j = tid & 63; aux[tid] = A.hy_w3[((size_t)l * 64 + j) * 1024 + k * 256 + c]; }
    __syncthreads();

    if (l < DEPTH - 1) {
        float ss0 = 0.f, ss1 = 0.f;
        if (tid < 256) {
            const int n = tid; const f32x4* hr = (const f32x4*)((const float*)(ws + WS_H2C) + ((size_t)l * CTXL + n) * 64);
            float f0 = 0.f, f1 = 0.f, b0 = 0.f, b1 = 0.f;
#pragma unroll 1
            for (int j4 = 0; j4 < 16; ++j4) { const f32x4 hv = hr[j4];
#pragma unroll
                for (int e = 0; e < 4; ++e) { const float hvv = hv[e]; const int j = 4 * j4 + e; f0 += hvv * aux[j]; f1 += hvv * aux[64 + j]; b0 += hvv * aux[128 + j]; b1 += hvv * aux[192 + j]; } }
            const float e = __expf(-((float)n * (1.0f / 255.0f)) * delta);
            f0 *= e; f1 *= e; b0 *= e; b1 *= e;
            fs[255 + n] = f0; fs[512 + 255 + n] = f1;
            if (n >= 1) { fs[255 - n] = b0; fs[512 + 255 - n] = b1; }
            ss0 = f0 * f0 + (n >= 1 ? b0 * b0 : 0.f); ss1 = f1 * f1 + (n >= 1 ? b1 * b1 : 0.f);
        }
        if (tid == 0) { fs[511] = 0.f; fs[1023] = 0.f; }
        const int b = tid >> 8, t = tid & 255, tok = MLAT + b * CTXL;
        const float z = hy_short(rowz, tok, t, CTXL, wz0, wz1, wz2, bz);
        const float x1 = hy_short(rowx1, tok, t, CTXL, wa0, wa1, wa2, ba);
        const float x2 = hy_short(rowx2, tok, t, CTXL, wb0, wb1, wb2, bb);
        const float gb = bf2f(rowg[tok + t]);
        fs[1024 + tid] = z;
        const float n0 = rsqrtf(block_sum(ss0, red, tid) + 1e-6f);
        const float n1 = rsqrtf(block_sum(ss1, red, tid) + 1e-6f);
        __syncthreads();
        float y = 0.f;
        { LAS const float* kc = fs + 255 + t; LAS const float* zz = fs + 1024 + b * 256;
#pragma unroll 8
          for (int s = 0; s < 256; ++s) y += zz[s] * kc[-s]; }
        const float z1 = x1 * (y * n0 + d0 * z);
        fs[1536 + tid] = z1;
        __syncthreads();
        float y2 = 0.f;
        { LAS const float* kc = fs + 512 + 255 + t; LAS const float* zz = fs + 1536 + b * 256;
#pragma unroll 8
          for (int s = 0; s < 256; ++s) y2 += zz[s] * kc[-s]; }
        const float o = x2 * (y2 * n1 + d1 * z1) * silu_f(gb);
        YBT[(size_t)c * MTOT + tok + t] = (bf16_t)(pk2(o, 0.f) & 0xffffu);
        __syncthreads();
    }

    unsigned* ZK = (unsigned*)((unsigned char*)A.out + OUT_ZS) + (size_t)c * 2 * NFFT;
    const int lane = tid & 63;
    {
        float ss0 = 0.f, ss1 = 0.f;
        const bf16_t* F0 = (const bf16_t*)((unsigned char*)A.out + OUT_FILT) + (size_t)c * SEQ;
        u32x4 fw[2][4];
#pragma unroll
        for (int j = 0; j < 2; ++j)
#pragma unroll
            for (int r = 0; r < 4; ++r) fw[j][r] = *(const u32x4*)(F0 + (size_t)(256 * r) * SEQ + 8 * (tid + 512 * j));
#pragma unroll
        for (int j = 0; j < 2; ++j)
#pragma unroll
            for (int e8 = 0; e8 < 8; ++e8) {
                const int n = 8 * (tid + 512 * j) + e8;
                const float e = __expf(-((float)n * (1.0f / 8191.0f)) * delta);
                const unsigned w0 = e8 < 2 ? fw[j][0].x : (e8 < 4 ? fw[j][0].y : (e8 < 6 ? fw[j][0].z : fw[j][0].w)), w1 = e8 < 2 ? fw[j][1].x : (e8 < 4 ? fw[j][1].y : (e8 < 6 ? fw[j][1].z : fw[j][1].w));
                const unsigned w2 = e8 < 2 ? fw[j][2].x : (e8 < 4 ? fw[j][2].y : (e8 < 6 ? fw[j][2].z : fw[j][2].w)), w3 = e8 < 2 ? fw[j][3].x : (e8 < 4 ? fw[j][3].y : (e8 < 6 ? fw[j][3].z : fw[j][3].w));
                const float f0 = ((e8 & 1) ? bfhi(w0) : bflo(w0)) * e, f1 = ((e8 & 1) ? bfhi(w1) : bflo(w1)) * e, b0 = ((e8 & 1) ? bfhi(w2) : bflo(w2)) * e, b1 = ((e8 & 1) ? bfhi(w3) : bflo(w3)) * e;
                buf[PA(n)] = mk2(f0, f1); ss0 += f0 * f0; ss1 += f1 * f1;
                if (n >= 1) { buf[PA(NFFT - n)] = mk2(b0, b1); ss0 += b0 * b0; ss1 += b1 * b1; }
            }
        if (tid == 0) { const float zf = delta * 0.0f; buf[PA(SEQ)] = mk2(zf, zf); }
        const float nrm0 = rsqrtf(block_sum(ss0, red, tid) + 1e-6f) * (0.5f / NFFT);
        const float nrm1 = rsqrtf(block_sum(ss1, red, tid) + 1e-6f) * (0.5f / NFFT);
        __syncthreads();
        fft_fwd(buf, tid);
#pragma unroll 4
        for (int k = 0; k < 32; ++k) {
            const int p = tid + 512 * k; const int f = (int)(__brev((unsigned)p) >> 18); const int pp = (int)(__brev((unsigned)((NFFT - f) & (NFFT - 1))) >> 18);
            const cf2 za = buf[PA(p)], zb = buf[PA(pp)];
            ZK[p] = pk2((za.x + zb.x) * nrm0 + d0 * (1.0f / NFFT), (za.y - zb.y) * nrm0);
            ZK[NFFT + p] = pk2((za.y + zb.y) * nrm1 + d1 * (1.0f / NFFT), -(za.x - zb.x) * nrm1);
        }
        __syncthreads();
    }
#define HY_RAW(prow_, j_, b_) (*(const u32x4*)((prow_) + (size_t)(b_) * SEQ + 8 * (tid + 512 * (j_))))
#define HY_CONV(prow_, raw_, j_, b_, w0_, w1_, w2_, bias_, u_) do { \
        const int q_ = tid + 512 * (j_); float own_[8]; \
        own_[0] = bflo((raw_).x); own_[1] = bfhi((raw_).x); own_[2] = bflo((raw_).y); own_[3] = bfhi((raw_).y); own_[4] = bflo((raw_).z); own_[5] = bfhi((raw_).z); own_[6] = bflo((raw_).w); own_[7] = bfhi((raw_).w); \
        float pl_ = lane_prev(own_[7], lane), nl_ = lane_next(own_[0], lane); \
        if (lane == 0) pl_ = q_ > 0 ? bf2f((prow_)[(size_t)(b_) * SEQ + 8 * q_ - 1]) : 0.f; \
        if (lane == 63) nl_ = 8 * q_ + 8 < SEQ ? bf2f((prow_)[(size_t)(b_) * SEQ + 8 * q_ + 8]) : 0.f; \
        _Pragma("unroll") for (int e = 0; e < 8; ++e) (u_)[e] = (w0_) * (e > 0 ? own_[e > 0 ? e - 1 : 0] : pl_) + (w1_) * own_[e] + (w2_) * (e < 7 ? own_[e < 7 ? e + 1 : 7] : nl_) + (bias_); } while (0)
    const int pq0 = PA(8 * tid), pq1 = PA(8 * (tid + 512));
    {
        const u32x4 r00 = HY_RAW(rowz, 0, 0), r01 = HY_RAW(rowz, 0, 1), r10 = HY_RAW(rowz, 1, 0), r11 = HY_RAW(rowz, 1, 1);
        float ua[8], ub[8];
        HY_CONV(rowz, r00, 0, 0, wz0, wz1, wz2, bz, ua); HY_CONV(rowz, r01, 0, 1, wz0, wz1, wz2, bz, ub);
#pragma unroll
        for (int e = 0; e < 8; ++e) buf[pq0 + e] = mk2(ua[e], ub[e]);
        HY_CONV(rowz, r10, 1, 0, wz0, wz1, wz2, bz, ua); HY_CONV(rowz, r11, 1, 1, wz0, wz1, wz2, bz, ub);
#pragma unroll
        for (int e = 0; e < 8; ++e) buf[pq1 + e] = mk2(ua[e], ub[e]);
    }
    __syncthreads();
    fft_fwd(buf, tid, ZK, true);
    fft_inv(buf, tid);
    {
        const u32x4 r00 = HY_RAW(rowx1, 0, 0), r01 = HY_RAW(rowx1, 0, 1), r10 = HY_RAW(rowx1, 1, 0), r11 = HY_RAW(rowx1, 1, 1);
        float xa[8], xb[8];
        HY_CONV(rowx1, r00, 0, 0, wa0, wa1, wa2, ba, xa); HY_CONV(rowx1, r01, 0, 1, wa0, wa1, wa2, ba, xb);
#pragma unroll
        for (int e = 0; e < 8; ++e) { const cf2 y = buf[pq0 + e]; buf[pq0 + e] = mk2(xa[e] * y.x, xb[e] * y.y); }
        HY_CONV(rowx1, r10, 1, 0, wa0, wa1, wa2, ba, xa); HY_CONV(rowx1, r11, 1, 1, wa0, wa1, wa2, ba, xb);
#pragma unroll
        for (int e = 0; e < 8; ++e) { const cf2 y = buf[pq1 + e]; buf[pq1 + e] = mk2(xa[e] * y.x, xb[e] * y.y); }
    }
    __syncthreads();
    fft_fwd(buf, tid, ZK + NFFT, true);
    fft_inv(buf, tid);
    {
        bf16_t* yrow = YBT + (size_t)c * MTOT;
        const u32x4 r00 = HY_RAW(rowx2, 0, 0), r01 = HY_RAW(rowx2, 0, 1), r10 = HY_RAW(rowx2, 1, 0), r11 = HY_RAW(rowx2, 1, 1);
        const u32x4 g00 = HY_RAW(rowg, 0, 0), g01 = HY_RAW(rowg, 0, 1), g10 = HY_RAW(rowg, 1, 0), g11 = HY_RAW(rowg, 1, 1);
        float xa[8], xb[8];
#define HY_OUT(pq_, ga_, gb_, j_) do { float oa_[8], ob_[8]; \
            const float gaf_[8] = {bflo((ga_).x), bfhi((ga_).x), bflo((ga_).y), bfhi((ga_).y), bflo((ga_).z), bfhi((ga_).z), bflo((ga_).w), bfhi((ga_).w)}; \
            const float gbf_[8] = {bflo((gb_).x), bfhi((gb_).x), bflo((gb_).y), bfhi((gb_).y), bflo((gb_).z), bfhi((gb_).z), bflo((gb_).w), bfhi((gb_).w)}; \
            _Pragma("unroll") for (int e = 0; e < 8; ++e) { const cf2 y = buf[(pq_) + e]; oa_[e] = xa[e] * y.x * silu_f(gaf_[e]); ob_[e] = xb[e] * y.y * silu_f(gbf_[e]); } \
            u32x4 wa_, wb_; wa_.x = pk2(oa_[0], oa_[1]); wa_.y = pk2(oa_[2], oa_[3]); wa_.z = pk2(oa_[4], oa_[5]); wa_.w = pk2(oa_[6], oa_[7]); \
            wb_.x = pk2(ob_[0], ob_[1]); wb_.y = pk2(ob_[2], ob_[3]); wb_.z = pk2(ob_[4], ob_[5]); wb_.w = pk2(ob_[6], ob_[7]); \
            *(u32x4*)(yrow + 8 * (tid + 512 * (j_))) = wa_; *(u32x4*)(yrow + SEQ + 8 * (tid + 512 * (j_))) = wb_; } while (0)
        HY_CONV(rowx2, r00, 0, 0, wb0, wb1, wb2, bb, xa); HY_CONV(rowx2, r01, 0, 1, wb0, wb1, wb2, bb, xb);
        HY_OUT(pq0, g00, g01, 0);
        HY_CONV(rowx2, r10, 1, 0, wb0, wb1, wb2, bb, xa); HY_CONV(rowx2, r11, 1, 1, wb0, wb1, wb2, bb, xb);
        HY_OUT(pq1, g10, g11, 1);
#undef HY_OUT
    }
#undef HY_RAW
#undef HY_CONV
    __syncthreads();
}

__device__ __forceinline__ void phase_mix(CKArgs& A, int l, LAS unsigned char* lds, int bid, int nblk, int tid) {
    for (int c = bid; c < 256; c += nblk) hyena_block(A, l, c, lds, tid);
    const int nctx = (l < DEPTH - 1) ? 12 : 0;
    const int nlr = (768 + nblk - 1) / nblk, ncr = (2 * nctx + nblk - 1) / nblk;
#pragma unroll 1
    for (int r = 0; r < nlr + ncr; ++r) {
        int it;
        if (r < nlr) { it = r * nblk + bid; if (it >= 768) continue; }
        else { const int j = (nblk - 1 - bid) + (r - nlr) * nblk; if (j >= 2 * nctx) continue; it = 768 + j; }
        int mode, item;
        if (it < 384) { mode = 0; item = it; } else if (it < 768) { mode = 1; item = it - 384; } else if (it < 768 + nctx) { mode = 2; item = it - 768; } else { mode = 3; item = it - 768 - nctx; }
        attn_block_item(A, l, mode, item, lds, tid);
    }
}

__device__ __forceinline__ void phase_tr(CKArgs& A, int l, LAS unsigned char* lds, int bid, int nblk, int tid) {
    const int wave = __builtin_amdgcn_readfirstlane(tid >> 6), lane = tid & 63;
    const int gw = bid * 8 + wave, NGW = nblk * 8;
    unsigned char* ws = A.ws;
    const bf16_t* YBT = (const bf16_t*)((unsigned char*)A.out + OUT_YBT);
    bf16_t* Y = (bf16_t*)(ws + WS_HY);
    LAS bf16_t* scr = (LAS bf16_t*)(lds + wave * 16384);
    const int ntok = (l < DEPTH - 1) ? MTOT : MLAT;
    const int nitems = (ntok / 64) * 4;
#pragma unroll 1
    for (int it = gw; it < nitems; it += NGW) {
        const int tb = (it >> 2) * 64, cb = (it & 3) * 64;
        u32x4 ld[8];
#pragma unroll
        for (int j = 0; j < 8; ++j) { const int idx = lane + 64 * j; ld[j] = *(const u32x4*)(YBT + (size_t)(cb + (idx >> 3)) * MTOT + tb + 8 * (idx & 7)); }
#pragma unroll
        for (int j = 0; j < 8; ++j) { const int idx = lane + 64 * j, ch = idx >> 3, t8 = 8 * (idx & 7);
#pragma unroll
            for (int e = 0; e < 8; ++e) { const unsigned w = e < 2 ? ld[j].x : (e < 4 ? ld[j].y : (e < 6 ? ld[j].z : ld[j].w));
                scr[(t8 + e) * 68 + ch] = (bf16_t)((e & 1) ? (w >> 16) : (w & 0xffffu)); } }
        asm volatile("s_waitcnt lgkmcnt(0)" ::: "memory");
#pragma unroll
        for (int k = 0; k < 8; ++k) {
            const int tq = (lane >> 3) + 8 * k, cc = (lane & 7) * 8;
            const u32x2 a = *(LAS const u32x2*)(scr + tq * 68 + cc), b2 = *(LAS const u32x2*)(scr + tq * 68 + cc + 4);
            u32x4 o; o.x = a.x; o.y = a.y; o.z = b2.x; o.w = b2.y;
            *(u32x4*)(Y + (size_t)(tb + tq) * DM + 384 + cb + cc) = o;
        }
        asm volatile("s_waitcnt lgkmcnt(0)" ::: "memory");
    }
}

__device__ __forceinline__ void phase_final(CKArgs& A, int bid, int nblk, int tid) {
    const int wave = __builtin_amdgcn_readfirstlane(tid >> 6), lane = tid & 63;
    const int gw = bid * 8 + wave, NGW = nblk * 8;
    const bf16_t* xb = (const bf16_t*)(A.ws + WS_XB);
#pragma unroll 1
    for (int m0 = gw; m0 < MLAT; m0 += 2 * NGW) {
        const int m1 = m0 + NGW; const bool has1 = m1 < MLAT; const int m1c = has1 ? m1 : m0;
        f32x4 xa[4], xc[4];
#pragma unroll
        for (int j = 0; j < 4; ++j) { const u32x2 w = *(const u32x2*)(xb + (size_t)m0 * DM + 4 * lane + 256 * j); xa[j] = (f32x4){bflo(w.x), bfhi(w.x), bflo(w.y), bfhi(w.y)}; }
#pragma unroll
        for (int j = 0; j < 4; ++j) { const u32x2 w = *(const u32x2*)(xb + (size_t)m1c * DM + 4 * lane + 256 * j); xc[j] = (f32x4){bflo(w.x), bfhi(w.x), bflo(w.y), bfhi(w.y)}; }
        const float ra = rsqrtf(wave_sum(norm_sumsq(xa), lane) * (1.0f / DM) + 1e-6f);
        const float rc = rsqrtf(wave_sum(norm_sumsq(xc), lane) * (1.0f / DM) + 1e-6f);
#pragma unroll
        for (int j = 0; j < 4; ++j) { const int col = 4 * lane + 256 * j; const f32x4 gv = *(const f32x4*)(A.final_g + col);
            *(f32x4*)(A.out + (size_t)m0 * DM + col) = xa[j] * ra * gv;
            if (has1) *(f32x4*)(A.out + (size_t)m1 * DM + col) = xc[j] * rc * gv; }
    }
}

#define XB_TMO      128
#define XB_XCNT(j)  (256  + 64 * (j))
#define XB_XSUB(j)  (1280 + 64 * (j))
#define XB_XGEN(j)  (2304 + 64 * (j))
#define XB_TOP      3328
#define XB_TOPGEN   3392
#define XCD_BAR_WORDS 3456
#define XB_SPIN_CAP (1u << 18)

__device__ __forceinline__ unsigned xb_ld(unsigned* p)              { return __hip_atomic_load(p, __ATOMIC_RELAXED, __HIP_MEMORY_SCOPE_AGENT); }
__device__ __forceinline__ unsigned xb_add(unsigned* p, unsigned v) { return __hip_atomic_fetch_add(p, v, __ATOMIC_RELAXED, __HIP_MEMORY_SCOPE_AGENT); }
__device__ __forceinline__ unsigned xb_xcc_id() { return (unsigned)__builtin_amdgcn_s_getreg((3 << 11) | 20) & 0xFu; }
#define XB_SPIN(cond, bar) do { unsigned _sp = 0; while (cond) { __builtin_amdgcn_s_sleep(1); \
    if ((++_sp & 255u) == 0u) { if (xb_ld(&(bar)[XB_TMO])) break; if (_sp > XB_SPIN_CAP) { atomicAdd(&(bar)[XB_TMO], 1u); break; } } } } while (0)

struct XcdBarrier {
    unsigned* bar; unsigned x;
    volatile LAS unsigned* st;
};

__device__ __forceinline__ XcdBarrier xcd_barrier_post(unsigned* bar, volatile LAS unsigned* st) {
    XcdBarrier b; b.bar = bar; b.x = xb_xcc_id(); b.st = st;
    if (threadIdx.x == 0) (void)xb_add(&bar[XB_XCNT(b.x)], 1u);
    return b;
}
__device__ __forceinline__ void xcd_barrier_complete(unsigned* bar, unsigned x, unsigned& nloc, unsigned& nx) {
    const unsigned G = gridDim.x * gridDim.y * gridDim.z;
    unsigned sum, cnt, mine, sp = 0u;
    for (;;) {
        sum = 0u; cnt = 0u; mine = 0u;
#pragma unroll
        for (unsigned j = 0; j < 16; ++j) { const unsigned c = xb_ld(&bar[XB_XCNT(j)]); sum += c; cnt += (c > 0u) ? 1u : 0u; mine = (j == x) ? c : mine; }
        if (sum == G) break;
        __builtin_amdgcn_s_sleep(1);
        if ((++sp & 255u) == 0u) { if (xb_ld(&bar[XB_TMO])) break; if (sp > XB_SPIN_CAP) { atomicAdd(&bar[XB_TMO], 1u); break; } }
    }
    nloc = mine > 0u ? mine : 1u; nx = cnt > 0u ? cnt : 1u;
}

__device__ __forceinline__ void xcd_barrier(const XcdBarrier& b) {
    asm volatile("s_waitcnt vmcnt(0)" ::: "memory");
    __syncthreads();
    if (threadIdx.x == 0) {
        unsigned* bar = b.bar;
        __builtin_amdgcn_s_waitcnt(0);
        unsigned nloc = b.st[0], nx = b.st[1];
        if (nloc == 0u) { xcd_barrier_complete(bar, b.x, nloc, nx); b.st[0] = nloc; b.st[1] = nx; }
        const unsigned old = xb_add(&bar[XB_XSUB(b.x)], 1u);
        const unsigned gen = old / nloc;
        if (old + 1u == (gen + 1u) * nloc) {
            __builtin_amdgcn_fence(__ATOMIC_RELEASE, "agent");
            asm volatile("s_waitcnt vmcnt(0)" ::: "memory");
            const unsigned og = xb_add(&bar[XB_TOP], 1u);
            const unsigned tg = og / nx;
            if (og + 1u == (tg + 1u) * nx) xb_add(&bar[XB_TOPGEN], 1u);
            else XB_SPIN(xb_ld(&bar[XB_TOPGEN]) == tg, bar);
            __builtin_amdgcn_fence(__ATOMIC_ACQUIRE, "agent");
            xb_add(&bar[XB_XGEN(b.x)], 1u);
            asm volatile("s_waitcnt vmcnt(0)" ::: "memory");
        } else {
            XB_SPIN(xb_ld(&bar[XB_XGEN(b.x)]) == gen, bar);
            __builtin_amdgcn_fence(__ATOMIC_ACQUIRE, "agent");
            asm volatile("s_waitcnt vmcnt(0)" ::: "memory");
        }
    }
    __syncthreads();
}


constexpr int NPHASE = 2 + 5 * DEPTH;
__global__ void __launch_bounds__(NTHREADS, 2) hybrid_fwd(KArgs Aval) {
    extern __shared__ __attribute__((aligned(16))) unsigned char lds_raw[];
    LAS unsigned char* lds = (LAS unsigned char*)lds_raw;
    const int tid0 = threadIdx.x, bid = blockIdx.x, nblk = gridDim.x;
    const int wave0 = __builtin_amdgcn_readfirstlane(tid0 >> 6);
#if !MK_MULTI
    volatile LAS unsigned* bst = (volatile LAS unsigned*)(lds + AUX_OFF + 8192);
    if (tid0 < 2) bst[tid0] = 0u;
    __syncthreads();
    const XcdBarrier bar = xcd_barrier_post((unsigned*)Aval.ws, bst);
#endif
#ifndef REP_PH
#define REP_PH 1000
#endif
#pragma unroll 1
    for (int pi = Aval.ph_lo; pi < Aval.ph_hi + (REP_PH < 1000 ? 1 : 0); ++pi) {
        const int ph = pi <= REP_PH ? pi : pi - 1;
#if !MK_MULTI
        if (pi > Aval.ph_lo) { if (Aval.ph_hi > 100000) cg::this_grid().sync(); else xcd_barrier(bar); }
#endif
#ifndef ONLY
#define ONLY -1
#endif
#define EN(k) (ONLY < 0 || ((ONLY >> (k)) & 1))
        int tid; asm volatile("v_mbcnt_lo_u32_b32 %0, -1, 0\n\tv_mbcnt_hi_u32_b32 %0, -1, %0" : "=v"(tid)); tid += wave0 * 64;
        CKArgs* Ap = (CKArgs*)__builtin_amdgcn_kernarg_segment_ptr(); asm volatile("" : "+s"(Ap));
        CKArgs& A = *Ap;
        unsigned char* ws = A.ws;
        if (ph == 0) { if (EN(0)) phase_prologue(A, lds, bid, nblk, tid); }
        else if (ph == NPHASE - 1) { if (EN(6)) phase_final(A, bid, nblk, tid); }
        else {
            const int l = (ph - 1) / 5, k = (ph - 1) % 5;
            if (k == 0) { if (EN(1)) phase_norm(A, l, bid, nblk, tid); }
            else if (k == 2) { if (EN(3)) phase_mix(A, l, lds, bid, nblk, tid); }
            else if (k == 3) { if (EN(4)) phase_tr(A, l, lds, bid, nblk, tid); }
            if (k == 1 || k == 4) {
                pg8::Gemm g; EpiAll E; E.l = l; E.Ap = Ap; g.A = (const bf16_t*)(ws + WS_HY); g.K = DM;
                if (k == 1) { g.Bt = (const bf16_t*)(ws + WS_WIN) + (size_t)l * NIN * DM; g.M = MTOT; g.N = NIN; E.mode = 0; }
                else { g.Bt = (const bf16_t*)(ws + WS_WOUT) + (size_t)l * DM * DM; g.M = MLAT; g.N = DM; E.mode = 1; }
                pg8::StaticOrder S; S.init(g.M, g.N, nblk, bid);
                if (EN(2)) pg8::gemm_phase<EpiAll, pg8::StaticOrder, true, true>(lds, g, S, E, tid);
                if (k == 1) {
                    const int nu = (MTOT / 256) * (NIN / 256), nfull = nu - ((nu - 1) / nblk) * nblk;
                    if (nfull >= nblk) filt_items(A, l, tid, bid, nblk, nullptr); else if (bid >= nfull) filt_items(A, l, tid, bid - nfull, nblk - nfull, nullptr);
                }
                if (k == 4 && l < DEPTH - 1) ctx_outproj_items(A, l, lds, tid, bid, nblk);
            }
        }
    }
}

extern "C" void kernel_launch(void* const* d_in, const int* in_sizes, int n_in, void* d_out, int out_size, void* d_ws, size_t ws_size, hipStream_t stream) {
    static int grid = 0;
    if (grid == 0) {
        if (n_in != 22 || ws_size < WS_END) { fprintf(stderr, "kernel_launch: unexpected inputs (n_in %d, ws %zu)\n", n_in, ws_size); grid = -1; return; }
        int dev = 0, cus = 0, per_cu = 0;
        if (hipGetDevice(&dev) != hipSuccess || hipDeviceGetAttribute(&cus, hipDeviceAttributeMultiprocessorCount, dev) != hipSuccess) { grid = -1; return; }
        if (hipFuncSetAttribute((const void*)hybrid_fwd, hipFuncAttributeMaxDynamicSharedMemorySize, LDS_BYTES) != hipSuccess) { fprintf(stderr, "kernel_launch: hipFuncSetAttribute failed\n"); grid = -1; return; }
        if (hipOccupancyMaxActiveBlocksPerMultiprocessor(&per_cu, (const void*)hybrid_fwd, NTHREADS, LDS_BYTES) != hipSuccess || per_cu < 1) { fprintf(stderr, "kernel_launch: occupancy query says %d\n", per_cu); per_cu = 1; }
        (void)hipGetLastError();
        grid = cus;
    }
    if (grid < 0) return;
    KArgs a{};
    a.x = (const float*)d_in[0]; a.c = (const float*)d_in[1]; a.ctx = (const float*)d_in[2]; a.c_ctx = (const float*)d_in[3]; a.norm_g = (const float*)d_in[4];
    a.w_ada = (const float*)d_in[5]; a.b_ada = (const float*)d_in[6]; a.w_in = (const float*)d_in[7]; a.w_out = (const float*)d_in[8]; a.na_rpb = (const float*)d_in[9];
    a.hy_conv_w = (const float*)d_in[10]; a.hy_conv_b = (const float*)d_in[11]; a.hy_w1 = (const float*)d_in[12]; a.hy_b1 = (const float*)d_in[13]; a.hy_freq1 = (const float*)d_in[14];
    a.hy_w2 = (const float*)d_in[15]; a.hy_b2 = (const float*)d_in[16]; a.hy_freq2 = (const float*)d_in[17]; a.hy_w3 = (const float*)d_in[18]; a.hy_d = (const float*)d_in[19];
    a.sink = (const float*)d_in[20]; a.final_g = (const float*)d_in[21];
    a.out = (float*)d_out; a.ws = (unsigned char*)d_ws;
#if MK_MULTI
    for (int ph = 0; ph < NPHASE; ++ph) {
        a.ph_lo = ph; a.ph_hi = ph + 1;
        hipLaunchKernelGGL(hybrid_fwd, dim3(grid), dim3(NTHREADS), LDS_BYTES, stream, a);
    }
#else
    if (hipMemsetAsync(d_ws, 0, 16384, stream) != hipSuccess) { fprintf(stderr, "kernel_launch: memset of the barrier words failed\n"); return; }
    a.ph_lo = 0; a.ph_hi = NPHASE;
    void* args[] = {&a};
    hipError_t e = hipLaunchCooperativeKernel((const void*)hybrid_fwd, dim3(grid), dim3(NTHREADS), args, LDS_BYTES, stream);
    if (e != hipSuccess) fprintf(stderr, "cooperative launch failed: %s (grid %d)\n", hipGetErrorString(e), grid);
#endif
}
```

```cpp
#include <hip/hip_runtime.h>
#include <hip/hip_cooperative_groups.h>
#include <cstdio>
#include <cstdint>
namespace cg = cooperative_groups;

#ifndef MK_MULTI
#define MK_MULTI 0
#endif

namespace pg8 {
#define PG8_LAS __attribute__((address_space(3)))
typedef unsigned short bf16_t;
typedef short bf16x8 __attribute__((ext_vector_type(8)));
typedef float f32x4 __attribute__((ext_vector_type(4)));
typedef unsigned u32x4 __attribute__((ext_vector_type(4)));
constexpr int BM = 256, BK = 64, HALF = 128, HTB = HALF * BK * 2  , STAGE_BYTES = 8 * HTB, NXCD = 8, WGM = 8;

__host__ __device__ __forceinline__ int lds_byte(int r, int c) { const int st = (r >> 4) * 2 + (c >> 5), rr = r & 15, cc = c & 31, ob = rr * 64 + cc * 2; return st * 1024 + (ob ^ (((ob >> 9) & 1) << 5)); }
__host__ __device__ __forceinline__ void stage_rc(int b, int& R, int& C) { const int st = b / 1024, sb = b % 1024, swz = sb ^ (((sb >> 9) & 1) << 5); R = (st >> 1) * 16 + swz / 64; C = (st & 1) * 32 + (swz % 64) / 2; }
__host__ __device__ __forceinline__ int perm32(int rho) { const int n = rho >> 4, i = rho & 15; return 8 * (i >> 2) + 4 * n + (i & 3); }

struct Unit { int pm, pn; };
struct Gemm { const bf16_t* A; const bf16_t* Bt; int M, N, K; };

struct StaticOrder {
    int nM, nN, nwg, G, c, pshift;
    __host__ __device__ void init(int M, int N, int G_, int c_, int pshift_ = 0) { nM = M / BM; nN = N / BM; nwg = nM * nN; G = G_; c = c_; pshift = pshift_; }
    __host__ __device__ bool next(int i, Unit& u) const {
        const long L = (long)i * G + c; if (L >= nwg) return false;
        int wgid = (int)L; { const int q = nwg / NXCD, r = nwg % NXCD, xcd = wgid % NXCD, off = wgid / NXCD; wgid = (xcd < r ? xcd * (q + 1) : r * (q + 1) + (xcd - r) * q) + off; }
        const int nig = WGM * nN, gid = wgid / nig, fm = gid * WGM, gsz = (nM - fm) < WGM ? (nM - fm) : WGM;
        u.pm = fm + ((wgid % nig) % gsz); u.pn = (wgid % nig) / gsz + pshift; if (u.pn >= nN) u.pn -= nN; return true;
    }
    __device__ __forceinline__ void a_ready(const Unit&) const {}
    __device__ __forceinline__ void done(const Unit&) const {}
};

template <class Epi, class Sched, bool ALIGN_EPI = false, bool SP2 = false>
__device__ __forceinline__ void gemm_phase(PG8_LAS unsigned char* lds, const Gemm g, const Sched& S, const Epi& E, const int tid) {
    const int wid = __builtin_amdgcn_readfirstlane(tid >> 6), lane = tid & 63, wr = wid >> 2, wc = wid & 3, fr = lane & 15, fq = lane >> 4;
    const int K = g.K, nt = K / BK;
    unsigned voffA[2], voffB[2];
#pragma unroll
    for (int i = 0; i < 2; ++i) { int R, C; stage_rc(tid * 16 + i * 8192, R, C); const int Rb = Epi::PERM ? ((R & ~31) + perm32(R & 31)) : R;
        voffA[i] = (unsigned)(R * K + C) * 2u; voffB[i] = (unsigned)(Rb * K + C) * 2u; }
    const size_t kstep = (size_t)(BK * 2);
    const size_t hstep = (size_t)HALF * K * 2;
    const size_t tstep = 2 * hstep;
    const unsigned ldsw = (unsigned)wid * 1024u;
    const int aoff = lds_byte(wr * 64 + fr, fq * 8), boff = lds_byte(wc * 32 + fr, fq * 8);
#define PG8_SA(b, h) (((b) * 2 + (h)) * HTB)
#define PG8_SB(b, h) ((4 + (b) * 2 + (h)) * HTB)
#define PG8_STAGE(bufoff, gbase, voff) do { _Pragma("unroll") for (int _i = 0; _i < 2; ++_i) \
        __builtin_amdgcn_global_load_lds((const unsigned*)((const char*)(gbase) + (voff)[_i]), (PG8_LAS unsigned*)(lds + (bufoff) + ldsw + _i * 8192), 16, 0, 0); } while (0)
#define PG8_LDA(dst, b, h) do { _Pragma("unroll") for (int m = 0; m < 4; ++m) _Pragma("unroll") for (int k = 0; k < 2; ++k) dst[m][k] = *(const PG8_LAS bf16x8*)(lds + PG8_SA(b, h) + aoff + m * 2048 + k * 1024); } while (0)
#define PG8_LDB(dst, b, h) do { _Pragma("unroll") for (int n = 0; n < 2; ++n) _Pragma("unroll") for (int k = 0; k < 2; ++k) dst[n][k] = *(const PG8_LAS bf16x8*)(lds + PG8_SB(b, h) + boff + n * 2048 + k * 1024); } while (0)
#define PG8_MMA(ai, bj, At, Bt) do { __builtin_amdgcn_s_setprio(1); _Pragma("unroll") for (int m = 0; m < 4; ++m) _Pragma("unroll") for (int n = 0; n < 2; ++n) _Pragma("unroll") for (int k = 0; k < 2; ++k) \
        acc[ai][bj][m][n] = __builtin_amdgcn_mfma_f32_16x16x32_bf16(Bt[n][k], At[m][k], acc[ai][bj][m][n], 0, 0, 0); __builtin_amdgcn_s_setprio(0); } while (0)
#define PG8_WAIT_V(n) asm volatile("s_waitcnt vmcnt(" #n ")" ::: "memory")
#define PG8_WAIT_L(n) asm volatile("s_waitcnt lgkmcnt(" #n ")" ::: "memory")
#define PG8_BAR __builtin_amdgcn_s_barrier()
#define PG8_SCHED __builtin_amdgcn_sched_barrier(0)
    Unit cur, nxt; int ui = 0;
    if (!S.next(0, cur)) return;
    f32x4 acc[2][2][4][2];
#pragma unroll
    for (int a = 0; a < 2; ++a)
#pragma unroll
        for (int b = 0; b < 2; ++b)
#pragma unroll
            for (int m = 0; m < 4; ++m)
#pragma unroll
                for (int n = 0; n < 2; ++n) acc[a][b][m][n] = (f32x4){0.f, 0.f, 0.f, 0.f};
    bf16x8 At[4][2], B0[2][2], B1[2][2];
    const char* cA = (const char*)g.A + (size_t)cur.pm * tstep; const char* cB = (const char*)g.Bt + (size_t)cur.pn * tstep;
    S.a_ready(cur);
    if constexpr (SP2) {
        PG8_STAGE(PG8_SB(0, 0), cB, voffB); PG8_STAGE(PG8_SB(0, 1), cB + hstep, voffB); PG8_STAGE(PG8_SA(0, 0), cA, voffA); PG8_STAGE(PG8_SA(0, 1), cA + hstep, voffA);
        if (wr == 1) PG8_BAR;
        PG8_WAIT_V(2); PG8_BAR;
        PG8_STAGE(PG8_SB(1, 0), cB + kstep, voffB); PG8_STAGE(PG8_SA(1, 0), cA + kstep, voffA); PG8_STAGE(PG8_SB(1, 1), cB + hstep + kstep, voffB);
        PG8_WAIT_V(6); PG8_BAR;
    } else {
        PG8_STAGE(PG8_SB(0, 0), cB, voffB); PG8_STAGE(PG8_SA(0, 0), cA, voffA); PG8_STAGE(PG8_SB(0, 1), cB + hstep, voffB); PG8_STAGE(PG8_SA(0, 1), cA + hstep, voffA);
        if (wr == 1) PG8_BAR;
        PG8_WAIT_V(4); PG8_BAR;
        PG8_STAGE(PG8_SB(1, 0), cB + kstep, voffB); PG8_STAGE(PG8_SA(1, 0), cA + kstep, voffA); PG8_STAGE(PG8_SB(1, 1), cB + hstep + kstep, voffB);
        PG8_WAIT_V(6); PG8_BAR;
    }
    for (;;) {
        const bool has_next = S.next(ui + 1, nxt);
        const char* nA = has_next ? (const char*)g.A + (size_t)nxt.pm * tstep : cA; const char* nB = has_next ? (const char*)g.Bt + (size_t)nxt.pn * tstep : cB;
        for (int t = 0; t < nt; t += 2) {
            const bool last = (t == nt - 2);
            const char* a1 = cA + (size_t)(t + 1) * kstep;
            const char* a2 = last ? nA : cA + (size_t)(t + 2) * kstep; const char* b2 = last ? nB : cB + (size_t)(t + 2) * kstep;
            const char* a3 = a2 + kstep; const char* b3 = b2 + kstep;
            if (last && has_next) S.a_ready(nxt);
            if constexpr (SP2) {
            PG8_LDB(B0, 0, 0); PG8_LDB(B1, 0, 1); PG8_SCHED; PG8_LDA(At, 0, 0); PG8_STAGE(PG8_SA(1, 1), a1 + hstep, voffA);
            PG8_WAIT_V(8); PG8_WAIT_L(0); PG8_BAR; PG8_MMA(0, 0, At, B0); PG8_MMA(0, 1, At, B1); PG8_BAR; PG8_SCHED;
            PG8_LDA(At, 0, 1); PG8_STAGE(PG8_SB(0, 0), b2, voffB); PG8_STAGE(PG8_SB(0, 1), b2 + hstep, voffB); PG8_STAGE(PG8_SA(0, 0), a2, voffA);
            PG8_WAIT_V(8); PG8_WAIT_L(0); PG8_BAR; PG8_MMA(1, 0, At, B0); PG8_MMA(1, 1, At, B1); PG8_BAR; PG8_SCHED;
            PG8_LDB(B0, 1, 0); PG8_LDB(B1, 1, 1); PG8_SCHED; PG8_LDA(At, 1, 0); PG8_STAGE(PG8_SA(0, 1), a2 + hstep, voffA);
            PG8_WAIT_V(8); PG8_WAIT_L(0); PG8_BAR; PG8_MMA(0, 0, At, B0); PG8_MMA(0, 1, At, B1); PG8_BAR; PG8_SCHED;
            PG8_LDA(At, 1, 1); PG8_STAGE(PG8_SB(1, 0), b3, voffB); PG8_STAGE(PG8_SB(1, 1), b3 + hstep, voffB); PG8_STAGE(PG8_SA(1, 0), a3, voffA);
            PG8_WAIT_V(8); PG8_WAIT_L(0); PG8_BAR; PG8_MMA(1, 0, At, B0); PG8_MMA(1, 1, At, B1); PG8_BAR; PG8_SCHED;
            } else {
            PG8_LDB(B0, 0, 0); PG8_SCHED; PG8_LDA(At, 0, 0); PG8_STAGE(PG8_SA(1, 1), a1 + hstep, voffA);
            PG8_WAIT_L(8); PG8_BAR; PG8_WAIT_L(0); PG8_MMA(0, 0, At, B0); PG8_BAR; PG8_SCHED;
            PG8_LDB(B1, 0, 1); PG8_STAGE(PG8_SB(0, 0), b2, voffB);
            PG8_BAR; PG8_WAIT_L(0); PG8_MMA(0, 1, At, B1); PG8_BAR;
            PG8_LDA(At, 0, 1); PG8_STAGE(PG8_SA(0, 0), a2, voffA);
            PG8_BAR; PG8_WAIT_L(0); PG8_MMA(1, 0, At, B0); PG8_BAR; PG8_SCHED;
            PG8_STAGE(PG8_SB(0, 1), b2 + hstep, voffB);
            PG8_WAIT_V(6); PG8_BAR; PG8_MMA(1, 1, At, B1); PG8_BAR;
            PG8_LDB(B0, 1, 0); PG8_SCHED; PG8_LDA(At, 1, 0); PG8_STAGE(PG8_SA(0, 1), a2 + hstep, voffA);
            PG8_WAIT_L(8); PG8_BAR; PG8_WAIT_L(0); PG8_MMA(0, 0, At, B0); PG8_BAR; PG8_SCHED;
            PG8_LDB(B1, 1, 1); PG8_STAGE(PG8_SB(1, 0), b3, voffB);
            PG8_BAR; PG8_WAIT_L(0); PG8_MMA(0, 1, At, B1); PG8_BAR;
            PG8_LDA(At, 1, 1); PG8_STAGE(PG8_SA(1, 0), a3, voffA);
            PG8_BAR; PG8_WAIT_L(0); PG8_MMA(1, 0, At, B0); PG8_BAR; PG8_SCHED;
            PG8_STAGE(PG8_SB(1, 1), b3 + hstep, voffB);
            PG8_WAIT_V(6); PG8_BAR; PG8_MMA(1, 1, At, B1); PG8_BAR;
            }
        }
        if constexpr (ALIGN_EPI) { if (wr == 0) PG8_BAR; }
        if constexpr (!Epi::AFTER_DRAIN) { if (!E.after) { E(acc, cur, wr, wc, fr, fq); S.done(cur); } }
        if (!has_next) break;
#pragma unroll
        for (int a = 0; a < 2; ++a)
#pragma unroll
            for (int b = 0; b < 2; ++b)
#pragma unroll
                for (int m = 0; m < 4; ++m)
#pragma unroll
                    for (int n = 0; n < 2; ++n) acc[a][b][m][n] = (f32x4){0.f, 0.f, 0.f, 0.f};
        cur = nxt; cA = nA; cB = nB; ++ui;
        if constexpr (ALIGN_EPI) { if (wr == 1) PG8_BAR; }
    }
    PG8_WAIT_V(0);
    if constexpr (!ALIGN_EPI) { if (wr == 0) PG8_BAR; }
    PG8_BAR;
    if (E.after) { E.fused(acc, cur, wr, wc, fr, fq, lds, tid); S.done(cur); }
#undef PG8_SA
#undef PG8_SB
#undef PG8_STAGE
#undef PG8_LDA
#undef PG8_LDB
#undef PG8_MMA
#undef PG8_WAIT_V
#undef PG8_WAIT_L
#undef PG8_BAR
#undef PG8_SCHED
}
}

#define LAS __attribute__((address_space(3)))
typedef unsigned short bf16_t;
typedef short bf16x8 __attribute__((ext_vector_type(8)));
typedef float f32x4 __attribute__((ext_vector_type(4)));
typedef float f32x16 __attribute__((ext_vector_type(16)));
typedef unsigned u32x2 __attribute__((ext_vector_type(2)));
typedef unsigned u32x4 __attribute__((ext_vector_type(4)));
typedef float f32x2_t __attribute__((ext_vector_type(2)));
typedef __bf16 bf16x2_t __attribute__((ext_vector_type(2)));

constexpr int DM = 1024, NBATCH = 2, SEQ = 8192, DEPTH = 4, CTXL = 256;
constexpr int MLAT = NBATCH * SEQ, MCTX = NBATCH * CTXL, MTOT = MLAT + MCTX;
constexpr int NIN = 3584, NTM = 1536, NCM = 1024, NTB = MTOT / 64;
constexpr int C_QA = 0, C_GA = 384, C_QC = 768, C_GC = 1152;
constexpr int R_HZ = 0, R_GB = 768;
constexpr int NFFT = 16384;
constexpr float LOG2E = 1.4426950408889634f;
constexpr float QK_SCALE = 0.125f * LOG2E;

constexpr size_t MiB = 1u << 20;
constexpr size_t WS_ADA = 1 * MiB;
constexpr size_t WS_ROPE = 1 * MiB + 256 * 1024;
constexpr size_t WS_H2C = 1 * MiB + 512 * 1024;
constexpr size_t WS_CX = 2 * MiB;
constexpr size_t WS_H2 = 4 * MiB;
constexpr size_t WS_WIN = 12 * MiB;
constexpr size_t WS_WOUT = 40 * MiB;
constexpr size_t WS_HY = 48 * MiB;
constexpr size_t WS_PT = 81 * MiB;
constexpr size_t WS_KH = 130 * MiB + 512 * 1024;
constexpr size_t WS_VT = 147 * MiB;
constexpr size_t WS_PCT = 163 * MiB + 512 * 1024;
constexpr size_t WS_YBT = 197 * MiB;
constexpr size_t WS_XB = 206 * MiB;
constexpr size_t OUT_H = 0;
constexpr size_t WS_PART = 64 * 1024;
constexpr size_t OUT_ZS = 0;
constexpr size_t OUT_FILT = 32 * MiB;
constexpr size_t OUT_YBT = 48 * MiB;
constexpr size_t WS_W3T = 238 * MiB;
constexpr size_t WS_FILT = 239 * MiB;
constexpr size_t WS_END = 255 * MiB;
static_assert(WS_PT + (size_t)MTOT * NTM * 2 <= WS_KH && WS_KH + (size_t)8 * MTOT * 128 <= WS_VT && WS_VT + (size_t)8 * MTOT * 128 <= WS_PCT && WS_PCT + (size_t)NCM * MTOT * 2 <= WS_YBT, "d_ws map");

constexpr int AUX_OFF = 147456;
constexpr int LDS_BYTES = 163840;
constexpr int NTHREADS = 512;

struct KArgs {
    const float* x; const float* c; const float* ctx; const float* c_ctx; const float* norm_g; const float* w_ada; const float* b_ada;
    const float* w_in; const float* w_out; const float* na_rpb; const float* hy_conv_w; const float* hy_conv_b;
    const float* hy_w1; const float* hy_b1; const float* hy_freq1; const float* hy_w2; const float* hy_b2; const float* hy_freq2; const float* hy_w3;
    const float* hy_d; const float* sink; const float* final_g;
    float* out; unsigned char* ws;
    int ph_lo, ph_hi;
};

typedef const __attribute__((address_space(4))) KArgs CKArgs;
__device__ __forceinline__ unsigned pk2(float lo, float hi) { f32x2_t v = {lo, hi}; bf16x2_t b = __builtin_convertvector(v, bf16x2_t); return __builtin_bit_cast(unsigned, b); }
__device__ __forceinline__ float bf2f(unsigned short u) { return __uint_as_float(((unsigned)u) << 16); }
__device__ __forceinline__ float bflo(unsigned w) { return __uint_as_float(w << 16); }
__device__ __forceinline__ float bfhi(unsigned w) { return __uint_as_float(w & 0xffff0000u); }
__device__ __forceinline__ float silu_f(float x) { return x / (1.0f + __expf(-x)); }
__device__ __forceinline__ void st16_wt(void* p, u32x4 v) { asm volatile("global_store_dwordx4 %0, %1, off sc1\n\ts_nop 1" :: "v"(p), "v"(v) : "memory"); }
typedef float cf2 __attribute__((ext_vector_type(2)));
__device__ __forceinline__ cf2 mk2(float x, float y) { cf2 r; r.x = x; r.y = y; return r; }
__device__ __forceinline__ float lane_xor(float v, int lane, int m) { return __int_as_float(__builtin_amdgcn_ds_bpermute((lane ^ m) << 2, __float_as_int(v))); }
__device__ __forceinline__ float half_pair_max(float x) { const auto r = __builtin_amdgcn_permlane32_swap(__float_as_uint(x), __float_as_uint(x), false, false);
    float m; asm("v_max_f32_e32 %0, %1, %2" : "=v"(m) : "v"(__uint_as_float(r[0])), "v"(__uint_as_float(r[1]))); return m; }
__device__ __forceinline__ float half_pair_sum(float x) { const auto r = __builtin_amdgcn_permlane32_swap(__float_as_uint(x), __float_as_uint(x), false, false); return __uint_as_float(r[0]) + __uint_as_float(r[1]); }
__device__ __forceinline__ float lane_prev(float v, int lane) { return __int_as_float(__builtin_amdgcn_ds_bpermute(((lane - 1) & 63) << 2, __float_as_int(v))); }
__device__ __forceinline__ float lane_next(float v, int lane) { return __int_as_float(__builtin_amdgcn_ds_bpermute(((lane + 1) & 63) << 2, __float_as_int(v))); }
__device__ __forceinline__ float wave_sum(float v, int lane) {
#pragma unroll
    for (int o = 1; o < 64; o <<= 1) v += lane_xor(v, lane, o);
    return v;
}
__device__ __forceinline__ float rdlane(float v, int l) { return __uint_as_float(__builtin_amdgcn_readlane(__float_as_uint(v), l)); }

__device__ __forceinline__ void transpose_item(const float* W, int K, int N, bf16_t* WT, int k0, int n0, int drow0, LAS float* scr, int lane, int ldk = 0) {
    if (ldk == 0) ldk = K;
    float v[32];
#pragma unroll
    for (int i = 0; i < 32; ++i) { const int kk = 2 * i + (lane >> 5); v[i] = __builtin_nontemporal_load(&W[(size_t)(k0 + kk) * N + n0 + (lane & 31)]); }
#pragma unroll
    for (int i = 0; i < 32; ++i) { const int kk = 2 * i + (lane >> 5); scr[kk * 33 + (lane & 31)] = v[i]; }
    asm volatile("s_waitcnt lgkmcnt(0)" ::: "memory");
    const int c = lane & 7;
#pragma unroll
    for (int j = 0; j < 4; ++j) { const int n = (lane >> 3) + 8 * j; const LAS float* s = scr + (8 * c) * 33 + n;
        u32x4 o; o.x = pk2(s[0 * 33], s[1 * 33]); o.y = pk2(s[2 * 33], s[3 * 33]); o.z = pk2(s[4 * 33], s[5 * 33]); o.w = pk2(s[6 * 33], s[7 * 33]);
        __builtin_nontemporal_store(o, (u32x4*)(WT + (size_t)(drow0 + n) * ldk + k0 + 8 * c)); }
    asm volatile("s_waitcnt lgkmcnt(0)" ::: "memory");
}
__device__ __forceinline__ int win_row(int n0) {
    if (n0 < 384) return n0;
    if (n0 < 768) return n0 - 384 + 1536;
    if (n0 < 1152) return n0 - 768 + 2048;
    if (n0 < 1536) return n0 - 1152 + 384;
    if (n0 < 2304) return n0 - 1536 + 2560;
    if (n0 < 2560) return n0 - 2304 + 3328;
    if (n0 < 2944) return n0 - 2560 + 768;
    if (n0 < 3072) return n0 - 2944 + 1920;
    if (n0 < 3200) return n0 - 3072 + 2432;
    return n0 - 3200 + 1152;
}

__device__ __forceinline__ void phase_prologue(CKArgs& A, LAS unsigned char* lds, int bid, int nblk, int tid) {
    const int wave = __builtin_amdgcn_readfirstlane(tid >> 6), lane = tid & 63;
    const int gw = bid * 8 + wave, NGW = nblk * 8;
    unsigned char* ws = A.ws;
    {
        LAS float* red = (LAS float*)lds;
        LAS float* sv = (LAS float*)(lds + 8192);
        for (int i = tid; i < 3 * DM; i += NTHREADS) sv[i] = silu_f(i < 2 * DM ? A.c[i] : A.c_ctx[i - 2 * DM]);
        __syncthreads();
        for (int it = bid; it < DEPTH * 48; it += nblk) {
            const int l = it / 48, n = (it % 48) * 64 + lane;
            const float* W = A.w_ada + (size_t)l * DM * 3072 + n;
            float a0 = 0.f, a1 = 0.f, a2 = 0.f;
            const int kb = wave * 128;
#pragma unroll 1
            for (int k0 = 0; k0 < 128; k0 += 16) {
                float w[16];
#pragma unroll
                for (int k = 0; k < 16; ++k) w[k] = __builtin_nontemporal_load(&W[(size_t)(kb + k0 + k) * 3072]);
#pragma unroll
                for (int k = 0; k < 16; ++k) { a0 += sv[kb + k0 + k] * w[k]; a1 += sv[DM + kb + k0 + k] * w[k]; a2 += sv[2 * DM + kb + k0 + k] * w[k]; }
            }
            red[(wave * 3 + 0) * 64 + lane] = a0; red[(wave * 3 + 1) * 64 + lane] = a1; red[(wave * 3 + 2) * 64 + lane] = a2;
            __syncthreads();
            if (tid < 192) { const int v = tid >> 6; float sacc = A.b_ada[l * 3072 + n];
#pragma unroll
                for (int w = 0; w < 8; ++w) sacc += red[(w * 3 + v) * 64 + lane];
                ((float*)(ws + WS_ADA))[((size_t)l * 3 + v) * 3072 + n] = sacc; }
            __syncthreads();
        }
    }
    __syncthreads();
#pragma unroll 1
    for (int st_ = 0; st_ < 2; ++st_) {
    if (((st_ ^ wave) & 1) == 0) {
        LAS float* scr = (LAS float*)(lds + wave * 16384);
        constexpr int I_IN = 16 * 112, I_OUT = 16 * 32, I_L = I_IN + I_OUT;
        for (int it = gw; it < DEPTH * I_L; it += NGW) {
            const int l = it / I_L; int r = it % I_L;
            if (r < I_IN) { const int kb = r / 112, nb = r % 112, n0 = nb * 32;
                transpose_item(A.w_in + (size_t)l * DM * NIN, DM, NIN, (bf16_t*)(ws + WS_WIN) + (size_t)l * NIN * DM, kb * 64, n0, win_row(n0), scr, lane); }
            else { r -= I_IN; const int kb = r / 32, nb = r % 32, n0 = nb * 32;
                transpose_item(A.w_out + (size_t)l * DM * DM, DM, DM, (bf16_t*)(ws + WS_WOUT) + (size_t)l * DM * DM, kb * 64, n0, n0, scr, lane); }
        }
    } else {
    {
        LAS float* hs = (LAS float*)(lds + wave * 16384);
        const int k4 = lane >> 4, rc = lane & 15;
#pragma unroll 1
        for (int it = gw; it < DEPTH * 528; it += NGW) {
            const int l = it / 528, g4 = it % 528, g = g4 >> 2, sub = g4 & 3;
            const int L = g < 128 ? SEQ : CTXL;
            const int n0 = (g < 128 ? g * 64 : (g - 128) * 64) + 16 * sub;
            const float* W1 = A.hy_w1 + (size_t)l * 33 * 64 + rc; const float* W2 = A.hy_w2 + (size_t)l * 64 * 64 + rc;
            const float nf = (float)(n0 + rc);
            const float t = nf * (1.0f / (float)(L - 1)), nl = nf * (1.0f / (float)L);
            f32x4 d[4];
#pragma unroll
            for (int nt = 0; nt < 4; ++nt) d[nt] = (f32x4){0.f, 0.f, 0.f, 0.f};
#pragma unroll
            for (int ks = 0; ks < 9; ++ks) {
                const int k = 9 * k4 + ks; const bool valid = k < 33; const int kc = valid ? k : 0;
                const int fj = k == 0 ? 0 : ((k - 1) & 15);
                const float fq = 1e-4f + (float)fj * ((15.0f - 1e-4f) / 15.0f);
                const float rev = fq * nl + (k <= 16 ? 0.25f : 0.5f);
                float zq = __builtin_amdgcn_sinf(rev - floorf(rev));
                if (k == 0) zq = t; if (!valid) zq = 0.f;
#pragma unroll
                for (int nt = 0; nt < 4; ++nt) d[nt] = __builtin_amdgcn_mfma_f32_16x16x4f32(zq, W1[kc * 64 + 16 * nt], d[nt], 0, 0, 0);
            }
#pragma unroll
            for (int nt = 0; nt < 4; ++nt) {
                const float b1 = A.hy_b1[l * 64 + 16 * nt + rc], fr1 = A.hy_freq1[l * 64 + 16 * nt + rc];
#pragma unroll
                for (int r = 0; r < 4; ++r) { const float x1 = fr1 * (d[nt][r] + b1) * 0.15915494309189535f; hs[(4 * k4 + r) * 68 + 16 * nt + rc] = __builtin_amdgcn_sinf(x1 - floorf(x1)); }
            }
            asm volatile("s_waitcnt lgkmcnt(0)" ::: "memory");
            f32x4 ha[4];
#pragma unroll
            for (int j = 0; j < 4; ++j) ha[j] = *(LAS const f32x4*)(hs + rc * 68 + 16 * k4 + 4 * j);
            f32x4 e[4];
#pragma unroll
            for (int nt = 0; nt < 4; ++nt) e[nt] = (f32x4){0.f, 0.f, 0.f, 0.f};
#pragma unroll
            for (int ks = 0; ks < 16; ++ks) {
                const float av = ha[ks >> 2][ks & 3];
#pragma unroll
                for (int nt = 0; nt < 4; ++nt) e[nt] = __builtin_amdgcn_mfma_f32_16x16x4f32(av, W2[(16 * k4 + ks) * 64 + 16 * nt], e[nt], 0, 0, 0);
            }
            asm volatile("s_waitcnt lgkmcnt(0)" ::: "memory");
            float* outp = (float*)(ws + WS_H2C) + ((size_t)l * CTXL + n0) * 64;
            bf16_t* outb = (bf16_t*)(ws + WS_H2) + ((size_t)l * SEQ + n0) * 64;
#pragma unroll
            for (int nt = 0; nt < 4; ++nt) {
                const float b2 = A.hy_b2[l * 64 + 16 * nt + rc], fr2 = A.hy_freq2[l * 64 + 16 * nt + rc];
#pragma unroll
                for (int r = 0; r < 4; ++r) { const float x2 = fr2 * (e[nt][r] + b2) * 0.15915494309189535f; const float h2 = __builtin_amdgcn_sinf(x2 - floorf(x2));
                    const int o = (4 * k4 + r) * 64 + 16 * nt + rc;
                    if (g < 128) outb[o] = (bf16_t)(pk2(h2, 0.f) & 0xffffu); else outp[o] = h2; }
            }
        }
    }
    }
    }
    {
        LAS float* scr = (LAS float*)(lds + wave * 16384);
        bf16_t* W3T = (bf16_t*)(ws + WS_W3T);
        for (int it = gw; it < DEPTH * 32; it += NGW) { const int l = it >> 5, nb = it & 31;
            transpose_item(A.hy_w3 + (size_t)l * 64 * 1024, 64, 1024, W3T + (size_t)l * 1024 * 64, 0, nb * 32, nb * 32, scr, lane); }
    }
    for (int idx = gw * 64 + lane; idx < 128 * 16; idx += NGW * 64) {
        const int p = idx >> 4, i = idx & 15;
        const float inv = powf(10000.0f, -(float)i / 16.0f);
        const float ang = (float)p * inv;
        ((float2*)(ws + WS_ROPE))[idx] = make_float2(cosf(ang), sinf(ang));
    }
}

__device__ __forceinline__ void filt_items(CKArgs& A, int lf, int tid, int bid, int nblk, unsigned* ctr) {
    unsigned char* ws = A.ws;
    const int wave = __builtin_amdgcn_readfirstlane(tid >> 6), lane = tid & 63;
    const int gw = bid * 8 + wave, NGW = nblk * 8;
    const bf16_t* H2B = (const bf16_t*)(ws + WS_H2) + (size_t)lf * SEQ * 64;
    const bf16_t* W3T = (const bf16_t*)(ws + WS_W3T) + (size_t)lf * 1024 * 64;
    bf16_t* FILT = (bf16_t*)(A.ws + WS_FILT);
    const int fr = lane & 15, fq = lane >> 4;
    int it = gw;
#pragma unroll 1
    for (;;) {
        if (ctr) { unsigned t = 0; if (lane == 0) t = __hip_atomic_fetch_add(ctr, 1u, __ATOMIC_RELAXED, __HIP_MEMORY_SCOPE_AGENT); it = (int)__builtin_amdgcn_readfirstlane(t); }
        if (it >= 2048) break;
        const int n0 = (it >> 4) * 64, c0 = (it & 15) * 64;
        bf16x8 af[4][2];
#pragma unroll
        for (int j = 0; j < 4; ++j) { const bf16_t* ap = H2B + (size_t)(n0 + 16 * (fr >> 2) + 4 * j + (fr & 3)) * 64 + 8 * fq; af[j][0] = *(const bf16x8*)ap; af[j][1] = *(const bf16x8*)(ap + 32); }
#pragma unroll 1
        for (int ct = 0; ct < 4; ++ct) {
            const bf16_t* bp = W3T + (size_t)(c0 + 16 * ct + fr) * 64 + 8 * fq;
            const bf16x8 b0 = *(const bf16x8*)bp, b1 = *(const bf16x8*)(bp + 32);
            u32x4 o0, o1;
#pragma unroll
            for (int j = 0; j < 4; ++j) {
                f32x4 acc = {0.f, 0.f, 0.f, 0.f};
                acc = __builtin_amdgcn_mfma_f32_16x16x32_bf16(af[j][0], b0, acc, 0, 0, 0);
                acc = __builtin_amdgcn_mfma_f32_16x16x32_bf16(af[j][1], b1, acc, 0, 0, 0);
                const unsigned w0 = pk2(acc.x, acc.y), w1 = pk2(acc.z, acc.w);
                if (j == 0) { o0.x = w0; o0.y = w1; } else if (j == 1) { o0.z = w0; o0.w = w1; } else if (j == 2) { o1.x = w0; o1.y = w1; } else { o1.z = w0; o1.w = w1; }
            }
            bf16_t* dp = FILT + (size_t)(c0 + 16 * ct + fr) * SEQ + n0 + 16 * fq;
            *(u32x4*)dp = o0; *(u32x4*)(dp + 8) = o1;
        }
        if (!ctr) it += NGW;
    }
}

__device__ __forceinline__ void norm_load_row(CKArgs& A, int l, int m, int lane, f32x4 (&xv)[4]) {
    unsigned char* ws = A.ws;
    if ((m < MLAT) && (l > 0)) {
        const bf16_t* sb = (const bf16_t*)(ws + WS_XB) + (size_t)m * DM;
#pragma unroll
        for (int j = 0; j < 4; ++j) { const u32x2 w = *(const u32x2*)(sb + 4 * lane + 256 * j); xv[j] = (f32x4){bflo(w.x), bfhi(w.x), bflo(w.y), bfhi(w.y)}; }
    } else {
        const float* src = (m < MLAT) ? A.x + (size_t)m * DM : (l == 0 ? A.ctx : (const float*)(ws + WS_CX)) + (size_t)(m - MLAT) * DM;
#pragma unroll
        for (int j = 0; j < 4; ++j) xv[j] = *(const f32x4*)(src + 4 * lane + 256 * j);
    }
}
__device__ __forceinline__ float norm_sumsq(const f32x4 (&xv)[4]) {
    float ss = 0.f;
#pragma unroll
    for (int j = 0; j < 4; ++j) ss += (xv[j].x * xv[j].x + xv[j].y * xv[j].y) + (xv[j].z * xv[j].z + xv[j].w * xv[j].w);
    return ss;
}
__device__ __forceinline__ void phase_norm(CKArgs& A, int l, int bid, int nblk, int tid) {
    const int wave = __builtin_amdgcn_readfirstlane(tid >> 6), lane = tid & 63;
    const int gw = bid * 8 + wave, NGW = nblk * 8;
    unsigned char* ws = A.ws;
    bf16_t* H = (bf16_t*)((unsigned char*)A.out + OUT_H);
    const float* ada = (const float*)(ws + WS_ADA) + (size_t)l * 3 * 3072;
    const float* g = A.norm_g + l * DM;
#pragma unroll 1
    for (int m0 = ((l > 0 && nblk == 256) ? MLAT : 0) + gw; m0 < MTOT; m0 += 2 * NGW) {
        const int m1 = m0 + NGW; const bool has1 = m1 < MTOT; const int m1c = has1 ? m1 : m0;
        f32x4 xa[4], xc[4];
        norm_load_row(A, l, m0, lane, xa); norm_load_row(A, l, m1c, lane, xc);
        const float* sh0 = ada + (m0 < MLAT ? m0 >> 13 : 2) * 3072; const float* sh1 = ada + (m1c < MLAT ? m1c >> 13 : 2) * 3072;
        const float ra = rsqrtf(wave_sum(norm_sumsq(xa), lane) * (1.0f / DM) + 1e-6f);
        const float rc = rsqrtf(wave_sum(norm_sumsq(xc), lane) * (1.0f / DM) + 1e-6f);
#pragma unroll
        for (int j = 0; j < 4; ++j) { const int col = 4 * lane + 256 * j;
            const f32x4 gv = *(const f32x4*)(g + col);
            { const f32x4 sc = *(const f32x4*)(sh0 + DM + col), sh = *(const f32x4*)(sh0 + col);
              const f32x4 h = xa[j] * ra * gv * (sc + 1.0f) + sh;
              u32x2 o; o.x = pk2(h.x, h.y); o.y = pk2(h.z, h.w);
              *(u32x2*)(H + (size_t)m0 * DM + col) = o; }
            if (has1) { const f32x4 sc = *(const f32x4*)(sh1 + DM + col), sh = *(const f32x4*)(sh1 + col);
              const f32x4 h = xc[j] * rc * gv * (sc + 1.0f) + sh;
              u32x2 o; o.x = pk2(h.x, h.y); o.y = pk2(h.z, h.w);
              *(u32x2*)(H + (size_t)m1 * DM + col) = o; }
        }
    }
}

#define XB_TMO      128
#define XB_XCNT(j)  (256  + 64 * (j))
#define XB_XSUB(j)  (1280 + 64 * (j))
#define XB_XGEN(j)  (2304 + 64 * (j))
#define XB_TOP      3328
#define XB_TOPGEN   3392
#define XCD_BAR_WORDS 3456
#define XB_SPIN_CAP (1u << 18)

__device__ __forceinline__ unsigned xb_ld(unsigned* p)              { return __hip_atomic_load(p, __ATOMIC_RELAXED, __HIP_MEMORY_SCOPE_AGENT); }
__device__ __forceinline__ unsigned xb_add(unsigned* p, unsigned v) { return __hip_atomic_fetch_add(p, v, __ATOMIC_RELAXED, __HIP_MEMORY_SCOPE_AGENT); }
__device__ __forceinline__ unsigned xb_xcc_id() { return (unsigned)__builtin_amdgcn_s_getreg((3 << 11) | 20) & 0xFu; }
#define XB_SPIN(cond, bar) do { unsigned _sp = 0; while (cond) { __builtin_amdgcn_s_sleep(1); \
    if ((++_sp & 255u) == 0u) { if (xb_ld(&(bar)[XB_TMO])) break; if (_sp > XB_SPIN_CAP) { atomicAdd(&(bar)[XB_TMO], 1u); break; } } } } while (0)
#define XB_CFLAG    3776
#define XB_HYFLAG   3840
#define XB_NFLAG3   3968
#define XB_NFLAG    3584

struct EpiIn {
    static constexpr bool PERM = true, AFTER_DRAIN = false;
    bf16_t* PT; bf16_t* KH; bf16_t* PCT; LAS const float2* rope;
    __device__ __forceinline__ void operator()(const f32x4 (&acc)[2][2][4][2], const pg8::Unit& u, int wr, int wc, int fr, int fq) const {
        const int row0 = u.pm * 256 + wr * 64 + fr;
        if (u.pn < 10) {
#pragma unroll
            for (int bj = 0; bj < 2; ++bj) {
                const int blk = 2 * u.pn + bj;
                const bool rp = ((blk >= 6 && blk <= 8) || blk == 15) && (u.pm < 64);
                const int col0 = 256 * u.pn + 128 * bj + 32 * wc + 8 * fq;
                bf16_t* dst; size_t ld;
                if (u.pn < 6) { dst = PT + col0; ld = NTM; }
                else { const int n2 = col0 - 1536; dst = KH + (size_t)(n2 >> 6) * MTOT * 64 + (n2 & 63); ld = 64; }
#pragma unroll
                for (int ai = 0; ai < 2; ++ai)
#pragma unroll
                    for (int m = 0; m < 4; ++m) {
                        const int r = row0 + 128 * ai + 16 * m;
                        f32x4 v0 = acc[ai][bj][m][0], v1 = acc[ai][bj][m][1];
                        if (rp) {
                            const int pos = r & (SEQ - 1);
                            const int p = (wc & 1) ? (pos & 63) : (pos >> 6);
                            LAS const f32x4* tb = (LAS const f32x4*)(rope + p * 16 + 8 * (fq & 1));
                            const int ln = fr + 16 * fq;
                            const float sg = (fq < 2) ? -1.0f : 1.0f;
                            { const f32x4 t0 = tb[0], t1 = tb[1];
                              const float qx = lane_xor(v0.x, ln, 32), qy = lane_xor(v0.y, ln, 32), qz = lane_xor(v0.z, ln, 32), qw = lane_xor(v0.w, ln, 32);
                              v0.x = v0.x * t0.x + sg * qx * t0.y; v0.y = v0.y * t0.z + sg * qy * t0.w; v0.z = v0.z * t1.x + sg * qz * t1.y; v0.w = v0.w * t1.z + sg * qw * t1.w; }
                            { const f32x4 t2 = tb[2], t3 = tb[3];
                              const float qx = lane_xor(v1.x, ln, 32), qy = lane_xor(v1.y, ln, 32), qz = lane_xor(v1.z, ln, 32), qw = lane_xor(v1.w, ln, 32);
                              v1.x = v1.x * t2.x + sg * qx * t2.y; v1.y = v1.y * t2.z + sg * qy * t2.w; v1.z = v1.z * t3.x + sg * qz * t3.y; v1.w = v1.w * t3.z + sg * qw * t3.w; }
                        }
                        u32x4 w; w.x = pk2(v0.x, v0.y); w.y = pk2(v0.z, v0.w); w.z = pk2(v1.x, v1.y); w.w = pk2(v1.z, v1.w);
                        *(u32x4*)(dst + (size_t)r * ld) = w;
                        asm volatile("" ::: "memory");
                    }
            }
        } else {
#pragma unroll
            for (int bj = 0; bj < 2; ++bj) {
                const int ch0 = 256 * (u.pn - 10) + 128 * bj + 32 * wc + 8 * fq;
#pragma unroll
                for (int ai = 0; ai < 2; ++ai)
#pragma unroll
                    for (int m = 0; m < 4; ++m) {
                        const int r = row0 + 128 * ai + 16 * m;
                        bf16_t* p = PCT + (size_t)ch0 * MTOT + r;
#pragma unroll
                        for (int n = 0; n < 2; ++n) {
                            const f32x4 v = acc[ai][bj][m][n];
                            bf16_t* q = p + (size_t)(4 * n) * MTOT;
                            const unsigned w0 = pk2(v.x, v.y), w1 = pk2(v.z, v.w);
                            q[0] = (bf16_t)(w0 & 0xffffu); q[MTOT] = (bf16_t)(w0 >> 16); q[2 * (size_t)MTOT] = (bf16_t)(w1 & 0xffffu); q[3 * (size_t)MTOT] = (bf16_t)(w1 >> 16);
                        }
                    }
            }
        }
    }
};
struct EpiFilt {
    static constexpr bool PERM = true, AFTER_DRAIN = false;
    bf16_t* O; int ldc;
    __device__ __forceinline__ void operator()(const f32x4 (&acc)[2][2][4][2], const pg8::Unit& u, int wr, int wc, int fr, int fq) const {
        const int row0 = u.pm * 256 + wr * 64 + fr;
#pragma unroll
        for (int bj = 0; bj < 2; ++bj) { const int col0 = 256 * u.pn + 128 * bj + 32 * wc + 8 * fq;
#pragma unroll
            for (int ai = 0; ai < 2; ++ai)
#pragma unroll
                for (int m = 0; m < 4; ++m) { const int r = row0 + 128 * ai + 16 * m; const f32x4 v0 = acc[ai][bj][m][0], v1 = acc[ai][bj][m][1];
                    u32x4 w; w.x = pk2(v0.x, v0.y); w.y = pk2(v0.z, v0.w); w.z = pk2(v1.x, v1.y); w.w = pk2(v1.z, v1.w);
                    *(u32x4*)(O + (size_t)r * ldc + col0) = w; } }
    }
};
struct EpiOut {
    static constexpr bool PERM = true, AFTER_DRAIN = false;
    const float* xsrc; bf16_t* xb; float* xdst; const float* ada; bool src32, dst32;
    __device__ __forceinline__ void operator()(const f32x4 (&acc)[2][2][4][2], const pg8::Unit& u, int wr, int wc, int fr, int fq) const {
        const int row0 = u.pm * 256 + wr * 64 + fr;
        const int v = row0 >> 13;
#pragma unroll
        for (int bj = 0; bj < 2; ++bj) {
            const int col0 = 256 * u.pn + 128 * bj + 32 * wc + 8 * fq;
            const float* gp = ada + v * 3072 + 2048 + col0;
            const f32x4 g0 = *(const f32x4*)gp, g1 = *(const f32x4*)(gp + 4);
#pragma unroll
            for (int ai = 0; ai < 2; ++ai)
#pragma unroll
              for (int mh = 0; mh < 2; ++mh) {
                f32x4 x0[2], x1[2];
                if (src32) {
#pragma unroll
                    for (int mm = 0; mm < 2; ++mm) { const float* sp = xsrc + (size_t)(row0 + 128 * ai + 16 * (2 * mh + mm)) * DM + col0; x0[mm] = *(const f32x4*)sp; x1[mm] = *(const f32x4*)(sp + 4); }
                } else {
#pragma unroll
                    for (int mm = 0; mm < 2; ++mm) { const u32x4 w = *(const u32x4*)(xb + (size_t)(row0 + 128 * ai + 16 * (2 * mh + mm)) * DM + col0);
                        x0[mm] = (f32x4){bflo(w.x), bfhi(w.x), bflo(w.y), bfhi(w.y)}; x1[mm] = (f32x4){bflo(w.z), bfhi(w.z), bflo(w.w), bfhi(w.w)}; }
                }
#pragma unroll
                for (int mm = 0; mm < 2; ++mm) { const int m = 2 * mh + mm; const size_t off = (size_t)(row0 + 128 * ai + 16 * m) * DM + col0;
                    const f32x4 y0 = x0[mm] + g0 * acc[ai][bj][m][0], y1 = x1[mm] + g1 * acc[ai][bj][m][1];
                    if (dst32) { *(f32x4*)(xdst + off) = y0; *(f32x4*)(xdst + off + 4) = y1; }
                    else { u32x4 w; w.x = pk2(y0.x, y0.y); w.y = pk2(y0.z, y0.w); w.z = pk2(y1.x, y1.y); w.w = pk2(y1.z, y1.w); *(u32x4*)(xb + off) = w; } }
                asm volatile("" ::: "memory");
              }
        }
    }
};
struct EpiOutNorm {
    const float* xsrc; bf16_t* xb; bf16_t* H; const float* ada; const float* adan; const float* gn; float* part; unsigned* flg; unsigned* bar; bool src32;
    __device__ __forceinline__ void fused(const f32x4 (&acc)[2][2][4][2], const pg8::Unit& u, int wr, int wc, int fr, int fq, LAS unsigned char* lds, int tid) const {
        const int row0 = u.pm * 256 + wr * 64 + fr;
        const int v = row0 >> 13, lane = tid & 63;
        float rs[2][4];
#pragma unroll
        for (int ai = 0; ai < 2; ++ai)
#pragma unroll
            for (int m = 0; m < 4; ++m) rs[ai][m] = 0.f;
#pragma unroll
        for (int bj = 0; bj < 2; ++bj) {
            const int col0 = 256 * u.pn + 128 * bj + 32 * wc + 8 * fq;
            const float* gp = ada + v * 3072 + 2048 + col0;
            const f32x4 g0 = *(const f32x4*)gp, g1 = *(const f32x4*)(gp + 4);
#pragma unroll
            for (int ai = 0; ai < 2; ++ai) {
                f32x4 x0[4], x1[4];
                if (src32) {
#pragma unroll
                    for (int m = 0; m < 4; ++m) { const float* sp = xsrc + (size_t)(row0 + 128 * ai + 16 * m) * DM + col0; x0[m] = *(const f32x4*)sp; x1[m] = *(const f32x4*)(sp + 4); }
                } else {
#pragma unroll
                    for (int m = 0; m < 4; ++m) { const u32x4 w = *(const u32x4*)(xb + (size_t)(row0 + 128 * ai + 16 * m) * DM + col0);
                        x0[m] = (f32x4){bflo(w.x), bfhi(w.x), bflo(w.y), bfhi(w.y)}; x1[m] = (f32x4){bflo(w.z), bfhi(w.z), bflo(w.w), bfhi(w.w)}; }
                }
#pragma unroll
                for (int m = 0; m < 4; ++m) { const size_t off = (size_t)(row0 + 128 * ai + 16 * m) * DM + col0;
                    const f32x4 y0 = x0[m] + g0 * acc[ai][bj][m][0], y1 = x1[m] + g1 * acc[ai][bj][m][1];
                    u32x4 w; w.x = pk2(y0.x, y0.y); w.y = pk2(y0.z, y0.w); w.z = pk2(y1.x, y1.y); w.w = pk2(y1.z, y1.w);
                    *(u32x4*)(xb + off) = w;
                    const f32x4 r0 = (f32x4){bflo(w.x), bfhi(w.x), bflo(w.y), bfhi(w.y)}, r1 = (f32x4){bflo(w.z), bfhi(w.z), bflo(w.w), bfhi(w.w)};
                    rs[ai][m] += (r0.x * r0.x + r0.y * r0.y) + (r0.z * r0.z + r0.w * r0.w) + (r1.x * r1.x + r1.y * r1.y) + (r1.z * r1.z + r1.w * r1.w); }
                asm volatile("" ::: "memory");
            }
        }
        LAS float* red = (LAS float*)lds;
#pragma unroll
        for (int ai = 0; ai < 2; ++ai)
#pragma unroll
            for (int m = 0; m < 4; ++m) { float t = rs[ai][m]; t += lane_xor(t, lane, 16); t = half_pair_sum(t); if (fq == 0) red[((wr * 4 + wc) * 8 + ai * 4 + m) * 16 + fr] = t; }
        __syncthreads();
        float* mypart = part + ((size_t)u.pm * 4) * 256;
        if (tid < 256) { const int ai = tid >> 7, wr2 = (tid >> 6) & 1, m = (tid >> 4) & 3, f = tid & 15; const int o = (wr2 * 4 * 8 + ai * 4 + m) * 16 + f;
            const float ps = (red[o] + red[o + 128]) + (red[o + 256] + red[o + 384]);
            __hip_atomic_store(mypart + u.pn * 256 + tid, ps, __ATOMIC_RELAXED, __HIP_MEMORY_SCOPE_AGENT); }
        asm volatile("s_waitcnt vmcnt(0)" ::: "memory");
        __syncthreads();
        if (tid == 0) xb_add(&flg[u.pm], 1u);
    }
    __device__ __forceinline__ void pass2(const pg8::Unit& u, LAS unsigned char* lds, int tid) const {
        if (tid == 0) XB_SPIN(xb_ld(&flg[u.pm]) < 4u, bar);
        __syncthreads();
        LAS float* rinvs = (LAS float*)lds;
        const float* mypart = part + ((size_t)u.pm * 4) * 256;
        if (tid < 256) { float tot = 0.f;
#pragma unroll
            for (int q = 0; q < 4; ++q) tot += __hip_atomic_load(mypart + q * 256 + tid, __ATOMIC_RELAXED, __HIP_MEMORY_SCOPE_AGENT);
            rinvs[tid] = rsqrtf(tot * (1.0f / DM) + 1e-6f); }
        __syncthreads();
        const int v = (u.pm * 256) >> 13, col0 = 256 * u.pn + 8 * (tid & 31), rb = tid >> 5;
        const float* shp = adan + v * 3072; const float* scp = shp + DM;
        const f32x4 gv0 = *(const f32x4*)(gn + col0), gv1 = *(const f32x4*)(gn + col0 + 4), sc0 = *(const f32x4*)(scp + col0), sc1 = *(const f32x4*)(scp + col0 + 4);
        const f32x4 a0 = gv0 * (sc0 + 1.0f), a1 = gv1 * (sc1 + 1.0f), s0 = *(const f32x4*)(shp + col0), s1 = *(const f32x4*)(shp + col0 + 4);
        u32x4 wv[16];
#pragma unroll
        for (int i = 0; i < 16; ++i) wv[i] = *(const u32x4*)(xb + (size_t)(u.pm * 256 + rb + 16 * i) * DM + col0);
#pragma unroll
        for (int i = 0; i < 16; ++i) {
            const int rl = rb + 16 * i; const size_t off = (size_t)(u.pm * 256 + rl) * DM + col0;
            const u32x4 w = wv[i];
            const float ri = rinvs[rl];
            const f32x4 h0 = (f32x4){bflo(w.x), bfhi(w.x), bflo(w.y), bfhi(w.y)} * ri * a0 + s0, h1 = (f32x4){bflo(w.z), bfhi(w.z), bflo(w.w), bfhi(w.w)} * ri * a1 + s1;
            u32x4 o; o.x = pk2(h0.x, h0.y); o.y = pk2(h0.z, h0.w); o.z = pk2(h1.x, h1.y); o.w = pk2(h1.z, h1.w);
            *(u32x4*)(H + off) = o;
        }
    }
    __device__ __forceinline__ void pass2f(const pg8::Unit& u, LAS unsigned char* lds, int tid, const float* gfin, float* outf) const {
        if (tid == 0) XB_SPIN(xb_ld(&flg[u.pm]) < 4u, bar);
        __syncthreads();
        LAS float* rinvs = (LAS float*)lds;
        const float* mypart = part + ((size_t)u.pm * 4) * 256;
        if (tid < 256) { float tot = 0.f;
#pragma unroll
            for (int q = 0; q < 4; ++q) tot += __hip_atomic_load(mypart + q * 256 + tid, __ATOMIC_RELAXED, __HIP_MEMORY_SCOPE_AGENT);
            rinvs[tid] = rsqrtf(tot * (1.0f / DM) + 1e-6f); }
        __syncthreads();
        const int col0 = 256 * u.pn + 8 * (tid & 31), rb = tid >> 5;
        const f32x4 gv0 = *(const f32x4*)(gfin + col0), gv1 = *(const f32x4*)(gfin + col0 + 4);
        u32x4 wv[16];
#pragma unroll
        for (int i = 0; i < 16; ++i) wv[i] = *(const u32x4*)(xb + (size_t)(u.pm * 256 + rb + 16 * i) * DM + col0);
#pragma unroll
        for (int i = 0; i < 16; ++i) {
            const int rl = rb + 16 * i; const size_t off = (size_t)(u.pm * 256 + rl) * DM + col0;
            const u32x4 w = wv[i];
            const float ri = rinvs[rl];
            *(f32x4*)(outf + off) = (f32x4){bflo(w.x), bfhi(w.x), bflo(w.y), bfhi(w.y)} * ri * gv0;
            *(f32x4*)(outf + off + 4) = (f32x4){bflo(w.z), bfhi(w.z), bflo(w.w), bfhi(w.w)} * ri * gv1;
        }
    }
};
struct EpiAll {
    static constexpr bool PERM = true, AFTER_DRAIN = false;
    int mode, l; CKArgs* Ap; bool after; LAS unsigned char* ldsb;
    __device__ __forceinline__ void operator()(const f32x4 (&acc)[2][2][4][2], const pg8::Unit& u, int wr, int wc, int fr, int fq) const {
        unsigned char* ws = Ap->ws;
        if (mode == 0) { const EpiIn E{(bf16_t*)(ws + WS_PT), (bf16_t*)(ws + WS_KH), (bf16_t*)(ws + WS_PCT), (LAS const float2*)(ldsb + 131072)}; E(acc, u, wr, wc, fr, fq); }
        else { const EpiOut E{Ap->x, (bf16_t*)(ws + WS_XB), Ap->out, (const float*)(ws + WS_ADA) + (size_t)l * 3 * 3072, l == 0, false}; E(acc, u, wr, wc, fr, fq); }
    }
    __device__ __forceinline__ EpiOutNorm outnorm() const {
        unsigned char* ws = Ap->ws;
        return EpiOutNorm{Ap->x, (bf16_t*)(ws + WS_XB), (bf16_t*)((unsigned char*)Ap->out + OUT_H), (const float*)(ws + WS_ADA) + (size_t)l * 3 * 3072, (const float*)(ws + WS_ADA) + (size_t)(l + 1) * 3 * 3072,
                          Ap->norm_g + (l + 1) * DM, (float*)(ws + WS_PART) + (size_t)(l % 3) * 64 * 4 * 256, (unsigned*)ws + (l < 3 ? XB_NFLAG + l * 64 : XB_NFLAG3), (unsigned*)ws, l == 0};
    }
    __device__ __forceinline__ void fused(const f32x4 (&acc)[2][2][4][2], const pg8::Unit& u, int wr, int wc, int fr, int fq, LAS unsigned char* lds, int tid) const { outnorm().fused(acc, u, wr, wc, fr, fq, lds, tid); }
};
__device__ __forceinline__ void ctx_outproj_items(CKArgs& A, int l, LAS unsigned char* lds, int tid, int bid, int nblk, bool fusednorm) {
    unsigned char* ws = A.ws;
    const int wave = __builtin_amdgcn_readfirstlane(tid >> 6), lane = tid & 63;
    const bf16_t* Y = (const bf16_t*)(ws + WS_HY) + (size_t)MLAT * DM;
    const bf16_t* WT = (const bf16_t*)(ws + WS_WOUT) + (size_t)l * DM * DM;
    const float* gate = (const float*)(ws + WS_ADA) + ((size_t)l * 3 + 2) * 3072 + 2048;
    const float* csrc = l == 0 ? A.ctx : (const float*)(ws + WS_CX);
    float* cdst = (float*)(ws + WS_CX);
    const int r31 = lane & 31, hh = lane >> 5;
    LAS float* part = (LAS float*)lds;
#pragma unroll 1
    for (int it = bid; it < 256; it += nblk) {
        const int T = 2 * it + (wave >> 2), kq = wave & 3;
        const int r0 = (T >> 5) * 32, c0 = (T & 31) * 32;
        const bf16_t* ap = WT + (size_t)(c0 + r31) * DM + 256 * kq + 8 * hh;
        const bf16_t* bp = Y + (size_t)(r0 + r31) * DM + 256 * kq + 8 * hh;
        f32x16 acc;
#pragma unroll
        for (int i = 0; i < 16; ++i) acc[i] = 0.f;
#pragma unroll 1
        for (int k0 = 0; k0 < 16; k0 += 8) {
            bf16x8 a[8], b[8];
#pragma unroll
            for (int k = 0; k < 8; ++k) { a[k] = *(const bf16x8*)(ap + 16 * (k0 + k)); b[k] = *(const bf16x8*)(bp + 16 * (k0 + k)); }
#pragma unroll
            for (int k = 0; k < 8; ++k) acc = __builtin_amdgcn_mfma_f32_32x32x16_bf16(a[k], b[k], acc, 0, 0, 0);
        }
        __syncthreads();
        LAS float* pw = part + wave * (32 * 36) + r31 * 36 + 4 * hh;
#pragma unroll
        for (int g = 0; g < 4; ++g) *(LAS f32x4*)(pw + 8 * g) = (f32x4){acc[4 * g], acc[4 * g + 1], acc[4 * g + 2], acc[4 * g + 3]};
        __syncthreads();
        {
            const int tt = tid >> 8, row = (tid & 255) >> 3, col = 4 * (tid & 7);
            const int T2 = 2 * it + tt, rr = (T2 >> 5) * 32 + row, cc = (T2 & 31) * 32 + col;
            LAS const float* pr = part + (4 * tt) * (32 * 36) + row * 36 + col;
            const f32x4 s = (*(LAS const f32x4*)pr + *(LAS const f32x4*)(pr + 32 * 36)) + (*(LAS const f32x4*)(pr + 2 * 32 * 36) + *(LAS const f32x4*)(pr + 3 * 32 * 36));
            const f32x4 g = *(const f32x4*)(gate + cc);
            const size_t off = (size_t)rr * DM + cc;
            const f32x4 cn = *(const f32x4*)(csrc + off) + g * s;
            if (fusednorm) st16_wt(cdst + off, __builtin_bit_cast(u32x4, cn)); else *(f32x4*)(cdst + off) = cn;
        }
    }
    if (fusednorm) {
        unsigned* cf = (unsigned*)ws + XB_CFLAG + l * 16;
        asm volatile("s_waitcnt vmcnt(0)" ::: "memory");
        __syncthreads();
        if (tid == 0) xb_add(&cf[bid >> 4], 1u);
    }
}
__device__ __forceinline__ void ctx_norm_finish(CKArgs& A, int l, int tid, int bid) {
    unsigned char* ws = A.ws;
    const int wave = __builtin_amdgcn_readfirstlane(tid >> 6), lane = tid & 63;
    unsigned* bar = (unsigned*)ws; unsigned* cf = bar + XB_CFLAG + l * 16;
    const int rg = bid >> 4;
    if (tid == 0) XB_SPIN(xb_ld(&cf[rg]) < 16u, bar);
    __syncthreads();
    if (wave < 2) {
        const int cr = 32 * rg + 2 * (bid & 15) + wave;
        const float* src = (const float*)(ws + WS_CX) + (size_t)cr * DM;
        const float* adan = (const float*)(ws + WS_ADA) + ((size_t)(l + 1) * 3 + 2) * 3072; const float* gn = A.norm_g + (l + 1) * DM;
        bf16_t* Hr = (bf16_t*)((unsigned char*)A.out + OUT_H) + (size_t)(MLAT + cr) * DM;
        f32x4 xv[4];
#pragma unroll
        for (int j = 0; j < 4; ++j) { const unsigned long long* p = (const unsigned long long*)(src + 4 * lane + 256 * j);
            const unsigned long long lo = __hip_atomic_load(p, __ATOMIC_RELAXED, __HIP_MEMORY_SCOPE_AGENT), hi = __hip_atomic_load(p + 1, __ATOMIC_RELAXED, __HIP_MEMORY_SCOPE_AGENT);
            xv[j] = (f32x4){__uint_as_float((unsigned)lo), __uint_as_float((unsigned)(lo >> 32)), __uint_as_float((unsigned)hi), __uint_as_float((unsigned)(hi >> 32))}; }
        const float rinv = rsqrtf(wave_sum(norm_sumsq(xv), lane) * (1.0f / DM) + 1e-6f);
#pragma unroll
        for (int j = 0; j < 4; ++j) { const int col = 4 * lane + 256 * j;
            const f32x4 gv = *(const f32x4*)(gn + col), sc = *(const f32x4*)(adan + DM + col), sh = *(const f32x4*)(adan + col);
            const f32x4 h = xv[j] * rinv * gv * (sc + 1.0f) + sh;
            u32x2 o; o.x = pk2(h.x, h.y); o.y = pk2(h.z, h.w);
            *(u32x2*)(Hr + col) = o; }
    }
}
typedef short s16x4 __attribute__((ext_vector_type(4)));
__device__ __forceinline__ int v_tr_lane(int r31, int hh, int db) { const int q = (r31 >> 2) & 3, p = r31 & 3, blk = (r31 >> 4) & 1;
    return 128 * (4 * hh + q) + 16 * (2 * blk + (p >> 1)) + 8 * (p & 1) + 64 * (db ^ ((q >> 1) & 1)); }
__device__ __forceinline__ u32x2 v_tr(LAS const unsigned char* p) { const s16x4 v = __builtin_amdgcn_ds_read_tr16_b64_v4i16((LAS s16x4*)p); return __builtin_bit_cast(u32x2, v); }
__device__ __forceinline__ float max3f(float a, float b, float c) { float r; asm("v_max3_f32 %0, %1, %2, %3" : "=v"(r) : "v"(a), "v"(b), "v"(c)); return r; }
__device__ __forceinline__ float max2f(float a, float b) { float r; asm("v_max_f32_e32 %0, %1, %2" : "=v"(r) : "v"(a), "v"(b)); return r; }
__device__ __forceinline__ float max4f_mfma(float a, float b, float c, float d) { float r; asm("s_nop 15\n\ts_nop 7\n\tv_max3_f32 %0, %1, %2, %3\n\tv_max_f32_e32 %0, %0, %4" : "=&v"(r) : "v"(a), "v"(b), "v"(c), "v"(d)); return r; }
__device__ __forceinline__ void attn_tile(LAS const unsigned char* slot, int cs, const bf16x8 (&bq)[4], f32x16& o0, f32x16& o1, float& m_run, float& l_run,
                                          int r31, int hh, bool use_mask, int clo, int chi, bool use_bias, LAS const float* btab, int bidx) {
    const int kr = cs + r31;
    LAS const unsigned char* kp = slot + kr * 128;
    const int ksw = (kr >> 1) & 7;
    const bf16x8 ka0 = *(LAS const bf16x8*)(kp + 16 * ((0 + hh) ^ ksw)), ka1 = *(LAS const bf16x8*)(kp + 16 * ((2 + hh) ^ ksw));
    const bf16x8 ka2 = *(LAS const bf16x8*)(kp + 16 * ((4 + hh) ^ ksw)), ka3 = *(LAS const bf16x8*)(kp + 16 * ((6 + hh) ^ ksw));
    LAS const unsigned char* vp0 = slot + 8192 + cs * 128 + v_tr_lane(r31, hh, 0);
    LAS const unsigned char* vp1 = slot + 8192 + cs * 128 + v_tr_lane(r31, hh, 1);
    const u32x2 a0l = v_tr(vp0), a0h = v_tr(vp0 + 1024), a1l = v_tr(vp0 + 2048), a1h = v_tr(vp0 + 3072);
    const u32x2 b0l = v_tr(vp1), b0h = v_tr(vp1 + 1024), b1l = v_tr(vp1 + 2048), b1h = v_tr(vp1 + 3072);
    f32x16 s, t;
#pragma unroll
    for (int i = 0; i < 16; ++i) { s[i] = 0.f; t[i] = 0.f; }
    s = __builtin_amdgcn_mfma_f32_32x32x16_bf16(ka0, bq[0], s, 0, 0, 0); t = __builtin_amdgcn_mfma_f32_32x32x16_bf16(ka1, bq[1], t, 0, 0, 0);
    s = __builtin_amdgcn_mfma_f32_32x32x16_bf16(ka2, bq[2], s, 0, 0, 0); t = __builtin_amdgcn_mfma_f32_32x32x16_bf16(ka3, bq[3], t, 0, 0, 0);
    if (use_bias) {
        LAS const float* bp = btab + bidx;
#pragma unroll
        for (int i = 0; i < 16; ++i) { const int c = (i & 3) + 8 * (i >> 2) + 4 * hh; s[i] = (s[i] + t[i]) * QK_SCALE + bp[c]; }
    } else {
#pragma unroll
        for (int i = 0; i < 16; ++i) s[i] = (s[i] + t[i]) * QK_SCALE;
    }
    if (use_mask) {
        const unsigned off = (unsigned)(4 * hh - clo), rng = (unsigned)(chi - clo);
        const bool any = chi >= clo;
#pragma unroll
        for (int i = 0; i < 16; ++i) { const unsigned c0 = (unsigned)((i & 3) + 8 * (i >> 2)); s[i] = (any && (c0 + off <= rng)) ? s[i] : -INFINITY; }
    }
    float tmax = max3f(s[0], s[1], s[2]);
#pragma unroll
    for (int i = 3; i < 15; i += 2) tmax = max3f(tmax, s[i], s[i + 1]);
    tmax = max2f(tmax, s[15]);
    tmax = half_pair_max(tmax);
    if (__any(tmax - m_run > 8.0f)) {
        const float m_new = fmaxf(m_run, tmax);
        const float alpha = __builtin_amdgcn_exp2f(m_run - m_new);
        m_run = m_new; l_run *= alpha;
#pragma unroll
        for (int i = 0; i < 16; ++i) { o0[i] *= alpha; o1[i] *= alpha; }
    }
    float ps0 = 0.f, ps1 = 0.f;
#pragma unroll
    for (int i = 0; i < 16; i += 2) { const float p0 = __builtin_amdgcn_exp2f(s[i] - m_run), p1 = __builtin_amdgcn_exp2f(s[i + 1] - m_run); s[i] = p0; s[i + 1] = p1; ps0 += p0; ps1 += p1; }
    l_run += ps0 + ps1;
    u32x4 pw0, pw1;
    pw0.x = pk2(s[0], s[1]); pw0.y = pk2(s[2], s[3]); pw0.z = pk2(s[4], s[5]); pw0.w = pk2(s[6], s[7]);
    pw1.x = pk2(s[8], s[9]); pw1.y = pk2(s[10], s[11]); pw1.z = pk2(s[12], s[13]); pw1.w = pk2(s[14], s[15]);
    const bf16x8 pb0 = __builtin_bit_cast(bf16x8, pw0), pb1 = __builtin_bit_cast(bf16x8, pw1);
    u32x4 w;
    w.x = a0l.x; w.y = a0l.y; w.z = a0h.x; w.w = a0h.y; const bf16x8 va00 = __builtin_bit_cast(bf16x8, w);
    w.x = a1l.x; w.y = a1l.y; w.z = a1h.x; w.w = a1h.y; const bf16x8 va01 = __builtin_bit_cast(bf16x8, w);
    w.x = b0l.x; w.y = b0l.y; w.z = b0h.x; w.w = b0h.y; const bf16x8 va10 = __builtin_bit_cast(bf16x8, w);
    w.x = b1l.x; w.y = b1l.y; w.z = b1h.x; w.w = b1h.y; const bf16x8 va11 = __builtin_bit_cast(bf16x8, w);
    o0 = __builtin_amdgcn_mfma_f32_32x32x16_bf16(va00, pb0, o0, 0, 0, 0); o1 = __builtin_amdgcn_mfma_f32_32x32x16_bf16(va10, pb0, o1, 0, 0, 0);
    o0 = __builtin_amdgcn_mfma_f32_32x32x16_bf16(va01, pb1, o0, 0, 0, 0); o1 = __builtin_amdgcn_mfma_f32_32x32x16_bf16(va11, pb1, o1, 0, 0, 0);
}

__device__ __forceinline__ void attn_tile2(LAS const unsigned char* slot, const bf16x8 (&bq)[4], f32x16& o0, f32x16& o1, float& m_run, float& l_run,
                                           int r31, int hh, bool use_mask, int clo0, int chi0, int clo1, int chi1) {
    const int ksw = (r31 >> 1) & 7;
    LAS const unsigned char* kp = slot + r31 * 128;
    const bf16x8 ka0 = *(LAS const bf16x8*)(kp + 16 * ((0 + hh) ^ ksw)), ka1 = *(LAS const bf16x8*)(kp + 16 * ((2 + hh) ^ ksw));
    const bf16x8 ka2 = *(LAS const bf16x8*)(kp + 16 * ((4 + hh) ^ ksw)), ka3 = *(LAS const bf16x8*)(kp + 16 * ((6 + hh) ^ ksw));
    const bf16x8 kb0 = *(LAS const bf16x8*)(kp + 4096 + 16 * ((0 + hh) ^ ksw)), kb1 = *(LAS const bf16x8*)(kp + 4096 + 16 * ((2 + hh) ^ ksw));
    const bf16x8 kb2 = *(LAS const bf16x8*)(kp + 4096 + 16 * ((4 + hh) ^ ksw)), kb3 = *(LAS const bf16x8*)(kp + 4096 + 16 * ((6 + hh) ^ ksw));
    f32x16 s0, s1;
#pragma unroll
    for (int i = 0; i < 16; ++i) { s0[i] = 0.f; s1[i] = 0.f; }
    s0 = __builtin_amdgcn_mfma_f32_32x32x16_bf16(ka0, bq[0], s0, 0, 0, 0); s1 = __builtin_amdgcn_mfma_f32_32x32x16_bf16(kb0, bq[0], s1, 0, 0, 0);
    s0 = __builtin_amdgcn_mfma_f32_32x32x16_bf16(ka1, bq[1], s0, 0, 0, 0); s1 = __builtin_amdgcn_mfma_f32_32x32x16_bf16(kb1, bq[1], s1, 0, 0, 0);
    s0 = __builtin_amdgcn_mfma_f32_32x32x16_bf16(ka2, bq[2], s0, 0, 0, 0); s1 = __builtin_amdgcn_mfma_f32_32x32x16_bf16(kb2, bq[2], s1, 0, 0, 0);
    s0 = __builtin_amdgcn_mfma_f32_32x32x16_bf16(ka3, bq[3], s0, 0, 0, 0); s1 = __builtin_amdgcn_mfma_f32_32x32x16_bf16(kb3, bq[3], s1, 0, 0, 0);
    u32x2 va[2][4][2];
#pragma unroll
    for (int db = 0; db < 2; ++db) { LAS const unsigned char* vp = slot + 8192 + v_tr_lane(r31, hh, db);
#pragma unroll
        for (int st = 0; st < 4; ++st) { va[db][st][0] = v_tr(vp + 2048 * st); va[db][st][1] = v_tr(vp + 2048 * st + 1024); } }
    if (use_mask) {
        const unsigned off0 = (unsigned)(4 * hh - clo0), rng0 = (unsigned)(chi0 - clo0), off1 = (unsigned)(4 * hh - clo1), rng1 = (unsigned)(chi1 - clo1);
#pragma unroll
        for (int i = 0; i < 16; ++i) { const unsigned c0 = (unsigned)((i & 3) + 8 * (i >> 2)); s0[i] = (c0 + off0 <= rng0) ? s0[i] : -INFINITY; s1[i] = (c0 + off1 <= rng1) ? s1[i] : -INFINITY; }
    }
    float tmax = max4f_mfma(s0[0], s0[1], s1[0], s1[1]);
#pragma unroll
    for (int i = 2; i < 16; i += 2) { tmax = max3f(tmax, s0[i], s0[i + 1]); tmax = max3f(tmax, s1[i], s1[i + 1]); }
    tmax = half_pair_max(tmax) * QK_SCALE;
    if (__any(tmax - m_run > 8.0f)) {
        const float m_new = fmaxf(m_run, tmax);
        const float alpha = __builtin_amdgcn_exp2f(m_run - m_new);
        m_run = m_new; l_run *= alpha;
#pragma unroll
        for (int i = 0; i < 16; ++i) { o0[i] *= alpha; o1[i] *= alpha; }
    }
    float ps0 = 0.f, ps1 = 0.f;
    const float nm = -m_run;
#pragma unroll
    for (int i = 0; i < 16; ++i) { const float p0 = __builtin_amdgcn_exp2f(fmaf(s0[i], QK_SCALE, nm)), p1 = __builtin_amdgcn_exp2f(fmaf(s1[i], QK_SCALE, nm)); s0[i] = p0; s1[i] = p1; ps0 += p0; ps1 += p1; }
    l_run += ps0 + ps1;
    u32x4 pw;
    pw.x = pk2(s0[0], s0[1]); pw.y = pk2(s0[2], s0[3]); pw.z = pk2(s0[4], s0[5]); pw.w = pk2(s0[6], s0[7]); const bf16x8 p00 = __builtin_bit_cast(bf16x8, pw);
    pw.x = pk2(s0[8], s0[9]); pw.y = pk2(s0[10], s0[11]); pw.z = pk2(s0[12], s0[13]); pw.w = pk2(s0[14], s0[15]); const bf16x8 p01 = __builtin_bit_cast(bf16x8, pw);
    pw.x = pk2(s1[0], s1[1]); pw.y = pk2(s1[2], s1[3]); pw.z = pk2(s1[4], s1[5]); pw.w = pk2(s1[6], s1[7]); const bf16x8 p10 = __builtin_bit_cast(bf16x8, pw);
    pw.x = pk2(s1[8], s1[9]); pw.y = pk2(s1[10], s1[11]); pw.z = pk2(s1[12], s1[13]); pw.w = pk2(s1[14], s1[15]); const bf16x8 p11 = __builtin_bit_cast(bf16x8, pw);
#define VA8(db_, st_) __builtin_bit_cast(bf16x8, (u32x4){va[db_][st_][0].x, va[db_][st_][0].y, va[db_][st_][1].x, va[db_][st_][1].y})
    o0 = __builtin_amdgcn_mfma_f32_32x32x16_bf16(VA8(0, 0), p00, o0, 0, 0, 0); o1 = __builtin_amdgcn_mfma_f32_32x32x16_bf16(VA8(1, 0), p00, o1, 0, 0, 0);
    o0 = __builtin_amdgcn_mfma_f32_32x32x16_bf16(VA8(0, 1), p01, o0, 0, 0, 0); o1 = __builtin_amdgcn_mfma_f32_32x32x16_bf16(VA8(1, 1), p01, o1, 0, 0, 0);
    o0 = __builtin_amdgcn_mfma_f32_32x32x16_bf16(VA8(0, 2), p10, o0, 0, 0, 0); o1 = __builtin_amdgcn_mfma_f32_32x32x16_bf16(VA8(1, 2), p10, o1, 0, 0, 0);
    o0 = __builtin_amdgcn_mfma_f32_32x32x16_bf16(VA8(0, 3), p11, o0, 0, 0, 0); o1 = __builtin_amdgcn_mfma_f32_32x32x16_bf16(VA8(1, 3), p11, o1, 0, 0, 0);
#undef VA8
}

__device__ __forceinline__ void attn_tile4(LAS const unsigned char* slotA, LAS const unsigned char* slotB, const bf16x8 (&bq)[4], f32x16& o0, f32x16& o1, float& m_run, float& l_run, int r31, int hh) {
    const int ksw = (r31 >> 1) & 7, vl0 = v_tr_lane(r31, hh, 0), vl1 = v_tr_lane(r31, hh, 1);
    f32x16 s[4];
#pragma unroll
    for (int t = 0; t < 4; ++t)
#pragma unroll
        for (int i = 0; i < 16; ++i) s[t][i] = 0.f;
#pragma unroll
    for (int ks = 0; ks < 4; ++ks) {
        LAS const unsigned char* ka = slotA + r31 * 128 + 16 * ((2 * ks + hh) ^ ksw);
        LAS const unsigned char* kb = slotB + r31 * 128 + 16 * ((2 * ks + hh) ^ ksw);
        const bf16x8 k0 = *(LAS const bf16x8*)ka, k1 = *(LAS const bf16x8*)(ka + 4096), k2 = *(LAS const bf16x8*)kb, k3 = *(LAS const bf16x8*)(kb + 4096);
        s[0] = __builtin_amdgcn_mfma_f32_32x32x16_bf16(k0, bq[ks], s[0], 0, 0, 0); s[1] = __builtin_amdgcn_mfma_f32_32x32x16_bf16(k1, bq[ks], s[1], 0, 0, 0);
        s[2] = __builtin_amdgcn_mfma_f32_32x32x16_bf16(k2, bq[ks], s[2], 0, 0, 0); s[3] = __builtin_amdgcn_mfma_f32_32x32x16_bf16(k3, bq[ks], s[3], 0, 0, 0);
    }
    float tmax = max4f_mfma(s[0][0], s[1][0], s[2][0], s[3][0]);
#pragma unroll
    for (int i = 1; i < 16; ++i) { tmax = max3f(tmax, s[0][i], s[1][i]); tmax = max3f(tmax, s[2][i], s[3][i]); }
    tmax = half_pair_max(tmax) * QK_SCALE;
    if (__any(tmax - m_run > 8.0f)) {
        const float m_new = fmaxf(m_run, tmax);
        const float alpha = __builtin_amdgcn_exp2f(m_run - m_new);
        m_run = m_new; l_run *= alpha;
#pragma unroll
        for (int i = 0; i < 16; ++i) { o0[i] *= alpha; o1[i] *= alpha; }
    }
    const float nm = -m_run;
    float ps0 = 0.f, ps1 = 0.f;
#pragma unroll
    for (int t = 0; t < 4; ++t)
#pragma unroll
        for (int i = 0; i < 16; i += 2) { const float p0 = __builtin_amdgcn_exp2f(fmaf(s[t][i], QK_SCALE, nm)), p1 = __builtin_amdgcn_exp2f(fmaf(s[t][i + 1], QK_SCALE, nm)); s[t][i] = p0; s[t][i + 1] = p1; ps0 += p0; ps1 += p1; }
    l_run += ps0 + ps1;
#pragma unroll
    for (int t = 0; t < 4; ++t) {
        LAS const unsigned char* vp0 = (t < 2 ? slotA : slotB) + 8192 + 4096 * (t & 1) + vl0; LAS const unsigned char* vp1 = (t < 2 ? slotA : slotB) + 8192 + 4096 * (t & 1) + vl1;
        u32x4 pw;
        pw.x = pk2(s[t][0], s[t][1]); pw.y = pk2(s[t][2], s[t][3]); pw.z = pk2(s[t][4], s[t][5]); pw.w = pk2(s[t][6], s[t][7]); const bf16x8 pa = __builtin_bit_cast(bf16x8, pw);
        pw.x = pk2(s[t][8], s[t][9]); pw.y = pk2(s[t][10], s[t][11]); pw.z = pk2(s[t][12], s[t][13]); pw.w = pk2(s[t][14], s[t][15]); const bf16x8 pb = __builtin_bit_cast(bf16x8, pw);
        const u32x2 a0l = v_tr(vp0), a0h = v_tr(vp0 + 1024), a1l = v_tr(vp0 + 2048), a1h = v_tr(vp0 + 3072);
        const u32x2 b0l = v_tr(vp1), b0h = v_tr(vp1 + 1024), b1l = v_tr(vp1 + 2048), b1h = v_tr(vp1 + 3072);
        o0 = __builtin_amdgcn_mfma_f32_32x32x16_bf16(__builtin_bit_cast(bf16x8, (u32x4){a0l.x, a0l.y, a0h.x, a0h.y}), pa, o0, 0, 0, 0);
        o1 = __builtin_amdgcn_mfma_f32_32x32x16_bf16(__builtin_bit_cast(bf16x8, (u32x4){b0l.x, b0l.y, b0h.x, b0h.y}), pa, o1, 0, 0, 0);
        o0 = __builtin_amdgcn_mfma_f32_32x32x16_bf16(__builtin_bit_cast(bf16x8, (u32x4){a1l.x, a1l.y, a1h.x, a1h.y}), pb, o0, 0, 0, 0);
        o1 = __builtin_amdgcn_mfma_f32_32x32x16_bf16(__builtin_bit_cast(bf16x8, (u32x4){b1l.x, b1l.y, b1h.x, b1h.y}), pb, o1, 0, 0, 0);
    }
}

__device__ __forceinline__ void attn_block_item(CKArgs& A, int l, int MODE, int item, LAS unsigned char* lds, int tid) {
    asm volatile("" : "+v"(tid));
    unsigned char* ws = A.ws;
    const bf16_t* PT = (const bf16_t*)(ws + WS_PT);
    bf16_t* Y = (bf16_t*)(ws + WS_HY);
    const int wave = __builtin_amdgcn_readfirstlane(tid >> 6), lane = tid & 63;
    const int r31 = lane & 31, hh = lane >> 5;
    int b, h, qtok, qi = 0;
    int rp = 0, mg = 0, qg = 0;
    if (MODE == 0) { b = item / 192; const int rem = item % 192; h = rem >> 5; qi = rem & 31; rp = 2 * qi + (wave >> 2); mg = wave & 3;
        qtok = b * SEQ + (2 * rp + (r31 >> 4)) * 64 + 16 * mg + (r31 & 15); }
    else if (MODE == 1) { b = item / 192; const int rem = item % 192; h = rem >> 5; qi = rem & 31; qg = 8 * qi + wave; qtok = b * SEQ + 32 * qg + r31; }
    else { b = item / 6; h = item % 6; qg = wave; qtok = MLAT + b * CTXL + 32 * qg + r31; }
    const bool grpA = (MODE == 0 || MODE == 2);
    const int kvh = grpA ? h : h / 3;
    const int qcol = (grpA ? C_QA : C_QC) + h * 64, gcol = (grpA ? C_GA : C_GC) + h * 64, ycol = (grpA ? 0 : 640) + h * 64;
    const int kh = grpA ? h : 6 + kvh;
    bf16x8 bq[4];
    { const bf16_t* qp = PT + (size_t)qtok * NTM + qcol + 8 * hh;
#pragma unroll
      for (int s = 0; s < 4; ++s) bq[s] = *(const bf16x8*)(qp + 16 * s); }
    f32x16 o0, o1;
#pragma unroll
    for (int i = 0; i < 16; ++i) { o0[i] = 0.f; o1[i] = 0.f; }
    float m_run = -1e30f, l_run = 0.f;
    if (!grpA) { m_run = A.sink[l * 6 + h] * LOG2E; l_run = hh == 0 ? 1.0f : 0.f; }
    int wrow0 = 0, nwin = 0;
    if (MODE == 0) { const int a0 = min(max(4 * qi - 4, 0), 120), a1 = min(max(4 * qi - 1, 0), 120) + 7; wrow0 = a0; nwin = a1 - a0 + 1; }
    if (MODE == 1) { const int k0 = max(4 * qi - 2, 0), k1 = min(4 * qi + 5, 127); wrow0 = k0; nwin = k1 - k0 + 1; }
    const int nsteps = 4 + nwin;
    int ra = 0, rb = -1, cs = 0, rq = 0, jq = 0, r0 = 0, cmin = 0;
    LAS const float* btab = (LAS const float*)(lds + AUX_OFF + 2048);
    if (MODE == 0) { ra = min(max(2 * rp - 4, 0), 120); rb = min(max(2 * rp - 3, 0), 120) + 7; cs = min(max(16 * mg - 8, 0), 32);
        rq = 2 * rp + (r31 >> 4); jq = 16 * mg + (r31 & 15); r0 = min(max(rq - 4, 0), 120); cmin = min(max(jq - 8, 0), 48) - cs;
        }
    const int lr = tid >> 3, lc = tid & 7;
    const bf16_t* kg = (const bf16_t*)(ws + WS_KH) + (size_t)kh * MTOT * 64 + 8 * tid;
    const bf16_t* vg = (const bf16_t*)(ws + WS_VT) + (size_t)kh * MTOT * 64 + 8 * tid;
    const int kdst = lr * 128 + 16 * (lc ^ ((lr >> 1) & 7));
    const int vdst = 8192 + lr * 128 + 16 * (lc ^ (((lr >> 1) & 1) << 2));
#define ROW_TOK(i) ((i) < 4 ? MLAT + b * CTXL + 64 * (i) : b * SEQ + 64 * (wrow0 + (i) - 4))
#define LOAD_ROW(i, kr_, vr_) do { const int t0_ = ROW_TOK(i); kr_ = *(const u32x4*)(kg + (size_t)t0_ * 64); vr_ = *(const u32x4*)(vg + (size_t)t0_ * 64); } while (0)
#define WRITE_ROW(sl_, kr_, vr_) do { *(LAS u32x4*)((sl_) + kdst) = kr_; *(LAS u32x4*)((sl_) + vdst) = vr_; } while (0)
    u32x4 k0, v0, k2, v2;
    LOAD_ROW(0, k0, v0); LOAD_ROW(1, k2, v2);
    const float rpbv = (MODE == 0 && tid < 465) ? A.na_rpb[(size_t)(l * 6 + h) * 465 + tid] * LOG2E : 0.f;
    __syncthreads();
    if (MODE == 0 && tid < 465) ((LAS float*)(lds + AUX_OFF + 2048))[tid] = rpbv;
    WRITE_ROW(lds, k0, v0); WRITE_ROW(lds + 16384, k2, v2);
    __syncthreads();
#pragma unroll 1
    for (int pr = 0; pr < 2; ++pr) {
        { const int ra_ = pr == 0 ? 2 : min(4, nsteps - 1), rb_ = pr == 0 ? 3 : min(5, nsteps - 1); LOAD_ROW(ra_, k0, v0); LOAD_ROW(rb_, k2, v2); }
        attn_tile4(lds, lds + 16384, bq, o0, o1, m_run, l_run, r31, hh);
        __syncthreads();
        if (pr == 0) { WRITE_ROW(lds, k0, v0); WRITE_ROW(lds + 16384, k2, v2); } else if (nsteps > 4) { WRITE_ROW(lds, k0, v0); }
        __syncthreads();
    }
    u32x2 gatev[8];
    { const bf16_t* gp_ = PT + (size_t)qtok * NTM + gcol + 4 * hh;
#pragma unroll
      for (int j = 0; j < 8; ++j) gatev[j] = *(const u32x2*)(gp_ + 32 * (j >> 2) + 8 * (j & 3)); }
#define ATT_STEP(i_, kL, vL, kW, vW) do { const int i = (i_); if (i < nsteps) { \
        LAS const unsigned char* slot = lds + (i & 1) * 16384; \
        { const int ir_ = min(i + 2, nsteps - 1); LOAD_ROW(ir_, kL, vL); }     \
        bool use2 = false, use1 = false, um = false, um1 = false, ub = false; int c1 = 0, lo0 = 0, hi0 = 31, lo1 = 0, hi1 = 31, bidx = 0; \
        if (i < 4) use2 = true; \
        else if (MODE == 0) { const int a = wrow0 + i - 4; use1 = (a >= ra) && (a <= rb); const bool rowok = (a >= r0) && (a < r0 + 8); \
            c1 = cs; lo0 = rowok ? cmin : 1; hi0 = rowok ? cmin + 15 : 0; ub = true; um1 = true; bidx = (a - rq + 7) * 31 + (cs - jq + 15); } \
        else if (MODE == 1) { const int rel0 = (64 * (wrow0 + i - 4) - (32 * qg - 128)) >> 5, rel1 = rel0 + 1;     \
            const bool a0 = (rel0 >= 0) && (rel0 <= 8), a1 = (rel1 >= 0) && (rel1 <= 8); \
            if (a0 && a1) { use2 = true; um = (rel0 == 0) || (rel1 == 8); lo0 = rel0 == 0 ? r31 : 0; hi1 = rel1 == 8 ? r31 : 31; } \
            else if (a0) { use1 = true; um1 = (rel0 == 0) || (rel0 == 8); lo0 = rel0 == 0 ? r31 : 0; hi0 = rel0 == 8 ? r31 : 31; } \
            else if (a1) { use1 = true; c1 = 32; um1 = (rel1 == 0) || (rel1 == 8); lo0 = rel1 == 0 ? r31 : 0; hi0 = rel1 == 8 ? r31 : 31; } } \
        if (use2) attn_tile2(slot, bq, o0, o1, m_run, l_run, r31, hh, um, lo0, hi0, lo1, hi1); \
        if (use1) attn_tile(slot, c1, bq, o0, o1, m_run, l_run, r31, hh, um1, lo0, hi0, ub, btab, bidx); \
        if (i + 1 < nsteps) { LAS unsigned char* nslot = lds + ((i + 1) & 1) * 16384; WRITE_ROW(nslot, kW, vW); } \
        __syncthreads(); } } while (0)
#pragma unroll 1
    for (int i3 = 4; i3 < nsteps; i3 += 2) {
        ATT_STEP(i3, k0, v0, k2, v2);
        ATT_STEP(i3 + 1, k2, v2, k0, v0);
    }
#undef ATT_STEP
#undef LOAD_ROW
#undef WRITE_ROW
    const float ltot = half_pair_sum(l_run);
    const float inv = 1.0f / ltot;
    bf16_t* yp = Y + (size_t)qtok * DM + ycol + 4 * hh;
#pragma unroll
    for (int db = 0; db < 2; ++db)
#pragma unroll
        for (int g4 = 0; g4 < 4; ++g4) {
            const int d0 = 32 * db + 8 * g4;
            const u32x2 gw = gatev[4 * db + g4];
            float v0, v1, v2, v3;
            if (db == 0) { v0 = o0[4 * g4]; v1 = o0[4 * g4 + 1]; v2 = o0[4 * g4 + 2]; v3 = o0[4 * g4 + 3]; }
            else { v0 = o1[4 * g4]; v1 = o1[4 * g4 + 1]; v2 = o1[4 * g4 + 2]; v3 = o1[4 * g4 + 3]; }
            v0 *= inv * silu_f(bflo(gw.x)); v1 *= inv * silu_f(bfhi(gw.x)); v2 *= inv * silu_f(bflo(gw.y)); v3 *= inv * silu_f(bfhi(gw.y));
            u32x2 o; o.x = pk2(v0, v1); o.y = pk2(v2, v3);
            *(u32x2*)(yp + d0) = o;
        }
}

__device__ __forceinline__ cf2 cmul(cf2 a, cf2 b) { const cf2 bs = mk2(-b.y, b.x); return a.xx * b + a.yy * bs; }
#define PA(e) ((e) + (((e) >> 4) << 1))
struct cf2x4 { cf2 a, b, c, d; };
__device__ __forceinline__ cf2x4 bfly4_fwd_w(cf2 x0, cf2 x1, cf2 x2, cf2 x3, cf2 w1);
__device__ __forceinline__ cf2x4 bfly4_fwd(cf2 x0, cf2 x1, cf2 x2, cf2 x3, float a) { return bfly4_fwd_w(x0, x1, x2, x3, mk2(__builtin_amdgcn_cosf(a), -__builtin_amdgcn_sinf(a))); }
__device__ __forceinline__ cf2x4 bfly4_fwd_w3(cf2 x0, cf2 x1, cf2 x2, cf2 x3, cf2 w1, cf2 w2, cf2 w3);
__device__ __forceinline__ cf2x4 bfly4_fwd_w(cf2 x0, cf2 x1, cf2 x2, cf2 x3, cf2 w1) { const cf2 w2 = cmul(w1, w1); return bfly4_fwd_w3(x0, x1, x2, x3, w1, w2, cmul(w2, w1)); }
__device__ __forceinline__ cf2x4 bfly4_fwd_w3(cf2 x0, cf2 x1, cf2 x2, cf2 x3, cf2 w1, cf2 w2, cf2 w3) {
    const cf2 s02 = x0 + x2, d02 = x0 - x2, s13 = x1 + x3, d13 = x1 - x3;
    cf2x4 r;
    r.a = s02 + s13;
    r.b = cmul(s02 - s13, w2);
    r.c = cmul(mk2(d02.x + d13.y, d02.y - d13.x), w1);
    r.d = cmul(mk2(d02.x - d13.y, d02.y + d13.x), w3);
    return r;
}
__device__ __forceinline__ cf2x4 bfly4_inv_w(cf2 v0, cf2 v1, cf2 v2, cf2 v3, cf2 w1);
__device__ __forceinline__ cf2x4 bfly4_inv(cf2 v0, cf2 v1, cf2 v2, cf2 v3, float a) { return bfly4_inv_w(v0, v1, v2, v3, mk2(__builtin_amdgcn_cosf(a), __builtin_amdgcn_sinf(a))); }
__device__ __forceinline__ cf2x4 bfly4_inv_w2(cf2 v0, cf2 v1, cf2 v2, cf2 v3, cf2 w1, cf2 w2);
__device__ __forceinline__ cf2x4 bfly4_inv_w(cf2 v0, cf2 v1, cf2 v2, cf2 v3, cf2 w1) { return bfly4_inv_w2(v0, v1, v2, v3, w1, cmul(w1, w1)); }
__device__ __forceinline__ cf2x4 bfly4_inv_w2(cf2 v0, cf2 v1, cf2 v2, cf2 v3, cf2 w1, cf2 w2) {
    const cf2 bb = cmul(v1, w2), dd = cmul(v3, w2);
    const cf2 u0 = v0 + bb, u1 = v0 - bb, u2 = v2 + dd, u3 = v2 - dd;
    const cf2 e = cmul(u2, w1), f0 = cmul(u3, w1);
    const cf2 f = mk2(-f0.y, f0.x);
    cf2x4 r; r.a = u0 + e; r.c = u0 - e; r.b = u1 + f; r.d = u1 - f; return r;
}
__device__ __forceinline__ void fft_fwd_fused(LAS cf2* buf, int tid, int lsb, bool zero_hi = false) {
    const int sB = 1 << lsb, s = 4 << lsb;
    const float ra = 1.0f / (float)(16 << lsb), rb = 1.0f / (float)(4 << lsb);
    int poff[4][4];
#pragma unroll
    for (int a = 0; a < 4; ++a)
#pragma unroll
        for (int b = 0; b < 4; ++b) { const int off = a * s + b * sB; poff[a][b] = PA(off); }
    cf2 wf1[4], wf2[4], wf3[4], ws1, ws2, ws3;
#define FFT_TWF(i_) do { const cf2 t0_ = mk2(__builtin_amdgcn_cosf((float)(i_) * ra), -__builtin_amdgcn_sinf((float)(i_) * ra)); \
        wf1[0] = t0_; wf1[1] = cmul(t0_, mk2(0.92387953251f, -0.38268343237f)); wf1[2] = cmul(t0_, mk2(0.70710678119f, -0.70710678119f)); wf1[3] = cmul(t0_, mk2(0.38268343237f, -0.92387953251f)); \
        _Pragma("unroll") for (int b = 0; b < 4; ++b) { wf2[b] = cmul(wf1[b], wf1[b]); wf3[b] = cmul(wf2[b], wf1[b]); } \
        ws1 = mk2(__builtin_amdgcn_cosf((float)(i_) * rb), -__builtin_amdgcn_sinf((float)(i_) * rb)); ws2 = cmul(ws1, ws1); ws3 = cmul(ws2, ws1); } while (0)
    FFT_TWF(tid & (sB - 1));
#pragma unroll
    for (int gg = 0; gg < 2; ++gg) {
        const int g = tid + 512 * gg, i = g & (sB - 1), base = ((g >> lsb) << (lsb + 4)) + i;
        const int pbase = PA(base);
        if (gg == 1 && lsb > 8) FFT_TWF(i);
        cf2 x[4][4];
#pragma unroll
        for (int a = 0; a < 4; ++a)
#pragma unroll
            for (int b = 0; b < 4; ++b) x[a][b] = (zero_hi && a >= 2) ? mk2(0.f, 0.f) : buf[pbase + poff[a][b]];
#pragma unroll
        for (int b = 0; b < 4; ++b) { const cf2x4 r = bfly4_fwd_w3(x[0][b], x[1][b], x[2][b], x[3][b], wf1[b], wf2[b], wf3[b]); x[0][b] = r.a; x[1][b] = r.b; x[2][b] = r.c; x[3][b] = r.d; }
#pragma unroll
        for (int a = 0; a < 4; ++a) { const cf2x4 r = bfly4_fwd_w3(x[a][0], x[a][1], x[a][2], x[a][3], ws1, ws2, ws3); x[a][0] = r.a; x[a][1] = r.b; x[a][2] = r.c; x[a][3] = r.d; }
#pragma unroll
        for (int a = 0; a < 4; ++a)
#pragma unroll
            for (int b = 0; b < 4; ++b) buf[pbase + poff[a][b]] = x[a][b];
    }
    if (lsb == 10) __syncthreads();
#undef FFT_TWF
}
__device__ __forceinline__ void fft_inv_fused(LAS cf2* buf, int tid, int lsb) {
    const int sB = 1 << lsb, s = 4 << lsb;
    const float ra = 1.0f / (float)(16 << lsb), rb = 1.0f / (float)(4 << lsb);
    int poff[4][4];
#pragma unroll
    for (int a = 0; a < 4; ++a)
#pragma unroll
        for (int b = 0; b < 4; ++b) { const int off = a * s + b * sB; poff[a][b] = PA(off); }
    cf2 wi1[4], wi2[4], ws1, ws2;
#define FFT_TWI(i_) do { const cf2 t0_ = mk2(__builtin_amdgcn_cosf((float)(i_) * ra), __builtin_amdgcn_sinf((float)(i_) * ra)); \
        wi1[0] = t0_; wi1[1] = cmul(t0_, mk2(0.92387953251f, 0.38268343237f)); wi1[2] = cmul(t0_, mk2(0.70710678119f, 0.70710678119f)); wi1[3] = cmul(t0_, mk2(0.38268343237f, 0.92387953251f)); \
        _Pragma("unroll") for (int b = 0; b < 4; ++b) wi2[b] = cmul(wi1[b], wi1[b]); \
        ws1 = mk2(__builtin_amdgcn_cosf((float)(i_) * rb), __builtin_amdgcn_sinf((float)(i_) * rb)); ws2 = cmul(ws1, ws1); } while (0)
    FFT_TWI(tid & (sB - 1));
#pragma unroll
    for (int gg = 0; gg < 2; ++gg) {
        const int g = tid + 512 * gg, i = g & (sB - 1), base = ((g >> lsb) << (lsb + 4)) + i;
        const int pbase = PA(base);
        if (gg == 1 && lsb > 8) FFT_TWI(i);
        cf2 x[4][4];
#pragma unroll
        for (int a = 0; a < 4; ++a)
#pragma unroll
            for (int b = 0; b < 4; ++b) x[a][b] = buf[pbase + poff[a][b]];
#pragma unroll
        for (int a = 0; a < 4; ++a) { const cf2x4 r = bfly4_inv_w2(x[a][0], x[a][1], x[a][2], x[a][3], ws1, ws2); x[a][0] = r.a; x[a][1] = r.b; x[a][2] = r.c; x[a][3] = r.d; }
#pragma unroll
        for (int b = 0; b < 4; ++b) { const cf2x4 r = bfly4_inv_w2(x[0][b], x[1][b], x[2][b], x[3][b], wi1[b], wi2[b]); x[0][b] = r.a; x[1][b] = r.b; x[2][b] = r.c; x[3][b] = r.d; }
#pragma unroll
        for (int a = 0; a < 4; ++a)
#pragma unroll
            for (int b = 0; b < 4; ++b) buf[pbase + poff[a][b]] = x[a][b];
    }
    if (lsb >= 4) __syncthreads();
#undef FFT_TWI
}
__device__ __forceinline__ cf2x4 bfly4_inv_1(cf2 v0, cf2 v1, cf2 v2, cf2 v3) {
    const cf2 u0 = v0 + v1, u1 = v0 - v1, u2 = v2 + v3, u3 = v2 - v3;
    const cf2 f = mk2(-u3.y, u3.x);
    cf2x4 r; r.a = u0 + u2; r.c = u0 - u2; r.b = u1 + f; r.d = u1 - f; return r;
}
__device__ __forceinline__ void fft_inv_first(LAS cf2* buf, int tid) {
#pragma unroll
    for (int gg = 0; gg < 2; ++gg) {
        const int g = tid + 512 * gg;
        const int pbase = 18 * g;
        cf2 x[4][4];
#pragma unroll
        for (int a = 0; a < 4; ++a)
#pragma unroll
            for (int b = 0; b < 4; ++b) x[a][b] = buf[pbase + 4 * a + b];
#pragma unroll
        for (int a = 0; a < 4; ++a) { const cf2x4 r = bfly4_inv_1(x[a][0], x[a][1], x[a][2], x[a][3]); x[a][0] = r.a; x[a][1] = r.b; x[a][2] = r.c; x[a][3] = r.d; }
        { const cf2x4 r = bfly4_inv_1(x[0][0], x[1][0], x[2][0], x[3][0]); x[0][0] = r.a; x[1][0] = r.b; x[2][0] = r.c; x[3][0] = r.d; }
        { const cf2x4 r = bfly4_inv_w2(x[0][1], x[1][1], x[2][1], x[3][1], mk2(0.92387953251f, 0.38268343237f), mk2(0.70710678119f, 0.70710678119f)); x[0][1] = r.a; x[1][1] = r.b; x[2][1] = r.c; x[3][1] = r.d; }
        { const cf2x4 r = bfly4_inv_w2(x[0][2], x[1][2], x[2][2], x[3][2], mk2(0.70710678119f, 0.70710678119f), mk2(0.0f, 1.0f)); x[0][2] = r.a; x[1][2] = r.b; x[2][2] = r.c; x[3][2] = r.d; }
        { const cf2x4 r = bfly4_inv_w2(x[0][3], x[1][3], x[2][3], x[3][3], mk2(0.38268343237f, 0.92387953251f), mk2(-0.70710678119f, 0.70710678119f)); x[0][3] = r.a; x[1][3] = r.b; x[2][3] = r.c; x[3][3] = r.d; }
#pragma unroll
        for (int a = 0; a < 4; ++a)
#pragma unroll
            for (int b = 0; b < 4; ++b) buf[pbase + 4 * a + b] = x[a][b];
    }
}
__device__ __forceinline__ void fft_fwd(LAS cf2* buf, int tid, const unsigned* zk = nullptr, bool zero_hi = false, bool end_sync = true) {
#pragma unroll 1
    for (int lsb = 10; lsb >= 2; lsb -= 4) fft_fwd_fused(buf, tid, lsb, zero_hi && lsb == 10);
    const int cbase = 256 * (tid >> 6) + (tid & 63);
    u32x4 zw[8];
    if (zk) {
#pragma unroll
        for (int k = 0; k < 8; ++k) zw[k] = *(const u32x4*)(zk + (unsigned)(4 * (cbase + 64 * (k & 3) + 2048 * (k >> 2))));
    }
#pragma unroll
    for (int k = 0; k < 8; ++k) {
        const int e0 = 4 * (cbase + 64 * (k & 3) + 2048 * (k >> 2)), base = PA(e0);
        cf2 x0 = buf[base], x1 = buf[base + 1], x2 = buf[base + 2], x3 = buf[base + 3];
        const cf2 s02 = x0 + x2, d02 = x0 - x2, s13 = x1 + x3, d13 = x1 - x3;
        cf2 y0 = s02 + s13, y1 = s02 - s13, y2 = mk2(d02.x + d13.y, d02.y - d13.x), y3 = mk2(d02.x - d13.y, d02.y + d13.x);
        if (zk) { const u32x4 w = zw[k];
            y0 = cmul(y0, mk2(bflo(w.x), bfhi(w.x))); y1 = cmul(y1, mk2(bflo(w.y), bfhi(w.y))); y2 = cmul(y2, mk2(bflo(w.z), bfhi(w.z))); y3 = cmul(y3, mk2(bflo(w.w), bfhi(w.w))); }
        buf[base] = y0; buf[base + 1] = y1; buf[base + 2] = y2; buf[base + 3] = y3;
    }
    if (end_sync) __syncthreads();
}
__device__ __forceinline__ void fft_inv(LAS cf2* buf, int tid) {
    fft_inv_first(buf, tid);
#pragma unroll 1
    for (int lsb = 4; lsb <= 8; lsb += 4) fft_inv_fused(buf, tid, lsb);
    cf2 wk = mk2(__builtin_amdgcn_cosf((float)tid * (1.0f / 16384.0f)), __builtin_amdgcn_sinf((float)tid * (1.0f / 16384.0f)));
#pragma unroll 4
    for (int k = 0; k < 8; ++k) {
        const int pi = PA(tid) + 576 * k;
        cf2 v0 = buf[pi], v1 = buf[pi + 4608], v2 = buf[pi + 9216], v3 = buf[pi + 13824];
        const cf2x4 r = bfly4_inv_w(v0, v1, v2, v3, wk);
        buf[pi] = r.a; buf[pi + 4608] = r.b;
        wk = cmul(wk, mk2(0.98078528040f, 0.19509032202f));
    }
    __syncthreads();
}
__device__ __forceinline__ float hy_short(const bf16_t* prow, int tb, int t, int L, float w0, float w1, float w2, float bias) {
    const float pm = t > 0 ? bf2f(prow[tb + t - 1]) : 0.f;
    const float pc = bf2f(prow[tb + t]);
    const float pp = t < L - 1 ? bf2f(prow[tb + t + 1]) : 0.f;
    return w0 * pm + w1 * pc + w2 * pp + bias;
}
__device__ __forceinline__ float block_sum(float v, LAS float* red, int tid) {
    v = wave_sum(v, tid & 63);
    __syncthreads();
    if ((tid & 63) == 0) red[tid >> 6] = v;
    __syncthreads();
    float s = 0.f;
#pragma unroll
    for (int w = 0; w < 8; ++w) s += red[w];
    return s;
}

__device__ __forceinline__ float2 block_sum2(float a, float b, LAS float* red, int tid) {
    a = wave_sum(a, tid & 63); b = wave_sum(b, tid & 63);
    __syncthreads();
    if ((tid & 63) == 0) { red[tid >> 6] = a; red[8 + (tid >> 6)] = b; }
    __syncthreads();
    float s = 0.f, t = 0.f;
#pragma unroll
    for (int w = 0; w < 8; ++w) { s += red[w]; t += red[8 + w]; }
    return make_float2(s, t);
}

__device__ __forceinline__ void hyena_block(CKArgs& A, int l, int c, LAS unsigned char* lds, int tid) {
    asm volatile("" : "+v"(tid));
    unsigned char* ws = A.ws;
    LAS cf2* buf = (LAS cf2*)lds;
    LAS float* fs = (LAS float*)lds;
    LAS float* aux = (LAS float*)(lds + AUX_OFF);
    LAS float* red = aux + 256;
    const bf16_t* PCT = (const bf16_t*)(ws + WS_PCT);
    bf16_t* YBT = (bf16_t*)(A.ws + WS_YBT);
    const bf16_t* rowz = PCT + (size_t)(R_HZ + c) * MTOT;
    const bf16_t* rowx1 = rowz + (size_t)256 * MTOT;
    const bf16_t* rowx2 = rowz + (size_t)512 * MTOT;
    const bf16_t* rowg = PCT + (size_t)(R_GB + c) * MTOT;
    const float* cw = A.hy_conv_w + (size_t)l * 3 * 768; const float* cb = A.hy_conv_b + (size_t)l * 768;
    const float wz0 = cw[c], wz1 = cw[768 + c], wz2 = cw[1536 + c], bz = cb[c];
    const float wa0 = cw[256 + c], wa1 = cw[768 + 256 + c], wa2 = cw[1536 + 256 + c], ba = cb[256 + c];
    const float wb0 = cw[512 + c], wb1 = cw[768 + 512 + c], wb2 = cw[1536 + 512 + c], bb = cb[512 + c];
    const float d0 = A.hy_d[(l * 2 + 0) * 256 + c], d1 = A.hy_d[(l * 2 + 1) * 256 + c];
    const float dmin = -3.0701134573253945f, dmax = -15.350567286626973f;
    const float delta = fabsf(dmin + (float)c * ((dmax - dmin) / 255.0f));
    float auxv = 0.f;
    if (l < DEPTH - 1 && tid < 256) { const int k = tid >> 6, j = tid & 63; auxv = A.hy_w3[((size_t)l * 64 + j) * 1024 + k * 256 + c]; }
    __syncthreads();
    if (l < DEPTH - 1) {
        if (tid < 256) aux[tid] = auxv;
        __syncthreads();
    }

    if (l < DEPTH - 1) {
        float ss0 = 0.f, ss1 = 0.f;
        const int b = tid >> 8, t = tid & 255, tok = MLAT + b * CTXL;
        const float z = hy_short(rowz, tok, t, CTXL, wz0, wz1, wz2, bz);
        const float x1 = hy_short(rowx1, tok, t, CTXL, wa0, wa1, wa2, ba);
        const float x2 = hy_short(rowx2, tok, t, CTXL, wb0, wb1, wb2, bb);
        const float gb = bf2f(rowg[tok + t]);
        {
            const int n = tid & 255, dirn = tid >> 8;
            const f32x4* hr = (const f32x4*)((const float*)(ws + WS_H2C) + ((size_t)l * CTXL + n) * 64);
            LAS const float* wq = aux + dirn * 128;
            float a0 = 0.f, a1 = 0.f;
#pragma unroll 1
            for (int j8 = 0; j8 < 16; j8 += 8) {
                f32x4 hv[8];
#pragma unroll
                for (int q = 0; q < 8; ++q) hv[q] = hr[j8 + q];
#pragma unroll
                for (int q = 0; q < 8; ++q)
#pragma unroll
                    for (int e = 0; e < 4; ++e) { const int j = 4 * (j8 + q) + e; a0 += hv[q][e] * wq[j]; a1 += hv[q][e] * wq[64 + j]; }
            }
            const float e = __expf(-((float)n * (1.0f / 255.0f)) * delta);
            a0 *= e; a1 *= e;
            if (dirn == 0) { fs[255 + n] = a0; fs[512 + 255 + n] = a1; ss0 = a0 * a0; ss1 = a1 * a1; }
            else if (n >= 1) { fs[255 - n] = a0; fs[512 + 255 - n] = a1; ss0 = a0 * a0; ss1 = a1 * a1; }
        }
        if (tid == 0) { fs[511] = 0.f; fs[1023] = 0.f; }
        fs[1024 + tid] = z;
        const float2 ssb = block_sum2(ss0, ss1, red, tid);
        const float n0 = rsqrtf(ssb.x + 1e-6f);
        const float n1 = rsqrtf(ssb.y + 1e-6f);
        __syncthreads();
        const int gq = tid >> 7, cbt = (tid >> 6) & 1, cu = tid & 63;
#define HY_CCONV(kbase_, zbase_, res_) do { \
            f32x4 acc_ = {0.f, 0.f, 0.f, 0.f}; \
            LAS const float* kc_ = fs + (kbase_) + 252 + 4 * cu; LAS const float* zz_ = fs + (zbase_) + cbt * 256; \
            _Pragma("unroll 4") for (int v = 16 * gq; v < 16 * gq + 16; ++v) { \
                const f32x4 zq_ = *(LAS const f32x4*)(zz_ + 4 * v); const f32x4 ka_ = *(LAS const f32x4*)(kc_ - 4 * v), kb_ = *(LAS const f32x4*)(kc_ - 4 * v + 4); \
                const float k8_[8] = {ka_.x, ka_.y, ka_.z, ka_.w, kb_.x, kb_.y, kb_.z, kb_.w}; \
                _Pragma("unroll") for (int i = 0; i < 4; ++i) _Pragma("unroll") for (int j = 0; j < 4; ++j) acc_[i] += zq_[j] * k8_[3 + i - j]; } \
            *(LAS f32x4*)(fs + 2048 + gq * 512 + cbt * 256 + 4 * cu) = acc_; \
            __syncthreads(); \
            res_ = (fs[2048 + tid] + fs[2048 + 512 + tid]) + (fs[2048 + 1024 + tid] + fs[2048 + 1536 + tid]); } while (0)
        float y; HY_CCONV(0, 1024, y);
        const float z1 = x1 * (y * n0 + d0 * z);
        fs[1536 + tid] = z1;
        __syncthreads();
        float y2; HY_CCONV(512, 1536, y2);
#undef HY_CCONV
        const float o = x2 * (y2 * n1 + d1 * z1) * silu_f(gb);
        { const unsigned ov = pk2(o, 0.f) & 0xffffu; asm volatile("global_store_short %0, %1, off sc1\n\ts_nop 1" :: "v"(YBT + (size_t)c * MTOT + tok + t), "v"(ov) : "memory"); }
        __syncthreads();
    }

    unsigned* ZK = (unsigned*)((unsigned char*)A.out + OUT_ZS) + (size_t)c * 2 * NFFT;
#define HY_LD(prow_, R_, E_) do { _Pragma("unroll") for (int j = 0; j < 2; ++j) _Pragma("unroll") for (int b = 0; b < 2; ++b) { \
        const int q_ = tid + 512 * j; const bf16_t* p_ = (prow_) + (size_t)b * SEQ + 8 * q_; \
        R_[j][b] = *(const u32x4*)p_; E_[j][b][0] = p_[q_ > 0 ? -1 : 0]; E_[j][b][1] = p_[q_ < 1023 ? 8 : 7]; } } while (0)
#define HY_CONV(R_, E_, j_, b_, w0_, w1_, w2_, bias_, u_) do { \
        const int q_ = tid + 512 * (j_); const u32x4 raw_ = R_[j_][b_]; float own_[8]; \
        own_[0] = bflo(raw_.x); own_[1] = bfhi(raw_.x); own_[2] = bflo(raw_.y); own_[3] = bfhi(raw_.y); own_[4] = bflo(raw_.z); own_[5] = bfhi(raw_.z); own_[6] = bflo(raw_.w); own_[7] = bfhi(raw_.w); \
        const float pl_ = q_ > 0 ? bf2f(E_[j_][b_][0]) : 0.f, nl_ = q_ < 1023 ? bf2f(E_[j_][b_][1]) : 0.f; \
        _Pragma("unroll") for (int e = 0; e < 8; ++e) (u_)[e] = (w0_) * (e > 0 ? own_[e > 0 ? e - 1 : 0] : pl_) + (w1_) * own_[e] + (w2_) * (e < 7 ? own_[e < 7 ? e + 1 : 7] : nl_) + (bias_); } while (0)
    u32x4 rz[2][2]; bf16_t ez[2][2][2];
    {
        float ss0 = 0.f, ss1 = 0.f;
        const bf16_t* F0 = (const bf16_t*)(A.ws + WS_FILT) + (size_t)c * SEQ;
        u32x4 fw[2][4];
#pragma unroll
        for (int j = 0; j < 2; ++j)
#pragma unroll
            for (int r = 0; r < 4; ++r) fw[j][r] = *(const u32x4*)(F0 + (size_t)(256 * r) * SEQ + 8 * (tid + 512 * j));
#pragma unroll
        for (int j = 0; j < 2; ++j)
#pragma unroll
            for (int e8 = 0; e8 < 8; ++e8) {
                const int n = 8 * (tid + 512 * j) + e8;
                const float e = __expf(-((float)n * (1.0f / 8191.0f)) * delta);
                const unsigned w0 = e8 < 2 ? fw[j][0].x : (e8 < 4 ? fw[j][0].y : (e8 < 6 ? fw[j][0].z : fw[j][0].w)), w1 = e8 < 2 ? fw[j][1].x : (e8 < 4 ? fw[j][1].y : (e8 < 6 ? fw[j][1].z : fw[j][1].w));
                const unsigned w2 = e8 < 2 ? fw[j][2].x : (e8 < 4 ? fw[j][2].y : (e8 < 6 ? fw[j][2].z : fw[j][2].w)), w3 = e8 < 2 ? fw[j][3].x : (e8 < 4 ? fw[j][3].y : (e8 < 6 ? fw[j][3].z : fw[j][3].w));
                const float f0 = ((e8 & 1) ? bfhi(w0) : bflo(w0)) * e, f1 = ((e8 & 1) ? bfhi(w1) : bflo(w1)) * e, b0 = ((e8 & 1) ? bfhi(w2) : bflo(w2)) * e, b1 = ((e8 & 1) ? bfhi(w3) : bflo(w3)) * e;
                buf[PA(n)] = mk2(f0, f1); ss0 += f0 * f0; ss1 += f1 * f1;
                if (n >= 1) { buf[PA(NFFT - n)] = mk2(b0, b1); ss0 += b0 * b0; ss1 += b1 * b1; }
            }
        if (tid == 0) { const float zf = delta * 0.0f; buf[PA(SEQ)] = mk2(zf, zf); }
        HY_LD(rowz, rz, ez);
        const float2 ssl = block_sum2(ss0, ss1, red, tid);
        const float nrm0 = rsqrtf(ssl.x + 1e-6f) * (0.5f / NFFT);
        const float nrm1 = rsqrtf(ssl.y + 1e-6f) * (0.5f / NFFT);
        __syncthreads();
        fft_fwd(buf, tid);
#pragma unroll 4
        for (int k = 0; k < 32; ++k) {
            const int p = tid + 512 * k; const int f = (int)(__brev((unsigned)p) >> 18); const int pp = (int)(__brev((unsigned)((NFFT - f) & (NFFT - 1))) >> 18);
            const cf2 za = buf[PA(p)], zb = buf[PA(pp)];
            ZK[p] = pk2((za.x + zb.x) * nrm0 + d0 * (1.0f / NFFT), (za.y - zb.y) * nrm0);
            ZK[NFFT + p] = pk2((za.y + zb.y) * nrm1 + d1 * (1.0f / NFFT), -(za.x - zb.x) * nrm1);
        }
        __syncthreads();
    }
    const int pq0 = PA(8 * tid), pq1 = PA(8 * (tid + 512));
    {
        float ua[8], ub[8];
        HY_CONV(rz, ez, 0, 0, wz0, wz1, wz2, bz, ua); HY_CONV(rz, ez, 0, 1, wz0, wz1, wz2, bz, ub);
#pragma unroll
        for (int e = 0; e < 8; ++e) buf[pq0 + e] = mk2(ua[e], ub[e]);
        HY_CONV(rz, ez, 1, 0, wz0, wz1, wz2, bz, ua); HY_CONV(rz, ez, 1, 1, wz0, wz1, wz2, bz, ub);
#pragma unroll
        for (int e = 0; e < 8; ++e) buf[pq1 + e] = mk2(ua[e], ub[e]);
    }
    HY_LD(rowx1, rz, ez);
    __syncthreads();
    fft_fwd(buf, tid, ZK, true, false);
    fft_inv(buf, tid);
    {
        float xa[8], xb[8];
        HY_CONV(rz, ez, 0, 0, wa0, wa1, wa2, ba, xa); HY_CONV(rz, ez, 0, 1, wa0, wa1, wa2, ba, xb);
#pragma unroll
        for (int e = 0; e < 8; ++e) { const cf2 y = buf[pq0 + e]; buf[pq0 + e] = mk2(xa[e] * y.x, xb[e] * y.y); }
        HY_CONV(rz, ez, 1, 0, wa0, wa1, wa2, ba, xa); HY_CONV(rz, ez, 1, 1, wa0, wa1, wa2, ba, xb);
#pragma unroll
        for (int e = 0; e < 8; ++e) { const cf2 y = buf[pq1 + e]; buf[pq1 + e] = mk2(xa[e] * y.x, xb[e] * y.y); }
    }
    u32x4 rg[2][2];
    HY_LD(rowx2, rz, ez);
#pragma unroll
    for (int j = 0; j < 2; ++j)
#pragma unroll
        for (int b = 0; b < 2; ++b) rg[j][b] = *(const u32x4*)(rowg + (size_t)b * SEQ + 8 * (tid + 512 * j));
    __syncthreads();
    fft_fwd(buf, tid, ZK + NFFT, true, false);
    fft_inv(buf, tid);
    {
        bf16_t* yrow = YBT + (size_t)c * MTOT;
        float xa[8], xb[8];
#define HY_OUT(pq_, ga_, gb_, j_) do { float oa_[8], ob_[8]; \
            const float gaf_[8] = {bflo((ga_).x), bfhi((ga_).x), bflo((ga_).y), bfhi((ga_).y), bflo((ga_).z), bfhi((ga_).z), bflo((ga_).w), bfhi((ga_).w)}; \
            const float gbf_[8] = {bflo((gb_).x), bfhi((gb_).x), bflo((gb_).y), bfhi((gb_).y), bflo((gb_).z), bfhi((gb_).z), bflo((gb_).w), bfhi((gb_).w)}; \
            _Pragma("unroll") for (int e = 0; e < 8; ++e) { const cf2 y = buf[(pq_) + e]; oa_[e] = xa[e] * y.x * silu_f(gaf_[e]); ob_[e] = xb[e] * y.y * silu_f(gbf_[e]); } \
            u32x4 wa_, wb_; wa_.x = pk2(oa_[0], oa_[1]); wa_.y = pk2(oa_[2], oa_[3]); wa_.z = pk2(oa_[4], oa_[5]); wa_.w = pk2(oa_[6], oa_[7]); \
            wb_.x = pk2(ob_[0], ob_[1]); wb_.y = pk2(ob_[2], ob_[3]); wb_.z = pk2(ob_[4], ob_[5]); wb_.w = pk2(ob_[6], ob_[7]); \
            st16_wt(yrow + 8 * (tid + 512 * (j_)), wa_); st16_wt(yrow + SEQ + 8 * (tid + 512 * (j_)), wb_); } while (0)
        HY_CONV(rz, ez, 0, 0, wb0, wb1, wb2, bb, xa); HY_CONV(rz, ez, 0, 1, wb0, wb1, wb2, bb, xb);
        HY_OUT(pq0, rg[0][0], rg[0][1], 0);
        HY_CONV(rz, ez, 1, 0, wb0, wb1, wb2, bb, xa); HY_CONV(rz, ez, 1, 1, wb0, wb1, wb2, bb, xb);
        HY_OUT(pq1, rg[1][0], rg[1][1], 1);
#undef HY_OUT
    }
#undef HY_LD
#undef HY_CONV
    __syncthreads();
}

__device__ __forceinline__ void phase_tr(CKArgs& A, int l, LAS unsigned char* lds, int bid, int nblk, int tid);
__device__ __forceinline__ void phase_mix(CKArgs& A, int l, LAS unsigned char* lds, int bid, int nblk, int tid) {
    int nch = 0;
    for (int c = bid; c < 256; c += nblk) { hyena_block(A, l, c, lds, tid); ++nch; }
    unsigned* hyf = (unsigned*)A.ws + XB_HYFLAG + l;
    bool published = false;
    const int nctx = (l < DEPTH - 1) ? 12 : 0;
    const int nlr = (768 + nblk - 1) / nblk, ncr = (2 * nctx + nblk - 1) / nblk;
#pragma unroll 1
    for (int r = 0; r < nlr + ncr; ++r) {
        int it;
        if (r < nlr) { it = r * nblk + bid; if (it >= 768) continue; }
        else { const int j = (nblk - 1 - bid) + (r - nlr) * nblk; if (j >= 2 * nctx) continue; it = 768 + j; }
        int mode, item;
        if (it < 384) { mode = 0; item = it; } else if (it < 768) { mode = 1; item = it - 384; } else if (it < 768 + nctx) { mode = 2; item = it - 768; } else { mode = 3; item = it - 768 - nctx; }
        attn_block_item(A, l, mode, item, lds, tid);
        if (!published) { if (tid == 0 && nch > 0) xb_add(hyf, (unsigned)nch); published = true; }
    }
    if (!published) { asm volatile("s_waitcnt vmcnt(0)" ::: "memory"); __syncthreads(); if (tid == 0 && nch > 0) xb_add(hyf, (unsigned)nch); }
    if (tid == 0) { XB_SPIN(xb_ld(hyf) < 256u, (unsigned*)A.ws); __builtin_amdgcn_fence(__ATOMIC_ACQUIRE, "agent"); asm volatile("s_waitcnt vmcnt(0)" ::: "memory"); }
    __syncthreads();
    phase_tr(A, l, lds, bid, nblk, tid);
}

__device__ __forceinline__ void phase_tr(CKArgs& A, int l, LAS unsigned char* lds, int bid, int nblk, int tid) {
    const int wave = __builtin_amdgcn_readfirstlane(tid >> 6), lane = tid & 63;
    int gw = wave * nblk + bid, NGW = nblk * 8;
    if (nblk == 256 && l < DEPTH - 1) {
        const int rank = bid >= 128 ? bid - 128 : bid + 104;
        gw = bid < 232 ? wave * 232 + rank : (1 << 30);
    }
    unsigned char* ws = A.ws;
    const bf16_t* YBT = (const bf16_t*)(A.ws + WS_YBT);
    bf16_t* Y = (bf16_t*)(ws + WS_HY);
    LAS bf16_t* scr = (LAS bf16_t*)(lds + wave * 16384);
    const int ntok = (l < DEPTH - 1) ? MTOT : MLAT;
    const int nitems = (ntok / 64) * 4;
#pragma unroll 1
    for (int it = gw; it < nitems; it += NGW) {
        const int tb = (it >> 2) * 64, cb = (it & 3) * 64;
        u32x4 ld[8];
#pragma unroll
        for (int j = 0; j < 8; ++j) { const int idx = lane + 64 * j; ld[j] = *(const u32x4*)(YBT + (size_t)(cb + (idx >> 3)) * MTOT + tb + 8 * (idx & 7)); }
#pragma unroll
        for (int j = 0; j < 8; ++j) { const int idx = lane + 64 * j, ch = idx >> 3, t8 = 8 * (idx & 7);
#pragma unroll
            for (int e = 0; e < 8; ++e) { const unsigned w = e < 2 ? ld[j].x : (e < 4 ? ld[j].y : (e < 6 ? ld[j].z : ld[j].w));
                scr[(t8 + e) * 68 + ch] = (bf16_t)((e & 1) ? (w >> 16) : (w & 0xffffu)); } }
        asm volatile("s_waitcnt lgkmcnt(0)" ::: "memory");
#pragma unroll
        for (int k = 0; k < 8; ++k) {
            const int tq = (lane >> 3) + 8 * k, cc = (lane & 7) * 8;
            const u32x2 a = *(LAS const u32x2*)(scr + tq * 68 + cc), b2 = *(LAS const u32x2*)(scr + tq * 68 + cc + 4);
            u32x4 o; o.x = a.x; o.y = a.y; o.z = b2.x; o.w = b2.y;
            *(u32x4*)(Y + (size_t)(tb + tq) * DM + 384 + cb + cc) = o;
        }
        asm volatile("s_waitcnt lgkmcnt(0)" ::: "memory");
    }
}

__device__ __forceinline__ void phase_final(CKArgs& A, int bid, int nblk, int tid) {
    const int wave = __builtin_amdgcn_readfirstlane(tid >> 6), lane = tid & 63;
    const int gw = bid * 8 + wave, NGW = nblk * 8;
    const bf16_t* xb = (const bf16_t*)(A.ws + WS_XB);
#pragma unroll 1
    for (int m0 = gw; m0 < MLAT; m0 += 2 * NGW) {
        const int m1 = m0 + NGW; const bool has1 = m1 < MLAT; const int m1c = has1 ? m1 : m0;
        f32x4 xa[4], xc[4];
#pragma unroll
        for (int j = 0; j < 4; ++j) { const u32x2 w = *(const u32x2*)(xb + (size_t)m0 * DM + 4 * lane + 256 * j); xa[j] = (f32x4){bflo(w.x), bfhi(w.x), bflo(w.y), bfhi(w.y)}; }
#pragma unroll
        for (int j = 0; j < 4; ++j) { const u32x2 w = *(const u32x2*)(xb + (size_t)m1c * DM + 4 * lane + 256 * j); xc[j] = (f32x4){bflo(w.x), bfhi(w.x), bflo(w.y), bfhi(w.y)}; }
        const float ra = rsqrtf(wave_sum(norm_sumsq(xa), lane) * (1.0f / DM) + 1e-6f);
        const float rc = rsqrtf(wave_sum(norm_sumsq(xc), lane) * (1.0f / DM) + 1e-6f);
#pragma unroll
        for (int j = 0; j < 4; ++j) { const int col = 4 * lane + 256 * j; const f32x4 gv = *(const f32x4*)(A.final_g + col);
            *(f32x4*)(A.out + (size_t)m0 * DM + col) = xa[j] * ra * gv;
            if (has1) *(f32x4*)(A.out + (size_t)m1 * DM + col) = xc[j] * rc * gv; }
    }
}


struct XcdBarrier {
    unsigned* bar; unsigned x;
    volatile LAS unsigned* st;
};

__device__ __forceinline__ XcdBarrier xcd_barrier_post(unsigned* bar, volatile LAS unsigned* st) {
    XcdBarrier b; b.bar = bar; b.x = xb_xcc_id(); b.st = st;
    if (threadIdx.x == 0) (void)xb_add(&bar[XB_XCNT(b.x)], 1u);
    return b;
}
__device__ __forceinline__ void xcd_barrier_complete(unsigned* bar, unsigned x, unsigned& nloc, unsigned& nx) {
    const unsigned G = gridDim.x * gridDim.y * gridDim.z;
    unsigned sum, cnt, mine, sp = 0u;
    for (;;) {
        sum = 0u; cnt = 0u; mine = 0u;
#pragma unroll
        for (unsigned j = 0; j < 16; ++j) { const unsigned c = xb_ld(&bar[XB_XCNT(j)]); sum += c; cnt += (c > 0u) ? 1u : 0u; mine = (j == x) ? c : mine; }
        if (sum == G) break;
        __builtin_amdgcn_s_sleep(1);
        if ((++sp & 255u) == 0u) { if (xb_ld(&bar[XB_TMO])) break; if (sp > XB_SPIN_CAP) { atomicAdd(&bar[XB_TMO], 1u); break; } }
    }
    nloc = mine > 0u ? mine : 1u; nx = cnt > 0u ? cnt : 1u;
}

__device__ __forceinline__ void xcd_barrier(const XcdBarrier& b) {
    asm volatile("s_waitcnt vmcnt(0)" ::: "memory");
    __syncthreads();
    if (threadIdx.x == 0) {
        unsigned* bar = b.bar;
        __builtin_amdgcn_s_waitcnt(0);
        unsigned nloc = b.st[0], nx = b.st[1];
        if (nloc == 0u) { xcd_barrier_complete(bar, b.x, nloc, nx); b.st[0] = nloc; b.st[1] = nx; }
        const unsigned old = xb_add(&bar[XB_XSUB(b.x)], 1u);
        const unsigned gen = old / nloc;
        if (old + 1u == (gen + 1u) * nloc) {
            __builtin_amdgcn_fence(__ATOMIC_RELEASE, "agent");
            asm volatile("s_waitcnt vmcnt(0)" ::: "memory");
            const unsigned og = xb_add(&bar[XB_TOP], 1u);
            const unsigned tg = og / nx;
            asm volatile("buffer_inv sc1" ::: "memory");
            if (og + 1u == (tg + 1u) * nx) xb_add(&bar[XB_TOPGEN], 1u);
            else XB_SPIN(xb_ld(&bar[XB_TOPGEN]) == tg, bar);
            xb_add(&bar[XB_XGEN(b.x)], 1u);
            asm volatile("s_waitcnt vmcnt(0)" ::: "memory");
        } else {
            asm volatile("buffer_inv sc1" ::: "memory");
            XB_SPIN(xb_ld(&bar[XB_XGEN(b.x)]) == gen, bar);
            asm volatile("s_waitcnt vmcnt(0)" ::: "memory");
        }
    }
    __syncthreads();
}


constexpr int NPHASE = 2 + 5 * DEPTH;
__global__ void __launch_bounds__(NTHREADS, 2) hybrid_fwd(KArgs Aval) {
    extern __shared__ __attribute__((aligned(16))) unsigned char lds_raw[];
    LAS unsigned char* lds = (LAS unsigned char*)lds_raw;
    const int tid0 = threadIdx.x, bid = blockIdx.x, nblk = gridDim.x;
    const int wave0 = __builtin_amdgcn_readfirstlane(tid0 >> 6);
#if !MK_MULTI
    volatile LAS unsigned* bst = (volatile LAS unsigned*)(lds + AUX_OFF + 8192);
    if (tid0 < 2) bst[tid0] = 0u;
    __syncthreads();
    const XcdBarrier bar = xcd_barrier_post((unsigned*)Aval.ws, bst);
#endif
#ifndef REP_PH
#define REP_PH 1000
#endif
#pragma unroll 1
    for (int pi = Aval.ph_lo; pi < Aval.ph_hi + (REP_PH < 1000 ? 1 : 0); ++pi) {
        const int ph = pi <= REP_PH ? pi : pi - 1;
        if (nblk == 256 && ph == NPHASE - 1) continue;
        if (ph > 0 && ph < NPHASE - 1 && ((ph - 1) % 5) == 3) continue;
        if (nblk == 256 && ph > 1 && ph < NPHASE - 1 && ((ph - 1) % 5) == 0) continue;
#if !MK_MULTI
        if (pi > Aval.ph_lo) { if (Aval.ph_hi > 100000) cg::this_grid().sync(); else xcd_barrier(bar); }
#endif
#ifndef ONLY
#define ONLY -1
#endif
#define EN(k) (ONLY < 0 || ((ONLY >> (k)) & 1))
        int tid; asm volatile("v_mbcnt_lo_u32_b32 %0, -1, 0\n\tv_mbcnt_hi_u32_b32 %0, -1, %0" : "=v"(tid)); tid += wave0 * 64;
        CKArgs* Ap = (CKArgs*)__builtin_amdgcn_kernarg_segment_ptr(); asm volatile("" : "+s"(Ap));
        CKArgs& A = *Ap;
        unsigned char* ws = A.ws;
        if (ph == 0) { if (EN(0)) phase_prologue(A, lds, bid, nblk, tid); }
        else if (ph == NPHASE - 1) { if (EN(6)) phase_final(A, bid, nblk, tid); }
        else {
            const int l = (ph - 1) / 5, k = (ph - 1) % 5;
            if (k == 0) { if (EN(1)) phase_norm(A, l, bid, nblk, tid); }
            else if (k == 2) { if (EN(3)) phase_mix(A, l, lds, bid, nblk, tid); }
            else if (k == 3) { if (EN(4)) phase_tr(A, l, lds, bid, nblk, tid); }
            if (k == 1 || k == 4) {
                pg8::Gemm g; EpiAll E; E.l = l; E.Ap = Ap; g.K = DM; E.after = (k == 4) && (nblk == 256);
                g.A = k == 1 ? (const bf16_t*)((unsigned char*)A.out + OUT_H) : (const bf16_t*)(ws + WS_HY);
                if (k == 1) { g.Bt = (const bf16_t*)(ws + WS_WIN) + (size_t)l * NIN * DM; g.M = MTOT; g.N = NIN; E.mode = 0; }
                else { g.Bt = (const bf16_t*)(ws + WS_WOUT) + (size_t)l * DM * DM; g.M = MLAT; g.N = DM; E.mode = 1; }
                pg8::StaticOrder S; S.init(g.M, g.N, nblk, bid, k == 1 ? 10 : 0);
                E.ldsb = lds;
                if (k == 1 && !(l > 0 && nblk == 256)) {
                    for (int i = tid; i < 1024; i += NTHREADS) ((LAS f32x4*)(lds + 131072))[i] = ((const f32x4*)(ws + WS_ROPE))[i];
                    __syncthreads();
                }
                if (EN(2)) pg8::gemm_phase<EpiAll, pg8::StaticOrder, true, true>(lds, g, S, E, tid);
                if (k == 1) {
                    const int nu = (MTOT / 256) * (NIN / 256), nfull = nu - ((nu - 1) / nblk) * nblk;
                    if (nfull >= nblk) filt_items(A, l, tid, bid, nblk, nullptr); else if (bid >= nfull) filt_items(A, l, tid, bid - nfull, nblk - nfull, nullptr);
                }
                const bool rope_ahead = (k == 4) && (l < DEPTH - 1) && (nblk == 256);
                if (k == 4 && l < DEPTH - 1) {
                    f32x4 rt0 = {0.f, 0.f, 0.f, 0.f}, rt1 = {0.f, 0.f, 0.f, 0.f};
                    if (rope_ahead) { rt0 = ((const f32x4*)(ws + WS_ROPE))[tid]; rt1 = ((const f32x4*)(ws + WS_ROPE))[tid + NTHREADS]; }
                    ctx_outproj_items(A, l, lds, tid, bid, nblk, nblk == 256);
                    if (E.after) { pg8::Unit u; S.next(0, u); __syncthreads(); E.outnorm().pass2(u, lds, tid); ctx_norm_finish(A, l, tid, bid); }
                    if (rope_ahead) { ((LAS f32x4*)(lds + 131072))[tid] = rt0; ((LAS f32x4*)(lds + 131072))[tid + NTHREADS] = rt1; }
                }
                else if (k == 4 && E.after) { pg8::Unit u; S.next(0, u); __syncthreads(); E.outnorm().pass2f(u, lds, tid, A.final_g, A.out); }
            }
        }
    }
}

extern "C" void kernel_launch(void* const* d_in, const int* in_sizes, int n_in, void* d_out, int out_size, void* d_ws, size_t ws_size, hipStream_t stream) {
    static int grid = 0;
    if (grid == 0) {
        if (n_in != 22 || ws_size < WS_END) { fprintf(stderr, "kernel_launch: unexpected inputs (n_in %d, ws %zu)\n", n_in, ws_size); grid = -1; return; }
        int dev = 0, cus = 0, per_cu = 0;
        if (hipGetDevice(&dev) != hipSuccess || hipDeviceGetAttribute(&cus, hipDeviceAttributeMultiprocessorCount, dev) != hipSuccess) { grid = -1; return; }
        if (hipFuncSetAttribute((const void*)hybrid_fwd, hipFuncAttributeMaxDynamicSharedMemorySize, LDS_BYTES) != hipSuccess) { fprintf(stderr, "kernel_launch: hipFuncSetAttribute failed\n"); grid = -1; return; }
        if (hipOccupancyMaxActiveBlocksPerMultiprocessor(&per_cu, (const void*)hybrid_fwd, NTHREADS, LDS_BYTES) != hipSuccess || per_cu < 1) { fprintf(stderr, "kernel_launch: occupancy query says %d\n", per_cu); per_cu = 1; }
        (void)hipGetLastError();
        grid = cus;
    }
    if (grid < 0) return;
    KArgs a{};
    a.x = (const float*)d_in[0]; a.c = (const float*)d_in[1]; a.ctx = (const float*)d_in[2]; a.c_ctx = (const float*)d_in[3]; a.norm_g = (const float*)d_in[4];
    a.w_ada = (const float*)d_in[5]; a.b_ada = (const float*)d_in[6]; a.w_in = (const float*)d_in[7]; a.w_out = (const float*)d_in[8]; a.na_rpb = (const float*)d_in[9];
    a.hy_conv_w = (const float*)d_in[10]; a.hy_conv_b = (const float*)d_in[11]; a.hy_w1 = (const float*)d_in[12]; a.hy_b1 = (const float*)d_in[13]; a.hy_freq1 = (const float*)d_in[14];
    a.hy_w2 = (const float*)d_in[15]; a.hy_b2 = (const float*)d_in[16]; a.hy_freq2 = (const float*)d_in[17]; a.hy_w3 = (const float*)d_in[18]; a.hy_d = (const float*)d_in[19];
    a.sink = (const float*)d_in[20]; a.final_g = (const float*)d_in[21];
    a.out = (float*)d_out; a.ws = (unsigned char*)d_ws;
#if MK_MULTI
    for (int ph = 0; ph < NPHASE; ++ph) {
        a.ph_lo = ph; a.ph_hi = ph + 1;
        hipLaunchKernelGGL(hybrid_fwd, dim3(grid), dim3(NTHREADS), LDS_BYTES, stream, a);
    }
#else
    if (hipMemsetAsync(d_ws, 0, 16384, stream) != hipSuccess) { fprintf(stderr, "kernel_launch: memset of the barrier words failed\n"); return; }
    a.ph_lo = 0; a.ph_hi = NPHASE;
    void* args[] = {&a};
    hipError_t e = hipLaunchCooperativeKernel((const void*)hybrid_fwd, dim3(grid), dim3(NTHREADS), args, LDS_BYTES, stream);
    if (e != hipSuccess) fprintf(stderr, "cooperative launch failed: %s (grid %d)\n", hipGetErrorString(e), grid);
#endif
}
```
